# Optimizing an MI355X kernel written in HIP

```python
import numpy as np
import jax
import jax.numpy as jnp
from jax import lax

D_MODEL = 2048
BATCH = 4
SEQ = 4096
DEPTH = 2

MEM_LEN = 256
N_BRANCH = 4
MIXER_WIDTH = D_MODEL // 4
HEAD_DIM = 128
N_HEADS_MIX = MIXER_WIDTH // HEAD_DIM
POOL_WINDOWS = (2, 4, 8, 16)
POOL_GROUP_DIM = MIXER_WIDTH // len(POOL_WINDOWS)
CONV_WIDTH = 3
MLSTM_CHUNK = 64
RET_CHUNK = 64
ROPE_BASE = 10000.0
XATTN_HEADS = 4
XATTN_HEAD_DIM = 128
N_EXPERTS = 64
TOP_K = 8
N_GROUPS = 8
TOPK_GROUPS = 4
EXPERT_DIM = D_MODEL // 4
SHARED_DIM = D_MODEL // 4
ROUTE_SCALE = 2.5
MOE_BLOCK = 128
LN_EPS = 1e-5
DEEPNORM_ALPHA = (2 * DEPTH) ** 0.25
DEEPNORM_BETA = (8 * DEPTH) ** -0.25
PROJ_SIZES = (MIXER_WIDTH,
              MIXER_WIDTH, MIXER_WIDTH, MIXER_WIDTH,
              MIXER_WIDTH, MIXER_WIDTH, MIXER_WIDTH, MIXER_WIDTH, N_HEADS_MIX, N_HEADS_MIX,
              MIXER_WIDTH, MIXER_WIDTH, MIXER_WIDTH, MIXER_WIDTH,
              N_BRANCH * D_MODEL)
PROJ_WIDTH = sum(PROJ_SIZES)

kernel_name = 'hybrid_pool_conv_mlstm_retention_moe_deepnorm'

F32 = jnp.float32


def layer_norm(x, w, b):
    xf = x.astype(F32)
    mu = xf.mean(-1, keepdims=True)
    var = jnp.square(xf - mu).mean(-1, keepdims=True)
    return ((xf - mu) * lax.rsqrt(var + LN_EPS) * w.astype(F32) + b.astype(F32)).astype(x.dtype)


def head_norm(h, w):
    hf = h.astype(F32)
    mu = hf.mean(-1, keepdims=True)
    var = jnp.square(hf - mu).mean(-1, keepdims=True)
    y = ((hf - mu) * lax.rsqrt(var + LN_EPS)).reshape(h.shape[0], h.shape[1], -1) * w.astype(F32)
    return y.astype(h.dtype)


def pool_mixer(u, pool_w, pool_scale):
    b, s, _ = u.shape
    ug = u.astype(F32).reshape(b, s, len(POOL_WINDOWS), POOL_GROUP_DIM)
    csum = jnp.cumsum(ug, axis=1)
    t = jnp.arange(s)
    pooled = []
    for g, win in enumerate(POOL_WINDOWS):
        cg = csum[:, :, g]
        lagged = jnp.pad(cg, ((0, 0), (win, 0), (0, 0)))[:, :s]
        count = jnp.minimum(t + 1, win).astype(F32)[None, :, None]
        pooled.append((cg - lagged) / count)
    mixed = jnp.stack(pooled, axis=2) - ug
    y = jnp.einsum('bsgc,gcd->bsgd', mixed, pool_w.astype(F32))
    return (y.reshape(b, s, -1) * pool_scale.astype(F32)).astype(u.dtype)


def short_conv(h, gate_b, gate_c, conv_w):
    s = h.shape[1]
    z = gate_c * h
    zp = jnp.pad(z, ((0, 0), (CONV_WIDTH - 1, 0), (0, 0)))
    conv = conv_w[0] * zp[:, CONV_WIDTH - 1:CONV_WIDTH - 1 + s]
    for lag in range(1, CONV_WIDTH):
        start = CONV_WIDTH - 1 - lag
        conv = conv + conv_w[lag] * zp[:, start:start + s]
    return gate_b * conv


def _to_chunks(a, chunk):
    b, s, h = a.shape[:3]
    a = a.astype(F32).reshape(b, s // chunk, chunk, h, *a.shape[3:])
    return jnp.moveaxis(a, (1, 3), (0, 2))


def _from_chunks(a):
    a = jnp.moveaxis(a, (0, 2), (1, 3))
    return a.reshape(a.shape[0], a.shape[1] * a.shape[2], a.shape[3], a.shape[4])


def mlstm_chunkwise(q, k, v, i_pre, f_pre):
    b, s, h, d = q.shape
    L = MLSTM_CHUNK
    qc = _to_chunks(q, L)
    kc = _to_chunks(k, L) * d ** -0.5
    vc = _to_chunks(v, L)
    ic = _to_chunks(i_pre, L)
    fc = jax.nn.log_sigmoid(_to_chunks(f_pre, L))
    causal = jnp.tril(jnp.ones((L, L), dtype=bool))

    def step(carry, xs):
        c_mat, n_vec, m_prev = carry
        q_, k_, v_, i_, lf = xs
        cum_f = jnp.cumsum(lf, axis=-1)
        dmat = jnp.where(causal, cum_f[..., :, None] - cum_f[..., None, :] + i_[..., None, :], -jnp.inf)
        m_inter = cum_f + m_prev[..., None]
        m_t = jnp.maximum(m_inter, dmat.max(-1))
        p = jnp.exp(dmat - m_t[..., None]) * jnp.einsum('bhtd,bhsd->bhts', q_, k_)
        inter = jnp.exp(m_inter - m_t)
        num = inter[..., None] * jnp.einsum('bhtk,bhkv->bhtv', q_, c_mat) + jnp.einsum('bhts,bhsv->bhtv', p, v_)
        den = inter * jnp.einsum('bhtk,bhk->bht', q_, n_vec) + p.sum(-1)
        h_out = num / jnp.maximum(jnp.abs(den), jnp.exp(-m_t))[..., None]
        f_tot = cum_f[..., -1]
        g = f_tot[..., None] - cum_f + i_
        m_new = jnp.maximum(f_tot + m_prev, g.max(-1))
        decay = jnp.exp(f_tot + m_prev - m_new)
        wg = jnp.exp(g - m_new[..., None])
        c_mat = decay[..., None, None] * c_mat + jnp.einsum('bhs,bhsk,bhsv->bhkv', wg, k_, v_)
        n_vec = decay[..., None] * n_vec + jnp.einsum('bhs,bhsk->bhk', wg, k_)
        return (c_mat, n_vec, m_new), h_out

    init = (jnp.zeros((b, h, d, d), F32), jnp.zeros((b, h, d), F32), jnp.zeros((b, h), F32))
    _, hs = lax.scan(step, init, (qc, kc, vc, ic, fc))
    return _from_chunks(hs).astype(q.dtype)


def rotary(x):
    s, d = x.shape[1], x.shape[3]
    half = d // 2
    inv = ROPE_BASE ** (-jnp.arange(half, dtype=F32) / half)
    ang = jnp.arange(s, dtype=F32)[:, None] * inv[None, :]
    cos = jnp.cos(ang)[None, :, None, :]
    sin = jnp.sin(ang)[None, :, None, :]
    x1, x2 = x[..., :half], x[..., half:]
    return jnp.concatenate([x1 * cos - x2 * sin, x1 * sin + x2 * cos], axis=-1)


def retention_chunkwise(q, k, v):
    b, s, h, d = q.shape
    L = RET_CHUNK
    log_g = jnp.log(1.0 - 2.0 ** (-5.0 - jnp.arange(h, dtype=F32)))
    t = jnp.arange(L, dtype=F32)
    lag = t[:, None] - t[None, :]
    intra = jnp.where(lag >= 0, jnp.exp(jnp.maximum(lag, 0.0)[None] * log_g[:, None, None]), 0.0)
    cross = jnp.exp((t + 1.0)[None, :] * log_g[:, None])
    zeta = jnp.exp((L - 1.0 - t)[None, :] * log_g[:, None])
    chunk_decay = jnp.exp(L * log_g)
    qc = _to_chunks(q, L)
    kc = _to_chunks(k, L) * d ** -0.5
    vc = _to_chunks(v, L)

    def step(r_state, xs):
        q_, k_, v_ = xs
        inner = jnp.einsum('bhts,bhsv->bhtv', jnp.einsum('bhtd,bhsd->bhts', q_, k_) * intra, v_)
        crs = jnp.einsum('bhtk,bhkv->bhtv', q_, r_state) * cross[..., None]
        r_state = chunk_decay[:, None, None] * r_state + jnp.einsum('bhsk,bhsv->bhkv', k_ * zeta[..., None], v_)
        return r_state, inner + crs

    _, ys = lax.scan(step, jnp.zeros((b, h, d, d), F32), (qc, kc, vc))
    return _from_chunks(ys).astype(v.dtype)


def mixer_sublayer(h, w_in, gate_b, pool_w, pool_scale, conv_w, mlstm_norm_w, ret_norm_w, w_branch, w_out):
    b, s, _ = h.shape
    nh, hd = N_HEADS_MIX, HEAD_DIM
    split_at = np.cumsum(PROJ_SIZES)[:-1].tolist()
    (u_pool, c_h, c_b, c_c, m_q, m_k, m_v, m_o, m_i, m_f,
     r_q, r_k, r_v, r_g, g_pre) = jnp.split(h @ w_in, split_at, axis=-1)

    def heads(a):
        return a.reshape(b, s, nh, hd)

    y_pool = pool_mixer(u_pool, pool_w, pool_scale)
    y_conv = short_conv(c_h, c_b, c_c, conv_w)
    m_h = mlstm_chunkwise(heads(m_q), heads(m_k), heads(m_v), m_i + gate_b[:nh], m_f + gate_b[nh:])
    y_mlstm = head_norm(heads(jax.nn.sigmoid(m_o)) * m_h, mlstm_norm_w)
    r_h = retention_chunkwise(rotary(heads(r_q).astype(F32)), rotary(heads(r_k).astype(F32)), heads(r_v))
    y_ret = jax.nn.silu(r_g) * head_norm(r_h, ret_norm_w)

    gates = jax.nn.sigmoid(g_pre.reshape(b, s, N_BRANCH, D_MODEL))
    branches = (y_pool, y_conv, y_mlstm, y_ret)
    merged = gates[:, :, 0] * (branches[0] @ w_branch[0])
    for n in range(1, N_BRANCH):
        merged = merged + gates[:, :, n] * (branches[n] @ w_branch[n])
    return merged @ w_out


def memory_xattn(h, mem, wq, wk, wv, wo):
    b, s, _ = h.shape
    m = mem.shape[1]
    q = (h @ wq).reshape(b, s, XATTN_HEADS, XATTN_HEAD_DIM)
    k = (mem @ wk).reshape(b, m, XATTN_HEADS, XATTN_HEAD_DIM)
    v = (mem @ wv).reshape(b, m, XATTN_HEADS, XATTN_HEAD_DIM)
    scores = jnp.einsum('bshd,bmhd->bhsm', q, k).astype(F32) * XATTN_HEAD_DIM ** -0.5
    probs = jax.nn.softmax(scores, axis=-1).astype(h.dtype)
    o = jnp.einsum('bhsm,bmhd->bshd', probs, v).reshape(b, s, XATTN_HEADS * XATTN_HEAD_DIM)
    return o @ wo


def swiglu(x, w_gu, w_dn):
    g, u = jnp.split(x @ w_gu, 2, axis=-1)
    return (jax.nn.silu(g) * u) @ w_dn


def route(xt, router_w, router_b):
    t = xt.shape[0]
    scores = jax.nn.sigmoid((xt @ router_w).astype(F32))
    biased = scores + router_b.astype(F32)
    grp = biased.reshape(t, N_GROUPS, N_EXPERTS // N_GROUPS)
    grp_score = lax.top_k(grp, 2)[0].sum(-1)
    _, grp_idx = lax.top_k(grp_score, TOPK_GROUPS)
    grp_mask = jax.nn.one_hot(grp_idx, N_GROUPS, dtype=F32).sum(1)
    exp_mask = jnp.repeat(grp_mask, N_EXPERTS // N_GROUPS, axis=1) > 0
    _, idx = lax.top_k(jnp.where(exp_mask, biased, -jnp.inf), TOP_K)
    w = jnp.take_along_axis(scores, idx, axis=1)
    w = w / w.sum(-1, keepdims=True) * ROUTE_SCALE
    return idx, w


def routed_experts(xt, idx, wts, w_gu, w_dn):
    t, dm = xt.shape
    flat_e = idx.reshape(-1).astype(jnp.int32)
    flat_w = wts.reshape(-1)
    a = flat_e.shape[0]
    order = jnp.argsort(flat_e).astype(jnp.int32)
    e_sorted = flat_e[order]
    counts = jnp.bincount(flat_e, length=N_EXPERTS).astype(jnp.int32)
    starts = jnp.cumsum(counts) - counts
    pcounts = (counts + MOE_BLOCK - 1) // MOE_BLOCK * MOE_BLOCK
    pends = jnp.cumsum(pcounts)
    pstarts = pends - pcounts
    dest = pstarts[e_sorted] + jnp.arange(a, dtype=jnp.int32) - starts[e_sorted]
    n_blocks = -(-a // MOE_BLOCK) + N_EXPERTS
    rows = n_blocks * MOE_BLOCK
    tok_buf = jnp.full((rows,), t, jnp.int32).at[dest].set(order // TOP_K)
    w_buf = jnp.zeros((rows,), xt.dtype).at[dest].set(flat_w[order].astype(xt.dtype))
    blk_e = jnp.minimum(jnp.searchsorted(pends, jnp.arange(n_blocks, dtype=jnp.int32) * MOE_BLOCK, side='right'),
                        N_EXPERTS - 1).astype(jnp.int32)
    x_pad = jnp.concatenate([xt, jnp.zeros((1, dm), xt.dtype)], axis=0)

    def step(out, blk):
        tok, wb, e = blk
        y = swiglu(x_pad[tok], w_gu[e], w_dn[e])
        return out.at[tok].add(y * wb[:, None]), None

    out, _ = lax.scan(step, jnp.zeros((t + 1, dm), xt.dtype),
                      (tok_buf.reshape(n_blocks, MOE_BLOCK), w_buf.reshape(n_blocks, MOE_BLOCK), blk_e))
    return out[:t]


def moe_sublayer(h, router_w, router_b, w_gu, w_dn, s_gu, s_dn):
    b, s, dm = h.shape
    xt = h.reshape(b * s, dm)
    idx, w = route(xt, router_w, router_b)
    y = routed_experts(xt, idx, w, w_gu, w_dn) + swiglu(xt, s_gu, s_dn)
    return y.reshape(b, s, dm)


def setup_inputs(seed: int = 0) -> dict:
    key = jax.random.key(seed)
    ks = jax.random.split(key, 24)

    def nrm(k, shape, scale):
        return jax.random.normal(k, shape, F32) * scale

    W, H, D = MIXER_WIDTH, N_HEADS_MIX, D_MODEL
    beta = DEEPNORM_BETA
    x = nrm(ks[0], (BATCH, SEQ, D), 1.0)
    mem = nrm(ks[1], (BATCH, MEM_LEN, D), 1.0)
    w_in = nrm(ks[2], (DEPTH, D, PROJ_WIDTH), D ** -0.5)
    i_bias = nrm(ks[3], (DEPTH, H), 0.1)
    f_bias = jnp.linspace(3.0, 6.0, H, dtype=F32)[None, :] + nrm(ks[4], (DEPTH, H), 0.1)
    mlstm_gate_b = jnp.concatenate([i_bias, f_bias], axis=-1)
    pool_w = nrm(ks[5], (DEPTH, len(POOL_WINDOWS), POOL_GROUP_DIM, POOL_GROUP_DIM), POOL_GROUP_DIM ** -0.5)
    pool_scale = 1.0 + nrm(ks[6], (DEPTH, W), 0.02)
    conv_w = nrm(ks[7], (DEPTH, CONV_WIDTH, W), CONV_WIDTH ** -0.5)
    mlstm_norm_w = 1.0 + nrm(ks[8], (DEPTH, W), 0.02)
    ret_norm_w = 1.0 + nrm(ks[9], (DEPTH, W), 0.02)
    w_branch = nrm(ks[10], (DEPTH, N_BRANCH, W, D), W ** -0.5)
    w_mix_out = nrm(ks[11], (DEPTH, D, D), D ** -0.5 * beta)
    xa_wq = nrm(ks[12], (DEPTH, D, XATTN_HEADS * XATTN_HEAD_DIM), D ** -0.5)
    xa_wk = nrm(ks[13], (DEPTH, D, XATTN_HEADS * XATTN_HEAD_DIM), D ** -0.5)
    xa_wv = nrm(ks[14], (DEPTH, D, XATTN_HEADS * XATTN_HEAD_DIM), D ** -0.5 * beta)
    xa_wo = nrm(ks[15], (DEPTH, XATTN_HEADS * XATTN_HEAD_DIM, D), (XATTN_HEADS * XATTN_HEAD_DIM) ** -0.5 * beta)
    router_w = nrm(ks[16], (DEPTH, D, N_EXPERTS), D ** -0.5)
    router_b = nrm(ks[17], (DEPTH, N_EXPERTS), 0.01)
    moe_w_gu = nrm(ks[18], (DEPTH, N_EXPERTS, D, 2 * EXPERT_DIM), D ** -0.5)
    moe_w_dn = nrm(ks[19], (DEPTH, N_EXPERTS, EXPERT_DIM, D), EXPERT_DIM ** -0.5 * beta)
    shared_w_gu = nrm(ks[20], (DEPTH, D, 2 * SHARED_DIM), D ** -0.5)
    shared_w_dn = nrm(ks[21], (DEPTH, SHARED_DIM, D), SHARED_DIM ** -0.5 * beta)
    ln_w = 1.0 + nrm(ks[22], (DEPTH, 3, D), 0.02)
    ln_b = nrm(ks[23], (DEPTH, 3, D), 0.02)
    return {'x': x, 'mem': mem, 'w_in': w_in, 'mlstm_gate_b': mlstm_gate_b, 'pool_w': pool_w,
            'pool_scale': pool_scale, 'conv_w': conv_w, 'mlstm_norm_w': mlstm_norm_w,
            'ret_norm_w': ret_norm_w, 'w_branch': w_branch, 'w_mix_out': w_mix_out,
            'xa_wq': xa_wq, 'xa_wk': xa_wk, 'xa_wv': xa_wv, 'xa_wo': xa_wo,
            'router_w': router_w, 'router_b': router_b, 'moe_w_gu': moe_w_gu, 'moe_w_dn': moe_w_dn,
            'shared_w_gu': shared_w_gu, 'shared_w_dn': shared_w_dn, 'ln_w': ln_w, 'ln_b': ln_b}


def reference(x, mem, w_in, mlstm_gate_b, pool_w, pool_scale, conv_w, mlstm_norm_w, ret_norm_w,
              w_branch, w_mix_out, xa_wq, xa_wk, xa_wv, xa_wo, router_w, router_b,
              moe_w_gu, moe_w_dn, shared_w_gu, shared_w_dn, ln_w, ln_b):
    for l in range(DEPTH):
        y = mixer_sublayer(x, w_in[l], mlstm_gate_b[l], pool_w[l], pool_scale[l], conv_w[l],
                           mlstm_norm_w[l], ret_norm_w[l], w_branch[l], w_mix_out[l])
        x = layer_norm(DEEPNORM_ALPHA * x + y, ln_w[l, 0], ln_b[l, 0])
        y = memory_xattn(x, mem, xa_wq[l], xa_wk[l], xa_wv[l], xa_wo[l])
        x = layer_norm(DEEPNORM_ALPHA * x + y, ln_w[l, 1], ln_b[l, 1])
        y = moe_sublayer(x, router_w[l], router_b[l], moe_w_gu[l], moe_w_dn[l], shared_w_gu[l], shared_w_dn[l])
        x = layer_norm(DEEPNORM_ALPHA * x + y, ln_w[l, 2], ln_b[l, 2])
    return x
```

```cpp
#include <hip/hip_runtime.h>
#include <cstdio>
#include <cstdint>

#ifndef PROBE_DBL
#define PROBE_DBL 0
#endif
#ifndef MK_PER_PHASE
#define MK_PER_PHASE 0
#endif

typedef unsigned short bf16_t;
typedef float f32x4 __attribute__((ext_vector_type(4)));
typedef float f32x2 __attribute__((ext_vector_type(2)));
typedef unsigned u32x4 __attribute__((ext_vector_type(4)));
typedef unsigned u32x2 __attribute__((ext_vector_type(2)));
#define LAS __attribute__((address_space(3)))

constexpr int BATCH = 4, SEQ = 4096, T = BATCH * SEQ, D = 2048, DEPTH = 2;
constexpr int W = 512, NH = 4, HD = 128, CH = 64, NCH = SEQ / CH, NBH = BATCH * NH;
constexpr int PROJ_W = 14344, NBR = 6144, NPROJ = 14336;
constexpr int MEM = 256, TM = BATCH * MEM;
constexpr int NE = 64, NEX = 65, TOPK = 8, ED = 512;
constexpr int NSLOT = 164096;
constexpr float LN_EPS = 1e-5f, ALPHA = 1.41421356237f, ROUTE_SCALE = 2.5f;
constexpr int NTHR = 512;

constexpr int PC_U = 0, PC_CH = 512, PC_CB = 1024, PC_CC = 1536, PC_MQ = 2048, PC_MK = 2560, PC_MV = 3072, PC_MO = 3584, PC_RQ = 4096, PC_RK = 4608, PC_RV = 5120, PC_RG = 5632;

constexpr size_t al256(size_t x) { return (x + 255) & ~(size_t)255; }
constexpr size_t WS_CTL = 0;
constexpr size_t CTL_BYTES = 65536;
constexpr int CW_COUNTS = 8192;
constexpr size_t WS_WIN = WS_CTL + CTL_BYTES;
constexpr size_t SZ_WIN = (size_t)NPROJ * D * 2;
constexpr size_t WS_WIF = WS_WIN + DEPTH * SZ_WIN;
constexpr size_t SZ_WIF = 8 * D * 4;
constexpr size_t WS_WB = WS_WIF + DEPTH * SZ_WIF;
constexpr size_t SZ_DD = (size_t)D * D * 2;
constexpr size_t WS_WOUT = WS_WB + DEPTH * SZ_DD;
constexpr size_t WS_WQ = WS_WOUT + DEPTH * SZ_DD;
constexpr size_t SZ_WQ = (size_t)W * D * 2;
constexpr size_t WS_WK = WS_WQ + DEPTH * SZ_WQ;
constexpr size_t WS_WV = WS_WK + DEPTH * SZ_WQ;
constexpr size_t WS_WO = WS_WV + DEPTH * SZ_WQ;
constexpr size_t WS_WGU = WS_WO + DEPTH * SZ_WQ;
constexpr size_t SZ_WGU1 = (size_t)1024 * D * 2;
constexpr size_t WS_WDN = WS_WGU + (size_t)DEPTH * NEX * SZ_WGU1;
constexpr size_t SZ_WDN1 = (size_t)D * ED * 2;
constexpr size_t WS_ROPE = WS_WDN + (size_t)DEPTH * NEX * SZ_WDN1;
constexpr size_t WS_X = WS_ROPE + (size_t)SEQ * 64 * 4 * 2;
constexpr size_t SZ_TD4 = (size_t)T * D * 4;
constexpr size_t WS_Y = WS_X + SZ_TD4;
constexpr size_t WS_XB = WS_Y + SZ_TD4;
constexpr size_t SZ_TD2 = (size_t)T * D * 2;
constexpr size_t WS_MEMB = WS_XB + SZ_TD2;
constexpr size_t WS_KM = WS_MEMB + (size_t)TM * D * 2;
constexpr size_t WS_VM = WS_KM + (size_t)DEPTH * TM * W * 2;
constexpr size_t WS_PROJ = WS_VM + (size_t)DEPTH * TM * W * 2;
constexpr size_t WS_GATES = WS_PROJ + (size_t)T * NBR * 2;
constexpr size_t WS_CUMF = WS_GATES + (size_t)T * 8192 * 2;
constexpr size_t WS_IPRE = WS_CUMF + (size_t)NBH * SEQ * 4;
constexpr size_t WS_SUMM = WS_IPRE + (size_t)NBH * SEQ * 4;
constexpr size_t WS_CST = WS_SUMM + al256((size_t)NBH * NCH * 2 * 4);
constexpr size_t WS_NST = WS_CST + (size_t)2 * NBH * NCH * HD * HD * 2;
constexpr size_t WS_BR = WS_NST + (size_t)NBH * NCH * HD * 4;
constexpr size_t WS_MRG = WS_BR + SZ_TD2;
constexpr size_t WS_Q = WS_MRG + SZ_TD2;
constexpr size_t WS_O = WS_Q + (size_t)T * W * 2;
constexpr size_t WS_EID = WS_O + (size_t)T * W * 2;
constexpr size_t WS_EW = WS_EID + (size_t)T * 8 * 4;
constexpr size_t WS_EPOS = WS_EW + (size_t)T * 8 * 4;
constexpr size_t WS_SLOTOF = WS_EPOS + (size_t)T * 8 * 4;
constexpr size_t WS_TOK = WS_SLOTOF + (size_t)T * 8 * 4;
constexpr size_t WS_WSL = WS_TOK + al256((size_t)NSLOT * 4);
constexpr size_t WS_HB = WS_WSL + al256((size_t)NSLOT * 4);
constexpr size_t WS_YB = WS_HB + (size_t)NSLOT * ED * 2;
constexpr size_t WS_AV = WS_YB + (size_t)NSLOT * D * 2;
constexpr size_t WS_PM = WS_AV + (size_t)NBH * SEQ * 4;
constexpr size_t WS_MSEQ = WS_PM + (size_t)NBH * SEQ * 4;
constexpr size_t WS_XB8 = WS_MSEQ + al256((size_t)NBH * 80 * 4);
constexpr size_t WS_WGU8 = WS_XB8 + (size_t)T * D;
constexpr size_t SZ_WGU8 = (size_t)1024 * D;
constexpr size_t WS_WIN8 = WS_WGU8 + (size_t)DEPTH * NEX * SZ_WGU8;
constexpr size_t SZ_WIN8 = (size_t)NPROJ * D;
constexpr size_t WS_RWT = WS_WIN8 + DEPTH * SZ_WIN8;
constexpr size_t WS_XQ8 = WS_RWT + (size_t)DEPTH * 2 * NE * D * 2;
constexpr size_t WS_XSC = WS_XQ8 + (size_t)T * D;
constexpr size_t WS_WINQ = WS_XSC + al256((size_t)T * 4);
constexpr size_t SZ_WINQ = (size_t)NBR * D;
constexpr size_t WS_END = WS_WINQ + DEPTH * SZ_WINQ;
constexpr int CW_WABS = 8320;
constexpr float X8_SCALE = 16.0f, W8_SCALE = 256.0f, H8_SCALE = 8.0f, Y8_SCALE = 64.0f;

constexpr int LDS_BYTES = 147456;

__device__ __forceinline__ bf16_t f2bf(float f) { unsigned u = __float_as_uint(f); u += 0x7FFFu + ((u >> 16) & 1u); return (bf16_t)(u >> 16); }
__device__ __forceinline__ float bf2f(bf16_t b) { return __uint_as_float(((unsigned)b) << 16); }
__device__ __forceinline__ unsigned pack2(float lo, float hi) { unsigned r; asm("v_cvt_pk_bf16_f32 %0, %1, %2" : "=v"(r) : "v"(lo), "v"(hi)); return r; }
__device__ __forceinline__ float sigmoidf_(float x) { return __builtin_amdgcn_rcpf(1.0f + __builtin_amdgcn_exp2f(-1.4426950408889634f * x)); }
__device__ __forceinline__ unsigned pack_fp8x4(float a, float b, float c, float d) {
    a = __builtin_amdgcn_fmed3f(a, -448.f, 448.f); b = __builtin_amdgcn_fmed3f(b, -448.f, 448.f); c = __builtin_amdgcn_fmed3f(c, -448.f, 448.f); d = __builtin_amdgcn_fmed3f(d, -448.f, 448.f);
    int w = 0; w = __builtin_amdgcn_cvt_pk_fp8_f32(a, b, w, false); w = __builtin_amdgcn_cvt_pk_fp8_f32(c, d, w, true); return (unsigned)w; }
__device__ __forceinline__ unsigned pack_i8x4(float a, float b, float c, float d) {
    const int ia = (int)__builtin_amdgcn_fmed3f(rintf(a), -127.f, 127.f), ib = (int)__builtin_amdgcn_fmed3f(rintf(b), -127.f, 127.f), ic = (int)__builtin_amdgcn_fmed3f(rintf(c), -127.f, 127.f), id = (int)__builtin_amdgcn_fmed3f(rintf(d), -127.f, 127.f);
    return (unsigned)(ia & 255) | ((unsigned)(ib & 255) << 8) | ((unsigned)(ic & 255) << 16) | ((unsigned)(id & 255) << 24); }
__device__ __forceinline__ float wave_sum(float v) { for (int o = 32; o >= 1; o >>= 1) v += __shfl_xor(v, o); return v; }
__device__ __forceinline__ float wave_max(float v) { for (int o = 32; o >= 1; o >>= 1) v = fmaxf(v, __shfl_xor(v, o)); return v; }

#define XB_TMO      128
#define XB_XCNT(j)  (256  + 64 * (j))
#define XB_XSUB(j)  (1280 + 64 * (j))
#define XB_XGEN(j)  (2304 + 64 * (j))
#define XB_TOP      3328
#define XB_TOPGEN   3392
#define XCD_BAR_WORDS 3456
#define XB_SPIN_CAP (1u << 27)
__device__ __forceinline__ unsigned xb_ld(unsigned* p)              { return __hip_atomic_load(p, __ATOMIC_RELAXED, __HIP_MEMORY_SCOPE_AGENT); }
__device__ __forceinline__ unsigned xb_add(unsigned* p, unsigned v) { return __hip_atomic_fetch_add(p, v, __ATOMIC_RELAXED, __HIP_MEMORY_SCOPE_AGENT); }
__device__ __forceinline__ unsigned xb_xcc_id() { return (unsigned)__builtin_amdgcn_s_getreg((3 << 11) | 20) & 0xFu; }
#define XB_SPIN(cond, bar) do { unsigned _sp = 0; while (cond) { __builtin_amdgcn_s_sleep(1); \
    if ((++_sp & 255u) == 0u) { if (xb_ld(&(bar)[XB_TMO])) break; if (_sp > XB_SPIN_CAP) { atomicAdd(&(bar)[XB_TMO], 1u); break; } } } } while (0)
struct XcdBarrier { unsigned* bar; unsigned x; volatile LAS unsigned* st; };
__device__ __forceinline__ XcdBarrier xcd_barrier_post(unsigned* bar, volatile LAS unsigned* st) {
    XcdBarrier b; b.bar = bar; b.x = xb_xcc_id(); b.st = st;
    if (threadIdx.x == 0) (void)xb_add(&bar[XB_XCNT(b.x)], 1u);
    return b;
}
__device__ __forceinline__ void xcd_barrier_complete(unsigned* bar, unsigned x, unsigned& nloc, unsigned& nx) {
    const unsigned G = gridDim.x * gridDim.y * gridDim.z;
    unsigned sum, cnt, mine, sp = 0u;
    for (;;) {
        sum = 0u; cnt = 0u; mine = 0u;
#pragma unroll
        for (unsigned j = 0; j < 16; ++j) { const unsigned c = xb_ld(&bar[XB_XCNT(j)]); sum += c; cnt += (c > 0u) ? 1u : 0u; mine = (j == x) ? c : mine; }
        if (sum == G) break;
        __builtin_amdgcn_s_sleep(1);
        if ((++sp & 255u) == 0u) { if (xb_ld(&bar[XB_TMO])) break; if (sp > XB_SPIN_CAP) { atomicAdd(&bar[XB_TMO], 1u); break; } }
    }
    nloc = mine > 0u ? mine : 1u; nx = cnt > 0u ? cnt : 1u;
}
__device__ __forceinline__ void xcd_barrier(const XcdBarrier& b) {
    asm volatile("s_waitcnt vmcnt(0)" ::: "memory");
    __syncthreads();
    if (threadIdx.x == 0) {
        unsigned* bar = b.bar;
        __builtin_amdgcn_s_waitcnt(0);
        unsigned nloc = b.st[0], nx = b.st[1];
        if (nloc == 0u) { xcd_barrier_complete(bar, b.x, nloc, nx); b.st[0] = nloc; b.st[1] = nx; }
        const unsigned old = xb_add(&bar[XB_XSUB(b.x)], 1u);
        const unsigned gen = old / nloc;
        if (old + 1u == (gen + 1u) * nloc) {
            __builtin_amdgcn_fence(__ATOMIC_RELEASE, "agent");
            asm volatile("s_waitcnt vmcnt(0)" ::: "memory");
            const unsigned og = xb_add(&bar[XB_TOP], 1u);
            const unsigned tg = og / nx;
            if (og + 1u == (tg + 1u) * nx) xb_add(&bar[XB_TOPGEN], 1u);
            else XB_SPIN(xb_ld(&bar[XB_TOPGEN]) == tg, bar);
            __builtin_amdgcn_fence(__ATOMIC_ACQUIRE, "agent");
            xb_add(&bar[XB_XGEN(b.x)], 1u);
            asm volatile("s_waitcnt vmcnt(0)" ::: "memory");
        } else {
            XB_SPIN(xb_ld(&bar[XB_XGEN(b.x)]) == gen, bar);
            __builtin_amdgcn_fence(__ATOMIC_ACQUIRE, "agent");
            asm volatile("s_waitcnt vmcnt(0)" ::: "memory");
        }
    }
    __syncthreads();
}

struct Args { const float* in[23]; float* out; unsigned char* ws; int ph_lo, ph_hi; };
enum { IN_X = 0, IN_MEM, IN_WIN, IN_GATEB, IN_POOLW, IN_POOLS, IN_CONVW, IN_MNORM, IN_RNORM, IN_WBR, IN_WMIX, IN_WQ, IN_WK, IN_WV, IN_WO, IN_RW, IN_RB, IN_WGU, IN_WDN, IN_SGU, IN_SDN, IN_LNW, IN_LNB };

#define GAS __attribute__((address_space(1)))
struct DArgs { const GAS float* in[23]; GAS float* out; GAS unsigned char* ws; int ph_lo, ph_hi; };
typedef const __attribute__((address_space(4))) DArgs* KArgs;
struct Frame {
    LAS unsigned char* lds; int tid, lane, wave, wg, nwg;
    GAS unsigned char* wsg; KArgs ka;
    __device__ __forceinline__ unsigned char* ws_() const { return (unsigned char*)wsg; }
};
__device__ __forceinline__ Frame fresh(const Frame& F) { Frame G = F; asm volatile("" : "+s"(G.wsg)); asm volatile("" : "+s"(G.ka)); asm volatile("" : "+v"(G.tid)); asm volatile("" : "+s"(G.wg));
    G.lane = G.tid & 63; G.wave = __builtin_amdgcn_readfirstlane(G.tid >> 6); return G; }

struct GUnit {
    const bf16_t* Bt;
    const bf16_t* A;
    const int* gather;
    int row0;
    int pn;
    int e;
    bf16_t* dst;
};

__device__ __forceinline__ void un8(u32x4 w, f32x4& a, f32x4& b) { a[0] = __uint_as_float(w[0] << 16); a[1] = __uint_as_float(w[0] & 0xffff0000u); a[2] = __uint_as_float(w[1] << 16); a[3] = __uint_as_float(w[1] & 0xffff0000u);
    b[0] = __uint_as_float(w[2] << 16); b[1] = __uint_as_float(w[2] & 0xffff0000u); b[2] = __uint_as_float(w[3] << 16); b[3] = __uint_as_float(w[3] & 0xffff0000u); }
__device__ __forceinline__ void st_bf16x8(bf16_t* p, f32x4 a, f32x4 b) { u32x4 w; w[0] = pack2(a[0], a[1]); w[1] = pack2(a[2], a[3]); w[2] = pack2(b[0], b[1]); w[3] = pack2(b[2], b[3]); *(u32x4*)p = w; }
__device__ __forceinline__ void st_bf16x4(bf16_t* p, f32x4 v) { u32x2 w; w.x = pack2(v[0], v[1]); w.y = pack2(v[2], v[3]); *(u32x2*)p = w; }
__device__ __forceinline__ void ld_row32(const bf16_t* row, int lane, float (&v)[32]) {
#pragma unroll
    for (int j = 0; j < 4; ++j) { const u32x4 w = *(const u32x4*)(row + j * 512 + lane * 8);
#pragma unroll
        for (int e = 0; e < 4; ++e) { v[j * 8 + 2 * e] = __uint_as_float(w[e] << 16); v[j * 8 + 2 * e + 1] = __uint_as_float(w[e] & 0xffff0000u); } } }
__device__ __forceinline__ void st_row32(bf16_t* row, int lane, const float (&v)[32]) {
#pragma unroll
    for (int j = 0; j < 4; ++j) { u32x4 w;
#pragma unroll
        for (int e = 0; e < 4; ++e) w[e] = pack2(v[j * 8 + 2 * e], v[j * 8 + 2 * e + 1]);
        *(u32x4*)(row + j * 512 + lane * 8) = w; } }
__device__ __forceinline__ void st_row32_i8(unsigned char* row, float* sc, int lane, const float (&v)[32]) {
    float am = 0.f;
#pragma unroll
    for (int j = 0; j < 32; ++j) am = fmaxf(am, fabsf(v[j]));
    am = fmaxf(wave_max(am), 1e-30f); const float q = 127.0f / am;
#pragma unroll
    for (int j = 0; j < 4; ++j) { u32x2 w; w.x = pack_i8x4(v[j * 8] * q, v[j * 8 + 1] * q, v[j * 8 + 2] * q, v[j * 8 + 3] * q); w.y = pack_i8x4(v[j * 8 + 4] * q, v[j * 8 + 5] * q, v[j * 8 + 6] * q, v[j * 8 + 7] * q);
        *(u32x2*)(row + j * 512 + lane * 8) = w; }
    if (lane == 0) *sc = am * (1.0f / 127.0f); }
__device__ __forceinline__ void st_row32_fp8(unsigned char* row, int lane, const float (&v)[32]) {
#pragma unroll
    for (int j = 0; j < 4; ++j) { u32x2 w; w.x = pack_fp8x4(v[j * 8] * X8_SCALE, v[j * 8 + 1] * X8_SCALE, v[j * 8 + 2] * X8_SCALE, v[j * 8 + 3] * X8_SCALE); w.y = pack_fp8x4(v[j * 8 + 4] * X8_SCALE, v[j * 8 + 5] * X8_SCALE, v[j * 8 + 6] * X8_SCALE, v[j * 8 + 7] * X8_SCALE);
        *(u32x2*)(row + j * 512 + lane * 8) = w; } }
struct NoPre { };
struct EpiProj {
    static constexpr bool SEG = false; typedef NoPre Pre;
    bf16_t* proj; bf16_t* gates;
    static __device__ __forceinline__ float unit_scale(const GUnit& u) { return (u.pn == PC_MK / 256 || u.pn == PC_MK / 256 + 1 || u.pn == PC_RK / 256 || u.pn == PC_RK / 256 + 1) ? 0.08838834764831845f : 1.0f; }
    __device__ __forceinline__ void pre(const GUnit&, int, int, Pre&) const {}
    __device__ __forceinline__ void fin(const GUnit& u, int r, int c, const f32x4 (&a)[2][2], const Pre&) const {
        const int col = u.pn * 256 + c; const size_t row = (size_t)(u.row0 + r);
        if (col < NBR) { st_bf16x8(proj + row * NBR + col, a[0][0], a[0][1]); st_bf16x8(proj + row * NBR + col + 128, a[1][0], a[1][1]); }
        else { f32x4 s[2][2];
#pragma unroll
            for (int h = 0; h < 2; ++h)
#pragma unroll
                for (int n = 0; n < 2; ++n)
#pragma unroll
                    for (int j = 0; j < 4; ++j) s[h][n][j] = fmaxf(sigmoidf_(a[h][n][j]), 1e-7f);
            st_bf16x8(gates + row * 8192 + (col - NBR), s[0][0], s[0][1]); st_bf16x8(gates + row * 8192 + (col - NBR) + 128, s[1][0], s[1][1]); }
    }
};
struct EpiBranch {
    static constexpr bool SEG = true;
    struct Pre { u32x4 g0, g1; };
    struct SPre { u32x4 a0, a1, b0, b1; };
    const bf16_t* gates; bf16_t* out;
    __device__ __forceinline__ void pre(const GUnit& u, int r, int c, Pre& p) const { const bf16_t* g = gates + (size_t)(u.row0 + r) * 8192 + 3 * 2048 + u.pn * 256 + c; p.g0 = *(const u32x4*)g; p.g1 = *(const u32x4*)(g + 128); }
    __device__ __forceinline__ void fin(const GUnit& u, int r, int c, const f32x4 (&a)[2][2], const Pre& p) const {
        f32x4 x0, x1, y0, y1; un8(p.g0, x0, x1); un8(p.g1, y0, y1);
        bf16_t* o = out + (size_t)(u.row0 + r) * D + u.pn * 256 + c; st_bf16x8(o, a[0][0] * x0, a[0][1] * x1); st_bf16x8(o + 128, a[1][0] * y0, a[1][1] * y1); }
    __device__ __forceinline__ void seg_pre(const GUnit& u, int r, int c, int s, SPre& p) const { const bf16_t* g = gates + (size_t)(u.row0 + r) * 8192 + s * 2048 + u.pn * 256 + c;
        p.a0 = *(const u32x4*)g; p.a1 = *(const u32x4*)(g + 128); p.b0 = *(const u32x4*)(g + 2048); p.b1 = *(const u32x4*)(g + 2048 + 128); }
    __device__ __forceinline__ void seg_fin(f32x4 (&h0)[2], f32x4 (&h1)[2], const SPre& p) const {
        f32x4 a0, a1, b0, b1; un8(p.a0, a0, a1); un8(p.b0, b0, b1);
#pragma unroll
        for (int j = 0; j < 4; ++j) { h0[0][j] *= a0[j] * __builtin_amdgcn_rcpf(b0[j]); h0[1][j] *= a1[j] * __builtin_amdgcn_rcpf(b1[j]); }
        un8(p.a1, a0, a1); un8(p.b1, b0, b1);
#pragma unroll
        for (int j = 0; j < 4; ++j) { h1[0][j] *= a0[j] * __builtin_amdgcn_rcpf(b0[j]); h1[1][j] *= a1[j] * __builtin_amdgcn_rcpf(b1[j]); }
    }
};
struct EpiResid {
    static constexpr bool SEG = false;
    struct Pre { u32x4 x0, x1; };
    const bf16_t* x; bf16_t* y;
    __device__ __forceinline__ void pre(const GUnit& u, int r, int c, Pre& p) const { const bf16_t* xp = x + (size_t)(u.row0 + r) * D + u.pn * 256 + c; p.x0 = *(const u32x4*)xp; p.x1 = *(const u32x4*)(xp + 128); }
    __device__ __forceinline__ void fin(const GUnit& u, int r, int c, const f32x4 (&a)[2][2], const Pre& p) const {
        f32x4 x0, x1, y0, y1; un8(p.x0, x0, x1); un8(p.x1, y0, y1);
        bf16_t* o = y + (size_t)(u.row0 + r) * D + u.pn * 256 + c; st_bf16x8(o, x0 * ALPHA + a[0][0], x1 * ALPHA + a[0][1]); st_bf16x8(o + 128, y0 * ALPHA + a[1][0], y1 * ALPHA + a[1][1]); }
};
struct EpiQKV {
    static constexpr bool SEG = false; typedef NoPre Pre; int pad_;
    __device__ __forceinline__ void pre(const GUnit&, int, int, Pre&) const {}
    __device__ __forceinline__ void fin(const GUnit& u, int r, int c, const f32x4 (&a)[2][2], const Pre&) const {
        bf16_t* o = u.dst + (size_t)(u.row0 + r) * W + u.pn * 256 + c; st_bf16x8(o, a[0][0], a[0][1]); st_bf16x8(o + 128, a[1][0], a[1][1]); }
};
struct EpiSwiglu {
    static constexpr bool SEG = false;
    struct Pre { float w; };
    const float* wsl; unsigned char* hb;
    __device__ __forceinline__ void pre(const GUnit& u, int r, int, Pre& p) const { p.w = wsl[u.row0 + r] * H8_SCALE; }
    __device__ __forceinline__ void fin(const GUnit& u, int r, int c, const f32x4 (&a)[2][2], const Pre& p) const {
        f32x4 o[2];
#pragma unroll
        for (int n = 0; n < 2; ++n)
#pragma unroll
            for (int j = 0; j < 4; ++j) o[n][j] = a[0][n][j] * sigmoidf_(a[0][n][j]) * a[1][n][j] * p.w;
        u32x2 w8; w8.x = pack_fp8x4(o[0][0], o[0][1], o[0][2], o[0][3]); w8.y = pack_fp8x4(o[1][0], o[1][1], o[1][2], o[1][3]); *(u32x2*)(hb + (size_t)(u.row0 + r) * ED + u.pn * 128 + c) = w8; }
};
struct EpiDown {
    static constexpr bool SEG = false; typedef NoPre Pre;
    unsigned char* yb;
    __device__ __forceinline__ void pre(const GUnit&, int, int, Pre&) const {}
    __device__ __forceinline__ void fin(const GUnit& u, int r, int c, const f32x4 (&a)[2][2], const Pre&) const {
        unsigned char* o = yb + (size_t)(u.row0 + r) * D + u.pn * 256 + c;
        u32x2 w0, w1; w0.x = pack_fp8x4(a[0][0][0], a[0][0][1], a[0][0][2], a[0][0][3]); w0.y = pack_fp8x4(a[0][1][0], a[0][1][1], a[0][1][2], a[0][1][3]);
        w1.x = pack_fp8x4(a[1][0][0], a[1][0][1], a[1][0][2], a[1][0][3]); w1.y = pack_fp8x4(a[1][1][0], a[1][1][1], a[1][1][2], a[1][1][3]);
        *(u32x2*)o = w0; *(u32x2*)(o + 128) = w1; }
};

typedef short bf16x8 __attribute__((ext_vector_type(8)));
typedef short s16x4 __attribute__((ext_vector_type(4)));
__device__ __forceinline__ s16x4 lds_tr(const LAS bf16_t* p) { return __builtin_amdgcn_ds_read_tr16_b64_v4i16((LAS s16x4*)p); }
__device__ __forceinline__ bf16x8 cat4(s16x4 a, s16x4 b) { bf16x8 r; r[0] = a[0]; r[1] = a[1]; r[2] = a[2]; r[3] = a[3]; r[4] = b[0]; r[5] = b[1]; r[6] = b[2]; r[7] = b[3]; return r; }
__device__ __forceinline__ bf16x8 pack8(f32x4 a, f32x4 b) { union { u32x4 u; bf16x8 h; } c; c.u[0] = pack2(a[0], a[1]); c.u[1] = pack2(a[2], a[3]); c.u[2] = pack2(b[0], b[1]); c.u[3] = pack2(b[2], b[3]); return c.h; }
constexpr int BK = 64, HTB = 128 * BK * 2;
__device__ __forceinline__ int lds_byte(int r, int c) { const int st = (r >> 4) * 2 + (c >> 5), rr = r & 15, cc = c & 31, ob = rr * 64 + cc * 2; return st * 1024 + (ob ^ (((ob >> 9) & 1) << 5)); }
__device__ __forceinline__ void stage_rc(int b, int& R, int& C) { const int st = b / 1024, sb = b % 1024, swz = sb ^ (((sb >> 9) & 1) << 5); R = (st >> 1) * 16 + swz / 64; C = (st & 1) * 32 + (swz % 64) / 2; }

typedef int i32x8 __attribute__((ext_vector_type(8)));
typedef int i32x4 __attribute__((ext_vector_type(4)));
template <class Epi, class Sched, int MODE = 0>
__device__ __forceinline__ void gemm_phase_mfma(const Frame& F, const int K, const Sched& S, const Epi& E, const float oscale = 1.0f, const float* rowscale = nullptr) {
    constexpr bool FP8 = (MODE == 1), I8 = (MODE == 2);
    LAS unsigned char* lds = F.lds;
    const int tid = F.tid, wid = F.wave, lane = F.lane, wr = wid >> 2, wc = wid & 3, fr = lane & 15, fq = lane >> 4;
    const int KB = MODE ? K : 2 * K;
    const int nt = KB / 128;
    unsigned voffB[2];
#pragma unroll
    for (int i = 0; i < 2; ++i) { int R, C; stage_rc(tid * 16 + i * 8192, R, C); const int rho = R & 31, Rb = (R & ~31) + 8 * ((rho & 15) >> 2) + 4 * (rho >> 4) + (rho & 3); voffB[i] = (unsigned)(Rb * KB + C * 2); }
    const size_t kstep = (size_t)(BK * 2);
    const size_t hstepB = (size_t)128 * KB;
    const unsigned ldsw = (unsigned)wid * 1024u;
    const int aoff = FP8 ? lds_byte(wr * 64 + fr, fq * 16) : lds_byte(wr * 64 + fr, fq * 8), boff = FP8 ? lds_byte(wc * 32 + fr, fq * 16) : lds_byte(wc * 32 + fr, fq * 8);
#define SA_(b, h) (((b) * 2 + (h)) * HTB)
#define SB_(b, h) ((4 + (b) * 2 + (h)) * HTB)
#define STAGE_(bufoff, gbase, voff) do { _Pragma("unroll") for (int _i = 0; _i < 2; ++_i) \
        __builtin_amdgcn_global_load_lds((const unsigned*)((const char*)(gbase) + (voff)[_i]), (LAS unsigned*)(lds + (bufoff) + ldsw + _i * 8192), 16, 0, 0); } while (0)
#define LDA_(dst, b, h) do { _Pragma("unroll") for (int m = 0; m < 4; ++m) { if constexpr (FP8) { const i32x4 _lo = *(const LAS i32x4*)(lds + SA_(b, h) + aoff + m * 2048), _hi = *(const LAS i32x4*)(lds + SA_(b, h) + aoff + m * 2048 + 16); \
            dst##8[m] = __builtin_shufflevector(_lo, _hi, 0, 1, 2, 3, 4, 5, 6, 7); } \
        else { _Pragma("unroll") for (int k = 0; k < 2; ++k) dst[m][k] = *(const LAS bf16x8*)(lds + SA_(b, h) + aoff + m * 2048 + k * 1024); } } } while (0)
#define LDB_(dst, b, h) do { _Pragma("unroll") for (int n = 0; n < 2; ++n) { if constexpr (FP8) { const i32x4 _lo = *(const LAS i32x4*)(lds + SB_(b, h) + boff + n * 2048), _hi = *(const LAS i32x4*)(lds + SB_(b, h) + boff + n * 2048 + 16); \
            dst##8[n] = __builtin_shufflevector(_lo, _hi, 0, 1, 2, 3, 4, 5, 6, 7); } \
        else { _Pragma("unroll") for (int k = 0; k < 2; ++k) dst[n][k] = *(const LAS bf16x8*)(lds + SB_(b, h) + boff + n * 2048 + k * 1024); } } } while (0)
#define MMA_(ai, bj, At, Bt) do { __builtin_amdgcn_s_setprio(1); _Pragma("unroll") for (int m = 0; m < 4; ++m) _Pragma("unroll") for (int n = 0; n < 2; ++n) { \
        if constexpr (FP8) asm volatile("v_mfma_scale_f32_16x16x128_f8f6f4 %0, %1, %2, %0, %3, %3 op_sel_hi:[0,0,0]" : "+v"(acc[ai][bj][m][n]) : "v"(Bt##8[n]), "v"(At##8[m]), "v"(sc8)); \
        else if constexpr (I8) { _Pragma("unroll") for (int k = 0; k < 2; ++k) acci[ai][bj][m][n] = __builtin_amdgcn_mfma_i32_16x16x64_i8(__builtin_bit_cast(i32x4, Bt[n][k]), __builtin_bit_cast(i32x4, At[m][k]), acci[ai][bj][m][n], 0, 0, 0); } \
        else { _Pragma("unroll") for (int k = 0; k < 2; ++k) acc[ai][bj][m][n] = __builtin_amdgcn_mfma_f32_16x16x32_bf16(Bt[n][k], At[m][k], acc[ai][bj][m][n], 0, 0, 0); } } \
        __builtin_amdgcn_s_setprio(0); } while (0)
#define WAIT_V_(n) asm volatile("s_waitcnt vmcnt(" #n ")" ::: "memory")
#define WAIT_L_(n) asm volatile("s_waitcnt lgkmcnt(" #n ")" ::: "memory")
#define BAR_ __builtin_amdgcn_s_barrier()
#define SCHED_ __builtin_amdgcn_sched_barrier(0)
#define VOFFS_(dst, u) do { int _tz = tid; asm volatile("" : "+v"(_tz)); _Pragma("unroll") for (int _i = 0; _i < 2; ++_i) { int _R, _C; stage_rc(_tz * 16 + _i * 8192, _R, _C); \
        _Pragma("unroll") for (int _h = 0; _h < 2; ++_h) { const int _r = _h * 128 + _R; \
        const unsigned _row = (u).gather ? (unsigned)(u).gather[_r] : (unsigned)((u).row0 + _r); dst[_h][_i] = _row * (unsigned)KB + (unsigned)_C * 2u; } } } while (0)
    GUnit cur, nxt; int ui = 0;
    if (!S.get(0, cur)) return;
    f32x4 acc[2][2][4][2]; i32x4 acci[2][2][4][2];
#pragma unroll
    for (int a = 0; a < 2; ++a)
#pragma unroll
        for (int b = 0; b < 2; ++b)
#pragma unroll
            for (int m = 0; m < 4; ++m)
#pragma unroll
                for (int n = 0; n < 2; ++n) { acc[a][b][m][n] = (f32x4){0.f, 0.f, 0.f, 0.f}; acci[a][b][m][n] = (i32x4){0, 0, 0, 0}; }
    bf16x8 At[4][2], B0[2][2], B1[2][2]; i32x8 At8[4], B08[2], B18[2];
    int sc8 = 0x7f7f7f7f; asm volatile("" : "+v"(sc8));
    unsigned vA[2][2], vN[2][2];
    VOFFS_(vA, cur);
    const char* cA = (const char*)cur.A; const char* cB = (const char*)cur.Bt;
    STAGE_(SB_(0, 0), cB, voffB); STAGE_(SA_(0, 0), cA, vA[0]); STAGE_(SB_(0, 1), cB + hstepB, voffB); STAGE_(SA_(0, 1), cA, vA[1]);
    if (wr == 1) BAR_;
    WAIT_V_(4); BAR_;
    STAGE_(SB_(1, 0), cB + kstep, voffB); STAGE_(SA_(1, 0), cA + kstep, vA[0]); STAGE_(SB_(1, 1), cB + hstepB + kstep, voffB);
    WAIT_V_(6); BAR_;
    for (;;) {
        const bool has_next = S.get(ui + 1, nxt);
        const char* nA = has_next ? (const char*)nxt.A : cA; const char* nB = has_next ? (const char*)nxt.Bt : cB;
        if (has_next) { VOFFS_(vN, nxt); }
        for (int t = 0; t < nt; t += 2) {
            const bool last = (t == nt - 2);
            if constexpr (Epi::SEG) { if (t > 0 && (t & 7) == 0) {
                int tz = tid; asm volatile("" : "+v"(tz)); const int er = ((tz >> 8) & 1) * 64 + (tz & 15), ec = ((tz >> 6) & 3) * 32 + ((tz >> 4) & 3) * 8;
#pragma unroll
                for (int ai = 0; ai < 2; ++ai) { typename Epi::SPre sp[4];
#pragma unroll
                    for (int m = 0; m < 4; ++m) E.seg_pre(cur, ai * 128 + m * 16 + er, ec, (t >> 3) - 1, sp[m]);
#pragma unroll
                    for (int m = 0; m < 4; ++m) E.seg_fin(acc[ai][0][m], acc[ai][1][m], sp[m]);
                    asm volatile("" ::: "memory"); }
            } }
            const char* a1 = cA + (size_t)(t + 1) * kstep;
            const char* a2 = last ? nA : cA + (size_t)(t + 2) * kstep; const char* b2 = last ? nB : cB + (size_t)(t + 2) * kstep;
            const char* a3 = a2 + kstep; const char* b3 = b2 + kstep;
            unsigned w0[2], w1[2];
#pragma unroll
            for (int i = 0; i < 2; ++i) { w0[i] = (last && has_next) ? vN[0][i] : vA[0][i]; w1[i] = (last && has_next) ? vN[1][i] : vA[1][i]; }
            LDB_(B0, 0, 0); SCHED_; LDA_(At, 0, 0); STAGE_(SA_(1, 1), a1, vA[1]);
            WAIT_L_(8); BAR_; WAIT_L_(0); MMA_(0, 0, At, B0); BAR_; SCHED_;
            LDB_(B1, 0, 1); STAGE_(SB_(0, 0), b2, voffB);
            BAR_; WAIT_L_(0); MMA_(0, 1, At, B1); BAR_;
            LDA_(At, 0, 1); STAGE_(SA_(0, 0), a2, w0);
            BAR_; WAIT_L_(0); MMA_(1, 0, At, B0); BAR_; SCHED_;
            STAGE_(SB_(0, 1), b2 + hstepB, voffB);
            WAIT_V_(6); BAR_; MMA_(1, 1, At, B1); BAR_;
            LDB_(B0, 1, 0); SCHED_; LDA_(At, 1, 0); STAGE_(SA_(0, 1), a2, w1);
            WAIT_L_(8); BAR_; WAIT_L_(0); MMA_(0, 0, At, B0); BAR_; SCHED_;
            LDB_(B1, 1, 1); STAGE_(SB_(1, 0), b3, voffB);
            BAR_; WAIT_L_(0); MMA_(0, 1, At, B1); BAR_;
            LDA_(At, 1, 1); STAGE_(SA_(1, 0), a3, w0);
            BAR_; WAIT_L_(0); MMA_(1, 0, At, B0); BAR_; SCHED_;
            STAGE_(SB_(1, 1), b3 + hstepB, voffB);
            WAIT_V_(6); BAR_; MMA_(1, 1, At, B1); BAR_;
        }
        { int tz = tid; asm volatile("" : "+v"(tz)); const int er = ((tz >> 8) & 1) * 64 + (tz & 15), ec = ((tz >> 6) & 3) * 32 + ((tz >> 4) & 3) * 8;
          typename Epi::Pre pre[2][4];
#pragma unroll
          for (int ai = 0; ai < 2; ++ai)
#pragma unroll
              for (int m = 0; m < 4; ++m) E.pre(cur, ai * 128 + m * 16 + er, ec, pre[ai][m]);
          if constexpr (I8) {
#pragma unroll
              for (int ai = 0; ai < 2; ++ai)
#pragma unroll
                  for (int m = 0; m < 4; ++m) { const float rs = rowscale[cur.row0 + ai * 128 + m * 16 + er] * oscale * Epi::unit_scale(cur);
#pragma unroll
                      for (int bj = 0; bj < 2; ++bj)
#pragma unroll
                          for (int n = 0; n < 2; ++n)
#pragma unroll
                              for (int j = 0; j < 4; ++j) acc[ai][bj][m][n][j] = (float)acci[ai][bj][m][n][j] * rs; } }
          if constexpr (FP8) {
#pragma unroll
              for (int ai = 0; ai < 2; ++ai)
#pragma unroll
                  for (int bj = 0; bj < 2; ++bj)
#pragma unroll
                      for (int m = 0; m < 4; ++m)
#pragma unroll
                          for (int n = 0; n < 2; ++n) acc[ai][bj][m][n] *= oscale; }
#pragma unroll
          for (int ai = 0; ai < 2; ++ai)
#pragma unroll
              for (int m = 0; m < 4; ++m) { const f32x4 a4[2][2] = {{acc[ai][0][m][0], acc[ai][0][m][1]}, {acc[ai][1][m][0], acc[ai][1][m][1]}}; E.fin(cur, ai * 128 + m * 16 + er, ec, a4, pre[ai][m]); } }
        if (!has_next) break;
#pragma unroll
        for (int a = 0; a < 2; ++a)
#pragma unroll
            for (int b = 0; b < 2; ++b)
#pragma unroll
                for (int m = 0; m < 4; ++m)
#pragma unroll
                    for (int n = 0; n < 2; ++n) { acc[a][b][m][n] = (f32x4){0.f, 0.f, 0.f, 0.f}; acci[a][b][m][n] = (i32x4){0, 0, 0, 0}; }
        cur = nxt; cA = nA; cB = nB; ++ui;
#pragma unroll
        for (int h = 0; h < 2; ++h)
#pragma unroll
            for (int i = 0; i < 2; ++i) vA[h][i] = vN[h][i];
    }
    WAIT_V_(0);
    if (wr == 0) BAR_;
    BAR_;
#undef SA_
#undef SB_
#undef STAGE_
#undef LDA_
#undef LDB_
#undef MMA_
#undef WAIT_V_
#undef WAIT_L_
#undef BAR_
#undef SCHED_
#undef VOFFS_
}

struct DenseSched {
    const bf16_t* A; const bf16_t* Bt; int K, nM, nN, nwg, G, c, i0, i1, split, pnoff;
    __device__ __forceinline__ void segment(int sg) { i0 = sg == 0 ? 0 : split; i1 = sg == 0 ? split : (1 << 30); }
    __device__ __forceinline__ bool get(int ii, GUnit& u) const {
        const int i = ii + i0; if (i >= i1) return false;
        const long L = (long)i * G + c; if (L >= nwg) return false;
        int wgid = (int)L; { const int q = nwg / 8, r = nwg % 8, xcd = wgid % 8, off = wgid / 8; wgid = (xcd < r ? xcd * (q + 1) : r * (q + 1) + (xcd - r) * q) + off; }
        const int nig = 8 * nN, gid = wgid / nig, fm = gid * 8, gsz = (nM - fm) < 8 ? (nM - fm) : 8;
        const int pm = fm + ((wgid % nig) % gsz), pn = (wgid % nig) / gsz;
        u.pn = pn + pnoff; u.row0 = pm * 256; u.A = A; u.gather = nullptr; u.Bt = Bt + (size_t)pn * 256 * K; u.e = 0; return true;
    }
};
struct QkvSched {
    unsigned char* ws; int l, G, c;
    __device__ __forceinline__ bool get(int i, GUnit& g) const {
        const int u = i * G + c; if (u >= 144) return false; g.gather = nullptr;
        if (u < 128) { g.e = 0; g.pn = u & 1; g.row0 = (u >> 1) * 256; g.A = (const bf16_t*)(ws + WS_XB); g.Bt = (const bf16_t*)(ws + WS_WQ + l * SZ_WQ) + (size_t)g.pn * 256 * D; g.dst = (bf16_t*)(ws + WS_Q); }
        else { const int v = u - 128; g.e = 1 + (v >> 3); g.pn = v & 1; g.row0 = ((v >> 1) & 3) * 256; g.A = (const bf16_t*)(ws + WS_MEMB); g.Bt = (const bf16_t*)(ws + (g.e == 1 ? WS_WK : WS_WV) + l * SZ_WQ) + (size_t)g.pn * 256 * D; g.dst = (bf16_t*)(ws + (g.e == 1 ? WS_KM : WS_VM)) + (size_t)l * TM * W; }
        return true;
    }
};
template <int NCT, bool GATEUP> struct MoeSched {
    unsigned char* ws; const LAS int* pst; int l, G, c, nunits;
    __device__ __forceinline__ bool get(int i, GUnit& g) const {
        const int u = i * G + c; if (u >= nunits) return false;
        const int rt = u / NCT; g.pn = u % NCT; g.row0 = rt * 256; const int e = __builtin_amdgcn_readfirstlane((int)((const LAS unsigned char*)(pst + 68))[rt]); g.e = e;
        if (GATEUP) { g.A = (const bf16_t*)(ws + WS_XB8); g.gather = (const int*)(ws + WS_TOK) + g.row0; g.Bt = (const bf16_t*)(ws + WS_WGU8 + ((size_t)l * NEX + e) * SZ_WGU8 + (size_t)g.pn * 256 * D); }
        else { g.A = (const bf16_t*)(ws + WS_HB); g.gather = nullptr; g.Bt = (const bf16_t*)(ws + WS_WDN + ((size_t)l * NEX + e) * SZ_WDN1 + (size_t)g.pn * 256 * ED); }
        return true;
    }
};

struct TDesc { const float* sp; int sld; unsigned char* dp; int dldb; int fp8; float qs; };
constexpr int TK_WINA = 1024, TK_WINB = 2560, TK_BR = 384, TK_WOUT = 512, TK_QKV = 384, TK_WO = 128, TK_GU = NEX * 8 * 32, TK_DN = NEX * 128;
constexpr int TK_L0DEF = TK_BR + TK_WOUT + TK_QKV + TK_WO + TK_GU + TK_DN, TK_LAYER = TK_WINA + TK_WINB + TK_L0DEF;
__device__ __forceinline__ void tile_desc(const Frame& F, int l, int t, TDesc& d) {
    const KArgs a = F.ka; unsigned char* ws = F.ws_(); d.fp8 = 0; d.qs = W8_SCALE;
    if (t < TK_WINA) { const int tk = t >> 6, tc = t & 63; d.sp = ((const float*)a->in[IN_WIN]) + (size_t)l * D * PROJ_W + (size_t)tk * 128 * PROJ_W + tc * 64; d.sld = PROJ_W; d.dldb = D; d.fp8 = 2; d.qs = 127.0f / fmaxf(__uint_as_float(((const unsigned*)(ws + WS_CTL))[CW_WABS + l]), 1e-30f); d.dp = ws + WS_WINQ + l * SZ_WINQ + (size_t)tc * 64 * D + tk * 128; return; }
    t -= TK_WINA;
    if (t < TK_WINB) { const int tk = t / 160, tc = t % 160; d.sp = ((const float*)a->in[IN_WIN]) + (size_t)l * D * PROJ_W + (size_t)tk * 128 * PROJ_W + 4104 + tc * 64; d.sld = PROJ_W;
        if (tc < 32) { d.dldb = D; d.fp8 = 2; d.qs = 127.0f / fmaxf(__uint_as_float(((const unsigned*)(ws + WS_CTL))[CW_WABS + l]), 1e-30f); d.dp = ws + WS_WINQ + l * SZ_WINQ + (size_t)(4096 + tc * 64) * D + tk * 128; }
        else { d.dldb = D; d.fp8 = 1; d.dp = ws + WS_WIN8 + l * SZ_WIN8 + (size_t)(4096 + tc * 64) * D + tk * 128; }
        return; }
    t -= TK_WINB;
    if (t < TK_BR) { const int n = 1 + (t >> 7), tt = t & 127, tk = tt >> 5, tc = tt & 31; d.sp = ((const float*)a->in[IN_WBR]) + ((size_t)l * 4 + n) * W * D + (size_t)tk * 128 * D + tc * 64; d.sld = D; d.dldb = D * 2; d.dp = ws + WS_WB + l * SZ_DD + ((size_t)tc * 64 * D + n * W + tk * 128) * 2; return; }
    t -= TK_BR;
    if (t < TK_WOUT) { const int tk = t >> 5, tc = t & 31; d.sp = ((const float*)a->in[IN_WMIX]) + (size_t)l * D * D + (size_t)tk * 128 * D + tc * 64; d.sld = D; d.dldb = D * 2; d.dp = ws + WS_WOUT + l * SZ_DD + ((size_t)tc * 64 * D + tk * 128) * 2; return; }
    t -= TK_WOUT;
    if (t < TK_QKV) { const int which = t >> 7, tt = t & 127, tk = tt >> 3, tc = tt & 7; d.sp = (const float*)a->in[which == 0 ? IN_WQ : (which == 1 ? IN_WK : IN_WV)] + (size_t)l * D * W + (size_t)tk * 128 * W + tc * 64; d.sld = W; d.dldb = D * 2;
        d.dp = ws + (which == 0 ? WS_WQ : (which == 1 ? WS_WK : WS_WV)) + l * SZ_WQ + ((size_t)tc * 64 * D + tk * 128) * 2; return; }
    t -= TK_QKV;
    if (t < TK_WO) { const int tk = t >> 5, tc = t & 31; d.sp = ((const float*)a->in[IN_WO]) + (size_t)l * W * D + (size_t)tk * 128 * D + tc * 64; d.sld = D; d.dldb = W * 2; d.dp = ws + WS_WO + l * SZ_WQ + ((size_t)tc * 64 * W + tk * 128) * 2; return; }
    t -= TK_WO;
    if (t < TK_GU) { const int tt = t & 31, job = t >> 5, half = job & 1, j = (job >> 1) & 3, e = job >> 3, tk = tt >> 1, tc = tt & 1;
        d.sp = (e < NE ? ((const float*)a->in[IN_WGU]) + ((size_t)l * NE + e) * D * 1024 : ((const float*)a->in[IN_SGU]) + (size_t)l * D * 1024) + half * 512 + j * 128 + (size_t)tk * 128 * 1024 + tc * 64; d.sld = 1024; d.dldb = D; d.fp8 = 1;
        d.dp = ws + WS_WGU8 + ((size_t)l * NEX + e) * SZ_WGU8 + (size_t)(j * 256 + half * 128 + tc * 64) * D + tk * 128; return; }
    t -= TK_GU;
    { const int tt = t & 127, e = t >> 7, tk = tt >> 5, tc = tt & 31;
      d.sp = (e < NE ? ((const float*)a->in[IN_WDN]) + ((size_t)l * NE + e) * ED * D : ((const float*)a->in[IN_SDN]) + (size_t)l * ED * D) + (size_t)tk * 128 * D + tc * 64; d.sld = D; d.dldb = ED; d.fp8 = 1;
      d.dp = ws + WS_WDN + ((size_t)l * NEX + e) * SZ_WDN1 + (size_t)tc * 64 * ED + tk * 128; }
}
constexpr int XP_SLOT = 64 * 256;
template <int NB> struct XRegs { f32x4 r[NB][4]; };
template <int NB> __device__ __forceinline__ void xpose_load(const Frame& F, int l, int t0, int tstep, int n, XRegs<NB>& X) {
    const int tid = F.tid, row4 = (tid >> 4) * 4, cq = (tid & 15) * 4;
#pragma unroll
    for (int b = 0; b < NB; ++b) if (b < n) { TDesc d; tile_desc(F, l, t0 + b * tstep, d); const float* sp = d.sp + (size_t)row4 * d.sld + cq;
#pragma unroll
        for (int q = 0; q < 4; ++q) X.r[b][q] = __builtin_nontemporal_load((const f32x4*)(sp + (size_t)q * d.sld)); }
}
template <int NB> __device__ __forceinline__ void xpose_finish(const Frame& F, int l, int t0, int tstep, int n, const XRegs<NB>& X) {
    const int tid = F.tid, row4 = (tid >> 4) * 4, cq = (tid & 15) * 4;
    int t1 = t0; asm volatile("" : "+s"(t1));
#pragma unroll
    for (int b = 0; b < NB; ++b) if (b < n) { TDesc d; tile_desc(F, l, t1 + b * tstep, d); LAS unsigned char* L = F.lds + b * XP_SLOT;
        if (d.fp8) { const int sw = ((cq >> 2) & 7) << 4;
#pragma unroll
            for (int j = 0; j < 4; ++j) *(LAS unsigned*)(L + (cq + j) * 128 + (row4 ^ sw)) = (d.fp8 == 2) ? pack_i8x4(X.r[b][0][j] * d.qs, X.r[b][1][j] * d.qs, X.r[b][2][j] * d.qs, X.r[b][3][j] * d.qs) : pack_fp8x4(X.r[b][0][j] * W8_SCALE, X.r[b][1][j] * W8_SCALE, X.r[b][2][j] * W8_SCALE, X.r[b][3][j] * W8_SCALE);
        } else { const int sw = ((cq >> 2) & 15) << 4;
#pragma unroll
            for (int j = 0; j < 4; ++j) { u32x2 w; w.x = pack2(X.r[b][0][j], X.r[b][1][j]); w.y = pack2(X.r[b][2][j], X.r[b][3][j]); *(LAS u32x2*)(L + (cq + j) * 256 + ((row4 * 2) ^ sw)) = w; } } }
    __syncthreads();
    int t2 = t0; asm volatile("" : "+s"(t2));
#pragma unroll
    for (int b = 0; b < NB; ++b) if (b < n) { TDesc d; tile_desc(F, l, t2 + b * tstep, d); const LAS unsigned char* L = F.lds + b * XP_SLOT; const int c = tid >> 3, kq = tid & 7;
        if (d.fp8) *(u32x4*)(d.dp + (size_t)c * d.dldb + kq * 16) = *(const LAS u32x4*)(L + c * 128 + ((kq * 16) ^ (((c >> 2) & 7) << 4)));
        else { const int sw = ((c >> 2) & 15) << 4; *(u32x4*)(d.dp + (size_t)c * d.dldb + kq * 16) = *(const LAS u32x4*)(L + c * 256 + ((kq * 16) ^ sw)); *(u32x4*)(d.dp + (size_t)c * d.dldb + 128 + kq * 16) = *(const LAS u32x4*)(L + c * 256 + ((128 + kq * 16) ^ sw)); } }
    __syncthreads();
}
__device__ __forceinline__ void xpose_range(const Frame& F, int l, int tlo, int thi, int rank, int nranks) {
    constexpr int NB = 4; const int step = nranks * NB;
    XRegs<NB> A, B;
    int t = tlo + rank * NB; if (t >= thi) return;
#define XP_CNT(tt) (((thi) - (tt)) < NB ? ((thi) - (tt)) : NB)
    xpose_load<NB>(F, l, t, 1, XP_CNT(t), A);
    for (;;) {
        const int tb = t + step; const bool hb = tb < thi; if (hb) xpose_load<NB>(F, l, tb, 1, XP_CNT(tb), B);
        xpose_finish<NB>(F, l, t, 1, XP_CNT(t), A);
        if (!hb) break;
        const int ta = tb + step; const bool ha = ta < thi; if (ha) xpose_load<NB>(F, l, ta, 1, XP_CNT(ta), A);
        xpose_finish<NB>(F, l, tb, 1, XP_CNT(tb), B);
        if (!ha) break;
        t = ta;
    }
#undef XP_CNT
}
__device__ __forceinline__ void pool_fold(const Frame& F, int l, int rank, int nranks) {
    const KArgs a = F.ka; unsigned char* ws = F.ws_();
    for (size_t i = (size_t)rank * NTHR + F.tid; i < (size_t)W * D; i += (size_t)nranks * NTHR) {
        const int d = (int)(i % D), gc = (int)(i / D), g = gc >> 7;
        const float* pw = ((const float*)a->in[IN_POOLW]) + ((size_t)l * W + gc) * 128; const float* ps = ((const float*)a->in[IN_POOLS]) + l * W + g * 128;
        const float* wb = ((const float*)a->in[IN_WBR]) + ((size_t)l * 4 * W + g * 128) * D + d;
        float s = 0.f;
        for (int e = 0; e < 128; ++e) s += pw[e] * ps[e] * wb[(size_t)e * D];
        ((bf16_t*)(ws + WS_WB + l * SZ_DD))[(size_t)d * D + gc] = f2bf(s);
    }
}
__device__ __forceinline__ void phase_wabs(const Frame& F) {
    const KArgs a = F.ka; unsigned char* ws = F.ws_();
    for (int l = 0; l < DEPTH; ++l) { float m = 0.f; const float* w = ((const float*)a->in[IN_WIN]) + (size_t)l * D * PROJ_W;
        for (size_t i = (size_t)F.wg * NTHR + F.tid; i < (size_t)D * (NBR / 4); i += (size_t)F.nwg * NTHR) { const int c4 = (int)(i % (NBR / 4)), k = (int)(i / (NBR / 4)); const int col = c4 * 4 < 4096 ? c4 * 4 : c4 * 4 + 8;
            const f32x4 v = *(const f32x4*)(w + (size_t)k * PROJ_W + col); m = fmaxf(m, fmaxf(fmaxf(fabsf(v[0]), fabsf(v[1])), fmaxf(fabsf(v[2]), fabsf(v[3])))); }
        m = wave_max(m);
        if (F.lane == 0) __hip_atomic_fetch_max((unsigned*)(ws + WS_CTL) + CW_WABS + l, __float_as_uint(m), __ATOMIC_RELAXED, __HIP_MEMORY_SCOPE_AGENT); }
}
__device__ __forceinline__ void phase_prologue(const Frame& F) {
    const KArgs a = F.ka;
    unsigned char* ws = F.ws_();
    xpose_range(F, 0, 0, TK_WINA + TK_WINB, F.wg, F.nwg);
    const size_t gtid = (size_t)F.wg * NTHR + F.tid, gn = (size_t)F.nwg * NTHR;
    for (size_t i = gtid; i < (size_t)DEPTH * 8 * D; i += gn) { const int k = (int)(i % D), c = (int)((i / D) % 8), l = (int)(i / (8 * D));
        ((float*)(ws + WS_WIF))[i] = ((const float*)a->in[IN_WIN])[(size_t)l * D * PROJ_W + (size_t)k * PROJ_W + 4096 + c]; }
    for (size_t i = gtid; i < (size_t)DEPTH * NE * D; i += gn) { const int k = (int)(i % D), e = (int)((i / D) % NE), l = (int)(i / ((size_t)NE * D));
        const float w = ((const float*)a->in[IN_RW])[((size_t)l * D + k) * NE + e]; const bf16_t hi = f2bf(w); const bf16_t lo = f2bf(w - bf2f(hi));
        bf16_t* o = (bf16_t*)(ws + WS_RWT) + (size_t)l * 2 * NE * D; o[(size_t)e * D + k] = hi; o[(size_t)(NE + e) * D + k] = lo; }
    for (size_t i = gtid; i < (size_t)SEQ * 64; i += gn) { const int f = (int)(i & 63), s = (int)(i >> 6);
        const float inv = powf(10000.0f, -(float)f / 64.0f); const float ang = (float)s * inv;
        ((float*)(ws + WS_ROPE))[i] = cosf(ang); ((float*)(ws + WS_ROPE))[(size_t)SEQ * 64 + i] = sinf(ang); }
    for (int row = F.wg * 8 + F.wave; row < T; row += F.nwg * 8) { float v[32]; const float* xr = ((const float*)a->in[IN_X]) + (size_t)row * D;
#pragma unroll
        for (int j = 0; j < 4; ++j) { const f32x4 p = *(const f32x4*)(xr + j * 512 + F.lane * 8), q = *(const f32x4*)(xr + j * 512 + F.lane * 8 + 4); v[j * 8] = p[0]; v[j * 8 + 1] = p[1]; v[j * 8 + 2] = p[2]; v[j * 8 + 3] = p[3]; v[j * 8 + 4] = q[0]; v[j * 8 + 5] = q[1]; v[j * 8 + 6] = q[2]; v[j * 8 + 7] = q[3]; }
        st_row32((bf16_t*)(ws + WS_XB) + (size_t)row * D, F.lane, v); st_row32_fp8(ws + WS_XB8 + (size_t)row * D, F.lane, v); st_row32_i8(ws + WS_XQ8 + (size_t)row * D, (float*)(ws + WS_XSC) + row, F.lane, v); }
    for (size_t i = gtid; i < (size_t)TM * D / 4; i += gn) { const f32x4 v = ((const f32x4*)((const float*)a->in[IN_MEM]))[i]; st_bf16x4((bf16_t*)(ws + WS_MEMB) + i * 4, v); }
    __syncthreads();
}
__device__ __forceinline__ void prologue_deferred(const Frame& F, int rank, int nranks) {
    xpose_range(F, 0, TK_WINA + TK_WINB, TK_LAYER, rank, nranks);
    xpose_range(F, 1, 0, TK_LAYER, rank, nranks);
    pool_fold(F, 0, rank, nranks); pool_fold(F, 1, rank, nranks);
    __syncthreads();
}

__device__ __forceinline__ void unpack8(u32x4 w, float (&f)[8]) {
#pragma unroll
    for (int j = 0; j < 4; ++j) { f[2 * j] = __uint_as_float(w[j] << 16); f[2 * j + 1] = __uint_as_float(w[j] & 0xffff0000u); } }
__device__ __forceinline__ u32x4 pack8f(const float (&f)[8]) { u32x4 w;
#pragma unroll
    for (int j = 0; j < 4; ++j) w[j] = pack2(f[2 * j], f[2 * j + 1]); return w; }
template <int WIN> __device__ __forceinline__ void pool_block(const bf16_t* pu, bf16_t* out, int s0) {
    float sum[8];
#pragma unroll
    for (int e = 0; e < 8; ++e) sum[e] = 0.f;
    u32x4 hist[WIN - 1 + 8];
#pragma unroll
    for (int j = 0; j < WIN - 1 + 8; ++j) { const int ds = j - (WIN - 1); hist[j] = (s0 + ds >= 0) ? *(const u32x4*)(pu + (ptrdiff_t)ds * NBR) : (u32x4){0u, 0u, 0u, 0u}; }
#pragma unroll
    for (int j = 0; j < WIN - 1; ++j) { float f[8]; unpack8(hist[j], f);
#pragma unroll
        for (int e = 0; e < 8; ++e) sum[e] += f[e]; }
#pragma unroll
    for (int i = 0; i < 8; ++i) { float f[8]; unpack8(hist[WIN - 1 + i], f); const int cnt = (s0 + i + 1 < WIN) ? s0 + i + 1 : WIN; const float rc = 1.0f / (float)cnt; float o[8];
#pragma unroll
        for (int e = 0; e < 8; ++e) { sum[e] += f[e]; o[e] = sum[e] * rc - f[e]; }
        *(u32x4*)(out + (size_t)i * D) = pack8f(o);
        float fo[8]; unpack8(hist[i], fo);
#pragma unroll
        for (int e = 0; e < 8; ++e) sum[e] -= fo[e]; }
}
template <bool WITH_D = true> __device__ __forceinline__ void phase_mix1v2(const Frame& F, int l, const bf16_t* xcur) {
    const KArgs a = F.ka;
    unsigned char* ws = F.ws_();
    LAS float* dots = (LAS float*)(F.lds + 65536);
    LAS float* wl = (LAS float*)F.lds;
    const float* wif = (const float*)(ws + WS_WIF) + (size_t)l * 8 * D;
    const float* gb = ((const float*)a->in[IN_GATEB]) + l * 8;
    float* cumf = (float*)(ws + WS_CUMF); float* ipre = (float*)(ws + WS_IPRE); float* summ = (float*)(ws + WS_SUMM); float* av = (float*)(ws + WS_AV); float* pm = (float*)(ws + WS_PM);
    if (F.wg < BATCH * NCH) { for (int i = F.tid; i < 8 * D / 4; i += NTHR) *(LAS f32x4*)(wl + i * 4) = *(const f32x4*)(wif + i * 4); __syncthreads(); }
    for (int item = F.wg; item < BATCH * NCH; item += F.nwg) {
        const int b = item / NCH, c = item % NCH; const int t0 = b * SEQ + c * CH;
        for (int i = 0; i < 8; i += 2) {
            const int tok = F.wave * 8 + i; const bf16_t* xr = xcur + (size_t)(t0 + tok) * D;
            float d0[8], d1[8];
#pragma unroll
            for (int q = 0; q < 8; ++q) { d0[q] = 0.f; d1[q] = 0.f; }
#pragma unroll 1
            for (int j = 0; j < 4; ++j) { float x0[8], x1[8]; unpack8(*(const u32x4*)(xr + j * 512 + F.lane * 8), x0); unpack8(*(const u32x4*)(xr + D + j * 512 + F.lane * 8), x1);
#pragma unroll
                for (int q = 0; q < 8; ++q) { const f32x4 wa = *(const LAS f32x4*)(wl + q * D + j * 512 + F.lane * 8), wb = *(const LAS f32x4*)(wl + q * D + j * 512 + F.lane * 8 + 4);
#pragma unroll
                    for (int e = 0; e < 4; ++e) { d0[q] += x0[e] * wa[e] + x0[4 + e] * wb[e]; d1[q] += x1[e] * wa[e] + x1[4 + e] * wb[e]; } } }
#pragma unroll
            for (int q = 0; q < 8; ++q) { const float s0 = wave_sum(d0[q]), s1 = wave_sum(d1[q]); if (F.lane == 0) { dots[tok * 8 + q] = s0; dots[(tok + 1) * 8 + q] = s1; } }
        }
        __syncthreads();
        if (F.wave < NH) {
            const int h = F.wave, s = F.lane; const float ip = dots[s * 8 + h] + gb[h], fp = dots[s * 8 + 4 + h] + gb[4 + h];
            const float lf = fminf(fp, 0.f) - log1pf(__expf(-fabsf(fp)));
            float cs = lf;
#pragma unroll
            for (int o = 1; o < 64; o <<= 1) { const float n = __shfl_up(cs, o); if (s >= o) cs += n; }
            const float ftot = __shfl(cs, 63); const float aa = ip - cs;
            float px = aa;
#pragma unroll
            for (int o = 1; o < 64; o <<= 1) { const float n = __shfl_up(px, o); if (s >= o) px = fmaxf(px, n); }
            const float gm = ftot + __shfl(px, 63);
            const size_t o = (size_t)(b * NH + h) * SEQ + c * CH + s; cumf[o] = cs; ipre[o] = ip; av[o] = aa; pm[o] = px;
            if (s == 0) { summ[((size_t)(b * NH + h) * NCH + c) * 2] = ftot; summ[((size_t)(b * NH + h) * NCH + c) * 2 + 1] = gm; }
        }
        __syncthreads();
    }
    bf16_t* proj = (bf16_t*)(ws + WS_PROJ); bf16_t* br = (bf16_t*)(ws + WS_BR);
    for (int it = F.wg * 8 + F.wave; it < (T / 32) * 4; it += F.nwg * 8) {
        const int grp = it & 3, tbq = it >> 2; const int tb = tbq * 4 + (F.lane >> 4), co = grp * 16 + (F.lane & 15);
        const int t0 = tb * 8, s0 = t0 % SEQ; const bf16_t* pu = proj + (size_t)t0 * NBR + PC_U + co * 8; bf16_t* out = br + (size_t)t0 * D + co * 8;
        if (grp == 0) pool_block<2>(pu, out, s0); else if (grp == 1) pool_block<4>(pu, out, s0); else if (grp == 2) pool_block<8>(pu, out, s0); else pool_block<16>(pu, out, s0);
    }
    { const float* cw = ((const float*)a->in[IN_CONVW]) + (size_t)l * 3 * W;
      for (size_t it = (size_t)F.wg * NTHR + F.tid; it < (size_t)(T / 8) * 64; it += (size_t)F.nwg * NTHR) {
        const int co = (int)(it & 63), tb = (int)(it >> 6), t0 = tb * 8, s0 = t0 % SEQ;
        const bf16_t* pr = proj + (size_t)t0 * NBR + co * 8;
        float w0[8], w1[8], w2[8];
#pragma unroll
        for (int e = 0; e < 8; ++e) { w0[e] = cw[co * 8 + e]; w1[e] = cw[W + co * 8 + e]; w2[e] = cw[2 * W + co * 8 + e]; }
        float z1[8], z2[8];
#pragma unroll
        for (int e = 0; e < 8; ++e) { z1[e] = 0.f; z2[e] = 0.f; }
        if (s0 >= 2) { float c_[8], h_[8]; unpack8(*(const u32x4*)(pr + PC_CC - 2 * NBR), c_); unpack8(*(const u32x4*)(pr + PC_CH - 2 * NBR), h_);
#pragma unroll
            for (int e = 0; e < 8; ++e) z2[e] = c_[e] * h_[e]; }
        if (s0 >= 1) { float c_[8], h_[8]; unpack8(*(const u32x4*)(pr + PC_CC - NBR), c_); unpack8(*(const u32x4*)(pr + PC_CH - NBR), h_);
#pragma unroll
            for (int e = 0; e < 8; ++e) z1[e] = c_[e] * h_[e]; }
#pragma unroll
        for (int i = 0; i < 8; ++i) { float c_[8], h_[8], b_[8], o[8]; unpack8(*(const u32x4*)(pr + PC_CC + (size_t)i * NBR), c_); unpack8(*(const u32x4*)(pr + PC_CH + (size_t)i * NBR), h_); unpack8(*(const u32x4*)(pr + PC_CB + (size_t)i * NBR), b_);
#pragma unroll
            for (int e = 0; e < 8; ++e) { const float z0 = c_[e] * h_[e]; o[e] = b_[e] * (w0[e] * z0 + w1[e] * z1[e] + w2[e] * z2[e]); z2[e] = z1[e]; z1[e] = z0; }
            *(u32x4*)(br + (size_t)(t0 + i) * D + W + co * 8) = pack8f(o); }
      } }
    if constexpr (WITH_D) { const float* ropec = (const float*)(ws + WS_ROPE); const float* ropes = ropec + (size_t)SEQ * 64;
      for (size_t it = (size_t)F.wg * NTHR + F.tid; it < (size_t)T * 64; it += (size_t)F.nwg * NTHR) {
        const int oc = (int)(it & 7), hh = (int)((it >> 3) & 3), isk = (int)((it >> 5) & 1), t = (int)(it >> 6), s = t % SEQ;
        bf16_t* p = proj + (size_t)t * NBR + (isk ? PC_RK : PC_RQ) + hh * HD + oc * 8;
        float x1[8], x2[8], o1[8], o2[8]; unpack8(*(const u32x4*)p, x1); unpack8(*(const u32x4*)(p + 64), x2);
#pragma unroll
        for (int e = 0; e < 8; ++e) { const float cs = ropec[(size_t)s * 64 + oc * 8 + e], sn = ropes[(size_t)s * 64 + oc * 8 + e]; o1[e] = x1[e] * cs - x2[e] * sn; o2[e] = x1[e] * sn + x2[e] * cs; }
        *(u32x4*)p = pack8f(o1); *(u32x4*)(p + 64) = pack8f(o2);
      } }
}

__device__ __forceinline__ float ret_gamma_log2(int h) { return log2f(1.0f - exp2f(-5.0f - (float)h)); }

__device__ __forceinline__ void phase_scan_mfma(const Frame& F) {
    unsigned char* ws = F.ws_();
    constexpr int KS2 = 144, WS2 = 48;
    LAS bf16_t* Kb = (LAS bf16_t*)F.lds;
    LAS bf16_t* Wb = Kb + 2 * 64 * KS2;
    LAS float* mS = (LAS float*)(Wb + 2 * 64 * WS2);
    LAS float* fT = mS + 80;
    const bf16_t* proj = (const bf16_t*)(ws + WS_PROJ);
    const float* av = (const float*)(ws + WS_AV); const float* summ = (const float*)(ws + WS_SUMM);
    const int lane = F.lane, g = lane >> 4, li = lane & 15, w = F.wave, tid = F.tid;
    for (int item = F.wg; item < 2 * NBH * 8; item += F.nwg) {
        const int type = item >> 7, bh = (item >> 3) & 15, vs = item & 7, b = bh >> 2, h = bh & 3;
        if (tid == 0) { float m = 0.f; mS[0] = 0.f; for (int c = 0; c < NCH; ++c) { m = fmaxf(summ[((size_t)bh * NCH + c) * 2] + m, summ[((size_t)bh * NCH + c) * 2 + 1]); mS[c + 1] = m; }
            if (type == 0 && vs == 0) { float* ms = (float*)(ws + WS_MSEQ) + bh * 80; for (int c = 0; c <= NCH; ++c) ms[c] = mS[c]; } }
        if (tid >= 64 && tid < 128) fT[tid - 64] = summ[((size_t)bh * NCH + (tid - 64)) * 2];
        __syncthreads();
        const float lg2 = ret_gamma_log2(h);
        const int kcol = (type == 0 ? PC_MK : PC_RK) + h * HD, vcol = (type == 0 ? PC_MV : PC_RV) + h * HD + vs * 16;
        bf16_t* cst = (bf16_t*)(ws + WS_CST) + ((size_t)(type * NBH + bh) * NCH) * HD * HD;
        float* nsv = (float*)(ws + WS_NST) + (size_t)bh * NCH * HD;
        const int krow = tid >> 3, koct = tid & 7, vrow = (tid >> 1) & 63, vhalf = tid & 1;
        const bf16_t* kbase = proj + (size_t)(b * SEQ + krow) * NBR + kcol + koct * 8;
        const bf16_t* vbase = proj + (size_t)(b * SEQ + vrow) * NBR + vcol + vhalf * 8;
        const float* abase = av + (size_t)bh * SEQ + vrow;
        u32x4 kr[2][2], vr[2]; float ar[2];
#define SCAN_LOAD(c, sl) do { const size_t _o = (size_t)(c) * CH * NBR; kr[sl][0] = *(const u32x4*)(kbase + _o); kr[sl][1] = *(const u32x4*)(kbase + _o + 64); \
        if (tid < 128) { vr[sl] = *(const u32x4*)(vbase + _o); ar[sl] = (type == 0) ? abase[(c) * CH] : 0.f; } } while (0)
#define SCAN_WRITE(c, sl, bf) do { LAS bf16_t* _k = Kb + (bf) * 64 * KS2 + krow * KS2 + koct * 8; *(LAS u32x4*)_k = kr[sl][0]; *(LAS u32x4*)(_k + 64) = kr[sl][1]; \
        if (tid < 128) { const float _w = (type == 0) ? __expf(ar[sl] + fT[c] - mS[(c) + 1]) : exp2f((float)(63 - vrow) * lg2); float _f[8]; unpack8(vr[sl], _f); \
            _Pragma("unroll") for (int _e = 0; _e < 8; ++_e) _f[_e] *= _w; LAS bf16_t* _p = Wb + (bf) * 64 * WS2 + vrow * WS2; *(LAS u32x4*)(_p + vhalf * 8) = pack8f(_f); \
            u32x4 _x = {0u, 0u, 0u, 0u}; if (vhalf == 0) _x[0] = (unsigned)f2bf(_w); *(LAS u32x4*)(_p + 16 + vhalf * 8) = _x; } } while (0)
        f32x4 st = {0.f, 0.f, 0.f, 0.f}, na = {0.f, 0.f, 0.f, 0.f};
#define SCAN_BODY(c, bf) do { { u32x2 _pw; _pw.x = pack2(st[0], st[1]); _pw.y = pack2(st[2], st[3]); *(u32x2*)(cst + (size_t)(c) * HD * HD + (size_t)(vs * 16 + li) * HD + 16 * w + 4 * g) = _pw; } \
        if (type == 0 && vs == 0 && li == 0) *(f32x4*)(nsv + (c) * HD + 16 * w + 4 * g) = na; \
        const float _d = (type == 0) ? __expf(fT[c] + mS[c] - mS[(c) + 1]) : exp2f(64.0f * lg2); st *= _d; na *= _d; \
        _Pragma("unroll") for (int _u = 0; _u < 2; ++_u) { const LAS bf16_t* _kp = Kb + (bf) * 64 * KS2 + (32 * _u + 8 * g + (li >> 2)) * KS2 + 16 * w + 4 * (li & 3); \
            const LAS bf16_t* _wp = Wb + (bf) * 64 * WS2 + (32 * _u + 8 * g + (li >> 2)) * WS2 + 4 * (li & 3); \
            const bf16x8 _A = cat4(lds_tr(_kp), lds_tr(_kp + 4 * KS2)); const bf16x8 _B = cat4(lds_tr(_wp), lds_tr(_wp + 4 * WS2)); \
            st = __builtin_amdgcn_mfma_f32_16x16x32_bf16(_A, _B, st, 0, 0, 0); \
            if (type == 0) { const bf16x8 _B2 = cat4(lds_tr(_wp + 16), lds_tr(_wp + 4 * WS2 + 16)); na = __builtin_amdgcn_mfma_f32_16x16x32_bf16(_A, _B2, na, 0, 0, 0); } } } while (0)
        SCAN_LOAD(0, 0); SCAN_WRITE(0, 0, 0); SCAN_LOAD(1, 1); SCAN_LOAD(2, 0);
        __syncthreads();
        for (int c = 0; c < NCH; c += 2) {
            SCAN_BODY(c, 0);
            SCAN_WRITE(c + 1, 1, 1);
            if (c + 3 < NCH) SCAN_LOAD(c + 3, 1);
            __syncthreads();
            SCAN_BODY(c + 1, 1);
            if (c + 2 < NCH) { SCAN_WRITE(c + 2, 0, 0); }
            if (c + 4 < NCH) SCAN_LOAD(c + 4, 0);
            __syncthreads();
        }
#undef SCAN_LOAD
#undef SCAN_WRITE
#undef SCAN_BODY
    }
}

__device__ __forceinline__ void phase_chunk_mfma(const Frame& F, int l) {
    const KArgs a = F.ka; unsigned char* ws = F.ws_();
    constexpr int QS = 136, VS = 144, PS = 72;
    LAS bf16_t* Qs = (LAS bf16_t*)F.lds; LAS bf16_t* Ks = Qs + 64 * QS; LAS bf16_t* Vs = Ks + 64 * QS; LAS bf16_t* Ps = Vs + 64 * VS;
    LAS float* rv = (LAS float*)(Ps + 64 * PS);
    LAS float* hp = rv + 256;
    const bf16_t* proj = (const bf16_t*)(ws + WS_PROJ); bf16_t* br = (bf16_t*)(ws + WS_BR);
    const float* cumf = (const float*)(ws + WS_CUMF); const float* av = (const float*)(ws + WS_AV); const float* pm = (const float*)(ws + WS_PM); const float* mseq = (const float*)(ws + WS_MSEQ);
    const int lane = F.lane, g = lane >> 4, li = lane & 15, w = F.wave;
    bf16x8 ones;
#pragma unroll
    for (int j = 0; j < 8; ++j) ones[j] = (short)0x3F80;
    for (int item = F.wg; item < 2 * NBH * NCH; item += F.nwg) {
        const int type = item / (NBH * NCH), bh = (item / NCH) % NBH, c = item % NCH, b = bh >> 2, h = bh & 3;
        const int t0 = b * SEQ + c * CH; const size_t go = (size_t)bh * SEQ + c * CH;
        const int qcol = (type == 0 ? PC_MQ : PC_RQ) + h * HD, kcol = (type == 0 ? PC_MK : PC_RK) + h * HD, vcol = (type == 0 ? PC_MV : PC_RV) + h * HD;
        const float lg2 = ret_gamma_log2(h);
        { const int row = F.tid >> 3, oct = F.tid & 7; const bf16_t* pr = proj + (size_t)(t0 + row) * NBR + oct * 8;
          *(LAS u32x4*)(Qs + row * QS + oct * 8) = *(const u32x4*)(pr + qcol); *(LAS u32x4*)(Qs + row * QS + 64 + oct * 8) = *(const u32x4*)(pr + qcol + 64);
          *(LAS u32x4*)(Ks + row * QS + oct * 8) = *(const u32x4*)(pr + kcol); *(LAS u32x4*)(Ks + row * QS + 64 + oct * 8) = *(const u32x4*)(pr + kcol + 64);
          *(LAS u32x4*)(Vs + row * VS + oct * 8) = *(const u32x4*)(pr + vcol); *(LAS u32x4*)(Vs + row * VS + 64 + oct * 8) = *(const u32x4*)(pr + vcol + 64); }
        if (F.tid < 64) { const int t = F.tid;
            if (type == 0) { const float mp = mseq[bh * 80 + c]; const float bt = fmaxf(mp, pm[go + t]); rv[t] = av[go + t]; rv[64 + t] = bt; rv[128 + t] = __expf(mp - bt); rv[192 + t] = __expf(-cumf[go + t] - bt); }
            else rv[128 + t] = exp2f((float)(t + 1) * lg2); }
        __syncthreads();
        { const int tt = w >> 1, t = 16 * tt + li;
#pragma unroll
          for (int sti = 0; sti < 2; ++sti) { const int st = (w & 1) * 2 + sti; f32x4 acc = {0.f, 0.f, 0.f, 0.f};
            if (st <= tt) {
#pragma unroll
                for (int kk = 0; kk < 4; ++kk) { const bf16x8 kf = *(const LAS bf16x8*)(Ks + (16 * st + li) * QS + kk * 32 + g * 8), qf = *(const LAS bf16x8*)(Qs + (16 * tt + li) * QS + kk * 32 + g * 8);
                    acc = __builtin_amdgcn_mfma_f32_16x16x32_bf16(kf, qf, acc, 0, 0, 0); }
#pragma unroll
                for (int r = 0; r < 4; ++r) { const int sx = 16 * st + 4 * g + r; float wgt;
                    if (type == 0) wgt = __expf(rv[sx] - rv[64 + t]); else wgt = exp2f((float)(t - sx) * lg2);
                    acc[r] = (sx <= t) ? acc[r] * wgt : 0.f; } }
            u32x2 pw; pw.x = pack2(acc[0], acc[1]); pw.y = pack2(acc[2], acc[3]); *(LAS u32x2*)(Ps + t * PS + 16 * st + 4 * g) = pw; } }
        __syncthreads();
        f32x4 pv[4], qc[4], dn[4], qn[4];
#pragma unroll
        for (int tt = 0; tt < 4; ++tt) { pv[tt] = (f32x4){0.f, 0.f, 0.f, 0.f}; qc[tt] = pv[tt]; dn[tt] = pv[tt]; qn[tt] = pv[tt]; }
#pragma unroll
        for (int u = 0; u < 2; ++u) {
            const bf16x8 vf = cat4(lds_tr(Vs + (32 * u + 8 * g + (li >> 2)) * VS + 16 * w + 4 * (li & 3)), lds_tr(Vs + (32 * u + 8 * g + 4 + (li >> 2)) * VS + 16 * w + 4 * (li & 3)));
#pragma unroll
            for (int tt = 0; tt < 4; ++tt) { const bf16x8 pf = *(const LAS bf16x8*)(Ps + (16 * tt + li) * PS + 32 * u + 8 * g);
                pv[tt] = __builtin_amdgcn_mfma_f32_16x16x32_bf16(vf, pf, pv[tt], 0, 0, 0);
                if (type == 0) dn[tt] = __builtin_amdgcn_mfma_f32_16x16x32_bf16(ones, pf, dn[tt], 0, 0, 0); } }
        if (c > 0) {
            const bf16_t* cst = (const bf16_t*)(ws + WS_CST) + ((size_t)(type * NBH + bh) * NCH + c) * HD * HD;
            const float* nsv = (const float*)(ws + WS_NST) + ((size_t)bh * NCH + c) * HD;
#pragma unroll
            for (int kk = 0; kk < 4; ++kk) { const bf16x8 cf = *(const bf16x8*)(cst + (size_t)(16 * w + li) * HD + kk * 32 + g * 8);
                bf16x8 nf = ones;
                if (type == 0) { const f32x4 n0 = *(const f32x4*)(nsv + kk * 32 + g * 8), n1 = *(const f32x4*)(nsv + kk * 32 + g * 8 + 4); nf = pack8(n0, n1); }
#pragma unroll
                for (int tt = 0; tt < 4; ++tt) { const bf16x8 qf = *(const LAS bf16x8*)(Qs + (16 * tt + li) * QS + kk * 32 + g * 8);
                    qc[tt] = __builtin_amdgcn_mfma_f32_16x16x32_bf16(cf, qf, qc[tt], 0, 0, 0);
                    if (type == 0) qn[tt] = __builtin_amdgcn_mfma_f32_16x16x32_bf16(nf, qf, qn[tt], 0, 0, 0); } } }
        const int vc = h * HD + 16 * w + 4 * g;
#pragma unroll
        for (int tt = 0; tt < 4; ++tt) { const int t = 16 * tt + li; const float inter = rv[128 + t]; f32x4 hv;
            if (type == 0) { const float den = inter * qn[tt][0] + dn[tt][0]; const float rd = 1.0f / fmaxf(fabsf(den), rv[192 + t]);
                const u32x2 ow = *(const u32x2*)(proj + (size_t)(t0 + t) * NBR + PC_MO + vc);
                const float o0 = __uint_as_float(ow.x << 16), o1 = __uint_as_float(ow.x & 0xffff0000u), o2 = __uint_as_float(ow.y << 16), o3 = __uint_as_float(ow.y & 0xffff0000u);
                hv[0] = sigmoidf_(o0) * (inter * qc[tt][0] + pv[tt][0]) * rd; hv[1] = sigmoidf_(o1) * (inter * qc[tt][1] + pv[tt][1]) * rd;
                hv[2] = sigmoidf_(o2) * (inter * qc[tt][2] + pv[tt][2]) * rd; hv[3] = sigmoidf_(o3) * (inter * qc[tt][3] + pv[tt][3]) * rd; }
            else hv = pv[tt] + qc[tt] * inter;
            pv[tt] = hv;
            float s1 = (hv[0] + hv[1]) + (hv[2] + hv[3]), s2 = (hv[0] * hv[0] + hv[1] * hv[1]) + (hv[2] * hv[2] + hv[3] * hv[3]);
            s1 += __shfl_xor(s1, 16); s1 += __shfl_xor(s1, 32); s2 += __shfl_xor(s2, 16); s2 += __shfl_xor(s2, 32);
            if (g == 0) { hp[(w * 64 + t) * 2] = s1; hp[(w * 64 + t) * 2 + 1] = s2; } }
        __syncthreads();
        const float* nw = (type == 0 ? ((const float*)a->in[IN_MNORM]) : ((const float*)a->in[IN_RNORM])) + l * W + vc; const f32x4 nw4 = *(const f32x4*)nw;
#pragma unroll
        for (int tt = 0; tt < 4; ++tt) { const int t = 16 * tt + li; float s1 = 0.f, s2 = 0.f;
#pragma unroll
            for (int ww = 0; ww < 8; ++ww) { const f32x2 p2 = *(const LAS f32x2*)(hp + (ww * 64 + t) * 2); s1 += p2.x; s2 += p2.y; }
            const float mu = s1 * (1.0f / 128.0f), var = fmaxf(s2 * (1.0f / 128.0f) - mu * mu, 0.f), rstd = rsqrtf(var + LN_EPS);
            f32x4 y = (pv[tt] - mu) * rstd * nw4;
            if (type == 1) { const u32x2 gw = *(const u32x2*)(proj + (size_t)(t0 + t) * NBR + PC_RG + vc);
                const float g0 = __uint_as_float(gw.x << 16), g1 = __uint_as_float(gw.x & 0xffff0000u), g2 = __uint_as_float(gw.y << 16), g3 = __uint_as_float(gw.y & 0xffff0000u);
                y[0] *= g0 * sigmoidf_(g0); y[1] *= g1 * sigmoidf_(g1); y[2] *= g2 * sigmoidf_(g2); y[3] *= g3 * sigmoidf_(g3); }
            st_bf16x4(br + (size_t)(t0 + t) * D + (type == 0 ? 1024 : 1536) + vc, y); }
        __syncthreads();
    }
}

__device__ __forceinline__ void ln_row(float (&v)[32], const float* lw, const float* lb, int lane) {
    float s = 0.f;
#pragma unroll
    for (int j = 0; j < 32; ++j) s += v[j];
    const float mu = wave_sum(s) * (1.0f / D); float q = 0.f;
#pragma unroll
    for (int j = 0; j < 32; ++j) { const float d = v[j] - mu; q += d * d; }
    const float rstd = rsqrtf(wave_sum(q) * (1.0f / D) + LN_EPS);
#pragma unroll
    for (int j = 0; j < 4; ++j)
#pragma unroll
        for (int h = 0; h < 2; ++h) { const f32x4 w4 = *(const f32x4*)(lw + j * 512 + lane * 8 + h * 4), b4 = *(const f32x4*)(lb + j * 512 + lane * 8 + h * 4);
#pragma unroll
            for (int e = 0; e < 4; ++e) v[j * 8 + h * 4 + e] = (v[j * 8 + h * 4 + e] - mu) * rstd * w4[e] + b4[e]; }
}
__device__ __forceinline__ void phase_ln(const Frame& F, const bf16_t* y, const float* lw, const float* lb, bf16_t* xb) {
    for (int row = F.wg * 8 + F.wave; row < T; row += F.nwg * 8) {
        float v[32]; ld_row32(y + (size_t)row * D, F.lane, v);
        ln_row(v, lw, lb, F.lane);
        st_row32(xb + (size_t)row * D, F.lane, v);
    }
}
__device__ __forceinline__ void split8(f32x4 a, f32x4 b, bf16x8& hi, bf16x8& lo) {
    union { u32x4 u; bf16x8 h; } H, L;
#pragma unroll
    for (int j = 0; j < 2; ++j) { const bf16_t h0 = f2bf(a[2 * j]), h1 = f2bf(a[2 * j + 1]); H.u[j] = (unsigned)h0 | ((unsigned)h1 << 16); L.u[j] = pack2(a[2 * j] - bf2f(h0), a[2 * j + 1] - bf2f(h1)); }
#pragma unroll
    for (int j = 0; j < 2; ++j) { const bf16_t h0 = f2bf(b[2 * j]), h1 = f2bf(b[2 * j + 1]); H.u[2 + j] = (unsigned)h0 | ((unsigned)h1 << 16); L.u[2 + j] = pack2(b[2 * j] - bf2f(h0), b[2 * j + 1] - bf2f(h1)); }
    hi = H.h; lo = L.h; }
__device__ __forceinline__ void phase_ln_router(const Frame& F, int l, const bf16_t* y, bf16_t* xb) {
    const KArgs a = F.ka;
    unsigned char* ws = F.ws_();
    constexpr int XS = D + 4;
    LAS float* xs = (LAS float*)F.lds;
    LAS float* part = xs + 16 * XS;
    const float* lw = ((const float*)a->in[IN_LNW]) + ((size_t)l * 3 + 1) * D; const float* lb = ((const float*)a->in[IN_LNB]) + ((size_t)l * 3 + 1) * D;
    const bf16_t* rwt = (const bf16_t*)(ws + WS_RWT) + (size_t)l * 2 * NE * D; const float* rb = ((const float*)a->in[IN_RB]) + l * NE;
    unsigned* counts = (unsigned*)(ws + WS_CTL) + CW_COUNTS + l * 64;
    int* eid = (int*)(ws + WS_EID); float* ew = (float*)(ws + WS_EW); int* epos = (int*)(ws + WS_EPOS);
    const int lane = F.lane, g = lane >> 4, li = lane & 15, nt = F.wave & 3, kh = F.wave >> 2;
    for (int blk = F.wg; blk < T / 16; blk += F.nwg) {
        for (int rr = 0; rr < 2; ++rr) {
            const int lr = F.wave * 2 + rr, row = blk * 16 + lr;
            float v[32]; ld_row32(y + (size_t)row * D, F.lane, v);
            ln_row(v, lw, lb, F.lane);
            st_row32(xb + (size_t)row * D, F.lane, v); st_row32_fp8(ws + WS_XB8 + (size_t)row * D, F.lane, v);
#pragma unroll
            for (int j = 0; j < 4; ++j) { *(LAS f32x4*)(xs + lr * XS + j * 512 + F.lane * 8) = (f32x4){v[j * 8], v[j * 8 + 1], v[j * 8 + 2], v[j * 8 + 3]}; *(LAS f32x4*)(xs + lr * XS + j * 512 + F.lane * 8 + 4) = (f32x4){v[j * 8 + 4], v[j * 8 + 5], v[j * 8 + 6], v[j * 8 + 7]}; }
        }
        __syncthreads();
        { f32x4 acc = {0.f, 0.f, 0.f, 0.f};
          const bf16_t* wh = rwt + (size_t)(16 * nt + li) * D + kh * 1024 + g * 8; const bf16_t* wl = wh + (size_t)NE * D;
          const LAS float* xr = xs + li * XS + kh * 1024 + g * 8;
#pragma unroll 4
          for (int ks = 0; ks < 32; ++ks) { bf16x8 xh, xl; split8(*(const LAS f32x4*)(xr + ks * 32), *(const LAS f32x4*)(xr + ks * 32 + 4), xh, xl);
              const bf16x8 bh = *(const bf16x8*)(wh + ks * 32), bl = *(const bf16x8*)(wl + ks * 32);
              acc = __builtin_amdgcn_mfma_f32_16x16x32_bf16(xh, bh, acc, 0, 0, 0); acc = __builtin_amdgcn_mfma_f32_16x16x32_bf16(xh, bl, acc, 0, 0, 0); acc = __builtin_amdgcn_mfma_f32_16x16x32_bf16(xl, bh, acc, 0, 0, 0); }
#pragma unroll
          for (int r = 0; r < 4; ++r) part[(kh * 16 + 4 * g + r) * 64 + 16 * nt + li] = acc[r]; }
        __syncthreads();
        const int e = F.lane;
        const float bias = rb[e];
        for (int rr = 0; rr < 2; ++rr) {
            const int lr = F.wave * 2 + rr, row = blk * 16 + lr;
            const float sc = sigmoidf_(part[lr * 64 + e] + part[(16 + lr) * 64 + e]), bs = sc + bias;
            float m1 = bs; m1 = fmaxf(m1, __shfl_xor(m1, 1)); m1 = fmaxf(m1, __shfl_xor(m1, 2)); m1 = fmaxf(m1, __shfl_xor(m1, 4));
            const unsigned long long eq = __ballot(bs == m1); const int gq = e >> 3; const unsigned gm = (unsigned)(eq >> (gq * 8)) & 0xffu; const int first = gq * 8 + __builtin_ctz(gm);
            float m2 = (e == first) ? -INFINITY : bs; m2 = fmaxf(m2, __shfl_xor(m2, 1)); m2 = fmaxf(m2, __shfl_xor(m2, 2)); m2 = fmaxf(m2, __shfl_xor(m2, 4));
            const float gs = m1 + m2;
            int grank = 0;
#pragma unroll
            for (int g2 = 0; g2 < 8; ++g2) { const float o = __shfl(gs, g2 * 8); grank += (o > gs || (o == gs && g2 < gq)) ? 1 : 0; }
            const bool gsel = grank < 4;
            const float val = gsel ? bs : -INFINITY;
            int rank = 0;
            for (int e2 = 0; e2 < 64; ++e2) { const float o = __shfl(val, e2); rank += (o > val || (o == val && e2 < e)) ? 1 : 0; }
            const bool sel = gsel && rank < TOPK;
            const float wsum = wave_sum(sel ? sc : 0.f);
            const unsigned long long sm = __ballot(sel);
            if (sel) { const int k = __builtin_popcountll(sm & ((1ull << e) - 1ull));
                const unsigned pos = __hip_atomic_fetch_add(counts + e, 1u, __ATOMIC_RELAXED, __HIP_MEMORY_SCOPE_AGENT);
                eid[(size_t)row * 8 + k] = e; ew[(size_t)row * 8 + k] = sc / wsum * ROUTE_SCALE; epos[(size_t)row * 8 + k] = (int)pos; }
        }
        __syncthreads();
    }
}
__device__ __forceinline__ void build_pstart(const Frame& F, int l, LAS int* pst) {
    const unsigned* counts = (const unsigned*)(F.ws_() + WS_CTL) + CW_COUNTS + l * 64;
    if (F.tid < 64) {
        const int c = (int)__hip_atomic_load(counts + F.tid, __ATOMIC_RELAXED, __HIP_MEMORY_SCOPE_AGENT); const int pc = (c + 255) & ~255; int inc = pc;
#pragma unroll
        for (int o = 1; o < 64; o <<= 1) { const int n = __shfl_up(inc, o); if (F.tid >= o) inc += n; }
        pst[F.tid] = inc - pc; if (F.tid == 63) { pst[NE] = inc; pst[NE + 1] = inc + T; } }
    __syncthreads();
    { LAS unsigned char* texp = (LAS unsigned char*)(pst + 68);
      for (int rt = F.tid; rt < (pst[NE + 1] >> 8); rt += NTHR) { int e = 0; while (e < NE && pst[e + 1] <= rt * 256) ++e; texp[rt] = (unsigned char)e; } }
    __syncthreads();
}
__device__ __forceinline__ void phase_slots(const Frame& F, int l) {
    unsigned char* ws = F.ws_();
    LAS int* pst = (LAS int*)F.lds;
    build_pstart(F, l, pst);
    const unsigned* counts = (const unsigned*)(ws + WS_CTL) + CW_COUNTS + l * 64;
    const int* eid = (const int*)(ws + WS_EID); const float* ew = (const float*)(ws + WS_EW); const int* epos = (const int*)(ws + WS_EPOS);
    int* slotof = (int*)(ws + WS_SLOTOF); int* tok = (int*)(ws + WS_TOK); float* wsl = (float*)(ws + WS_WSL);
    const size_t gtid = (size_t)F.wg * NTHR + F.tid, gn = (size_t)F.nwg * NTHR;
    for (size_t i = gtid; i < (size_t)T * 8; i += gn) { const int e = eid[i]; const int slot = pst[e] + epos[i]; slotof[i] = slot; tok[slot] = (int)(i >> 3); wsl[slot] = ew[i]; }
    for (size_t i = gtid; i < (size_t)NE * 256; i += gn) { const int e = (int)(i >> 8), r = (int)(i & 255); const int c = (int)counts[e]; const int slot = pst[e] + c + r; if (slot < pst[e + 1]) { tok[slot] = 0; wsl[slot] = 0.f; } }
    for (size_t i = gtid; i < (size_t)T; i += gn) { tok[pst[NE] + i] = (int)i; wsl[pst[NE] + i] = 1.0f; }
    __syncthreads();
}
__device__ __forceinline__ void phase_combine_ln(const Frame& F, int l, bf16_t* xb, float* out) {
    const KArgs a = F.ka;
    unsigned char* ws = F.ws_();
    LAS int* pst = (LAS int*)F.lds;
    build_pstart(F, l, pst);
    const int sh0 = pst[NE];
    const int* slotof = (const int*)(ws + WS_SLOTOF); const unsigned char* yb = ws + WS_YB;
    const float* lw = ((const float*)a->in[IN_LNW]) + ((size_t)l * 3 + 2) * D; const float* lb = ((const float*)a->in[IN_LNB]) + ((size_t)l * 3 + 2) * D;
    for (int row = F.wg * 8 + F.wave; row < T; row += F.nwg * 8) {
        float v[32]; ld_row32(xb + (size_t)row * D, F.lane, v);
#pragma unroll
        for (int j = 0; j < 32; ++j) v[j] *= ALPHA;
        float ys[32];
#pragma unroll
        for (int j = 0; j < 32; ++j) ys[j] = 0.f;
#pragma unroll 3
        for (int k = 0; k < 9; ++k) { const int slot = k < 8 ? slotof[(size_t)row * 8 + k] : sh0 + row; const unsigned char* yr = yb + (size_t)slot * D;
#pragma unroll
            for (int j = 0; j < 4; ++j) { const u32x2 w = *(const u32x2*)(yr + j * 512 + F.lane * 8);
                const f32x2 p0 = __builtin_amdgcn_cvt_pk_f32_fp8((int)w.x, false), p1 = __builtin_amdgcn_cvt_pk_f32_fp8((int)w.x, true), p2 = __builtin_amdgcn_cvt_pk_f32_fp8((int)w.y, false), p3 = __builtin_amdgcn_cvt_pk_f32_fp8((int)w.y, true);
                ys[j * 8] += p0.x; ys[j * 8 + 1] += p0.y; ys[j * 8 + 2] += p1.x; ys[j * 8 + 3] += p1.y; ys[j * 8 + 4] += p2.x; ys[j * 8 + 5] += p2.y; ys[j * 8 + 6] += p3.x; ys[j * 8 + 7] += p3.y; } }
#pragma unroll
        for (int j = 0; j < 32; ++j) v[j] += ys[j] * (1.0f / Y8_SCALE);
        ln_row(v, lw, lb, F.lane);
        if (out) {
#pragma unroll
            for (int j = 0; j < 4; ++j) { *(f32x4*)(out + (size_t)row * D + j * 512 + F.lane * 8) = (f32x4){v[j * 8], v[j * 8 + 1], v[j * 8 + 2], v[j * 8 + 3]}; *(f32x4*)(out + (size_t)row * D + j * 512 + F.lane * 8 + 4) = (f32x4){v[j * 8 + 4], v[j * 8 + 5], v[j * 8 + 6], v[j * 8 + 7]}; }
        } else { st_row32(xb + (size_t)row * D, F.lane, v); st_row32_fp8(ws + WS_XB8 + (size_t)row * D, F.lane, v); st_row32_i8(ws + WS_XQ8 + (size_t)row * D, (float*)(ws + WS_XSC) + row, F.lane, v); }
    }
    __syncthreads();
}

__device__ __forceinline__ void phase_attn_mfma(const Frame& F, int l) {
    unsigned char* ws = F.ws_();
    constexpr int KS = 136, VS = 144;
    LAS bf16_t* Ks = (LAS bf16_t*)F.lds; LAS bf16_t* Vs = Ks + 256 * KS;
    const bf16_t* q = (const bf16_t*)(ws + WS_Q); const bf16_t* km = (const bf16_t*)(ws + WS_KM) + (size_t)l * TM * W; const bf16_t* vm = (const bf16_t*)(ws + WS_VM) + (size_t)l * TM * W;
    bf16_t* o = (bf16_t*)(ws + WS_O);
    const int nunit = (T / 128) * 4, upw = (nunit + F.nwg - 1) / F.nwg;
    const int lane = F.lane, g = lane >> 4, li = lane & 15;
    int loaded = -1;
    const int u_end = (F.wg + 1) * upw < nunit ? (F.wg + 1) * upw : nunit;
    for (int u = F.wg * upw; u < u_end; ++u) {
        const int bh = u >> 5, blk = u & 31, b = bh >> 2, hh = bh & 3;
        if (bh != loaded) {
            __syncthreads();
            const int m = F.tid >> 1, half = F.tid & 1;
            const bf16_t* kr = km + (size_t)(b * MEM + m) * W + hh * HD + half * 64; const bf16_t* vr = vm + (size_t)(b * MEM + m) * W + hh * HD + half * 64;
#pragma unroll
            for (int j = 0; j < 8; ++j) { *(LAS u32x4*)(Ks + m * KS + half * 64 + j * 8) = *(const u32x4*)(kr + j * 8); *(LAS u32x4*)(Vs + m * VS + half * 64 + j * 8) = *(const u32x4*)(vr + j * 8); }
            __syncthreads(); loaded = bh;
        }
        const int t0 = b * SEQ + blk * 128 + F.wave * 16;
        bf16x8 qf[4];
#pragma unroll
        for (int kk = 0; kk < 4; ++kk) qf[kk] = *(const bf16x8*)(q + (size_t)(t0 + li) * W + hh * HD + kk * 32 + g * 8);
        f32x4 sacc[16];
#pragma unroll
        for (int tt = 0; tt < 16; ++tt) { f32x4 acc = {0.f, 0.f, 0.f, 0.f};
#pragma unroll
            for (int kk = 0; kk < 4; ++kk) { const bf16x8 kf = *(const LAS bf16x8*)(Ks + (16 * tt + li) * KS + kk * 32 + g * 8); acc = __builtin_amdgcn_mfma_f32_16x16x32_bf16(kf, qf[kk], acc, 0, 0, 0); }
            sacc[tt] = acc; }
        float mx = -INFINITY;
#pragma unroll
        for (int tt = 0; tt < 16; ++tt) mx = fmaxf(mx, fmaxf(fmaxf(sacc[tt][0], sacc[tt][1]), fmaxf(sacc[tt][2], sacc[tt][3])));
        mx = fmaxf(mx, __shfl_xor(mx, 16)); mx = fmaxf(mx, __shfl_xor(mx, 32));
        const float c2 = 0.08838834764831845f * 1.4426950408889634f; float sum = 0.f;
#pragma unroll
        for (int tt = 0; tt < 16; ++tt)
#pragma unroll
            for (int r = 0; r < 4; ++r) { const float p = exp2f((sacc[tt][r] - mx) * c2); sacc[tt][r] = p; sum += p; }
        sum += __shfl_xor(sum, 16); sum += __shfl_xor(sum, 32);
        const float rs = 1.0f / sum;
        bf16x8 pk[8];
#pragma unroll
        for (int u8 = 0; u8 < 8; ++u8) pk[u8] = pack8(sacc[2 * u8], sacc[2 * u8 + 1]);
#pragma unroll
        for (int dvt = 0; dvt < 8; ++dvt) { f32x4 acc = {0.f, 0.f, 0.f, 0.f};
#pragma unroll
            for (int u8 = 0; u8 < 8; ++u8) { const s16x4 a0 = lds_tr(Vs + (32 * u8 + 4 * g + (li >> 2)) * VS + dvt * 16 + 4 * (li & 3)); const s16x4 a1 = lds_tr(Vs + (32 * u8 + 16 + 4 * g + (li >> 2)) * VS + dvt * 16 + 4 * (li & 3));
                acc = __builtin_amdgcn_mfma_f32_16x16x32_bf16(cat4(a0, a1), pk[u8], acc, 0, 0, 0); }
            st_bf16x4(o + (size_t)(t0 + li) * W + hh * HD + dvt * 16 + 4 * g, acc * rs); }
    }
    __syncthreads();
}

template <class Epi>
__device__ __forceinline__ void gemm_dense_mfma(const Frame& F, const bf16_t* A, const bf16_t* Bt, int M, int N, int K, const Epi& E) {
    DenseSched S; S.A = A; S.Bt = Bt; S.K = K; S.nM = M / 256; S.nN = N / 256; S.nwg = S.nM * S.nN; S.G = F.nwg; S.c = F.wg; S.i0 = 0; S.i1 = 1 << 30; S.pnoff = 0;
    gemm_phase_mfma(F, K, S, E);
}
constexpr int NPL = 15, NPHASE = 1 + DEPTH * NPL;
#ifndef NCONV
#define NCONV 40
#endif
#if MK_PER_PHASE
#define IN(k) (lo <= (k) && (k) < hi)
#define SEAM(k) do { if (IN((k) + 1)) { XcdBarrier b2_ = bar; asm volatile("" : "+s"(b2_.bar)); asm volatile("" : "+s"(b2_.x)); xcd_barrier(b2_); } } while (0)
#else
#define IN(k) true
#define SEAM(k) do { if ((k) + 1 < NPHASE) for (int rb_ = 0; rb_ < ((PROBE_DBL & 4096) ? 3 : 1); ++rb_) { XcdBarrier b2_ = bar; asm volatile("" : "+s"(b2_.bar)); asm volatile("" : "+s"(b2_.x)); xcd_barrier(b2_); } } while (0)
#endif
template <int l> __device__ __forceinline__ void run_layer(const Frame& F0, const XcdBarrier& bar, int lo, int hi) {
    const int pb = 1 + l * NPL;
    if (IN(pb + 0)) { const Frame F = fresh(F0); unsigned char* ws = F.ws_();
        EpiProj E{(bf16_t*)(ws + WS_PROJ), (bf16_t*)(ws + WS_GATES)};
        { DenseSched S; S.A = (const bf16_t*)(ws + WS_XQ8); S.Bt = (const bf16_t*)(ws + WS_WINQ + l * SZ_WINQ); S.K = D / 2; S.nM = T / 256; S.nN = NBR / 256; S.nwg = S.nM * S.nN; S.G = F.nwg; S.c = F.wg; S.i0 = 0; S.i1 = 1 << 30; S.pnoff = 0;
          const float wsc = __uint_as_float(((const unsigned*)(ws + WS_CTL))[CW_WABS + l]) * (1.0f / 127.0f);
          gemm_phase_mfma<EpiProj, DenseSched, 2>(F, D, S, E, wsc, (const float*)(ws + WS_XSC)); }
        { const Frame F2 = fresh(F0); unsigned char* ws2 = F2.ws_(); EpiProj E2{(bf16_t*)(ws2 + WS_PROJ), (bf16_t*)(ws2 + WS_GATES)};
          DenseSched S; S.A = (const bf16_t*)(ws2 + WS_XB8); S.Bt = (const bf16_t*)(ws2 + WS_WIN8 + l * SZ_WIN8 + (size_t)NBR * D); S.K = D / 2; S.nM = T / 256; S.nN = (NPROJ - NBR) / 256; S.nwg = S.nM * S.nN; S.G = F2.nwg; S.c = F2.wg; S.i0 = 0; S.i1 = 1 << 30; S.pnoff = NBR / 256;
          gemm_phase_mfma<EpiProj, DenseSched, 1>(F2, D, S, E2, 1.0f / (X8_SCALE * W8_SCALE)); if (PROBE_DBL & 64) gemm_phase_mfma<EpiProj, DenseSched, 1>(F2, D, S, E2, 1.0f / (X8_SCALE * W8_SCALE)); }
        SEAM(pb + 0); }
    if (IN(pb + 1)) { const Frame F = fresh(F0); phase_mix1v2(F, l, (const bf16_t*)(F.ws_() + WS_XB)); if (PROBE_DBL & 8192) { const Frame G = fresh(F0); phase_mix1v2<false>(G, l, (const bf16_t*)(G.ws_() + WS_XB)); } SEAM(pb + 1); }
    if (IN(pb + 2)) { const Frame F = fresh(F0); phase_scan_mfma(F); if (PROBE_DBL & 2) { const Frame G = fresh(F0); phase_scan_mfma(G); } SEAM(pb + 2); }
    if (IN(pb + 3)) { const Frame F = fresh(F0); phase_chunk_mfma(F, l); if (PROBE_DBL & 4) { const Frame G = fresh(F0); phase_chunk_mfma(G, l); } SEAM(pb + 3); }
    if (IN(pb + 4)) { const Frame F = fresh(F0); unsigned char* ws = F.ws_();
        EpiBranch E{(const bf16_t*)(ws + WS_GATES), (bf16_t*)(ws + WS_MRG)}; gemm_dense_mfma(F, (const bf16_t*)(ws + WS_BR), (const bf16_t*)(ws + WS_WB + l * SZ_DD), T, D, D, E); if (PROBE_DBL & 128) gemm_dense_mfma(F, (const bf16_t*)(ws + WS_BR), (const bf16_t*)(ws + WS_WB + l * SZ_DD), T, D, D, E); SEAM(pb + 4); }
    if (IN(pb + 5)) { const Frame F = fresh(F0); unsigned char* ws = F.ws_();
        EpiResid E{(const bf16_t*)(ws + WS_XB), (bf16_t*)(ws + WS_Y)}; gemm_dense_mfma(F, (const bf16_t*)(ws + WS_MRG), (const bf16_t*)(ws + WS_WOUT + l * SZ_DD), T, D, D, E); if (PROBE_DBL & 256) gemm_dense_mfma(F, (const bf16_t*)(ws + WS_MRG), (const bf16_t*)(ws + WS_WOUT + l * SZ_DD), T, D, D, E); SEAM(pb + 5); }
    if (IN(pb + 6)) { const Frame F = fresh(F0); unsigned char* ws = F.ws_();
        phase_ln(F, (const bf16_t*)(ws + WS_Y), ((const float*)F.ka->in[IN_LNW]) + (size_t)l * 3 * D, ((const float*)F.ka->in[IN_LNB]) + (size_t)l * 3 * D, (bf16_t*)(ws + WS_XB)); if (PROBE_DBL & 1) { const Frame G = fresh(F0); unsigned char* wsg = G.ws_(); phase_ln(G, (const bf16_t*)(wsg + WS_Y), ((const float*)G.ka->in[IN_LNW]) + (size_t)l * 3 * D, ((const float*)G.ka->in[IN_LNB]) + (size_t)l * 3 * D, (bf16_t*)(wsg + WS_XB)); } SEAM(pb + 6); }
    if (IN(pb + 7)) { const Frame F = fresh(F0);
        EpiQKV E{}; QkvSched S; S.ws = F.ws_(); S.l = l; S.G = F.nwg; S.c = F.wg; gemm_phase_mfma(F, D, S, E); if (PROBE_DBL & 1024) gemm_phase_mfma(F, D, S, E); SEAM(pb + 7); }
    if (IN(pb + 8)) { const Frame F = fresh(F0); phase_attn_mfma(F, l); if (PROBE_DBL & 8) { const Frame G = fresh(F0); phase_attn_mfma(G, l); } SEAM(pb + 8); }
    if (IN(pb + 9)) { const Frame F = fresh(F0); unsigned char* ws = F.ws_();
        EpiResid E{(const bf16_t*)(ws + WS_XB), (bf16_t*)(ws + WS_Y)}; gemm_dense_mfma(F, (const bf16_t*)(ws + WS_O), (const bf16_t*)(ws + WS_WO + l * SZ_WQ), T, D, W, E); if (PROBE_DBL & 2048) gemm_dense_mfma(F, (const bf16_t*)(ws + WS_O), (const bf16_t*)(ws + WS_WO + l * SZ_WQ), T, D, W, E); SEAM(pb + 9); }
    if (IN(pb + 10)) { const Frame F = fresh(F0); unsigned char* ws = F.ws_(); phase_ln_router(F, l, (const bf16_t*)(ws + WS_Y), (bf16_t*)(ws + WS_XB)); SEAM(pb + 10); }
    if (IN(pb + 11)) { const Frame F = fresh(F0); phase_slots(F, l); if (PROBE_DBL & 16) { const Frame G = fresh(F0); phase_slots(G, l); } SEAM(pb + 11); }
    if (IN(pb + 12)) { const Frame F = fresh(F0); unsigned char* ws = F.ws_();
        LAS int* pst = (LAS int*)(F.lds + LDS_BYTES - 1024); build_pstart(F, l, pst);
        const int nrt = pst[NE + 1] >> 8; EpiSwiglu E{(const float*)(ws + WS_WSL), ws + WS_HB};
        MoeSched<4, true> S; S.ws = ws; S.pst = pst; S.l = l; S.G = F.nwg; S.c = F.wg; S.nunits = nrt * 4; gemm_phase_mfma<EpiSwiglu, MoeSched<4, true>, 1>(F, D, S, E, 1.0f / (X8_SCALE * W8_SCALE)); SEAM(pb + 12); }
    if (IN(pb + 13)) { const Frame F = fresh(F0); unsigned char* ws = F.ws_();
        LAS int* pst = (LAS int*)(F.lds + LDS_BYTES - 1024); build_pstart(F, l, pst);
        const int nrt = pst[NE + 1] >> 8; EpiDown E{ws + WS_YB};
        MoeSched<8, false> S; S.ws = ws; S.pst = pst; S.l = l; S.G = F.nwg; S.c = F.wg; S.nunits = nrt * 8; gemm_phase_mfma<EpiDown, MoeSched<8, false>, 1>(F, ED, S, E, Y8_SCALE / (H8_SCALE * W8_SCALE)); SEAM(pb + 13); }
    if (IN(pb + 14)) { const Frame F = fresh(F0); phase_combine_ln(F, l, (bf16_t*)(F.ws_() + WS_XB), l == DEPTH - 1 ? ((float*)F.ka->out) : (float*)nullptr); if ((PROBE_DBL & 16384) && l == DEPTH - 1) { const Frame G = fresh(F0); phase_combine_ln(G, l, (bf16_t*)(G.ws_() + WS_XB), ((float*)G.ka->out)); } SEAM(pb + 14); }
}

__global__ void __launch_bounds__(NTHR, 2) fwd(Args args_unused) {
    extern __shared__ __attribute__((aligned(16))) unsigned char lds_raw[];
    Frame F0; F0.lds = (LAS unsigned char*)lds_raw; F0.tid = threadIdx.x; F0.lane = F0.tid & 63; F0.wave = __builtin_amdgcn_readfirstlane(F0.tid >> 6); F0.wg = blockIdx.x; F0.nwg = gridDim.x;
    F0.ka = (KArgs)__builtin_amdgcn_kernarg_segment_ptr(); F0.wsg = F0.ka->ws;
    volatile LAS unsigned* xbw = (volatile LAS unsigned*)(F0.lds + LDS_BYTES - 16);
    if (F0.tid == 0) { xbw[0] = 0u; xbw[1] = 0u; }
    __syncthreads();
    XcdBarrier bar; bar.bar = (unsigned*)(F0.ws_() + WS_CTL); bar.x = 0; bar.st = xbw;
#if MK_PER_PHASE
    const int lo = F0.ka->ph_lo, hi = F0.ka->ph_hi;
    if (hi - lo > 1) bar = xcd_barrier_post((unsigned*)(F0.ws_() + WS_CTL), xbw);
#else
    const int lo = 0, hi = NPHASE;
    bar = xcd_barrier_post((unsigned*)(F0.ws_() + WS_CTL), xbw);
#endif
    if (IN(0)) { { const Frame F = fresh(F0); phase_wabs(F); } { XcdBarrier b2_ = bar; asm volatile("" : "+s"(b2_.bar)); asm volatile("" : "+s"(b2_.x)); xcd_barrier(b2_); }
        const Frame F = fresh(F0); phase_prologue(F); { const Frame G = fresh(F0); prologue_deferred(G, G.wg, G.nwg); } SEAM(0); }
    run_layer<0>(F0, bar, lo, hi);
    run_layer<1>(F0, bar, lo, hi);
#undef IN
#undef SEAM
}

extern "C" void kernel_launch(void* const* d_in, const int* in_sizes, int n_in, void* d_out, int out_size, void* d_ws, size_t ws_size, hipStream_t stream) {
    static int grid = 0;
    if (grid == 0) {
        if (n_in != 23 || ws_size < WS_END) { fprintf(stderr, "kernel_launch: unexpected inputs (n_in %d, ws %zu < %zu)\n", n_in, ws_size, (size_t)WS_END); grid = -1; return; }
        int dev = 0, cus = 0, per_cu = 0;
        if (hipGetDevice(&dev) != hipSuccess || hipDeviceGetAttribute(&cus, hipDeviceAttributeMultiprocessorCount, dev) != hipSuccess) { grid = -1; return; }
        if (hipFuncSetAttribute((const void*)fwd, hipFuncAttributeMaxDynamicSharedMemorySize, LDS_BYTES) != hipSuccess) { fprintf(stderr, "kernel_launch: hipFuncSetAttribute failed\n"); grid = -1; return; }
        if (hipOccupancyMaxActiveBlocksPerMultiprocessor(&per_cu, (const void*)fwd, NTHR, LDS_BYTES) != hipSuccess || per_cu < 1) { fprintf(stderr, "kernel_launch: occupancy query says %d\n", per_cu); }
        (void)hipGetLastError();
        grid = cus;
    }
    if (grid < 0) return;
    (void)hipMemsetAsync((char*)d_ws + WS_CTL, 0, CTL_BYTES, stream);
    Args a{};
    for (int i = 0; i < 23; ++i) a.in[i] = (const float*)d_in[i];
    a.out = (float*)d_out; a.ws = (unsigned char*)d_ws;
#if MK_PER_PHASE
    for (int p = 0; p < NPHASE; ++p) { a.ph_lo = p; a.ph_hi = p + 1; hipLaunchKernelGGL(fwd, dim3(grid), dim3(NTHR), LDS_BYTES, stream, a); }
#else
    a.ph_lo = 0; a.ph_hi = NPHASE;
    hipLaunchKernelGGL(fwd, dim3(grid), dim3(NTHR), LDS_BYTES, stream, a);
#endif
    const hipError_t le = hipPeekAtLastError();
    if (le != hipSuccess) fprintf(stderr, "kernel_launch: launch failed: %s\n", hipGetErrorName(le));
}
```

```cpp
#include <hip/hip_runtime.h>
#include <cstdio>
#include <cstdint>

#ifndef PROBE_DBL
#define PROBE_DBL 0
#endif
#ifndef MK_PER_PHASE
#define MK_PER_PHASE 0
#endif

typedef unsigned short bf16_t;
typedef float f32x4 __attribute__((ext_vector_type(4)));
typedef float f32x2 __attribute__((ext_vector_type(2)));
typedef unsigned u32x4 __attribute__((ext_vector_type(4)));
typedef unsigned u32x2 __attribute__((ext_vector_type(2)));
#define LAS __attribute__((address_space(3)))

constexpr int BATCH = 4, SEQ = 4096, T = BATCH * SEQ, D = 2048, DEPTH = 2;
constexpr int W = 512, NH = 4, HD = 128, CH = 64, NCH = SEQ / CH, NBH = BATCH * NH;
constexpr int PROJ_W = 14344, NBR = 6144, NPROJ = 14336;
constexpr int MEM = 256, TM = BATCH * MEM;
constexpr int NE = 64, NEX = 65, TOPK = 8, ED = 512;
constexpr int NSLOT = 164096;
constexpr float LN_EPS = 1e-5f, ALPHA = 1.41421356237f, ROUTE_SCALE = 2.5f;
constexpr int NTHR = 512;

constexpr int PC_U = 0, PC_CH = 512, PC_CB = 1024, PC_CC = 1536, PC_MQ = 2048, PC_MK = 2560, PC_MV = 3072, PC_MO = 3584, PC_RQ = 4096, PC_RK = 4608, PC_RV = 5120, PC_RG = 5632;

constexpr size_t al256(size_t x) { return (x + 255) & ~(size_t)255; }
constexpr size_t WS_CTL = 0;
constexpr size_t CTL_BYTES = 65536;
constexpr int CW_COUNTS = 8192;
constexpr size_t WS_WIN = WS_CTL + CTL_BYTES;
constexpr size_t SZ_WIN = (size_t)NPROJ * D * 2;
constexpr size_t WS_WIF = WS_WIN + DEPTH * SZ_WIN;
constexpr size_t SZ_WIF = 8 * D * 4;
constexpr size_t WS_WB = WS_WIF + DEPTH * SZ_WIF;
constexpr size_t SZ_DD = (size_t)D * D * 2;
constexpr size_t WS_WOUT = WS_WB + DEPTH * SZ_DD;
constexpr size_t WS_WQ = WS_WOUT + DEPTH * SZ_DD;
constexpr size_t SZ_WQ = (size_t)W * D * 2;
constexpr size_t WS_WK = WS_WQ + DEPTH * SZ_WQ;
constexpr size_t WS_WV = WS_WK + DEPTH * SZ_WQ;
constexpr size_t WS_WO = WS_WV + DEPTH * SZ_WQ;
constexpr size_t WS_WGU = WS_WO + DEPTH * SZ_WQ;
constexpr size_t SZ_WGU1 = (size_t)1024 * D * 2;
constexpr size_t WS_WDN = WS_WGU + (size_t)DEPTH * NEX * SZ_WGU1;
constexpr size_t SZ_WDN1 = (size_t)D * ED * 2;
constexpr size_t WS_ROPE = WS_WDN + (size_t)DEPTH * NEX * SZ_WDN1;
constexpr size_t WS_X = WS_ROPE + (size_t)SEQ * 64 * 4 * 2;
constexpr size_t SZ_TD4 = (size_t)T * D * 4;
constexpr size_t WS_Y = WS_X + SZ_TD4;
constexpr size_t WS_XB = WS_Y + SZ_TD4;
constexpr size_t SZ_TD2 = (size_t)T * D * 2;
constexpr size_t WS_MEMB = WS_XB + SZ_TD2;
constexpr size_t WS_KM = WS_MEMB + (size_t)TM * D * 2;
constexpr size_t WS_VM = WS_KM + (size_t)DEPTH * TM * W * 2;
constexpr size_t WS_PROJ = WS_VM + (size_t)DEPTH * TM * W * 2;
constexpr size_t WS_GATES = WS_PROJ + (size_t)T * NBR * 2;
constexpr size_t WS_CUMF = WS_GATES + (size_t)T * 8192 * 2;
constexpr size_t WS_IPRE = WS_CUMF + (size_t)NBH * SEQ * 4;
constexpr size_t WS_SUMM = WS_IPRE + (size_t)NBH * SEQ * 4;
constexpr size_t WS_CST = WS_SUMM + al256((size_t)NBH * NCH * 2 * 4);
constexpr size_t WS_NST = WS_CST + (size_t)2 * NBH * NCH * HD * HD * 2;
constexpr size_t WS_BR = WS_NST + (size_t)NBH * NCH * HD * 4;
constexpr size_t WS_MRG = WS_BR + SZ_TD2;
constexpr size_t WS_Q = WS_MRG + SZ_TD2;
constexpr size_t WS_O = WS_Q + (size_t)T * W * 2;
constexpr size_t WS_EID = WS_O + (size_t)T * W * 2;
constexpr size_t WS_EW = WS_EID + (size_t)T * 8 * 4;
constexpr size_t WS_EPOS = WS_EW + (size_t)T * 8 * 4;
constexpr size_t WS_SLOTOF = WS_EPOS + (size_t)T * 8 * 4;
constexpr size_t WS_TOK = WS_SLOTOF + (size_t)T * 8 * 4;
constexpr size_t WS_WSL = WS_TOK + al256((size_t)NSLOT * 4);
constexpr size_t WS_HB = WS_WSL + al256((size_t)NSLOT * 4);
constexpr size_t WS_YB = WS_HB + (size_t)NSLOT * ED * 2;
constexpr size_t WS_AV = WS_YB + (size_t)NSLOT * D * 2;
constexpr size_t WS_PM = WS_AV + (size_t)NBH * SEQ * 4;
constexpr size_t WS_MSEQ = WS_PM + (size_t)NBH * SEQ * 4;
constexpr size_t WS_XB8 = WS_MSEQ + al256((size_t)NBH * 80 * 4);
constexpr size_t WS_WGU8 = WS_XB8 + (size_t)T * D;
constexpr size_t SZ_WGU8 = (size_t)1024 * D;
constexpr size_t WS_WIN8 = WS_WGU8 + (size_t)DEPTH * NEX * SZ_WGU8;
constexpr size_t SZ_WIN8 = (size_t)NPROJ * D;
constexpr size_t WS_RWT = WS_WIN8 + DEPTH * SZ_WIN8;
constexpr size_t WS_XQ8 = WS_RWT + (size_t)DEPTH * 2 * NE * D * 2;
constexpr size_t WS_XSC = WS_XQ8 + (size_t)T * D;
constexpr size_t WS_WINQ = WS_XSC + al256((size_t)T * 4);
constexpr size_t SZ_WINQ = (size_t)NBR * D;
constexpr size_t WS_END = WS_WINQ + DEPTH * SZ_WINQ;
constexpr int CW_WABS = 8320;
constexpr float X8_SCALE = 16.0f, W8_SCALE = 256.0f, H8_SCALE = 8.0f, Y8_SCALE = 64.0f;

constexpr int LDS_BYTES = 147456;

__device__ __forceinline__ bf16_t f2bf(float f) { unsigned u = __float_as_uint(f); u += 0x7FFFu + ((u >> 16) & 1u); return (bf16_t)(u >> 16); }
__device__ __forceinline__ float bf2f(bf16_t b) { return __uint_as_float(((unsigned)b) << 16); }
__device__ __forceinline__ unsigned pack2(float lo, float hi) { unsigned r; asm("v_cvt_pk_bf16_f32 %0, %1, %2" : "=v"(r) : "v"(lo), "v"(hi)); return r; }
__device__ __forceinline__ float sigmoidf_(float x) { return __builtin_amdgcn_rcpf(1.0f + __builtin_amdgcn_exp2f(-1.4426950408889634f * x)); }
__device__ __forceinline__ unsigned pack_fp8x4(float a, float b, float c, float d) {
    a = __builtin_amdgcn_fmed3f(a, -448.f, 448.f); b = __builtin_amdgcn_fmed3f(b, -448.f, 448.f); c = __builtin_amdgcn_fmed3f(c, -448.f, 448.f); d = __builtin_amdgcn_fmed3f(d, -448.f, 448.f);
    int w = 0; w = __builtin_amdgcn_cvt_pk_fp8_f32(a, b, w, false); w = __builtin_amdgcn_cvt_pk_fp8_f32(c, d, w, true); return (unsigned)w; }
__device__ __forceinline__ unsigned pack_i8x4(float a, float b, float c, float d) {
    const int ia = (int)__builtin_amdgcn_fmed3f(rintf(a), -127.f, 127.f), ib = (int)__builtin_amdgcn_fmed3f(rintf(b), -127.f, 127.f), ic = (int)__builtin_amdgcn_fmed3f(rintf(c), -127.f, 127.f), id = (int)__builtin_amdgcn_fmed3f(rintf(d), -127.f, 127.f);
    return (unsigned)(ia & 255) | ((unsigned)(ib & 255) << 8) | ((unsigned)(ic & 255) << 16) | ((unsigned)(id & 255) << 24); }
__device__ __forceinline__ float wave_sum(float v) { for (int o = 32; o >= 1; o >>= 1) v += __shfl_xor(v, o); return v; }
__device__ __forceinline__ float wave_max(float v) { for (int o = 32; o >= 1; o >>= 1) v = fmaxf(v, __shfl_xor(v, o)); return v; }

#define XB_TMO      128
#define XB_XCNT(j)  (256  + 64 * (j))
#define XB_XSUB(j)  (1280 + 64 * (j))
#define XB_XGEN(j)  (2304 + 64 * (j))
#define XB_TOP      3328
#define XB_TOPGEN   3392
#define XCD_BAR_WORDS 3456
#define XB_SPIN_CAP (1u << 27)
__device__ __forceinline__ unsigned xb_ld(unsigned* p)              { return __hip_atomic_load(p, __ATOMIC_RELAXED, __HIP_MEMORY_SCOPE_AGENT); }
__device__ __forceinline__ unsigned xb_add(unsigned* p, unsigned v) { return __hip_atomic_fetch_add(p, v, __ATOMIC_RELAXED, __HIP_MEMORY_SCOPE_AGENT); }
__device__ __forceinline__ unsigned xb_xcc_id() { return (unsigned)__builtin_amdgcn_s_getreg((3 << 11) | 20) & 0xFu; }
#define XB_SPIN(cond, bar) do { unsigned _sp = 0; while (cond) { __builtin_amdgcn_s_sleep(1); \
    if ((++_sp & 255u) == 0u) { if (xb_ld(&(bar)[XB_TMO])) break; if (_sp > XB_SPIN_CAP) { atomicAdd(&(bar)[XB_TMO], 1u); break; } } } } while (0)
struct XcdBarrier { unsigned* bar; unsigned x; volatile LAS unsigned* st; };
__device__ __forceinline__ XcdBarrier xcd_barrier_post(unsigned* bar, volatile LAS unsigned* st) {
    XcdBarrier b; b.bar = bar; b.x = xb_xcc_id(); b.st = st;
    if (threadIdx.x == 0) (void)xb_add(&bar[XB_XCNT(b.x)], 1u);
    return b;
}
__device__ __forceinline__ void xcd_barrier_complete(unsigned* bar, unsigned x, unsigned& nloc, unsigned& nx) {
    const unsigned G = gridDim.x * gridDim.y * gridDim.z;
    unsigned sum, cnt, mine, sp = 0u;
    for (;;) {
        sum = 0u; cnt = 0u; mine = 0u;
#pragma unroll
        for (unsigned j = 0; j < 16; ++j) { const unsigned c = xb_ld(&bar[XB_XCNT(j)]); sum += c; cnt += (c > 0u) ? 1u : 0u; mine = (j == x) ? c : mine; }
        if (sum == G) break;
        __builtin_amdgcn_s_sleep(1);
        if ((++sp & 255u) == 0u) { if (xb_ld(&bar[XB_TMO])) break; if (sp > XB_SPIN_CAP) { atomicAdd(&bar[XB_TMO], 1u); break; } }
    }
    nloc = mine > 0u ? mine : 1u; nx = cnt > 0u ? cnt : 1u;
}
__device__ __forceinline__ void xcd_barrier(const XcdBarrier& b) {
    asm volatile("s_waitcnt vmcnt(0)" ::: "memory");
    __syncthreads();
    if (threadIdx.x == 0) {
        unsigned* bar = b.bar;
        __builtin_amdgcn_s_waitcnt(0);
        unsigned nloc = b.st[0], nx = b.st[1];
        if (nloc == 0u) { xcd_barrier_complete(bar, b.x, nloc, nx); b.st[0] = nloc; b.st[1] = nx; }
        const unsigned old = xb_add(&bar[XB_XSUB(b.x)], 1u);
        const unsigned gen = old / nloc;
        if (old + 1u == (gen + 1u) * nloc) {
            __builtin_amdgcn_fence(__ATOMIC_RELEASE, "agent");
            asm volatile("s_waitcnt vmcnt(0)" ::: "memory");
            const unsigned og = xb_add(&bar[XB_TOP], 1u);
            const unsigned tg = og / nx;
            if (og + 1u == (tg + 1u) * nx) xb_add(&bar[XB_TOPGEN], 1u);
            else XB_SPIN(xb_ld(&bar[XB_TOPGEN]) == tg, bar);
            __builtin_amdgcn_fence(__ATOMIC_ACQUIRE, "agent");
            xb_add(&bar[XB_XGEN(b.x)], 1u);
            asm volatile("s_waitcnt vmcnt(0)" ::: "memory");
        } else {
            XB_SPIN(xb_ld(&bar[XB_XGEN(b.x)]) == gen, bar);
            __builtin_amdgcn_fence(__ATOMIC_ACQUIRE, "agent");
            asm volatile("s_waitcnt vmcnt(0)" ::: "memory");
        }
    }
    __syncthreads();
}

struct Args { const float* in[23]; float* out; unsigned char* ws; int ph_lo, ph_hi; };
enum { IN_X = 0, IN_MEM, IN_WIN, IN_GATEB, IN_POOLW, IN_POOLS, IN_CONVW, IN_MNORM, IN_RNORM, IN_WBR, IN_WMIX, IN_WQ, IN_WK, IN_WV, IN_WO, IN_RW, IN_RB, IN_WGU, IN_WDN, IN_SGU, IN_SDN, IN_LNW, IN_LNB };

#define GAS __attribute__((address_space(1)))
struct DArgs { const GAS float* in[23]; GAS float* out; GAS unsigned char* ws; int ph_lo, ph_hi; };
typedef const __attribute__((address_space(4))) DArgs* KArgs;
struct Frame {
    LAS unsigned char* lds; int tid, lane, wave, wg, nwg;
    GAS unsigned char* wsg; KArgs ka;
    __device__ __forceinline__ unsigned char* ws_() const { return (unsigned char*)wsg; }
};
__device__ __forceinline__ Frame fresh(const Frame& F) { Frame G = F; asm volatile("" : "+s"(G.wsg)); asm volatile("" : "+s"(G.ka)); asm volatile("" : "+v"(G.tid)); asm volatile("" : "+s"(G.wg));
    G.lane = G.tid & 63; G.wave = __builtin_amdgcn_readfirstlane(G.tid >> 6); return G; }

struct GUnit {
    const bf16_t* Bt;
    const bf16_t* A;
    const int* gather;
    int row0;
    int pn;
    int e;
    bf16_t* dst;
};

__device__ __forceinline__ void un8(u32x4 w, f32x4& a, f32x4& b) { a[0] = __uint_as_float(w[0] << 16); a[1] = __uint_as_float(w[0] & 0xffff0000u); a[2] = __uint_as_float(w[1] << 16); a[3] = __uint_as_float(w[1] & 0xffff0000u);
    b[0] = __uint_as_float(w[2] << 16); b[1] = __uint_as_float(w[2] & 0xffff0000u); b[2] = __uint_as_float(w[3] << 16); b[3] = __uint_as_float(w[3] & 0xffff0000u); }
__device__ __forceinline__ void st_bf16x8(bf16_t* p, f32x4 a, f32x4 b) { u32x4 w; w[0] = pack2(a[0], a[1]); w[1] = pack2(a[2], a[3]); w[2] = pack2(b[0], b[1]); w[3] = pack2(b[2], b[3]); *(u32x4*)p = w; }
__device__ __forceinline__ void st_bf16x4(bf16_t* p, f32x4 v) { u32x2 w; w.x = pack2(v[0], v[1]); w.y = pack2(v[2], v[3]); *(u32x2*)p = w; }
__device__ __forceinline__ void ld_row32(const bf16_t* row, int lane, float (&v)[32]) {
#pragma unroll
    for (int j = 0; j < 4; ++j) { const u32x4 w = *(const u32x4*)(row + j * 512 + lane * 8);
#pragma unroll
        for (int e = 0; e < 4; ++e) { v[j * 8 + 2 * e] = __uint_as_float(w[e] << 16); v[j * 8 + 2 * e + 1] = __uint_as_float(w[e] & 0xffff0000u); } } }
__device__ __forceinline__ void st_row32(bf16_t* row, int lane, const float (&v)[32]) {
#pragma unroll
    for (int j = 0; j < 4; ++j) { u32x4 w;
#pragma unroll
        for (int e = 0; e < 4; ++e) w[e] = pack2(v[j * 8 + 2 * e], v[j * 8 + 2 * e + 1]);
        *(u32x4*)(row + j * 512 + lane * 8) = w; } }
__device__ __forceinline__ void st_row32_i8(unsigned char* row, float* sc, int lane, const float (&v)[32]) {
    float am = 0.f;
#pragma unroll
    for (int j = 0; j < 32; ++j) am = fmaxf(am, fabsf(v[j]));
    am = fmaxf(wave_max(am), 1e-30f); const float q = 127.0f / am;
#pragma unroll
    for (int j = 0; j < 4; ++j) { u32x2 w; w.x = pack_i8x4(v[j * 8] * q, v[j * 8 + 1] * q, v[j * 8 + 2] * q, v[j * 8 + 3] * q); w.y = pack_i8x4(v[j * 8 + 4] * q, v[j * 8 + 5] * q, v[j * 8 + 6] * q, v[j * 8 + 7] * q);
        *(u32x2*)(row + j * 512 + lane * 8) = w; }
    if (lane == 0) *sc = am * (1.0f / 127.0f); }
__device__ __forceinline__ void st_row32_fp8(unsigned char* row, int lane, const float (&v)[32]) {
#pragma unroll
    for (int j = 0; j < 4; ++j) { u32x2 w; w.x = pack_fp8x4(v[j * 8] * X8_SCALE, v[j * 8 + 1] * X8_SCALE, v[j * 8 + 2] * X8_SCALE, v[j * 8 + 3] * X8_SCALE); w.y = pack_fp8x4(v[j * 8 + 4] * X8_SCALE, v[j * 8 + 5] * X8_SCALE, v[j * 8 + 6] * X8_SCALE, v[j * 8 + 7] * X8_SCALE);
        *(u32x2*)(row + j * 512 + lane * 8) = w; } }
struct NoPre { };
struct EpiProj {
    static constexpr bool PAIR_M = false; static constexpr bool SEG = false; typedef NoPre Pre;
    bf16_t* proj; bf16_t* gates;
    static __device__ __forceinline__ float unit_scale(const GUnit& u) { return (u.pn == PC_MK / 256 || u.pn == PC_MK / 256 + 1 || u.pn == PC_RK / 256 || u.pn == PC_RK / 256 + 1) ? 0.08838834764831845f : 1.0f; }
    __device__ __forceinline__ void pre(const GUnit&, int, int, Pre&) const {}
    __device__ __forceinline__ void fin(const GUnit& u, int r, int c, const f32x4 (&a)[2][2], const Pre&) const {
        const int col = u.pn * 256 + c; const size_t row = (size_t)(u.row0 + r);
        if (col < NBR) { st_bf16x8(proj + row * NBR + col, a[0][0], a[0][1]); st_bf16x8(proj + row * NBR + col + 128, a[1][0], a[1][1]); }
        else { f32x4 s[2][2];
#pragma unroll
            for (int h = 0; h < 2; ++h)
#pragma unroll
                for (int n = 0; n < 2; ++n)
#pragma unroll
                    for (int j = 0; j < 4; ++j) s[h][n][j] = fmaxf(sigmoidf_(a[h][n][j]), 1e-7f);
            st_bf16x8(gates + row * 8192 + (col - NBR), s[0][0], s[0][1]); st_bf16x8(gates + row * 8192 + (col - NBR) + 128, s[1][0], s[1][1]); }
    }
};
struct EpiBranch {
    static constexpr bool PAIR_M = false; static constexpr bool SEG = true;
    struct Pre { u32x4 g0, g1; };
    struct SPre { u32x4 a0, a1, b0, b1; };
    const bf16_t* gates; bf16_t* out;
    __device__ __forceinline__ void pre(const GUnit& u, int r, int c, Pre& p) const { const bf16_t* g = gates + (size_t)(u.row0 + r) * 8192 + 3 * 2048 + u.pn * 256 + c; p.g0 = *(const u32x4*)g; p.g1 = *(const u32x4*)(g + 128); }
    __device__ __forceinline__ void fin(const GUnit& u, int r, int c, const f32x4 (&a)[2][2], const Pre& p) const {
        f32x4 x0, x1, y0, y1; un8(p.g0, x0, x1); un8(p.g1, y0, y1);
        bf16_t* o = out + (size_t)(u.row0 + r) * D + u.pn * 256 + c; st_bf16x8(o, a[0][0] * x0, a[0][1] * x1); st_bf16x8(o + 128, a[1][0] * y0, a[1][1] * y1); }
    __device__ __forceinline__ void seg_pre(const GUnit& u, int r, int c, int s, SPre& p) const { const bf16_t* g = gates + (size_t)(u.row0 + r) * 8192 + s * 2048 + u.pn * 256 + c;
        p.a0 = *(const u32x4*)g; p.a1 = *(const u32x4*)(g + 128); p.b0 = *(const u32x4*)(g + 2048); p.b1 = *(const u32x4*)(g + 2048 + 128); }
    __device__ __forceinline__ void seg_fin(f32x4 (&h0)[2], f32x4 (&h1)[2], const SPre& p) const {
        f32x4 a0, a1, b0, b1; un8(p.a0, a0, a1); un8(p.b0, b0, b1);
#pragma unroll
        for (int j = 0; j < 4; ++j) { h0[0][j] *= a0[j] * __builtin_amdgcn_rcpf(b0[j]); h0[1][j] *= a1[j] * __builtin_amdgcn_rcpf(b1[j]); }
        un8(p.a1, a0, a1); un8(p.b1, b0, b1);
#pragma unroll
        for (int j = 0; j < 4; ++j) { h1[0][j] *= a0[j] * __builtin_amdgcn_rcpf(b0[j]); h1[1][j] *= a1[j] * __builtin_amdgcn_rcpf(b1[j]); }
    }
};
struct EpiResid {
    static constexpr bool PAIR_M = false; static constexpr bool SEG = false;
    struct Pre { u32x4 x0, x1; };
    const bf16_t* x; bf16_t* y;
    __device__ __forceinline__ void pre(const GUnit& u, int r, int c, Pre& p) const { const bf16_t* xp = x + (size_t)(u.row0 + r) * D + u.pn * 256 + c; p.x0 = *(const u32x4*)xp; p.x1 = *(const u32x4*)(xp + 128); }
    __device__ __forceinline__ void fin(const GUnit& u, int r, int c, const f32x4 (&a)[2][2], const Pre& p) const {
        f32x4 x0, x1, y0, y1; un8(p.x0, x0, x1); un8(p.x1, y0, y1);
        bf16_t* o = y + (size_t)(u.row0 + r) * D + u.pn * 256 + c; st_bf16x8(o, x0 * ALPHA + a[0][0], x1 * ALPHA + a[0][1]); st_bf16x8(o + 128, y0 * ALPHA + a[1][0], y1 * ALPHA + a[1][1]); }
};
struct EpiQKV {
    static constexpr bool PAIR_M = false; static constexpr bool SEG = false; typedef NoPre Pre; int pad_;
    __device__ __forceinline__ void pre(const GUnit&, int, int, Pre&) const {}
    __device__ __forceinline__ void fin(const GUnit& u, int r, int c, const f32x4 (&a)[2][2], const Pre&) const {
        bf16_t* o = u.dst + (size_t)(u.row0 + r) * W + u.pn * 256 + c; st_bf16x8(o, a[0][0], a[0][1]); st_bf16x8(o + 128, a[1][0], a[1][1]); }
};
struct EpiSwiglu {
    static constexpr bool SEG = false; static constexpr bool PAIR_M = true;
    struct Pre { float w; };
    const float* wsl; unsigned char* hb;
    __device__ __forceinline__ void pre(const GUnit& u, int r, int, Pre& p) const { p.w = wsl[u.row0 + r] * H8_SCALE; }
    __device__ __forceinline__ u32x2 act(const f32x4 (&a)[2][2], float w) const { f32x4 o[2];
#pragma unroll
        for (int n = 0; n < 2; ++n)
#pragma unroll
            for (int j = 0; j < 4; ++j) o[n][j] = a[0][n][j] * sigmoidf_(a[0][n][j]) * a[1][n][j] * w;
        u32x2 w8; w8.x = pack_fp8x4(o[0][0], o[0][1], o[0][2], o[0][3]); w8.y = pack_fp8x4(o[1][0], o[1][1], o[1][2], o[1][3]); return w8; }
    __device__ __forceinline__ void fin2(const GUnit& u, int r0, int r1, int c, const f32x4 (&a0)[2][2], const f32x4 (&a1)[2][2], const Pre& p0, const Pre& p1) const {
        u32x2 v0 = act(a0, p0.w), v1 = act(a1, p1.w);
        { const auto rx = __builtin_amdgcn_permlane32_swap(v0.x, v1.x, false, false); v0.x = rx[0]; v1.x = rx[1]; const auto ry = __builtin_amdgcn_permlane32_swap(v0.y, v1.y, false, false); v0.y = ry[0]; v1.y = ry[1]; }
        const bool up = (threadIdx.x & 32u) != 0u;
        unsigned char* o = hb + (size_t)(u.row0 + (up ? r1 : r0)) * ED + u.pn * 128 + (up ? c - 8 : c);
        u32x4 w; w[0] = v0.x; w[1] = v0.y; w[2] = v1.x; w[3] = v1.y; *(u32x4*)o = w; }
    __device__ __forceinline__ void fin(const GUnit&, int, int, const f32x4 (&)[2][2], const Pre&) const {}
};
struct EpiDown {
    static constexpr bool PAIR_M = false; static constexpr bool SEG = false; typedef NoPre Pre;
    unsigned char* yb;
    __device__ __forceinline__ void pre(const GUnit&, int, int, Pre&) const {}
    __device__ __forceinline__ void fin(const GUnit& u, int r, int c, const f32x4 (&a)[2][2], const Pre&) const {
        u32x2 w0, w1; w0.x = pack_fp8x4(a[0][0][0], a[0][0][1], a[0][0][2], a[0][0][3]); w0.y = pack_fp8x4(a[0][1][0], a[0][1][1], a[0][1][2], a[0][1][3]);
        w1.x = pack_fp8x4(a[1][0][0], a[1][0][1], a[1][0][2], a[1][0][3]); w1.y = pack_fp8x4(a[1][1][0], a[1][1][1], a[1][1][2], a[1][1][3]);
        { const auto rx = __builtin_amdgcn_permlane32_swap(w0.x, w1.x, false, false); w0.x = rx[0]; w1.x = rx[1]; const auto ry = __builtin_amdgcn_permlane32_swap(w0.y, w1.y, false, false); w0.y = ry[0]; w1.y = ry[1]; }
        const bool up = (threadIdx.x & 32u) != 0u;
        unsigned char* o = yb + (size_t)(u.row0 + r) * D + u.pn * 256 + (up ? 128 + c - 8 : c);
        u32x4 w; w[0] = w0.x; w[1] = w0.y; w[2] = w1.x; w[3] = w1.y; *(u32x4*)o = w; }
};

typedef short bf16x8 __attribute__((ext_vector_type(8)));
typedef short s16x4 __attribute__((ext_vector_type(4)));
__device__ __forceinline__ s16x4 lds_tr(const LAS bf16_t* p) { return __builtin_amdgcn_ds_read_tr16_b64_v4i16((LAS s16x4*)p); }
__device__ __forceinline__ bf16x8 cat4(s16x4 a, s16x4 b) { bf16x8 r; r[0] = a[0]; r[1] = a[1]; r[2] = a[2]; r[3] = a[3]; r[4] = b[0]; r[5] = b[1]; r[6] = b[2]; r[7] = b[3]; return r; }
__device__ __forceinline__ bf16x8 pack8(f32x4 a, f32x4 b) { union { u32x4 u; bf16x8 h; } c; c.u[0] = pack2(a[0], a[1]); c.u[1] = pack2(a[2], a[3]); c.u[2] = pack2(b[0], b[1]); c.u[3] = pack2(b[2], b[3]); return c.h; }
constexpr int BK = 64, HTB = 128 * BK * 2;
__device__ __forceinline__ int lds_byte(int r, int c) { const int st = (r >> 4) * 2 + (c >> 5), rr = r & 15, cc = c & 31, ob = rr * 64 + cc * 2; return st * 1024 + (ob ^ (((ob >> 9) & 1) << 5)); }
__device__ __forceinline__ void stage_rc(int b, int& R, int& C) { const int st = b / 1024, sb = b % 1024, swz = sb ^ (((sb >> 9) & 1) << 5); R = (st >> 1) * 16 + swz / 64; C = (st & 1) * 32 + (swz % 64) / 2; }

typedef int i32x8 __attribute__((ext_vector_type(8)));
typedef int i32x4 __attribute__((ext_vector_type(4)));
template <class Epi, class Sched, int MODE = 0>
__device__ __forceinline__ void gemm_phase_mfma(const Frame& F, const int K, const Sched& S, const Epi& E, const float oscale = 1.0f, const float* rowscale = nullptr) {
    constexpr bool FP8 = (MODE == 1), I8 = (MODE == 2);
    LAS unsigned char* lds = F.lds;
    const int tid = F.tid, wid = F.wave, lane = F.lane, wr = wid >> 2, wc = wid & 3, fr = lane & 15, fq = lane >> 4;
    const int KB = MODE ? K : 2 * K;
    const int nt = KB / 128;
    unsigned voffB[2];
#pragma unroll
    for (int i = 0; i < 2; ++i) { int R, C; stage_rc(tid * 16 + i * 8192, R, C); const int rho = R & 31, q4 = (rho & 15) >> 2, Rb = (R & ~31) + 8 * (((q4 & 1) << 1) | (q4 >> 1)) + 4 * (rho >> 4) + (rho & 3); voffB[i] = (unsigned)(Rb * KB + C * 2); }
    const size_t kstep = (size_t)(BK * 2);
    const size_t hstepB = (size_t)128 * KB;
    const unsigned ldsw = (unsigned)wid * 1024u;
    const int aoff = FP8 ? lds_byte(wr * 64 + fr, fq * 16) : lds_byte(wr * 64 + fr, fq * 8), boff = FP8 ? lds_byte(wc * 32 + fr, fq * 16) : lds_byte(wc * 32 + fr, fq * 8);
#define SA_(b, h) (((b) * 2 + (h)) * HTB)
#define SB_(b, h) ((4 + (b) * 2 + (h)) * HTB)
#define STAGE_(bufoff, gbase, voff) do { _Pragma("unroll") for (int _i = 0; _i < 2; ++_i) \
        __builtin_amdgcn_global_load_lds((const unsigned*)((const char*)(gbase) + (voff)[_i]), (LAS unsigned*)(lds + (bufoff) + ldsw + _i * 8192), 16, 0, 0); } while (0)
#define LDA_(dst, b, h) do { _Pragma("unroll") for (int m = 0; m < 4; ++m) { if constexpr (FP8) { const i32x4 _lo = *(const LAS i32x4*)(lds + SA_(b, h) + aoff + m * 2048), _hi = *(const LAS i32x4*)(lds + SA_(b, h) + aoff + m * 2048 + 16); \
            dst##8[m] = __builtin_shufflevector(_lo, _hi, 0, 1, 2, 3, 4, 5, 6, 7); } \
        else { _Pragma("unroll") for (int k = 0; k < 2; ++k) dst[m][k] = *(const LAS bf16x8*)(lds + SA_(b, h) + aoff + m * 2048 + k * 1024); } } } while (0)
#define LDB_(dst, b, h) do { _Pragma("unroll") for (int n = 0; n < 2; ++n) { if constexpr (FP8) { const i32x4 _lo = *(const LAS i32x4*)(lds + SB_(b, h) + boff + n * 2048), _hi = *(const LAS i32x4*)(lds + SB_(b, h) + boff + n * 2048 + 16); \
            dst##8[n] = __builtin_shufflevector(_lo, _hi, 0, 1, 2, 3, 4, 5, 6, 7); } \
        else { _Pragma("unroll") for (int k = 0; k < 2; ++k) dst[n][k] = *(const LAS bf16x8*)(lds + SB_(b, h) + boff + n * 2048 + k * 1024); } } } while (0)
#define MMA_(ai, bj, At, Bt) do { __builtin_amdgcn_s_setprio(1); _Pragma("unroll") for (int m = 0; m < 4; ++m) _Pragma("unroll") for (int n = 0; n < 2; ++n) { \
        if constexpr (FP8) asm volatile("v_mfma_scale_f32_16x16x128_f8f6f4 %0, %1, %2, %0, %3, %3 op_sel_hi:[0,0,0]" : "+v"(acc[ai][bj][m][n]) : "v"(Bt##8[n]), "v"(At##8[m]), "v"(sc8)); \
        else if constexpr (I8) { _Pragma("unroll") for (int k = 0; k < 2; ++k) acci[ai][bj][m][n] = __builtin_amdgcn_mfma_i32_16x16x64_i8(__builtin_bit_cast(i32x4, Bt[n][k]), __builtin_bit_cast(i32x4, At[m][k]), acci[ai][bj][m][n], 0, 0, 0); } \
        else { _Pragma("unroll") for (int k = 0; k < 2; ++k) acc[ai][bj][m][n] = __builtin_amdgcn_mfma_f32_16x16x32_bf16(Bt[n][k], At[m][k], acc[ai][bj][m][n], 0, 0, 0); } } \
        __builtin_amdgcn_s_setprio(0); } while (0)
#define WAIT_V_(n) asm volatile("s_waitcnt vmcnt(" #n ")" ::: "memory")
#define WAIT_L_(n) asm volatile("s_waitcnt lgkmcnt(" #n ")" ::: "memory")
#define BAR_ __builtin_amdgcn_s_barrier()
#define SCHED_ __builtin_amdgcn_sched_barrier(0)
#define VOFFS_(dst, u) do { int _tz = tid; asm volatile("" : "+v"(_tz)); _Pragma("unroll") for (int _i = 0; _i < 2; ++_i) { int _R, _C; stage_rc(_tz * 16 + _i * 8192, _R, _C); \
        _Pragma("unroll") for (int _h = 0; _h < 2; ++_h) { const int _r = _h * 128 + _R; \
        const unsigned _row = (u).gather ? (unsigned)(u).gather[_r] : (unsigned)((u).row0 + _r); dst[_h][_i] = _row * (unsigned)KB + (unsigned)_C * 2u; } } } while (0)
    GUnit cur, nxt; int ui = 0;
    if (!S.get(0, cur)) return;
    f32x4 acc[2][2][4][2]; i32x4 acci[2][2][4][2];
#pragma unroll
    for (int a = 0; a < 2; ++a)
#pragma unroll
        for (int b = 0; b < 2; ++b)
#pragma unroll
            for (int m = 0; m < 4; ++m)
#pragma unroll
                for (int n = 0; n < 2; ++n) { acc[a][b][m][n] = (f32x4){0.f, 0.f, 0.f, 0.f}; acci[a][b][m][n] = (i32x4){0, 0, 0, 0}; }
    bf16x8 At[4][2], B0[2][2], B1[2][2]; i32x8 At8[4], B08[2], B18[2];
    int sc8 = 0x7f7f7f7f; asm volatile("" : "+v"(sc8));
    unsigned vA[2][2], vN[2][2];
    VOFFS_(vA, cur);
    const char* cA = (const char*)cur.A; const char* cB = (const char*)cur.Bt;
    STAGE_(SB_(0, 0), cB, voffB); STAGE_(SA_(0, 0), cA, vA[0]); STAGE_(SB_(0, 1), cB + hstepB, voffB); STAGE_(SA_(0, 1), cA, vA[1]);
    if (wr == 1) BAR_;
    WAIT_V_(4); BAR_;
    STAGE_(SB_(1, 0), cB + kstep, voffB); STAGE_(SA_(1, 0), cA + kstep, vA[0]); STAGE_(SB_(1, 1), cB + hstepB + kstep, voffB);
    WAIT_V_(6); BAR_;
    for (;;) {
        const bool has_next = S.get(ui + 1, nxt);
        const char* nA = has_next ? (const char*)nxt.A : cA; const char* nB = has_next ? (const char*)nxt.Bt : cB;
        if (has_next) { VOFFS_(vN, nxt); }
        for (int t = 0; t < nt; t += 2) {
            const bool last = (t == nt - 2);
            if constexpr (Epi::SEG) { if (t > 0 && (t & 7) == 0) {
                int tz = tid; asm volatile("" : "+v"(tz)); const int er = ((tz >> 8) & 1) * 64 + (tz & 15), ec = ((tz >> 6) & 3) * 32 + ((((tz >> 4) & 1) << 1) | ((tz >> 5) & 1)) * 8;
#pragma unroll
                for (int ai = 0; ai < 2; ++ai) { typename Epi::SPre sp[4];
#pragma unroll
                    for (int m = 0; m < 4; ++m) E.seg_pre(cur, ai * 128 + m * 16 + er, ec, (t >> 3) - 1, sp[m]);
#pragma unroll
                    for (int m = 0; m < 4; ++m) E.seg_fin(acc[ai][0][m], acc[ai][1][m], sp[m]);
                    asm volatile("" ::: "memory"); }
            } }
            const char* a1 = cA + (size_t)(t + 1) * kstep;
            const char* a2 = last ? nA : cA + (size_t)(t + 2) * kstep; const char* b2 = last ? nB : cB + (size_t)(t + 2) * kstep;
            const char* a3 = a2 + kstep; const char* b3 = b2 + kstep;
            unsigned w0[2], w1[2];
#pragma unroll
            for (int i = 0; i < 2; ++i) { w0[i] = (last && has_next) ? vN[0][i] : vA[0][i]; w1[i] = (last && has_next) ? vN[1][i] : vA[1][i]; }
            LDB_(B0, 0, 0); SCHED_; LDA_(At, 0, 0); STAGE_(SA_(1, 1), a1, vA[1]);
            WAIT_L_(8); BAR_; WAIT_L_(0); MMA_(0, 0, At, B0); BAR_; SCHED_;
            LDB_(B1, 0, 1); STAGE_(SB_(0, 0), b2, voffB);
            BAR_; WAIT_L_(0); MMA_(0, 1, At, B1); BAR_;
            LDA_(At, 0, 1); STAGE_(SA_(0, 0), a2, w0);
            BAR_; WAIT_L_(0); MMA_(1, 0, At, B0); BAR_; SCHED_;
            STAGE_(SB_(0, 1), b2 + hstepB, voffB);
            WAIT_V_(6); BAR_; MMA_(1, 1, At, B1); BAR_;
            LDB_(B0, 1, 0); SCHED_; LDA_(At, 1, 0); STAGE_(SA_(0, 1), a2, w1);
            WAIT_L_(8); BAR_; WAIT_L_(0); MMA_(0, 0, At, B0); BAR_; SCHED_;
            LDB_(B1, 1, 1); STAGE_(SB_(1, 0), b3, voffB);
            BAR_; WAIT_L_(0); MMA_(0, 1, At, B1); BAR_;
            LDA_(At, 1, 1); STAGE_(SA_(1, 0), a3, w0);
            BAR_; WAIT_L_(0); MMA_(1, 0, At, B0); BAR_; SCHED_;
            STAGE_(SB_(1, 1), b3 + hstepB, voffB);
            WAIT_V_(6); BAR_; MMA_(1, 1, At, B1); BAR_;
        }
        { int tz = tid; asm volatile("" : "+v"(tz)); const int er = ((tz >> 8) & 1) * 64 + (tz & 15), ec = ((tz >> 6) & 3) * 32 + ((((tz >> 4) & 1) << 1) | ((tz >> 5) & 1)) * 8;
          typename Epi::Pre pre[2][4];
#pragma unroll
          for (int ai = 0; ai < 2; ++ai)
#pragma unroll
              for (int m = 0; m < 4; ++m) E.pre(cur, ai * 128 + m * 16 + er, ec, pre[ai][m]);
          if constexpr (I8) {
#pragma unroll
              for (int ai = 0; ai < 2; ++ai)
#pragma unroll
                  for (int m = 0; m < 4; ++m) { const float rs = rowscale[cur.row0 + ai * 128 + m * 16 + er] * oscale * Epi::unit_scale(cur);
#pragma unroll
                      for (int bj = 0; bj < 2; ++bj)
#pragma unroll
                          for (int n = 0; n < 2; ++n)
#pragma unroll
                              for (int j = 0; j < 4; ++j) acc[ai][bj][m][n][j] = (float)acci[ai][bj][m][n][j] * rs; } }
          if constexpr (FP8) {
#pragma unroll
              for (int ai = 0; ai < 2; ++ai)
#pragma unroll
                  for (int bj = 0; bj < 2; ++bj)
#pragma unroll
                      for (int m = 0; m < 4; ++m)
#pragma unroll
                          for (int n = 0; n < 2; ++n) acc[ai][bj][m][n] *= oscale; }
          if constexpr (Epi::PAIR_M) {
#pragma unroll
          for (int ai = 0; ai < 2; ++ai)
#pragma unroll
              for (int m = 0; m < 4; m += 2) { const f32x4 a4[2][2] = {{acc[ai][0][m][0], acc[ai][0][m][1]}, {acc[ai][1][m][0], acc[ai][1][m][1]}}; const f32x4 b4[2][2] = {{acc[ai][0][m + 1][0], acc[ai][0][m + 1][1]}, {acc[ai][1][m + 1][0], acc[ai][1][m + 1][1]}};
                  E.fin2(cur, ai * 128 + m * 16 + er, ai * 128 + (m + 1) * 16 + er, ec, a4, b4, pre[ai][m], pre[ai][m + 1]); }
          } else {
#pragma unroll
          for (int ai = 0; ai < 2; ++ai)
#pragma unroll
              for (int m = 0; m < 4; ++m) { const f32x4 a4[2][2] = {{acc[ai][0][m][0], acc[ai][0][m][1]}, {acc[ai][1][m][0], acc[ai][1][m][1]}}; E.fin(cur, ai * 128 + m * 16 + er, ec, a4, pre[ai][m]); } } }
        if (!has_next) break;
#pragma unroll
        for (int a = 0; a < 2; ++a)
#pragma unroll
            for (int b = 0; b < 2; ++b)
#pragma unroll
                for (int m = 0; m < 4; ++m)
#pragma unroll
                    for (int n = 0; n < 2; ++n) { acc[a][b][m][n] = (f32x4){0.f, 0.f, 0.f, 0.f}; acci[a][b][m][n] = (i32x4){0, 0, 0, 0}; }
        cur = nxt; cA = nA; cB = nB; ++ui;
#pragma unroll
        for (int h = 0; h < 2; ++h)
#pragma unroll
            for (int i = 0; i < 2; ++i) vA[h][i] = vN[h][i];
    }
    WAIT_V_(0);
    if (wr == 0) BAR_;
    BAR_;
#undef SA_
#undef SB_
#undef STAGE_
#undef LDA_
#undef LDB_
#undef MMA_
#undef WAIT_V_
#undef WAIT_L_
#undef BAR_
#undef SCHED_
#undef VOFFS_
}

struct DenseSched {
    const bf16_t* A; const bf16_t* Bt; int K, nM, nN, nwg, G, c, i0, i1, split, pnoff;
    __device__ __forceinline__ void segment(int sg) { i0 = sg == 0 ? 0 : split; i1 = sg == 0 ? split : (1 << 30); }
    __device__ __forceinline__ bool get(int ii, GUnit& u) const {
        const int i = ii + i0; if (i >= i1) return false;
        const long L = (long)i * G + c; if (L >= nwg) return false;
        int wgid = (int)L; { const int q = nwg / 8, r = nwg % 8, xcd = wgid % 8, off = wgid / 8; wgid = (xcd < r ? xcd * (q + 1) : r * (q + 1) + (xcd - r) * q) + off; }
        const int nig = 8 * nN, gid = wgid / nig, fm = gid * 8, gsz = (nM - fm) < 8 ? (nM - fm) : 8;
        const int pm = fm + ((wgid % nig) % gsz), pn = (wgid % nig) / gsz;
        u.pn = pn + pnoff; u.row0 = pm * 256; u.A = A; u.gather = nullptr; u.Bt = Bt + (size_t)pn * 256 * K; u.e = 0; return true;
    }
};
struct QkvSched {
    unsigned char* ws; int l, G, c;
    __device__ __forceinline__ bool get(int i, GUnit& g) const {
        const int u = i * G + c; if (u >= 144) return false; g.gather = nullptr;
        if (u < 128) { g.e = 0; g.pn = u & 1; g.row0 = (u >> 1) * 256; g.A = (const bf16_t*)(ws + WS_XB); g.Bt = (const bf16_t*)(ws + WS_WQ + l * SZ_WQ) + (size_t)g.pn * 256 * D; g.dst = (bf16_t*)(ws + WS_Q); }
        else { const int v = u - 128; g.e = 1 + (v >> 3); g.pn = v & 1; g.row0 = ((v >> 1) & 3) * 256; g.A = (const bf16_t*)(ws + WS_MEMB); g.Bt = (const bf16_t*)(ws + (g.e == 1 ? WS_WK : WS_WV) + l * SZ_WQ) + (size_t)g.pn * 256 * D; g.dst = (bf16_t*)(ws + (g.e == 1 ? WS_KM : WS_VM)) + (size_t)l * TM * W; }
        return true;
    }
};
template <int NCT, bool GATEUP> struct MoeSched {
    unsigned char* ws; const LAS int* pst; int l, G, c, nunits;
    __device__ __forceinline__ bool get(int i, GUnit& g) const {
        const int u = i * G + c; if (u >= nunits) return false;
        const int rt = u / NCT; g.pn = u % NCT; g.row0 = rt * 256; const int e = __builtin_amdgcn_readfirstlane((int)((const LAS unsigned char*)(pst + 68))[rt]); g.e = e;
        if (GATEUP) { g.A = (const bf16_t*)(ws + WS_XB8); g.gather = (const int*)(ws + WS_TOK) + g.row0; g.Bt = (const bf16_t*)(ws + WS_WGU8 + ((size_t)l * NEX + e) * SZ_WGU8 + (size_t)g.pn * 256 * D); }
        else { g.A = (const bf16_t*)(ws + WS_HB); g.gather = nullptr; g.Bt = (const bf16_t*)(ws + WS_WDN + ((size_t)l * NEX + e) * SZ_WDN1 + (size_t)g.pn * 256 * ED); }
        return true;
    }
};

struct TDesc { const float* sp; int sld; unsigned char* dp; int dldb; int fp8; float qs; };
constexpr int TK_WINA = 1024, TK_WINB = 2560, TK_BR = 384, TK_WOUT = 512, TK_QKV = 384, TK_WO = 128, TK_GU = NEX * 8 * 32, TK_DN = NEX * 128;
constexpr int TK_L0DEF = TK_BR + TK_WOUT + TK_QKV + TK_WO + TK_GU + TK_DN, TK_LAYER = TK_WINA + TK_WINB + TK_L0DEF;
__device__ __forceinline__ void tile_desc(const Frame& F, int l, int t, TDesc& d) {
    const KArgs a = F.ka; unsigned char* ws = F.ws_(); d.fp8 = 0; d.qs = W8_SCALE;
    if (t < TK_WINA) { const int tk = t >> 6, tc = t & 63; d.sp = ((const float*)a->in[IN_WIN]) + (size_t)l * D * PROJ_W + (size_t)tk * 128 * PROJ_W + tc * 64; d.sld = PROJ_W; d.dldb = D; d.fp8 = 2; d.qs = 127.0f / fmaxf(__uint_as_float(((const unsigned*)(ws + WS_CTL))[CW_WABS + l]), 1e-30f); d.dp = ws + WS_WINQ + l * SZ_WINQ + (size_t)tc * 64 * D + tk * 128; return; }
    t -= TK_WINA;
    if (t < TK_WINB) { const int tk = t / 160, tc = t % 160; d.sp = ((const float*)a->in[IN_WIN]) + (size_t)l * D * PROJ_W + (size_t)tk * 128 * PROJ_W + 4104 + tc * 64; d.sld = PROJ_W;
        if (tc < 32) { d.dldb = D; d.fp8 = 2; d.qs = 127.0f / fmaxf(__uint_as_float(((const unsigned*)(ws + WS_CTL))[CW_WABS + l]), 1e-30f); d.dp = ws + WS_WINQ + l * SZ_WINQ + (size_t)(4096 + tc * 64) * D + tk * 128; }
        else { d.dldb = D; d.fp8 = 1; d.dp = ws + WS_WIN8 + l * SZ_WIN8 + (size_t)(4096 + tc * 64) * D + tk * 128; }
        return; }
    t -= TK_WINB;
    if (t < TK_BR) { const int n = 1 + (t >> 7), tt = t & 127, tk = tt >> 5, tc = tt & 31; d.sp = ((const float*)a->in[IN_WBR]) + ((size_t)l * 4 + n) * W * D + (size_t)tk * 128 * D + tc * 64; d.sld = D; d.dldb = D * 2; d.dp = ws + WS_WB + l * SZ_DD + ((size_t)tc * 64 * D + n * W + tk * 128) * 2; return; }
    t -= TK_BR;
    if (t < TK_WOUT) { const int tk = t >> 5, tc = t & 31; d.sp = ((const float*)a->in[IN_WMIX]) + (size_t)l * D * D + (size_t)tk * 128 * D + tc * 64; d.sld = D; d.dldb = D * 2; d.dp = ws + WS_WOUT + l * SZ_DD + ((size_t)tc * 64 * D + tk * 128) * 2; return; }
    t -= TK_WOUT;
    if (t < TK_QKV) { const int which = t >> 7, tt = t & 127, tk = tt >> 3, tc = tt & 7; d.sp = (const float*)a->in[which == 0 ? IN_WQ : (which == 1 ? IN_WK : IN_WV)] + (size_t)l * D * W + (size_t)tk * 128 * W + tc * 64; d.sld = W; d.dldb = D * 2;
        d.dp = ws + (which == 0 ? WS_WQ : (which == 1 ? WS_WK : WS_WV)) + l * SZ_WQ + ((size_t)tc * 64 * D + tk * 128) * 2; return; }
    t -= TK_QKV;
    if (t < TK_WO) { const int tk = t >> 5, tc = t & 31; d.sp = ((const float*)a->in[IN_WO]) + (size_t)l * W * D + (size_t)tk * 128 * D + tc * 64; d.sld = D; d.dldb = W * 2; d.dp = ws + WS_WO + l * SZ_WQ + ((size_t)tc * 64 * W + tk * 128) * 2; return; }
    t -= TK_WO;
    if (t < TK_GU) { const int tt = t & 31, job = t >> 5, half = job & 1, j = (job >> 1) & 3, e = job >> 3, tk = tt >> 1, tc = tt & 1;
        d.sp = (e < NE ? ((const float*)a->in[IN_WGU]) + ((size_t)l * NE + e) * D * 1024 : ((const float*)a->in[IN_SGU]) + (size_t)l * D * 1024) + half * 512 + j * 128 + (size_t)tk * 128 * 1024 + tc * 64; d.sld = 1024; d.dldb = D; d.fp8 = 1;
        d.dp = ws + WS_WGU8 + ((size_t)l * NEX + e) * SZ_WGU8 + (size_t)(j * 256 + half * 128 + tc * 64) * D + tk * 128; return; }
    t -= TK_GU;
    { const int tt = t & 127, e = t >> 7, tk = tt >> 5, tc = tt & 31;
      d.sp = (e < NE ? ((const float*)a->in[IN_WDN]) + ((size_t)l * NE + e) * ED * D : ((const float*)a->in[IN_SDN]) + (size_t)l * ED * D) + (size_t)tk * 128 * D + tc * 64; d.sld = D; d.dldb = ED; d.fp8 = 1;
      d.dp = ws + WS_WDN + ((size_t)l * NEX + e) * SZ_WDN1 + (size_t)tc * 64 * ED + tk * 128; }
}
constexpr int XP_SLOT = 64 * 256;
template <int NB> struct XRegs { f32x4 r[NB][4]; };
template <int NB> __device__ __forceinline__ void xpose_load(const Frame& F, int l, int t0, int tstep, int n, XRegs<NB>& X) {
    const int tid = F.tid, row4 = (tid >> 4) * 4, cq = (tid & 15) * 4;
#pragma unroll
    for (int b = 0; b < NB; ++b) if (b < n) { TDesc d; tile_desc(F, l, t0 + b * tstep, d); const float* sp = d.sp + (size_t)row4 * d.sld + cq;
#pragma unroll
        for (int q = 0; q < 4; ++q) X.r[b][q] = __builtin_nontemporal_load((const f32x4*)(sp + (size_t)q * d.sld)); }
}
template <int NB> __device__ __forceinline__ void xpose_finish(const Frame& F, int l, int t0, int tstep, int n, const XRegs<NB>& X) {
    const int tid = F.tid, row4 = (tid >> 4) * 4, cq = (tid & 15) * 4;
    int t1 = t0; asm volatile("" : "+s"(t1));
#pragma unroll
    for (int b = 0; b < NB; ++b) if (b < n) { TDesc d; tile_desc(F, l, t1 + b * tstep, d); LAS unsigned char* L = F.lds + b * XP_SLOT;
        if (d.fp8) { const int sw = ((cq >> 2) & 7) << 4;
#pragma unroll
            for (int j = 0; j < 4; ++j) *(LAS unsigned*)(L + (cq + j) * 128 + (row4 ^ sw)) = (d.fp8 == 2) ? pack_i8x4(X.r[b][0][j] * d.qs, X.r[b][1][j] * d.qs, X.r[b][2][j] * d.qs, X.r[b][3][j] * d.qs) : pack_fp8x4(X.r[b][0][j] * W8_SCALE, X.r[b][1][j] * W8_SCALE, X.r[b][2][j] * W8_SCALE, X.r[b][3][j] * W8_SCALE);
        } else { const int sw = ((cq >> 2) & 15) << 4;
#pragma unroll
            for (int j = 0; j < 4; ++j) { u32x2 w; w.x = pack2(X.r[b][0][j], X.r[b][1][j]); w.y = pack2(X.r[b][2][j], X.r[b][3][j]); *(LAS u32x2*)(L + (cq + j) * 256 + ((row4 * 2) ^ sw)) = w; } } }
    __syncthreads();
    int t2 = t0; asm volatile("" : "+s"(t2));
#pragma unroll
    for (int b = 0; b < NB; ++b) if (b < n) { TDesc d; tile_desc(F, l, t2 + b * tstep, d); const LAS unsigned char* L = F.lds + b * XP_SLOT; const int c = tid >> 3, kq = tid & 7;
        if (d.fp8) *(u32x4*)(d.dp + (size_t)c * d.dldb + kq * 16) = *(const LAS u32x4*)(L + c * 128 + ((kq * 16) ^ (((c >> 2) & 7) << 4)));
        else { const int sw = ((c >> 2) & 15) << 4; *(u32x4*)(d.dp + (size_t)c * d.dldb + kq * 16) = *(const LAS u32x4*)(L + c * 256 + ((kq * 16) ^ sw)); *(u32x4*)(d.dp + (size_t)c * d.dldb + 128 + kq * 16) = *(const LAS u32x4*)(L + c * 256 + ((128 + kq * 16) ^ sw)); } }
    __syncthreads();
}
__device__ __forceinline__ void xpose_range(const Frame& F, int l, int tlo, int thi, int rank, int nranks) {
    constexpr int NB = 4; const int step = nranks * NB;
    XRegs<NB> A, B;
    int t = tlo + rank * NB; if (t >= thi) return;
#define XP_CNT(tt) (((thi) - (tt)) < NB ? ((thi) - (tt)) : NB)
    xpose_load<NB>(F, l, t, 1, XP_CNT(t), A);
    for (;;) {
        const int tb = t + step; const bool hb = tb < thi; if (hb) xpose_load<NB>(F, l, tb, 1, XP_CNT(tb), B);
        xpose_finish<NB>(F, l, t, 1, XP_CNT(t), A);
        if (!hb) break;
        const int ta = tb + step; const bool ha = ta < thi; if (ha) xpose_load<NB>(F, l, ta, 1, XP_CNT(ta), A);
        xpose_finish<NB>(F, l, tb, 1, XP_CNT(tb), B);
        if (!ha) break;
        t = ta;
    }
#undef XP_CNT
}
__device__ __forceinline__ void pool_fold(const Frame& F, int l, int rank, int nranks) {
    const KArgs a = F.ka; unsigned char* ws = F.ws_();
    for (size_t i = (size_t)rank * NTHR + F.tid; i < (size_t)W * D; i += (size_t)nranks * NTHR) {
        const int d = (int)(i % D), gc = (int)(i / D), g = gc >> 7;
        const float* pw = ((const float*)a->in[IN_POOLW]) + ((size_t)l * W + gc) * 128; const float* ps = ((const float*)a->in[IN_POOLS]) + l * W + g * 128;
        const float* wb = ((const float*)a->in[IN_WBR]) + ((size_t)l * 4 * W + g * 128) * D + d;
        float s = 0.f;
        for (int e = 0; e < 128; ++e) s += pw[e] * ps[e] * wb[(size_t)e * D];
        ((bf16_t*)(ws + WS_WB + l * SZ_DD))[(size_t)d * D + gc] = f2bf(s);
    }
}
__device__ __forceinline__ void phase_wabs(const Frame& F) {
    const KArgs a = F.ka; unsigned char* ws = F.ws_();
    for (int l = 0; l < DEPTH; ++l) { float m = 0.f; const float* w = ((const float*)a->in[IN_WIN]) + (size_t)l * D * PROJ_W;
        for (size_t i = (size_t)F.wg * NTHR + F.tid; i < (size_t)D * (NBR / 4); i += (size_t)F.nwg * NTHR) { const int c4 = (int)(i % (NBR / 4)), k = (int)(i / (NBR / 4)); const int col = c4 * 4 < 4096 ? c4 * 4 : c4 * 4 + 8;
            const f32x4 v = *(const f32x4*)(w + (size_t)k * PROJ_W + col); m = fmaxf(m, fmaxf(fmaxf(fabsf(v[0]), fabsf(v[1])), fmaxf(fabsf(v[2]), fabsf(v[3])))); }
        m = wave_max(m);
        if (F.lane == 0) __hip_atomic_fetch_max((unsigned*)(ws + WS_CTL) + CW_WABS + l, __float_as_uint(m), __ATOMIC_RELAXED, __HIP_MEMORY_SCOPE_AGENT); }
}
__device__ __forceinline__ void phase_prologue(const Frame& F) {
    const KArgs a = F.ka;
    unsigned char* ws = F.ws_();
    xpose_range(F, 0, 0, TK_WINA + TK_WINB, F.wg, F.nwg);
    const size_t gtid = (size_t)F.wg * NTHR + F.tid, gn = (size_t)F.nwg * NTHR;
    for (size_t i = gtid; i < (size_t)DEPTH * 8 * D; i += gn) { const int k = (int)(i % D), c = (int)((i / D) % 8), l = (int)(i / (8 * D));
        ((float*)(ws + WS_WIF))[i] = ((const float*)a->in[IN_WIN])[(size_t)l * D * PROJ_W + (size_t)k * PROJ_W + 4096 + c]; }
    for (size_t i = gtid; i < (size_t)DEPTH * NE * D; i += gn) { const int k = (int)(i % D), e = (int)((i / D) % NE), l = (int)(i / ((size_t)NE * D));
        const float w = ((const float*)a->in[IN_RW])[((size_t)l * D + k) * NE + e]; const bf16_t hi = f2bf(w); const bf16_t lo = f2bf(w - bf2f(hi));
        bf16_t* o = (bf16_t*)(ws + WS_RWT) + (size_t)l * 2 * NE * D; o[(size_t)e * D + k] = hi; o[(size_t)(NE + e) * D + k] = lo; }
    for (size_t i = gtid; i < (size_t)SEQ * 64; i += gn) { const int f = (int)(i & 63), s = (int)(i >> 6);
        const float inv = powf(10000.0f, -(float)f / 64.0f); const float ang = (float)s * inv;
        ((float*)(ws + WS_ROPE))[i] = cosf(ang); ((float*)(ws + WS_ROPE))[(size_t)SEQ * 64 + i] = sinf(ang); }
    for (int row = F.wg * 8 + F.wave; row < T; row += F.nwg * 8) { float v[32]; const float* xr = ((const float*)a->in[IN_X]) + (size_t)row * D;
#pragma unroll
        for (int j = 0; j < 4; ++j) { const f32x4 p = *(const f32x4*)(xr + j * 512 + F.lane * 8), q = *(const f32x4*)(xr + j * 512 + F.lane * 8 + 4); v[j * 8] = p[0]; v[j * 8 + 1] = p[1]; v[j * 8 + 2] = p[2]; v[j * 8 + 3] = p[3]; v[j * 8 + 4] = q[0]; v[j * 8 + 5] = q[1]; v[j * 8 + 6] = q[2]; v[j * 8 + 7] = q[3]; }
        st_row32((bf16_t*)(ws + WS_XB) + (size_t)row * D, F.lane, v); st_row32_fp8(ws + WS_XB8 + (size_t)row * D, F.lane, v); st_row32_i8(ws + WS_XQ8 + (size_t)row * D, (float*)(ws + WS_XSC) + row, F.lane, v); }
    for (size_t i = gtid; i < (size_t)TM * D / 4; i += gn) { const f32x4 v = ((const f32x4*)((const float*)a->in[IN_MEM]))[i]; st_bf16x4((bf16_t*)(ws + WS_MEMB) + i * 4, v); }
    __syncthreads();
}
__device__ __forceinline__ void prologue_deferred(const Frame& F, int rank, int nranks) {
    xpose_range(F, 0, TK_WINA + TK_WINB, TK_LAYER, rank, nranks);
    xpose_range(F, 1, 0, TK_LAYER, rank, nranks);
    pool_fold(F, 0, rank, nranks); pool_fold(F, 1, rank, nranks);
    __syncthreads();
}

__device__ __forceinline__ void unpack8(u32x4 w, float (&f)[8]) {
#pragma unroll
    for (int j = 0; j < 4; ++j) { f[2 * j] = __uint_as_float(w[j] << 16); f[2 * j + 1] = __uint_as_float(w[j] & 0xffff0000u); } }
__device__ __forceinline__ u32x4 pack8f(const float (&f)[8]) { u32x4 w;
#pragma unroll
    for (int j = 0; j < 4; ++j) w[j] = pack2(f[2 * j], f[2 * j + 1]); return w; }
template <int WIN> __device__ __forceinline__ void pool_block(const bf16_t* pu, bf16_t* out, int s0) {
    float sum[8];
#pragma unroll
    for (int e = 0; e < 8; ++e) sum[e] = 0.f;
    u32x4 hist[WIN - 1 + 8];
#pragma unroll
    for (int j = 0; j < WIN - 1 + 8; ++j) { const int ds = j - (WIN - 1); hist[j] = (s0 + ds >= 0) ? *(const u32x4*)(pu + (ptrdiff_t)ds * NBR) : (u32x4){0u, 0u, 0u, 0u}; }
#pragma unroll
    for (int j = 0; j < WIN - 1; ++j) { float f[8]; unpack8(hist[j], f);
#pragma unroll
        for (int e = 0; e < 8; ++e) sum[e] += f[e]; }
#pragma unroll
    for (int i = 0; i < 8; ++i) { float f[8]; unpack8(hist[WIN - 1 + i], f); const int cnt = (s0 + i + 1 < WIN) ? s0 + i + 1 : WIN; const float rc = 1.0f / (float)cnt; float o[8];
#pragma unroll
        for (int e = 0; e < 8; ++e) { sum[e] += f[e]; o[e] = sum[e] * rc - f[e]; }
        *(u32x4*)(out + (size_t)i * D) = pack8f(o);
        float fo[8]; unpack8(hist[i], fo);
#pragma unroll
        for (int e = 0; e < 8; ++e) sum[e] -= fo[e]; }
}
template <bool WITH_D = true> __device__ __forceinline__ void phase_mix1v2(const Frame& F, int l, const bf16_t* xcur) {
    const KArgs a = F.ka;
    unsigned char* ws = F.ws_();
    LAS float* dots = (LAS float*)(F.lds + 65536);
    LAS float* wl = (LAS float*)F.lds;
    const float* wif = (const float*)(ws + WS_WIF) + (size_t)l * 8 * D;
    const float* gb = ((const float*)a->in[IN_GATEB]) + l * 8;
    float* cumf = (float*)(ws + WS_CUMF); float* ipre = (float*)(ws + WS_IPRE); float* summ = (float*)(ws + WS_SUMM); float* av = (float*)(ws + WS_AV); float* pm = (float*)(ws + WS_PM);
    if (F.wg < BATCH * NCH) { for (int i = F.tid; i < 8 * D / 4; i += NTHR) *(LAS f32x4*)(wl + i * 4) = *(const f32x4*)(wif + i * 4); __syncthreads(); }
    for (int item = F.wg; item < BATCH * NCH; item += F.nwg) {
        const int b = item / NCH, c = item % NCH; const int t0 = b * SEQ + c * CH;
        for (int i = 0; i < 8; i += 2) {
            const int tok = F.wave * 8 + i; const bf16_t* xr = xcur + (size_t)(t0 + tok) * D;
            float d0[8], d1[8];
#pragma unroll
            for (int q = 0; q < 8; ++q) { d0[q] = 0.f; d1[q] = 0.f; }
#pragma unroll 1
            for (int j = 0; j < 4; ++j) { float x0[8], x1[8]; unpack8(*(const u32x4*)(xr + j * 512 + F.lane * 8), x0); unpack8(*(const u32x4*)(xr + D + j * 512 + F.lane * 8), x1);
#pragma unroll
                for (int q = 0; q < 8; ++q) { const f32x4 wa = *(const LAS f32x4*)(wl + q * D + j * 512 + F.lane * 8), wb = *(const LAS f32x4*)(wl + q * D + j * 512 + F.lane * 8 + 4);
#pragma unroll
                    for (int e = 0; e < 4; ++e) { d0[q] += x0[e] * wa[e] + x0[4 + e] * wb[e]; d1[q] += x1[e] * wa[e] + x1[4 + e] * wb[e]; } } }
#pragma unroll
            for (int q = 0; q < 8; ++q) { const float s0 = wave_sum(d0[q]), s1 = wave_sum(d1[q]); if (F.lane == 0) { dots[tok * 8 + q] = s0; dots[(tok + 1) * 8 + q] = s1; } }
        }
        __syncthreads();
        if (F.wave < NH) {
            const int h = F.wave, s = F.lane; const float ip = dots[s * 8 + h] + gb[h], fp = dots[s * 8 + 4 + h] + gb[4 + h];
            const float lf = fminf(fp, 0.f) - log1pf(__expf(-fabsf(fp)));
            float cs = lf;
#pragma unroll
            for (int o = 1; o < 64; o <<= 1) { const float n = __shfl_up(cs, o); if (s >= o) cs += n; }
            const float ftot = __shfl(cs, 63); const float aa = ip - cs;
            float px = aa;
#pragma unroll
            for (int o = 1; o < 64; o <<= 1) { const float n = __shfl_up(px, o); if (s >= o) px = fmaxf(px, n); }
            const float gm = ftot + __shfl(px, 63);
            const size_t o = (size_t)(b * NH + h) * SEQ + c * CH + s; cumf[o] = cs; ipre[o] = ip; av[o] = aa; pm[o] = px;
            if (s == 0) { summ[((size_t)(b * NH + h) * NCH + c) * 2] = ftot; summ[((size_t)(b * NH + h) * NCH + c) * 2 + 1] = gm; }
        }
        __syncthreads();
    }
    bf16_t* proj = (bf16_t*)(ws + WS_PROJ); bf16_t* br = (bf16_t*)(ws + WS_BR);
    for (int it = F.wg * 8 + F.wave; it < (T / 32) * 4; it += F.nwg * 8) {
        const int grp = it & 3, tbq = it >> 2; const int tb = tbq * 4 + (F.lane >> 4), co = grp * 16 + (F.lane & 15);
        const int t0 = tb * 8, s0 = t0 % SEQ; const bf16_t* pu = proj + (size_t)t0 * NBR + PC_U + co * 8; bf16_t* out = br + (size_t)t0 * D + co * 8;
        if (grp == 0) pool_block<2>(pu, out, s0); else if (grp == 1) pool_block<4>(pu, out, s0); else if (grp == 2) pool_block<8>(pu, out, s0); else pool_block<16>(pu, out, s0);
    }
    { const float* cw = ((const float*)a->in[IN_CONVW]) + (size_t)l * 3 * W;
      for (size_t it = (size_t)F.wg * NTHR + F.tid; it < (size_t)(T / 8) * 64; it += (size_t)F.nwg * NTHR) {
        const int co = (int)(it & 63), tb = (int)(it >> 6), t0 = tb * 8, s0 = t0 % SEQ;
        const bf16_t* pr = proj + (size_t)t0 * NBR + co * 8;
        float w0[8], w1[8], w2[8];
#pragma unroll
        for (int e = 0; e < 8; ++e) { w0[e] = cw[co * 8 + e]; w1[e] = cw[W + co * 8 + e]; w2[e] = cw[2 * W + co * 8 + e]; }
        float z1[8], z2[8];
#pragma unroll
        for (int e = 0; e < 8; ++e) { z1[e] = 0.f; z2[e] = 0.f; }
        if (s0 >= 2) { float c_[8], h_[8]; unpack8(*(const u32x4*)(pr + PC_CC - 2 * NBR), c_); unpack8(*(const u32x4*)(pr + PC_CH - 2 * NBR), h_);
#pragma unroll
            for (int e = 0; e < 8; ++e) z2[e] = c_[e] * h_[e]; }
        if (s0 >= 1) { float c_[8], h_[8]; unpack8(*(const u32x4*)(pr + PC_CC - NBR), c_); unpack8(*(const u32x4*)(pr + PC_CH - NBR), h_);
#pragma unroll
            for (int e = 0; e < 8; ++e) z1[e] = c_[e] * h_[e]; }
#pragma unroll
        for (int i = 0; i < 8; ++i) { float c_[8], h_[8], b_[8], o[8]; unpack8(*(const u32x4*)(pr + PC_CC + (size_t)i * NBR), c_); unpack8(*(const u32x4*)(pr + PC_CH + (size_t)i * NBR), h_); unpack8(*(const u32x4*)(pr + PC_CB + (size_t)i * NBR), b_);
#pragma unroll
            for (int e = 0; e < 8; ++e) { const float z0 = c_[e] * h_[e]; o[e] = b_[e] * (w0[e] * z0 + w1[e] * z1[e] + w2[e] * z2[e]); z2[e] = z1[e]; z1[e] = z0; }
            *(u32x4*)(br + (size_t)(t0 + i) * D + W + co * 8) = pack8f(o); }
      } }
    if constexpr (WITH_D) { const float* ropec = (const float*)(ws + WS_ROPE); const float* ropes = ropec + (size_t)SEQ * 64;
      for (size_t it = (size_t)F.wg * NTHR + F.tid; it < (size_t)T * 64; it += (size_t)F.nwg * NTHR) {
        const int oc = (int)(it & 7), hh = (int)((it >> 3) & 3), isk = (int)((it >> 5) & 1), t = (int)(it >> 6), s = t % SEQ;
        bf16_t* p = proj + (size_t)t * NBR + (isk ? PC_RK : PC_RQ) + hh * HD + oc * 8;
        float x1[8], x2[8], o1[8], o2[8]; unpack8(*(const u32x4*)p, x1); unpack8(*(const u32x4*)(p + 64), x2);
#pragma unroll
        for (int e = 0; e < 8; ++e) { const float cs = ropec[(size_t)s * 64 + oc * 8 + e], sn = ropes[(size_t)s * 64 + oc * 8 + e]; o1[e] = x1[e] * cs - x2[e] * sn; o2[e] = x1[e] * sn + x2[e] * cs; }
        *(u32x4*)p = pack8f(o1); *(u32x4*)(p + 64) = pack8f(o2);
      } }
}

__device__ __forceinline__ float ret_gamma_log2(int h) { return log2f(1.0f - exp2f(-5.0f - (float)h)); }

__device__ __forceinline__ void phase_scan_mfma(const Frame& F) {
    unsigned char* ws = F.ws_();
    constexpr int KS2 = 144, WS2 = 48;
    LAS bf16_t* Kb = (LAS bf16_t*)F.lds;
    LAS bf16_t* Wb = Kb + 2 * 64 * KS2;
    LAS float* mS = (LAS float*)(Wb + 2 * 64 * WS2);
    LAS float* fT = mS + 80;
    const bf16_t* proj = (const bf16_t*)(ws + WS_PROJ);
    const float* av = (const float*)(ws + WS_AV); const float* summ = (const float*)(ws + WS_SUMM);
    const int lane = F.lane, g = lane >> 4, li = lane & 15, w = F.wave, tid = F.tid;
    for (int item = F.wg; item < 2 * NBH * 8; item += F.nwg) {
        const int type = item >> 7, bh = (item >> 3) & 15, vs = item & 7, b = bh >> 2, h = bh & 3;
        if (tid == 0) { float m = 0.f; mS[0] = 0.f; for (int c = 0; c < NCH; ++c) { m = fmaxf(summ[((size_t)bh * NCH + c) * 2] + m, summ[((size_t)bh * NCH + c) * 2 + 1]); mS[c + 1] = m; }
            if (type == 0 && vs == 0) { float* ms = (float*)(ws + WS_MSEQ) + bh * 80; for (int c = 0; c <= NCH; ++c) ms[c] = mS[c]; } }
        if (tid >= 64 && tid < 128) fT[tid - 64] = summ[((size_t)bh * NCH + (tid - 64)) * 2];
        __syncthreads();
        const float lg2 = ret_gamma_log2(h);
        const int kcol = (type == 0 ? PC_MK : PC_RK) + h * HD, vcol = (type == 0 ? PC_MV : PC_RV) + h * HD + vs * 16;
        bf16_t* cst = (bf16_t*)(ws + WS_CST) + ((size_t)(type * NBH + bh) * NCH) * HD * HD;
        float* nsv = (float*)(ws + WS_NST) + (size_t)bh * NCH * HD;
        const int krow = tid >> 3, koct = tid & 7, vrow = (tid >> 1) & 63, vhalf = tid & 1;
        const bf16_t* kbase = proj + (size_t)(b * SEQ + krow) * NBR + kcol + koct * 8;
        const bf16_t* vbase = proj + (size_t)(b * SEQ + vrow) * NBR + vcol + vhalf * 8;
        const float* abase = av + (size_t)bh * SEQ + vrow;
        u32x4 kr[2][2], vr[2]; float ar[2];
#define SCAN_LOAD(c, sl) do { const size_t _o = (size_t)(c) * CH * NBR; kr[sl][0] = *(const u32x4*)(kbase + _o); kr[sl][1] = *(const u32x4*)(kbase + _o + 64); \
        if (tid < 128) { vr[sl] = *(const u32x4*)(vbase + _o); ar[sl] = (type == 0) ? abase[(c) * CH] : 0.f; } } while (0)
#define SCAN_WRITE(c, sl, bf) do { LAS bf16_t* _k = Kb + (bf) * 64 * KS2 + krow * KS2 + koct * 8; *(LAS u32x4*)_k = kr[sl][0]; *(LAS u32x4*)(_k + 64) = kr[sl][1]; \
        if (tid < 128) { const float _w = (type == 0) ? __expf(ar[sl] + fT[c] - mS[(c) + 1]) : exp2f((float)(63 - vrow) * lg2); float _f[8]; unpack8(vr[sl], _f); \
            _Pragma("unroll") for (int _e = 0; _e < 8; ++_e) _f[_e] *= _w; LAS bf16_t* _p = Wb + (bf) * 64 * WS2 + vrow * WS2; *(LAS u32x4*)(_p + vhalf * 8) = pack8f(_f); \
            u32x4 _x = {0u, 0u, 0u, 0u}; if (vhalf == 0) _x[0] = (unsigned)f2bf(_w); *(LAS u32x4*)(_p + 16 + vhalf * 8) = _x; } } while (0)
        f32x4 st = {0.f, 0.f, 0.f, 0.f}, na = {0.f, 0.f, 0.f, 0.f};
#define SCAN_BODY(c, bf) do { { u32x2 _pw; _pw.x = pack2(st[0], st[1]); _pw.y = pack2(st[2], st[3]); *(u32x2*)(cst + (size_t)(c) * HD * HD + (size_t)(vs * 16 + li) * HD + 16 * w + 4 * g) = _pw; } \
        if (type == 0 && vs == 0 && li == 0) *(f32x4*)(nsv + (c) * HD + 16 * w + 4 * g) = na; \
        const float _d = (type == 0) ? __expf(fT[c] + mS[c] - mS[(c) + 1]) : exp2f(64.0f * lg2); st *= _d; na *= _d; \
        _Pragma("unroll") for (int _u = 0; _u < 2; ++_u) { const LAS bf16_t* _kp = Kb + (bf) * 64 * KS2 + (32 * _u + 8 * g + (li >> 2)) * KS2 + 16 * w + 4 * (li & 3); \
            const LAS bf16_t* _wp = Wb + (bf) * 64 * WS2 + (32 * _u + 8 * g + (li >> 2)) * WS2 + 4 * (li & 3); \
            const bf16x8 _A = cat4(lds_tr(_kp), lds_tr(_kp + 4 * KS2)); const bf16x8 _B = cat4(lds_tr(_wp), lds_tr(_wp + 4 * WS2)); \
            st = __builtin_amdgcn_mfma_f32_16x16x32_bf16(_A, _B, st, 0, 0, 0); \
            if (type == 0) { const bf16x8 _B2 = cat4(lds_tr(_wp + 16), lds_tr(_wp + 4 * WS2 + 16)); na = __builtin_amdgcn_mfma_f32_16x16x32_bf16(_A, _B2, na, 0, 0, 0); } } } while (0)
        SCAN_LOAD(0, 0); SCAN_WRITE(0, 0, 0); SCAN_LOAD(1, 1); SCAN_LOAD(2, 0);
        __syncthreads();
        for (int c = 0; c < NCH; c += 2) {
            SCAN_BODY(c, 0);
            SCAN_WRITE(c + 1, 1, 1);
            if (c + 3 < NCH) SCAN_LOAD(c + 3, 1);
            __syncthreads();
            SCAN_BODY(c + 1, 1);
            if (c + 2 < NCH) { SCAN_WRITE(c + 2, 0, 0); }
            if (c + 4 < NCH) SCAN_LOAD(c + 4, 0);
            __syncthreads();
        }
#undef SCAN_LOAD
#undef SCAN_WRITE
#undef SCAN_BODY
    }
}

__device__ __forceinline__ void phase_chunk_mfma(const Frame& F, int l) {
    const KArgs a = F.ka; unsigned char* ws = F.ws_();
    constexpr int QS = 136, VS = 144, PS = 72;
    LAS bf16_t* Qs = (LAS bf16_t*)F.lds; LAS bf16_t* Ks = Qs + 64 * QS; LAS bf16_t* Vs = Ks + 64 * QS; LAS bf16_t* Ps = Vs + 64 * VS;
    LAS float* rv = (LAS float*)(Ps + 64 * PS);
    LAS float* hp = rv + 256;
    const bf16_t* proj = (const bf16_t*)(ws + WS_PROJ); bf16_t* br = (bf16_t*)(ws + WS_BR);
    const float* cumf = (const float*)(ws + WS_CUMF); const float* av = (const float*)(ws + WS_AV); const float* pm = (const float*)(ws + WS_PM); const float* mseq = (const float*)(ws + WS_MSEQ);
    const int lane = F.lane, g = lane >> 4, li = lane & 15, w = F.wave;
    bf16x8 ones;
#pragma unroll
    for (int j = 0; j < 8; ++j) ones[j] = (short)0x3F80;
    for (int item = F.wg; item < 2 * NBH * NCH; item += F.nwg) {
        const int type = item / (NBH * NCH), bh = (item / NCH) % NBH, c = item % NCH, b = bh >> 2, h = bh & 3;
        const int t0 = b * SEQ + c * CH; const size_t go = (size_t)bh * SEQ + c * CH;
        const int qcol = (type == 0 ? PC_MQ : PC_RQ) + h * HD, kcol = (type == 0 ? PC_MK : PC_RK) + h * HD, vcol = (type == 0 ? PC_MV : PC_RV) + h * HD;
        const float lg2 = ret_gamma_log2(h);
        { const int row = F.tid >> 3, oct = F.tid & 7; const bf16_t* pr = proj + (size_t)(t0 + row) * NBR + oct * 8;
          *(LAS u32x4*)(Qs + row * QS + oct * 8) = *(const u32x4*)(pr + qcol); *(LAS u32x4*)(Qs + row * QS + 64 + oct * 8) = *(const u32x4*)(pr + qcol + 64);
          *(LAS u32x4*)(Ks + row * QS + oct * 8) = *(const u32x4*)(pr + kcol); *(LAS u32x4*)(Ks + row * QS + 64 + oct * 8) = *(const u32x4*)(pr + kcol + 64);
          *(LAS u32x4*)(Vs + row * VS + oct * 8) = *(const u32x4*)(pr + vcol); *(LAS u32x4*)(Vs + row * VS + 64 + oct * 8) = *(const u32x4*)(pr + vcol + 64); }
        if (F.tid < 64) { const int t = F.tid;
            if (type == 0) { const float mp = mseq[bh * 80 + c]; const float bt = fmaxf(mp, pm[go + t]); rv[t] = av[go + t]; rv[64 + t] = bt; rv[128 + t] = __expf(mp - bt); rv[192 + t] = __expf(-cumf[go + t] - bt); }
            else rv[128 + t] = exp2f((float)(t + 1) * lg2); }
        __syncthreads();
        { const int tt = w >> 1, t = 16 * tt + li;
#pragma unroll
          for (int sti = 0; sti < 2; ++sti) { const int st = (w & 1) * 2 + sti; f32x4 acc = {0.f, 0.f, 0.f, 0.f};
            if (st <= tt) {
#pragma unroll
                for (int kk = 0; kk < 4; ++kk) { const bf16x8 kf = *(const LAS bf16x8*)(Ks + (16 * st + li) * QS + kk * 32 + g * 8), qf = *(const LAS bf16x8*)(Qs + (16 * tt + li) * QS + kk * 32 + g * 8);
                    acc = __builtin_amdgcn_mfma_f32_16x16x32_bf16(kf, qf, acc, 0, 0, 0); }
#pragma unroll
                for (int r = 0; r < 4; ++r) { const int sx = 16 * st + 4 * g + r; float wgt;
                    if (type == 0) wgt = __expf(rv[sx] - rv[64 + t]); else wgt = exp2f((float)(t - sx) * lg2);
                    acc[r] = (sx <= t) ? acc[r] * wgt : 0.f; } }
            u32x2 pw; pw.x = pack2(acc[0], acc[1]); pw.y = pack2(acc[2], acc[3]); *(LAS u32x2*)(Ps + t * PS + 16 * st + 4 * g) = pw; } }
        __syncthreads();
        f32x4 pv[4], qc[4], dn[4], qn[4];
#pragma unroll
        for (int tt = 0; tt < 4; ++tt) { pv[tt] = (f32x4){0.f, 0.f, 0.f, 0.f}; qc[tt] = pv[tt]; dn[tt] = pv[tt]; qn[tt] = pv[tt]; }
#pragma unroll
        for (int u = 0; u < 2; ++u) {
            const bf16x8 vf = cat4(lds_tr(Vs + (32 * u + 8 * g + (li >> 2)) * VS + 16 * w + 4 * (li & 3)), lds_tr(Vs + (32 * u + 8 * g + 4 + (li >> 2)) * VS + 16 * w + 4 * (li & 3)));
#pragma unroll
            for (int tt = 0; tt < 4; ++tt) { const bf16x8 pf = *(const LAS bf16x8*)(Ps + (16 * tt + li) * PS + 32 * u + 8 * g);
                pv[tt] = __builtin_amdgcn_mfma_f32_16x16x32_bf16(vf, pf, pv[tt], 0, 0, 0);
                if (type == 0) dn[tt] = __builtin_amdgcn_mfma_f32_16x16x32_bf16(ones, pf, dn[tt], 0, 0, 0); } }
        if (c > 0) {
            const bf16_t* cst = (const bf16_t*)(ws + WS_CST) + ((size_t)(type * NBH + bh) * NCH + c) * HD * HD;
            const float* nsv = (const float*)(ws + WS_NST) + ((size_t)bh * NCH + c) * HD;
#pragma unroll
            for (int kk = 0; kk < 4; ++kk) { const bf16x8 cf = *(const bf16x8*)(cst + (size_t)(16 * w + li) * HD + kk * 32 + g * 8);
                bf16x8 nf = ones;
                if (type == 0) { const f32x4 n0 = *(const f32x4*)(nsv + kk * 32 + g * 8), n1 = *(const f32x4*)(nsv + kk * 32 + g * 8 + 4); nf = pack8(n0, n1); }
#pragma unroll
                for (int tt = 0; tt < 4; ++tt) { const bf16x8 qf = *(const LAS bf16x8*)(Qs + (16 * tt + li) * QS + kk * 32 + g * 8);
                    qc[tt] = __builtin_amdgcn_mfma_f32_16x16x32_bf16(cf, qf, qc[tt], 0, 0, 0);
                    if (type == 0) qn[tt] = __builtin_amdgcn_mfma_f32_16x16x32_bf16(nf, qf, qn[tt], 0, 0, 0); } } }
        const int vc = h * HD + 16 * w + 4 * g;
#pragma unroll
        for (int tt = 0; tt < 4; ++tt) { const int t = 16 * tt + li; const float inter = rv[128 + t]; f32x4 hv;
            if (type == 0) { const float den = inter * qn[tt][0] + dn[tt][0]; const float rd = 1.0f / fmaxf(fabsf(den), rv[192 + t]);
                const u32x2 ow = *(const u32x2*)(proj + (size_t)(t0 + t) * NBR + PC_MO + vc);
                const float o0 = __uint_as_float(ow.x << 16), o1 = __uint_as_float(ow.x & 0xffff0000u), o2 = __uint_as_float(ow.y << 16), o3 = __uint_as_float(ow.y & 0xffff0000u);
                hv[0] = sigmoidf_(o0) * (inter * qc[tt][0] + pv[tt][0]) * rd; hv[1] = sigmoidf_(o1) * (inter * qc[tt][1] + pv[tt][1]) * rd;
                hv[2] = sigmoidf_(o2) * (inter * qc[tt][2] + pv[tt][2]) * rd; hv[3] = sigmoidf_(o3) * (inter * qc[tt][3] + pv[tt][3]) * rd; }
            else hv = pv[tt] + qc[tt] * inter;
            pv[tt] = hv;
            float s1 = (hv[0] + hv[1]) + (hv[2] + hv[3]), s2 = (hv[0] * hv[0] + hv[1] * hv[1]) + (hv[2] * hv[2] + hv[3] * hv[3]);
            s1 += __shfl_xor(s1, 16); s1 += __shfl_xor(s1, 32); s2 += __shfl_xor(s2, 16); s2 += __shfl_xor(s2, 32);
            if (g == 0) { hp[(w * 64 + t) * 2] = s1; hp[(w * 64 + t) * 2 + 1] = s2; } }
        __syncthreads();
        const float* nw = (type == 0 ? ((const float*)a->in[IN_MNORM]) : ((const float*)a->in[IN_RNORM])) + l * W + vc; const f32x4 nw4 = *(const f32x4*)nw;
#pragma unroll
        for (int tt = 0; tt < 4; ++tt) { const int t = 16 * tt + li; float s1 = 0.f, s2 = 0.f;
#pragma unroll
            for (int ww = 0; ww < 8; ++ww) { const f32x2 p2 = *(const LAS f32x2*)(hp + (ww * 64 + t) * 2); s1 += p2.x; s2 += p2.y; }
            const float mu = s1 * (1.0f / 128.0f), var = fmaxf(s2 * (1.0f / 128.0f) - mu * mu, 0.f), rstd = rsqrtf(var + LN_EPS);
            f32x4 y = (pv[tt] - mu) * rstd * nw4;
            if (type == 1) { const u32x2 gw = *(const u32x2*)(proj + (size_t)(t0 + t) * NBR + PC_RG + vc);
                const float g0 = __uint_as_float(gw.x << 16), g1 = __uint_as_float(gw.x & 0xffff0000u), g2 = __uint_as_float(gw.y << 16), g3 = __uint_as_float(gw.y & 0xffff0000u);
                y[0] *= g0 * sigmoidf_(g0); y[1] *= g1 * sigmoidf_(g1); y[2] *= g2 * sigmoidf_(g2); y[3] *= g3 * sigmoidf_(g3); }
            st_bf16x4(br + (size_t)(t0 + t) * D + (type == 0 ? 1024 : 1536) + vc, y); }
        __syncthreads();
    }
}

__device__ __forceinline__ void ln_row(float (&v)[32], const float* lw, const float* lb, int lane) {
    float s = 0.f;
#pragma unroll
    for (int j = 0; j < 32; ++j) s += v[j];
    const float mu = wave_sum(s) * (1.0f / D); float q = 0.f;
#pragma unroll
    for (int j = 0; j < 32; ++j) { const float d = v[j] - mu; q += d * d; }
    const float rstd = rsqrtf(wave_sum(q) * (1.0f / D) + LN_EPS);
#pragma unroll
    for (int j = 0; j < 4; ++j)
#pragma unroll
        for (int h = 0; h < 2; ++h) { const f32x4 w4 = *(const f32x4*)(lw + j * 512 + lane * 8 + h * 4), b4 = *(const f32x4*)(lb + j * 512 + lane * 8 + h * 4);
#pragma unroll
            for (int e = 0; e < 4; ++e) v[j * 8 + h * 4 + e] = (v[j * 8 + h * 4 + e] - mu) * rstd * w4[e] + b4[e]; }
}
__device__ __forceinline__ void phase_ln(const Frame& F, const bf16_t* y, const float* lw, const float* lb, bf16_t* xb) {
    for (int row = F.wg * 8 + F.wave; row < T; row += F.nwg * 8) {
        float v[32]; ld_row32(y + (size_t)row * D, F.lane, v);
        ln_row(v, lw, lb, F.lane);
        st_row32(xb + (size_t)row * D, F.lane, v);
    }
}
__device__ __forceinline__ void split8(f32x4 a, f32x4 b, bf16x8& hi, bf16x8& lo) {
    union { u32x4 u; bf16x8 h; } H, L;
#pragma unroll
    for (int j = 0; j < 2; ++j) { const bf16_t h0 = f2bf(a[2 * j]), h1 = f2bf(a[2 * j + 1]); H.u[j] = (unsigned)h0 | ((unsigned)h1 << 16); L.u[j] = pack2(a[2 * j] - bf2f(h0), a[2 * j + 1] - bf2f(h1)); }
#pragma unroll
    for (int j = 0; j < 2; ++j) { const bf16_t h0 = f2bf(b[2 * j]), h1 = f2bf(b[2 * j + 1]); H.u[2 + j] = (unsigned)h0 | ((unsigned)h1 << 16); L.u[2 + j] = pack2(b[2 * j] - bf2f(h0), b[2 * j + 1] - bf2f(h1)); }
    hi = H.h; lo = L.h; }
__device__ __forceinline__ void phase_ln_router(const Frame& F, int l, const bf16_t* y, bf16_t* xb) {
    const KArgs a = F.ka;
    unsigned char* ws = F.ws_();
    constexpr int XS = D + 4;
    LAS float* xs = (LAS float*)F.lds;
    LAS float* part = xs + 16 * XS;
    const float* lw = ((const float*)a->in[IN_LNW]) + ((size_t)l * 3 + 1) * D; const float* lb = ((const float*)a->in[IN_LNB]) + ((size_t)l * 3 + 1) * D;
    const bf16_t* rwt = (const bf16_t*)(ws + WS_RWT) + (size_t)l * 2 * NE * D; const float* rb = ((const float*)a->in[IN_RB]) + l * NE;
    unsigned* counts = (unsigned*)(ws + WS_CTL) + CW_COUNTS + l * 64;
    int* eid = (int*)(ws + WS_EID); float* ew = (float*)(ws + WS_EW); int* epos = (int*)(ws + WS_EPOS);
    const int lane = F.lane, g = lane >> 4, li = lane & 15, nt = F.wave & 3, kh = F.wave >> 2;
    for (int blk = F.wg; blk < T / 16; blk += F.nwg) {
        for (int rr = 0; rr < 2; ++rr) {
            const int lr = F.wave * 2 + rr, row = blk * 16 + lr;
            float v[32]; ld_row32(y + (size_t)row * D, F.lane, v);
            ln_row(v, lw, lb, F.lane);
            st_row32(xb + (size_t)row * D, F.lane, v); st_row32_fp8(ws + WS_XB8 + (size_t)row * D, F.lane, v);
#pragma unroll
            for (int j = 0; j < 4; ++j) { *(LAS f32x4*)(xs + lr * XS + j * 512 + F.lane * 8) = (f32x4){v[j * 8], v[j * 8 + 1], v[j * 8 + 2], v[j * 8 + 3]}; *(LAS f32x4*)(xs + lr * XS + j * 512 + F.lane * 8 + 4) = (f32x4){v[j * 8 + 4], v[j * 8 + 5], v[j * 8 + 6], v[j * 8 + 7]}; }
        }
        __syncthreads();
        { f32x4 acc = {0.f, 0.f, 0.f, 0.f};
          const bf16_t* wh = rwt + (size_t)(16 * nt + li) * D + kh * 1024 + g * 8; const bf16_t* wl = wh + (size_t)NE * D;
          const LAS float* xr = xs + li * XS + kh * 1024 + g * 8;
#pragma unroll 4
          for (int ks = 0; ks < 32; ++ks) { bf16x8 xh, xl; split8(*(const LAS f32x4*)(xr + ks * 32), *(const LAS f32x4*)(xr + ks * 32 + 4), xh, xl);
              const bf16x8 bh = *(const bf16x8*)(wh + ks * 32), bl = *(const bf16x8*)(wl + ks * 32);
              acc = __builtin_amdgcn_mfma_f32_16x16x32_bf16(xh, bh, acc, 0, 0, 0); acc = __builtin_amdgcn_mfma_f32_16x16x32_bf16(xh, bl, acc, 0, 0, 0); acc = __builtin_amdgcn_mfma_f32_16x16x32_bf16(xl, bh, acc, 0, 0, 0); }
#pragma unroll
          for (int r = 0; r < 4; ++r) part[(kh * 16 + 4 * g + r) * 64 + 16 * nt + li] = acc[r]; }
        __syncthreads();
        const int e = F.lane;
        const float bias = rb[e];
        for (int rr = 0; rr < 2; ++rr) {
            const int lr = F.wave * 2 + rr, row = blk * 16 + lr;
            const float sc = sigmoidf_(part[lr * 64 + e] + part[(16 + lr) * 64 + e]), bs = sc + bias;
            float m1 = bs; m1 = fmaxf(m1, __shfl_xor(m1, 1)); m1 = fmaxf(m1, __shfl_xor(m1, 2)); m1 = fmaxf(m1, __shfl_xor(m1, 4));
            const unsigned long long eq = __ballot(bs == m1); const int gq = e >> 3; const unsigned gm = (unsigned)(eq >> (gq * 8)) & 0xffu; const int first = gq * 8 + __builtin_ctz(gm);
            float m2 = (e == first) ? -INFINITY : bs; m2 = fmaxf(m2, __shfl_xor(m2, 1)); m2 = fmaxf(m2, __shfl_xor(m2, 2)); m2 = fmaxf(m2, __shfl_xor(m2, 4));
            const float gs = m1 + m2;
            int grank = 0;
#pragma unroll
            for (int g2 = 0; g2 < 8; ++g2) { const float o = __shfl(gs, g2 * 8); grank += (o > gs || (o == gs && g2 < gq)) ? 1 : 0; }
            const bool gsel = grank < 4;
            const float val = gsel ? bs : -INFINITY;
            int rank = 0;
            for (int e2 = 0; e2 < 64; ++e2) { const float o = __shfl(val, e2); rank += (o > val || (o == val && e2 < e)) ? 1 : 0; }
            const bool sel = gsel && rank < TOPK;
            const float wsum = wave_sum(sel ? sc : 0.f);
            const unsigned long long sm = __ballot(sel);
            if (sel) { const int k = __builtin_popcountll(sm & ((1ull << e) - 1ull));
                const unsigned pos = __hip_atomic_fetch_add(counts + e, 1u, __ATOMIC_RELAXED, __HIP_MEMORY_SCOPE_AGENT);
                eid[(size_t)row * 8 + k] = e; ew[(size_t)row * 8 + k] = sc / wsum * ROUTE_SCALE; epos[(size_t)row * 8 + k] = (int)pos; }
        }
        __syncthreads();
    }
}
__device__ __forceinline__ void build_pstart(const Frame& F, int l, LAS int* pst) {
    const unsigned* counts = (const unsigned*)(F.ws_() + WS_CTL) + CW_COUNTS + l * 64;
    if (F.tid < 64) {
        const int c = (int)__hip_atomic_load(counts + F.tid, __ATOMIC_RELAXED, __HIP_MEMORY_SCOPE_AGENT); const int pc = (c + 255) & ~255; int inc = pc;
#pragma unroll
        for (int o = 1; o < 64; o <<= 1) { const int n = __shfl_up(inc, o); if (F.tid >= o) inc += n; }
        pst[F.tid] = inc - pc; if (F.tid == 63) { pst[NE] = inc; pst[NE + 1] = inc + T; } }
    __syncthreads();
    { LAS unsigned char* texp = (LAS unsigned char*)(pst + 68);
      for (int rt = F.tid; rt < (pst[NE + 1] >> 8); rt += NTHR) { int e = 0; while (e < NE && pst[e + 1] <= rt * 256) ++e; texp[rt] = (unsigned char)e; } }
    __syncthreads();
}
__device__ __forceinline__ void phase_slots(const Frame& F, int l) {
    unsigned char* ws = F.ws_();
    LAS int* pst = (LAS int*)F.lds;
    build_pstart(F, l, pst);
    const unsigned* counts = (const unsigned*)(ws + WS_CTL) + CW_COUNTS + l * 64;
    const int* eid = (const int*)(ws + WS_EID); const float* ew = (const float*)(ws + WS_EW); const int* epos = (const int*)(ws + WS_EPOS);
    int* slotof = (int*)(ws + WS_SLOTOF); int* tok = (int*)(ws + WS_TOK); float* wsl = (float*)(ws + WS_WSL);
    const size_t gtid = (size_t)F.wg * NTHR + F.tid, gn = (size_t)F.nwg * NTHR;
    for (size_t i = gtid; i < (size_t)T * 8; i += gn) { const int e = eid[i]; const int slot = pst[e] + epos[i]; slotof[i] = slot; tok[slot] = (int)(i >> 3); wsl[slot] = ew[i]; }
    for (size_t i = gtid; i < (size_t)NE * 256; i += gn) { const int e = (int)(i >> 8), r = (int)(i & 255); const int c = (int)counts[e]; const int slot = pst[e] + c + r; if (slot < pst[e + 1]) { tok[slot] = 0; wsl[slot] = 0.f; } }
    for (size_t i = gtid; i < (size_t)T; i += gn) { tok[pst[NE] + i] = (int)i; wsl[pst[NE] + i] = 1.0f; }
    __syncthreads();
}
__device__ __forceinline__ void phase_combine_ln(const Frame& F, int l, bf16_t* xb, float* out) {
    const KArgs a = F.ka;
    unsigned char* ws = F.ws_();
    LAS int* pst = (LAS int*)F.lds;
    build_pstart(F, l, pst);
    const int sh0 = pst[NE];
    const int* slotof = (const int*)(ws + WS_SLOTOF); const unsigned char* yb = ws + WS_YB;
    const float* lw = ((const float*)a->in[IN_LNW]) + ((size_t)l * 3 + 2) * D; const float* lb = ((const float*)a->in[IN_LNB]) + ((size_t)l * 3 + 2) * D;
    for (int row = F.wg * 8 + F.wave; row < T; row += F.nwg * 8) {
        float v[32]; ld_row32(xb + (size_t)row * D, F.lane, v);
#pragma unroll
        for (int j = 0; j < 32; ++j) v[j] *= ALPHA;
        float ys[32];
#pragma unroll
        for (int j = 0; j < 32; ++j) ys[j] = 0.f;
#pragma unroll 3
        for (int k = 0; k < 9; ++k) { const int slot = k < 8 ? slotof[(size_t)row * 8 + k] : sh0 + row; const unsigned char* yr = yb + (size_t)slot * D;
#pragma unroll
            for (int j = 0; j < 4; ++j) { const u32x2 w = *(const u32x2*)(yr + j * 512 + F.lane * 8);
                const f32x2 p0 = __builtin_amdgcn_cvt_pk_f32_fp8((int)w.x, false), p1 = __builtin_amdgcn_cvt_pk_f32_fp8((int)w.x, true), p2 = __builtin_amdgcn_cvt_pk_f32_fp8((int)w.y, false), p3 = __builtin_amdgcn_cvt_pk_f32_fp8((int)w.y, true);
                ys[j * 8] += p0.x; ys[j * 8 + 1] += p0.y; ys[j * 8 + 2] += p1.x; ys[j * 8 + 3] += p1.y; ys[j * 8 + 4] += p2.x; ys[j * 8 + 5] += p2.y; ys[j * 8 + 6] += p3.x; ys[j * 8 + 7] += p3.y; } }
#pragma unroll
        for (int j = 0; j < 32; ++j) v[j] += ys[j] * (1.0f / Y8_SCALE);
        ln_row(v, lw, lb, F.lane);
        if (out) {
#pragma unroll
            for (int j = 0; j < 4; ++j) { *(f32x4*)(out + (size_t)row * D + j * 512 + F.lane * 8) = (f32x4){v[j * 8], v[j * 8 + 1], v[j * 8 + 2], v[j * 8 + 3]}; *(f32x4*)(out + (size_t)row * D + j * 512 + F.lane * 8 + 4) = (f32x4){v[j * 8 + 4], v[j * 8 + 5], v[j * 8 + 6], v[j * 8 + 7]}; }
        } else { st_row32(xb + (size_t)row * D, F.lane, v); st_row32_fp8(ws + WS_XB8 + (size_t)row * D, F.lane, v); st_row32_i8(ws + WS_XQ8 + (size_t)row * D, (float*)(ws + WS_XSC) + row, F.lane, v); }
    }
    __syncthreads();
}

__device__ __forceinline__ void phase_attn_mfma(const Frame& F, int l) {
    unsigned char* ws = F.ws_();
    constexpr int KS = 136, VS = 144;
    LAS bf16_t* Ks = (LAS bf16_t*)F.lds; LAS bf16_t* Vs = Ks + 256 * KS;
    const bf16_t* q = (const bf16_t*)(ws + WS_Q); const bf16_t* km = (const bf16_t*)(ws + WS_KM) + (size_t)l * TM * W; const bf16_t* vm = (const bf16_t*)(ws + WS_VM) + (size_t)l * TM * W;
    bf16_t* o = (bf16_t*)(ws + WS_O);
    const int nunit = (T / 128) * 4, upw = (nunit + F.nwg - 1) / F.nwg;
    const int lane = F.lane, g = lane >> 4, li = lane & 15;
    int loaded = -1;
    const int u_end = (F.wg + 1) * upw < nunit ? (F.wg + 1) * upw : nunit;
    for (int u = F.wg * upw; u < u_end; ++u) {
        const int bh = u >> 5, blk = u & 31, b = bh >> 2, hh = bh & 3;
        if (bh != loaded) {
            __syncthreads();
            const int m = F.tid >> 1, half = F.tid & 1;
            const bf16_t* kr = km + (size_t)(b * MEM + m) * W + hh * HD + half * 64; const bf16_t* vr = vm + (size_t)(b * MEM + m) * W + hh * HD + half * 64;
#pragma unroll
            for (int j = 0; j < 8; ++j) { *(LAS u32x4*)(Ks + m * KS + half * 64 + j * 8) = *(const u32x4*)(kr + j * 8); *(LAS u32x4*)(Vs + m * VS + half * 64 + j * 8) = *(const u32x4*)(vr + j * 8); }
            __syncthreads(); loaded = bh;
        }
        const int t0 = b * SEQ + blk * 128 + F.wave * 16;
        bf16x8 qf[4];
#pragma unroll
        for (int kk = 0; kk < 4; ++kk) qf[kk] = *(const bf16x8*)(q + (size_t)(t0 + li) * W + hh * HD + kk * 32 + g * 8);
        f32x4 sacc[16];
#pragma unroll
        for (int tt = 0; tt < 16; ++tt) { f32x4 acc = {0.f, 0.f, 0.f, 0.f};
#pragma unroll
            for (int kk = 0; kk < 4; ++kk) { const bf16x8 kf = *(const LAS bf16x8*)(Ks + (16 * tt + li) * KS + kk * 32 + g * 8); acc = __builtin_amdgcn_mfma_f32_16x16x32_bf16(kf, qf[kk], acc, 0, 0, 0); }
            sacc[tt] = acc; }
        float mx = -INFINITY;
#pragma unroll
        for (int tt = 0; tt < 16; ++tt) mx = fmaxf(mx, fmaxf(fmaxf(sacc[tt][0], sacc[tt][1]), fmaxf(sacc[tt][2], sacc[tt][3])));
        mx = fmaxf(mx, __shfl_xor(mx, 16)); mx = fmaxf(mx, __shfl_xor(mx, 32));
        const float c2 = 0.08838834764831845f * 1.4426950408889634f; float sum = 0.f;
#pragma unroll
        for (int tt = 0; tt < 16; ++tt)
#pragma unroll
            for (int r = 0; r < 4; ++r) { const float p = exp2f((sacc[tt][r] - mx) * c2); sacc[tt][r] = p; sum += p; }
        sum += __shfl_xor(sum, 16); sum += __shfl_xor(sum, 32);
        const float rs = 1.0f / sum;
        bf16x8 pk[8];
#pragma unroll
        for (int u8 = 0; u8 < 8; ++u8) pk[u8] = pack8(sacc[2 * u8], sacc[2 * u8 + 1]);
#pragma unroll
        for (int dvt = 0; dvt < 8; ++dvt) { f32x4 acc = {0.f, 0.f, 0.f, 0.f};
#pragma unroll
            for (int u8 = 0; u8 < 8; ++u8) { const s16x4 a0 = lds_tr(Vs + (32 * u8 + 4 * g + (li >> 2)) * VS + dvt * 16 + 4 * (li & 3)); const s16x4 a1 = lds_tr(Vs + (32 * u8 + 16 + 4 * g + (li >> 2)) * VS + dvt * 16 + 4 * (li & 3));
                acc = __builtin_amdgcn_mfma_f32_16x16x32_bf16(cat4(a0, a1), pk[u8], acc, 0, 0, 0); }
            st_bf16x4(o + (size_t)(t0 + li) * W + hh * HD + dvt * 16 + 4 * g, acc * rs); }
    }
    __syncthreads();
}

template <class Epi>
__device__ __forceinline__ void gemm_dense_mfma(const Frame& F, const bf16_t* A, const bf16_t* Bt, int M, int N, int K, const Epi& E) {
    DenseSched S; S.A = A; S.Bt = Bt; S.K = K; S.nM = M / 256; S.nN = N / 256; S.nwg = S.nM * S.nN; S.G = F.nwg; S.c = F.wg; S.i0 = 0; S.i1 = 1 << 30; S.pnoff = 0;
    gemm_phase_mfma(F, K, S, E);
}
constexpr int NPL = 15, NPHASE = 1 + DEPTH * NPL;
#ifndef NCONV
#define NCONV 40
#endif
#if MK_PER_PHASE
#define IN(k) (lo <= (k) && (k) < hi)
#define SEAM(k) do { if (IN((k) + 1)) { XcdBarrier b2_ = bar; asm volatile("" : "+s"(b2_.bar)); asm volatile("" : "+s"(b2_.x)); xcd_barrier(b2_); } } while (0)
#else
#define IN(k) true
#define SEAM(k) do { if ((k) + 1 < NPHASE) for (int rb_ = 0; rb_ < ((PROBE_DBL & 4096) ? 3 : 1); ++rb_) { XcdBarrier b2_ = bar; asm volatile("" : "+s"(b2_.bar)); asm volatile("" : "+s"(b2_.x)); xcd_barrier(b2_); } } while (0)
#endif
template <int l> __device__ __forceinline__ void run_layer(const Frame& F0, const XcdBarrier& bar, int lo, int hi) {
    const int pb = 1 + l * NPL;
    if (IN(pb + 0)) { const Frame F = fresh(F0); unsigned char* ws = F.ws_();
        EpiProj E{(bf16_t*)(ws + WS_PROJ), (bf16_t*)(ws + WS_GATES)};
        { DenseSched S; S.A = (const bf16_t*)(ws + WS_XQ8); S.Bt = (const bf16_t*)(ws + WS_WINQ + l * SZ_WINQ); S.K = D / 2; S.nM = T / 256; S.nN = NBR / 256; S.nwg = S.nM * S.nN; S.G = F.nwg; S.c = F.wg; S.i0 = 0; S.i1 = 1 << 30; S.pnoff = 0;
          const float wsc = __uint_as_float(((const unsigned*)(ws + WS_CTL))[CW_WABS + l]) * (1.0f / 127.0f);
          gemm_phase_mfma<EpiProj, DenseSched, 2>(F, D, S, E, wsc, (const float*)(ws + WS_XSC)); }
        { const Frame F2 = fresh(F0); unsigned char* ws2 = F2.ws_(); EpiProj E2{(bf16_t*)(ws2 + WS_PROJ), (bf16_t*)(ws2 + WS_GATES)};
          DenseSched S; S.A = (const bf16_t*)(ws2 + WS_XB8); S.Bt = (const bf16_t*)(ws2 + WS_WIN8 + l * SZ_WIN8 + (size_t)NBR * D); S.K = D / 2; S.nM = T / 256; S.nN = (NPROJ - NBR) / 256; S.nwg = S.nM * S.nN; S.G = F2.nwg; S.c = F2.wg; S.i0 = 0; S.i1 = 1 << 30; S.pnoff = NBR / 256;
          gemm_phase_mfma<EpiProj, DenseSched, 1>(F2, D, S, E2, 1.0f / (X8_SCALE * W8_SCALE)); if (PROBE_DBL & 64) gemm_phase_mfma<EpiProj, DenseSched, 1>(F2, D, S, E2, 1.0f / (X8_SCALE * W8_SCALE)); }
        SEAM(pb + 0); }
    if (IN(pb + 1)) { const Frame F = fresh(F0); phase_mix1v2(F, l, (const bf16_t*)(F.ws_() + WS_XB)); if (PROBE_DBL & 8192) { const Frame G = fresh(F0); phase_mix1v2<false>(G, l, (const bf16_t*)(G.ws_() + WS_XB)); } SEAM(pb + 1); }
    if (IN(pb + 2)) { const Frame F = fresh(F0); phase_scan_mfma(F); if (PROBE_DBL & 2) { const Frame G = fresh(F0); phase_scan_mfma(G); } SEAM(pb + 2); }
    if (IN(pb + 3)) { const Frame F = fresh(F0); phase_chunk_mfma(F, l); if (PROBE_DBL & 4) { const Frame G = fresh(F0); phase_chunk_mfma(G, l); } SEAM(pb + 3); }
    if (IN(pb + 4)) { const Frame F = fresh(F0); unsigned char* ws = F.ws_();
        EpiBranch E{(const bf16_t*)(ws + WS_GATES), (bf16_t*)(ws + WS_MRG)}; gemm_dense_mfma(F, (const bf16_t*)(ws + WS_BR), (const bf16_t*)(ws + WS_WB + l * SZ_DD), T, D, D, E); if (PROBE_DBL & 128) gemm_dense_mfma(F, (const bf16_t*)(ws + WS_BR), (const bf16_t*)(ws + WS_WB + l * SZ_DD), T, D, D, E); SEAM(pb + 4); }
    if (IN(pb + 5)) { const Frame F = fresh(F0); unsigned char* ws = F.ws_();
        EpiResid E{(const bf16_t*)(ws + WS_XB), (bf16_t*)(ws + WS_Y)}; gemm_dense_mfma(F, (const bf16_t*)(ws + WS_MRG), (const bf16_t*)(ws + WS_WOUT + l * SZ_DD), T, D, D, E); if (PROBE_DBL & 256) gemm_dense_mfma(F, (const bf16_t*)(ws + WS_MRG), (const bf16_t*)(ws + WS_WOUT + l * SZ_DD), T, D, D, E); SEAM(pb + 5); }
    if (IN(pb + 6)) { const Frame F = fresh(F0); unsigned char* ws = F.ws_();
        phase_ln(F, (const bf16_t*)(ws + WS_Y), ((const float*)F.ka->in[IN_LNW]) + (size_t)l * 3 * D, ((const float*)F.ka->in[IN_LNB]) + (size_t)l * 3 * D, (bf16_t*)(ws + WS_XB)); if (PROBE_DBL & 1) { const Frame G = fresh(F0); unsigned char* wsg = G.ws_(); phase_ln(G, (const bf16_t*)(wsg + WS_Y), ((const float*)G.ka->in[IN_LNW]) + (size_t)l * 3 * D, ((const float*)G.ka->in[IN_LNB]) + (size_t)l * 3 * D, (bf16_t*)(wsg + WS_XB)); } SEAM(pb + 6); }
    if (IN(pb + 7)) { const Frame F = fresh(F0);
        EpiQKV E{}; QkvSched S; S.ws = F.ws_(); S.l = l; S.G = F.nwg; S.c = F.wg; gemm_phase_mfma(F, D, S, E); if (PROBE_DBL & 1024) gemm_phase_mfma(F, D, S, E); SEAM(pb + 7); }
    if (IN(pb + 8)) { const Frame F = fresh(F0); phase_attn_mfma(F, l); if (PROBE_DBL & 8) { const Frame G = fresh(F0); phase_attn_mfma(G, l); } SEAM(pb + 8); }
    if (IN(pb + 9)) { const Frame F = fresh(F0); unsigned char* ws = F.ws_();
        EpiResid E{(const bf16_t*)(ws + WS_XB), (bf16_t*)(ws + WS_Y)}; gemm_dense_mfma(F, (const bf16_t*)(ws + WS_O), (const bf16_t*)(ws + WS_WO + l * SZ_WQ), T, D, W, E); if (PROBE_DBL & 2048) gemm_dense_mfma(F, (const bf16_t*)(ws + WS_O), (const bf16_t*)(ws + WS_WO + l * SZ_WQ), T, D, W, E); SEAM(pb + 9); }
    if (IN(pb + 10)) { const Frame F = fresh(F0); unsigned char* ws = F.ws_(); phase_ln_router(F, l, (const bf16_t*)(ws + WS_Y), (bf16_t*)(ws + WS_XB)); SEAM(pb + 10); }
    if (IN(pb + 11)) { const Frame F = fresh(F0); phase_slots(F, l); if (PROBE_DBL & 16) { const Frame G = fresh(F0); phase_slots(G, l); } SEAM(pb + 11); }
    if (IN(pb + 12)) { const Frame F = fresh(F0); unsigned char* ws = F.ws_();
        LAS int* pst = (LAS int*)(F.lds + LDS_BYTES - 1024); build_pstart(F, l, pst);
        const int nrt = pst[NE + 1] >> 8; EpiSwiglu E{(const float*)(ws + WS_WSL), ws + WS_HB};
        MoeSched<4, true> S; S.ws = ws; S.pst = pst; S.l = l; S.G = F.nwg; S.c = F.wg; S.nunits = nrt * 4; gemm_phase_mfma<EpiSwiglu, MoeSched<4, true>, 1>(F, D, S, E, 1.0f / (X8_SCALE * W8_SCALE)); SEAM(pb + 12); }
    if (IN(pb + 13)) { const Frame F = fresh(F0); unsigned char* ws = F.ws_();
        LAS int* pst = (LAS int*)(F.lds + LDS_BYTES - 1024); build_pstart(F, l, pst);
        const int nrt = pst[NE + 1] >> 8; EpiDown E{ws + WS_YB};
        MoeSched<8, false> S; S.ws = ws; S.pst = pst; S.l = l; S.G = F.nwg; S.c = F.wg; S.nunits = nrt * 8; gemm_phase_mfma<EpiDown, MoeSched<8, false>, 1>(F, ED, S, E, Y8_SCALE / (H8_SCALE * W8_SCALE)); SEAM(pb + 13); }
    if (IN(pb + 14)) { const Frame F = fresh(F0); phase_combine_ln(F, l, (bf16_t*)(F.ws_() + WS_XB), l == DEPTH - 1 ? ((float*)F.ka->out) : (float*)nullptr); if ((PROBE_DBL & 16384) && l == DEPTH - 1) { const Frame G = fresh(F0); phase_combine_ln(G, l, (bf16_t*)(G.ws_() + WS_XB), ((float*)G.ka->out)); } SEAM(pb + 14); }
}

__global__ void __launch_bounds__(NTHR, 2) fwd(Args args_unused) {
    extern __shared__ __attribute__((aligned(16))) unsigned char lds_raw[];
    Frame F0; F0.lds = (LAS unsigned char*)lds_raw; F0.tid = threadIdx.x; F0.lane = F0.tid & 63; F0.wave = __builtin_amdgcn_readfirstlane(F0.tid >> 6); F0.wg = blockIdx.x; F0.nwg = gridDim.x;
    F0.ka = (KArgs)__builtin_amdgcn_kernarg_segment_ptr(); F0.wsg = F0.ka->ws;
    volatile LAS unsigned* xbw = (volatile LAS unsigned*)(F0.lds + LDS_BYTES - 16);
    if (F0.tid == 0) { xbw[0] = 0u; xbw[1] = 0u; }
    __syncthreads();
    XcdBarrier bar; bar.bar = (unsigned*)(F0.ws_() + WS_CTL); bar.x = 0; bar.st = xbw;
#if MK_PER_PHASE
    const int lo = F0.ka->ph_lo, hi = F0.ka->ph_hi;
    if (hi - lo > 1) bar = xcd_barrier_post((unsigned*)(F0.ws_() + WS_CTL), xbw);
#else
    const int lo = 0, hi = NPHASE;
    bar = xcd_barrier_post((unsigned*)(F0.ws_() + WS_CTL), xbw);
#endif
    if (IN(0)) { { const Frame F = fresh(F0); phase_wabs(F); } { XcdBarrier b2_ = bar; asm volatile("" : "+s"(b2_.bar)); asm volatile("" : "+s"(b2_.x)); xcd_barrier(b2_); }
        const Frame F = fresh(F0); phase_prologue(F); { const Frame G = fresh(F0); prologue_deferred(G, G.wg, G.nwg); } SEAM(0); }
    run_layer<0>(F0, bar, lo, hi);
    run_layer<1>(F0, bar, lo, hi);
#undef IN
#undef SEAM
}

extern "C" void kernel_launch(void* const* d_in, const int* in_sizes, int n_in, void* d_out, int out_size, void* d_ws, size_t ws_size, hipStream_t stream) {
    static int grid = 0;
    if (grid == 0) {
        if (n_in != 23 || ws_size < WS_END) { fprintf(stderr, "kernel_launch: unexpected inputs (n_in %d, ws %zu < %zu)\n", n_in, ws_size, (size_t)WS_END); grid = -1; return; }
        int dev = 0, cus = 0, per_cu = 0;
        if (hipGetDevice(&dev) != hipSuccess || hipDeviceGetAttribute(&cus, hipDeviceAttributeMultiprocessorCount, dev) != hipSuccess) { grid = -1; return; }
        if (hipFuncSetAttribute((const void*)fwd, hipFuncAttributeMaxDynamicSharedMemorySize, LDS_BYTES) != hipSuccess) { fprintf(stderr, "kernel_launch: hipFuncSetAttribute failed\n"); grid = -1; return; }
        if (hipOccupancyMaxActiveBlocksPerMultiprocessor(&per_cu, (const void*)fwd, NTHR, LDS_BYTES) != hipSuccess || per_cu < 1) { fprintf(stderr, "kernel_launch: occupancy query says %d\n", per_cu); }
        (void)hipGetLastError();
        grid = cus;
    }
    if (grid < 0) return;
    (void)hipMemsetAsync((char*)d_ws + WS_CTL, 0, CTL_BYTES, stream);
    Args a{};
    for (int i = 0; i < 23; ++i) a.in[i] = (const float*)d_in[i];
    a.out = (float*)d_out; a.ws = (unsigned char*)d_ws;
#if MK_PER_PHASE
    for (int p = 0; p < NPHASE; ++p) { a.ph_lo = p; a.ph_hi = p + 1; hipLaunchKernelGGL(fwd, dim3(grid), dim3(NTHR), LDS_BYTES, stream, a); }
#else
    a.ph_lo = 0; a.ph_hi = NPHASE;
    hipLaunchKernelGGL(fwd, dim3(grid), dim3(NTHR), LDS_BYTES, stream, a);
#endif
    const hipError_t le = hipPeekAtLastError();
    if (le != hipSuccess) fprintf(stderr, "kernel_launch: launch failed: %s\n", hipGetErrorName(le));
}
```

```cpp
#include <hip/hip_runtime.h>
#include <cstdio>
#include <cstdint>

#ifndef PROBE_DBL
#define PROBE_DBL 0
#endif
#ifndef MK_PER_PHASE
#define MK_PER_PHASE 0
#endif

typedef unsigned short bf16_t;
typedef float f32x4 __attribute__((ext_vector_type(4)));
typedef float f32x2 __attribute__((ext_vector_type(2)));
typedef unsigned u32x4 __attribute__((ext_vector_type(4)));
typedef unsigned u32x2 __attribute__((ext_vector_type(2)));
#define LAS __attribute__((address_space(3)))

constexpr int BATCH = 4, SEQ = 4096, T = BATCH * SEQ, D = 2048, DEPTH = 2;
constexpr int W = 512, NH = 4, HD = 128, CH = 64, NCH = SEQ / CH, NBH = BATCH * NH;
constexpr int PROJ_W = 14344, NBR = 6144, NPROJ = 14336;
constexpr int MEM = 256, TM = BATCH * MEM;
constexpr int NE = 64, NEX = 65, TOPK = 8, ED = 512;
constexpr int NSLOT = 164096;
constexpr float LN_EPS = 1e-5f, ALPHA = 1.41421356237f, ROUTE_SCALE = 2.5f;
constexpr int NTHR = 512;

constexpr int PC_U = 0, PC_CH = 512, PC_CB = 1024, PC_CC = 1536, PC_MQ = 2048, PC_MK = 2560, PC_MV = 3072, PC_MO = 3584, PC_RQ = 4096, PC_RK = 4608, PC_RV = 5120, PC_RG = 5632;

constexpr size_t al256(size_t x) { return (x + 255) & ~(size_t)255; }
constexpr size_t WS_CTL = 0;
constexpr size_t CTL_BYTES = 65536;
constexpr int CW_COUNTS = 8192;
constexpr size_t WS_WIN = WS_CTL + CTL_BYTES;
constexpr size_t SZ_WIN = (size_t)NPROJ * D * 2;
constexpr size_t WS_WIF = WS_WIN + DEPTH * SZ_WIN;
constexpr size_t SZ_WIF = 8 * D * 4;
constexpr size_t WS_WB = WS_WIF + DEPTH * SZ_WIF;
constexpr size_t SZ_DD = (size_t)D * D * 2;
constexpr size_t WS_WOUT = WS_WB + DEPTH * SZ_DD;
constexpr size_t WS_WQ = WS_WOUT + DEPTH * SZ_DD;
constexpr size_t SZ_WQ = (size_t)W * D * 2;
constexpr size_t WS_WK = WS_WQ + DEPTH * SZ_WQ;
constexpr size_t WS_WV = WS_WK + DEPTH * SZ_WQ;
constexpr size_t WS_WO = WS_WV + DEPTH * SZ_WQ;
constexpr size_t WS_WGU = WS_WO + DEPTH * SZ_WQ;
constexpr size_t SZ_WGU1 = (size_t)1024 * D * 2;
constexpr size_t WS_WDN = WS_WGU + (size_t)DEPTH * NEX * SZ_WGU1;
constexpr size_t SZ_WDN1 = (size_t)D * ED * 2;
constexpr size_t WS_ROPE = WS_WDN + (size_t)DEPTH * NEX * SZ_WDN1;
constexpr size_t WS_X = WS_ROPE + (size_t)SEQ * 64 * 4 * 2;
constexpr size_t SZ_TD4 = (size_t)T * D * 4;
constexpr size_t WS_Y = WS_X + SZ_TD4;
constexpr size_t WS_XB = WS_Y + SZ_TD4;
constexpr size_t SZ_TD2 = (size_t)T * D * 2;
constexpr size_t WS_MEMB = WS_XB + SZ_TD2;
constexpr size_t WS_KM = WS_MEMB + (size_t)TM * D * 2;
constexpr size_t WS_VM = WS_KM + (size_t)DEPTH * TM * W * 2;
constexpr size_t WS_PROJ = WS_VM + (size_t)DEPTH * TM * W * 2;
constexpr size_t WS_GATES = WS_PROJ + (size_t)T * NBR * 2;
constexpr size_t WS_CUMF = WS_GATES + (size_t)T * 8192 * 2;
constexpr size_t WS_IPRE = WS_CUMF + (size_t)NBH * SEQ * 4;
constexpr size_t WS_SUMM = WS_IPRE + (size_t)NBH * SEQ * 4;
constexpr size_t WS_CST = WS_SUMM + al256((size_t)NBH * NCH * 2 * 4);
constexpr size_t WS_NST = WS_CST + (size_t)2 * NBH * NCH * HD * HD * 2;
constexpr size_t WS_BR = WS_NST + (size_t)NBH * NCH * HD * 4;
constexpr size_t WS_MRG = WS_BR + SZ_TD2;
constexpr size_t WS_Q = WS_MRG + SZ_TD2;
constexpr size_t WS_O = WS_Q + (size_t)T * W * 2;
constexpr size_t WS_EID = WS_O + (size_t)T * W * 2;
constexpr size_t WS_EW = WS_EID + (size_t)T * 8 * 4;
constexpr size_t WS_EPOS = WS_EW + (size_t)T * 8 * 4;
constexpr size_t WS_SLOTOF = WS_EPOS + (size_t)T * 8 * 4;
constexpr size_t WS_TOK = WS_SLOTOF + (size_t)T * 8 * 4;
constexpr size_t WS_WSL = WS_TOK + al256((size_t)NSLOT * 4);
constexpr size_t WS_HB = WS_WSL + al256((size_t)NSLOT * 4);
constexpr size_t WS_YB = WS_HB + (size_t)NSLOT * ED * 2;
constexpr size_t WS_AV = WS_YB + (size_t)NSLOT * D * 2;
constexpr size_t WS_PM = WS_AV + (size_t)NBH * SEQ * 4;
constexpr size_t WS_MSEQ = WS_PM + (size_t)NBH * SEQ * 4;
constexpr size_t WS_XB8 = WS_MSEQ + al256((size_t)NBH * 80 * 4);
constexpr size_t WS_WGU8 = WS_XB8 + (size_t)T * D;
constexpr size_t SZ_WGU8 = (size_t)1024 * D;
constexpr size_t WS_WIN8 = WS_WGU8 + (size_t)DEPTH * NEX * SZ_WGU8;
constexpr size_t SZ_WIN8 = (size_t)NPROJ * D;
constexpr size_t WS_RWT = WS_WIN8 + DEPTH * SZ_WIN8;
constexpr size_t WS_XQ8 = WS_RWT + (size_t)DEPTH * 2 * NE * D * 2;
constexpr size_t WS_XSC = WS_XQ8 + (size_t)T * D;
constexpr size_t WS_WINQ = WS_XSC + al256((size_t)T * 4);
constexpr size_t SZ_WINQ = (size_t)NBR * D;
constexpr size_t WS_END = WS_WINQ + DEPTH * SZ_WINQ;
constexpr int CW_WABS = 8320;
constexpr float X8_SCALE = 16.0f, W8_SCALE = 256.0f, H8_SCALE = 8.0f, Y8_SCALE = 64.0f;

constexpr int LDS_BYTES = 147456;

__device__ __forceinline__ bf16_t f2bf(float f) { unsigned u = __float_as_uint(f); u += 0x7FFFu + ((u >> 16) & 1u); return (bf16_t)(u >> 16); }
__device__ __forceinline__ float bf2f(bf16_t b) { return __uint_as_float(((unsigned)b) << 16); }
__device__ __forceinline__ unsigned pack2(float lo, float hi) { unsigned r; asm("v_cvt_pk_bf16_f32 %0, %1, %2" : "=v"(r) : "v"(lo), "v"(hi)); return r; }
__device__ __forceinline__ float sigmoidf_(float x) { return __builtin_amdgcn_rcpf(1.0f + __builtin_amdgcn_exp2f(-1.4426950408889634f * x)); }
__device__ __forceinline__ unsigned pack_fp8x4(float a, float b, float c, float d) {
    a = __builtin_amdgcn_fmed3f(a, -448.f, 448.f); b = __builtin_amdgcn_fmed3f(b, -448.f, 448.f); c = __builtin_amdgcn_fmed3f(c, -448.f, 448.f); d = __builtin_amdgcn_fmed3f(d, -448.f, 448.f);
    int w = 0; w = __builtin_amdgcn_cvt_pk_fp8_f32(a, b, w, false); w = __builtin_amdgcn_cvt_pk_fp8_f32(c, d, w, true); return (unsigned)w; }
__device__ __forceinline__ unsigned pack_i8x4(float a, float b, float c, float d) {
    const int ia = (int)__builtin_amdgcn_fmed3f(rintf(a), -127.f, 127.f), ib = (int)__builtin_amdgcn_fmed3f(rintf(b), -127.f, 127.f), ic = (int)__builtin_amdgcn_fmed3f(rintf(c), -127.f, 127.f), id = (int)__builtin_amdgcn_fmed3f(rintf(d), -127.f, 127.f);
    return (unsigned)(ia & 255) | ((unsigned)(ib & 255) << 8) | ((unsigned)(ic & 255) << 16) | ((unsigned)(id & 255) << 24); }
__device__ __forceinline__ unsigned pack_u8x4(float a, float b, float c, float d) {
    return (unsigned)rintf(a) | ((unsigned)rintf(b) << 8) | ((unsigned)rintf(c) << 16) | ((unsigned)rintf(d) << 24); }
__device__ __forceinline__ void un8u(u32x2 w, f32x4& a, f32x4& b) { a[0] = (float)(w.x & 255u); a[1] = (float)((w.x >> 8) & 255u); a[2] = (float)((w.x >> 16) & 255u); a[3] = (float)(w.x >> 24);
    b[0] = (float)(w.y & 255u); b[1] = (float)((w.y >> 8) & 255u); b[2] = (float)((w.y >> 16) & 255u); b[3] = (float)(w.y >> 24); }
__device__ __forceinline__ float wave_sum(float v) { for (int o = 32; o >= 1; o >>= 1) v += __shfl_xor(v, o); return v; }
__device__ __forceinline__ float wave_max(float v) { for (int o = 32; o >= 1; o >>= 1) v = fmaxf(v, __shfl_xor(v, o)); return v; }

#define XB_TMO      128
#define XB_XCNT(j)  (256  + 64 * (j))
#define XB_XSUB(j)  (1280 + 64 * (j))
#define XB_XGEN(j)  (2304 + 64 * (j))
#define XB_TOP      3328
#define XB_TOPGEN   3392
#define XCD_BAR_WORDS 3456
#define XB_SPIN_CAP (1u << 27)
__device__ __forceinline__ unsigned xb_ld(unsigned* p)              { return __hip_atomic_load(p, __ATOMIC_RELAXED, __HIP_MEMORY_SCOPE_AGENT); }
__device__ __forceinline__ unsigned xb_add(unsigned* p, unsigned v) { return __hip_atomic_fetch_add(p, v, __ATOMIC_RELAXED, __HIP_MEMORY_SCOPE_AGENT); }
__device__ __forceinline__ unsigned xb_xcc_id() { return (unsigned)__builtin_amdgcn_s_getreg((3 << 11) | 20) & 0xFu; }
#define XB_SPIN(cond, bar) do { unsigned _sp = 0; while (cond) { __builtin_amdgcn_s_sleep(1); \
    if ((++_sp & 255u) == 0u) { if (xb_ld(&(bar)[XB_TMO])) break; if (_sp > XB_SPIN_CAP) { atomicAdd(&(bar)[XB_TMO], 1u); break; } } } } while (0)
struct XcdBarrier { unsigned* bar; unsigned x; volatile LAS unsigned* st; };
__device__ __forceinline__ XcdBarrier xcd_barrier_post(unsigned* bar, volatile LAS unsigned* st) {
    XcdBarrier b; b.bar = bar; b.x = xb_xcc_id(); b.st = st;
    if (threadIdx.x == 0) (void)xb_add(&bar[XB_XCNT(b.x)], 1u);
    return b;
}
__device__ __forceinline__ void xcd_barrier_complete(unsigned* bar, unsigned x, unsigned& nloc, unsigned& nx) {
    const unsigned G = gridDim.x * gridDim.y * gridDim.z;
    unsigned sum, cnt, mine, sp = 0u;
    for (;;) {
        sum = 0u; cnt = 0u; mine = 0u;
#pragma unroll
        for (unsigned j = 0; j < 16; ++j) { const unsigned c = xb_ld(&bar[XB_XCNT(j)]); sum += c; cnt += (c > 0u) ? 1u : 0u; mine = (j == x) ? c : mine; }
        if (sum == G) break;
        __builtin_amdgcn_s_sleep(1);
        if ((++sp & 255u) == 0u) { if (xb_ld(&bar[XB_TMO])) break; if (sp > XB_SPIN_CAP) { atomicAdd(&bar[XB_TMO], 1u); break; } }
    }
    nloc = mine > 0u ? mine : 1u; nx = cnt > 0u ? cnt : 1u;
}
__device__ __forceinline__ void xcd_barrier(const XcdBarrier& b) {
    asm volatile("s_waitcnt vmcnt(0)" ::: "memory");
    __syncthreads();
    if (threadIdx.x == 0) {
        unsigned* bar = b.bar;
        __builtin_amdgcn_s_waitcnt(0);
        unsigned nloc = b.st[0], nx = b.st[1];
        if (nloc == 0u) { xcd_barrier_complete(bar, b.x, nloc, nx); b.st[0] = nloc; b.st[1] = nx; }
        const unsigned old = xb_add(&bar[XB_XSUB(b.x)], 1u);
        const unsigned gen = old / nloc;
        if (old + 1u == (gen + 1u) * nloc) {
            __builtin_amdgcn_fence(__ATOMIC_RELEASE, "agent");
            asm volatile("s_waitcnt vmcnt(0)" ::: "memory");
            const unsigned og = xb_add(&bar[XB_TOP], 1u);
            const unsigned tg = og / nx;
            if (og + 1u == (tg + 1u) * nx) xb_add(&bar[XB_TOPGEN], 1u);
            else XB_SPIN(xb_ld(&bar[XB_TOPGEN]) == tg, bar);
            __builtin_amdgcn_fence(__ATOMIC_ACQUIRE, "agent");
            xb_add(&bar[XB_XGEN(b.x)], 1u);
            asm volatile("s_waitcnt vmcnt(0)" ::: "memory");
        } else {
            XB_SPIN(xb_ld(&bar[XB_XGEN(b.x)]) == gen, bar);
            __builtin_amdgcn_fence(__ATOMIC_ACQUIRE, "agent");
            asm volatile("s_waitcnt vmcnt(0)" ::: "memory");
        }
    }
    __syncthreads();
}

struct Args { const float* in[23]; float* out; unsigned char* ws; int ph_lo, ph_hi; };
enum { IN_X = 0, IN_MEM, IN_WIN, IN_GATEB, IN_POOLW, IN_POOLS, IN_CONVW, IN_MNORM, IN_RNORM, IN_WBR, IN_WMIX, IN_WQ, IN_WK, IN_WV, IN_WO, IN_RW, IN_RB, IN_WGU, IN_WDN, IN_SGU, IN_SDN, IN_LNW, IN_LNB };

#define GAS __attribute__((address_space(1)))
struct DArgs { const GAS float* in[23]; GAS float* out; GAS unsigned char* ws; int ph_lo, ph_hi; };
typedef const __attribute__((address_space(4))) DArgs* KArgs;
struct Frame {
    LAS unsigned char* lds; int tid, lane, wave, wg, nwg;
    GAS unsigned char* wsg; KArgs ka;
    __device__ __forceinline__ unsigned char* ws_() const { return (unsigned char*)wsg; }
};
__device__ __forceinline__ Frame fresh(const Frame& F) { Frame G = F; asm volatile("" : "+s"(G.wsg)); asm volatile("" : "+s"(G.ka)); asm volatile("" : "+v"(G.tid)); asm volatile("" : "+s"(G.wg));
    G.lane = G.tid & 63; G.wave = __builtin_amdgcn_readfirstlane(G.tid >> 6); return G; }

struct GUnit {
    const bf16_t* Bt;
    const bf16_t* A;
    const int* gather;
    int row0;
    int pn;
    int e;
    bf16_t* dst;
};

__device__ __forceinline__ void un8(u32x4 w, f32x4& a, f32x4& b) { a[0] = __uint_as_float(w[0] << 16); a[1] = __uint_as_float(w[0] & 0xffff0000u); a[2] = __uint_as_float(w[1] << 16); a[3] = __uint_as_float(w[1] & 0xffff0000u);
    b[0] = __uint_as_float(w[2] << 16); b[1] = __uint_as_float(w[2] & 0xffff0000u); b[2] = __uint_as_float(w[3] << 16); b[3] = __uint_as_float(w[3] & 0xffff0000u); }
__device__ __forceinline__ void st_bf16x8(bf16_t* p, f32x4 a, f32x4 b) { u32x4 w; w[0] = pack2(a[0], a[1]); w[1] = pack2(a[2], a[3]); w[2] = pack2(b[0], b[1]); w[3] = pack2(b[2], b[3]); *(u32x4*)p = w; }
__device__ __forceinline__ void st_bf16x4(bf16_t* p, f32x4 v) { u32x2 w; w.x = pack2(v[0], v[1]); w.y = pack2(v[2], v[3]); *(u32x2*)p = w; }
__device__ __forceinline__ void ld_row32(const bf16_t* row, int lane, float (&v)[32]) {
#pragma unroll
    for (int j = 0; j < 4; ++j) { const u32x4 w = *(const u32x4*)(row + j * 512 + lane * 8);
#pragma unroll
        for (int e = 0; e < 4; ++e) { v[j * 8 + 2 * e] = __uint_as_float(w[e] << 16); v[j * 8 + 2 * e + 1] = __uint_as_float(w[e] & 0xffff0000u); } } }
__device__ __forceinline__ void st_row32(bf16_t* row, int lane, const float (&v)[32]) {
#pragma unroll
    for (int j = 0; j < 4; ++j) { u32x4 w;
#pragma unroll
        for (int e = 0; e < 4; ++e) w[e] = pack2(v[j * 8 + 2 * e], v[j * 8 + 2 * e + 1]);
        *(u32x4*)(row + j * 512 + lane * 8) = w; } }
__device__ __forceinline__ void st_row32_i8(unsigned char* row, float* sc, int lane, const float (&v)[32]) {
    float am = 0.f;
#pragma unroll
    for (int j = 0; j < 32; ++j) am = fmaxf(am, fabsf(v[j]));
    am = fmaxf(wave_max(am), 1e-30f); const float q = 127.0f / am;
#pragma unroll
    for (int j = 0; j < 4; ++j) { u32x2 w; w.x = pack_i8x4(v[j * 8] * q, v[j * 8 + 1] * q, v[j * 8 + 2] * q, v[j * 8 + 3] * q); w.y = pack_i8x4(v[j * 8 + 4] * q, v[j * 8 + 5] * q, v[j * 8 + 6] * q, v[j * 8 + 7] * q);
        *(u32x2*)(row + j * 512 + lane * 8) = w; }
    if (lane == 0) *sc = am * (1.0f / 127.0f); }
__device__ __forceinline__ void st_row32_fp8(unsigned char* row, int lane, const float (&v)[32]) {
#pragma unroll
    for (int j = 0; j < 4; ++j) { u32x2 w; w.x = pack_fp8x4(v[j * 8] * X8_SCALE, v[j * 8 + 1] * X8_SCALE, v[j * 8 + 2] * X8_SCALE, v[j * 8 + 3] * X8_SCALE); w.y = pack_fp8x4(v[j * 8 + 4] * X8_SCALE, v[j * 8 + 5] * X8_SCALE, v[j * 8 + 6] * X8_SCALE, v[j * 8 + 7] * X8_SCALE);
        *(u32x2*)(row + j * 512 + lane * 8) = w; } }
struct NoPre { };
struct EpiProj {
    static constexpr bool PAIR_M = false; static constexpr bool SEG = false; typedef NoPre Pre;
    bf16_t* proj; bf16_t* gates;
    static __device__ __forceinline__ float unit_scale(const GUnit& u) { return (u.pn == PC_MK / 256 || u.pn == PC_MK / 256 + 1 || u.pn == PC_RK / 256 || u.pn == PC_RK / 256 + 1) ? 0.08838834764831845f : 1.0f; }
    __device__ __forceinline__ void pre(const GUnit&, int, int, Pre&) const {}
    __device__ __forceinline__ void fin(const GUnit& u, int r, int c, const f32x4 (&a)[2][2], const Pre&) const {
        const int col = u.pn * 256 + c; const size_t row = (size_t)(u.row0 + r);
        if (col < NBR) { st_bf16x8(proj + row * NBR + col, a[0][0], a[0][1]); st_bf16x8(proj + row * NBR + col + 128, a[1][0], a[1][1]); }
        else { f32x4 s[2][2];
#pragma unroll
            for (int h = 0; h < 2; ++h)
#pragma unroll
                for (int n = 0; n < 2; ++n)
#pragma unroll
                    for (int j = 0; j < 4; ++j) s[h][n][j] = __builtin_amdgcn_fmed3f(sigmoidf_(a[h][n][j]) * 255.0f, 1.0f, 255.0f);
            u32x2 w0, w1; w0.x = pack_u8x4(s[0][0][0], s[0][0][1], s[0][0][2], s[0][0][3]); w0.y = pack_u8x4(s[0][1][0], s[0][1][1], s[0][1][2], s[0][1][3]);
            w1.x = pack_u8x4(s[1][0][0], s[1][0][1], s[1][0][2], s[1][0][3]); w1.y = pack_u8x4(s[1][1][0], s[1][1][1], s[1][1][2], s[1][1][3]);
            { const auto rx = __builtin_amdgcn_permlane32_swap(w0.x, w1.x, false, false); w0.x = rx[0]; w1.x = rx[1]; const auto ry = __builtin_amdgcn_permlane32_swap(w0.y, w1.y, false, false); w0.y = ry[0]; w1.y = ry[1]; }
            const bool up = (threadIdx.x & 32u) != 0u; const int gc = col - NBR;
            unsigned char* gp = (unsigned char*)gates + row * 8192 + (up ? gc + 128 - 8 : gc);
            u32x4 w; w[0] = w0.x; w[1] = w0.y; w[2] = w1.x; w[3] = w1.y; *(u32x4*)gp = w; }
    }
};
struct EpiBranch {
    static constexpr bool PAIR_M = false; static constexpr bool SEG = true;
    struct Pre { u32x2 g0, g1; };
    struct SPre { u32x2 a0, a1, b0, b1; };
    const unsigned char* gates; bf16_t* out;
    __device__ __forceinline__ void pre(const GUnit& u, int r, int c, Pre& p) const { const unsigned char* g = gates + (size_t)(u.row0 + r) * 8192 + 3 * 2048 + u.pn * 256 + c; p.g0 = *(const u32x2*)g; p.g1 = *(const u32x2*)(g + 128); }
    __device__ __forceinline__ void fin(const GUnit& u, int r, int c, const f32x4 (&a)[2][2], const Pre& p) const {
        f32x4 x0, x1, y0, y1; un8u(p.g0, x0, x1); un8u(p.g1, y0, y1); const float k = 1.0f / 255.0f;
        bf16_t* o = out + (size_t)(u.row0 + r) * D + u.pn * 256 + c; st_bf16x8(o, a[0][0] * x0 * k, a[0][1] * x1 * k); st_bf16x8(o + 128, a[1][0] * y0 * k, a[1][1] * y1 * k); }
    __device__ __forceinline__ void seg_pre(const GUnit& u, int r, int c, int s, SPre& p) const { const unsigned char* g = gates + (size_t)(u.row0 + r) * 8192 + s * 2048 + u.pn * 256 + c;
        p.a0 = *(const u32x2*)g; p.a1 = *(const u32x2*)(g + 128); p.b0 = *(const u32x2*)(g + 2048); p.b1 = *(const u32x2*)(g + 2048 + 128); }
    __device__ __forceinline__ void seg_fin(f32x4 (&h0)[2], f32x4 (&h1)[2], const SPre& p) const {
        f32x4 a0, a1, b0, b1; un8u(p.a0, a0, a1); un8u(p.b0, b0, b1);
#pragma unroll
        for (int j = 0; j < 4; ++j) { h0[0][j] *= a0[j] * __builtin_amdgcn_rcpf(b0[j]); h0[1][j] *= a1[j] * __builtin_amdgcn_rcpf(b1[j]); }
        un8u(p.a1, a0, a1); un8u(p.b1, b0, b1);
#pragma unroll
        for (int j = 0; j < 4; ++j) { h1[0][j] *= a0[j] * __builtin_amdgcn_rcpf(b0[j]); h1[1][j] *= a1[j] * __builtin_amdgcn_rcpf(b1[j]); }
    }
};
struct EpiResid {
    static constexpr bool PAIR_M = false; static constexpr bool SEG = false;
    struct Pre { u32x4 x0, x1; };
    const bf16_t* x; bf16_t* y;
    __device__ __forceinline__ void pre(const GUnit& u, int r, int c, Pre& p) const { const bf16_t* xp = x + (size_t)(u.row0 + r) * D + u.pn * 256 + c; p.x0 = *(const u32x4*)xp; p.x1 = *(const u32x4*)(xp + 128); }
    __device__ __forceinline__ void fin(const GUnit& u, int r, int c, const f32x4 (&a)[2][2], const Pre& p) const {
        f32x4 x0, x1, y0, y1; un8(p.x0, x0, x1); un8(p.x1, y0, y1);
        bf16_t* o = y + (size_t)(u.row0 + r) * D + u.pn * 256 + c; st_bf16x8(o, x0 * ALPHA + a[0][0], x1 * ALPHA + a[0][1]); st_bf16x8(o + 128, y0 * ALPHA + a[1][0], y1 * ALPHA + a[1][1]); }
};
struct EpiQKV {
    static constexpr bool PAIR_M = false; static constexpr bool SEG = false; typedef NoPre Pre; int pad_;
    __device__ __forceinline__ void pre(const GUnit&, int, int, Pre&) const {}
    __device__ __forceinline__ void fin(const GUnit& u, int r, int c, const f32x4 (&a)[2][2], const Pre&) const {
        bf16_t* o = u.dst + (size_t)(u.row0 + r) * W + u.pn * 256 + c; st_bf16x8(o, a[0][0], a[0][1]); st_bf16x8(o + 128, a[1][0], a[1][1]); }
};
struct EpiSwiglu {
    static constexpr bool SEG = false; static constexpr bool PAIR_M = true;
    struct Pre { float w; };
    const float* wsl; unsigned char* hb;
    __device__ __forceinline__ void pre(const GUnit& u, int r, int, Pre& p) const { p.w = wsl[u.row0 + r] * H8_SCALE; }
    __device__ __forceinline__ u32x2 act(const f32x4 (&a)[2][2], float w) const { f32x4 o[2];
#pragma unroll
        for (int n = 0; n < 2; ++n)
#pragma unroll
            for (int j = 0; j < 4; ++j) o[n][j] = a[0][n][j] * sigmoidf_(a[0][n][j]) * a[1][n][j] * w;
        u32x2 w8; w8.x = pack_fp8x4(o[0][0], o[0][1], o[0][2], o[0][3]); w8.y = pack_fp8x4(o[1][0], o[1][1], o[1][2], o[1][3]); return w8; }
    __device__ __forceinline__ void fin2(const GUnit& u, int r0, int r1, int c, const f32x4 (&a0)[2][2], const f32x4 (&a1)[2][2], const Pre& p0, const Pre& p1) const {
        u32x2 v0 = act(a0, p0.w), v1 = act(a1, p1.w);
        { const auto rx = __builtin_amdgcn_permlane32_swap(v0.x, v1.x, false, false); v0.x = rx[0]; v1.x = rx[1]; const auto ry = __builtin_amdgcn_permlane32_swap(v0.y, v1.y, false, false); v0.y = ry[0]; v1.y = ry[1]; }
        const bool up = (threadIdx.x & 32u) != 0u;
        unsigned char* o = hb + (size_t)(u.row0 + (up ? r1 : r0)) * ED + u.pn * 128 + (up ? c - 8 : c);
        u32x4 w; w[0] = v0.x; w[1] = v0.y; w[2] = v1.x; w[3] = v1.y; *(u32x4*)o = w; }
    __device__ __forceinline__ void fin(const GUnit&, int, int, const f32x4 (&)[2][2], const Pre&) const {}
};
struct EpiDown {
    static constexpr bool PAIR_M = false; static constexpr bool SEG = false; typedef NoPre Pre;
    unsigned char* yb;
    __device__ __forceinline__ void pre(const GUnit&, int, int, Pre&) const {}
    __device__ __forceinline__ void fin(const GUnit& u, int r, int c, const f32x4 (&a)[2][2], const Pre&) const {
        u32x2 w0, w1; w0.x = pack_fp8x4(a[0][0][0], a[0][0][1], a[0][0][2], a[0][0][3]); w0.y = pack_fp8x4(a[0][1][0], a[0][1][1], a[0][1][2], a[0][1][3]);
        w1.x = pack_fp8x4(a[1][0][0], a[1][0][1], a[1][0][2], a[1][0][3]); w1.y = pack_fp8x4(a[1][1][0], a[1][1][1], a[1][1][2], a[1][1][3]);
        { const auto rx = __builtin_amdgcn_permlane32_swap(w0.x, w1.x, false, false); w0.x = rx[0]; w1.x = rx[1]; const auto ry = __builtin_amdgcn_permlane32_swap(w0.y, w1.y, false, false); w0.y = ry[0]; w1.y = ry[1]; }
        const bool up = (threadIdx.x & 32u) != 0u;
        unsigned char* o = yb + (size_t)(u.row0 + r) * D + u.pn * 256 + (up ? 128 + c - 8 : c);
        u32x4 w; w[0] = w0.x; w[1] = w0.y; w[2] = w1.x; w[3] = w1.y; *(u32x4*)o = w; }
};

typedef short bf16x8 __attribute__((ext_vector_type(8)));
typedef short s16x4 __attribute__((ext_vector_type(4)));
__device__ __forceinline__ s16x4 lds_tr(const LAS bf16_t* p) { return __builtin_amdgcn_ds_read_tr16_b64_v4i16((LAS s16x4*)p); }
__device__ __forceinline__ bf16x8 cat4(s16x4 a, s16x4 b) { bf16x8 r; r[0] = a[0]; r[1] = a[1]; r[2] = a[2]; r[3] = a[3]; r[4] = b[0]; r[5] = b[1]; r[6] = b[2]; r[7] = b[3]; return r; }
__device__ __forceinline__ bf16x8 pack8(f32x4 a, f32x4 b) { union { u32x4 u; bf16x8 h; } c; c.u[0] = pack2(a[0], a[1]); c.u[1] = pack2(a[2], a[3]); c.u[2] = pack2(b[0], b[1]); c.u[3] = pack2(b[2], b[3]); return c.h; }
constexpr int BK = 64, HTB = 128 * BK * 2;
__device__ __forceinline__ int lds_byte(int r, int c) { const int st = (r >> 4) * 2 + (c >> 5), rr = r & 15, cc = c & 31, ob = rr * 64 + cc * 2; return st * 1024 + (ob ^ (((ob >> 9) & 1) << 5)); }
__device__ __forceinline__ void stage_rc(int b, int& R, int& C) { const int st = b / 1024, sb = b % 1024, swz = sb ^ (((sb >> 9) & 1) << 5); R = (st >> 1) * 16 + swz / 64; C = (st & 1) * 32 + (swz % 64) / 2; }

typedef int i32x8 __attribute__((ext_vector_type(8)));
typedef int i32x4 __attribute__((ext_vector_type(4)));
template <class Epi, class Sched, int MODE = 0>
__device__ __forceinline__ void gemm_phase_mfma(const Frame& F, const int K, const Sched& S, const Epi& E, const float oscale = 1.0f, const float* rowscale = nullptr) {
    constexpr bool FP8 = (MODE == 1), I8 = (MODE == 2);
    LAS unsigned char* lds = F.lds;
    const int tid = F.tid, wid = F.wave, lane = F.lane, wr = wid >> 2, wc = wid & 3, fr = lane & 15, fq = lane >> 4;
    const int KB = MODE ? K : 2 * K;
    const int nt = KB / 128;
    unsigned voffB[2];
#pragma unroll
    for (int i = 0; i < 2; ++i) { int R, C; stage_rc(tid * 16 + i * 8192, R, C); const int rho = R & 31, q4 = (rho & 15) >> 2, Rb = (R & ~31) + 8 * (((q4 & 1) << 1) | (q4 >> 1)) + 4 * (rho >> 4) + (rho & 3); voffB[i] = (unsigned)(Rb * KB + C * 2); }
    const size_t kstep = (size_t)(BK * 2);
    const size_t hstepB = (size_t)128 * KB;
    const unsigned ldsw = (unsigned)wid * 1024u;
    const int aoff = FP8 ? lds_byte(wr * 64 + fr, fq * 16) : lds_byte(wr * 64 + fr, fq * 8), boff = FP8 ? lds_byte(wc * 32 + fr, fq * 16) : lds_byte(wc * 32 + fr, fq * 8);
#define SA_(b, h) (((b) * 2 + (h)) * HTB)
#define SB_(b, h) ((4 + (b) * 2 + (h)) * HTB)
#define STAGE_(bufoff, gbase, voff) do { _Pragma("unroll") for (int _i = 0; _i < 2; ++_i) \
        __builtin_amdgcn_global_load_lds((const unsigned*)((const char*)(gbase) + (voff)[_i]), (LAS unsigned*)(lds + (bufoff) + ldsw + _i * 8192), 16, 0, 0); } while (0)
#define LDA_(dst, b, h) do { _Pragma("unroll") for (int m = 0; m < 4; ++m) { if constexpr (FP8) { const i32x4 _lo = *(const LAS i32x4*)(lds + SA_(b, h) + aoff + m * 2048), _hi = *(const LAS i32x4*)(lds + SA_(b, h) + aoff + m * 2048 + 16); \
            dst##8[m] = __builtin_shufflevector(_lo, _hi, 0, 1, 2, 3, 4, 5, 6, 7); } \
        else { _Pragma("unroll") for (int k = 0; k < 2; ++k) dst[m][k] = *(const LAS bf16x8*)(lds + SA_(b, h) + aoff + m * 2048 + k * 1024); } } } while (0)
#define LDB_(dst, b, h) do { _Pragma("unroll") for (int n = 0; n < 2; ++n) { if constexpr (FP8) { const i32x4 _lo = *(const LAS i32x4*)(lds + SB_(b, h) + boff + n * 2048), _hi = *(const LAS i32x4*)(lds + SB_(b, h) + boff + n * 2048 + 16); \
            dst##8[n] = __builtin_shufflevector(_lo, _hi, 0, 1, 2, 3, 4, 5, 6, 7); } \
        else { _Pragma("unroll") for (int k = 0; k < 2; ++k) dst[n][k] = *(const LAS bf16x8*)(lds + SB_(b, h) + boff + n * 2048 + k * 1024); } } } while (0)
#define MMA_(ai, bj, At, Bt) do { __builtin_amdgcn_s_setprio(1); _Pragma("unroll") for (int m = 0; m < 4; ++m) _Pragma("unroll") for (int n = 0; n < 2; ++n) { \
        if constexpr (FP8) asm volatile("v_mfma_scale_f32_16x16x128_f8f6f4 %0, %1, %2, %0, %3, %3 op_sel_hi:[0,0,0]" : "+v"(acc[ai][bj][m][n]) : "v"(Bt##8[n]), "v"(At##8[m]), "v"(sc8)); \
        else if constexpr (I8) { _Pragma("unroll") for (int k = 0; k < 2; ++k) acci[ai][bj][m][n] = __builtin_amdgcn_mfma_i32_16x16x64_i8(__builtin_bit_cast(i32x4, Bt[n][k]), __builtin_bit_cast(i32x4, At[m][k]), acci[ai][bj][m][n], 0, 0, 0); } \
        else { _Pragma("unroll") for (int k = 0; k < 2; ++k) acc[ai][bj][m][n] = __builtin_amdgcn_mfma_f32_16x16x32_bf16(Bt[n][k], At[m][k], acc[ai][bj][m][n], 0, 0, 0); } } \
        __builtin_amdgcn_s_setprio(0); } while (0)
#define WAIT_V_(n) asm volatile("s_waitcnt vmcnt(" #n ")" ::: "memory")
#define WAIT_L_(n) asm volatile("s_waitcnt lgkmcnt(" #n ")" ::: "memory")
#define BAR_ __builtin_amdgcn_s_barrier()
#define SCHED_ __builtin_amdgcn_sched_barrier(0)
#define VOFFS_(dst, u) do { int _tz = tid; asm volatile("" : "+v"(_tz)); _Pragma("unroll") for (int _i = 0; _i < 2; ++_i) { int _R, _C; stage_rc(_tz * 16 + _i * 8192, _R, _C); \
        _Pragma("unroll") for (int _h = 0; _h < 2; ++_h) { const int _r = _h * 128 + _R; \
        const unsigned _row = (u).gather ? (unsigned)(u).gather[_r] : (unsigned)((u).row0 + _r); dst[_h][_i] = _row * (unsigned)KB + (unsigned)_C * 2u; } } } while (0)
    GUnit cur, nxt; int ui = 0;
    if (!S.get(0, cur)) return;
    f32x4 acc[2][2][4][2]; i32x4 acci[2][2][4][2];
#pragma unroll
    for (int a = 0; a < 2; ++a)
#pragma unroll
        for (int b = 0; b < 2; ++b)
#pragma unroll
            for (int m = 0; m < 4; ++m)
#pragma unroll
                for (int n = 0; n < 2; ++n) { acc[a][b][m][n] = (f32x4){0.f, 0.f, 0.f, 0.f}; acci[a][b][m][n] = (i32x4){0, 0, 0, 0}; }
    bf16x8 At[4][2], B0[2][2], B1[2][2]; i32x8 At8[4], B08[2], B18[2];
    int sc8 = 0x7f7f7f7f; asm volatile("" : "+v"(sc8));
    unsigned vA[2][2], vN[2][2];
    VOFFS_(vA, cur);
    const char* cA = (const char*)cur.A; const char* cB = (const char*)cur.Bt;
    STAGE_(SB_(0, 0), cB, voffB); STAGE_(SA_(0, 0), cA, vA[0]); STAGE_(SB_(0, 1), cB + hstepB, voffB); STAGE_(SA_(0, 1), cA, vA[1]);
    if (wr == 1) BAR_;
    WAIT_V_(4); BAR_;
    STAGE_(SB_(1, 0), cB + kstep, voffB); STAGE_(SA_(1, 0), cA + kstep, vA[0]); STAGE_(SB_(1, 1), cB + hstepB + kstep, voffB);
    WAIT_V_(6); BAR_;
    for (;;) {
        const bool has_next = S.get(ui + 1, nxt);
        const char* nA = has_next ? (const char*)nxt.A : cA; const char* nB = has_next ? (const char*)nxt.Bt : cB;
        if (has_next) { VOFFS_(vN, nxt); }
        for (int t = 0; t < nt; t += 2) {
            const bool last = (t == nt - 2);
            if constexpr (Epi::SEG) { if (t > 0 && (t & 7) == 0) {
                int tz = tid; asm volatile("" : "+v"(tz)); const int er = ((tz >> 8) & 1) * 64 + (tz & 15), ec = ((tz >> 6) & 3) * 32 + ((((tz >> 4) & 1) << 1) | ((tz >> 5) & 1)) * 8;
#pragma unroll
                for (int ai = 0; ai < 2; ++ai) { typename Epi::SPre sp[4];
#pragma unroll
                    for (int m = 0; m < 4; ++m) E.seg_pre(cur, ai * 128 + m * 16 + er, ec, (t >> 3) - 1, sp[m]);
#pragma unroll
                    for (int m = 0; m < 4; ++m) E.seg_fin(acc[ai][0][m], acc[ai][1][m], sp[m]);
                    asm volatile("" ::: "memory"); }
            } }
            const char* a1 = cA + (size_t)(t + 1) * kstep;
            const char* a2 = last ? nA : cA + (size_t)(t + 2) * kstep; const char* b2 = last ? nB : cB + (size_t)(t + 2) * kstep;
            const char* a3 = a2 + kstep; const char* b3 = b2 + kstep;
            unsigned w0[2], w1[2];
#pragma unroll
            for (int i = 0; i < 2; ++i) { w0[i] = (last && has_next) ? vN[0][i] : vA[0][i]; w1[i] = (last && has_next) ? vN[1][i] : vA[1][i]; }
            LDB_(B0, 0, 0); SCHED_; LDA_(At, 0, 0); STAGE_(SA_(1, 1), a1, vA[1]);
            WAIT_L_(8); BAR_; WAIT_L_(0); MMA_(0, 0, At, B0); BAR_; SCHED_;
            LDB_(B1, 0, 1); STAGE_(SB_(0, 0), b2, voffB);
            BAR_; WAIT_L_(0); MMA_(0, 1, At, B1); BAR_;
            LDA_(At, 0, 1); STAGE_(SA_(0, 0), a2, w0);
            BAR_; WAIT_L_(0); MMA_(1, 0, At, B0); BAR_; SCHED_;
            STAGE_(SB_(0, 1), b2 + hstepB, voffB);
            WAIT_V_(6); BAR_; MMA_(1, 1, At, B1); BAR_;
            LDB_(B0, 1, 0); SCHED_; LDA_(At, 1, 0); STAGE_(SA_(0, 1), a2, w1);
            WAIT_L_(8); BAR_; WAIT_L_(0); MMA_(0, 0, At, B0); BAR_; SCHED_;
            LDB_(B1, 1, 1); STAGE_(SB_(1, 0), b3, voffB);
            BAR_; WAIT_L_(0); MMA_(0, 1, At, B1); BAR_;
            LDA_(At, 1, 1); STAGE_(SA_(1, 0), a3, w0);
            BAR_; WAIT_L_(0); MMA_(1, 0, At, B0); BAR_; SCHED_;
            STAGE_(SB_(1, 1), b3 + hstepB, voffB);
            WAIT_V_(6); BAR_; MMA_(1, 1, At, B1); BAR_;
        }
        { int tz = tid; asm volatile("" : "+v"(tz)); const int er = ((tz >> 8) & 1) * 64 + (tz & 15), ec = ((tz >> 6) & 3) * 32 + ((((tz >> 4) & 1) << 1) | ((tz >> 5) & 1)) * 8;
          typename Epi::Pre pre[2][4];
#pragma unroll
          for (int ai = 0; ai < 2; ++ai)
#pragma unroll
              for (int m = 0; m < 4; ++m) E.pre(cur, ai * 128 + m * 16 + er, ec, pre[ai][m]);
          if constexpr (I8) {
#pragma unroll
              for (int ai = 0; ai < 2; ++ai)
#pragma unroll
                  for (int m = 0; m < 4; ++m) { const float rs = rowscale[cur.row0 + ai * 128 + m * 16 + er] * oscale * Epi::unit_scale(cur);
#pragma unroll
                      for (int bj = 0; bj < 2; ++bj)
#pragma unroll
                          for (int n = 0; n < 2; ++n)
#pragma unroll
                              for (int j = 0; j < 4; ++j) acc[ai][bj][m][n][j] = (float)acci[ai][bj][m][n][j] * rs; } }
          if constexpr (FP8) {
#pragma unroll
              for (int ai = 0; ai < 2; ++ai)
#pragma unroll
                  for (int bj = 0; bj < 2; ++bj)
#pragma unroll
                      for (int m = 0; m < 4; ++m)
#pragma unroll
                          for (int n = 0; n < 2; ++n) acc[ai][bj][m][n] *= oscale; }
          if constexpr (Epi::PAIR_M) {
#pragma unroll
          for (int ai = 0; ai < 2; ++ai)
#pragma unroll
              for (int m = 0; m < 4; m += 2) { const f32x4 a4[2][2] = {{acc[ai][0][m][0], acc[ai][0][m][1]}, {acc[ai][1][m][0], acc[ai][1][m][1]}}; const f32x4 b4[2][2] = {{acc[ai][0][m + 1][0], acc[ai][0][m + 1][1]}, {acc[ai][1][m + 1][0], acc[ai][1][m + 1][1]}};
                  E.fin2(cur, ai * 128 + m * 16 + er, ai * 128 + (m + 1) * 16 + er, ec, a4, b4, pre[ai][m], pre[ai][m + 1]); }
          } else {
#pragma unroll
          for (int ai = 0; ai < 2; ++ai)
#pragma unroll
              for (int m = 0; m < 4; ++m) { const f32x4 a4[2][2] = {{acc[ai][0][m][0], acc[ai][0][m][1]}, {acc[ai][1][m][0], acc[ai][1][m][1]}}; E.fin(cur, ai * 128 + m * 16 + er, ec, a4, pre[ai][m]); } } }
        if (!has_next) break;
#pragma unroll
        for (int a = 0; a < 2; ++a)
#pragma unroll
            for (int b = 0; b < 2; ++b)
#pragma unroll
                for (int m = 0; m < 4; ++m)
#pragma unroll
                    for (int n = 0; n < 2; ++n) { acc[a][b][m][n] = (f32x4){0.f, 0.f, 0.f, 0.f}; acci[a][b][m][n] = (i32x4){0, 0, 0, 0}; }
        cur = nxt; cA = nA; cB = nB; ++ui;
#pragma unroll
        for (int h = 0; h < 2; ++h)
#pragma unroll
            for (int i = 0; i < 2; ++i) vA[h][i] = vN[h][i];
    }
    WAIT_V_(0);
    if (wr == 0) BAR_;
    BAR_;
#undef SA_
#undef SB_
#undef STAGE_
#undef LDA_
#undef LDB_
#undef MMA_
#undef WAIT_V_
#undef WAIT_L_
#undef BAR_
#undef SCHED_
#undef VOFFS_
}

struct DenseSched {
    const bf16_t* A; const bf16_t* Bt; int K, nM, nN, nwg, G, c, i0, i1, split, pnoff;
    __device__ __forceinline__ void segment(int sg) { i0 = sg == 0 ? 0 : split; i1 = sg == 0 ? split : (1 << 30); }
    __device__ __forceinline__ bool get(int ii, GUnit& u) const {
        const int i = ii + i0; if (i >= i1) return false;
        const long L = (long)i * G + c; if (L >= nwg) return false;
        int wgid = (int)L; { const int q = nwg / 8, r = nwg % 8, xcd = wgid % 8, off = wgid / 8; wgid = (xcd < r ? xcd * (q + 1) : r * (q + 1) + (xcd - r) * q) + off; }
        const int nig = 8 * nN, gid = wgid / nig, fm = gid * 8, gsz = (nM - fm) < 8 ? (nM - fm) : 8;
        const int pm = fm + ((wgid % nig) % gsz), pn = (wgid % nig) / gsz;
        u.pn = pn + pnoff; u.row0 = pm * 256; u.A = A; u.gather = nullptr; u.Bt = Bt + (size_t)pn * 256 * K; u.e = 0; return true;
    }
};
struct QkvSched {
    unsigned char* ws; int l, G, c;
    __device__ __forceinline__ bool get(int i, GUnit& g) const {
        const int u = i * G + c; if (u >= 144) return false; g.gather = nullptr;
        if (u < 128) { g.e = 0; g.pn = u & 1; g.row0 = (u >> 1) * 256; g.A = (const bf16_t*)(ws + WS_XB); g.Bt = (const bf16_t*)(ws + WS_WQ + l * SZ_WQ) + (size_t)g.pn * 256 * D; g.dst = (bf16_t*)(ws + WS_Q); }
        else { const int v = u - 128; g.e = 1 + (v >> 3); g.pn = v & 1; g.row0 = ((v >> 1) & 3) * 256; g.A = (const bf16_t*)(ws + WS_MEMB); g.Bt = (const bf16_t*)(ws + (g.e == 1 ? WS_WK : WS_WV) + l * SZ_WQ) + (size_t)g.pn * 256 * D; g.dst = (bf16_t*)(ws + (g.e == 1 ? WS_KM : WS_VM)) + (size_t)l * TM * W; }
        return true;
    }
};
template <int NCT, bool GATEUP> struct MoeSched {
    unsigned char* ws; const LAS int* pst; int l, G, c, nunits;
    __device__ __forceinline__ bool get(int i, GUnit& g) const {
        const int u = i * G + c; if (u >= nunits) return false;
        const int rt = u / NCT; g.pn = u % NCT; g.row0 = rt * 256; const int e = __builtin_amdgcn_readfirstlane((int)((const LAS unsigned char*)(pst + 68))[rt]); g.e = e;
        if (GATEUP) { g.A = (const bf16_t*)(ws + WS_XB8); g.gather = (const int*)(ws + WS_TOK) + g.row0; g.Bt = (const bf16_t*)(ws + WS_WGU8 + ((size_t)l * NEX + e) * SZ_WGU8 + (size_t)g.pn * 256 * D); }
        else { g.A = (const bf16_t*)(ws + WS_HB); g.gather = nullptr; g.Bt = (const bf16_t*)(ws + WS_WDN + ((size_t)l * NEX + e) * SZ_WDN1 + (size_t)g.pn * 256 * ED); }
        return true;
    }
};

struct TDesc { const float* sp; int sld; unsigned char* dp; int dldb; int fp8; float qs; };
constexpr int TK_WINA = 1024, TK_WINB = 2560, TK_BR = 384, TK_WOUT = 512, TK_QKV = 384, TK_WO = 128, TK_GU = NEX * 8 * 32, TK_DN = NEX * 128;
constexpr int TK_L0DEF = TK_BR + TK_WOUT + TK_QKV + TK_WO + TK_GU + TK_DN, TK_LAYER = TK_WINA + TK_WINB + TK_L0DEF;
__device__ __forceinline__ void tile_desc(const Frame& F, int l, int t, TDesc& d) {
    const KArgs a = F.ka; unsigned char* ws = F.ws_(); d.fp8 = 0; d.qs = W8_SCALE;
    if (t < TK_WINA) { const int tk = t >> 6, tc = t & 63; d.sp = ((const float*)a->in[IN_WIN]) + (size_t)l * D * PROJ_W + (size_t)tk * 128 * PROJ_W + tc * 64; d.sld = PROJ_W; d.dldb = D; d.fp8 = 2; d.qs = 127.0f / fmaxf(__uint_as_float(((const unsigned*)(ws + WS_CTL))[CW_WABS + l]), 1e-30f); d.dp = ws + WS_WINQ + l * SZ_WINQ + (size_t)tc * 64 * D + tk * 128; return; }
    t -= TK_WINA;
    if (t < TK_WINB) { const int tk = t / 160, tc = t % 160; d.sp = ((const float*)a->in[IN_WIN]) + (size_t)l * D * PROJ_W + (size_t)tk * 128 * PROJ_W + 4104 + tc * 64; d.sld = PROJ_W;
        if (tc < 32) { d.dldb = D; d.fp8 = 2; d.qs = 127.0f / fmaxf(__uint_as_float(((const unsigned*)(ws + WS_CTL))[CW_WABS + l]), 1e-30f); d.dp = ws + WS_WINQ + l * SZ_WINQ + (size_t)(4096 + tc * 64) * D + tk * 128; }
        else { d.dldb = D; d.fp8 = 1; d.dp = ws + WS_WIN8 + l * SZ_WIN8 + (size_t)(4096 + tc * 64) * D + tk * 128; }
        return; }
    t -= TK_WINB;
    if (t < TK_BR) { const int n = 1 + (t >> 7), tt = t & 127, tk = tt >> 5, tc = tt & 31; d.sp = ((const float*)a->in[IN_WBR]) + ((size_t)l * 4 + n) * W * D + (size_t)tk * 128 * D + tc * 64; d.sld = D; d.dldb = D * 2; d.dp = ws + WS_WB + l * SZ_DD + ((size_t)tc * 64 * D + n * W + tk * 128) * 2; return; }
    t -= TK_BR;
    if (t < TK_WOUT) { const int tk = t >> 5, tc = t & 31; d.sp = ((const float*)a->in[IN_WMIX]) + (size_t)l * D * D + (size_t)tk * 128 * D + tc * 64; d.sld = D; d.dldb = D * 2; d.dp = ws + WS_WOUT + l * SZ_DD + ((size_t)tc * 64 * D + tk * 128) * 2; return; }
    t -= TK_WOUT;
    if (t < TK_QKV) { const int which = t >> 7, tt = t & 127, tk = tt >> 3, tc = tt & 7; d.sp = (const float*)a->in[which == 0 ? IN_WQ : (which == 1 ? IN_WK : IN_WV)] + (size_t)l * D * W + (size_t)tk * 128 * W + tc * 64; d.sld = W; d.dldb = D * 2;
        d.dp = ws + (which == 0 ? WS_WQ : (which == 1 ? WS_WK : WS_WV)) + l * SZ_WQ + ((size_t)tc * 64 * D + tk * 128) * 2; return; }
    t -= TK_QKV;
    if (t < TK_WO) { const int tk = t >> 5, tc = t & 31; d.sp = ((const float*)a->in[IN_WO]) + (size_t)l * W * D + (size_t)tk * 128 * D + tc * 64; d.sld = D; d.dldb = W * 2; d.dp = ws + WS_WO + l * SZ_WQ + ((size_t)tc * 64 * W + tk * 128) * 2; return; }
    t -= TK_WO;
    if (t < TK_GU) { const int tt = t & 31, job = t >> 5, half = job & 1, j = (job >> 1) & 3, e = job >> 3, tk = tt >> 1, tc = tt & 1;
        d.sp = (e < NE ? ((const float*)a->in[IN_WGU]) + ((size_t)l * NE + e) * D * 1024 : ((const float*)a->in[IN_SGU]) + (size_t)l * D * 1024) + half * 512 + j * 128 + (size_t)tk * 128 * 1024 + tc * 64; d.sld = 1024; d.dldb = D; d.fp8 = 1;
        d.dp = ws + WS_WGU8 + ((size_t)l * NEX + e) * SZ_WGU8 + (size_t)(j * 256 + half * 128 + tc * 64) * D + tk * 128; return; }
    t -= TK_GU;
    { const int tt = t & 127, e = t >> 7, tk = tt >> 5, tc = tt & 31;
      d.sp = (e < NE ? ((const float*)a->in[IN_WDN]) + ((size_t)l * NE + e) * ED * D : ((const float*)a->in[IN_SDN]) + (size_t)l * ED * D) + (size_t)tk * 128 * D + tc * 64; d.sld = D; d.dldb = ED; d.fp8 = 1;
      d.dp = ws + WS_WDN + ((size_t)l * NEX + e) * SZ_WDN1 + (size_t)tc * 64 * ED + tk * 128; }
}
constexpr int XP_SLOT = 64 * 256;
template <int NB> struct XRegs { f32x4 r[NB][4]; };
template <int NB> __device__ __forceinline__ void xpose_load(const Frame& F, int l, int t0, int tstep, int n, XRegs<NB>& X) {
    const int tid = F.tid, row4 = (tid >> 4) * 4, cq = (tid & 15) * 4;
#pragma unroll
    for (int b = 0; b < NB; ++b) if (b < n) { TDesc d; tile_desc(F, l, t0 + b * tstep, d); const float* sp = d.sp + (size_t)row4 * d.sld + cq;
#pragma unroll
        for (int q = 0; q < 4; ++q) X.r[b][q] = __builtin_nontemporal_load((const f32x4*)(sp + (size_t)q * d.sld)); }
}
template <int NB> __device__ __forceinline__ void xpose_finish(const Frame& F, int l, int t0, int tstep, int n, const XRegs<NB>& X) {
    const int tid = F.tid, row4 = (tid >> 4) * 4, cq = (tid & 15) * 4;
    int t1 = t0; asm volatile("" : "+s"(t1));
#pragma unroll
    for (int b = 0; b < NB; ++b) if (b < n) { TDesc d; tile_desc(F, l, t1 + b * tstep, d); LAS unsigned char* L = F.lds + b * XP_SLOT;
        if (d.fp8) { const int sw = ((cq >> 2) & 7) << 4;
#pragma unroll
            for (int j = 0; j < 4; ++j) *(LAS unsigned*)(L + (cq + j) * 128 + (row4 ^ sw)) = (d.fp8 == 2) ? pack_i8x4(X.r[b][0][j] * d.qs, X.r[b][1][j] * d.qs, X.r[b][2][j] * d.qs, X.r[b][3][j] * d.qs) : pack_fp8x4(X.r[b][0][j] * W8_SCALE, X.r[b][1][j] * W8_SCALE, X.r[b][2][j] * W8_SCALE, X.r[b][3][j] * W8_SCALE);
        } else { const int sw = ((cq >> 2) & 15) << 4;
#pragma unroll
            for (int j = 0; j < 4; ++j) { u32x2 w; w.x = pack2(X.r[b][0][j], X.r[b][1][j]); w.y = pack2(X.r[b][2][j], X.r[b][3][j]); *(LAS u32x2*)(L + (cq + j) * 256 + ((row4 * 2) ^ sw)) = w; } } }
    __syncthreads();
    int t2 = t0; asm volatile("" : "+s"(t2));
#pragma unroll
    for (int b = 0; b < NB; ++b) if (b < n) { TDesc d; tile_desc(F, l, t2 + b * tstep, d); const LAS unsigned char* L = F.lds + b * XP_SLOT; const int c = tid >> 3, kq = tid & 7;
        if (d.fp8) *(u32x4*)(d.dp + (size_t)c * d.dldb + kq * 16) = *(const LAS u32x4*)(L + c * 128 + ((kq * 16) ^ (((c >> 2) & 7) << 4)));
        else { const int sw = ((c >> 2) & 15) << 4; *(u32x4*)(d.dp + (size_t)c * d.dldb + kq * 16) = *(const LAS u32x4*)(L + c * 256 + ((kq * 16) ^ sw)); *(u32x4*)(d.dp + (size_t)c * d.dldb + 128 + kq * 16) = *(const LAS u32x4*)(L + c * 256 + ((128 + kq * 16) ^ sw)); } }
    __syncthreads();
}
__device__ __forceinline__ void xpose_range(const Frame& F, int l, int tlo, int thi, int rank, int nranks) {
    constexpr int NB = 4; const int step = nranks * NB;
    XRegs<NB> A, B;
    int t = tlo + rank * NB; if (t >= thi) return;
#define XP_CNT(tt) (((thi) - (tt)) < NB ? ((thi) - (tt)) : NB)
    xpose_load<NB>(F, l, t, 1, XP_CNT(t), A);
    for (;;) {
        const int tb = t + step; const bool hb = tb < thi; if (hb) xpose_load<NB>(F, l, tb, 1, XP_CNT(tb), B);
        xpose_finish<NB>(F, l, t, 1, XP_CNT(t), A);
        if (!hb) break;
        const int ta = tb + step; const bool ha = ta < thi; if (ha) xpose_load<NB>(F, l, ta, 1, XP_CNT(ta), A);
        xpose_finish<NB>(F, l, tb, 1, XP_CNT(tb), B);
        if (!ha) break;
        t = ta;
    }
#undef XP_CNT
}
__device__ __forceinline__ void pool_fold(const Frame& F, int l, int rank, int nranks) {
    const KArgs a = F.ka; unsigned char* ws = F.ws_();
    for (size_t i = (size_t)rank * NTHR + F.tid; i < (size_t)W * D; i += (size_t)nranks * NTHR) {
        const int d = (int)(i % D), gc = (int)(i / D), g = gc >> 7;
        const float* pw = ((const float*)a->in[IN_POOLW]) + ((size_t)l * W + gc) * 128; const float* ps = ((const float*)a->in[IN_POOLS]) + l * W + g * 128;
        const float* wb = ((const float*)a->in[IN_WBR]) + ((size_t)l * 4 * W + g * 128) * D + d;
        float s = 0.f;
        for (int e = 0; e < 128; ++e) s += pw[e] * ps[e] * wb[(size_t)e * D];
        ((bf16_t*)(ws + WS_WB + l * SZ_DD))[(size_t)d * D + gc] = f2bf(s);
    }
}
__device__ __forceinline__ void phase_wabs(const Frame& F) {
    const KArgs a = F.ka; unsigned char* ws = F.ws_();
    for (int l = 0; l < DEPTH; ++l) { float m = 0.f; const float* w = ((const float*)a->in[IN_WIN]) + (size_t)l * D * PROJ_W;
        for (size_t i = (size_t)F.wg * NTHR + F.tid; i < (size_t)D * (NBR / 4); i += (size_t)F.nwg * NTHR) { const int c4 = (int)(i % (NBR / 4)), k = (int)(i / (NBR / 4)); const int col = c4 * 4 < 4096 ? c4 * 4 : c4 * 4 + 8;
            const f32x4 v = *(const f32x4*)(w + (size_t)k * PROJ_W + col); m = fmaxf(m, fmaxf(fmaxf(fabsf(v[0]), fabsf(v[1])), fmaxf(fabsf(v[2]), fabsf(v[3])))); }
        m = wave_max(m);
        if (F.lane == 0) __hip_atomic_fetch_max((unsigned*)(ws + WS_CTL) + CW_WABS + l, __float_as_uint(m), __ATOMIC_RELAXED, __HIP_MEMORY_SCOPE_AGENT); }
}
__device__ __forceinline__ void phase_prologue(const Frame& F) {
    const KArgs a = F.ka;
    unsigned char* ws = F.ws_();
    xpose_range(F, 0, 0, TK_WINA + TK_WINB, F.wg, F.nwg);
    const size_t gtid = (size_t)F.wg * NTHR + F.tid, gn = (size_t)F.nwg * NTHR;
    for (size_t i = gtid; i < (size_t)DEPTH * 8 * D; i += gn) { const int k = (int)(i % D), c = (int)((i / D) % 8), l = (int)(i / (8 * D));
        ((float*)(ws + WS_WIF))[i] = ((const float*)a->in[IN_WIN])[(size_t)l * D * PROJ_W + (size_t)k * PROJ_W + 4096 + c]; }
    for (size_t i = gtid; i < (size_t)DEPTH * NE * D; i += gn) { const int k = (int)(i % D), e = (int)((i / D) % NE), l = (int)(i / ((size_t)NE * D));
        const float w = ((const float*)a->in[IN_RW])[((size_t)l * D + k) * NE + e]; const bf16_t hi = f2bf(w); const bf16_t lo = f2bf(w - bf2f(hi));
        bf16_t* o = (bf16_t*)(ws + WS_RWT) + (size_t)l * 2 * NE * D; o[(size_t)e * D + k] = hi; o[(size_t)(NE + e) * D + k] = lo; }
    for (size_t i = gtid; i < (size_t)SEQ * 64; i += gn) { const int f = (int)(i & 63), s = (int)(i >> 6);
        const float inv = powf(10000.0f, -(float)f / 64.0f); const float ang = (float)s * inv;
        ((float*)(ws + WS_ROPE))[i] = cosf(ang); ((float*)(ws + WS_ROPE))[(size_t)SEQ * 64 + i] = sinf(ang); }
    for (int row = F.wg * 8 + F.wave; row < T; row += F.nwg * 8) { float v[32]; const float* xr = ((const float*)a->in[IN_X]) + (size_t)row * D;
#pragma unroll
        for (int j = 0; j < 4; ++j) { const f32x4 p = *(const f32x4*)(xr + j * 512 + F.lane * 8), q = *(const f32x4*)(xr + j * 512 + F.lane * 8 + 4); v[j * 8] = p[0]; v[j * 8 + 1] = p[1]; v[j * 8 + 2] = p[2]; v[j * 8 + 3] = p[3]; v[j * 8 + 4] = q[0]; v[j * 8 + 5] = q[1]; v[j * 8 + 6] = q[2]; v[j * 8 + 7] = q[3]; }
        st_row32((bf16_t*)(ws + WS_XB) + (size_t)row * D, F.lane, v); st_row32_fp8(ws + WS_XB8 + (size_t)row * D, F.lane, v); st_row32_i8(ws + WS_XQ8 + (size_t)row * D, (float*)(ws + WS_XSC) + row, F.lane, v); }
    for (size_t i = gtid; i < (size_t)TM * D / 4; i += gn) { const f32x4 v = ((const f32x4*)((const float*)a->in[IN_MEM]))[i]; st_bf16x4((bf16_t*)(ws + WS_MEMB) + i * 4, v); }
    __syncthreads();
}
__device__ __forceinline__ void prologue_deferred(const Frame& F, int rank, int nranks) {
    xpose_range(F, 0, TK_WINA + TK_WINB, TK_LAYER, rank, nranks);
    xpose_range(F, 1, 0, TK_LAYER, rank, nranks);
    pool_fold(F, 0, rank, nranks); pool_fold(F, 1, rank, nranks);
    __syncthreads();
}

__device__ __forceinline__ void unpack8(u32x4 w, float (&f)[8]) {
#pragma unroll
    for (int j = 0; j < 4; ++j) { f[2 * j] = __uint_as_float(w[j] << 16); f[2 * j + 1] = __uint_as_float(w[j] & 0xffff0000u); } }
__device__ __forceinline__ u32x4 pack8f(const float (&f)[8]) { u32x4 w;
#pragma unroll
    for (int j = 0; j < 4; ++j) w[j] = pack2(f[2 * j], f[2 * j + 1]); return w; }
template <int WIN> __device__ __forceinline__ void pool_block(const bf16_t* pu, bf16_t* out, int s0) {
    float sum[8];
#pragma unroll
    for (int e = 0; e < 8; ++e) sum[e] = 0.f;
    u32x4 hist[WIN - 1 + 8];
#pragma unroll
    for (int j = 0; j < WIN - 1 + 8; ++j) { const int ds = j - (WIN - 1); hist[j] = (s0 + ds >= 0) ? *(const u32x4*)(pu + (ptrdiff_t)ds * NBR) : (u32x4){0u, 0u, 0u, 0u}; }
#pragma unroll
    for (int j = 0; j < WIN - 1; ++j) { float f[8]; unpack8(hist[j], f);
#pragma unroll
        for (int e = 0; e < 8; ++e) sum[e] += f[e]; }
#pragma unroll
    for (int i = 0; i < 8; ++i) { float f[8]; unpack8(hist[WIN - 1 + i], f); const int cnt = (s0 + i + 1 < WIN) ? s0 + i + 1 : WIN; const float rc = 1.0f / (float)cnt; float o[8];
#pragma unroll
        for (int e = 0; e < 8; ++e) { sum[e] += f[e]; o[e] = sum[e] * rc - f[e]; }
        *(u32x4*)(out + (size_t)i * D) = pack8f(o);
        float fo[8]; unpack8(hist[i], fo);
#pragma unroll
        for (int e = 0; e < 8; ++e) sum[e] -= fo[e]; }
}
template <bool WITH_D = true> __device__ __forceinline__ void phase_mix1v2(const Frame& F, int l, const bf16_t* xcur) {
    const KArgs a = F.ka;
    unsigned char* ws = F.ws_();
    LAS float* dots = (LAS float*)(F.lds + 65536);
    LAS float* wl = (LAS float*)F.lds;
    const float* wif = (const float*)(ws + WS_WIF) + (size_t)l * 8 * D;
    const float* gb = ((const float*)a->in[IN_GATEB]) + l * 8;
    float* cumf = (float*)(ws + WS_CUMF); float* ipre = (float*)(ws + WS_IPRE); float* summ = (float*)(ws + WS_SUMM); float* av = (float*)(ws + WS_AV); float* pm = (float*)(ws + WS_PM);
    if (F.wg < BATCH * NCH) { for (int i = F.tid; i < 8 * D / 4; i += NTHR) *(LAS f32x4*)(wl + i * 4) = *(const f32x4*)(wif + i * 4); __syncthreads(); }
    for (int item = F.wg; item < BATCH * NCH; item += F.nwg) {
        const int b = item / NCH, c = item % NCH; const int t0 = b * SEQ + c * CH;
        for (int i = 0; i < 8; i += 2) {
            const int tok = F.wave * 8 + i; const bf16_t* xr = xcur + (size_t)(t0 + tok) * D;
            float d0[8], d1[8];
#pragma unroll
            for (int q = 0; q < 8; ++q) { d0[q] = 0.f; d1[q] = 0.f; }
#pragma unroll 1
            for (int j = 0; j < 4; ++j) { float x0[8], x1[8]; unpack8(*(const u32x4*)(xr + j * 512 + F.lane * 8), x0); unpack8(*(const u32x4*)(xr + D + j * 512 + F.lane * 8), x1);
#pragma unroll
                for (int q = 0; q < 8; ++q) { const f32x4 wa = *(const LAS f32x4*)(wl + q * D + j * 512 + F.lane * 8), wb = *(const LAS f32x4*)(wl + q * D + j * 512 + F.lane * 8 + 4);
#pragma unroll
                    for (int e = 0; e < 4; ++e) { d0[q] += x0[e] * wa[e] + x0[4 + e] * wb[e]; d1[q] += x1[e] * wa[e] + x1[4 + e] * wb[e]; } } }
#pragma unroll
            for (int q = 0; q < 8; ++q) { const float s0 = wave_sum(d0[q]), s1 = wave_sum(d1[q]); if (F.lane == 0) { dots[tok * 8 + q] = s0; dots[(tok + 1) * 8 + q] = s1; } }
        }
        __syncthreads();
        if (F.wave < NH) {
            const int h = F.wave, s = F.lane; const float ip = dots[s * 8 + h] + gb[h], fp = dots[s * 8 + 4 + h] + gb[4 + h];
            const float lf = fminf(fp, 0.f) - log1pf(__expf(-fabsf(fp)));
            float cs = lf;
#pragma unroll
            for (int o = 1; o < 64; o <<= 1) { const float n = __shfl_up(cs, o); if (s >= o) cs += n; }
            const float ftot = __shfl(cs, 63); const float aa = ip - cs;
            float px = aa;
#pragma unroll
            for (int o = 1; o < 64; o <<= 1) { const float n = __shfl_up(px, o); if (s >= o) px = fmaxf(px, n); }
            const float gm = ftot + __shfl(px, 63);
            const size_t o = (size_t)(b * NH + h) * SEQ + c * CH + s; cumf[o] = cs; ipre[o] = ip; av[o] = aa; pm[o] = px;
            if (s == 0) { summ[((size_t)(b * NH + h) * NCH + c) * 2] = ftot; summ[((size_t)(b * NH + h) * NCH + c) * 2 + 1] = gm; }
        }
        __syncthreads();
    }
    bf16_t* proj = (bf16_t*)(ws + WS_PROJ); bf16_t* br = (bf16_t*)(ws + WS_BR);
    for (int it = F.wg * 8 + F.wave; it < (T / 32) * 4; it += F.nwg * 8) {
        const int grp = it & 3, tbq = it >> 2; const int tb = tbq * 4 + (F.lane >> 4), co = grp * 16 + (F.lane & 15);
        const int t0 = tb * 8, s0 = t0 % SEQ; const bf16_t* pu = proj + (size_t)t0 * NBR + PC_U + co * 8; bf16_t* out = br + (size_t)t0 * D + co * 8;
        if (grp == 0) pool_block<2>(pu, out, s0); else if (grp == 1) pool_block<4>(pu, out, s0); else if (grp == 2) pool_block<8>(pu, out, s0); else pool_block<16>(pu, out, s0);
    }
    { const float* cw = ((const float*)a->in[IN_CONVW]) + (size_t)l * 3 * W;
      for (size_t it = (size_t)F.wg * NTHR + F.tid; it < (size_t)(T / 8) * 64; it += (size_t)F.nwg * NTHR) {
        const int co = (int)(it & 63), tb = (int)(it >> 6), t0 = tb * 8, s0 = t0 % SEQ;
        const bf16_t* pr = proj + (size_t)t0 * NBR + co * 8;
        float w0[8], w1[8], w2[8];
#pragma unroll
        for (int e = 0; e < 8; ++e) { w0[e] = cw[co * 8 + e]; w1[e] = cw[W + co * 8 + e]; w2[e] = cw[2 * W + co * 8 + e]; }
        float z1[8], z2[8];
#pragma unroll
        for (int e = 0; e < 8; ++e) { z1[e] = 0.f; z2[e] = 0.f; }
        if (s0 >= 2) { float c_[8], h_[8]; unpack8(*(const u32x4*)(pr + PC_CC - 2 * NBR), c_); unpack8(*(const u32x4*)(pr + PC_CH - 2 * NBR), h_);
#pragma unroll
            for (int e = 0; e < 8; ++e) z2[e] = c_[e] * h_[e]; }
        if (s0 >= 1) { float c_[8], h_[8]; unpack8(*(const u32x4*)(pr + PC_CC - NBR), c_); unpack8(*(const u32x4*)(pr + PC_CH - NBR), h_);
#pragma unroll
            for (int e = 0; e < 8; ++e) z1[e] = c_[e] * h_[e]; }
#pragma unroll
        for (int i = 0; i < 8; ++i) { float c_[8], h_[8], b_[8], o[8]; unpack8(*(const u32x4*)(pr + PC_CC + (size_t)i * NBR), c_); unpack8(*(const u32x4*)(pr + PC_CH + (size_t)i * NBR), h_); unpack8(*(const u32x4*)(pr + PC_CB + (size_t)i * NBR), b_);
#pragma unroll
            for (int e = 0; e < 8; ++e) { const float z0 = c_[e] * h_[e]; o[e] = b_[e] * (w0[e] * z0 + w1[e] * z1[e] + w2[e] * z2[e]); z2[e] = z1[e]; z1[e] = z0; }
            *(u32x4*)(br + (size_t)(t0 + i) * D + W + co * 8) = pack8f(o); }
      } }
    if constexpr (WITH_D) { const float* ropec = (const float*)(ws + WS_ROPE); const float* ropes = ropec + (size_t)SEQ * 64;
      for (size_t it = (size_t)F.wg * NTHR + F.tid; it < (size_t)T * 64; it += (size_t)F.nwg * NTHR) {
        const int oc = (int)(it & 7), hh = (int)((it >> 3) & 3), isk = (int)((it >> 5) & 1), t = (int)(it >> 6), s = t % SEQ;
        bf16_t* p = proj + (size_t)t * NBR + (isk ? PC_RK : PC_RQ) + hh * HD + oc * 8;
        float x1[8], x2[8], o1[8], o2[8]; unpack8(*(const u32x4*)p, x1); unpack8(*(const u32x4*)(p + 64), x2);
#pragma unroll
        for (int e = 0; e < 8; ++e) { const float cs = ropec[(size_t)s * 64 + oc * 8 + e], sn = ropes[(size_t)s * 64 + oc * 8 + e]; o1[e] = x1[e] * cs - x2[e] * sn; o2[e] = x1[e] * sn + x2[e] * cs; }
        *(u32x4*)p = pack8f(o1); *(u32x4*)(p + 64) = pack8f(o2);
      } }
}

__device__ __forceinline__ float ret_gamma_log2(int h) { return log2f(1.0f - exp2f(-5.0f - (float)h)); }

__device__ __forceinline__ void phase_scan_mfma(const Frame& F) {
    unsigned char* ws = F.ws_();
    constexpr int KS2 = 144, WS2 = 48;
    LAS bf16_t* Kb = (LAS bf16_t*)F.lds;
    LAS bf16_t* Wb = Kb + 2 * 64 * KS2;
    LAS float* mS = (LAS float*)(Wb + 2 * 64 * WS2);
    LAS float* fT = mS + 80;
    const bf16_t* proj = (const bf16_t*)(ws + WS_PROJ);
    const float* av = (const float*)(ws + WS_AV); const float* summ = (const float*)(ws + WS_SUMM);
    const int lane = F.lane, g = lane >> 4, li = lane & 15, w = F.wave, tid = F.tid;
    for (int item = F.wg; item < 2 * NBH * 8; item += F.nwg) {
        const int type = item >> 7, bh = (item >> 3) & 15, vs = item & 7, b = bh >> 2, h = bh & 3;
        if (tid == 0) { float m = 0.f; mS[0] = 0.f; for (int c = 0; c < NCH; ++c) { m = fmaxf(summ[((size_t)bh * NCH + c) * 2] + m, summ[((size_t)bh * NCH + c) * 2 + 1]); mS[c + 1] = m; }
            if (type == 0 && vs == 0) { float* ms = (float*)(ws + WS_MSEQ) + bh * 80; for (int c = 0; c <= NCH; ++c) ms[c] = mS[c]; } }
        if (tid >= 64 && tid < 128) fT[tid - 64] = summ[((size_t)bh * NCH + (tid - 64)) * 2];
        __syncthreads();
        const float lg2 = ret_gamma_log2(h);
        const int kcol = (type == 0 ? PC_MK : PC_RK) + h * HD, vcol = (type == 0 ? PC_MV : PC_RV) + h * HD + vs * 16;
        bf16_t* cst = (bf16_t*)(ws + WS_CST) + ((size_t)(type * NBH + bh) * NCH) * HD * HD;
        float* nsv = (float*)(ws + WS_NST) + (size_t)bh * NCH * HD;
        const int krow = tid >> 3, koct = tid & 7, vrow = (tid >> 1) & 63, vhalf = tid & 1;
        const bf16_t* kbase = proj + (size_t)(b * SEQ + krow) * NBR + kcol + koct * 8;
        const bf16_t* vbase = proj + (size_t)(b * SEQ + vrow) * NBR + vcol + vhalf * 8;
        const float* abase = av + (size_t)bh * SEQ + vrow;
        u32x4 kr[2][2], vr[2]; float ar[2];
#define SCAN_LOAD(c, sl) do { const size_t _o = (size_t)(c) * CH * NBR; kr[sl][0] = *(const u32x4*)(kbase + _o); kr[sl][1] = *(const u32x4*)(kbase + _o + 64); \
        if (tid < 128) { vr[sl] = *(const u32x4*)(vbase + _o); ar[sl] = (type == 0) ? abase[(c) * CH] : 0.f; } } while (0)
#define SCAN_WRITE(c, sl, bf) do { LAS bf16_t* _k = Kb + (bf) * 64 * KS2 + krow * KS2 + koct * 8; *(LAS u32x4*)_k = kr[sl][0]; *(LAS u32x4*)(_k + 64) = kr[sl][1]; \
        if (tid < 128) { const float _w = (type == 0) ? __expf(ar[sl] + fT[c] - mS[(c) + 1]) : exp2f((float)(63 - vrow) * lg2); float _f[8]; unpack8(vr[sl], _f); \
            _Pragma("unroll") for (int _e = 0; _e < 8; ++_e) _f[_e] *= _w; LAS bf16_t* _p = Wb + (bf) * 64 * WS2 + vrow * WS2; *(LAS u32x4*)(_p + vhalf * 8) = pack8f(_f); \
            u32x4 _x = {0u, 0u, 0u, 0u}; if (vhalf == 0) _x[0] = (unsigned)f2bf(_w); *(LAS u32x4*)(_p + 16 + vhalf * 8) = _x; } } while (0)
        f32x4 st = {0.f, 0.f, 0.f, 0.f}, na = {0.f, 0.f, 0.f, 0.f};
#define SCAN_BODY(c, bf) do { { u32x2 _pw; _pw.x = pack2(st[0], st[1]); _pw.y = pack2(st[2], st[3]); *(u32x2*)(cst + (size_t)(c) * HD * HD + (size_t)(vs * 16 + li) * HD + 16 * w + 4 * g) = _pw; } \
        if (type == 0 && vs == 0 && li == 0) *(f32x4*)(nsv + (c) * HD + 16 * w + 4 * g) = na; \
        const float _d = (type == 0) ? __expf(fT[c] + mS[c] - mS[(c) + 1]) : exp2f(64.0f * lg2); st *= _d; na *= _d; \
        _Pragma("unroll") for (int _u = 0; _u < 2; ++_u) { const LAS bf16_t* _kp = Kb + (bf) * 64 * KS2 + (32 * _u + 8 * g + (li >> 2)) * KS2 + 16 * w + 4 * (li & 3); \
            const LAS bf16_t* _wp = Wb + (bf) * 64 * WS2 + (32 * _u + 8 * g + (li >> 2)) * WS2 + 4 * (li & 3); \
            const bf16x8 _A = cat4(lds_tr(_kp), lds_tr(_kp + 4 * KS2)); const bf16x8 _B = cat4(lds_tr(_wp), lds_tr(_wp + 4 * WS2)); \
            st = __builtin_amdgcn_mfma_f32_16x16x32_bf16(_A, _B, st, 0, 0, 0); \
            if (type == 0) { const bf16x8 _B2 = cat4(lds_tr(_wp + 16), lds_tr(_wp + 4 * WS2 + 16)); na = __builtin_amdgcn_mfma_f32_16x16x32_bf16(_A, _B2, na, 0, 0, 0); } } } while (0)
        SCAN_LOAD(0, 0); SCAN_WRITE(0, 0, 0); SCAN_LOAD(1, 1); SCAN_LOAD(2, 0);
        __syncthreads();
        for (int c = 0; c < NCH; c += 2) {
            SCAN_BODY(c, 0);
            SCAN_WRITE(c + 1, 1, 1);
            if (c + 3 < NCH) SCAN_LOAD(c + 3, 1);
            __syncthreads();
            SCAN_BODY(c + 1, 1);
            if (c + 2 < NCH) { SCAN_WRITE(c + 2, 0, 0); }
            if (c + 4 < NCH) SCAN_LOAD(c + 4, 0);
            __syncthreads();
        }
#undef SCAN_LOAD
#undef SCAN_WRITE
#undef SCAN_BODY
    }
}

__device__ __forceinline__ void phase_chunk_mfma(const Frame& F, int l) {
    const KArgs a = F.ka; unsigned char* ws = F.ws_();
    constexpr int QS = 136, VS = 144, PS = 72;
    LAS bf16_t* Qs = (LAS bf16_t*)F.lds; LAS bf16_t* Ks = Qs + 64 * QS; LAS bf16_t* Vs = Ks + 64 * QS; LAS bf16_t* Ps = Vs + 64 * VS;
    LAS float* rv = (LAS float*)(Ps + 64 * PS);
    LAS float* hp = rv + 256;
    const bf16_t* proj = (const bf16_t*)(ws + WS_PROJ); bf16_t* br = (bf16_t*)(ws + WS_BR);
    const float* cumf = (const float*)(ws + WS_CUMF); const float* av = (const float*)(ws + WS_AV); const float* pm = (const float*)(ws + WS_PM); const float* mseq = (const float*)(ws + WS_MSEQ);
    const int lane = F.lane, g = lane >> 4, li = lane & 15, w = F.wave;
    bf16x8 ones;
#pragma unroll
    for (int j = 0; j < 8; ++j) ones[j] = (short)0x3F80;
    for (int item = F.wg; item < 2 * NBH * NCH; item += F.nwg) {
        const int type = item / (NBH * NCH), bh = (item / NCH) % NBH, c = item % NCH, b = bh >> 2, h = bh & 3;
        const int t0 = b * SEQ + c * CH; const size_t go = (size_t)bh * SEQ + c * CH;
        const int qcol = (type == 0 ? PC_MQ : PC_RQ) + h * HD, kcol = (type == 0 ? PC_MK : PC_RK) + h * HD, vcol = (type == 0 ? PC_MV : PC_RV) + h * HD;
        const float lg2 = ret_gamma_log2(h);
        { const int row = F.tid >> 3, oct = F.tid & 7; const bf16_t* pr = proj + (size_t)(t0 + row) * NBR + oct * 8;
          *(LAS u32x4*)(Qs + row * QS + oct * 8) = *(const u32x4*)(pr + qcol); *(LAS u32x4*)(Qs + row * QS + 64 + oct * 8) = *(const u32x4*)(pr + qcol + 64);
          *(LAS u32x4*)(Ks + row * QS + oct * 8) = *(const u32x4*)(pr + kcol); *(LAS u32x4*)(Ks + row * QS + 64 + oct * 8) = *(const u32x4*)(pr + kcol + 64);
          *(LAS u32x4*)(Vs + row * VS + oct * 8) = *(const u32x4*)(pr + vcol); *(LAS u32x4*)(Vs + row * VS + 64 + oct * 8) = *(const u32x4*)(pr + vcol + 64); }
        if (F.tid < 64) { const int t = F.tid;
            if (type == 0) { const float mp = mseq[bh * 80 + c]; const float bt = fmaxf(mp, pm[go + t]); rv[t] = av[go + t]; rv[64 + t] = bt; rv[128 + t] = __expf(mp - bt); rv[192 + t] = __expf(-cumf[go + t] - bt); }
            else rv[128 + t] = exp2f((float)(t + 1) * lg2); }
        __syncthreads();
        { const int tt = w >> 1, t = 16 * tt + li;
#pragma unroll
          for (int sti = 0; sti < 2; ++sti) { const int st = (w & 1) * 2 + sti; f32x4 acc = {0.f, 0.f, 0.f, 0.f};
            if (st <= tt) {
#pragma unroll
                for (int kk = 0; kk < 4; ++kk) { const bf16x8 kf = *(const LAS bf16x8*)(Ks + (16 * st + li) * QS + kk * 32 + g * 8), qf = *(const LAS bf16x8*)(Qs + (16 * tt + li) * QS + kk * 32 + g * 8);
                    acc = __builtin_amdgcn_mfma_f32_16x16x32_bf16(kf, qf, acc, 0, 0, 0); }
#pragma unroll
                for (int r = 0; r < 4; ++r) { const int sx = 16 * st + 4 * g + r; float wgt;
                    if (type == 0) wgt = __expf(rv[sx] - rv[64 + t]); else wgt = exp2f((float)(t - sx) * lg2);
                    acc[r] = (sx <= t) ? acc[r] * wgt : 0.f; } }
            u32x2 pw; pw.x = pack2(acc[0], acc[1]); pw.y = pack2(acc[2], acc[3]); *(LAS u32x2*)(Ps + t * PS + 16 * st + 4 * g) = pw; } }
        __syncthreads();
        f32x4 pv[4], qc[4], dn[4], qn[4];
#pragma unroll
        for (int tt = 0; tt < 4; ++tt) { pv[tt] = (f32x4){0.f, 0.f, 0.f, 0.f}; qc[tt] = pv[tt]; dn[tt] = pv[tt]; qn[tt] = pv[tt]; }
#pragma unroll
        for (int u = 0; u < 2; ++u) {
            const bf16x8 vf = cat4(lds_tr(Vs + (32 * u + 8 * g + (li >> 2)) * VS + 16 * w + 4 * (li & 3)), lds_tr(Vs + (32 * u + 8 * g + 4 + (li >> 2)) * VS + 16 * w + 4 * (li & 3)));
#pragma unroll
            for (int tt = 0; tt < 4; ++tt) { const bf16x8 pf = *(const LAS bf16x8*)(Ps + (16 * tt + li) * PS + 32 * u + 8 * g);
                pv[tt] = __builtin_amdgcn_mfma_f32_16x16x32_bf16(vf, pf, pv[tt], 0, 0, 0);
                if (type == 0) dn[tt] = __builtin_amdgcn_mfma_f32_16x16x32_bf16(ones, pf, dn[tt], 0, 0, 0); } }
        if (c > 0) {
            const bf16_t* cst = (const bf16_t*)(ws + WS_CST) + ((size_t)(type * NBH + bh) * NCH + c) * HD * HD;
            const float* nsv = (const float*)(ws + WS_NST) + ((size_t)bh * NCH + c) * HD;
#pragma unroll
            for (int kk = 0; kk < 4; ++kk) { const bf16x8 cf = *(const bf16x8*)(cst + (size_t)(16 * w + li) * HD + kk * 32 + g * 8);
                bf16x8 nf = ones;
                if (type == 0) { const f32x4 n0 = *(const f32x4*)(nsv + kk * 32 + g * 8), n1 = *(const f32x4*)(nsv + kk * 32 + g * 8 + 4); nf = pack8(n0, n1); }
#pragma unroll
                for (int tt = 0; tt < 4; ++tt) { const bf16x8 qf = *(const LAS bf16x8*)(Qs + (16 * tt + li) * QS + kk * 32 + g * 8);
                    qc[tt] = __builtin_amdgcn_mfma_f32_16x16x32_bf16(cf, qf, qc[tt], 0, 0, 0);
                    if (type == 0) qn[tt] = __builtin_amdgcn_mfma_f32_16x16x32_bf16(nf, qf, qn[tt], 0, 0, 0); } } }
        const int vc = h * HD + 16 * w + 4 * g;
#pragma unroll
        for (int tt = 0; tt < 4; ++tt) { const int t = 16 * tt + li; const float inter = rv[128 + t]; f32x4 hv;
            if (type == 0) { const float den = inter * qn[tt][0] + dn[tt][0]; const float rd = 1.0f / fmaxf(fabsf(den), rv[192 + t]);
                const u32x2 ow = *(const u32x2*)(proj + (size_t)(t0 + t) * NBR + PC_MO + vc);
                const float o0 = __uint_as_float(ow.x << 16), o1 = __uint_as_float(ow.x & 0xffff0000u), o2 = __uint_as_float(ow.y << 16), o3 = __uint_as_float(ow.y & 0xffff0000u);
                hv[0] = sigmoidf_(o0) * (inter * qc[tt][0] + pv[tt][0]) * rd; hv[1] = sigmoidf_(o1) * (inter * qc[tt][1] + pv[tt][1]) * rd;
                hv[2] = sigmoidf_(o2) * (inter * qc[tt][2] + pv[tt][2]) * rd; hv[3] = sigmoidf_(o3) * (inter * qc[tt][3] + pv[tt][3]) * rd; }
            else hv = pv[tt] + qc[tt] * inter;
            pv[tt] = hv;
            float s1 = (hv[0] + hv[1]) + (hv[2] + hv[3]), s2 = (hv[0] * hv[0] + hv[1] * hv[1]) + (hv[2] * hv[2] + hv[3] * hv[3]);
            s1 += __shfl_xor(s1, 16); s1 += __shfl_xor(s1, 32); s2 += __shfl_xor(s2, 16); s2 += __shfl_xor(s2, 32);
            if (g == 0) { hp[(w * 64 + t) * 2] = s1; hp[(w * 64 + t) * 2 + 1] = s2; } }
        __syncthreads();
        const float* nw = (type == 0 ? ((const float*)a->in[IN_MNORM]) : ((const float*)a->in[IN_RNORM])) + l * W + vc; const f32x4 nw4 = *(const f32x4*)nw;
#pragma unroll
        for (int tt = 0; tt < 4; ++tt) { const int t = 16 * tt + li; float s1 = 0.f, s2 = 0.f;
#pragma unroll
            for (int ww = 0; ww < 8; ++ww) { const f32x2 p2 = *(const LAS f32x2*)(hp + (ww * 64 + t) * 2); s1 += p2.x; s2 += p2.y; }
            const float mu = s1 * (1.0f / 128.0f), var = fmaxf(s2 * (1.0f / 128.0f) - mu * mu, 0.f), rstd = rsqrtf(var + LN_EPS);
            f32x4 y = (pv[tt] - mu) * rstd * nw4;
            if (type == 1) { const u32x2 gw = *(const u32x2*)(proj + (size_t)(t0 + t) * NBR + PC_RG + vc);
                const float g0 = __uint_as_float(gw.x << 16), g1 = __uint_as_float(gw.x & 0xffff0000u), g2 = __uint_as_float(gw.y << 16), g3 = __uint_as_float(gw.y & 0xffff0000u);
                y[0] *= g0 * sigmoidf_(g0); y[1] *= g1 * sigmoidf_(g1); y[2] *= g2 * sigmoidf_(g2); y[3] *= g3 * sigmoidf_(g3); }
            st_bf16x4(br + (size_t)(t0 + t) * D + (type == 0 ? 1024 : 1536) + vc, y); }
        __syncthreads();
    }
}

__device__ __forceinline__ void ln_row(float (&v)[32], const float* lw, const float* lb, int lane) {
    float s = 0.f;
#pragma unroll
    for (int j = 0; j < 32; ++j) s += v[j];
    const float mu = wave_sum(s) * (1.0f / D); float q = 0.f;
#pragma unroll
    for (int j = 0; j < 32; ++j) { const float d = v[j] - mu; q += d * d; }
    const float rstd = rsqrtf(wave_sum(q) * (1.0f / D) + LN_EPS);
#pragma unroll
    for (int j = 0; j < 4; ++j)
#pragma unroll
        for (int h = 0; h < 2; ++h) { const f32x4 w4 = *(const f32x4*)(lw + j * 512 + lane * 8 + h * 4), b4 = *(const f32x4*)(lb + j * 512 + lane * 8 + h * 4);
#pragma unroll
            for (int e = 0; e < 4; ++e) v[j * 8 + h * 4 + e] = (v[j * 8 + h * 4 + e] - mu) * rstd * w4[e] + b4[e]; }
}
__device__ __forceinline__ void phase_ln(const Frame& F, const bf16_t* y, const float* lw, const float* lb, bf16_t* xb) {
    for (int row = F.wg * 8 + F.wave; row < T; row += F.nwg * 8) {
        float v[32]; ld_row32(y + (size_t)row * D, F.lane, v);
        ln_row(v, lw, lb, F.lane);
        st_row32(xb + (size_t)row * D, F.lane, v);
    }
}
__device__ __forceinline__ void split8(f32x4 a, f32x4 b, bf16x8& hi, bf16x8& lo) {
    union { u32x4 u; bf16x8 h; } H, L;
#pragma unroll
    for (int j = 0; j < 2; ++j) { const bf16_t h0 = f2bf(a[2 * j]), h1 = f2bf(a[2 * j + 1]); H.u[j] = (unsigned)h0 | ((unsigned)h1 << 16); L.u[j] = pack2(a[2 * j] - bf2f(h0), a[2 * j + 1] - bf2f(h1)); }
#pragma unroll
    for (int j = 0; j < 2; ++j) { const bf16_t h0 = f2bf(b[2 * j]), h1 = f2bf(b[2 * j + 1]); H.u[2 + j] = (unsigned)h0 | ((unsigned)h1 << 16); L.u[2 + j] = pack2(b[2 * j] - bf2f(h0), b[2 * j + 1] - bf2f(h1)); }
    hi = H.h; lo = L.h; }
__device__ __forceinline__ void phase_ln_router(const Frame& F, int l, const bf16_t* y, bf16_t* xb) {
    const KArgs a = F.ka;
    unsigned char* ws = F.ws_();
    constexpr int XS = D + 4;
    LAS float* xs = (LAS float*)F.lds;
    LAS float* part = xs + 16 * XS;
    const float* lw = ((const float*)a->in[IN_LNW]) + ((size_t)l * 3 + 1) * D; const float* lb = ((const float*)a->in[IN_LNB]) + ((size_t)l * 3 + 1) * D;
    const bf16_t* rwt = (const bf16_t*)(ws + WS_RWT) + (size_t)l * 2 * NE * D; const float* rb = ((const float*)a->in[IN_RB]) + l * NE;
    unsigned* counts = (unsigned*)(ws + WS_CTL) + CW_COUNTS + l * 64;
    int* eid = (int*)(ws + WS_EID); float* ew = (float*)(ws + WS_EW); int* epos = (int*)(ws + WS_EPOS);
    const int lane = F.lane, g = lane >> 4, li = lane & 15, nt = F.wave & 3, kh = F.wave >> 2;
    for (int blk = F.wg; blk < T / 16; blk += F.nwg) {
        for (int rr = 0; rr < 2; ++rr) {
            const int lr = F.wave * 2 + rr, row = blk * 16 + lr;
            float v[32]; ld_row32(y + (size_t)row * D, F.lane, v);
            ln_row(v, lw, lb, F.lane);
            st_row32(xb + (size_t)row * D, F.lane, v); st_row32_fp8(ws + WS_XB8 + (size_t)row * D, F.lane, v);
#pragma unroll
            for (int j = 0; j < 4; ++j) { *(LAS f32x4*)(xs + lr * XS + j * 512 + F.lane * 8) = (f32x4){v[j * 8], v[j * 8 + 1], v[j * 8 + 2], v[j * 8 + 3]}; *(LAS f32x4*)(xs + lr * XS + j * 512 + F.lane * 8 + 4) = (f32x4){v[j * 8 + 4], v[j * 8 + 5], v[j * 8 + 6], v[j * 8 + 7]}; }
        }
        __syncthreads();
        { f32x4 acc = {0.f, 0.f, 0.f, 0.f};
          const bf16_t* wh = rwt + (size_t)(16 * nt + li) * D + kh * 1024 + g * 8; const bf16_t* wl = wh + (size_t)NE * D;
          const LAS float* xr = xs + li * XS + kh * 1024 + g * 8;
#pragma unroll 4
          for (int ks = 0; ks < 32; ++ks) { bf16x8 xh, xl; split8(*(const LAS f32x4*)(xr + ks * 32), *(const LAS f32x4*)(xr + ks * 32 + 4), xh, xl);
              const bf16x8 bh = *(const bf16x8*)(wh + ks * 32), bl = *(const bf16x8*)(wl + ks * 32);
              acc = __builtin_amdgcn_mfma_f32_16x16x32_bf16(xh, bh, acc, 0, 0, 0); acc = __builtin_amdgcn_mfma_f32_16x16x32_bf16(xh, bl, acc, 0, 0, 0); acc = __builtin_amdgcn_mfma_f32_16x16x32_bf16(xl, bh, acc, 0, 0, 0); }
#pragma unroll
          for (int r = 0; r < 4; ++r) part[(kh * 16 + 4 * g + r) * 64 + 16 * nt + li] = acc[r]; }
        __syncthreads();
        const int e = F.lane;
        const float bias = rb[e];
        for (int rr = 0; rr < 2; ++rr) {
            const int lr = F.wave * 2 + rr, row = blk * 16 + lr;
            const float sc = sigmoidf_(part[lr * 64 + e] + part[(16 + lr) * 64 + e]), bs = sc + bias;
            float m1 = bs; m1 = fmaxf(m1, __shfl_xor(m1, 1)); m1 = fmaxf(m1, __shfl_xor(m1, 2)); m1 = fmaxf(m1, __shfl_xor(m1, 4));
            const unsigned long long eq = __ballot(bs == m1); const int gq = e >> 3; const unsigned gm = (unsigned)(eq >> (gq * 8)) & 0xffu; const int first = gq * 8 + __builtin_ctz(gm);
            float m2 = (e == first) ? -INFINITY : bs; m2 = fmaxf(m2, __shfl_xor(m2, 1)); m2 = fmaxf(m2, __shfl_xor(m2, 2)); m2 = fmaxf(m2, __shfl_xor(m2, 4));
            const float gs = m1 + m2;
            int grank = 0;
#pragma unroll
            for (int g2 = 0; g2 < 8; ++g2) { const float o = __shfl(gs, g2 * 8); grank += (o > gs || (o == gs && g2 < gq)) ? 1 : 0; }
            const bool gsel = grank < 4;
            const float val = gsel ? bs : -INFINITY;
            int rank = 0;
            for (int e2 = 0; e2 < 64; ++e2) { const float o = __shfl(val, e2); rank += (o > val || (o == val && e2 < e)) ? 1 : 0; }
            const bool sel = gsel && rank < TOPK;
            const float wsum = wave_sum(sel ? sc : 0.f);
            const unsigned long long sm = __ballot(sel);
            if (sel) { const int k = __builtin_popcountll(sm & ((1ull << e) - 1ull));
                const unsigned pos = __hip_atomic_fetch_add(counts + e, 1u, __ATOMIC_RELAXED, __HIP_MEMORY_SCOPE_AGENT);
                eid[(size_t)row * 8 + k] = e; ew[(size_t)row * 8 + k] = sc / wsum * ROUTE_SCALE; epos[(size_t)row * 8 + k] = (int)pos; }
        }
        __syncthreads();
    }
}
__device__ __forceinline__ void build_pstart(const Frame& F, int l, LAS int* pst) {
    const unsigned* counts = (const unsigned*)(F.ws_() + WS_CTL) + CW_COUNTS + l * 64;
    if (F.tid < 64) {
        const int c = (int)__hip_atomic_load(counts + F.tid, __ATOMIC_RELAXED, __HIP_MEMORY_SCOPE_AGENT); const int pc = (c + 255) & ~255; int inc = pc;
#pragma unroll
        for (int o = 1; o < 64; o <<= 1) { const int n = __shfl_up(inc, o); if (F.tid >= o) inc += n; }
        pst[F.tid] = inc - pc; if (F.tid == 63) { pst[NE] = inc; pst[NE + 1] = inc + T; } }
    __syncthreads();
    { LAS unsigned char* texp = (LAS unsigned char*)(pst + 68);
      for (int rt = F.tid; rt < (pst[NE + 1] >> 8); rt += NTHR) { int e = 0; while (e < NE && pst[e + 1] <= rt * 256) ++e; texp[rt] = (unsigned char)e; } }
    __syncthreads();
}
__device__ __forceinline__ void phase_slots(const Frame& F, int l) {
    unsigned char* ws = F.ws_();
    LAS int* pst = (LAS int*)F.lds;
    build_pstart(F, l, pst);
    const unsigned* counts = (const unsigned*)(ws + WS_CTL) + CW_COUNTS + l * 64;
    const int* eid = (const int*)(ws + WS_EID); const float* ew = (const float*)(ws + WS_EW); const int* epos = (const int*)(ws + WS_EPOS);
    int* slotof = (int*)(ws + WS_SLOTOF); int* tok = (int*)(ws + WS_TOK); float* wsl = (float*)(ws + WS_WSL);
    const size_t gtid = (size_t)F.wg * NTHR + F.tid, gn = (size_t)F.nwg * NTHR;
    for (size_t i = gtid; i < (size_t)T * 8; i += gn) { const int e = eid[i]; const int slot = pst[e] + epos[i]; slotof[i] = slot; tok[slot] = (int)(i >> 3); wsl[slot] = ew[i]; }
    for (size_t i = gtid; i < (size_t)NE * 256; i += gn) { const int e = (int)(i >> 8), r = (int)(i & 255); const int c = (int)counts[e]; const int slot = pst[e] + c + r; if (slot < pst[e + 1]) { tok[slot] = 0; wsl[slot] = 0.f; } }
    for (size_t i = gtid; i < (size_t)T; i += gn) { tok[pst[NE] + i] = (int)i; wsl[pst[NE] + i] = 1.0f; }
    __syncthreads();
}
__device__ __forceinline__ void phase_combine_ln(const Frame& F, int l, bf16_t* xb, float* out) {
    const KArgs a = F.ka;
    unsigned char* ws = F.ws_();
    LAS int* pst = (LAS int*)F.lds;
    build_pstart(F, l, pst);
    const int sh0 = pst[NE];
    const int* slotof = (const int*)(ws + WS_SLOTOF); const unsigned char* yb = ws + WS_YB;
    const float* lw = ((const float*)a->in[IN_LNW]) + ((size_t)l * 3 + 2) * D; const float* lb = ((const float*)a->in[IN_LNB]) + ((size_t)l * 3 + 2) * D;
    for (int row = F.wg * 8 + F.wave; row < T; row += F.nwg * 8) {
        float v[32]; ld_row32(xb + (size_t)row * D, F.lane, v);
#pragma unroll
        for (int j = 0; j < 32; ++j) v[j] *= ALPHA;
        float ys[32];
#pragma unroll
        for (int j = 0; j < 32; ++j) ys[j] = 0.f;
#pragma unroll 3
        for (int k = 0; k < 9; ++k) { const int slot = k < 8 ? slotof[(size_t)row * 8 + k] : sh0 + row; const unsigned char* yr = yb + (size_t)slot * D;
#pragma unroll
            for (int j = 0; j < 4; ++j) { const u32x2 w = *(const u32x2*)(yr + j * 512 + F.lane * 8);
                const f32x2 p0 = __builtin_amdgcn_cvt_pk_f32_fp8((int)w.x, false), p1 = __builtin_amdgcn_cvt_pk_f32_fp8((int)w.x, true), p2 = __builtin_amdgcn_cvt_pk_f32_fp8((int)w.y, false), p3 = __builtin_amdgcn_cvt_pk_f32_fp8((int)w.y, true);
                ys[j * 8] += p0.x; ys[j * 8 + 1] += p0.y; ys[j * 8 + 2] += p1.x; ys[j * 8 + 3] += p1.y; ys[j * 8 + 4] += p2.x; ys[j * 8 + 5] += p2.y; ys[j * 8 + 6] += p3.x; ys[j * 8 + 7] += p3.y; } }
#pragma unroll
        for (int j = 0; j < 32; ++j) v[j] += ys[j] * (1.0f / Y8_SCALE);
        ln_row(v, lw, lb, F.lane);
        if (out) {
#pragma unroll
            for (int j = 0; j < 4; ++j) { *(f32x4*)(out + (size_t)row * D + j * 512 + F.lane * 8) = (f32x4){v[j * 8], v[j * 8 + 1], v[j * 8 + 2], v[j * 8 + 3]}; *(f32x4*)(out + (size_t)row * D + j * 512 + F.lane * 8 + 4) = (f32x4){v[j * 8 + 4], v[j * 8 + 5], v[j * 8 + 6], v[j * 8 + 7]}; }
        } else { st_row32(xb + (size_t)row * D, F.lane, v); st_row32_fp8(ws + WS_XB8 + (size_t)row * D, F.lane, v); st_row32_i8(ws + WS_XQ8 + (size_t)row * D, (float*)(ws + WS_XSC) + row, F.lane, v); }
    }
    __syncthreads();
}

__device__ __forceinline__ void phase_attn_mfma(const Frame& F, int l) {
    unsigned char* ws = F.ws_();
    constexpr int KS = 136, VS = 144;
    LAS bf16_t* Ks = (LAS bf16_t*)F.lds; LAS bf16_t* Vs = Ks + 256 * KS;
    const bf16_t* q = (const bf16_t*)(ws + WS_Q); const bf16_t* km = (const bf16_t*)(ws + WS_KM) + (size_t)l * TM * W; const bf16_t* vm = (const bf16_t*)(ws + WS_VM) + (size_t)l * TM * W;
    bf16_t* o = (bf16_t*)(ws + WS_O);
    const int nunit = (T / 128) * 4, upw = (nunit + F.nwg - 1) / F.nwg;
    const int lane = F.lane, g = lane >> 4, li = lane & 15;
    int loaded = -1;
    const int u_end = (F.wg + 1) * upw < nunit ? (F.wg + 1) * upw : nunit;
    for (int u = F.wg * upw; u < u_end; ++u) {
        const int bh = u >> 5, blk = u & 31, b = bh >> 2, hh = bh & 3;
        if (bh != loaded) {
            __syncthreads();
            const int m = F.tid >> 1, half = F.tid & 1;
            const bf16_t* kr = km + (size_t)(b * MEM + m) * W + hh * HD + half * 64; const bf16_t* vr = vm + (size_t)(b * MEM + m) * W + hh * HD + half * 64;
#pragma unroll
            for (int j = 0; j < 8; ++j) { *(LAS u32x4*)(Ks + m * KS + half * 64 + j * 8) = *(const u32x4*)(kr + j * 8); *(LAS u32x4*)(Vs + m * VS + half * 64 + j * 8) = *(const u32x4*)(vr + j * 8); }
            __syncthreads(); loaded = bh;
        }
        const int t0 = b * SEQ + blk * 128 + F.wave * 16;
        bf16x8 qf[4];
#pragma unroll
        for (int kk = 0; kk < 4; ++kk) qf[kk] = *(const bf16x8*)(q + (size_t)(t0 + li) * W + hh * HD + kk * 32 + g * 8);
        f32x4 sacc[16];
#pragma unroll
        for (int tt = 0; tt < 16; ++tt) { f32x4 acc = {0.f, 0.f, 0.f, 0.f};
#pragma unroll
            for (int kk = 0; kk < 4; ++kk) { const bf16x8 kf = *(const LAS bf16x8*)(Ks + (16 * tt + li) * KS + kk * 32 + g * 8); acc = __builtin_amdgcn_mfma_f32_16x16x32_bf16(kf, qf[kk], acc, 0, 0, 0); }
            sacc[tt] = acc; }
        float mx = -INFINITY;
#pragma unroll
        for (int tt = 0; tt < 16; ++tt) mx = fmaxf(mx, fmaxf(fmaxf(sacc[tt][0], sacc[tt][1]), fmaxf(sacc[tt][2], sacc[tt][3])));
        mx = fmaxf(mx, __shfl_xor(mx, 16)); mx = fmaxf(mx, __shfl_xor(mx, 32));
        const float c2 = 0.08838834764831845f * 1.4426950408889634f; float sum = 0.f;
#pragma unroll
        for (int tt = 0; tt < 16; ++tt)
#pragma unroll
            for (int r = 0; r < 4; ++r) { const float p = exp2f((sacc[tt][r] - mx) * c2); sacc[tt][r] = p; sum += p; }
        sum += __shfl_xor(sum, 16); sum += __shfl_xor(sum, 32);
        const float rs = 1.0f / sum;
        bf16x8 pk[8];
#pragma unroll
        for (int u8 = 0; u8 < 8; ++u8) pk[u8] = pack8(sacc[2 * u8], sacc[2 * u8 + 1]);
#pragma unroll
        for (int dvt = 0; dvt < 8; ++dvt) { f32x4 acc = {0.f, 0.f, 0.f, 0.f};
#pragma unroll
            for (int u8 = 0; u8 < 8; ++u8) { const s16x4 a0 = lds_tr(Vs + (32 * u8 + 4 * g + (li >> 2)) * VS + dvt * 16 + 4 * (li & 3)); const s16x4 a1 = lds_tr(Vs + (32 * u8 + 16 + 4 * g + (li >> 2)) * VS + dvt * 16 + 4 * (li & 3));
                acc = __builtin_amdgcn_mfma_f32_16x16x32_bf16(cat4(a0, a1), pk[u8], acc, 0, 0, 0); }
            st_bf16x4(o + (size_t)(t0 + li) * W + hh * HD + dvt * 16 + 4 * g, acc * rs); }
    }
    __syncthreads();
}

template <class Epi>
__device__ __forceinline__ void gemm_dense_mfma(const Frame& F, const bf16_t* A, const bf16_t* Bt, int M, int N, int K, const Epi& E) {
    DenseSched S; S.A = A; S.Bt = Bt; S.K = K; S.nM = M / 256; S.nN = N / 256; S.nwg = S.nM * S.nN; S.G = F.nwg; S.c = F.wg; S.i0 = 0; S.i1 = 1 << 30; S.pnoff = 0;
    gemm_phase_mfma(F, K, S, E);
}
constexpr int NPL = 15, NPHASE = 1 + DEPTH * NPL;
#ifndef NCONV
#define NCONV 40
#endif
#if MK_PER_PHASE
#define IN(k) (lo <= (k) && (k) < hi)
#define SEAM(k) do { if (IN((k) + 1)) { XcdBarrier b2_ = bar; asm volatile("" : "+s"(b2_.bar)); asm volatile("" : "+s"(b2_.x)); xcd_barrier(b2_); } } while (0)
#else
#define IN(k) true
#define SEAM(k) do { if ((k) + 1 < NPHASE) for (int rb_ = 0; rb_ < ((PROBE_DBL & 4096) ? 3 : 1); ++rb_) { XcdBarrier b2_ = bar; asm volatile("" : "+s"(b2_.bar)); asm volatile("" : "+s"(b2_.x)); xcd_barrier(b2_); } } while (0)
#endif
template <int l> __device__ __forceinline__ void run_layer(const Frame& F0, const XcdBarrier& bar, int lo, int hi) {
    const int pb = 1 + l * NPL;
    if (IN(pb + 0)) { const Frame F = fresh(F0); unsigned char* ws = F.ws_();
        EpiProj E{(bf16_t*)(ws + WS_PROJ), (bf16_t*)(ws + WS_GATES)};
        { DenseSched S; S.A = (const bf16_t*)(ws + WS_XQ8); S.Bt = (const bf16_t*)(ws + WS_WINQ + l * SZ_WINQ); S.K = D / 2; S.nM = T / 256; S.nN = NBR / 256; S.nwg = S.nM * S.nN; S.G = F.nwg; S.c = F.wg; S.i0 = 0; S.i1 = 1 << 30; S.pnoff = 0;
          const float wsc = __uint_as_float(((const unsigned*)(ws + WS_CTL))[CW_WABS + l]) * (1.0f / 127.0f);
          gemm_phase_mfma<EpiProj, DenseSched, 2>(F, D, S, E, wsc, (const float*)(ws + WS_XSC)); }
        { const Frame F2 = fresh(F0); unsigned char* ws2 = F2.ws_(); EpiProj E2{(bf16_t*)(ws2 + WS_PROJ), (bf16_t*)(ws2 + WS_GATES)};
          DenseSched S; S.A = (const bf16_t*)(ws2 + WS_XB8); S.Bt = (const bf16_t*)(ws2 + WS_WIN8 + l * SZ_WIN8 + (size_t)NBR * D); S.K = D / 2; S.nM = T / 256; S.nN = (NPROJ - NBR) / 256; S.nwg = S.nM * S.nN; S.G = F2.nwg; S.c = F2.wg; S.i0 = 0; S.i1 = 1 << 30; S.pnoff = NBR / 256;
          gemm_phase_mfma<EpiProj, DenseSched, 1>(F2, D, S, E2, 1.0f / (X8_SCALE * W8_SCALE)); if (PROBE_DBL & 64) gemm_phase_mfma<EpiProj, DenseSched, 1>(F2, D, S, E2, 1.0f / (X8_SCALE * W8_SCALE)); }
        SEAM(pb + 0); }
    if (IN(pb + 1)) { const Frame F = fresh(F0); phase_mix1v2(F, l, (const bf16_t*)(F.ws_() + WS_XB)); if (PROBE_DBL & 8192) { const Frame G = fresh(F0); phase_mix1v2<false>(G, l, (const bf16_t*)(G.ws_() + WS_XB)); } SEAM(pb + 1); }
    if (IN(pb + 2)) { const Frame F = fresh(F0); phase_scan_mfma(F); if (PROBE_DBL & 2) { const Frame G = fresh(F0); phase_scan_mfma(G); } SEAM(pb + 2); }
    if (IN(pb + 3)) { const Frame F = fresh(F0); phase_chunk_mfma(F, l); if (PROBE_DBL & 4) { const Frame G = fresh(F0); phase_chunk_mfma(G, l); } SEAM(pb + 3); }
    if (IN(pb + 4)) { const Frame F = fresh(F0); unsigned char* ws = F.ws_();
        EpiBranch E{ws + WS_GATES, (bf16_t*)(ws + WS_MRG)}; gemm_dense_mfma(F, (const bf16_t*)(ws + WS_BR), (const bf16_t*)(ws + WS_WB + l * SZ_DD), T, D, D, E); if (PROBE_DBL & 128) gemm_dense_mfma(F, (const bf16_t*)(ws + WS_BR), (const bf16_t*)(ws + WS_WB + l * SZ_DD), T, D, D, E); SEAM(pb + 4); }
    if (IN(pb + 5)) { const Frame F = fresh(F0); unsigned char* ws = F.ws_();
        EpiResid E{(const bf16_t*)(ws + WS_XB), (bf16_t*)(ws + WS_Y)}; gemm_dense_mfma(F, (const bf16_t*)(ws + WS_MRG), (const bf16_t*)(ws + WS_WOUT + l * SZ_DD), T, D, D, E); if (PROBE_DBL & 256) gemm_dense_mfma(F, (const bf16_t*)(ws + WS_MRG), (const bf16_t*)(ws + WS_WOUT + l * SZ_DD), T, D, D, E); SEAM(pb + 5); }
    if (IN(pb + 6)) { const Frame F = fresh(F0); unsigned char* ws = F.ws_();
        phase_ln(F, (const bf16_t*)(ws + WS_Y), ((const float*)F.ka->in[IN_LNW]) + (size_t)l * 3 * D, ((const float*)F.ka->in[IN_LNB]) + (size_t)l * 3 * D, (bf16_t*)(ws + WS_XB)); if (PROBE_DBL & 1) { const Frame G = fresh(F0); unsigned char* wsg = G.ws_(); phase_ln(G, (const bf16_t*)(wsg + WS_Y), ((const float*)G.ka->in[IN_LNW]) + (size_t)l * 3 * D, ((const float*)G.ka->in[IN_LNB]) + (size_t)l * 3 * D, (bf16_t*)(wsg + WS_XB)); } SEAM(pb + 6); }
    if (IN(pb + 7)) { const Frame F = fresh(F0);
        EpiQKV E{}; QkvSched S; S.ws = F.ws_(); S.l = l; S.G = F.nwg; S.c = F.wg; gemm_phase_mfma(F, D, S, E); if (PROBE_DBL & 1024) gemm_phase_mfma(F, D, S, E); SEAM(pb + 7); }
    if (IN(pb + 8)) { const Frame F = fresh(F0); phase_attn_mfma(F, l); if (PROBE_DBL & 8) { const Frame G = fresh(F0); phase_attn_mfma(G, l); } SEAM(pb + 8); }
    if (IN(pb + 9)) { const Frame F = fresh(F0); unsigned char* ws = F.ws_();
        EpiResid E{(const bf16_t*)(ws + WS_XB), (bf16_t*)(ws + WS_Y)}; gemm_dense_mfma(F, (const bf16_t*)(ws + WS_O), (const bf16_t*)(ws + WS_WO + l * SZ_WQ), T, D, W, E); if (PROBE_DBL & 2048) gemm_dense_mfma(F, (const bf16_t*)(ws + WS_O), (const bf16_t*)(ws + WS_WO + l * SZ_WQ), T, D, W, E); SEAM(pb + 9); }
    if (IN(pb + 10)) { const Frame F = fresh(F0); unsigned char* ws = F.ws_(); phase_ln_router(F, l, (const bf16_t*)(ws + WS_Y), (bf16_t*)(ws + WS_XB)); SEAM(pb + 10); }
    if (IN(pb + 11)) { const Frame F = fresh(F0); phase_slots(F, l); if (PROBE_DBL & 16) { const Frame G = fresh(F0); phase_slots(G, l); } SEAM(pb + 11); }
    if (IN(pb + 12)) { const Frame F = fresh(F0); unsigned char* ws = F.ws_();
        LAS int* pst = (LAS int*)(F.lds + LDS_BYTES - 1024); build_pstart(F, l, pst);
        const int nrt = pst[NE + 1] >> 8; EpiSwiglu E{(const float*)(ws + WS_WSL), ws + WS_HB};
        MoeSched<4, true> S; S.ws = ws; S.pst = pst; S.l = l; S.G = F.nwg; S.c = F.wg; S.nunits = nrt * 4; gemm_phase_mfma<EpiSwiglu, MoeSched<4, true>, 1>(F, D, S, E, 1.0f / (X8_SCALE * W8_SCALE)); SEAM(pb + 12); }
    if (IN(pb + 13)) { const Frame F = fresh(F0); unsigned char* ws = F.ws_();
        LAS int* pst = (LAS int*)(F.lds + LDS_BYTES - 1024); build_pstart(F, l, pst);
        const int nrt = pst[NE + 1] >> 8; EpiDown E{ws + WS_YB};
        MoeSched<8, false> S; S.ws = ws; S.pst = pst; S.l = l; S.G = F.nwg; S.c = F.wg; S.nunits = nrt * 8; gemm_phase_mfma<EpiDown, MoeSched<8, false>, 1>(F, ED, S, E, Y8_SCALE / (H8_SCALE * W8_SCALE)); SEAM(pb + 13); }
    if (IN(pb + 14)) { const Frame F = fresh(F0); phase_combine_ln(F, l, (bf16_t*)(F.ws_() + WS_XB), l == DEPTH - 1 ? ((float*)F.ka->out) : (float*)nullptr); if ((PROBE_DBL & 16384) && l == DEPTH - 1) { const Frame G = fresh(F0); phase_combine_ln(G, l, (bf16_t*)(G.ws_() + WS_XB), ((float*)G.ka->out)); } SEAM(pb + 14); }
}

__global__ void __launch_bounds__(NTHR, 2) fwd(Args args_unused) {
    extern __shared__ __attribute__((aligned(16))) unsigned char lds_raw[];
    Frame F0; F0.lds = (LAS unsigned char*)lds_raw; F0.tid = threadIdx.x; F0.lane = F0.tid & 63; F0.wave = __builtin_amdgcn_readfirstlane(F0.tid >> 6); F0.wg = blockIdx.x; F0.nwg = gridDim.x;
    F0.ka = (KArgs)__builtin_amdgcn_kernarg_segment_ptr(); F0.wsg = F0.ka->ws;
    volatile LAS unsigned* xbw = (volatile LAS unsigned*)(F0.lds + LDS_BYTES - 16);
    if (F0.tid == 0) { xbw[0] = 0u; xbw[1] = 0u; }
    __syncthreads();
    XcdBarrier bar; bar.bar = (unsigned*)(F0.ws_() + WS_CTL); bar.x = 0; bar.st = xbw;
#if MK_PER_PHASE
    const int lo = F0.ka->ph_lo, hi = F0.ka->ph_hi;
    if (hi - lo > 1) bar = xcd_barrier_post((unsigned*)(F0.ws_() + WS_CTL), xbw);
#else
    const int lo = 0, hi = NPHASE;
    bar = xcd_barrier_post((unsigned*)(F0.ws_() + WS_CTL), xbw);
#endif
    if (IN(0)) { { const Frame F = fresh(F0); phase_wabs(F); } { XcdBarrier b2_ = bar; asm volatile("" : "+s"(b2_.bar)); asm volatile("" : "+s"(b2_.x)); xcd_barrier(b2_); }
        const Frame F = fresh(F0); phase_prologue(F); { const Frame G = fresh(F0); prologue_deferred(G, G.wg, G.nwg); } SEAM(0); }
    run_layer<0>(F0, bar, lo, hi);
    run_layer<1>(F0, bar, lo, hi);
#undef IN
#undef SEAM
}

extern "C" void kernel_launch(void* const* d_in, const int* in_sizes, int n_in, void* d_out, int out_size, void* d_ws, size_t ws_size, hipStream_t stream) {
    static int grid = 0;
    if (grid == 0) {
        if (n_in != 23 || ws_size < WS_END) { fprintf(stderr, "kernel_launch: unexpected inputs (n_in %d, ws %zu < %zu)\n", n_in, ws_size, (size_t)WS_END); grid = -1; return; }
        int dev = 0, cus = 0, per_cu = 0;
        if (hipGetDevice(&dev) != hipSuccess || hipDeviceGetAttribute(&cus, hipDeviceAttributeMultiprocessorCount, dev) != hipSuccess) { grid = -1; return; }
        if (hipFuncSetAttribute((const void*)fwd, hipFuncAttributeMaxDynamicSharedMemorySize, LDS_BYTES) != hipSuccess) { fprintf(stderr, "kernel_launch: hipFuncSetAttribute failed\n"); grid = -1; return; }
        if (hipOccupancyMaxActiveBlocksPerMultiprocessor(&per_cu, (const void*)fwd, NTHR, LDS_BYTES) != hipSuccess || per_cu < 1) { fprintf(stderr, "kernel_launch: occupancy query says %d\n", per_cu); }
        (void)hipGetLastError();
        grid = cus;
    }
    if (grid < 0) return;
    (void)hipMemsetAsync((char*)d_ws + WS_CTL, 0, CTL_BYTES, stream);
    Args a{};
    for (int i = 0; i < 23; ++i) a.in[i] = (const float*)d_in[i];
    a.out = (float*)d_out; a.ws = (unsigned char*)d_ws;
#if MK_PER_PHASE
    for (int p = 0; p < NPHASE; ++p) { a.ph_lo = p; a.ph_hi = p + 1; hipLaunchKernelGGL(fwd, dim3(grid), dim3(NTHR), LDS_BYTES, stream, a); }
#else
    a.ph_lo = 0; a.ph_hi = NPHASE;
    hipLaunchKernelGGL(fwd, dim3(grid), dim3(NTHR), LDS_BYTES, stream, a);
#endif
    const hipError_t le = hipPeekAtLastError();
    if (le != hipSuccess) fprintf(stderr, "kernel_launch: launch failed: %s\n", hipGetErrorName(le));
}
```

```cpp
#include <hip/hip_runtime.h>
#include <cstdio>
#include <cstdint>

#ifndef PROBE_DBL
#define PROBE_DBL 0
#endif
#ifndef MK_PER_PHASE
#define MK_PER_PHASE 0
#endif

typedef unsigned short bf16_t;
typedef float f32x4 __attribute__((ext_vector_type(4)));
typedef float f32x2 __attribute__((ext_vector_type(2)));
typedef unsigned u32x4 __attribute__((ext_vector_type(4)));
typedef unsigned u32x2 __attribute__((ext_vector_type(2)));
#define LAS __attribute__((address_space(3)))

constexpr int BATCH = 4, SEQ = 4096, T = BATCH * SEQ, D = 2048, DEPTH = 2;
constexpr int W = 512, NH = 4, HD = 128, CH = 64, NCH = SEQ / CH, NBH = BATCH * NH;
constexpr int PROJ_W = 14344, NBR = 6144, NPROJ = 14336;
constexpr int MEM = 256, TM = BATCH * MEM;
constexpr int NE = 64, NEX = 65, TOPK = 8, ED = 512;
constexpr int NSLOT = 164096;
constexpr float LN_EPS = 1e-5f, ALPHA = 1.41421356237f, ROUTE_SCALE = 2.5f;
constexpr int NTHR = 512;

constexpr int PC_U = 0, PC_CH = 512, PC_CB = 1024, PC_CC = 1536, PC_MQ = 2048, PC_MK = 2560, PC_MV = 3072, PC_MO = 3584, PC_RQ = 4096, PC_RK = 4608, PC_RV = 5120, PC_RG = 5632;

constexpr size_t al256(size_t x) { return (x + 255) & ~(size_t)255; }
constexpr size_t WS_CTL = 0;
constexpr size_t CTL_BYTES = 65536;
constexpr int CW_COUNTS = 8192;
constexpr size_t WS_WIN = WS_CTL + CTL_BYTES;
constexpr size_t SZ_WIN = (size_t)NPROJ * D * 2;
constexpr size_t WS_WIF = WS_WIN + DEPTH * SZ_WIN;
constexpr size_t SZ_WIF = 8 * D * 4;
constexpr size_t WS_WB = WS_WIF + DEPTH * SZ_WIF;
constexpr size_t SZ_DD = (size_t)D * D * 2;
constexpr size_t WS_WOUT = WS_WB + DEPTH * SZ_DD;
constexpr size_t WS_WQ = WS_WOUT + DEPTH * SZ_DD;
constexpr size_t SZ_WQ = (size_t)W * D * 2;
constexpr size_t WS_WK = WS_WQ + DEPTH * SZ_WQ;
constexpr size_t WS_WV = WS_WK + DEPTH * SZ_WQ;
constexpr size_t WS_WO = WS_WV + DEPTH * SZ_WQ;
constexpr size_t WS_WGU = WS_WO + DEPTH * SZ_WQ;
constexpr size_t SZ_WGU1 = (size_t)1024 * D * 2;
constexpr size_t WS_WDN = WS_WGU + (size_t)DEPTH * NEX * SZ_WGU1;
constexpr size_t SZ_WDN1 = (size_t)D * ED * 2;
constexpr size_t WS_ROPE = WS_WDN + (size_t)DEPTH * NEX * SZ_WDN1;
constexpr size_t WS_X = WS_ROPE + (size_t)SEQ * 64 * 4 * 2;
constexpr size_t SZ_TD4 = (size_t)T * D * 4;
constexpr size_t WS_Y = WS_X + SZ_TD4;
constexpr size_t WS_XB = WS_Y + SZ_TD4;
constexpr size_t SZ_TD2 = (size_t)T * D * 2;
constexpr size_t WS_MEMB = WS_XB + SZ_TD2;
constexpr size_t WS_KM = WS_MEMB + (size_t)TM * D * 2;
constexpr size_t WS_VM = WS_KM + (size_t)DEPTH * TM * W * 2;
constexpr size_t WS_PROJ = WS_VM + (size_t)DEPTH * TM * W * 2;
constexpr size_t WS_GATES = WS_PROJ + (size_t)T * NBR * 2;
constexpr size_t WS_CUMF = WS_GATES + (size_t)T * 8192 * 2;
constexpr size_t WS_IPRE = WS_CUMF + (size_t)NBH * SEQ * 4;
constexpr size_t WS_SUMM = WS_IPRE + (size_t)NBH * SEQ * 4;
constexpr size_t WS_CST = WS_SUMM + al256((size_t)NBH * NCH * 2 * 4);
constexpr size_t WS_NST = WS_CST + (size_t)2 * NBH * NCH * HD * HD * 2;
constexpr size_t WS_BR = WS_NST + (size_t)NBH * NCH * HD * 4;
constexpr size_t WS_MRG = WS_BR + SZ_TD2;
constexpr size_t WS_Q = WS_MRG + SZ_TD2;
constexpr size_t WS_O = WS_Q + (size_t)T * W * 2;
constexpr size_t WS_EID = WS_O + (size_t)T * W * 2;
constexpr size_t WS_EW = WS_EID + (size_t)T * 8 * 4;
constexpr size_t WS_EPOS = WS_EW + (size_t)T * 8 * 4;
constexpr size_t WS_SLOTOF = WS_EPOS + (size_t)T * 8 * 4;
constexpr size_t WS_TOK = WS_SLOTOF + (size_t)T * 8 * 4;
constexpr size_t WS_WSL = WS_TOK + al256((size_t)NSLOT * 4);
constexpr size_t WS_HB = WS_WSL + al256((size_t)NSLOT * 4);
constexpr size_t WS_YB = WS_HB + (size_t)NSLOT * ED * 2;
constexpr size_t WS_AV = WS_YB + (size_t)NSLOT * D * 2;
constexpr size_t WS_PM = WS_AV + (size_t)NBH * SEQ * 4;
constexpr size_t WS_MSEQ = WS_PM + (size_t)NBH * SEQ * 4;
constexpr size_t WS_XB8 = WS_MSEQ + al256((size_t)NBH * 80 * 4);
constexpr size_t WS_WGU8 = WS_XB8 + (size_t)T * D;
constexpr size_t SZ_WGU8 = (size_t)1024 * D;
constexpr size_t WS_WIN8 = WS_WGU8 + (size_t)DEPTH * NEX * SZ_WGU8;
constexpr size_t SZ_WIN8 = (size_t)NPROJ * D;
constexpr size_t WS_RWT = WS_WIN8 + DEPTH * SZ_WIN8;
constexpr size_t WS_XQ8 = WS_RWT + (size_t)DEPTH * 2 * NE * D * 2;
constexpr size_t WS_XSC = WS_XQ8 + (size_t)T * D;
constexpr size_t WS_WINQ = WS_XSC + al256((size_t)T * 4);
constexpr size_t SZ_WINQ = (size_t)NBR * D;
constexpr size_t WS_END = WS_WINQ + DEPTH * SZ_WINQ;
constexpr int CW_WABS = 8320;
constexpr float X8_SCALE = 16.0f, W8_SCALE = 256.0f, H8_SCALE = 8.0f, Y8_SCALE = 64.0f;

constexpr int LDS_BYTES = 147456;

__device__ __forceinline__ bf16_t f2bf(float f) { unsigned u = __float_as_uint(f); u += 0x7FFFu + ((u >> 16) & 1u); return (bf16_t)(u >> 16); }
__device__ __forceinline__ float bf2f(bf16_t b) { return __uint_as_float(((unsigned)b) << 16); }
__device__ __forceinline__ unsigned pack2(float lo, float hi) { unsigned r; asm("v_cvt_pk_bf16_f32 %0, %1, %2" : "=v"(r) : "v"(lo), "v"(hi)); return r; }
__device__ __forceinline__ float sigmoidf_(float x) { return __builtin_amdgcn_rcpf(1.0f + __builtin_amdgcn_exp2f(-1.4426950408889634f * x)); }
__device__ __forceinline__ unsigned pack_fp8x4(float a, float b, float c, float d) {
    a = __builtin_amdgcn_fmed3f(a, -448.f, 448.f); b = __builtin_amdgcn_fmed3f(b, -448.f, 448.f); c = __builtin_amdgcn_fmed3f(c, -448.f, 448.f); d = __builtin_amdgcn_fmed3f(d, -448.f, 448.f);
    int w = 0; w = __builtin_amdgcn_cvt_pk_fp8_f32(a, b, w, false); w = __builtin_amdgcn_cvt_pk_fp8_f32(c, d, w, true); return (unsigned)w; }
__device__ __forceinline__ unsigned pack_i8x4(float a, float b, float c, float d) {
    const int ia = (int)__builtin_amdgcn_fmed3f(rintf(a), -127.f, 127.f), ib = (int)__builtin_amdgcn_fmed3f(rintf(b), -127.f, 127.f), ic = (int)__builtin_amdgcn_fmed3f(rintf(c), -127.f, 127.f), id = (int)__builtin_amdgcn_fmed3f(rintf(d), -127.f, 127.f);
    return (unsigned)(ia & 255) | ((unsigned)(ib & 255) << 8) | ((unsigned)(ic & 255) << 16) | ((unsigned)(id & 255) << 24); }
__device__ __forceinline__ unsigned pack_u8x4(float a, float b, float c, float d) {
    return (unsigned)rintf(a) | ((unsigned)rintf(b) << 8) | ((unsigned)rintf(c) << 16) | ((unsigned)rintf(d) << 24); }
__device__ __forceinline__ void un8u(u32x2 w, f32x4& a, f32x4& b) { a[0] = (float)(w.x & 255u); a[1] = (float)((w.x >> 8) & 255u); a[2] = (float)((w.x >> 16) & 255u); a[3] = (float)(w.x >> 24);
    b[0] = (float)(w.y & 255u); b[1] = (float)((w.y >> 8) & 255u); b[2] = (float)((w.y >> 16) & 255u); b[3] = (float)(w.y >> 24); }
__device__ __forceinline__ float wave_sum(float v) { for (int o = 32; o >= 1; o >>= 1) v += __shfl_xor(v, o); return v; }
__device__ __forceinline__ float wave_max(float v) { for (int o = 32; o >= 1; o >>= 1) v = fmaxf(v, __shfl_xor(v, o)); return v; }

#define XB_TMO      128
#define XB_XCNT(j)  (256  + 64 * (j))
#define XB_XSUB(j)  (1280 + 64 * (j))
#define XB_XGEN(j)  (2304 + 64 * (j))
#define XB_TOP      3328
#define XB_TOPGEN   3392
#define XCD_BAR_WORDS 3456
#define XB_SPIN_CAP (1u << 27)
__device__ __forceinline__ unsigned xb_ld(unsigned* p)              { return __hip_atomic_load(p, __ATOMIC_RELAXED, __HIP_MEMORY_SCOPE_AGENT); }
__device__ __forceinline__ unsigned xb_add(unsigned* p, unsigned v) { return __hip_atomic_fetch_add(p, v, __ATOMIC_RELAXED, __HIP_MEMORY_SCOPE_AGENT); }
__device__ __forceinline__ unsigned xb_xcc_id() { return (unsigned)__builtin_amdgcn_s_getreg((3 << 11) | 20) & 0xFu; }
#define XB_SPIN(cond, bar) do { unsigned _sp = 0; while (cond) { __builtin_amdgcn_s_sleep(1); \
    if ((++_sp & 255u) == 0u) { if (xb_ld(&(bar)[XB_TMO])) break; if (_sp > XB_SPIN_CAP) { atomicAdd(&(bar)[XB_TMO], 1u); break; } } } } while (0)
struct XcdBarrier { unsigned* bar; unsigned x; volatile LAS unsigned* st; };
__device__ __forceinline__ XcdBarrier xcd_barrier_post(unsigned* bar, volatile LAS unsigned* st) {
    XcdBarrier b; b.bar = bar; b.x = xb_xcc_id(); b.st = st;
    if (threadIdx.x == 0) (void)xb_add(&bar[XB_XCNT(b.x)], 1u);
    return b;
}
__device__ __forceinline__ void xcd_barrier_complete(unsigned* bar, unsigned x, unsigned& nloc, unsigned& nx) {
    const unsigned G = gridDim.x * gridDim.y * gridDim.z;
    unsigned sum, cnt, mine, sp = 0u;
    for (;;) {
        sum = 0u; cnt = 0u; mine = 0u;
#pragma unroll
        for (unsigned j = 0; j < 16; ++j) { const unsigned c = xb_ld(&bar[XB_XCNT(j)]); sum += c; cnt += (c > 0u) ? 1u : 0u; mine = (j == x) ? c : mine; }
        if (sum == G) break;
        __builtin_amdgcn_s_sleep(1);
        if ((++sp & 255u) == 0u) { if (xb_ld(&bar[XB_TMO])) break; if (sp > XB_SPIN_CAP) { atomicAdd(&bar[XB_TMO], 1u); break; } }
    }
    nloc = mine > 0u ? mine : 1u; nx = cnt > 0u ? cnt : 1u;
}
__device__ __forceinline__ void xcd_barrier(const XcdBarrier& b) {
    asm volatile("s_waitcnt vmcnt(0)" ::: "memory");
    __syncthreads();
    if (threadIdx.x == 0) {
        unsigned* bar = b.bar;
        __builtin_amdgcn_s_waitcnt(0);
        unsigned nloc = b.st[0], nx = b.st[1];
        if (nloc == 0u) { xcd_barrier_complete(bar, b.x, nloc, nx); b.st[0] = nloc; b.st[1] = nx; }
        const unsigned old = xb_add(&bar[XB_XSUB(b.x)], 1u);
        const unsigned gen = old / nloc;
        if (old + 1u == (gen + 1u) * nloc) {
            __builtin_amdgcn_fence(__ATOMIC_RELEASE, "agent");
            asm volatile("s_waitcnt vmcnt(0)" ::: "memory");
            const unsigned og = xb_add(&bar[XB_TOP], 1u);
            const unsigned tg = og / nx;
            if (og + 1u == (tg + 1u) * nx) xb_add(&bar[XB_TOPGEN], 1u);
            else XB_SPIN(xb_ld(&bar[XB_TOPGEN]) == tg, bar);
            __builtin_amdgcn_fence(__ATOMIC_ACQUIRE, "agent");
            xb_add(&bar[XB_XGEN(b.x)], 1u);
            asm volatile("s_waitcnt vmcnt(0)" ::: "memory");
        } else {
            XB_SPIN(xb_ld(&bar[XB_XGEN(b.x)]) == gen, bar);
            __builtin_amdgcn_fence(__ATOMIC_ACQUIRE, "agent");
            asm volatile("s_waitcnt vmcnt(0)" ::: "memory");
        }
    }
    __syncthreads();
}

struct Args { const float* in[23]; float* out; unsigned char* ws; int ph_lo, ph_hi; };
enum { IN_X = 0, IN_MEM, IN_WIN, IN_GATEB, IN_POOLW, IN_POOLS, IN_CONVW, IN_MNORM, IN_RNORM, IN_WBR, IN_WMIX, IN_WQ, IN_WK, IN_WV, IN_WO, IN_RW, IN_RB, IN_WGU, IN_WDN, IN_SGU, IN_SDN, IN_LNW, IN_LNB };

#define GAS __attribute__((address_space(1)))
struct DArgs { const GAS float* in[23]; GAS float* out; GAS unsigned char* ws; int ph_lo, ph_hi; };
typedef const __attribute__((address_space(4))) DArgs* KArgs;
struct Frame {
    LAS unsigned char* lds; int tid, lane, wave, wg, nwg;
    GAS unsigned char* wsg; KArgs ka;
    __device__ __forceinline__ unsigned char* ws_() const { return (unsigned char*)wsg; }
};
__device__ __forceinline__ Frame fresh(const Frame& F) { Frame G = F; asm volatile("" : "+s"(G.wsg)); asm volatile("" : "+s"(G.ka)); asm volatile("" : "+v"(G.tid)); asm volatile("" : "+s"(G.wg));
    G.lane = G.tid & 63; G.wave = __builtin_amdgcn_readfirstlane(G.tid >> 6); return G; }

struct GUnit {
    const bf16_t* Bt;
    const bf16_t* A;
    const int* gather;
    int row0;
    int pn;
    int e;
    bf16_t* dst;
};

__device__ __forceinline__ void un8(u32x4 w, f32x4& a, f32x4& b) { a[0] = __uint_as_float(w[0] << 16); a[1] = __uint_as_float(w[0] & 0xffff0000u); a[2] = __uint_as_float(w[1] << 16); a[3] = __uint_as_float(w[1] & 0xffff0000u);
    b[0] = __uint_as_float(w[2] << 16); b[1] = __uint_as_float(w[2] & 0xffff0000u); b[2] = __uint_as_float(w[3] << 16); b[3] = __uint_as_float(w[3] & 0xffff0000u); }
__device__ __forceinline__ void st_bf16x8(bf16_t* p, f32x4 a, f32x4 b) { u32x4 w; w[0] = pack2(a[0], a[1]); w[1] = pack2(a[2], a[3]); w[2] = pack2(b[0], b[1]); w[3] = pack2(b[2], b[3]); *(u32x4*)p = w; }
__device__ __forceinline__ void st_bf16x4(bf16_t* p, f32x4 v) { u32x2 w; w.x = pack2(v[0], v[1]); w.y = pack2(v[2], v[3]); *(u32x2*)p = w; }
__device__ __forceinline__ void ld_row32(const bf16_t* row, int lane, float (&v)[32]) {
#pragma unroll
    for (int j = 0; j < 4; ++j) { const u32x4 w = *(const u32x4*)(row + j * 512 + lane * 8);
#pragma unroll
        for (int e = 0; e < 4; ++e) { v[j * 8 + 2 * e] = __uint_as_float(w[e] << 16); v[j * 8 + 2 * e + 1] = __uint_as_float(w[e] & 0xffff0000u); } } }
__device__ __forceinline__ void st_row32(bf16_t* row, int lane, const float (&v)[32]) {
#pragma unroll
    for (int j = 0; j < 4; ++j) { u32x4 w;
#pragma unroll
        for (int e = 0; e < 4; ++e) w[e] = pack2(v[j * 8 + 2 * e], v[j * 8 + 2 * e + 1]);
        *(u32x4*)(row + j * 512 + lane * 8) = w; } }
__device__ __forceinline__ void st_row32_i8(unsigned char* row, float* sc, int lane, const float (&v)[32]) {
    float am = 0.f;
#pragma unroll
    for (int j = 0; j < 32; ++j) am = fmaxf(am, fabsf(v[j]));
    am = fmaxf(wave_max(am), 1e-30f); const float q = 127.0f / am;
#pragma unroll
    for (int j = 0; j < 4; ++j) { u32x2 w; w.x = pack_i8x4(v[j * 8] * q, v[j * 8 + 1] * q, v[j * 8 + 2] * q, v[j * 8 + 3] * q); w.y = pack_i8x4(v[j * 8 + 4] * q, v[j * 8 + 5] * q, v[j * 8 + 6] * q, v[j * 8 + 7] * q);
        *(u32x2*)(row + j * 512 + lane * 8) = w; }
    if (lane == 0) *sc = am * (1.0f / 127.0f); }
__device__ __forceinline__ void st_row32_fp8(unsigned char* row, int lane, const float (&v)[32]) {
#pragma unroll
    for (int j = 0; j < 4; ++j) { u32x2 w; w.x = pack_fp8x4(v[j * 8] * X8_SCALE, v[j * 8 + 1] * X8_SCALE, v[j * 8 + 2] * X8_SCALE, v[j * 8 + 3] * X8_SCALE); w.y = pack_fp8x4(v[j * 8 + 4] * X8_SCALE, v[j * 8 + 5] * X8_SCALE, v[j * 8 + 6] * X8_SCALE, v[j * 8 + 7] * X8_SCALE);
        *(u32x2*)(row + j * 512 + lane * 8) = w; } }
struct NoPre { };
struct EpiProj {
    static constexpr bool PAIR_M = false; static constexpr bool SEG = false; typedef NoPre Pre;
    bf16_t* proj; bf16_t* gates;
    static __device__ __forceinline__ float unit_scale(const GUnit& u) { return (u.pn == PC_MK / 256 || u.pn == PC_MK / 256 + 1 || u.pn == PC_RK / 256 || u.pn == PC_RK / 256 + 1) ? 0.08838834764831845f : 1.0f; }
    __device__ __forceinline__ void pre(const GUnit&, int, int, Pre&) const {}
    __device__ __forceinline__ void fin(const GUnit& u, int r, int c, const f32x4 (&a)[2][2], const Pre&) const {
        const int col = u.pn * 256 + c; const size_t row = (size_t)(u.row0 + r);
        if (col < NBR) { st_bf16x8(proj + row * NBR + col, a[0][0], a[0][1]); st_bf16x8(proj + row * NBR + col + 128, a[1][0], a[1][1]); }
        else { f32x4 s[2][2];
#pragma unroll
            for (int h = 0; h < 2; ++h)
#pragma unroll
                for (int n = 0; n < 2; ++n)
#pragma unroll
                    for (int j = 0; j < 4; ++j) s[h][n][j] = __builtin_amdgcn_fmed3f(sigmoidf_(a[h][n][j]) * 255.0f, 1.0f, 255.0f);
            u32x2 w0, w1; w0.x = pack_u8x4(s[0][0][0], s[0][0][1], s[0][0][2], s[0][0][3]); w0.y = pack_u8x4(s[0][1][0], s[0][1][1], s[0][1][2], s[0][1][3]);
            w1.x = pack_u8x4(s[1][0][0], s[1][0][1], s[1][0][2], s[1][0][3]); w1.y = pack_u8x4(s[1][1][0], s[1][1][1], s[1][1][2], s[1][1][3]);
            { const auto rx = __builtin_amdgcn_permlane32_swap(w0.x, w1.x, false, false); w0.x = rx[0]; w1.x = rx[1]; const auto ry = __builtin_amdgcn_permlane32_swap(w0.y, w1.y, false, false); w0.y = ry[0]; w1.y = ry[1]; }
            const bool up = (threadIdx.x & 32u) != 0u; const int gc = col - NBR;
            unsigned char* gp = (unsigned char*)gates + row * 8192 + (up ? gc + 128 - 8 : gc);
            u32x4 w; w[0] = w0.x; w[1] = w0.y; w[2] = w1.x; w[3] = w1.y; *(u32x4*)gp = w; }
    }
};
struct EpiBranch {
    static constexpr bool PAIR_M = false; static constexpr bool SEG = true;
    struct Pre { u32x2 g0, g1; };
    struct SPre { u32x2 a0, a1, b0, b1; };
    const unsigned char* gates; bf16_t* out;
    __device__ __forceinline__ void pre(const GUnit& u, int r, int c, Pre& p) const { const unsigned char* g = gates + (size_t)(u.row0 + r) * 8192 + 3 * 2048 + u.pn * 256 + c; p.g0 = *(const u32x2*)g; p.g1 = *(const u32x2*)(g + 128); }
    __device__ __forceinline__ void fin(const GUnit& u, int r, int c, const f32x4 (&a)[2][2], const Pre& p) const {
        f32x4 x0, x1, y0, y1; un8u(p.g0, x0, x1); un8u(p.g1, y0, y1); const float k = 1.0f / 255.0f;
        bf16_t* o = out + (size_t)(u.row0 + r) * D + u.pn * 256 + c; st_bf16x8(o, a[0][0] * x0 * k, a[0][1] * x1 * k); st_bf16x8(o + 128, a[1][0] * y0 * k, a[1][1] * y1 * k); }
    __device__ __forceinline__ void seg_pre(const GUnit& u, int r, int c, int s, SPre& p) const { const unsigned char* g = gates + (size_t)(u.row0 + r) * 8192 + s * 2048 + u.pn * 256 + c;
        p.a0 = *(const u32x2*)g; p.a1 = *(const u32x2*)(g + 128); p.b0 = *(const u32x2*)(g + 2048); p.b1 = *(const u32x2*)(g + 2048 + 128); }
    __device__ __forceinline__ void seg_fin(f32x4 (&h0)[2], f32x4 (&h1)[2], const SPre& p) const {
        f32x4 a0, a1, b0, b1; un8u(p.a0, a0, a1); un8u(p.b0, b0, b1);
#pragma unroll
        for (int j = 0; j < 4; ++j) { h0[0][j] *= a0[j] * __builtin_amdgcn_rcpf(b0[j]); h0[1][j] *= a1[j] * __builtin_amdgcn_rcpf(b1[j]); }
        un8u(p.a1, a0, a1); un8u(p.b1, b0, b1);
#pragma unroll
        for (int j = 0; j < 4; ++j) { h1[0][j] *= a0[j] * __builtin_amdgcn_rcpf(b0[j]); h1[1][j] *= a1[j] * __builtin_amdgcn_rcpf(b1[j]); }
    }
};
struct EpiResid {
    static constexpr bool PAIR_M = false; static constexpr bool SEG = false;
    struct Pre { u32x4 x0, x1; };
    const bf16_t* x; bf16_t* y;
    __device__ __forceinline__ void pre(const GUnit& u, int r, int c, Pre& p) const { const bf16_t* xp = x + (size_t)(u.row0 + r) * D + u.pn * 256 + c; p.x0 = *(const u32x4*)xp; p.x1 = *(const u32x4*)(xp + 128); }
    __device__ __forceinline__ void fin(const GUnit& u, int r, int c, const f32x4 (&a)[2][2], const Pre& p) const {
        f32x4 x0, x1, y0, y1; un8(p.x0, x0, x1); un8(p.x1, y0, y1);
        bf16_t* o = y + (size_t)(u.row0 + r) * D + u.pn * 256 + c; st_bf16x8(o, x0 * ALPHA + a[0][0], x1 * ALPHA + a[0][1]); st_bf16x8(o + 128, y0 * ALPHA + a[1][0], y1 * ALPHA + a[1][1]); }
};
struct EpiQKV {
    static constexpr bool PAIR_M = false; static constexpr bool SEG = false; typedef NoPre Pre; int pad_;
    __device__ __forceinline__ void pre(const GUnit&, int, int, Pre&) const {}
    __device__ __forceinline__ void fin(const GUnit& u, int r, int c, const f32x4 (&a)[2][2], const Pre&) const {
        bf16_t* o = u.dst + (size_t)(u.row0 + r) * W + u.pn * 256 + c; st_bf16x8(o, a[0][0], a[0][1]); st_bf16x8(o + 128, a[1][0], a[1][1]); }
};
struct EpiSwiglu {
    static constexpr bool SEG = false; static constexpr bool PAIR_M = true;
    struct Pre { float w; };
    const float* wsl; unsigned char* hb;
    __device__ __forceinline__ void pre(const GUnit& u, int r, int, Pre& p) const { p.w = wsl[u.row0 + r] * H8_SCALE; }
    __device__ __forceinline__ u32x2 act(const f32x4 (&a)[2][2], float w) const { f32x4 o[2];
#pragma unroll
        for (int n = 0; n < 2; ++n)
#pragma unroll
            for (int j = 0; j < 4; ++j) o[n][j] = a[0][n][j] * sigmoidf_(a[0][n][j]) * a[1][n][j] * w;
        u32x2 w8; w8.x = pack_fp8x4(o[0][0], o[0][1], o[0][2], o[0][3]); w8.y = pack_fp8x4(o[1][0], o[1][1], o[1][2], o[1][3]); return w8; }
    __device__ __forceinline__ void fin2(const GUnit& u, int r0, int r1, int c, const f32x4 (&a0)[2][2], const f32x4 (&a1)[2][2], const Pre& p0, const Pre& p1) const {
        u32x2 v0 = act(a0, p0.w), v1 = act(a1, p1.w);
        { const auto rx = __builtin_amdgcn_permlane32_swap(v0.x, v1.x, false, false); v0.x = rx[0]; v1.x = rx[1]; const auto ry = __builtin_amdgcn_permlane32_swap(v0.y, v1.y, false, false); v0.y = ry[0]; v1.y = ry[1]; }
        const bool up = (threadIdx.x & 32u) != 0u;
        unsigned char* o = hb + (size_t)(u.row0 + (up ? r1 : r0)) * ED + u.pn * 128 + (up ? c - 8 : c);
        u32x4 w; w[0] = v0.x; w[1] = v0.y; w[2] = v1.x; w[3] = v1.y; *(u32x4*)o = w; }
    __device__ __forceinline__ void fin(const GUnit&, int, int, const f32x4 (&)[2][2], const Pre&) const {}
};
struct EpiDown {
    static constexpr bool PAIR_M = false; static constexpr bool SEG = false; typedef NoPre Pre;
    unsigned char* yb;
    __device__ __forceinline__ void pre(const GUnit&, int, int, Pre&) const {}
    __device__ __forceinline__ void fin(const GUnit& u, int r, int c, const f32x4 (&a)[2][2], const Pre&) const {
        u32x2 w0, w1; w0.x = pack_fp8x4(a[0][0][0], a[0][0][1], a[0][0][2], a[0][0][3]); w0.y = pack_fp8x4(a[0][1][0], a[0][1][1], a[0][1][2], a[0][1][3]);
        w1.x = pack_fp8x4(a[1][0][0], a[1][0][1], a[1][0][2], a[1][0][3]); w1.y = pack_fp8x4(a[1][1][0], a[1][1][1], a[1][1][2], a[1][1][3]);
        { const auto rx = __builtin_amdgcn_permlane32_swap(w0.x, w1.x, false, false); w0.x = rx[0]; w1.x = rx[1]; const auto ry = __builtin_amdgcn_permlane32_swap(w0.y, w1.y, false, false); w0.y = ry[0]; w1.y = ry[1]; }
        const bool up = (threadIdx.x & 32u) != 0u;
        unsigned char* o = yb + (size_t)(u.row0 + r) * D + u.pn * 256 + (up ? 128 + c - 8 : c);
        u32x4 w; w[0] = w0.x; w[1] = w0.y; w[2] = w1.x; w[3] = w1.y; *(u32x4*)o = w; }
};

typedef short bf16x8 __attribute__((ext_vector_type(8)));
typedef short s16x4 __attribute__((ext_vector_type(4)));
__device__ __forceinline__ s16x4 lds_tr(const LAS bf16_t* p) { return __builtin_amdgcn_ds_read_tr16_b64_v4i16((LAS s16x4*)p); }
__device__ __forceinline__ bf16x8 cat4(s16x4 a, s16x4 b) { bf16x8 r; r[0] = a[0]; r[1] = a[1]; r[2] = a[2]; r[3] = a[3]; r[4] = b[0]; r[5] = b[1]; r[6] = b[2]; r[7] = b[3]; return r; }
__device__ __forceinline__ bf16x8 pack8(f32x4 a, f32x4 b) { union { u32x4 u; bf16x8 h; } c; c.u[0] = pack2(a[0], a[1]); c.u[1] = pack2(a[2], a[3]); c.u[2] = pack2(b[0], b[1]); c.u[3] = pack2(b[2], b[3]); return c.h; }
constexpr int BK = 64, HTB = 128 * BK * 2;
__device__ __forceinline__ int lds_byte(int r, int c) { const int st = (r >> 4) * 2 + (c >> 5), rr = r & 15, cc = c & 31, ob = rr * 64 + cc * 2; return st * 1024 + (ob ^ (((ob >> 9) & 1) << 5)); }
__device__ __forceinline__ void stage_rc(int b, int& R, int& C) { const int st = b / 1024, sb = b % 1024, swz = sb ^ (((sb >> 9) & 1) << 5); R = (st >> 1) * 16 + swz / 64; C = (st & 1) * 32 + (swz % 64) / 2; }

typedef int i32x8 __attribute__((ext_vector_type(8)));
typedef int i32x4 __attribute__((ext_vector_type(4)));
template <class Epi, class Sched, int MODE = 0>
__device__ __forceinline__ void gemm_phase_mfma(const Frame& F, const int K, const Sched& S, const Epi& E, const float oscale = 1.0f, const float* rowscale = nullptr) {
    constexpr bool FP8 = (MODE == 1), I8 = (MODE == 2);
    LAS unsigned char* lds = F.lds;
    const int tid = F.tid, wid = F.wave, lane = F.lane, wr = wid >> 2, wc = wid & 3, fr = lane & 15, fq = lane >> 4;
    const int KB = MODE ? K : 2 * K;
    const int nt = KB / 128;
    unsigned voffB[2];
#pragma unroll
    for (int i = 0; i < 2; ++i) { int R, C; stage_rc(tid * 16 + i * 8192, R, C); const int rho = R & 31, q4 = (rho & 15) >> 2, Rb = (R & ~31) + 8 * (((q4 & 1) << 1) | (q4 >> 1)) + 4 * (rho >> 4) + (rho & 3); voffB[i] = (unsigned)(Rb * KB + C * 2); }
    const size_t kstep = (size_t)(BK * 2);
    const size_t hstepB = (size_t)128 * KB;
    const unsigned ldsw = (unsigned)wid * 1024u;
    const int aoff = FP8 ? lds_byte(wr * 64 + fr, fq * 16) : lds_byte(wr * 64 + fr, fq * 8), boff = FP8 ? lds_byte(wc * 32 + fr, fq * 16) : lds_byte(wc * 32 + fr, fq * 8);
#define SA_(b, h) (((b) * 2 + (h)) * HTB)
#define SB_(b, h) ((4 + (b) * 2 + (h)) * HTB)
#define STAGE_(bufoff, gbase, voff) do { _Pragma("unroll") for (int _i = 0; _i < 2; ++_i) \
        __builtin_amdgcn_global_load_lds((const unsigned*)((const char*)(gbase) + (voff)[_i]), (LAS unsigned*)(lds + (bufoff) + ldsw + _i * 8192), 16, 0, 0); } while (0)
#define LDA_(dst, b, h) do { _Pragma("unroll") for (int m = 0; m < 4; ++m) { if constexpr (FP8) { const i32x4 _lo = *(const LAS i32x4*)(lds + SA_(b, h) + aoff + m * 2048), _hi = *(const LAS i32x4*)(lds + SA_(b, h) + aoff + m * 2048 + 16); \
            dst##8[m] = __builtin_shufflevector(_lo, _hi, 0, 1, 2, 3, 4, 5, 6, 7); } \
        else { _Pragma("unroll") for (int k = 0; k < 2; ++k) dst[m][k] = *(const LAS bf16x8*)(lds + SA_(b, h) + aoff + m * 2048 + k * 1024); } } } while (0)
#define LDB_(dst, b, h) do { _Pragma("unroll") for (int n = 0; n < 2; ++n) { if constexpr (FP8) { const i32x4 _lo = *(const LAS i32x4*)(lds + SB_(b, h) + boff + n * 2048), _hi = *(const LAS i32x4*)(lds + SB_(b, h) + boff + n * 2048 + 16); \
            dst##8[n] = __builtin_shufflevector(_lo, _hi, 0, 1, 2, 3, 4, 5, 6, 7); } \
        else { _Pragma("unroll") for (int k = 0; k < 2; ++k) dst[n][k] = *(const LAS bf16x8*)(lds + SB_(b, h) + boff + n * 2048 + k * 1024); } } } while (0)
#define MMA_(ai, bj, At, Bt) do { __builtin_amdgcn_s_setprio(1); _Pragma("unroll") for (int m = 0; m < 4; ++m) _Pragma("unroll") for (int n = 0; n < 2; ++n) { \
        if constexpr (FP8) asm volatile("v_mfma_scale_f32_16x16x128_f8f6f4 %0, %1, %2, %0, %3, %3 op_sel_hi:[0,0,0]" : "+v"(acc[ai][bj][m][n]) : "v"(Bt##8[n]), "v"(At##8[m]), "v"(sc8)); \
        else if constexpr (I8) { _Pragma("unroll") for (int k = 0; k < 2; ++k) acci[ai][bj][m][n] = __builtin_amdgcn_mfma_i32_16x16x64_i8(__builtin_bit_cast(i32x4, Bt[n][k]), __builtin_bit_cast(i32x4, At[m][k]), acci[ai][bj][m][n], 0, 0, 0); } \
        else { _Pragma("unroll") for (int k = 0; k < 2; ++k) acc[ai][bj][m][n] = __builtin_amdgcn_mfma_f32_16x16x32_bf16(Bt[n][k], At[m][k], acc[ai][bj][m][n], 0, 0, 0); } } \
        __builtin_amdgcn_s_setprio(0); } while (0)
#define WAIT_V_(n) asm volatile("s_waitcnt vmcnt(" #n ")" ::: "memory")
#define WAIT_L_(n) asm volatile("s_waitcnt lgkmcnt(" #n ")" ::: "memory")
#define BAR_ __builtin_amdgcn_s_barrier()
#define SCHED_ __builtin_amdgcn_sched_barrier(0)
#define VOFFS_(dst, u) do { int _tz = tid; asm volatile("" : "+v"(_tz)); _Pragma("unroll") for (int _i = 0; _i < 2; ++_i) { int _R, _C; stage_rc(_tz * 16 + _i * 8192, _R, _C); \
        _Pragma("unroll") for (int _h = 0; _h < 2; ++_h) { const int _r = _h * 128 + _R; \
        const unsigned _row = (u).gather ? (unsigned)(u).gather[_r] : (unsigned)((u).row0 + _r); dst[_h][_i] = _row * (unsigned)KB + (unsigned)_C * 2u; } } } while (0)
    GUnit cur, nxt; int ui = 0;
    if (!S.get(0, cur)) return;
    f32x4 acc[2][2][4][2]; i32x4 acci[2][2][4][2];
#pragma unroll
    for (int a = 0; a < 2; ++a)
#pragma unroll
        for (int b = 0; b < 2; ++b)
#pragma unroll
            for (int m = 0; m < 4; ++m)
#pragma unroll
                for (int n = 0; n < 2; ++n) { acc[a][b][m][n] = (f32x4){0.f, 0.f, 0.f, 0.f}; acci[a][b][m][n] = (i32x4){0, 0, 0, 0}; }
    bf16x8 At[4][2], B0[2][2], B1[2][2]; i32x8 At8[4], B08[2], B18[2];
    int sc8 = 0x7f7f7f7f; asm volatile("" : "+v"(sc8));
    unsigned vA[2][2], vN[2][2];
    VOFFS_(vA, cur);
    const char* cA = (const char*)cur.A; const char* cB = (const char*)cur.Bt;
    STAGE_(SB_(0, 0), cB, voffB); STAGE_(SA_(0, 0), cA, vA[0]); STAGE_(SB_(0, 1), cB + hstepB, voffB); STAGE_(SA_(0, 1), cA, vA[1]);
    if (wr == 1) BAR_;
    WAIT_V_(4); BAR_;
    STAGE_(SB_(1, 0), cB + kstep, voffB); STAGE_(SA_(1, 0), cA + kstep, vA[0]); STAGE_(SB_(1, 1), cB + hstepB + kstep, voffB);
    WAIT_V_(6); BAR_;
    for (;;) {
        const bool has_next = S.get(ui + 1, nxt);
        const char* nA = has_next ? (const char*)nxt.A : cA; const char* nB = has_next ? (const char*)nxt.Bt : cB;
        if (has_next) { VOFFS_(vN, nxt); }
        for (int t = 0; t < nt; t += 2) {
            const bool last = (t == nt - 2);
            if constexpr (Epi::SEG) { if (t > 0 && (t & 7) == 0) {
                int tz = tid; asm volatile("" : "+v"(tz)); const int er = ((tz >> 8) & 1) * 64 + (tz & 15), ec = ((tz >> 6) & 3) * 32 + ((((tz >> 4) & 1) << 1) | ((tz >> 5) & 1)) * 8;
#pragma unroll
                for (int ai = 0; ai < 2; ++ai) { typename Epi::SPre sp[4];
#pragma unroll
                    for (int m = 0; m < 4; ++m) E.seg_pre(cur, ai * 128 + m * 16 + er, ec, (t >> 3) - 1, sp[m]);
#pragma unroll
                    for (int m = 0; m < 4; ++m) E.seg_fin(acc[ai][0][m], acc[ai][1][m], sp[m]);
                    asm volatile("" ::: "memory"); }
            } }
            const char* a1 = cA + (size_t)(t + 1) * kstep;
            const char* a2 = last ? nA : cA + (size_t)(t + 2) * kstep; const char* b2 = last ? nB : cB + (size_t)(t + 2) * kstep;
            const char* a3 = a2 + kstep; const char* b3 = b2 + kstep;
            unsigned w0[2], w1[2];
#pragma unroll
            for (int i = 0; i < 2; ++i) { w0[i] = (last && has_next) ? vN[0][i] : vA[0][i]; w1[i] = (last && has_next) ? vN[1][i] : vA[1][i]; }
            LDB_(B0, 0, 0); SCHED_; LDA_(At, 0, 0); STAGE_(SA_(1, 1), a1, vA[1]);
            WAIT_L_(8); BAR_; WAIT_L_(0); MMA_(0, 0, At, B0); BAR_; SCHED_;
            LDB_(B1, 0, 1); STAGE_(SB_(0, 0), b2, voffB);
            BAR_; WAIT_L_(0); MMA_(0, 1, At, B1); BAR_;
            LDA_(At, 0, 1); STAGE_(SA_(0, 0), a2, w0);
            BAR_; WAIT_L_(0); MMA_(1, 0, At, B0); BAR_; SCHED_;
            STAGE_(SB_(0, 1), b2 + hstepB, voffB);
            WAIT_V_(6); BAR_; MMA_(1, 1, At, B1); BAR_;
            LDB_(B0, 1, 0); SCHED_; LDA_(At, 1, 0); STAGE_(SA_(0, 1), a2, w1);
            WAIT_L_(8); BAR_; WAIT_L_(0); MMA_(0, 0, At, B0); BAR_; SCHED_;
            LDB_(B1, 1, 1); STAGE_(SB_(1, 0), b3, voffB);
            BAR_; WAIT_L_(0); MMA_(0, 1, At, B1); BAR_;
            LDA_(At, 1, 1); STAGE_(SA_(1, 0), a3, w0);
            BAR_; WAIT_L_(0); MMA_(1, 0, At, B0); BAR_; SCHED_;
            STAGE_(SB_(1, 1), b3 + hstepB, voffB);
            WAIT_V_(6); BAR_; MMA_(1, 1, At, B1); BAR_;
        }
        { int tz = tid; asm volatile("" : "+v"(tz)); const int er = ((tz >> 8) & 1) * 64 + (tz & 15), ec = ((tz >> 6) & 3) * 32 + ((((tz >> 4) & 1) << 1) | ((tz >> 5) & 1)) * 8;
          typename Epi::Pre pre[2][4];
#pragma unroll
          for (int ai = 0; ai < 2; ++ai)
#pragma unroll
              for (int m = 0; m < 4; ++m) E.pre(cur, ai * 128 + m * 16 + er, ec, pre[ai][m]);
          if constexpr (I8) {
#pragma unroll
              for (int ai = 0; ai < 2; ++ai)
#pragma unroll
                  for (int m = 0; m < 4; ++m) { const float rs = rowscale[cur.row0 + ai * 128 + m * 16 + er] * oscale * Epi::unit_scale(cur);
#pragma unroll
                      for (int bj = 0; bj < 2; ++bj)
#pragma unroll
                          for (int n = 0; n < 2; ++n)
#pragma unroll
                              for (int j = 0; j < 4; ++j) acc[ai][bj][m][n][j] = (float)acci[ai][bj][m][n][j] * rs; } }
          if constexpr (FP8) {
#pragma unroll
              for (int ai = 0; ai < 2; ++ai)
#pragma unroll
                  for (int bj = 0; bj < 2; ++bj)
#pragma unroll
                      for (int m = 0; m < 4; ++m)
#pragma unroll
                          for (int n = 0; n < 2; ++n) acc[ai][bj][m][n] *= oscale; }
          if constexpr (Epi::PAIR_M) {
#pragma unroll
          for (int ai = 0; ai < 2; ++ai)
#pragma unroll
              for (int m = 0; m < 4; m += 2) { const f32x4 a4[2][2] = {{acc[ai][0][m][0], acc[ai][0][m][1]}, {acc[ai][1][m][0], acc[ai][1][m][1]}}; const f32x4 b4[2][2] = {{acc[ai][0][m + 1][0], acc[ai][0][m + 1][1]}, {acc[ai][1][m + 1][0], acc[ai][1][m + 1][1]}};
                  E.fin2(cur, ai * 128 + m * 16 + er, ai * 128 + (m + 1) * 16 + er, ec, a4, b4, pre[ai][m], pre[ai][m + 1]); }
          } else {
#pragma unroll
          for (int ai = 0; ai < 2; ++ai)
#pragma unroll
              for (int m = 0; m < 4; ++m) { const f32x4 a4[2][2] = {{acc[ai][0][m][0], acc[ai][0][m][1]}, {acc[ai][1][m][0], acc[ai][1][m][1]}}; E.fin(cur, ai * 128 + m * 16 + er, ec, a4, pre[ai][m]); } } }
        if (!has_next) break;
#pragma unroll
        for (int a = 0; a < 2; ++a)
#pragma unroll
            for (int b = 0; b < 2; ++b)
#pragma unroll
                for (int m = 0; m < 4; ++m)
#pragma unroll
                    for (int n = 0; n < 2; ++n) { acc[a][b][m][n] = (f32x4){0.f, 0.f, 0.f, 0.f}; acci[a][b][m][n] = (i32x4){0, 0, 0, 0}; }
        cur = nxt; cA = nA; cB = nB; ++ui;
#pragma unroll
        for (int h = 0; h < 2; ++h)
#pragma unroll
            for (int i = 0; i < 2; ++i) vA[h][i] = vN[h][i];
    }
    WAIT_V_(0);
    if (wr == 0) BAR_;
    BAR_;
#undef SA_
#undef SB_
#undef STAGE_
#undef LDA_
#undef LDB_
#undef MMA_
#undef WAIT_V_
#undef WAIT_L_
#undef BAR_
#undef SCHED_
#undef VOFFS_
}

struct DenseSched {
    const bf16_t* A; const bf16_t* Bt; int K, nM, nN, nwg, G, c, i0, i1, split, pnoff;
    __device__ __forceinline__ void segment(int sg) { i0 = sg == 0 ? 0 : split; i1 = sg == 0 ? split : (1 << 30); }
    __device__ __forceinline__ bool get(int ii, GUnit& u) const {
        const int i = ii + i0; if (i >= i1) return false;
        const long L = (long)i * G + c; if (L >= nwg) return false;
        int wgid = (int)L; { const int q = nwg / 8, r = nwg % 8, xcd = wgid % 8, off = wgid / 8; wgid = (xcd < r ? xcd * (q + 1) : r * (q + 1) + (xcd - r) * q) + off; }
        const int nig = 8 * nN, gid = wgid / nig, fm = gid * 8, gsz = (nM - fm) < 8 ? (nM - fm) : 8;
        const int pm = fm + ((wgid % nig) % gsz), pn = (wgid % nig) / gsz;
        u.pn = pn + pnoff; u.row0 = pm * 256; u.A = A; u.gather = nullptr; u.Bt = Bt + (size_t)pn * 256 * K; u.e = 0; return true;
    }
};
struct QkvSched {
    unsigned char* ws; int l, G, c;
    __device__ __forceinline__ bool get(int i, GUnit& g) const {
        const int u = i * G + c; if (u >= 144) return false; g.gather = nullptr;
        if (u < 128) { g.e = 0; g.pn = u & 1; g.row0 = (u >> 1) * 256; g.A = (const bf16_t*)(ws + WS_XB); g.Bt = (const bf16_t*)(ws + WS_WQ + l * SZ_WQ) + (size_t)g.pn * 256 * D; g.dst = (bf16_t*)(ws + WS_Q); }
        else { const int v = u - 128; g.e = 1 + (v >> 3); g.pn = v & 1; g.row0 = ((v >> 1) & 3) * 256; g.A = (const bf16_t*)(ws + WS_MEMB); g.Bt = (const bf16_t*)(ws + (g.e == 1 ? WS_WK : WS_WV) + l * SZ_WQ) + (size_t)g.pn * 256 * D; g.dst = (bf16_t*)(ws + (g.e == 1 ? WS_KM : WS_VM)) + (size_t)l * TM * W; }
        return true;
    }
};
template <int NCT, bool GATEUP> struct MoeSched {
    unsigned char* ws; const LAS int* pst; int l, G, c, nunits;
    __device__ __forceinline__ bool get(int i, GUnit& g) const {
        const int u = i * G + c; if (u >= nunits) return false;
        const int rt = u / NCT; g.pn = u % NCT; g.row0 = rt * 256; const int e = __builtin_amdgcn_readfirstlane((int)((const LAS unsigned char*)(pst + 68))[rt]); g.e = e;
        if (GATEUP) { g.A = (const bf16_t*)(ws + WS_XB8); g.gather = (const int*)(ws + WS_TOK) + g.row0; g.Bt = (const bf16_t*)(ws + WS_WGU8 + ((size_t)l * NEX + e) * SZ_WGU8 + (size_t)g.pn * 256 * D); }
        else { g.A = (const bf16_t*)(ws + WS_HB); g.gather = nullptr; g.Bt = (const bf16_t*)(ws + WS_WDN + ((size_t)l * NEX + e) * SZ_WDN1 + (size_t)g.pn * 256 * ED); }
        return true;
    }
};

struct TDesc { const float* sp; int sld; unsigned char* dp; int dldb; int fp8; float qs; };
constexpr int TK_WINA = 1024, TK_WINB = 2560, TK_BR = 384, TK_WOUT = 512, TK_QKV = 384, TK_WO = 128, TK_GU = NEX * 8 * 32, TK_DN = NEX * 128;
constexpr int TK_L0DEF = TK_BR + TK_WOUT + TK_QKV + TK_WO + TK_GU + TK_DN, TK_LAYER = TK_WINA + TK_WINB + TK_L0DEF;
__device__ __forceinline__ void tile_desc(const Frame& F, int l, int t, TDesc& d) {
    const KArgs a = F.ka; unsigned char* ws = F.ws_(); d.fp8 = 0; d.qs = W8_SCALE;
    if (t < TK_WINA) { const int tk = t >> 6, tc = t & 63; d.sp = ((const float*)a->in[IN_WIN]) + (size_t)l * D * PROJ_W + (size_t)tk * 128 * PROJ_W + tc * 64; d.sld = PROJ_W; d.dldb = D; d.fp8 = 2; d.qs = 127.0f / fmaxf(__uint_as_float(((const unsigned*)(ws + WS_CTL))[CW_WABS + l]), 1e-30f); d.dp = ws + WS_WINQ + l * SZ_WINQ + (size_t)tc * 64 * D + tk * 128; return; }
    t -= TK_WINA;
    if (t < TK_WINB) { const int tk = t / 160, tc = t % 160; d.sp = ((const float*)a->in[IN_WIN]) + (size_t)l * D * PROJ_W + (size_t)tk * 128 * PROJ_W + 4104 + tc * 64; d.sld = PROJ_W;
        if (tc < 32) { d.dldb = D; d.fp8 = 2; d.qs = 127.0f / fmaxf(__uint_as_float(((const unsigned*)(ws + WS_CTL))[CW_WABS + l]), 1e-30f); d.dp = ws + WS_WINQ + l * SZ_WINQ + (size_t)(4096 + tc * 64) * D + tk * 128; }
        else { d.dldb = D; d.fp8 = 1; d.dp = ws + WS_WIN8 + l * SZ_WIN8 + (size_t)(4096 + tc * 64) * D + tk * 128; }
        return; }
    t -= TK_WINB;
    if (t < TK_BR) { const int n = 1 + (t >> 7), tt = t & 127, tk = tt >> 5, tc = tt & 31; d.sp = ((const float*)a->in[IN_WBR]) + ((size_t)l * 4 + n) * W * D + (size_t)tk * 128 * D + tc * 64; d.sld = D; d.dldb = D * 2; d.dp = ws + WS_WB + l * SZ_DD + ((size_t)tc * 64 * D + n * W + tk * 128) * 2; return; }
    t -= TK_BR;
    if (t < TK_WOUT) { const int tk = t >> 5, tc = t & 31; d.sp = ((const float*)a->in[IN_WMIX]) + (size_t)l * D * D + (size_t)tk * 128 * D + tc * 64; d.sld = D; d.dldb = D * 2; d.dp = ws + WS_WOUT + l * SZ_DD + ((size_t)tc * 64 * D + tk * 128) * 2; return; }
    t -= TK_WOUT;
    if (t < TK_QKV) { const int which = t >> 7, tt = t & 127, tk = tt >> 3, tc = tt & 7; d.sp = (const float*)a->in[which == 0 ? IN_WQ : (which == 1 ? IN_WK : IN_WV)] + (size_t)l * D * W + (size_t)tk * 128 * W + tc * 64; d.sld = W; d.dldb = D * 2;
        d.dp = ws + (which == 0 ? WS_WQ : (which == 1 ? WS_WK : WS_WV)) + l * SZ_WQ + ((size_t)tc * 64 * D + tk * 128) * 2; return; }
    t -= TK_QKV;
    if (t < TK_WO) { const int tk = t >> 5, tc = t & 31; d.sp = ((const float*)a->in[IN_WO]) + (size_t)l * W * D + (size_t)tk * 128 * D + tc * 64; d.sld = D; d.dldb = W * 2; d.dp = ws + WS_WO + l * SZ_WQ + ((size_t)tc * 64 * W + tk * 128) * 2; return; }
    t -= TK_WO;
    if (t < TK_GU) { const int tt = t & 31, job = t >> 5, half = job & 1, j = (job >> 1) & 3, e = job >> 3, tk = tt >> 1, tc = tt & 1;
        d.sp = (e < NE ? ((const float*)a->in[IN_WGU]) + ((size_t)l * NE + e) * D * 1024 : ((const float*)a->in[IN_SGU]) + (size_t)l * D * 1024) + half * 512 + j * 128 + (size_t)tk * 128 * 1024 + tc * 64; d.sld = 1024; d.dldb = D; d.fp8 = 1;
        d.dp = ws + WS_WGU8 + ((size_t)l * NEX + e) * SZ_WGU8 + (size_t)(j * 256 + half * 128 + tc * 64) * D + tk * 128; return; }
    t -= TK_GU;
    { const int tt = t & 127, e = t >> 7, tk = tt >> 5, tc = tt & 31;
      d.sp = (e < NE ? ((const float*)a->in[IN_WDN]) + ((size_t)l * NE + e) * ED * D : ((const float*)a->in[IN_SDN]) + (size_t)l * ED * D) + (size_t)tk * 128 * D + tc * 64; d.sld = D; d.dldb = ED; d.fp8 = 1;
      d.dp = ws + WS_WDN + ((size_t)l * NEX + e) * SZ_WDN1 + (size_t)tc * 64 * ED + tk * 128; }
}
constexpr int XP_SLOT = 64 * 256;
template <int NB> struct XRegs { f32x4 r[NB][4]; };
template <int NB> __device__ __forceinline__ void xpose_load(const Frame& F, int l, int t0, int tstep, int n, XRegs<NB>& X) {
    const int tid = F.tid, row4 = (tid >> 4) * 4, cq = (tid & 15) * 4;
#pragma unroll
    for (int b = 0; b < NB; ++b) if (b < n) { TDesc d; tile_desc(F, l, t0 + b * tstep, d); const float* sp = d.sp + (size_t)row4 * d.sld + cq;
#pragma unroll
        for (int q = 0; q < 4; ++q) X.r[b][q] = __builtin_nontemporal_load((const f32x4*)(sp + (size_t)q * d.sld)); }
}
template <int NB> __device__ __forceinline__ void xpose_finish(const Frame& F, int l, int t0, int tstep, int n, const XRegs<NB>& X) {
    const int tid = F.tid, row4 = (tid >> 4) * 4, cq = (tid & 15) * 4;
    int t1 = t0; asm volatile("" : "+s"(t1));
#pragma unroll
    for (int b = 0; b < NB; ++b) if (b < n) { TDesc d; tile_desc(F, l, t1 + b * tstep, d); LAS unsigned char* L = F.lds + b * XP_SLOT;
        if (d.fp8) { const int sw = ((cq >> 2) & 7) << 4;
#pragma unroll
            for (int j = 0; j < 4; ++j) *(LAS unsigned*)(L + (cq + j) * 128 + (row4 ^ sw)) = (d.fp8 == 2) ? pack_i8x4(X.r[b][0][j] * d.qs, X.r[b][1][j] * d.qs, X.r[b][2][j] * d.qs, X.r[b][3][j] * d.qs) : pack_fp8x4(X.r[b][0][j] * W8_SCALE, X.r[b][1][j] * W8_SCALE, X.r[b][2][j] * W8_SCALE, X.r[b][3][j] * W8_SCALE);
        } else { const int sw = ((cq >> 2) & 15) << 4;
#pragma unroll
            for (int j = 0; j < 4; ++j) { u32x2 w; w.x = pack2(X.r[b][0][j], X.r[b][1][j]); w.y = pack2(X.r[b][2][j], X.r[b][3][j]); *(LAS u32x2*)(L + (cq + j) * 256 + ((row4 * 2) ^ sw)) = w; } } }
    __syncthreads();
    int t2 = t0; asm volatile("" : "+s"(t2));
#pragma unroll
    for (int b = 0; b < NB; ++b) if (b < n) { TDesc d; tile_desc(F, l, t2 + b * tstep, d); const LAS unsigned char* L = F.lds + b * XP_SLOT; const int c = tid >> 3, kq = tid & 7;
        if (d.fp8) *(u32x4*)(d.dp + (size_t)c * d.dldb + kq * 16) = *(const LAS u32x4*)(L + c * 128 + ((kq * 16) ^ (((c >> 2) & 7) << 4)));
        else { const int sw = ((c >> 2) & 15) << 4; *(u32x4*)(d.dp + (size_t)c * d.dldb + kq * 16) = *(const LAS u32x4*)(L + c * 256 + ((kq * 16) ^ sw)); *(u32x4*)(d.dp + (size_t)c * d.dldb + 128 + kq * 16) = *(const LAS u32x4*)(L + c * 256 + ((128 + kq * 16) ^ sw)); } }
    __syncthreads();
}
__device__ __forceinline__ void xpose_range(const Frame& F, int l, int tlo, int thi, int rank, int nranks) {
    constexpr int NB = 4; const int step = nranks * NB;
    XRegs<NB> A, B;
    int t = tlo + rank * NB; if (t >= thi) return;
#define XP_CNT(tt) (((thi) - (tt)) < NB ? ((thi) - (tt)) : NB)
    xpose_load<NB>(F, l, t, 1, XP_CNT(t), A);
    for (;;) {
        const int tb = t + step; const bool hb = tb < thi; if (hb) xpose_load<NB>(F, l, tb, 1, XP_CNT(tb), B);
        xpose_finish<NB>(F, l, t, 1, XP_CNT(t), A);
        if (!hb) break;
        const int ta = tb + step; const bool ha = ta < thi; if (ha) xpose_load<NB>(F, l, ta, 1, XP_CNT(ta), A);
        xpose_finish<NB>(F, l, tb, 1, XP_CNT(tb), B);
        if (!ha) break;
        t = ta;
    }
#undef XP_CNT
}
__device__ __forceinline__ void pool_fold(const Frame& F, int l, int rank, int nranks) {
    const KArgs a = F.ka; unsigned char* ws = F.ws_();
    for (size_t i = (size_t)rank * NTHR + F.tid; i < (size_t)W * D; i += (size_t)nranks * NTHR) {
        const int d = (int)(i % D), gc = (int)(i / D), g = gc >> 7;
        const float* pw = ((const float*)a->in[IN_POOLW]) + ((size_t)l * W + gc) * 128; const float* ps = ((const float*)a->in[IN_POOLS]) + l * W + g * 128;
        const float* wb = ((const float*)a->in[IN_WBR]) + ((size_t)l * 4 * W + g * 128) * D + d;
        float s = 0.f;
        for (int e = 0; e < 128; ++e) s += pw[e] * ps[e] * wb[(size_t)e * D];
        ((bf16_t*)(ws + WS_WB + l * SZ_DD))[(size_t)d * D + gc] = f2bf(s);
    }
}
__device__ __forceinline__ void phase_wabs(const Frame& F) {
    const KArgs a = F.ka; unsigned char* ws = F.ws_();
    for (int l = 0; l < DEPTH; ++l) { float m = 0.f; const float* w = ((const float*)a->in[IN_WIN]) + (size_t)l * D * PROJ_W;
        for (size_t i = (size_t)F.wg * NTHR + F.tid; i < (size_t)D * (NBR / 4); i += (size_t)F.nwg * NTHR) { const int c4 = (int)(i % (NBR / 4)), k = (int)(i / (NBR / 4)); const int col = c4 * 4 < 4096 ? c4 * 4 : c4 * 4 + 8;
            const f32x4 v = *(const f32x4*)(w + (size_t)k * PROJ_W + col); m = fmaxf(m, fmaxf(fmaxf(fabsf(v[0]), fabsf(v[1])), fmaxf(fabsf(v[2]), fabsf(v[3])))); }
        m = wave_max(m);
        if (F.lane == 0) __hip_atomic_fetch_max((unsigned*)(ws + WS_CTL) + CW_WABS + l, __float_as_uint(m), __ATOMIC_RELAXED, __HIP_MEMORY_SCOPE_AGENT); }
}
__device__ __forceinline__ void phase_prologue(const Frame& F) {
    const KArgs a = F.ka;
    unsigned char* ws = F.ws_();
    xpose_range(F, 0, 0, TK_WINA + TK_WINB, F.wg, F.nwg);
    const size_t gtid = (size_t)F.wg * NTHR + F.tid, gn = (size_t)F.nwg * NTHR;
    for (size_t i = gtid; i < (size_t)DEPTH * 8 * D; i += gn) { const int k = (int)(i % D), c = (int)((i / D) % 8), l = (int)(i / (8 * D));
        ((float*)(ws + WS_WIF))[i] = ((const float*)a->in[IN_WIN])[(size_t)l * D * PROJ_W + (size_t)k * PROJ_W + 4096 + c]; }
    for (size_t i = gtid; i < (size_t)DEPTH * NE * D; i += gn) { const int k = (int)(i % D), e = (int)((i / D) % NE), l = (int)(i / ((size_t)NE * D));
        const float w = ((const float*)a->in[IN_RW])[((size_t)l * D + k) * NE + e]; const bf16_t hi = f2bf(w); const bf16_t lo = f2bf(w - bf2f(hi));
        bf16_t* o = (bf16_t*)(ws + WS_RWT) + (size_t)l * 2 * NE * D; o[(size_t)e * D + k] = hi; o[(size_t)(NE + e) * D + k] = lo; }
    for (size_t i = gtid; i < (size_t)SEQ * 64; i += gn) { const int f = (int)(i & 63), s = (int)(i >> 6);
        const float inv = powf(10000.0f, -(float)f / 64.0f); const float ang = (float)s * inv;
        ((float*)(ws + WS_ROPE))[i] = cosf(ang); ((float*)(ws + WS_ROPE))[(size_t)SEQ * 64 + i] = sinf(ang); }
    for (int row = F.wg * 8 + F.wave; row < T; row += F.nwg * 8) { float v[32]; const float* xr = ((const float*)a->in[IN_X]) + (size_t)row * D;
#pragma unroll
        for (int j = 0; j < 4; ++j) { const f32x4 p = *(const f32x4*)(xr + j * 512 + F.lane * 8), q = *(const f32x4*)(xr + j * 512 + F.lane * 8 + 4); v[j * 8] = p[0]; v[j * 8 + 1] = p[1]; v[j * 8 + 2] = p[2]; v[j * 8 + 3] = p[3]; v[j * 8 + 4] = q[0]; v[j * 8 + 5] = q[1]; v[j * 8 + 6] = q[2]; v[j * 8 + 7] = q[3]; }
        st_row32((bf16_t*)(ws + WS_XB) + (size_t)row * D, F.lane, v); st_row32_fp8(ws + WS_XB8 + (size_t)row * D, F.lane, v); st_row32_i8(ws + WS_XQ8 + (size_t)row * D, (float*)(ws + WS_XSC) + row, F.lane, v); }
    for (size_t i = gtid; i < (size_t)TM * D / 4; i += gn) { const f32x4 v = ((const f32x4*)((const float*)a->in[IN_MEM]))[i]; st_bf16x4((bf16_t*)(ws + WS_MEMB) + i * 4, v); }
    __syncthreads();
}
__device__ __forceinline__ void prologue_deferred(const Frame& F, int rank, int nranks) {
    xpose_range(F, 0, TK_WINA + TK_WINB, TK_LAYER, rank, nranks);
    xpose_range(F, 1, 0, TK_LAYER, rank, nranks);
    pool_fold(F, 0, rank, nranks); pool_fold(F, 1, rank, nranks);
    __syncthreads();
}

__device__ __forceinline__ void unpack8(u32x4 w, float (&f)[8]) {
#pragma unroll
    for (int j = 0; j < 4; ++j) { f[2 * j] = __uint_as_float(w[j] << 16); f[2 * j + 1] = __uint_as_float(w[j] & 0xffff0000u); } }
__device__ __forceinline__ u32x4 pack8f(const float (&f)[8]) { u32x4 w;
#pragma unroll
    for (int j = 0; j < 4; ++j) w[j] = pack2(f[2 * j], f[2 * j + 1]); return w; }
template <int WIN> __device__ __forceinline__ void pool_block(const bf16_t* pu, bf16_t* out, int s0) {
    float sum[8];
#pragma unroll
    for (int e = 0; e < 8; ++e) sum[e] = 0.f;
    u32x4 hist[WIN - 1 + 8];
#pragma unroll
    for (int j = 0; j < WIN - 1 + 8; ++j) { const int ds = j - (WIN - 1); hist[j] = (s0 + ds >= 0) ? *(const u32x4*)(pu + (ptrdiff_t)ds * NBR) : (u32x4){0u, 0u, 0u, 0u}; }
#pragma unroll
    for (int j = 0; j < WIN - 1; ++j) { float f[8]; unpack8(hist[j], f);
#pragma unroll
        for (int e = 0; e < 8; ++e) sum[e] += f[e]; }
#pragma unroll
    for (int i = 0; i < 8; ++i) { float f[8]; unpack8(hist[WIN - 1 + i], f); const int cnt = (s0 + i + 1 < WIN) ? s0 + i + 1 : WIN; const float rc = 1.0f / (float)cnt; float o[8];
#pragma unroll
        for (int e = 0; e < 8; ++e) { sum[e] += f[e]; o[e] = sum[e] * rc - f[e]; }
        *(u32x4*)(out + (size_t)i * D) = pack8f(o);
        float fo[8]; unpack8(hist[i], fo);
#pragma unroll
        for (int e = 0; e < 8; ++e) sum[e] -= fo[e]; }
}
template <bool WITH_D = true> __device__ __forceinline__ void phase_mix1v2(const Frame& F, int l, const bf16_t* xcur) {
    const KArgs a = F.ka;
    unsigned char* ws = F.ws_();
    LAS float* dots = (LAS float*)(F.lds + 65536);
    LAS float* wl = (LAS float*)F.lds;
    const float* wif = (const float*)(ws + WS_WIF) + (size_t)l * 8 * D;
    const float* gb = ((const float*)a->in[IN_GATEB]) + l * 8;
    float* cumf = (float*)(ws + WS_CUMF); float* ipre = (float*)(ws + WS_IPRE); float* summ = (float*)(ws + WS_SUMM); float* av = (float*)(ws + WS_AV); float* pm = (float*)(ws + WS_PM);
    if (F.wg < BATCH * NCH) { for (int i = F.tid; i < 8 * D / 4; i += NTHR) *(LAS f32x4*)(wl + i * 4) = *(const f32x4*)(wif + i * 4); __syncthreads(); }
    for (int item = F.wg; item < BATCH * NCH; item += F.nwg) {
        const int b = item / NCH, c = item % NCH; const int t0 = b * SEQ + c * CH;
        for (int i = 0; i < 8; i += 2) {
            const int tok = F.wave * 8 + i; const bf16_t* xr = xcur + (size_t)(t0 + tok) * D;
            float d0[8], d1[8];
#pragma unroll
            for (int q = 0; q < 8; ++q) { d0[q] = 0.f; d1[q] = 0.f; }
#pragma unroll 1
            for (int j = 0; j < 4; ++j) { float x0[8], x1[8]; unpack8(*(const u32x4*)(xr + j * 512 + F.lane * 8), x0); unpack8(*(const u32x4*)(xr + D + j * 512 + F.lane * 8), x1);
#pragma unroll
                for (int q = 0; q < 8; ++q) { const f32x4 wa = *(const LAS f32x4*)(wl + q * D + j * 512 + F.lane * 8), wb = *(const LAS f32x4*)(wl + q * D + j * 512 + F.lane * 8 + 4);
#pragma unroll
                    for (int e = 0; e < 4; ++e) { d0[q] += x0[e] * wa[e] + x0[4 + e] * wb[e]; d1[q] += x1[e] * wa[e] + x1[4 + e] * wb[e]; } } }
#pragma unroll
            for (int q = 0; q < 8; ++q) { const float s0 = wave_sum(d0[q]), s1 = wave_sum(d1[q]); if (F.lane == 0) { dots[tok * 8 + q] = s0; dots[(tok + 1) * 8 + q] = s1; } }
        }
        __syncthreads();
        if (F.wave < NH) {
            const int h = F.wave, s = F.lane; const float ip = dots[s * 8 + h] + gb[h], fp = dots[s * 8 + 4 + h] + gb[4 + h];
            const float lf = fminf(fp, 0.f) - log1pf(__expf(-fabsf(fp)));
            float cs = lf;
#pragma unroll
            for (int o = 1; o < 64; o <<= 1) { const float n = __shfl_up(cs, o); if (s >= o) cs += n; }
            const float ftot = __shfl(cs, 63); const float aa = ip - cs;
            float px = aa;
#pragma unroll
            for (int o = 1; o < 64; o <<= 1) { const float n = __shfl_up(px, o); if (s >= o) px = fmaxf(px, n); }
            const float gm = ftot + __shfl(px, 63);
            const size_t o = (size_t)(b * NH + h) * SEQ + c * CH + s; cumf[o] = cs; ipre[o] = ip; av[o] = aa; pm[o] = px;
            if (s == 0) { summ[((size_t)(b * NH + h) * NCH + c) * 2] = ftot; summ[((size_t)(b * NH + h) * NCH + c) * 2 + 1] = gm; }
        }
        __syncthreads();
    }
    bf16_t* proj = (bf16_t*)(ws + WS_PROJ); bf16_t* br = (bf16_t*)(ws + WS_BR);
    for (int it = F.wg * 8 + F.wave; it < (T / 32) * 4; it += F.nwg * 8) {
        const int grp = it & 3, tbq = it >> 2; const int tb = tbq * 4 + (F.lane >> 4), co = grp * 16 + (F.lane & 15);
        const int t0 = tb * 8, s0 = t0 % SEQ; const bf16_t* pu = proj + (size_t)t0 * NBR + PC_U + co * 8; bf16_t* out = br + (size_t)t0 * D + co * 8;
        if (grp == 0) pool_block<2>(pu, out, s0); else if (grp == 1) pool_block<4>(pu, out, s0); else if (grp == 2) pool_block<8>(pu, out, s0); else pool_block<16>(pu, out, s0);
    }
    { const float* cw = ((const float*)a->in[IN_CONVW]) + (size_t)l * 3 * W;
      for (size_t it = (size_t)F.wg * NTHR + F.tid; it < (size_t)(T / 8) * 64; it += (size_t)F.nwg * NTHR) {
        const int co = (int)(it & 63), tb = (int)(it >> 6), t0 = tb * 8, s0 = t0 % SEQ;
        const bf16_t* pr = proj + (size_t)t0 * NBR + co * 8;
        float w0[8], w1[8], w2[8];
#pragma unroll
        for (int e = 0; e < 8; ++e) { w0[e] = cw[co * 8 + e]; w1[e] = cw[W + co * 8 + e]; w2[e] = cw[2 * W + co * 8 + e]; }
        float z1[8], z2[8];
#pragma unroll
        for (int e = 0; e < 8; ++e) { z1[e] = 0.f; z2[e] = 0.f; }
        if (s0 >= 2) { float c_[8], h_[8]; unpack8(*(const u32x4*)(pr + PC_CC - 2 * NBR), c_); unpack8(*(const u32x4*)(pr + PC_CH - 2 * NBR), h_);
#pragma unroll
            for (int e = 0; e < 8; ++e) z2[e] = c_[e] * h_[e]; }
        if (s0 >= 1) { float c_[8], h_[8]; unpack8(*(const u32x4*)(pr + PC_CC - NBR), c_); unpack8(*(const u32x4*)(pr + PC_CH - NBR), h_);
#pragma unroll
            for (int e = 0; e < 8; ++e) z1[e] = c_[e] * h_[e]; }
#pragma unroll
        for (int i = 0; i < 8; ++i) { float c_[8], h_[8], b_[8], o[8]; unpack8(*(const u32x4*)(pr + PC_CC + (size_t)i * NBR), c_); unpack8(*(const u32x4*)(pr + PC_CH + (size_t)i * NBR), h_); unpack8(*(const u32x4*)(pr + PC_CB + (size_t)i * NBR), b_);
#pragma unroll
            for (int e = 0; e < 8; ++e) { const float z0 = c_[e] * h_[e]; o[e] = b_[e] * (w0[e] * z0 + w1[e] * z1[e] + w2[e] * z2[e]); z2[e] = z1[e]; z1[e] = z0; }
            *(u32x4*)(br + (size_t)(t0 + i) * D + W + co * 8) = pack8f(o); }
      } }
    if constexpr (WITH_D) { const float* ropec = (const float*)(ws + WS_ROPE); const float* ropes = ropec + (size_t)SEQ * 64;
      for (size_t it = (size_t)F.wg * NTHR + F.tid; it < (size_t)T * 64; it += (size_t)F.nwg * NTHR) {
        const int oc = (int)(it & 7), hh = (int)((it >> 3) & 3), isk = (int)((it >> 5) & 1), t = (int)(it >> 6), s = t % SEQ;
        bf16_t* p = proj + (size_t)t * NBR + (isk ? PC_RK : PC_RQ) + hh * HD + oc * 8;
        float x1[8], x2[8], o1[8], o2[8]; unpack8(*(const u32x4*)p, x1); unpack8(*(const u32x4*)(p + 64), x2);
#pragma unroll
        for (int e = 0; e < 8; ++e) { const float cs = ropec[(size_t)s * 64 + oc * 8 + e], sn = ropes[(size_t)s * 64 + oc * 8 + e]; o1[e] = x1[e] * cs - x2[e] * sn; o2[e] = x1[e] * sn + x2[e] * cs; }
        *(u32x4*)p = pack8f(o1); *(u32x4*)(p + 64) = pack8f(o2);
      } }
}

__device__ __forceinline__ float ret_gamma_log2(int h) { return log2f(1.0f - exp2f(-5.0f - (float)h)); }

__device__ __forceinline__ void phase_scan_mfma(const Frame& F) {
    unsigned char* ws = F.ws_();
    constexpr int KS2 = 144, WS2 = 48;
    LAS bf16_t* Kb = (LAS bf16_t*)F.lds;
    LAS bf16_t* Wb = Kb + 2 * 64 * KS2;
    LAS float* mS = (LAS float*)(Wb + 2 * 64 * WS2);
    LAS float* fT = mS + 80;
    const bf16_t* proj = (const bf16_t*)(ws + WS_PROJ);
    const float* av = (const float*)(ws + WS_AV); const float* summ = (const float*)(ws + WS_SUMM);
    const int lane = F.lane, g = lane >> 4, li = lane & 15, w = F.wave, tid = F.tid;
    for (int item = F.wg; item < 2 * NBH * 8; item += F.nwg) {
        const int type = item >> 7, bh = (item >> 3) & 15, vs = item & 7, b = bh >> 2, h = bh & 3;
        if (tid == 0) { float m = 0.f; mS[0] = 0.f; for (int c = 0; c < NCH; ++c) { m = fmaxf(summ[((size_t)bh * NCH + c) * 2] + m, summ[((size_t)bh * NCH + c) * 2 + 1]); mS[c + 1] = m; }
            if (type == 0 && vs == 0) { float* ms = (float*)(ws + WS_MSEQ) + bh * 80; for (int c = 0; c <= NCH; ++c) ms[c] = mS[c]; } }
        if (tid >= 64 && tid < 128) fT[tid - 64] = summ[((size_t)bh * NCH + (tid - 64)) * 2];
        __syncthreads();
        const float lg2 = ret_gamma_log2(h);
        const int kcol = (type == 0 ? PC_MK : PC_RK) + h * HD, vcol = (type == 0 ? PC_MV : PC_RV) + h * HD + vs * 16;
        bf16_t* cst = (bf16_t*)(ws + WS_CST) + ((size_t)(type * NBH + bh) * NCH) * HD * HD;
        float* nsv = (float*)(ws + WS_NST) + (size_t)bh * NCH * HD;
        const int krow = tid >> 3, koct = tid & 7, vrow = (tid >> 1) & 63, vhalf = tid & 1;
        const bf16_t* kbase = proj + (size_t)(b * SEQ + krow) * NBR + kcol + koct * 8;
        const bf16_t* vbase = proj + (size_t)(b * SEQ + vrow) * NBR + vcol + vhalf * 8;
        const float* abase = av + (size_t)bh * SEQ + vrow;
        u32x4 kr[2][2], vr[2]; float ar[2];
#define SCAN_LOAD(c, sl) do { const size_t _o = (size_t)(c) * CH * NBR; kr[sl][0] = *(const u32x4*)(kbase + _o); kr[sl][1] = *(const u32x4*)(kbase + _o + 64); \
        if (tid < 128) { vr[sl] = *(const u32x4*)(vbase + _o); ar[sl] = (type == 0) ? abase[(c) * CH] : 0.f; } } while (0)
#define SCAN_WRITE(c, sl, bf) do { LAS bf16_t* _k = Kb + (bf) * 64 * KS2 + krow * KS2 + koct * 8; *(LAS u32x4*)_k = kr[sl][0]; *(LAS u32x4*)(_k + 64) = kr[sl][1]; \
        if (tid < 128) { const float _w = (type == 0) ? __expf(ar[sl] + fT[c] - mS[(c) + 1]) : exp2f((float)(63 - vrow) * lg2); float _f[8]; unpack8(vr[sl], _f); \
            _Pragma("unroll") for (int _e = 0; _e < 8; ++_e) _f[_e] *= _w; LAS bf16_t* _p = Wb + (bf) * 64 * WS2 + vrow * WS2; *(LAS u32x4*)(_p + vhalf * 8) = pack8f(_f); \
            u32x4 _x = {0u, 0u, 0u, 0u}; if (vhalf == 0) _x[0] = (unsigned)f2bf(_w); *(LAS u32x4*)(_p + 16 + vhalf * 8) = _x; } } while (0)
        f32x4 st = {0.f, 0.f, 0.f, 0.f}, na = {0.f, 0.f, 0.f, 0.f};
#define SCAN_BODY(c, bf) do { { u32x2 _pw; _pw.x = pack2(st[0], st[1]); _pw.y = pack2(st[2], st[3]); *(u32x2*)(cst + (size_t)(c) * HD * HD + (size_t)(vs * 16 + li) * HD + 16 * w + 4 * g) = _pw; } \
        if (type == 0 && vs == 0 && li == 0) *(f32x4*)(nsv + (c) * HD + 16 * w + 4 * g) = na; \
        const float _d = (type == 0) ? __expf(fT[c] + mS[c] - mS[(c) + 1]) : exp2f(64.0f * lg2); st *= _d; na *= _d; \
        _Pragma("unroll") for (int _u = 0; _u < 2; ++_u) { const LAS bf16_t* _kp = Kb + (bf) * 64 * KS2 + (32 * _u + 8 * g + (li >> 2)) * KS2 + 16 * w + 4 * (li & 3); \
            const LAS bf16_t* _wp = Wb + (bf) * 64 * WS2 + (32 * _u + 8 * g + (li >> 2)) * WS2 + 4 * (li & 3); \
            const bf16x8 _A = cat4(lds_tr(_kp), lds_tr(_kp + 4 * KS2)); const bf16x8 _B = cat4(lds_tr(_wp), lds_tr(_wp + 4 * WS2)); \
            st = __builtin_amdgcn_mfma_f32_16x16x32_bf16(_A, _B, st, 0, 0, 0); \
            if (type == 0) { const bf16x8 _B2 = cat4(lds_tr(_wp + 16), lds_tr(_wp + 4 * WS2 + 16)); na = __builtin_amdgcn_mfma_f32_16x16x32_bf16(_A, _B2, na, 0, 0, 0); } } } while (0)
        SCAN_LOAD(0, 0); SCAN_WRITE(0, 0, 0); SCAN_LOAD(1, 1); SCAN_LOAD(2, 0);
        __syncthreads();
        for (int c = 0; c < NCH; c += 2) {
            SCAN_BODY(c, 0);
            SCAN_WRITE(c + 1, 1, 1);
            if (c + 3 < NCH) SCAN_LOAD(c + 3, 1);
            __syncthreads();
            SCAN_BODY(c + 1, 1);
            if (c + 2 < NCH) { SCAN_WRITE(c + 2, 0, 0); }
            if (c + 4 < NCH) SCAN_LOAD(c + 4, 0);
            __syncthreads();
        }
#undef SCAN_LOAD
#undef SCAN_WRITE
#undef SCAN_BODY
    }
}

__device__ __forceinline__ void phase_chunk_mfma(const Frame& F, int l) {
    const KArgs a = F.ka; unsigned char* ws = F.ws_();
    constexpr int QS = 136, VS = 144, PS = 72;
    LAS bf16_t* Qs = (LAS bf16_t*)F.lds; LAS bf16_t* Ks = Qs + 64 * QS; LAS bf16_t* Vs = Ks + 64 * QS; LAS bf16_t* Ps = Vs + 64 * VS;
    LAS float* rv = (LAS float*)(Ps + 64 * PS);
    LAS float* hp = rv + 256;
    const bf16_t* proj = (const bf16_t*)(ws + WS_PROJ); bf16_t* br = (bf16_t*)(ws + WS_BR);
    const float* cumf = (const float*)(ws + WS_CUMF); const float* av = (const float*)(ws + WS_AV); const float* pm = (const float*)(ws + WS_PM); const float* mseq = (const float*)(ws + WS_MSEQ);
    const int lane = F.lane, g = lane >> 4, li = lane & 15, w = F.wave;
    bf16x8 ones;
#pragma unroll
    for (int j = 0; j < 8; ++j) ones[j] = (short)0x3F80;
    for (int item = F.wg; item < 2 * NBH * NCH; item += F.nwg) {
        const int type = item / (NBH * NCH), bh = (item / NCH) % NBH, c = item % NCH, b = bh >> 2, h = bh & 3;
        const int t0 = b * SEQ + c * CH; const size_t go = (size_t)bh * SEQ + c * CH;
        const int qcol = (type == 0 ? PC_MQ : PC_RQ) + h * HD, kcol = (type == 0 ? PC_MK : PC_RK) + h * HD, vcol = (type == 0 ? PC_MV : PC_RV) + h * HD;
        const float lg2 = ret_gamma_log2(h);
        { const int row = F.tid >> 3, oct = F.tid & 7; const bf16_t* pr = proj + (size_t)(t0 + row) * NBR + oct * 8;
          *(LAS u32x4*)(Qs + row * QS + oct * 8) = *(const u32x4*)(pr + qcol); *(LAS u32x4*)(Qs + row * QS + 64 + oct * 8) = *(const u32x4*)(pr + qcol + 64);
          *(LAS u32x4*)(Ks + row * QS + oct * 8) = *(const u32x4*)(pr + kcol); *(LAS u32x4*)(Ks + row * QS + 64 + oct * 8) = *(const u32x4*)(pr + kcol + 64);
          *(LAS u32x4*)(Vs + row * VS + oct * 8) = *(const u32x4*)(pr + vcol); *(LAS u32x4*)(Vs + row * VS + 64 + oct * 8) = *(const u32x4*)(pr + vcol + 64); }
        if (F.tid < 64) { const int t = F.tid;
            if (type == 0) { const float mp = mseq[bh * 80 + c]; const float bt = fmaxf(mp, pm[go + t]); rv[t] = av[go + t]; rv[64 + t] = bt; rv[128 + t] = __expf(mp - bt); rv[192 + t] = __expf(-cumf[go + t] - bt); }
            else rv[128 + t] = exp2f((float)(t + 1) * lg2); }
        __syncthreads();
        { const int tt = w >> 1, t = 16 * tt + li;
#pragma unroll
          for (int sti = 0; sti < 2; ++sti) { const int st = (w & 1) * 2 + sti; f32x4 acc = {0.f, 0.f, 0.f, 0.f};
            if (st <= tt) {
#pragma unroll
                for (int kk = 0; kk < 4; ++kk) { const bf16x8 kf = *(const LAS bf16x8*)(Ks + (16 * st + li) * QS + kk * 32 + g * 8), qf = *(const LAS bf16x8*)(Qs + (16 * tt + li) * QS + kk * 32 + g * 8);
                    acc = __builtin_amdgcn_mfma_f32_16x16x32_bf16(kf, qf, acc, 0, 0, 0); }
#pragma unroll
                for (int r = 0; r < 4; ++r) { const int sx = 16 * st + 4 * g + r; float wgt;
                    if (type == 0) wgt = __expf(rv[sx] - rv[64 + t]); else wgt = exp2f((float)(t - sx) * lg2);
                    acc[r] = (sx <= t) ? acc[r] * wgt : 0.f; } }
            u32x2 pw; pw.x = pack2(acc[0], acc[1]); pw.y = pack2(acc[2], acc[3]); *(LAS u32x2*)(Ps + t * PS + 16 * st + 4 * g) = pw; } }
        __syncthreads();
        f32x4 pv[4], qc[4], dn[4], qn[4];
#pragma unroll
        for (int tt = 0; tt < 4; ++tt) { pv[tt] = (f32x4){0.f, 0.f, 0.f, 0.f}; qc[tt] = pv[tt]; dn[tt] = pv[tt]; qn[tt] = pv[tt]; }
#pragma unroll
        for (int u = 0; u < 2; ++u) {
            const bf16x8 vf = cat4(lds_tr(Vs + (32 * u + 8 * g + (li >> 2)) * VS + 16 * w + 4 * (li & 3)), lds_tr(Vs + (32 * u + 8 * g + 4 + (li >> 2)) * VS + 16 * w + 4 * (li & 3)));
#pragma unroll
            for (int tt = 0; tt < 4; ++tt) { const bf16x8 pf = *(const LAS bf16x8*)(Ps + (16 * tt + li) * PS + 32 * u + 8 * g);
                pv[tt] = __builtin_amdgcn_mfma_f32_16x16x32_bf16(vf, pf, pv[tt], 0, 0, 0);
                if (type == 0) dn[tt] = __builtin_amdgcn_mfma_f32_16x16x32_bf16(ones, pf, dn[tt], 0, 0, 0); } }
        if (c > 0) {
            const bf16_t* cst = (const bf16_t*)(ws + WS_CST) + ((size_t)(type * NBH + bh) * NCH + c) * HD * HD;
            const float* nsv = (const float*)(ws + WS_NST) + ((size_t)bh * NCH + c) * HD;
#pragma unroll
            for (int kk = 0; kk < 4; ++kk) { const bf16x8 cf = *(const bf16x8*)(cst + (size_t)(16 * w + li) * HD + kk * 32 + g * 8);
                bf16x8 nf = ones;
                if (type == 0) { const f32x4 n0 = *(const f32x4*)(nsv + kk * 32 + g * 8), n1 = *(const f32x4*)(nsv + kk * 32 + g * 8 + 4); nf = pack8(n0, n1); }
#pragma unroll
                for (int tt = 0; tt < 4; ++tt) { const bf16x8 qf = *(const LAS bf16x8*)(Qs + (16 * tt + li) * QS + kk * 32 + g * 8);
                    qc[tt] = __builtin_amdgcn_mfma_f32_16x16x32_bf16(cf, qf, qc[tt], 0, 0, 0);
                    if (type == 0) qn[tt] = __builtin_amdgcn_mfma_f32_16x16x32_bf16(nf, qf, qn[tt], 0, 0, 0); } } }
        const int vc = h * HD + 16 * w + 4 * g;
#pragma unroll
        for (int tt = 0; tt < 4; ++tt) { const int t = 16 * tt + li; const float inter = rv[128 + t]; f32x4 hv;
            if (type == 0) { const float den = inter * qn[tt][0] + dn[tt][0]; const float rd = 1.0f / fmaxf(fabsf(den), rv[192 + t]);
                const u32x2 ow = *(const u32x2*)(proj + (size_t)(t0 + t) * NBR + PC_MO + vc);
                const float o0 = __uint_as_float(ow.x << 16), o1 = __uint_as_float(ow.x & 0xffff0000u), o2 = __uint_as_float(ow.y << 16), o3 = __uint_as_float(ow.y & 0xffff0000u);
                hv[0] = sigmoidf_(o0) * (inter * qc[tt][0] + pv[tt][0]) * rd; hv[1] = sigmoidf_(o1) * (inter * qc[tt][1] + pv[tt][1]) * rd;
                hv[2] = sigmoidf_(o2) * (inter * qc[tt][2] + pv[tt][2]) * rd; hv[3] = sigmoidf_(o3) * (inter * qc[tt][3] + pv[tt][3]) * rd; }
            else hv = pv[tt] + qc[tt] * inter;
            pv[tt] = hv;
            float s1 = (hv[0] + hv[1]) + (hv[2] + hv[3]), s2 = (hv[0] * hv[0] + hv[1] * hv[1]) + (hv[2] * hv[2] + hv[3] * hv[3]);
            s1 += __shfl_xor(s1, 16); s1 += __shfl_xor(s1, 32); s2 += __shfl_xor(s2, 16); s2 += __shfl_xor(s2, 32);
            if (g == 0) { hp[(w * 64 + t) * 2] = s1; hp[(w * 64 + t) * 2 + 1] = s2; } }
        __syncthreads();
        const float* nw = (type == 0 ? ((const float*)a->in[IN_MNORM]) : ((const float*)a->in[IN_RNORM])) + l * W + vc; const f32x4 nw4 = *(const f32x4*)nw;
#pragma unroll
        for (int tt = 0; tt < 4; ++tt) { const int t = 16 * tt + li; float s1 = 0.f, s2 = 0.f;
#pragma unroll
            for (int ww = 0; ww < 8; ++ww) { const f32x2 p2 = *(const LAS f32x2*)(hp + (ww * 64 + t) * 2); s1 += p2.x; s2 += p2.y; }
            const float mu = s1 * (1.0f / 128.0f), var = fmaxf(s2 * (1.0f / 128.0f) - mu * mu, 0.f), rstd = rsqrtf(var + LN_EPS);
            f32x4 y = (pv[tt] - mu) * rstd * nw4;
            if (type == 1) { const u32x2 gw = *(const u32x2*)(proj + (size_t)(t0 + t) * NBR + PC_RG + vc);
                const float g0 = __uint_as_float(gw.x << 16), g1 = __uint_as_float(gw.x & 0xffff0000u), g2 = __uint_as_float(gw.y << 16), g3 = __uint_as_float(gw.y & 0xffff0000u);
                y[0] *= g0 * sigmoidf_(g0); y[1] *= g1 * sigmoidf_(g1); y[2] *= g2 * sigmoidf_(g2); y[3] *= g3 * sigmoidf_(g3); }
            st_bf16x4(br + (size_t)(t0 + t) * D + (type == 0 ? 1024 : 1536) + vc, y); }
        __syncthreads();
    }
}

__device__ __forceinline__ void ln_row(float (&v)[32], const float* lw, const float* lb, int lane) {
    float s = 0.f;
#pragma unroll
    for (int j = 0; j < 32; ++j) s += v[j];
    const float mu = wave_sum(s) * (1.0f / D); float q = 0.f;
#pragma unroll
    for (int j = 0; j < 32; ++j) { const float d = v[j] - mu; q += d * d; }
    const float rstd = rsqrtf(wave_sum(q) * (1.0f / D) + LN_EPS);
#pragma unroll
    for (int j = 0; j < 4; ++j)
#pragma unroll
        for (int h = 0; h < 2; ++h) { const f32x4 w4 = *(const f32x4*)(lw + j * 512 + lane * 8 + h * 4), b4 = *(const f32x4*)(lb + j * 512 + lane * 8 + h * 4);
#pragma unroll
            for (int e = 0; e < 4; ++e) v[j * 8 + h * 4 + e] = (v[j * 8 + h * 4 + e] - mu) * rstd * w4[e] + b4[e]; }
}
__device__ __forceinline__ void phase_ln(const Frame& F, const bf16_t* y, const float* lw, const float* lb, bf16_t* xb) {
    for (int row = F.wg * 8 + F.wave; row < T; row += F.nwg * 8) {
        float v[32]; ld_row32(y + (size_t)row * D, F.lane, v);
        ln_row(v, lw, lb, F.lane);
        st_row32(xb + (size_t)row * D, F.lane, v);
    }
}
__device__ __forceinline__ void split8(f32x4 a, f32x4 b, bf16x8& hi, bf16x8& lo) {
    union { u32x4 u; bf16x8 h; } H, L;
#pragma unroll
    for (int j = 0; j < 2; ++j) { const bf16_t h0 = f2bf(a[2 * j]), h1 = f2bf(a[2 * j + 1]); H.u[j] = (unsigned)h0 | ((unsigned)h1 << 16); L.u[j] = pack2(a[2 * j] - bf2f(h0), a[2 * j + 1] - bf2f(h1)); }
#pragma unroll
    for (int j = 0; j < 2; ++j) { const bf16_t h0 = f2bf(b[2 * j]), h1 = f2bf(b[2 * j + 1]); H.u[2 + j] = (unsigned)h0 | ((unsigned)h1 << 16); L.u[2 + j] = pack2(b[2 * j] - bf2f(h0), b[2 * j + 1] - bf2f(h1)); }
    hi = H.h; lo = L.h; }
__device__ __forceinline__ void phase_ln_router(const Frame& F, int l, const bf16_t* y, bf16_t* xb) {
    const KArgs a = F.ka;
    unsigned char* ws = F.ws_();
    constexpr int XS = D + 4;
    LAS float* xs = (LAS float*)F.lds;
    LAS float* part = xs + 16 * XS;
    LAS int* lcnt = (LAS int*)(part + 2048);
    if (F.tid < 128) lcnt[F.tid] = 0;
    __syncthreads();
    const float* lw = ((const float*)a->in[IN_LNW]) + ((size_t)l * 3 + 1) * D; const float* lb = ((const float*)a->in[IN_LNB]) + ((size_t)l * 3 + 1) * D;
    const bf16_t* rwt = (const bf16_t*)(ws + WS_RWT) + (size_t)l * 2 * NE * D; const float* rb = ((const float*)a->in[IN_RB]) + l * NE;
    unsigned* counts = (unsigned*)(ws + WS_CTL) + CW_COUNTS + l * 64;
    int* eid = (int*)(ws + WS_EID); float* ew = (float*)(ws + WS_EW); int* epos = (int*)(ws + WS_EPOS);
    const int lane = F.lane, g = lane >> 4, li = lane & 15, nt = F.wave & 3, kh = F.wave >> 2;
    for (int blk = F.wg; blk < T / 16; blk += F.nwg) {
        for (int rr = 0; rr < 2; ++rr) {
            const int lr = F.wave * 2 + rr, row = blk * 16 + lr;
            float v[32]; ld_row32(y + (size_t)row * D, F.lane, v);
            ln_row(v, lw, lb, F.lane);
            st_row32(xb + (size_t)row * D, F.lane, v); st_row32_fp8(ws + WS_XB8 + (size_t)row * D, F.lane, v);
#pragma unroll
            for (int j = 0; j < 4; ++j) { *(LAS f32x4*)(xs + lr * XS + j * 512 + F.lane * 8) = (f32x4){v[j * 8], v[j * 8 + 1], v[j * 8 + 2], v[j * 8 + 3]}; *(LAS f32x4*)(xs + lr * XS + j * 512 + F.lane * 8 + 4) = (f32x4){v[j * 8 + 4], v[j * 8 + 5], v[j * 8 + 6], v[j * 8 + 7]}; }
        }
        __syncthreads();
        { f32x4 acc = {0.f, 0.f, 0.f, 0.f};
          const bf16_t* wh = rwt + (size_t)(16 * nt + li) * D + kh * 1024 + g * 8; const bf16_t* wl = wh + (size_t)NE * D;
          const LAS float* xr = xs + li * XS + kh * 1024 + g * 8;
#pragma unroll 4
          for (int ks = 0; ks < 32; ++ks) { bf16x8 xh, xl; split8(*(const LAS f32x4*)(xr + ks * 32), *(const LAS f32x4*)(xr + ks * 32 + 4), xh, xl);
              const bf16x8 bh = *(const bf16x8*)(wh + ks * 32), bl = *(const bf16x8*)(wl + ks * 32);
              acc = __builtin_amdgcn_mfma_f32_16x16x32_bf16(xh, bh, acc, 0, 0, 0); acc = __builtin_amdgcn_mfma_f32_16x16x32_bf16(xh, bl, acc, 0, 0, 0); acc = __builtin_amdgcn_mfma_f32_16x16x32_bf16(xl, bh, acc, 0, 0, 0); }
#pragma unroll
          for (int r = 0; r < 4; ++r) part[(kh * 16 + 4 * g + r) * 64 + 16 * nt + li] = acc[r]; }
        __syncthreads();
        const int e = F.lane;
        const float bias = rb[e];
        for (int rr = 0; rr < 2; ++rr) {
            const int lr = F.wave * 2 + rr, row = blk * 16 + lr;
            const float sc = sigmoidf_(part[lr * 64 + e] + part[(16 + lr) * 64 + e]), bs = sc + bias;
            float m1 = bs; m1 = fmaxf(m1, __shfl_xor(m1, 1)); m1 = fmaxf(m1, __shfl_xor(m1, 2)); m1 = fmaxf(m1, __shfl_xor(m1, 4));
            const unsigned long long eq = __ballot(bs == m1); const int gq = e >> 3; const unsigned gm = (unsigned)(eq >> (gq * 8)) & 0xffu; const int first = gq * 8 + __builtin_ctz(gm);
            float m2 = (e == first) ? -INFINITY : bs; m2 = fmaxf(m2, __shfl_xor(m2, 1)); m2 = fmaxf(m2, __shfl_xor(m2, 2)); m2 = fmaxf(m2, __shfl_xor(m2, 4));
            const float gs = m1 + m2;
            int grank = 0;
#pragma unroll
            for (int g2 = 0; g2 < 8; ++g2) { const float o = __shfl(gs, g2 * 8); grank += (o > gs || (o == gs && g2 < gq)) ? 1 : 0; }
            const bool gsel = grank < 4;
            const float val = gsel ? bs : -INFINITY;
            int rank = 0;
            for (int e2 = 0; e2 < 64; ++e2) { const float o = __shfl(val, e2); rank += (o > val || (o == val && e2 < e)) ? 1 : 0; }
            const bool sel = gsel && rank < TOPK;
            const float wsum = wave_sum(sel ? sc : 0.f);
            const unsigned long long sm = __ballot(sel);
            if (sel) { const int k = __builtin_popcountll(sm & ((1ull << e) - 1ull));
                const int pos = __hip_atomic_fetch_add((int*)lcnt + e, 1, __ATOMIC_RELAXED, __HIP_MEMORY_SCOPE_WORKGROUP);
                eid[(size_t)row * 8 + k] = e; ew[(size_t)row * 8 + k] = sc / wsum * ROUTE_SCALE; epos[(size_t)row * 8 + k] = pos; }
        }
        __syncthreads();
    }
    if (F.tid < 64) { const int n = lcnt[F.tid]; lcnt[64 + F.tid] = n > 0 ? (int)__hip_atomic_fetch_add(counts + F.tid, (unsigned)n, __ATOMIC_RELAXED, __HIP_MEMORY_SCOPE_AGENT) : 0; }
    asm volatile("s_waitcnt vmcnt(0)" ::: "memory");
    __syncthreads();
    for (int blk = F.wg; blk < T / 16; blk += F.nwg) { if (F.tid < 128) { const size_t i = (size_t)blk * 128 + F.tid; epos[i] += lcnt[64 + eid[i]]; } }
    __syncthreads();
}
__device__ __forceinline__ void build_pstart(const Frame& F, int l, LAS int* pst) {
    const unsigned* counts = (const unsigned*)(F.ws_() + WS_CTL) + CW_COUNTS + l * 64;
    if (F.tid < 64) {
        const int c = (int)__hip_atomic_load(counts + F.tid, __ATOMIC_RELAXED, __HIP_MEMORY_SCOPE_AGENT); const int pc = (c + 255) & ~255; int inc = pc;
#pragma unroll
        for (int o = 1; o < 64; o <<= 1) { const int n = __shfl_up(inc, o); if (F.tid >= o) inc += n; }
        pst[F.tid] = inc - pc; if (F.tid == 63) { pst[NE] = inc; pst[NE + 1] = inc + T; } }
    __syncthreads();
    { LAS unsigned char* texp = (LAS unsigned char*)(pst + 68);
      for (int rt = F.tid; rt < (pst[NE + 1] >> 8); rt += NTHR) { int e = 0; while (e < NE && pst[e + 1] <= rt * 256) ++e; texp[rt] = (unsigned char)e; } }
    __syncthreads();
}
__device__ __forceinline__ void phase_slots(const Frame& F, int l) {
    unsigned char* ws = F.ws_();
    LAS int* pst = (LAS int*)F.lds;
    build_pstart(F, l, pst);
    const unsigned* counts = (const unsigned*)(ws + WS_CTL) + CW_COUNTS + l * 64;
    const int* eid = (const int*)(ws + WS_EID); const float* ew = (const float*)(ws + WS_EW); const int* epos = (const int*)(ws + WS_EPOS);
    int* slotof = (int*)(ws + WS_SLOTOF); int* tok = (int*)(ws + WS_TOK); float* wsl = (float*)(ws + WS_WSL);
    const size_t gtid = (size_t)F.wg * NTHR + F.tid, gn = (size_t)F.nwg * NTHR;
    for (size_t i = gtid; i < (size_t)T * 8; i += gn) { const int e = eid[i]; const int slot = pst[e] + epos[i]; slotof[i] = slot; tok[slot] = (int)(i >> 3); wsl[slot] = ew[i]; }
    for (size_t i = gtid; i < (size_t)NE * 256; i += gn) { const int e = (int)(i >> 8), r = (int)(i & 255); const int c = (int)counts[e]; const int slot = pst[e] + c + r; if (slot < pst[e + 1]) { tok[slot] = 0; wsl[slot] = 0.f; } }
    for (size_t i = gtid; i < (size_t)T; i += gn) { tok[pst[NE] + i] = (int)i; wsl[pst[NE] + i] = 1.0f; }
    __syncthreads();
}
__device__ __forceinline__ void phase_combine_ln(const Frame& F, int l, bf16_t* xb, float* out) {
    const KArgs a = F.ka;
    unsigned char* ws = F.ws_();
    LAS int* pst = (LAS int*)F.lds;
    build_pstart(F, l, pst);
    const int sh0 = pst[NE];
    const int* slotof = (const int*)(ws + WS_SLOTOF); const unsigned char* yb = ws + WS_YB;
    const float* lw = ((const float*)a->in[IN_LNW]) + ((size_t)l * 3 + 2) * D; const float* lb = ((const float*)a->in[IN_LNB]) + ((size_t)l * 3 + 2) * D;
    for (int row = F.wg * 8 + F.wave; row < T; row += F.nwg * 8) {
        float v[32]; ld_row32(xb + (size_t)row * D, F.lane, v);
#pragma unroll
        for (int j = 0; j < 32; ++j) v[j] *= ALPHA;
        float ys[32];
#pragma unroll
        for (int j = 0; j < 32; ++j) ys[j] = 0.f;
#pragma unroll 3
        for (int k = 0; k < 9; ++k) { const int slot = k < 8 ? slotof[(size_t)row * 8 + k] : sh0 + row; const unsigned char* yr = yb + (size_t)slot * D;
#pragma unroll
            for (int j = 0; j < 4; ++j) { const u32x2 w = *(const u32x2*)(yr + j * 512 + F.lane * 8);
                const f32x2 p0 = __builtin_amdgcn_cvt_pk_f32_fp8((int)w.x, false), p1 = __builtin_amdgcn_cvt_pk_f32_fp8((int)w.x, true), p2 = __builtin_amdgcn_cvt_pk_f32_fp8((int)w.y, false), p3 = __builtin_amdgcn_cvt_pk_f32_fp8((int)w.y, true);
                ys[j * 8] += p0.x; ys[j * 8 + 1] += p0.y; ys[j * 8 + 2] += p1.x; ys[j * 8 + 3] += p1.y; ys[j * 8 + 4] += p2.x; ys[j * 8 + 5] += p2.y; ys[j * 8 + 6] += p3.x; ys[j * 8 + 7] += p3.y; } }
#pragma unroll
        for (int j = 0; j < 32; ++j) v[j] += ys[j] * (1.0f / Y8_SCALE);
        ln_row(v, lw, lb, F.lane);
        if (out) {
#pragma unroll
            for (int j = 0; j < 4; ++j) { *(f32x4*)(out + (size_t)row * D + j * 512 + F.lane * 8) = (f32x4){v[j * 8], v[j * 8 + 1], v[j * 8 + 2], v[j * 8 + 3]}; *(f32x4*)(out + (size_t)row * D + j * 512 + F.lane * 8 + 4) = (f32x4){v[j * 8 + 4], v[j * 8 + 5], v[j * 8 + 6], v[j * 8 + 7]}; }
        } else { st_row32(xb + (size_t)row * D, F.lane, v); st_row32_fp8(ws + WS_XB8 + (size_t)row * D, F.lane, v); st_row32_i8(ws + WS_XQ8 + (size_t)row * D, (float*)(ws + WS_XSC) + row, F.lane, v); }
    }
    __syncthreads();
}

__device__ __forceinline__ void phase_attn_mfma(const Frame& F, int l) {
    unsigned char* ws = F.ws_();
    constexpr int KS = 136, VS = 144;
    LAS bf16_t* Ks = (LAS bf16_t*)F.lds; LAS bf16_t* Vs = Ks + 256 * KS;
    const bf16_t* q = (const bf16_t*)(ws + WS_Q); const bf16_t* km = (const bf16_t*)(ws + WS_KM) + (size_t)l * TM * W; const bf16_t* vm = (const bf16_t*)(ws + WS_VM) + (size_t)l * TM * W;
    bf16_t* o = (bf16_t*)(ws + WS_O);
    const int nunit = (T / 128) * 4, upw = (nunit + F.nwg - 1) / F.nwg;
    const int lane = F.lane, g = lane >> 4, li = lane & 15;
    int loaded = -1;
    const int u_end = (F.wg + 1) * upw < nunit ? (F.wg + 1) * upw : nunit;
    for (int u = F.wg * upw; u < u_end; ++u) {
        const int bh = u >> 5, blk = u & 31, b = bh >> 2, hh = bh & 3;
        if (bh != loaded) {
            __syncthreads();
            const int m = F.tid >> 1, half = F.tid & 1;
            const bf16_t* kr = km + (size_t)(b * MEM + m) * W + hh * HD + half * 64; const bf16_t* vr = vm + (size_t)(b * MEM + m) * W + hh * HD + half * 64;
#pragma unroll
            for (int j = 0; j < 8; ++j) { *(LAS u32x4*)(Ks + m * KS + half * 64 + j * 8) = *(const u32x4*)(kr + j * 8); *(LAS u32x4*)(Vs + m * VS + half * 64 + j * 8) = *(const u32x4*)(vr + j * 8); }
            __syncthreads(); loaded = bh;
        }
        const int t0 = b * SEQ + blk * 128 + F.wave * 16;
        bf16x8 qf[4];
#pragma unroll
        for (int kk = 0; kk < 4; ++kk) qf[kk] = *(const bf16x8*)(q + (size_t)(t0 + li) * W + hh * HD + kk * 32 + g * 8);
        f32x4 sacc[16];
#pragma unroll
        for (int tt = 0; tt < 16; ++tt) { f32x4 acc = {0.f, 0.f, 0.f, 0.f};
#pragma unroll
            for (int kk = 0; kk < 4; ++kk) { const bf16x8 kf = *(const LAS bf16x8*)(Ks + (16 * tt + li) * KS + kk * 32 + g * 8); acc = __builtin_amdgcn_mfma_f32_16x16x32_bf16(kf, qf[kk], acc, 0, 0, 0); }
            sacc[tt] = acc; }
        float mx = -INFINITY;
#pragma unroll
        for (int tt = 0; tt < 16; ++tt) mx = fmaxf(mx, fmaxf(fmaxf(sacc[tt][0], sacc[tt][1]), fmaxf(sacc[tt][2], sacc[tt][3])));
        mx = fmaxf(mx, __shfl_xor(mx, 16)); mx = fmaxf(mx, __shfl_xor(mx, 32));
        const float c2 = 0.08838834764831845f * 1.4426950408889634f; float sum = 0.f;
#pragma unroll
        for (int tt = 0; tt < 16; ++tt)
#pragma unroll
            for (int r = 0; r < 4; ++r) { const float p = exp2f((sacc[tt][r] - mx) * c2); sacc[tt][r] = p; sum += p; }
        sum += __shfl_xor(sum, 16); sum += __shfl_xor(sum, 32);
        const float rs = 1.0f / sum;
        bf16x8 pk[8];
#pragma unroll
        for (int u8 = 0; u8 < 8; ++u8) pk[u8] = pack8(sacc[2 * u8], sacc[2 * u8 + 1]);
#pragma unroll
        for (int dvt = 0; dvt < 8; ++dvt) { f32x4 acc = {0.f, 0.f, 0.f, 0.f};
#pragma unroll
            for (int u8 = 0; u8 < 8; ++u8) { const s16x4 a0 = lds_tr(Vs + (32 * u8 + 4 * g + (li >> 2)) * VS + dvt * 16 + 4 * (li & 3)); const s16x4 a1 = lds_tr(Vs + (32 * u8 + 16 + 4 * g + (li >> 2)) * VS + dvt * 16 + 4 * (li & 3));
                acc = __builtin_amdgcn_mfma_f32_16x16x32_bf16(cat4(a0, a1), pk[u8], acc, 0, 0, 0); }
            st_bf16x4(o + (size_t)(t0 + li) * W + hh * HD + dvt * 16 + 4 * g, acc * rs); }
    }
    __syncthreads();
}

template <class Epi>
__device__ __forceinline__ void gemm_dense_mfma(const Frame& F, const bf16_t* A, const bf16_t* Bt, int M, int N, int K, const Epi& E) {
    DenseSched S; S.A = A; S.Bt = Bt; S.K = K; S.nM = M / 256; S.nN = N / 256; S.nwg = S.nM * S.nN; S.G = F.nwg; S.c = F.wg; S.i0 = 0; S.i1 = 1 << 30; S.pnoff = 0;
    gemm_phase_mfma(F, K, S, E);
}
constexpr int NPL = 15, NPHASE = 1 + DEPTH * NPL;
#ifndef NCONV
#define NCONV 40
#endif
#if MK_PER_PHASE
#define IN(k) (lo <= (k) && (k) < hi)
#define SEAM(k) do { if (IN((k) + 1)) { XcdBarrier b2_ = bar; asm volatile("" : "+s"(b2_.bar)); asm volatile("" : "+s"(b2_.x)); xcd_barrier(b2_); } } while (0)
#else
#define IN(k) true
#define SEAM(k) do { if ((k) + 1 < NPHASE) for (int rb_ = 0; rb_ < ((PROBE_DBL & 4096) ? 3 : 1); ++rb_) { XcdBarrier b2_ = bar; asm volatile("" : "+s"(b2_.bar)); asm volatile("" : "+s"(b2_.x)); xcd_barrier(b2_); } } while (0)
#endif
template <int l> __device__ __forceinline__ void run_layer(const Frame& F0, const XcdBarrier& bar, int lo, int hi) {
    const int pb = 1 + l * NPL;
    if (IN(pb + 0)) { const Frame F = fresh(F0); unsigned char* ws = F.ws_();
        EpiProj E{(bf16_t*)(ws + WS_PROJ), (bf16_t*)(ws + WS_GATES)};
        { DenseSched S; S.A = (const bf16_t*)(ws + WS_XQ8); S.Bt = (const bf16_t*)(ws + WS_WINQ + l * SZ_WINQ); S.K = D / 2; S.nM = T / 256; S.nN = NBR / 256; S.nwg = S.nM * S.nN; S.G = F.nwg; S.c = F.wg; S.i0 = 0; S.i1 = 1 << 30; S.pnoff = 0;
          const float wsc = __uint_as_float(((const unsigned*)(ws + WS_CTL))[CW_WABS + l]) * (1.0f / 127.0f);
          gemm_phase_mfma<EpiProj, DenseSched, 2>(F, D, S, E, wsc, (const float*)(ws + WS_XSC)); }
        { const Frame F2 = fresh(F0); unsigned char* ws2 = F2.ws_(); EpiProj E2{(bf16_t*)(ws2 + WS_PROJ), (bf16_t*)(ws2 + WS_GATES)};
          DenseSched S; S.A = (const bf16_t*)(ws2 + WS_XB8); S.Bt = (const bf16_t*)(ws2 + WS_WIN8 + l * SZ_WIN8 + (size_t)NBR * D); S.K = D / 2; S.nM = T / 256; S.nN = (NPROJ - NBR) / 256; S.nwg = S.nM * S.nN; S.G = F2.nwg; S.c = F2.wg; S.i0 = 0; S.i1 = 1 << 30; S.pnoff = NBR / 256;
          gemm_phase_mfma<EpiProj, DenseSched, 1>(F2, D, S, E2, 1.0f / (X8_SCALE * W8_SCALE)); if (PROBE_DBL & 64) gemm_phase_mfma<EpiProj, DenseSched, 1>(F2, D, S, E2, 1.0f / (X8_SCALE * W8_SCALE)); }
        SEAM(pb + 0); }
    if (IN(pb + 1)) { const Frame F = fresh(F0); phase_mix1v2(F, l, (const bf16_t*)(F.ws_() + WS_XB)); if (PROBE_DBL & 8192) { const Frame G = fresh(F0); phase_mix1v2<false>(G, l, (const bf16_t*)(G.ws_() + WS_XB)); } SEAM(pb + 1); }
    if (IN(pb + 2)) { const Frame F = fresh(F0); phase_scan_mfma(F); if (PROBE_DBL & 2) { const Frame G = fresh(F0); phase_scan_mfma(G); } SEAM(pb + 2); }
    if (IN(pb + 3)) { const Frame F = fresh(F0); phase_chunk_mfma(F, l); if (PROBE_DBL & 4) { const Frame G = fresh(F0); phase_chunk_mfma(G, l); } SEAM(pb + 3); }
    if (IN(pb + 4)) { const Frame F = fresh(F0); unsigned char* ws = F.ws_();
        EpiBranch E{ws + WS_GATES, (bf16_t*)(ws + WS_MRG)}; gemm_dense_mfma(F, (const bf16_t*)(ws + WS_BR), (const bf16_t*)(ws + WS_WB + l * SZ_DD), T, D, D, E); if (PROBE_DBL & 128) gemm_dense_mfma(F, (const bf16_t*)(ws + WS_BR), (const bf16_t*)(ws + WS_WB + l * SZ_DD), T, D, D, E); SEAM(pb + 4); }
    if (IN(pb + 5)) { const Frame F = fresh(F0); unsigned char* ws = F.ws_();
        EpiResid E{(const bf16_t*)(ws + WS_XB), (bf16_t*)(ws + WS_Y)}; gemm_dense_mfma(F, (const bf16_t*)(ws + WS_MRG), (const bf16_t*)(ws + WS_WOUT + l * SZ_DD), T, D, D, E); if (PROBE_DBL & 256) gemm_dense_mfma(F, (const bf16_t*)(ws + WS_MRG), (const bf16_t*)(ws + WS_WOUT + l * SZ_DD), T, D, D, E); SEAM(pb + 5); }
    if (IN(pb + 6)) { const Frame F = fresh(F0); unsigned char* ws = F.ws_();
        phase_ln(F, (const bf16_t*)(ws + WS_Y), ((const float*)F.ka->in[IN_LNW]) + (size_t)l * 3 * D, ((const float*)F.ka->in[IN_LNB]) + (size_t)l * 3 * D, (bf16_t*)(ws + WS_XB)); if (PROBE_DBL & 1) { const Frame G = fresh(F0); unsigned char* wsg = G.ws_(); phase_ln(G, (const bf16_t*)(wsg + WS_Y), ((const float*)G.ka->in[IN_LNW]) + (size_t)l * 3 * D, ((const float*)G.ka->in[IN_LNB]) + (size_t)l * 3 * D, (bf16_t*)(wsg + WS_XB)); } SEAM(pb + 6); }
    if (IN(pb + 7)) { const Frame F = fresh(F0);
        EpiQKV E{}; QkvSched S; S.ws = F.ws_(); S.l = l; S.G = F.nwg; S.c = F.wg; gemm_phase_mfma(F, D, S, E); if (PROBE_DBL & 1024) gemm_phase_mfma(F, D, S, E); SEAM(pb + 7); }
    if (IN(pb + 8)) { const Frame F = fresh(F0); phase_attn_mfma(F, l); if (PROBE_DBL & 8) { const Frame G = fresh(F0); phase_attn_mfma(G, l); } SEAM(pb + 8); }
    if (IN(pb + 9)) { const Frame F = fresh(F0); unsigned char* ws = F.ws_();
        EpiResid E{(const bf16_t*)(ws + WS_XB), (bf16_t*)(ws + WS_Y)}; gemm_dense_mfma(F, (const bf16_t*)(ws + WS_O), (const bf16_t*)(ws + WS_WO + l * SZ_WQ), T, D, W, E); if (PROBE_DBL & 2048) gemm_dense_mfma(F, (const bf16_t*)(ws + WS_O), (const bf16_t*)(ws + WS_WO + l * SZ_WQ), T, D, W, E); SEAM(pb + 9); }
    if (IN(pb + 10)) { const Frame F = fresh(F0); unsigned char* ws = F.ws_(); phase_ln_router(F, l, (const bf16_t*)(ws + WS_Y), (bf16_t*)(ws + WS_XB)); SEAM(pb + 10); }
    if (IN(pb + 11)) { const Frame F = fresh(F0); phase_slots(F, l); if (PROBE_DBL & 16) { const Frame G = fresh(F0); phase_slots(G, l); } SEAM(pb + 11); }
    if (IN(pb + 12)) { const Frame F = fresh(F0); unsigned char* ws = F.ws_();
        LAS int* pst = (LAS int*)(F.lds + LDS_BYTES - 1024); build_pstart(F, l, pst);
        const int nrt = pst[NE + 1] >> 8; EpiSwiglu E{(const float*)(ws + WS_WSL), ws + WS_HB};
        MoeSched<4, true> S; S.ws = ws; S.pst = pst; S.l = l; S.G = F.nwg; S.c = F.wg; S.nunits = nrt * 4; gemm_phase_mfma<EpiSwiglu, MoeSched<4, true>, 1>(F, D, S, E, 1.0f / (X8_SCALE * W8_SCALE)); SEAM(pb + 12); }
    if (IN(pb + 13)) { const Frame F = fresh(F0); unsigned char* ws = F.ws_();
        LAS int* pst = (LAS int*)(F.lds + LDS_BYTES - 1024); build_pstart(F, l, pst);
        const int nrt = pst[NE + 1] >> 8; EpiDown E{ws + WS_YB};
        MoeSched<8, false> S; S.ws = ws; S.pst = pst; S.l = l; S.G = F.nwg; S.c = F.wg; S.nunits = nrt * 8; gemm_phase_mfma<EpiDown, MoeSched<8, false>, 1>(F, ED, S, E, Y8_SCALE / (H8_SCALE * W8_SCALE)); SEAM(pb + 13); }
    if (IN(pb + 14)) { const Frame F = fresh(F0); phase_combine_ln(F, l, (bf16_t*)(F.ws_() + WS_XB), l == DEPTH - 1 ? ((float*)F.ka->out) : (float*)nullptr); if ((PROBE_DBL & 16384) && l == DEPTH - 1) { const Frame G = fresh(F0); phase_combine_ln(G, l, (bf16_t*)(G.ws_() + WS_XB), ((float*)G.ka->out)); } SEAM(pb + 14); }
}

__global__ void __launch_bounds__(NTHR, 2) fwd(Args args_unused) {
    extern __shared__ __attribute__((aligned(16))) unsigned char lds_raw[];
    Frame F0; F0.lds = (LAS unsigned char*)lds_raw; F0.tid = threadIdx.x; F0.lane = F0.tid & 63; F0.wave = __builtin_amdgcn_readfirstlane(F0.tid >> 6); F0.wg = blockIdx.x; F0.nwg = gridDim.x;
    F0.ka = (KArgs)__builtin_amdgcn_kernarg_segment_ptr(); F0.wsg = F0.ka->ws;
    volatile LAS unsigned* xbw = (volatile LAS unsigned*)(F0.lds + LDS_BYTES - 16);
    if (F0.tid == 0) { xbw[0] = 0u; xbw[1] = 0u; }
    __syncthreads();
    XcdBarrier bar; bar.bar = (unsigned*)(F0.ws_() + WS_CTL); bar.x = 0; bar.st = xbw;
#if MK_PER_PHASE
    const int lo = F0.ka->ph_lo, hi = F0.ka->ph_hi;
    if (hi - lo > 1) bar = xcd_barrier_post((unsigned*)(F0.ws_() + WS_CTL), xbw);
#else
    const int lo = 0, hi = NPHASE;
    bar = xcd_barrier_post((unsigned*)(F0.ws_() + WS_CTL), xbw);
#endif
    if (IN(0)) { { const Frame F = fresh(F0); phase_wabs(F); } { XcdBarrier b2_ = bar; asm volatile("" : "+s"(b2_.bar)); asm volatile("" : "+s"(b2_.x)); xcd_barrier(b2_); }
        const Frame F = fresh(F0); phase_prologue(F); { const Frame G = fresh(F0); prologue_deferred(G, G.wg, G.nwg); } SEAM(0); }
    run_layer<0>(F0, bar, lo, hi);
    run_layer<1>(F0, bar, lo, hi);
#undef IN
#undef SEAM
}

extern "C" void kernel_launch(void* const* d_in, const int* in_sizes, int n_in, void* d_out, int out_size, void* d_ws, size_t ws_size, hipStream_t stream) {
    static int grid = 0;
    if (grid == 0) {
        if (n_in != 23 || ws_size < WS_END) { fprintf(stderr, "kernel_launch: unexpected inputs (n_in %d, ws %zu < %zu)\n", n_in, ws_size, (size_t)WS_END); grid = -1; return; }
        int dev = 0, cus = 0, per_cu = 0;
        if (hipGetDevice(&dev) != hipSuccess || hipDeviceGetAttribute(&cus, hipDeviceAttributeMultiprocessorCount, dev) != hipSuccess) { grid = -1; return; }
        if (hipFuncSetAttribute((const void*)fwd, hipFuncAttributeMaxDynamicSharedMemorySize, LDS_BYTES) != hipSuccess) { fprintf(stderr, "kernel_launch: hipFuncSetAttribute failed\n"); grid = -1; return; }
        if (hipOccupancyMaxActiveBlocksPerMultiprocessor(&per_cu, (const void*)fwd, NTHR, LDS_BYTES) != hipSuccess || per_cu < 1) { fprintf(stderr, "kernel_launch: occupancy query says %d\n", per_cu); }
        (void)hipGetLastError();
        grid = cus;
    }
    if (grid < 0) return;
    (void)hipMemsetAsync((char*)d_ws + WS_CTL, 0, CTL_BYTES, stream);
    Args a{};
    for (int i = 0; i < 23; ++i) a.in[i] = (const float*)d_in[i];
    a.out = (float*)d_out; a.ws = (unsigned char*)d_ws;
#if MK_PER_PHASE
    for (int p = 0; p < NPHASE; ++p) { a.ph_lo = p; a.ph_hi = p + 1; hipLaunchKernelGGL(fwd, dim3(grid), dim3(NTHR), LDS_BYTES, stream, a); }
#else
    a.ph_lo = 0; a.ph_hi = NPHASE;
    hipLaunchKernelGGL(fwd, dim3(grid), dim3(NTHR), LDS_BYTES, stream, a);
#endif
    const hipError_t le = hipPeekAtLastError();
    if (le != hipSuccess) fprintf(stderr, "kernel_launch: launch failed: %s\n", hipGetErrorName(le));
}
```

```cpp
#include <hip/hip_runtime.h>
#include <cstdio>
#include <cstdint>

#ifndef PROBE_DBL
#define PROBE_DBL 0
#endif
#ifndef MK_PER_PHASE
#define MK_PER_PHASE 0
#endif

typedef unsigned short bf16_t;
typedef float f32x4 __attribute__((ext_vector_type(4)));
typedef float f32x2 __attribute__((ext_vector_type(2)));
typedef unsigned u32x4 __attribute__((ext_vector_type(4)));
typedef unsigned u32x2 __attribute__((ext_vector_type(2)));
#define LAS __attribute__((address_space(3)))

constexpr int BATCH = 4, SEQ = 4096, T = BATCH * SEQ, D = 2048, DEPTH = 2;
constexpr int W = 512, NH = 4, HD = 128, CH = 64, NCH = SEQ / CH, NBH = BATCH * NH;
constexpr int PROJ_W = 14344, NBR = 6144, NPROJ = 14336;
constexpr int MEM = 256, TM = BATCH * MEM;
constexpr int NE = 64, NEX = 65, TOPK = 8, ED = 512;
constexpr int NSLOT = 164096;
constexpr float LN_EPS = 1e-5f, ALPHA = 1.41421356237f, ROUTE_SCALE = 2.5f;
constexpr int NTHR = 512;

constexpr int PC_U = 0, PC_CH = 512, PC_CB = 1024, PC_CC = 1536, PC_MQ = 2048, PC_MK = 2560, PC_MV = 3072, PC_MO = 3584, PC_RQ = 4096, PC_RK = 4608, PC_RV = 5120, PC_RG = 5632;

constexpr size_t al256(size_t x) { return (x + 255) & ~(size_t)255; }
constexpr size_t WS_CTL = 0;
constexpr size_t CTL_BYTES = 65536;
constexpr int CW_COUNTS = 8192;
constexpr size_t WS_WIN = WS_CTL + CTL_BYTES;
constexpr size_t SZ_WIN = (size_t)NPROJ * D * 2;
constexpr size_t WS_WIF = WS_WIN + DEPTH * SZ_WIN;
constexpr size_t SZ_WIF = 8 * D * 4;
constexpr size_t WS_WB = WS_WIF + DEPTH * SZ_WIF;
constexpr size_t SZ_DD = (size_t)D * D * 2;
constexpr size_t WS_WOUT = WS_WB + DEPTH * SZ_DD;
constexpr size_t WS_WQ = WS_WOUT + DEPTH * SZ_DD;
constexpr size_t SZ_WQ = (size_t)W * D * 2;
constexpr size_t WS_WK = WS_WQ + DEPTH * SZ_WQ;
constexpr size_t WS_WV = WS_WK + DEPTH * SZ_WQ;
constexpr size_t WS_WO = WS_WV + DEPTH * SZ_WQ;
constexpr size_t WS_WGU = WS_WO + DEPTH * SZ_WQ;
constexpr size_t SZ_WGU1 = (size_t)1024 * D * 2;
constexpr size_t WS_WDN = WS_WGU + (size_t)DEPTH * NEX * SZ_WGU1;
constexpr size_t SZ_WDN1 = (size_t)D * ED * 2;
constexpr size_t WS_ROPE = WS_WDN + (size_t)DEPTH * NEX * SZ_WDN1;
constexpr size_t WS_X = WS_ROPE + (size_t)SEQ * 64 * 4 * 2;
constexpr size_t SZ_TD4 = (size_t)T * D * 4;
constexpr size_t WS_Y = WS_X + SZ_TD4;
constexpr size_t WS_XB = WS_Y + SZ_TD4;
constexpr size_t SZ_TD2 = (size_t)T * D * 2;
constexpr size_t WS_MEMB = WS_XB + SZ_TD2;
constexpr size_t WS_KM = WS_MEMB + (size_t)TM * D * 2;
constexpr size_t WS_VM = WS_KM + (size_t)DEPTH * TM * W * 2;
constexpr size_t WS_PROJ = WS_VM + (size_t)DEPTH * TM * W * 2;
constexpr size_t WS_GATES = WS_PROJ + (size_t)T * NBR * 2;
constexpr size_t WS_CUMF = WS_GATES + (size_t)T * 8192 * 2;
constexpr size_t WS_IPRE = WS_CUMF + (size_t)NBH * SEQ * 4;
constexpr size_t WS_SUMM = WS_IPRE + (size_t)NBH * SEQ * 4;
constexpr size_t WS_CST = WS_SUMM + al256((size_t)NBH * NCH * 2 * 4);
constexpr size_t WS_NST = WS_CST + (size_t)2 * NBH * NCH * HD * HD * 2;
constexpr size_t WS_BR = WS_NST + (size_t)NBH * NCH * HD * 4;
constexpr size_t WS_MRG = WS_BR + SZ_TD2;
constexpr size_t WS_Q = WS_MRG + SZ_TD2;
constexpr size_t WS_O = WS_Q + (size_t)T * W * 2;
constexpr size_t WS_EID = WS_O + (size_t)T * W * 2;
constexpr size_t WS_EW = WS_EID + (size_t)T * 8 * 4;
constexpr size_t WS_EPOS = WS_EW + (size_t)T * 8 * 4;
constexpr size_t WS_SLOTOF = WS_EPOS + (size_t)T * 8 * 4;
constexpr size_t WS_TOK = WS_SLOTOF + (size_t)T * 8 * 4;
constexpr size_t WS_WSL = WS_TOK + al256((size_t)NSLOT * 4);
constexpr size_t WS_HB = WS_WSL + al256((size_t)NSLOT * 4);
constexpr size_t WS_YB = WS_HB + (size_t)NSLOT * ED * 2;
constexpr size_t WS_AV = WS_YB + (size_t)NSLOT * D * 2;
constexpr size_t WS_PM = WS_AV + (size_t)NBH * SEQ * 4;
constexpr size_t WS_MSEQ = WS_PM + (size_t)NBH * SEQ * 4;
constexpr size_t WS_XB8 = WS_MSEQ + al256((size_t)NBH * 80 * 4);
constexpr size_t WS_WGU8 = WS_XB8 + (size_t)T * D;
constexpr size_t SZ_WGU8 = (size_t)1024 * D;
constexpr size_t WS_WIN8 = WS_WGU8 + (size_t)DEPTH * NEX * SZ_WGU8;
constexpr size_t SZ_WIN8 = (size_t)NPROJ * D;
constexpr size_t WS_RWT = WS_WIN8 + DEPTH * SZ_WIN8;
constexpr size_t WS_XQ8 = WS_RWT + (size_t)DEPTH * 2 * NE * D * 2;
constexpr size_t WS_XSC = WS_XQ8 + (size_t)T * D;
constexpr size_t WS_WINQ = WS_XSC + al256((size_t)T * 4);
constexpr size_t SZ_WINQ = (size_t)NBR * D;
constexpr size_t WS_END = WS_WINQ + DEPTH * SZ_WINQ;
constexpr int CW_WABS = 8320;
constexpr float X8_SCALE = 16.0f, W8_SCALE = 256.0f, H8_SCALE = 8.0f, Y8_SCALE = 64.0f;

constexpr int LDS_BYTES = 147456;

__device__ __forceinline__ bf16_t f2bf(float f) { unsigned u = __float_as_uint(f); u += 0x7FFFu + ((u >> 16) & 1u); return (bf16_t)(u >> 16); }
__device__ __forceinline__ float bf2f(bf16_t b) { return __uint_as_float(((unsigned)b) << 16); }
__device__ __forceinline__ unsigned pack2(float lo, float hi) { unsigned r; asm("v_cvt_pk_bf16_f32 %0, %1, %2" : "=v"(r) : "v"(lo), "v"(hi)); return r; }
__device__ __forceinline__ float sigmoidf_(float x) { return __builtin_amdgcn_rcpf(1.0f + __builtin_amdgcn_exp2f(-1.4426950408889634f * x)); }
__device__ __forceinline__ unsigned pack_fp8x4(float a, float b, float c, float d) {
    a = __builtin_amdgcn_fmed3f(a, -448.f, 448.f); b = __builtin_amdgcn_fmed3f(b, -448.f, 448.f); c = __builtin_amdgcn_fmed3f(c, -448.f, 448.f); d = __builtin_amdgcn_fmed3f(d, -448.f, 448.f);
    int w = 0; w = __builtin_amdgcn_cvt_pk_fp8_f32(a, b, w, false); w = __builtin_amdgcn_cvt_pk_fp8_f32(c, d, w, true); return (unsigned)w; }
__device__ __forceinline__ unsigned pack_i8x4(float a, float b, float c, float d) {
    const int ia = (int)__builtin_amdgcn_fmed3f(rintf(a), -127.f, 127.f), ib = (int)__builtin_amdgcn_fmed3f(rintf(b), -127.f, 127.f), ic = (int)__builtin_amdgcn_fmed3f(rintf(c), -127.f, 127.f), id = (int)__builtin_amdgcn_fmed3f(rintf(d), -127.f, 127.f);
    return (unsigned)(ia & 255) | ((unsigned)(ib & 255) << 8) | ((unsigned)(ic & 255) << 16) | ((unsigned)(id & 255) << 24); }
__device__ __forceinline__ unsigned pack_u8x4(float a, float b, float c, float d) {
    return (unsigned)rintf(a) | ((unsigned)rintf(b) << 8) | ((unsigned)rintf(c) << 16) | ((unsigned)rintf(d) << 24); }
__device__ __forceinline__ void un8u(u32x2 w, f32x4& a, f32x4& b) { a[0] = (float)(w.x & 255u); a[1] = (float)((w.x >> 8) & 255u); a[2] = (float)((w.x >> 16) & 255u); a[3] = (float)(w.x >> 24);
    b[0] = (float)(w.y & 255u); b[1] = (float)((w.y >> 8) & 255u); b[2] = (float)((w.y >> 16) & 255u); b[3] = (float)(w.y >> 24); }
__device__ __forceinline__ float wave_sum(float v) { for (int o = 32; o >= 1; o >>= 1) v += __shfl_xor(v, o); return v; }
__device__ __forceinline__ float wave_max(float v) { for (int o = 32; o >= 1; o >>= 1) v = fmaxf(v, __shfl_xor(v, o)); return v; }

#define XB_TMO      128
#define XB_XCNT(j)  (256  + 64 * (j))
#define XB_XSUB(j)  (1280 + 64 * (j))
#define XB_XGEN(j)  (2304 + 64 * (j))
#define XB_TOP      3328
#define XB_TOPGEN   3392
#define XCD_BAR_WORDS 3456
#define XB_SPIN_CAP (1u << 27)
__device__ __forceinline__ unsigned xb_ld(unsigned* p)              { return __hip_atomic_load(p, __ATOMIC_RELAXED, __HIP_MEMORY_SCOPE_AGENT); }
__device__ __forceinline__ unsigned xb_add(unsigned* p, unsigned v) { return __hip_atomic_fetch_add(p, v, __ATOMIC_RELAXED, __HIP_MEMORY_SCOPE_AGENT); }
__device__ __forceinline__ unsigned xb_xcc_id() { return (unsigned)__builtin_amdgcn_s_getreg((3 << 11) | 20) & 0xFu; }
#define XB_SPIN(cond, bar) do { unsigned _sp = 0; while (cond) { __builtin_amdgcn_s_sleep(1); \
    if ((++_sp & 255u) == 0u) { if (xb_ld(&(bar)[XB_TMO])) break; if (_sp > XB_SPIN_CAP) { atomicAdd(&(bar)[XB_TMO], 1u); break; } } } } while (0)
struct XcdBarrier { unsigned* bar; unsigned x; volatile LAS unsigned* st; };
__device__ __forceinline__ XcdBarrier xcd_barrier_post(unsigned* bar, volatile LAS unsigned* st) {
    XcdBarrier b; b.bar = bar; b.x = xb_xcc_id(); b.st = st;
    if (threadIdx.x == 0) (void)xb_add(&bar[XB_XCNT(b.x)], 1u);
    return b;
}
__device__ __forceinline__ void xcd_barrier_complete(unsigned* bar, unsigned x, unsigned& nloc, unsigned& nx) {
    const unsigned G = gridDim.x * gridDim.y * gridDim.z;
    unsigned sum, cnt, mine, sp = 0u;
    for (;;) {
        sum = 0u; cnt = 0u; mine = 0u;
#pragma unroll
        for (unsigned j = 0; j < 16; ++j) { const unsigned c = xb_ld(&bar[XB_XCNT(j)]); sum += c; cnt += (c > 0u) ? 1u : 0u; mine = (j == x) ? c : mine; }
        if (sum == G) break;
        __builtin_amdgcn_s_sleep(1);
        if ((++sp & 255u) == 0u) { if (xb_ld(&bar[XB_TMO])) break; if (sp > XB_SPIN_CAP) { atomicAdd(&bar[XB_TMO], 1u); break; } }
    }
    nloc = mine > 0u ? mine : 1u; nx = cnt > 0u ? cnt : 1u;
}
__device__ __forceinline__ void xcd_barrier(const XcdBarrier& b) {
    asm volatile("s_waitcnt vmcnt(0)" ::: "memory");
    __syncthreads();
    if (threadIdx.x == 0) {
        unsigned* bar = b.bar;
        __builtin_amdgcn_s_waitcnt(0);
        unsigned nloc = b.st[0], nx = b.st[1];
        if (nloc == 0u) { xcd_barrier_complete(bar, b.x, nloc, nx); b.st[0] = nloc; b.st[1] = nx; }
        const unsigned old = xb_add(&bar[XB_XSUB(b.x)], 1u);
        const unsigned gen = old / nloc;
        if (old + 1u == (gen + 1u) * nloc) {
            __builtin_amdgcn_fence(__ATOMIC_RELEASE, "agent");
            asm volatile("s_waitcnt vmcnt(0)" ::: "memory");
            const unsigned og = xb_add(&bar[XB_TOP], 1u);
            const unsigned tg = og / nx;
            if (og + 1u == (tg + 1u) * nx) xb_add(&bar[XB_TOPGEN], 1u);
            else XB_SPIN(xb_ld(&bar[XB_TOPGEN]) == tg, bar);
            __builtin_amdgcn_fence(__ATOMIC_ACQUIRE, "agent");
            xb_add(&bar[XB_XGEN(b.x)], 1u);
            asm volatile("s_waitcnt vmcnt(0)" ::: "memory");
        } else {
            XB_SPIN(xb_ld(&bar[XB_XGEN(b.x)]) == gen, bar);
            __builtin_amdgcn_fence(__ATOMIC_ACQUIRE, "agent");
            asm volatile("s_waitcnt vmcnt(0)" ::: "memory");
        }
    }
    __syncthreads();
}

struct Args { const float* in[23]; float* out; unsigned char* ws; int ph_lo, ph_hi; };
enum { IN_X = 0, IN_MEM, IN_WIN, IN_GATEB, IN_POOLW, IN_POOLS, IN_CONVW, IN_MNORM, IN_RNORM, IN_WBR, IN_WMIX, IN_WQ, IN_WK, IN_WV, IN_WO, IN_RW, IN_RB, IN_WGU, IN_WDN, IN_SGU, IN_SDN, IN_LNW, IN_LNB };

#define GAS __attribute__((address_space(1)))
struct DArgs { const GAS float* in[23]; GAS float* out; GAS unsigned char* ws; int ph_lo, ph_hi; };
typedef const __attribute__((address_space(4))) DArgs* KArgs;
struct Frame {
    LAS unsigned char* lds; int tid, lane, wave, wg, nwg;
    GAS unsigned char* wsg; KArgs ka;
    __device__ __forceinline__ unsigned char* ws_() const { return (unsigned char*)wsg; }
};
__device__ __forceinline__ Frame fresh(const Frame& F) { Frame G = F; asm volatile("" : "+s"(G.wsg)); asm volatile("" : "+s"(G.ka)); asm volatile("" : "+v"(G.tid)); asm volatile("" : "+s"(G.wg));
    G.lane = G.tid & 63; G.wave = __builtin_amdgcn_readfirstlane(G.tid >> 6); return G; }

struct GUnit {
    const bf16_t* Bt;
    const bf16_t* A;
    const int* gather;
    int row0;
    int pn;
    int e;
    bf16_t* dst;
};

__device__ __forceinline__ void un8(u32x4 w, f32x4& a, f32x4& b) { a[0] = __uint_as_float(w[0] << 16); a[1] = __uint_as_float(w[0] & 0xffff0000u); a[2] = __uint_as_float(w[1] << 16); a[3] = __uint_as_float(w[1] & 0xffff0000u);
    b[0] = __uint_as_float(w[2] << 16); b[1] = __uint_as_float(w[2] & 0xffff0000u); b[2] = __uint_as_float(w[3] << 16); b[3] = __uint_as_float(w[3] & 0xffff0000u); }
__device__ __forceinline__ void st_bf16x8(bf16_t* p, f32x4 a, f32x4 b) { u32x4 w; w[0] = pack2(a[0], a[1]); w[1] = pack2(a[2], a[3]); w[2] = pack2(b[0], b[1]); w[3] = pack2(b[2], b[3]); *(u32x4*)p = w; }
__device__ __forceinline__ void st_bf16x4(bf16_t* p, f32x4 v) { u32x2 w; w.x = pack2(v[0], v[1]); w.y = pack2(v[2], v[3]); *(u32x2*)p = w; }
__device__ __forceinline__ void ld_row32(const bf16_t* row, int lane, float (&v)[32]) {
#pragma unroll
    for (int j = 0; j < 4; ++j) { const u32x4 w = *(const u32x4*)(row + j * 512 + lane * 8);
#pragma unroll
        for (int e = 0; e < 4; ++e) { v[j * 8 + 2 * e] = __uint_as_float(w[e] << 16); v[j * 8 + 2 * e + 1] = __uint_as_float(w[e] & 0xffff0000u); } } }
__device__ __forceinline__ void st_row32(bf16_t* row, int lane, const float (&v)[32]) {
#pragma unroll
    for (int j = 0; j < 4; ++j) { u32x4 w;
#pragma unroll
        for (int e = 0; e < 4; ++e) w[e] = pack2(v[j * 8 + 2 * e], v[j * 8 + 2 * e + 1]);
        *(u32x4*)(row + j * 512 + lane * 8) = w; } }
__device__ __forceinline__ void st_row32_i8(unsigned char* row, float* sc, int lane, const float (&v)[32]) {
    float am = 0.f;
#pragma unroll
    for (int j = 0; j < 32; ++j) am = fmaxf(am, fabsf(v[j]));
    am = fmaxf(wave_max(am), 1e-30f); const float q = 127.0f / am;
#pragma unroll
    for (int j = 0; j < 4; ++j) { u32x2 w; w.x = pack_i8x4(v[j * 8] * q, v[j * 8 + 1] * q, v[j * 8 + 2] * q, v[j * 8 + 3] * q); w.y = pack_i8x4(v[j * 8 + 4] * q, v[j * 8 + 5] * q, v[j * 8 + 6] * q, v[j * 8 + 7] * q);
        *(u32x2*)(row + j * 512 + lane * 8) = w; }
    if (lane == 0) *sc = am * (1.0f / 127.0f); }
__device__ __forceinline__ void st_row32_fp8(unsigned char* row, int lane, const float (&v)[32]) {
#pragma unroll
    for (int j = 0; j < 4; ++j) { u32x2 w; w.x = pack_fp8x4(v[j * 8] * X8_SCALE, v[j * 8 + 1] * X8_SCALE, v[j * 8 + 2] * X8_SCALE, v[j * 8 + 3] * X8_SCALE); w.y = pack_fp8x4(v[j * 8 + 4] * X8_SCALE, v[j * 8 + 5] * X8_SCALE, v[j * 8 + 6] * X8_SCALE, v[j * 8 + 7] * X8_SCALE);
        *(u32x2*)(row + j * 512 + lane * 8) = w; } }
struct NoPre { };
struct EpiProj {
    static constexpr bool PAIR_M = false; static constexpr bool SEG = false; typedef NoPre Pre;
    bf16_t* proj; bf16_t* gates;
    static __device__ __forceinline__ float unit_scale(const GUnit& u) { return (u.pn == PC_MK / 256 || u.pn == PC_MK / 256 + 1 || u.pn == PC_RK / 256 || u.pn == PC_RK / 256 + 1) ? 0.08838834764831845f : 1.0f; }
    __device__ __forceinline__ void pre(const GUnit&, int, int, Pre&) const {}
    __device__ __forceinline__ void fin(const GUnit& u, int r, int c, const f32x4 (&a)[2][2], const Pre&) const {
        const int col = u.pn * 256 + c; const size_t row = (size_t)(u.row0 + r);
        if (col < NBR) { st_bf16x8(proj + row * NBR + col, a[0][0], a[0][1]); st_bf16x8(proj + row * NBR + col + 128, a[1][0], a[1][1]); }
        else { f32x4 s[2][2];
#pragma unroll
            for (int h = 0; h < 2; ++h)
#pragma unroll
                for (int n = 0; n < 2; ++n)
#pragma unroll
                    for (int j = 0; j < 4; ++j) s[h][n][j] = __builtin_amdgcn_fmed3f(sigmoidf_(a[h][n][j]) * 255.0f, 1.0f, 255.0f);
            u32x2 w0, w1; w0.x = pack_u8x4(s[0][0][0], s[0][0][1], s[0][0][2], s[0][0][3]); w0.y = pack_u8x4(s[0][1][0], s[0][1][1], s[0][1][2], s[0][1][3]);
            w1.x = pack_u8x4(s[1][0][0], s[1][0][1], s[1][0][2], s[1][0][3]); w1.y = pack_u8x4(s[1][1][0], s[1][1][1], s[1][1][2], s[1][1][3]);
            { const auto rx = __builtin_amdgcn_permlane32_swap(w0.x, w1.x, false, false); w0.x = rx[0]; w1.x = rx[1]; const auto ry = __builtin_amdgcn_permlane32_swap(w0.y, w1.y, false, false); w0.y = ry[0]; w1.y = ry[1]; }
            const bool up = (threadIdx.x & 32u) != 0u; const int gc = col - NBR;
            unsigned char* gp = (unsigned char*)gates + row * 8192 + (up ? gc + 128 - 8 : gc);
            u32x4 w; w[0] = w0.x; w[1] = w0.y; w[2] = w1.x; w[3] = w1.y; *(u32x4*)gp = w; }
    }
};
struct EpiBranch {
    static constexpr bool PAIR_M = false; static constexpr bool SEG = true;
    struct Pre { u32x2 g0, g1; };
    struct SPre { u32x2 a0, a1, b0, b1; };
    const unsigned char* gates; bf16_t* out;
    __device__ __forceinline__ void pre(const GUnit& u, int r, int c, Pre& p) const { const unsigned char* g = gates + (size_t)(u.row0 + r) * 8192 + 3 * 2048 + u.pn * 256 + c; p.g0 = *(const u32x2*)g; p.g1 = *(const u32x2*)(g + 128); }
    __device__ __forceinline__ void fin(const GUnit& u, int r, int c, const f32x4 (&a)[2][2], const Pre& p) const {
        f32x4 x0, x1, y0, y1; un8u(p.g0, x0, x1); un8u(p.g1, y0, y1); const float k = 1.0f / 255.0f;
        bf16_t* o = out + (size_t)(u.row0 + r) * D + u.pn * 256 + c; st_bf16x8(o, a[0][0] * x0 * k, a[0][1] * x1 * k); st_bf16x8(o + 128, a[1][0] * y0 * k, a[1][1] * y1 * k); }
    __device__ __forceinline__ void seg_pre(const GUnit& u, int r, int c, int s, SPre& p) const { const unsigned char* g = gates + (size_t)(u.row0 + r) * 8192 + s * 2048 + u.pn * 256 + c;
        p.a0 = *(const u32x2*)g; p.a1 = *(const u32x2*)(g + 128); p.b0 = *(const u32x2*)(g + 2048); p.b1 = *(const u32x2*)(g + 2048 + 128); }
    __device__ __forceinline__ void seg_fin(f32x4 (&h0)[2], f32x4 (&h1)[2], const SPre& p) const {
        f32x4 a0, a1, b0, b1; un8u(p.a0, a0, a1); un8u(p.b0, b0, b1);
#pragma unroll
        for (int j = 0; j < 4; ++j) { h0[0][j] *= a0[j] * __builtin_amdgcn_rcpf(b0[j]); h0[1][j] *= a1[j] * __builtin_amdgcn_rcpf(b1[j]); }
        un8u(p.a1, a0, a1); un8u(p.b1, b0, b1);
#pragma unroll
        for (int j = 0; j < 4; ++j) { h1[0][j] *= a0[j] * __builtin_amdgcn_rcpf(b0[j]); h1[1][j] *= a1[j] * __builtin_amdgcn_rcpf(b1[j]); }
    }
};
struct EpiResid {
    static constexpr bool PAIR_M = false; static constexpr bool SEG = false;
    struct Pre { u32x4 x0, x1; };
    const bf16_t* x; bf16_t* y;
    __device__ __forceinline__ void pre(const GUnit& u, int r, int c, Pre& p) const { const bf16_t* xp = x + (size_t)(u.row0 + r) * D + u.pn * 256 + c; p.x0 = *(const u32x4*)xp; p.x1 = *(const u32x4*)(xp + 128); }
    __device__ __forceinline__ void fin(const GUnit& u, int r, int c, const f32x4 (&a)[2][2], const Pre& p) const {
        f32x4 x0, x1, y0, y1; un8(p.x0, x0, x1); un8(p.x1, y0, y1);
        bf16_t* o = y + (size_t)(u.row0 + r) * D + u.pn * 256 + c; st_bf16x8(o, x0 * ALPHA + a[0][0], x1 * ALPHA + a[0][1]); st_bf16x8(o + 128, y0 * ALPHA + a[1][0], y1 * ALPHA + a[1][1]); }
};
struct EpiQKV {
    static constexpr bool PAIR_M = false; static constexpr bool SEG = false; typedef NoPre Pre; int pad_;
    __device__ __forceinline__ void pre(const GUnit&, int, int, Pre&) const {}
    __device__ __forceinline__ void fin(const GUnit& u, int r, int c, const f32x4 (&a)[2][2], const Pre&) const {
        bf16_t* o = u.dst + (size_t)(u.row0 + r) * W + u.pn * 256 + c; st_bf16x8(o, a[0][0], a[0][1]); st_bf16x8(o + 128, a[1][0], a[1][1]); }
};
struct EpiSwiglu {
    static constexpr bool SEG = false; static constexpr bool PAIR_M = true;
    struct Pre { float w; };
    const float* wsl; unsigned char* hb;
    __device__ __forceinline__ void pre(const GUnit& u, int r, int, Pre& p) const { p.w = wsl[u.row0 + r] * H8_SCALE; }
    __device__ __forceinline__ u32x2 act(const f32x4 (&a)[2][2], float w) const { f32x4 o[2];
#pragma unroll
        for (int n = 0; n < 2; ++n)
#pragma unroll
            for (int j = 0; j < 4; ++j) o[n][j] = a[0][n][j] * sigmoidf_(a[0][n][j]) * a[1][n][j] * w;
        u32x2 w8; w8.x = pack_fp8x4(o[0][0], o[0][1], o[0][2], o[0][3]); w8.y = pack_fp8x4(o[1][0], o[1][1], o[1][2], o[1][3]); return w8; }
    __device__ __forceinline__ void fin2(const GUnit& u, int r0, int r1, int c, const f32x4 (&a0)[2][2], const f32x4 (&a1)[2][2], const Pre& p0, const Pre& p1) const {
        u32x2 v0 = act(a0, p0.w), v1 = act(a1, p1.w);
        { const auto rx = __builtin_amdgcn_permlane32_swap(v0.x, v1.x, false, false); v0.x = rx[0]; v1.x = rx[1]; const auto ry = __builtin_amdgcn_permlane32_swap(v0.y, v1.y, false, false); v0.y = ry[0]; v1.y = ry[1]; }
        const bool up = (threadIdx.x & 32u) != 0u;
        unsigned char* o = hb + (size_t)(u.row0 + (up ? r1 : r0)) * ED + u.pn * 128 + (up ? c - 8 : c);
        u32x4 w; w[0] = v0.x; w[1] = v0.y; w[2] = v1.x; w[3] = v1.y; *(u32x4*)o = w; }
    __device__ __forceinline__ void fin(const GUnit&, int, int, const f32x4 (&)[2][2], const Pre&) const {}
};
struct EpiDown {
    static constexpr bool PAIR_M = false; static constexpr bool SEG = false; typedef NoPre Pre;
    unsigned char* yb;
    __device__ __forceinline__ void pre(const GUnit&, int, int, Pre&) const {}
    __device__ __forceinline__ void fin(const GUnit& u, int r, int c, const f32x4 (&a)[2][2], const Pre&) const {
        u32x2 w0, w1; w0.x = pack_fp8x4(a[0][0][0], a[0][0][1], a[0][0][2], a[0][0][3]); w0.y = pack_fp8x4(a[0][1][0], a[0][1][1], a[0][1][2], a[0][1][3]);
        w1.x = pack_fp8x4(a[1][0][0], a[1][0][1], a[1][0][2], a[1][0][3]); w1.y = pack_fp8x4(a[1][1][0], a[1][1][1], a[1][1][2], a[1][1][3]);
        { const auto rx = __builtin_amdgcn_permlane32_swap(w0.x, w1.x, false, false); w0.x = rx[0]; w1.x = rx[1]; const auto ry = __builtin_amdgcn_permlane32_swap(w0.y, w1.y, false, false); w0.y = ry[0]; w1.y = ry[1]; }
        const bool up = (threadIdx.x & 32u) != 0u;
        unsigned char* o = yb + (size_t)(u.row0 + r) * D + u.pn * 256 + (up ? 128 + c - 8 : c);
        u32x4 w; w[0] = w0.x; w[1] = w0.y; w[2] = w1.x; w[3] = w1.y; *(u32x4*)o = w; }
};

typedef short bf16x8 __attribute__((ext_vector_type(8)));
typedef short s16x4 __attribute__((ext_vector_type(4)));
__device__ __forceinline__ s16x4 lds_tr(const LAS bf16_t* p) { return __builtin_amdgcn_ds_read_tr16_b64_v4i16((LAS s16x4*)p); }
__device__ __forceinline__ bf16x8 cat4(s16x4 a, s16x4 b) { bf16x8 r; r[0] = a[0]; r[1] = a[1]; r[2] = a[2]; r[3] = a[3]; r[4] = b[0]; r[5] = b[1]; r[6] = b[2]; r[7] = b[3]; return r; }
__device__ __forceinline__ bf16x8 pack8(f32x4 a, f32x4 b) { union { u32x4 u; bf16x8 h; } c; c.u[0] = pack2(a[0], a[1]); c.u[1] = pack2(a[2], a[3]); c.u[2] = pack2(b[0], b[1]); c.u[3] = pack2(b[2], b[3]); return c.h; }
constexpr int BK = 64, HTB = 128 * BK * 2;
__device__ __forceinline__ int lds_byte(int r, int c) { const int st = (r >> 4) * 2 + (c >> 5), rr = r & 15, cc = c & 31, ob = rr * 64 + cc * 2; return st * 1024 + (ob ^ (((ob >> 9) & 1) << 5)); }
__device__ __forceinline__ void stage_rc(int b, int& R, int& C) { const int st = b / 1024, sb = b % 1024, swz = sb ^ (((sb >> 9) & 1) << 5); R = (st >> 1) * 16 + swz / 64; C = (st & 1) * 32 + (swz % 64) / 2; }

typedef int i32x8 __attribute__((ext_vector_type(8)));
typedef int i32x4 __attribute__((ext_vector_type(4)));
template <class Epi, class Sched, int MODE = 0>
__device__ __forceinline__ void gemm_phase_mfma(const Frame& F, const int K, const Sched& S, const Epi& E, const float oscale = 1.0f, const float* rowscale = nullptr) {
    constexpr bool FP8 = (MODE == 1), I8 = (MODE == 2);
    LAS unsigned char* lds = F.lds;
    const int tid = F.tid, wid = F.wave, lane = F.lane, wr = wid >> 2, wc = wid & 3, fr = lane & 15, fq = lane >> 4;
    const int KB = MODE ? K : 2 * K;
    const int nt = KB / 128;
    unsigned voffB[2];
#pragma unroll
    for (int i = 0; i < 2; ++i) { int R, C; stage_rc(tid * 16 + i * 8192, R, C); const int rho = R & 31, q4 = (rho & 15) >> 2, Rb = (R & ~31) + 8 * (((q4 & 1) << 1) | (q4 >> 1)) + 4 * (rho >> 4) + (rho & 3); voffB[i] = (unsigned)(Rb * KB + C * 2); }
    const size_t kstep = (size_t)(BK * 2);
    const size_t hstepB = (size_t)128 * KB;
    const unsigned ldsw = (unsigned)wid * 1024u;
    const int aoff = FP8 ? lds_byte(wr * 64 + fr, fq * 16) : lds_byte(wr * 64 + fr, fq * 8), boff = FP8 ? lds_byte(wc * 32 + fr, fq * 16) : lds_byte(wc * 32 + fr, fq * 8);
#define SA_(b, h) (((b) * 2 + (h)) * HTB)
#define SB_(b, h) ((4 + (b) * 2 + (h)) * HTB)
#define STAGE_(bufoff, gbase, voff) do { _Pragma("unroll") for (int _i = 0; _i < 2; ++_i) \
        __builtin_amdgcn_global_load_lds((const unsigned*)((const char*)(gbase) + (voff)[_i]), (LAS unsigned*)(lds + (bufoff) + ldsw + _i * 8192), 16, 0, 0); } while (0)
#define LDA_(dst, b, h) do { _Pragma("unroll") for (int m = 0; m < 4; ++m) { if constexpr (FP8) { const i32x4 _lo = *(const LAS i32x4*)(lds + SA_(b, h) + aoff + m * 2048), _hi = *(const LAS i32x4*)(lds + SA_(b, h) + aoff + m * 2048 + 16); \
            dst##8[m] = __builtin_shufflevector(_lo, _hi, 0, 1, 2, 3, 4, 5, 6, 7); } \
        else { _Pragma("unroll") for (int k = 0; k < 2; ++k) dst[m][k] = *(const LAS bf16x8*)(lds + SA_(b, h) + aoff + m * 2048 + k * 1024); } } } while (0)
#define LDB_(dst, b, h) do { _Pragma("unroll") for (int n = 0; n < 2; ++n) { if constexpr (FP8) { const i32x4 _lo = *(const LAS i32x4*)(lds + SB_(b, h) + boff + n * 2048), _hi = *(const LAS i32x4*)(lds + SB_(b, h) + boff + n * 2048 + 16); \
            dst##8[n] = __builtin_shufflevector(_lo, _hi, 0, 1, 2, 3, 4, 5, 6, 7); } \
        else { _Pragma("unroll") for (int k = 0; k < 2; ++k) dst[n][k] = *(const LAS bf16x8*)(lds + SB_(b, h) + boff + n * 2048 + k * 1024); } } } while (0)
#define MMA_(ai, bj, At, Bt) do { __builtin_amdgcn_s_setprio(1); _Pragma("unroll") for (int m = 0; m < 4; ++m) _Pragma("unroll") for (int n = 0; n < 2; ++n) { \
        if constexpr (FP8) asm volatile("v_mfma_scale_f32_16x16x128_f8f6f4 %0, %1, %2, %0, %3, %3 op_sel_hi:[0,0,0]" : "+v"(acc[ai][bj][m][n]) : "v"(Bt##8[n]), "v"(At##8[m]), "v"(sc8)); \
        else if constexpr (I8) { _Pragma("unroll") for (int k = 0; k < 2; ++k) acci[ai][bj][m][n] = __builtin_amdgcn_mfma_i32_16x16x64_i8(__builtin_bit_cast(i32x4, Bt[n][k]), __builtin_bit_cast(i32x4, At[m][k]), acci[ai][bj][m][n], 0, 0, 0); } \
        else { _Pragma("unroll") for (int k = 0; k < 2; ++k) acc[ai][bj][m][n] = __builtin_amdgcn_mfma_f32_16x16x32_bf16(Bt[n][k], At[m][k], acc[ai][bj][m][n], 0, 0, 0); } } \
        __builtin_amdgcn_s_setprio(0); } while (0)
#define WAIT_V_(n) asm volatile("s_waitcnt vmcnt(" #n ")" ::: "memory")
#define WAIT_L_(n) asm volatile("s_waitcnt lgkmcnt(" #n ")" ::: "memory")
#define BAR_ __builtin_amdgcn_s_barrier()
#define SCHED_ __builtin_amdgcn_sched_barrier(0)
#define VOFFS_(dst, u) do { int _tz = tid; asm volatile("" : "+v"(_tz)); _Pragma("unroll") for (int _i = 0; _i < 2; ++_i) { int _R, _C; stage_rc(_tz * 16 + _i * 8192, _R, _C); \
        _Pragma("unroll") for (int _h = 0; _h < 2; ++_h) { const int _r = _h * 128 + _R; \
        const unsigned _row = (u).gather ? (unsigned)(u).gather[_r] : (unsigned)((u).row0 + _r); dst[_h][_i] = _row * (unsigned)KB + (unsigned)_C * 2u; } } } while (0)
    GUnit cur, nxt; int ui = 0;
    if (!S.get(0, cur)) return;
    f32x4 acc[2][2][4][2]; i32x4 acci[2][2][4][2];
#pragma unroll
    for (int a = 0; a < 2; ++a)
#pragma unroll
        for (int b = 0; b < 2; ++b)
#pragma unroll
            for (int m = 0; m < 4; ++m)
#pragma unroll
                for (int n = 0; n < 2; ++n) { acc[a][b][m][n] = (f32x4){0.f, 0.f, 0.f, 0.f}; acci[a][b][m][n] = (i32x4){0, 0, 0, 0}; }
    bf16x8 At[4][2], B0[2][2], B1[2][2]; i32x8 At8[4], B08[2], B18[2];
    int sc8 = 0x7f7f7f7f; asm volatile("" : "+v"(sc8));
    unsigned vA[2][2], vN[2][2];
    VOFFS_(vA, cur);
    const char* cA = (const char*)cur.A; const char* cB = (const char*)cur.Bt;
    STAGE_(SB_(0, 0), cB, voffB); STAGE_(SA_(0, 0), cA, vA[0]); STAGE_(SB_(0, 1), cB + hstepB, voffB); STAGE_(SA_(0, 1), cA, vA[1]);
    if (wr == 1) BAR_;
    WAIT_V_(4); BAR_;
    STAGE_(SB_(1, 0), cB + kstep, voffB); STAGE_(SA_(1, 0), cA + kstep, vA[0]); STAGE_(SB_(1, 1), cB + hstepB + kstep, voffB);
    WAIT_V_(6); BAR_;
    for (;;) {
        const bool has_next = S.get(ui + 1, nxt);
        const char* nA = has_next ? (const char*)nxt.A : cA; const char* nB = has_next ? (const char*)nxt.Bt : cB;
        if (has_next) { VOFFS_(vN, nxt); }
        for (int t = 0; t < nt; t += 2) {
            const bool last = (t == nt - 2);
            if constexpr (Epi::SEG) { if (t > 0 && (t & 7) == 0) {
                int tz = tid; asm volatile("" : "+v"(tz)); const int er = ((tz >> 8) & 1) * 64 + (tz & 15), ec = ((tz >> 6) & 3) * 32 + ((((tz >> 4) & 1) << 1) | ((tz >> 5) & 1)) * 8;
#pragma unroll
                for (int ai = 0; ai < 2; ++ai) { typename Epi::SPre sp[4];
#pragma unroll
                    for (int m = 0; m < 4; ++m) E.seg_pre(cur, ai * 128 + m * 16 + er, ec, (t >> 3) - 1, sp[m]);
#pragma unroll
                    for (int m = 0; m < 4; ++m) E.seg_fin(acc[ai][0][m], acc[ai][1][m], sp[m]);
                    asm volatile("" ::: "memory"); }
            } }
            const char* a1 = cA + (size_t)(t + 1) * kstep;
            const char* a2 = last ? nA : cA + (size_t)(t + 2) * kstep; const char* b2 = last ? nB : cB + (size_t)(t + 2) * kstep;
            const char* a3 = a2 + kstep; const char* b3 = b2 + kstep;
            unsigned w0[2], w1[2];
#pragma unroll
            for (int i = 0; i < 2; ++i) { w0[i] = (last && has_next) ? vN[0][i] : vA[0][i]; w1[i] = (last && has_next) ? vN[1][i] : vA[1][i]; }
            LDB_(B0, 0, 0); SCHED_; LDA_(At, 0, 0); STAGE_(SA_(1, 1), a1, vA[1]);
            WAIT_L_(8); BAR_; WAIT_L_(0); MMA_(0, 0, At, B0); BAR_; SCHED_;
            LDB_(B1, 0, 1); STAGE_(SB_(0, 0), b2, voffB);
            BAR_; WAIT_L_(0); MMA_(0, 1, At, B1); BAR_;
            LDA_(At, 0, 1); STAGE_(SA_(0, 0), a2, w0);
            BAR_; WAIT_L_(0); MMA_(1, 0, At, B0); BAR_; SCHED_;
            STAGE_(SB_(0, 1), b2 + hstepB, voffB);
            WAIT_V_(6); BAR_; MMA_(1, 1, At, B1); BAR_;
            LDB_(B0, 1, 0); SCHED_; LDA_(At, 1, 0); STAGE_(SA_(0, 1), a2, w1);
            WAIT_L_(8); BAR_; WAIT_L_(0); MMA_(0, 0, At, B0); BAR_; SCHED_;
            LDB_(B1, 1, 1); STAGE_(SB_(1, 0), b3, voffB);
            BAR_; WAIT_L_(0); MMA_(0, 1, At, B1); BAR_;
            LDA_(At, 1, 1); STAGE_(SA_(1, 0), a3, w0);
            BAR_; WAIT_L_(0); MMA_(1, 0, At, B0); BAR_; SCHED_;
            STAGE_(SB_(1, 1), b3 + hstepB, voffB);
            WAIT_V_(6); BAR_; MMA_(1, 1, At, B1); BAR_;
        }
        { int tz = tid; asm volatile("" : "+v"(tz)); const int er = ((tz >> 8) & 1) * 64 + (tz & 15), ec = ((tz >> 6) & 3) * 32 + ((((tz >> 4) & 1) << 1) | ((tz >> 5) & 1)) * 8;
          typename Epi::Pre pre[2][4];
#pragma unroll
          for (int ai = 0; ai < 2; ++ai)
#pragma unroll
              for (int m = 0; m < 4; ++m) E.pre(cur, ai * 128 + m * 16 + er, ec, pre[ai][m]);
          if constexpr (I8) {
#pragma unroll
              for (int ai = 0; ai < 2; ++ai)
#pragma unroll
                  for (int m = 0; m < 4; ++m) { const float rs = rowscale[cur.row0 + ai * 128 + m * 16 + er] * oscale * Epi::unit_scale(cur);
#pragma unroll
                      for (int bj = 0; bj < 2; ++bj)
#pragma unroll
                          for (int n = 0; n < 2; ++n)
#pragma unroll
                              for (int j = 0; j < 4; ++j) acc[ai][bj][m][n][j] = (float)acci[ai][bj][m][n][j] * rs; } }
          if constexpr (FP8) {
#pragma unroll
              for (int ai = 0; ai < 2; ++ai)
#pragma unroll
                  for (int bj = 0; bj < 2; ++bj)
#pragma unroll
                      for (int m = 0; m < 4; ++m)
#pragma unroll
                          for (int n = 0; n < 2; ++n) acc[ai][bj][m][n] *= oscale; }
          if constexpr (Epi::PAIR_M) {
#pragma unroll
          for (int ai = 0; ai < 2; ++ai)
#pragma unroll
              for (int m = 0; m < 4; m += 2) { const f32x4 a4[2][2] = {{acc[ai][0][m][0], acc[ai][0][m][1]}, {acc[ai][1][m][0], acc[ai][1][m][1]}}; const f32x4 b4[2][2] = {{acc[ai][0][m + 1][0], acc[ai][0][m + 1][1]}, {acc[ai][1][m + 1][0], acc[ai][1][m + 1][1]}};
                  E.fin2(cur, ai * 128 + m * 16 + er, ai * 128 + (m + 1) * 16 + er, ec, a4, b4, pre[ai][m], pre[ai][m + 1]); }
          } else {
#pragma unroll
          for (int ai = 0; ai < 2; ++ai)
#pragma unroll
              for (int m = 0; m < 4; ++m) { const f32x4 a4[2][2] = {{acc[ai][0][m][0], acc[ai][0][m][1]}, {acc[ai][1][m][0], acc[ai][1][m][1]}}; E.fin(cur, ai * 128 + m * 16 + er, ec, a4, pre[ai][m]); } } }
        if (!has_next) break;
#pragma unroll
        for (int a = 0; a < 2; ++a)
#pragma unroll
            for (int b = 0; b < 2; ++b)
#pragma unroll
                for (int m = 0; m < 4; ++m)
#pragma unroll
                    for (int n = 0; n < 2; ++n) { acc[a][b][m][n] = (f32x4){0.f, 0.f, 0.f, 0.f}; acci[a][b][m][n] = (i32x4){0, 0, 0, 0}; }
        cur = nxt; cA = nA; cB = nB; ++ui;
#pragma unroll
        for (int h = 0; h < 2; ++h)
#pragma unroll
            for (int i = 0; i < 2; ++i) vA[h][i] = vN[h][i];
    }
    WAIT_V_(0);
    if (wr == 0) BAR_;
    BAR_;
#undef SA_
#undef SB_
#undef STAGE_
#undef LDA_
#undef LDB_
#undef MMA_
#undef WAIT_V_
#undef WAIT_L_
#undef BAR_
#undef SCHED_
#undef VOFFS_
}

struct DenseSched {
    const bf16_t* A; const bf16_t* Bt; int K, nM, nN, nwg, G, c, i0, i1, split, pnoff;
    __device__ __forceinline__ void segment(int sg) { i0 = sg == 0 ? 0 : split; i1 = sg == 0 ? split : (1 << 30); }
    __device__ __forceinline__ bool get(int ii, GUnit& u) const {
        const int i = ii + i0; if (i >= i1) return false;
        const long L = (long)i * G + c; if (L >= nwg) return false;
        int wgid = (int)L; { const int q = nwg / 8, r = nwg % 8, xcd = wgid % 8, off = wgid / 8; wgid = (xcd < r ? xcd * (q + 1) : r * (q + 1) + (xcd - r) * q) + off; }
        const int nig = 8 * nN, gid = wgid / nig, fm = gid * 8, gsz = (nM - fm) < 8 ? (nM - fm) : 8;
        const int pm = fm + ((wgid % nig) % gsz), pn = (wgid % nig) / gsz;
        u.pn = pn + pnoff; u.row0 = pm * 256; u.A = A; u.gather = nullptr; u.Bt = Bt + (size_t)pn * 256 * K; u.e = 0; return true;
    }
};
struct QkvSched {
    unsigned char* ws; int l, G, c;
    __device__ __forceinline__ bool get(int i, GUnit& g) const {
        const int u = i * G + c; if (u >= 144) return false; g.gather = nullptr;
        if (u < 128) { g.e = 0; g.pn = u & 1; g.row0 = (u >> 1) * 256; g.A = (const bf16_t*)(ws + WS_XB); g.Bt = (const bf16_t*)(ws + WS_WQ + l * SZ_WQ) + (size_t)g.pn * 256 * D; g.dst = (bf16_t*)(ws + WS_Q); }
        else { const int v = u - 128; g.e = 1 + (v >> 3); g.pn = v & 1; g.row0 = ((v >> 1) & 3) * 256; g.A = (const bf16_t*)(ws + WS_MEMB); g.Bt = (const bf16_t*)(ws + (g.e == 1 ? WS_WK : WS_WV) + l * SZ_WQ) + (size_t)g.pn * 256 * D; g.dst = (bf16_t*)(ws + (g.e == 1 ? WS_KM : WS_VM)) + (size_t)l * TM * W; }
        return true;
    }
};
template <int NCT, bool GATEUP> struct MoeSched {
    unsigned char* ws; const LAS int* pst; int l, G, c, nunits;
    __device__ __forceinline__ bool get(int i, GUnit& g) const {
        const int u = i * G + c; if (u >= nunits) return false;
        const int rt = u / NCT; g.pn = u % NCT; g.row0 = rt * 256; const int e = __builtin_amdgcn_readfirstlane((int)((const LAS unsigned char*)(pst + 68))[rt]); g.e = e;
        if (GATEUP) { g.A = (const bf16_t*)(ws + WS_XB8); g.gather = (const int*)(ws + WS_TOK) + g.row0; g.Bt = (const bf16_t*)(ws + WS_WGU8 + ((size_t)l * NEX + e) * SZ_WGU8 + (size_t)g.pn * 256 * D); }
        else { g.A = (const bf16_t*)(ws + WS_HB); g.gather = nullptr; g.Bt = (const bf16_t*)(ws + WS_WDN + ((size_t)l * NEX + e) * SZ_WDN1 + (size_t)g.pn * 256 * ED); }
        return true;
    }
};

struct TDesc { const float* sp; int sld; unsigned char* dp; int dldb; int fp8; float qs; };
constexpr int TK_WINA = 1024, TK_WINB = 2560, TK_BR = 384, TK_WOUT = 512, TK_QKV = 384, TK_WO = 128, TK_GU = NEX * 8 * 32, TK_DN = NEX * 128;
constexpr int TK_L0DEF = TK_BR + TK_WOUT + TK_QKV + TK_WO + TK_GU + TK_DN, TK_LAYER = TK_WINA + TK_WINB + TK_L0DEF;
__device__ __forceinline__ void tile_desc(const Frame& F, int l, int t, TDesc& d) {
    const KArgs a = F.ka; unsigned char* ws = F.ws_(); d.fp8 = 0; d.qs = W8_SCALE;
    if (t < TK_WINA) { const int tk = t >> 6, tc = t & 63; d.sp = ((const float*)a->in[IN_WIN]) + (size_t)l * D * PROJ_W + (size_t)tk * 128 * PROJ_W + tc * 64; d.sld = PROJ_W; d.dldb = D; d.fp8 = 2; d.qs = 127.0f / fmaxf(__uint_as_float(((const unsigned*)(ws + WS_CTL))[CW_WABS + l]), 1e-30f); d.dp = ws + WS_WINQ + l * SZ_WINQ + (size_t)tc * 64 * D + tk * 128; return; }
    t -= TK_WINA;
    if (t < TK_WINB) { const int tk = t / 160, tc = t % 160; d.sp = ((const float*)a->in[IN_WIN]) + (size_t)l * D * PROJ_W + (size_t)tk * 128 * PROJ_W + 4104 + tc * 64; d.sld = PROJ_W;
        if (tc < 32) { d.dldb = D; d.fp8 = 2; d.qs = 127.0f / fmaxf(__uint_as_float(((const unsigned*)(ws + WS_CTL))[CW_WABS + l]), 1e-30f); d.dp = ws + WS_WINQ + l * SZ_WINQ + (size_t)(4096 + tc * 64) * D + tk * 128; }
        else { d.dldb = D; d.fp8 = 1; d.dp = ws + WS_WIN8 + l * SZ_WIN8 + (size_t)(4096 + tc * 64) * D + tk * 128; }
        return; }
    t -= TK_WINB;
    if (t < TK_BR) { const int n = 1 + (t >> 7), tt = t & 127, tk = tt >> 5, tc = tt & 31; d.sp = ((const float*)a->in[IN_WBR]) + ((size_t)l * 4 + n) * W * D + (size_t)tk * 128 * D + tc * 64; d.sld = D; d.dldb = D * 2; d.dp = ws + WS_WB + l * SZ_DD + ((size_t)tc * 64 * D + n * W + tk * 128) * 2; return; }
    t -= TK_BR;
    if (t < TK_WOUT) { const int tk = t >> 5, tc = t & 31; d.sp = ((const float*)a->in[IN_WMIX]) + (size_t)l * D * D + (size_t)tk * 128 * D + tc * 64; d.sld = D; d.dldb = D * 2; d.dp = ws + WS_WOUT + l * SZ_DD + ((size_t)tc * 64 * D + tk * 128) * 2; return; }
    t -= TK_WOUT;
    if (t < TK_QKV) { const int which = t >> 7, tt = t & 127, tk = tt >> 3, tc = tt & 7; d.sp = (const float*)a->in[which == 0 ? IN_WQ : (which == 1 ? IN_WK : IN_WV)] + (size_t)l * D * W + (size_t)tk * 128 * W + tc * 64; d.sld = W; d.dldb = D * 2;
        d.dp = ws + (which == 0 ? WS_WQ : (which == 1 ? WS_WK : WS_WV)) + l * SZ_WQ + ((size_t)tc * 64 * D + tk * 128) * 2; return; }
    t -= TK_QKV;
    if (t < TK_WO) { const int tk = t >> 5, tc = t & 31; d.sp = ((const float*)a->in[IN_WO]) + (size_t)l * W * D + (size_t)tk * 128 * D + tc * 64; d.sld = D; d.dldb = W * 2; d.dp = ws + WS_WO + l * SZ_WQ + ((size_t)tc * 64 * W + tk * 128) * 2; return; }
    t -= TK_WO;
    if (t < TK_GU) { const int tt = t & 31, job = t >> 5, half = job & 1, j = (job >> 1) & 3, e = job >> 3, tk = tt >> 1, tc = tt & 1;
        d.sp = (e < NE ? ((const float*)a->in[IN_WGU]) + ((size_t)l * NE + e) * D * 1024 : ((const float*)a->in[IN_SGU]) + (size_t)l * D * 1024) + half * 512 + j * 128 + (size_t)tk * 128 * 1024 + tc * 64; d.sld = 1024; d.dldb = D; d.fp8 = 1;
        d.dp = ws + WS_WGU8 + ((size_t)l * NEX + e) * SZ_WGU8 + (size_t)(j * 256 + half * 128 + tc * 64) * D + tk * 128; return; }
    t -= TK_GU;
    { const int tt = t & 127, e = t >> 7, tk = tt >> 5, tc = tt & 31;
      d.sp = (e < NE ? ((const float*)a->in[IN_WDN]) + ((size_t)l * NE + e) * ED * D : ((const float*)a->in[IN_SDN]) + (size_t)l * ED * D) + (size_t)tk * 128 * D + tc * 64; d.sld = D; d.dldb = ED; d.fp8 = 1;
      d.dp = ws + WS_WDN + ((size_t)l * NEX + e) * SZ_WDN1 + (size_t)tc * 64 * ED + tk * 128; }
}
constexpr int XP_SLOT = 64 * 256;
template <int NB> struct XRegs { f32x4 r[NB][4]; };
template <int NB> __device__ __forceinline__ void xpose_load(const Frame& F, int l, int t0, int tstep, int n, XRegs<NB>& X) {
    const int tid = F.tid, row4 = (tid >> 4) * 4, cq = (tid & 15) * 4;
#pragma unroll
    for (int b = 0; b < NB; ++b) if (b < n) { TDesc d; tile_desc(F, l, t0 + b * tstep, d); const float* sp = d.sp + (size_t)row4 * d.sld + cq;
#pragma unroll
        for (int q = 0; q < 4; ++q) X.r[b][q] = __builtin_nontemporal_load((const f32x4*)(sp + (size_t)q * d.sld)); }
}
template <int NB> __device__ __forceinline__ void xpose_finish(const Frame& F, int l, int t0, int tstep, int n, const XRegs<NB>& X) {
    const int tid = F.tid, row4 = (tid >> 4) * 4, cq = (tid & 15) * 4;
    int t1 = t0; asm volatile("" : "+s"(t1));
#pragma unroll
    for (int b = 0; b < NB; ++b) if (b < n) { TDesc d; tile_desc(F, l, t1 + b * tstep, d); LAS unsigned char* L = F.lds + b * XP_SLOT;
        if (d.fp8) { const int sw = ((cq >> 2) & 7) << 4;
#pragma unroll
            for (int j = 0; j < 4; ++j) *(LAS unsigned*)(L + (cq + j) * 128 + (row4 ^ sw)) = (d.fp8 == 2) ? pack_i8x4(X.r[b][0][j] * d.qs, X.r[b][1][j] * d.qs, X.r[b][2][j] * d.qs, X.r[b][3][j] * d.qs) : pack_fp8x4(X.r[b][0][j] * W8_SCALE, X.r[b][1][j] * W8_SCALE, X.r[b][2][j] * W8_SCALE, X.r[b][3][j] * W8_SCALE);
        } else { const int sw = ((cq >> 2) & 15) << 4;
#pragma unroll
            for (int j = 0; j < 4; ++j) { u32x2 w; w.x = pack2(X.r[b][0][j], X.r[b][1][j]); w.y = pack2(X.r[b][2][j], X.r[b][3][j]); *(LAS u32x2*)(L + (cq + j) * 256 + ((row4 * 2) ^ sw)) = w; } } }
    __syncthreads();
    int t2 = t0; asm volatile("" : "+s"(t2));
#pragma unroll
    for (int b = 0; b < NB; ++b) if (b < n) { TDesc d; tile_desc(F, l, t2 + b * tstep, d); const LAS unsigned char* L = F.lds + b * XP_SLOT; const int c = tid >> 3, kq = tid & 7;
        if (d.fp8) *(u32x4*)(d.dp + (size_t)c * d.dldb + kq * 16) = *(const LAS u32x4*)(L + c * 128 + ((kq * 16) ^ (((c >> 2) & 7) << 4)));
        else { const int sw = ((c >> 2) & 15) << 4; *(u32x4*)(d.dp + (size_t)c * d.dldb + kq * 16) = *(const LAS u32x4*)(L + c * 256 + ((kq * 16) ^ sw)); *(u32x4*)(d.dp + (size_t)c * d.dldb + 128 + kq * 16) = *(const LAS u32x4*)(L + c * 256 + ((128 + kq * 16) ^ sw)); } }
    __syncthreads();
}
__device__ __forceinline__ void xpose_range(const Frame& F, int l, int tlo, int thi, int rank, int nranks) {
    constexpr int NB = 4; const int step = nranks * NB;
    XRegs<NB> A, B;
    int t = tlo + rank * NB; if (t >= thi) return;
#define XP_CNT(tt) (((thi) - (tt)) < NB ? ((thi) - (tt)) : NB)
    xpose_load<NB>(F, l, t, 1, XP_CNT(t), A);
    for (;;) {
        const int tb = t + step; const bool hb = tb < thi; if (hb) xpose_load<NB>(F, l, tb, 1, XP_CNT(tb), B);
        xpose_finish<NB>(F, l, t, 1, XP_CNT(t), A);
        if (!hb) break;
        const int ta = tb + step; const bool ha = ta < thi; if (ha) xpose_load<NB>(F, l, ta, 1, XP_CNT(ta), A);
        xpose_finish<NB>(F, l, tb, 1, XP_CNT(tb), B);
        if (!ha) break;
        t = ta;
    }
#undef XP_CNT
}
__device__ __forceinline__ void pool_fold(const Frame& F, int l, int rank, int nranks) {
    const KArgs a = F.ka; unsigned char* ws = F.ws_();
    for (size_t i = (size_t)rank * NTHR + F.tid; i < (size_t)W * D; i += (size_t)nranks * NTHR) {
        const int d = (int)(i % D), gc = (int)(i / D), g = gc >> 7;
        const float* pw = ((const float*)a->in[IN_POOLW]) + ((size_t)l * W + gc) * 128; const float* ps = ((const float*)a->in[IN_POOLS]) + l * W + g * 128;
        const float* wb = ((const float*)a->in[IN_WBR]) + ((size_t)l * 4 * W + g * 128) * D + d;
        float s = 0.f;
        for (int e = 0; e < 128; ++e) s += pw[e] * ps[e] * wb[(size_t)e * D];
        ((bf16_t*)(ws + WS_WB + l * SZ_DD))[(size_t)d * D + gc] = f2bf(s);
    }
}
__device__ __forceinline__ void phase_wabs(const Frame& F) {
    const KArgs a = F.ka; unsigned char* ws = F.ws_();
    for (int l = 0; l < DEPTH; ++l) { float m = 0.f; const float* w = ((const float*)a->in[IN_WIN]) + (size_t)l * D * PROJ_W;
        for (size_t i = (size_t)F.wg * NTHR + F.tid; i < (size_t)D * (NBR / 4); i += (size_t)F.nwg * NTHR) { const int c4 = (int)(i % (NBR / 4)), k = (int)(i / (NBR / 4)); const int col = c4 * 4 < 4096 ? c4 * 4 : c4 * 4 + 8;
            const f32x4 v = *(const f32x4*)(w + (size_t)k * PROJ_W + col); m = fmaxf(m, fmaxf(fmaxf(fabsf(v[0]), fabsf(v[1])), fmaxf(fabsf(v[2]), fabsf(v[3])))); }
        m = wave_max(m);
        if (F.lane == 0) __hip_atomic_fetch_max((unsigned*)(ws + WS_CTL) + CW_WABS + l, __float_as_uint(m), __ATOMIC_RELAXED, __HIP_MEMORY_SCOPE_AGENT); }
}
__device__ __forceinline__ void phase_prologue(const Frame& F) {
    const KArgs a = F.ka;
    unsigned char* ws = F.ws_();
    xpose_range(F, 0, 0, TK_WINA + TK_WINB, F.wg, F.nwg);
    const size_t gtid = (size_t)F.wg * NTHR + F.tid, gn = (size_t)F.nwg * NTHR;
    for (size_t i = gtid; i < (size_t)DEPTH * 8 * D; i += gn) { const int k = (int)(i % D), c = (int)((i / D) % 8), l = (int)(i / (8 * D));
        ((float*)(ws + WS_WIF))[i] = ((const float*)a->in[IN_WIN])[(size_t)l * D * PROJ_W + (size_t)k * PROJ_W + 4096 + c]; }
    for (size_t i = gtid; i < (size_t)DEPTH * NE * D; i += gn) { const int k = (int)(i % D), e = (int)((i / D) % NE), l = (int)(i / ((size_t)NE * D));
        const float w = ((const float*)a->in[IN_RW])[((size_t)l * D + k) * NE + e]; const bf16_t hi = f2bf(w); const bf16_t lo = f2bf(w - bf2f(hi));
        bf16_t* o = (bf16_t*)(ws + WS_RWT) + (size_t)l * 2 * NE * D; o[(size_t)e * D + k] = hi; o[(size_t)(NE + e) * D + k] = lo; }
    for (size_t i = gtid; i < (size_t)SEQ * 64; i += gn) { const int f = (int)(i & 63), s = (int)(i >> 6);
        const float inv = powf(10000.0f, -(float)f / 64.0f); const float ang = (float)s * inv;
        ((float*)(ws + WS_ROPE))[i] = cosf(ang); ((float*)(ws + WS_ROPE))[(size_t)SEQ * 64 + i] = sinf(ang); }
    for (int row = F.wg * 8 + F.wave; row < T; row += F.nwg * 8) { float v[32]; const float* xr = ((const float*)a->in[IN_X]) + (size_t)row * D;
#pragma unroll
        for (int j = 0; j < 4; ++j) { const f32x4 p = *(const f32x4*)(xr + j * 512 + F.lane * 8), q = *(const f32x4*)(xr + j * 512 + F.lane * 8 + 4); v[j * 8] = p[0]; v[j * 8 + 1] = p[1]; v[j * 8 + 2] = p[2]; v[j * 8 + 3] = p[3]; v[j * 8 + 4] = q[0]; v[j * 8 + 5] = q[1]; v[j * 8 + 6] = q[2]; v[j * 8 + 7] = q[3]; }
        st_row32((bf16_t*)(ws + WS_XB) + (size_t)row * D, F.lane, v); st_row32_fp8(ws + WS_XB8 + (size_t)row * D, F.lane, v); st_row32_i8(ws + WS_XQ8 + (size_t)row * D, (float*)(ws + WS_XSC) + row, F.lane, v); }
    for (size_t i = gtid; i < (size_t)TM * D / 4; i += gn) { const f32x4 v = ((const f32x4*)((const float*)a->in[IN_MEM]))[i]; st_bf16x4((bf16_t*)(ws + WS_MEMB) + i * 4, v); }
    __syncthreads();
}
__device__ __forceinline__ void prologue_deferred(const Frame& F, int rank, int nranks) {
    xpose_range(F, 0, TK_WINA + TK_WINB, TK_LAYER, rank, nranks);
    xpose_range(F, 1, 0, TK_LAYER, rank, nranks);
    pool_fold(F, 0, rank, nranks); pool_fold(F, 1, rank, nranks);
    __syncthreads();
}

__device__ __forceinline__ void unpack8(u32x4 w, float (&f)[8]) {
#pragma unroll
    for (int j = 0; j < 4; ++j) { f[2 * j] = __uint_as_float(w[j] << 16); f[2 * j + 1] = __uint_as_float(w[j] & 0xffff0000u); } }
__device__ __forceinline__ u32x4 pack8f(const float (&f)[8]) { u32x4 w;
#pragma unroll
    for (int j = 0; j < 4; ++j) w[j] = pack2(f[2 * j], f[2 * j + 1]); return w; }
template <int WIN> __device__ __forceinline__ void pool_block(const bf16_t* pu, bf16_t* out, int s0) {
    float sum[8];
#pragma unroll
    for (int e = 0; e < 8; ++e) sum[e] = 0.f;
    u32x4 hist[WIN - 1 + 8];
#pragma unroll
    for (int j = 0; j < WIN - 1 + 8; ++j) { const int ds = j - (WIN - 1); hist[j] = (s0 + ds >= 0) ? *(const u32x4*)(pu + (ptrdiff_t)ds * NBR) : (u32x4){0u, 0u, 0u, 0u}; }
#pragma unroll
    for (int j = 0; j < WIN - 1; ++j) { float f[8]; unpack8(hist[j], f);
#pragma unroll
        for (int e = 0; e < 8; ++e) sum[e] += f[e]; }
#pragma unroll
    for (int i = 0; i < 8; ++i) { float f[8]; unpack8(hist[WIN - 1 + i], f); const int cnt = (s0 + i + 1 < WIN) ? s0 + i + 1 : WIN; const float rc = 1.0f / (float)cnt; float o[8];
#pragma unroll
        for (int e = 0; e < 8; ++e) { sum[e] += f[e]; o[e] = sum[e] * rc - f[e]; }
        *(u32x4*)(out + (size_t)i * D) = pack8f(o);
        float fo[8]; unpack8(hist[i], fo);
#pragma unroll
        for (int e = 0; e < 8; ++e) sum[e] -= fo[e]; }
}
template <bool WITH_D = true> __device__ __forceinline__ void phase_mix1v2(const Frame& F, int l, const bf16_t* xcur) {
    const KArgs a = F.ka;
    unsigned char* ws = F.ws_();
    LAS float* dots = (LAS float*)(F.lds + 65536);
    LAS float* wl = (LAS float*)F.lds;
    const float* wif = (const float*)(ws + WS_WIF) + (size_t)l * 8 * D;
    const float* gb = ((const float*)a->in[IN_GATEB]) + l * 8;
    float* cumf = (float*)(ws + WS_CUMF); float* ipre = (float*)(ws + WS_IPRE); float* summ = (float*)(ws + WS_SUMM); float* av = (float*)(ws + WS_AV); float* pm = (float*)(ws + WS_PM);
    if (F.wg < BATCH * NCH) { for (int i = F.tid; i < 8 * D / 4; i += NTHR) *(LAS f32x4*)(wl + i * 4) = *(const f32x4*)(wif + i * 4); __syncthreads(); }
    for (int item = F.wg; item < BATCH * NCH; item += F.nwg) {
        const int b = item / NCH, c = item % NCH; const int t0 = b * SEQ + c * CH;
        for (int i = 0; i < 8; i += 2) {
            const int tok = F.wave * 8 + i; const bf16_t* xr = xcur + (size_t)(t0 + tok) * D;
            float d0[8], d1[8];
#pragma unroll
            for (int q = 0; q < 8; ++q) { d0[q] = 0.f; d1[q] = 0.f; }
#pragma unroll 1
            for (int j = 0; j < 4; ++j) { float x0[8], x1[8]; unpack8(*(const u32x4*)(xr + j * 512 + F.lane * 8), x0); unpack8(*(const u32x4*)(xr + D + j * 512 + F.lane * 8), x1);
#pragma unroll
                for (int q = 0; q < 8; ++q) { const f32x4 wa = *(const LAS f32x4*)(wl + q * D + j * 512 + F.lane * 8), wb = *(const LAS f32x4*)(wl + q * D + j * 512 + F.lane * 8 + 4);
#pragma unroll
                    for (int e = 0; e < 4; ++e) { d0[q] += x0[e] * wa[e] + x0[4 + e] * wb[e]; d1[q] += x1[e] * wa[e] + x1[4 + e] * wb[e]; } } }
#pragma unroll
            for (int q = 0; q < 8; ++q) { const float s0 = wave_sum(d0[q]), s1 = wave_sum(d1[q]); if (F.lane == 0) { dots[tok * 8 + q] = s0; dots[(tok + 1) * 8 + q] = s1; } }
        }
        __syncthreads();
        if (F.wave < NH) {
            const int h = F.wave, s = F.lane; const float ip = dots[s * 8 + h] + gb[h], fp = dots[s * 8 + 4 + h] + gb[4 + h];
            const float lf = fminf(fp, 0.f) - log1pf(__expf(-fabsf(fp)));
            float cs = lf;
#pragma unroll
            for (int o = 1; o < 64; o <<= 1) { const float n = __shfl_up(cs, o); if (s >= o) cs += n; }
            const float ftot = __shfl(cs, 63); const float aa = ip - cs;
            float px = aa;
#pragma unroll
            for (int o = 1; o < 64; o <<= 1) { const float n = __shfl_up(px, o); if (s >= o) px = fmaxf(px, n); }
            const float gm = ftot + __shfl(px, 63);
            const size_t o = (size_t)(b * NH + h) * SEQ + c * CH + s; cumf[o] = cs; ipre[o] = ip; av[o] = aa; pm[o] = px;
            if (s == 0) { summ[((size_t)(b * NH + h) * NCH + c) * 2] = ftot; summ[((size_t)(b * NH + h) * NCH + c) * 2 + 1] = gm; }
        }
        __syncthreads();
    }
    bf16_t* proj = (bf16_t*)(ws + WS_PROJ); bf16_t* br = (bf16_t*)(ws + WS_BR);
    for (int it = F.wg * 8 + F.wave; it < (T / 32) * 4; it += F.nwg * 8) {
        const int grp = it & 3, tbq = it >> 2; const int tb = tbq * 4 + (F.lane >> 4), co = grp * 16 + (F.lane & 15);
        const int t0 = tb * 8, s0 = t0 % SEQ; const bf16_t* pu = proj + (size_t)t0 * NBR + PC_U + co * 8; bf16_t* out = br + (size_t)t0 * D + co * 8;
        if (grp == 0) pool_block<2>(pu, out, s0); else if (grp == 1) pool_block<4>(pu, out, s0); else if (grp == 2) pool_block<8>(pu, out, s0); else pool_block<16>(pu, out, s0);
    }
    { const float* cw = ((const float*)a->in[IN_CONVW]) + (size_t)l * 3 * W;
      for (size_t it = (size_t)F.wg * NTHR + F.tid; it < (size_t)(T / 8) * 64; it += (size_t)F.nwg * NTHR) {
        const int co = (int)(it & 63), tb = (int)(it >> 6), t0 = tb * 8, s0 = t0 % SEQ;
        const bf16_t* pr = proj + (size_t)t0 * NBR + co * 8;
        float w0[8], w1[8], w2[8];
#pragma unroll
        for (int e = 0; e < 8; ++e) { w0[e] = cw[co * 8 + e]; w1[e] = cw[W + co * 8 + e]; w2[e] = cw[2 * W + co * 8 + e]; }
        float z1[8], z2[8];
#pragma unroll
        for (int e = 0; e < 8; ++e) { z1[e] = 0.f; z2[e] = 0.f; }
        if (s0 >= 2) { float c_[8], h_[8]; unpack8(*(const u32x4*)(pr + PC_CC - 2 * NBR), c_); unpack8(*(const u32x4*)(pr + PC_CH - 2 * NBR), h_);
#pragma unroll
            for (int e = 0; e < 8; ++e) z2[e] = c_[e] * h_[e]; }
        if (s0 >= 1) { float c_[8], h_[8]; unpack8(*(const u32x4*)(pr + PC_CC - NBR), c_); unpack8(*(const u32x4*)(pr + PC_CH - NBR), h_);
#pragma unroll
            for (int e = 0; e < 8; ++e) z1[e] = c_[e] * h_[e]; }
#pragma unroll
        for (int i = 0; i < 8; ++i) { float c_[8], h_[8], b_[8], o[8]; unpack8(*(const u32x4*)(pr + PC_CC + (size_t)i * NBR), c_); unpack8(*(const u32x4*)(pr + PC_CH + (size_t)i * NBR), h_); unpack8(*(const u32x4*)(pr + PC_CB + (size_t)i * NBR), b_);
#pragma unroll
            for (int e = 0; e < 8; ++e) { const float z0 = c_[e] * h_[e]; o[e] = b_[e] * (w0[e] * z0 + w1[e] * z1[e] + w2[e] * z2[e]); z2[e] = z1[e]; z1[e] = z0; }
            *(u32x4*)(br + (size_t)(t0 + i) * D + W + co * 8) = pack8f(o); }
      } }
    if constexpr (WITH_D) { const float* ropec = (const float*)(ws + WS_ROPE); const float* ropes = ropec + (size_t)SEQ * 64;
      for (size_t it = (size_t)F.wg * NTHR + F.tid; it < (size_t)T * 64; it += (size_t)F.nwg * NTHR) {
        const int oc = (int)(it & 7), hh = (int)((it >> 3) & 3), isk = (int)((it >> 5) & 1), t = (int)(it >> 6), s = t % SEQ;
        bf16_t* p = proj + (size_t)t * NBR + (isk ? PC_RK : PC_RQ) + hh * HD + oc * 8;
        float x1[8], x2[8], o1[8], o2[8]; unpack8(*(const u32x4*)p, x1); unpack8(*(const u32x4*)(p + 64), x2);
#pragma unroll
        for (int e = 0; e < 8; ++e) { const float cs = ropec[(size_t)s * 64 + oc * 8 + e], sn = ropes[(size_t)s * 64 + oc * 8 + e]; o1[e] = x1[e] * cs - x2[e] * sn; o2[e] = x1[e] * sn + x2[e] * cs; }
        *(u32x4*)p = pack8f(o1); *(u32x4*)(p + 64) = pack8f(o2);
      } }
}

__device__ __forceinline__ float ret_gamma_log2(int h) { return log2f(1.0f - exp2f(-5.0f - (float)h)); }

__device__ __forceinline__ void phase_scan_mfma(const Frame& F) {
    unsigned char* ws = F.ws_();
    constexpr int KS2 = 144, WS2 = 48;
    LAS bf16_t* Kb = (LAS bf16_t*)F.lds;
    LAS bf16_t* Wb = Kb + 2 * 64 * KS2;
    LAS float* mS = (LAS float*)(Wb + 2 * 64 * WS2);
    LAS float* fT = mS + 80;
    const bf16_t* proj = (const bf16_t*)(ws + WS_PROJ);
    const float* av = (const float*)(ws + WS_AV); const float* summ = (const float*)(ws + WS_SUMM);
    const int lane = F.lane, g = lane >> 4, li = lane & 15, w = F.wave, tid = F.tid;
    for (int item = F.wg; item < 2 * NBH * 8; item += F.nwg) {
        const int type = item >> 7, bh = (item >> 3) & 15, vs = item & 7, b = bh >> 2, h = bh & 3;
        if (tid == 0) { float m = 0.f; mS[0] = 0.f; for (int c = 0; c < NCH; ++c) { m = fmaxf(summ[((size_t)bh * NCH + c) * 2] + m, summ[((size_t)bh * NCH + c) * 2 + 1]); mS[c + 1] = m; }
            if (type == 0 && vs == 0) { float* ms = (float*)(ws + WS_MSEQ) + bh * 80; for (int c = 0; c <= NCH; ++c) ms[c] = mS[c]; } }
        if (tid >= 64 && tid < 128) fT[tid - 64] = summ[((size_t)bh * NCH + (tid - 64)) * 2];
        __syncthreads();
        const float lg2 = ret_gamma_log2(h);
        const int kcol = (type == 0 ? PC_MK : PC_RK) + h * HD, vcol = (type == 0 ? PC_MV : PC_RV) + h * HD + vs * 16;
        bf16_t* cst = (bf16_t*)(ws + WS_CST) + ((size_t)(type * NBH + bh) * NCH) * HD * HD;
        float* nsv = (float*)(ws + WS_NST) + (size_t)bh * NCH * HD;
        const int krow = tid >> 3, koct = tid & 7, vrow = (tid >> 1) & 63, vhalf = tid & 1;
        const bf16_t* kbase = proj + (size_t)(b * SEQ + krow) * NBR + kcol + koct * 8;
        const bf16_t* vbase = proj + (size_t)(b * SEQ + vrow) * NBR + vcol + vhalf * 8;
        const float* abase = av + (size_t)bh * SEQ + vrow;
        u32x4 kr[2][2], vr[2]; float ar[2];
#define SCAN_LOAD(c, sl) do { const size_t _o = (size_t)(c) * CH * NBR; kr[sl][0] = *(const u32x4*)(kbase + _o); kr[sl][1] = *(const u32x4*)(kbase + _o + 64); \
        if (tid < 128) { vr[sl] = *(const u32x4*)(vbase + _o); ar[sl] = (type == 0) ? abase[(c) * CH] : 0.f; } } while (0)
#define SCAN_WRITE(c, sl, bf) do { LAS bf16_t* _k = Kb + (bf) * 64 * KS2 + krow * KS2 + koct * 8; *(LAS u32x4*)_k = kr[sl][0]; *(LAS u32x4*)(_k + 64) = kr[sl][1]; \
        if (tid < 128) { const float _w = (type == 0) ? __expf(ar[sl] + fT[c] - mS[(c) + 1]) : exp2f((float)(63 - vrow) * lg2); float _f[8]; unpack8(vr[sl], _f); \
            _Pragma("unroll") for (int _e = 0; _e < 8; ++_e) _f[_e] *= _w; LAS bf16_t* _p = Wb + (bf) * 64 * WS2 + vrow * WS2; *(LAS u32x4*)(_p + vhalf * 8) = pack8f(_f); \
            u32x4 _x = {0u, 0u, 0u, 0u}; if (vhalf == 0) _x[0] = (unsigned)f2bf(_w); *(LAS u32x4*)(_p + 16 + vhalf * 8) = _x; } } while (0)
        f32x4 st = {0.f, 0.f, 0.f, 0.f}, na = {0.f, 0.f, 0.f, 0.f};
#define SCAN_BODY(c, bf) do { { u32x2 _pw; _pw.x = pack2(st[0], st[1]); _pw.y = pack2(st[2], st[3]); *(u32x2*)(cst + (size_t)(c) * HD * HD + (size_t)(vs * 16 + li) * HD + 16 * w + 4 * g) = _pw; } \
        if (type == 0 && vs == 0 && li == 0) *(f32x4*)(nsv + (c) * HD + 16 * w + 4 * g) = na; \
        const float _d = (type == 0) ? __expf(fT[c] + mS[c] - mS[(c) + 1]) : exp2f(64.0f * lg2); st *= _d; na *= _d; \
        _Pragma("unroll") for (int _u = 0; _u < 2; ++_u) { const LAS bf16_t* _kp = Kb + (bf) * 64 * KS2 + (32 * _u + 8 * g + (li >> 2)) * KS2 + 16 * w + 4 * (li & 3); \
            const LAS bf16_t* _wp = Wb + (bf) * 64 * WS2 + (32 * _u + 8 * g + (li >> 2)) * WS2 + 4 * (li & 3); \
            const bf16x8 _A = cat4(lds_tr(_kp), lds_tr(_kp + 4 * KS2)); const bf16x8 _B = cat4(lds_tr(_wp), lds_tr(_wp + 4 * WS2)); \
            st = __builtin_amdgcn_mfma_f32_16x16x32_bf16(_A, _B, st, 0, 0, 0); \
            if (type == 0) { const bf16x8 _B2 = cat4(lds_tr(_wp + 16), lds_tr(_wp + 4 * WS2 + 16)); na = __builtin_amdgcn_mfma_f32_16x16x32_bf16(_A, _B2, na, 0, 0, 0); } } } while (0)
        SCAN_LOAD(0, 0); SCAN_WRITE(0, 0, 0); SCAN_LOAD(1, 1); SCAN_LOAD(2, 0);
        __syncthreads();
        for (int c = 0; c < NCH; c += 2) {
            SCAN_BODY(c, 0);
            SCAN_WRITE(c + 1, 1, 1);
            if (c + 3 < NCH) SCAN_LOAD(c + 3, 1);
            __syncthreads();
            SCAN_BODY(c + 1, 1);
            if (c + 2 < NCH) { SCAN_WRITE(c + 2, 0, 0); }
            if (c + 4 < NCH) SCAN_LOAD(c + 4, 0);
            __syncthreads();
        }
#undef SCAN_LOAD
#undef SCAN_WRITE
#undef SCAN_BODY
    }
}

__device__ __forceinline__ void phase_chunk_mfma(const Frame& F, int l) {
    const KArgs a = F.ka; unsigned char* ws = F.ws_();
    constexpr int QS = 136, VS = 144, PS = 72;
    LAS bf16_t* Qs = (LAS bf16_t*)F.lds; LAS bf16_t* Ks = Qs + 64 * QS; LAS bf16_t* Vs = Ks + 64 * QS; LAS bf16_t* Ps = Vs + 64 * VS;
    LAS float* rv = (LAS float*)(Ps + 64 * PS);
    LAS float* hp = rv + 256;
    const bf16_t* proj = (const bf16_t*)(ws + WS_PROJ); bf16_t* br = (bf16_t*)(ws + WS_BR);
    const float* cumf = (const float*)(ws + WS_CUMF); const float* av = (const float*)(ws + WS_AV); const float* pm = (const float*)(ws + WS_PM); const float* mseq = (const float*)(ws + WS_MSEQ);
    const int lane = F.lane, g = lane >> 4, li = lane & 15, w = F.wave;
    bf16x8 ones;
#pragma unroll
    for (int j = 0; j < 8; ++j) ones[j] = (short)0x3F80;
    for (int item = F.wg; item < 2 * NBH * NCH; item += F.nwg) {
        const int type = item / (NBH * NCH), bh = (item / NCH) % NBH, c = item % NCH, b = bh >> 2, h = bh & 3;
        const int t0 = b * SEQ + c * CH; const size_t go = (size_t)bh * SEQ + c * CH;
        const int qcol = (type == 0 ? PC_MQ : PC_RQ) + h * HD, kcol = (type == 0 ? PC_MK : PC_RK) + h * HD, vcol = (type == 0 ? PC_MV : PC_RV) + h * HD;
        const float lg2 = ret_gamma_log2(h);
        { const int row = F.tid >> 3, oct = F.tid & 7; const bf16_t* pr = proj + (size_t)(t0 + row) * NBR + oct * 8;
          *(LAS u32x4*)(Qs + row * QS + oct * 8) = *(const u32x4*)(pr + qcol); *(LAS u32x4*)(Qs + row * QS + 64 + oct * 8) = *(const u32x4*)(pr + qcol + 64);
          *(LAS u32x4*)(Ks + row * QS + oct * 8) = *(const u32x4*)(pr + kcol); *(LAS u32x4*)(Ks + row * QS + 64 + oct * 8) = *(const u32x4*)(pr + kcol + 64);
          *(LAS u32x4*)(Vs + row * VS + oct * 8) = *(const u32x4*)(pr + vcol); *(LAS u32x4*)(Vs + row * VS + 64 + oct * 8) = *(const u32x4*)(pr + vcol + 64); }
        if (F.tid < 64) { const int t = F.tid;
            if (type == 0) { const float mp = mseq[bh * 80 + c]; const float bt = fmaxf(mp, pm[go + t]); rv[t] = av[go + t]; rv[64 + t] = bt; rv[128 + t] = __expf(mp - bt); rv[192 + t] = __expf(-cumf[go + t] - bt); }
            else rv[128 + t] = exp2f((float)(t + 1) * lg2); }
        __syncthreads();
        { const int tt = w >> 1, t = 16 * tt + li;
#pragma unroll
          for (int sti = 0; sti < 2; ++sti) { const int st = (w & 1) * 2 + sti; f32x4 acc = {0.f, 0.f, 0.f, 0.f};
            if (st <= tt) {
#pragma unroll
                for (int kk = 0; kk < 4; ++kk) { const bf16x8 kf = *(const LAS bf16x8*)(Ks + (16 * st + li) * QS + kk * 32 + g * 8), qf = *(const LAS bf16x8*)(Qs + (16 * tt + li) * QS + kk * 32 + g * 8);
                    acc = __builtin_amdgcn_mfma_f32_16x16x32_bf16(kf, qf, acc, 0, 0, 0); }
#pragma unroll
                for (int r = 0; r < 4; ++r) { const int sx = 16 * st + 4 * g + r; float wgt;
                    if (type == 0) wgt = __expf(rv[sx] - rv[64 + t]); else wgt = exp2f((float)(t - sx) * lg2);
                    acc[r] = (sx <= t) ? acc[r] * wgt : 0.f; } }
            u32x2 pw; pw.x = pack2(acc[0], acc[1]); pw.y = pack2(acc[2], acc[3]); *(LAS u32x2*)(Ps + t * PS + 16 * st + 4 * g) = pw; } }
        __syncthreads();
        f32x4 pv[4], qc[4], dn[4], qn[4];
#pragma unroll
        for (int tt = 0; tt < 4; ++tt) { pv[tt] = (f32x4){0.f, 0.f, 0.f, 0.f}; qc[tt] = pv[tt]; dn[tt] = pv[tt]; qn[tt] = pv[tt]; }
#pragma unroll
        for (int u = 0; u < 2; ++u) {
            const bf16x8 vf = cat4(lds_tr(Vs + (32 * u + 8 * g + (li >> 2)) * VS + 16 * w + 4 * (li & 3)), lds_tr(Vs + (32 * u + 8 * g + 4 + (li >> 2)) * VS + 16 * w + 4 * (li & 3)));
#pragma unroll
            for (int tt = 0; tt < 4; ++tt) { const bf16x8 pf = *(const LAS bf16x8*)(Ps + (16 * tt + li) * PS + 32 * u + 8 * g);
                pv[tt] = __builtin_amdgcn_mfma_f32_16x16x32_bf16(vf, pf, pv[tt], 0, 0, 0);
                if (type == 0) dn[tt] = __builtin_amdgcn_mfma_f32_16x16x32_bf16(ones, pf, dn[tt], 0, 0, 0); } }
        if (c > 0) {
            const bf16_t* cst = (const bf16_t*)(ws + WS_CST) + ((size_t)(type * NBH + bh) * NCH + c) * HD * HD;
            const float* nsv = (const float*)(ws + WS_NST) + ((size_t)bh * NCH + c) * HD;
#pragma unroll
            for (int kk = 0; kk < 4; ++kk) { const bf16x8 cf = *(const bf16x8*)(cst + (size_t)(16 * w + li) * HD + kk * 32 + g * 8);
                bf16x8 nf = ones;
                if (type == 0) { const f32x4 n0 = *(const f32x4*)(nsv + kk * 32 + g * 8), n1 = *(const f32x4*)(nsv + kk * 32 + g * 8 + 4); nf = pack8(n0, n1); }
#pragma unroll
                for (int tt = 0; tt < 4; ++tt) { const bf16x8 qf = *(const LAS bf16x8*)(Qs + (16 * tt + li) * QS + kk * 32 + g * 8);
                    qc[tt] = __builtin_amdgcn_mfma_f32_16x16x32_bf16(cf, qf, qc[tt], 0, 0, 0);
                    if (type == 0) qn[tt] = __builtin_amdgcn_mfma_f32_16x16x32_bf16(nf, qf, qn[tt], 0, 0, 0); } } }
        const int vc = h * HD + 16 * w + 4 * g;
#pragma unroll
        for (int tt = 0; tt < 4; ++tt) { const int t = 16 * tt + li; const float inter = rv[128 + t]; f32x4 hv;
            if (type == 0) { const float den = inter * qn[tt][0] + dn[tt][0]; const float rd = 1.0f / fmaxf(fabsf(den), rv[192 + t]);
                const u32x2 ow = *(const u32x2*)(proj + (size_t)(t0 + t) * NBR + PC_MO + vc);
                const float o0 = __uint_as_float(ow.x << 16), o1 = __uint_as_float(ow.x & 0xffff0000u), o2 = __uint_as_float(ow.y << 16), o3 = __uint_as_float(ow.y & 0xffff0000u);
                hv[0] = sigmoidf_(o0) * (inter * qc[tt][0] + pv[tt][0]) * rd; hv[1] = sigmoidf_(o1) * (inter * qc[tt][1] + pv[tt][1]) * rd;
                hv[2] = sigmoidf_(o2) * (inter * qc[tt][2] + pv[tt][2]) * rd; hv[3] = sigmoidf_(o3) * (inter * qc[tt][3] + pv[tt][3]) * rd; }
            else hv = pv[tt] + qc[tt] * inter;
            pv[tt] = hv;
            float s1 = (hv[0] + hv[1]) + (hv[2] + hv[3]), s2 = (hv[0] * hv[0] + hv[1] * hv[1]) + (hv[2] * hv[2] + hv[3] * hv[3]);
            s1 += __shfl_xor(s1, 16); s1 += __shfl_xor(s1, 32); s2 += __shfl_xor(s2, 16); s2 += __shfl_xor(s2, 32);
            if (g == 0) { hp[(w * 64 + t) * 2] = s1; hp[(w * 64 + t) * 2 + 1] = s2; } }
        __syncthreads();
        const float* nw = (type == 0 ? ((const float*)a->in[IN_MNORM]) : ((const float*)a->in[IN_RNORM])) + l * W + vc; const f32x4 nw4 = *(const f32x4*)nw;
#pragma unroll
        for (int tt = 0; tt < 4; ++tt) { const int t = 16 * tt + li; float s1 = 0.f, s2 = 0.f;
#pragma unroll
            for (int ww = 0; ww < 8; ++ww) { const f32x2 p2 = *(const LAS f32x2*)(hp + (ww * 64 + t) * 2); s1 += p2.x; s2 += p2.y; }
            const float mu = s1 * (1.0f / 128.0f), var = fmaxf(s2 * (1.0f / 128.0f) - mu * mu, 0.f), rstd = rsqrtf(var + LN_EPS);
            f32x4 y = (pv[tt] - mu) * rstd * nw4;
            if (type == 1) { const u32x2 gw = *(const u32x2*)(proj + (size_t)(t0 + t) * NBR + PC_RG + vc);
                const float g0 = __uint_as_float(gw.x << 16), g1 = __uint_as_float(gw.x & 0xffff0000u), g2 = __uint_as_float(gw.y << 16), g3 = __uint_as_float(gw.y & 0xffff0000u);
                y[0] *= g0 * sigmoidf_(g0); y[1] *= g1 * sigmoidf_(g1); y[2] *= g2 * sigmoidf_(g2); y[3] *= g3 * sigmoidf_(g3); }
            st_bf16x4(br + (size_t)(t0 + t) * D + (type == 0 ? 1024 : 1536) + vc, y); }
        __syncthreads();
    }
}

__device__ __forceinline__ void ln_row(float (&v)[32], const float* lw, const float* lb, int lane) {
    float s = 0.f;
#pragma unroll
    for (int j = 0; j < 32; ++j) s += v[j];
    const float mu = wave_sum(s) * (1.0f / D); float q = 0.f;
#pragma unroll
    for (int j = 0; j < 32; ++j) { const float d = v[j] - mu; q += d * d; }
    const float rstd = rsqrtf(wave_sum(q) * (1.0f / D) + LN_EPS);
#pragma unroll
    for (int j = 0; j < 4; ++j)
#pragma unroll
        for (int h = 0; h < 2; ++h) { const f32x4 w4 = *(const f32x4*)(lw + j * 512 + lane * 8 + h * 4), b4 = *(const f32x4*)(lb + j * 512 + lane * 8 + h * 4);
#pragma unroll
            for (int e = 0; e < 4; ++e) v[j * 8 + h * 4 + e] = (v[j * 8 + h * 4 + e] - mu) * rstd * w4[e] + b4[e]; }
}
__device__ __forceinline__ void phase_ln(const Frame& F, const bf16_t* y, const float* lw, const float* lb, bf16_t* xb) {
    for (int row = F.wg * 8 + F.wave; row < T; row += F.nwg * 8) {
        float v[32]; ld_row32(y + (size_t)row * D, F.lane, v);
        ln_row(v, lw, lb, F.lane);
        st_row32(xb + (size_t)row * D, F.lane, v);
    }
}
__device__ __forceinline__ void split8(f32x4 a, f32x4 b, bf16x8& hi, bf16x8& lo) {
    union { u32x4 u; bf16x8 h; } H, L;
#pragma unroll
    for (int j = 0; j < 2; ++j) { const bf16_t h0 = f2bf(a[2 * j]), h1 = f2bf(a[2 * j + 1]); H.u[j] = (unsigned)h0 | ((unsigned)h1 << 16); L.u[j] = pack2(a[2 * j] - bf2f(h0), a[2 * j + 1] - bf2f(h1)); }
#pragma unroll
    for (int j = 0; j < 2; ++j) { const bf16_t h0 = f2bf(b[2 * j]), h1 = f2bf(b[2 * j + 1]); H.u[2 + j] = (unsigned)h0 | ((unsigned)h1 << 16); L.u[2 + j] = pack2(b[2 * j] - bf2f(h0), b[2 * j + 1] - bf2f(h1)); }
    hi = H.h; lo = L.h; }
__device__ __forceinline__ void phase_ln_router(const Frame& F, int l, const bf16_t* y, bf16_t* xb) {
    const KArgs a = F.ka;
    unsigned char* ws = F.ws_();
    constexpr int XS = D + 8, RB = 32;
    LAS bf16_t* xsh = (LAS bf16_t*)F.lds;
    LAS float* part = (LAS float*)F.lds;
    LAS int* lcnt = (LAS int*)(xsh + RB * XS);
    if (F.tid < 128) lcnt[F.tid] = 0;
    __syncthreads();
    const float* lw = ((const float*)a->in[IN_LNW]) + ((size_t)l * 3 + 1) * D; const float* lb = ((const float*)a->in[IN_LNB]) + ((size_t)l * 3 + 1) * D;
    const bf16_t* rwt = (const bf16_t*)(ws + WS_RWT) + (size_t)l * 2 * NE * D; const float* rb = ((const float*)a->in[IN_RB]) + l * NE;
    unsigned* counts = (unsigned*)(ws + WS_CTL) + CW_COUNTS + l * 64;
    int* eid = (int*)(ws + WS_EID); float* ew = (float*)(ws + WS_EW); int* epos = (int*)(ws + WS_EPOS);
    const int lane = F.lane, g = lane >> 4, li = lane & 15, nt = F.wave & 3, kh = F.wave >> 2;
    for (int blk = F.wg; blk < T / RB; blk += F.nwg) {
        for (int rr = 0; rr < 4; ++rr) {
            const int lr = F.wave * 4 + rr, row = blk * RB + lr;
            float v[32]; ld_row32(y + (size_t)row * D, F.lane, v);
            ln_row(v, lw, lb, F.lane);
            st_row32(xb + (size_t)row * D, F.lane, v); st_row32_fp8(ws + WS_XB8 + (size_t)row * D, F.lane, v);
#pragma unroll
            for (int j = 0; j < 4; ++j) { u32x4 hi;
#pragma unroll
                for (int e2 = 0; e2 < 4; ++e2) hi[e2] = pack2(v[j * 8 + 2 * e2], v[j * 8 + 2 * e2 + 1]);
                *(LAS u32x4*)(xsh + lr * XS + j * 512 + F.lane * 8) = hi; }
        }
        __syncthreads();
        f32x4 acc[2] = {{0.f, 0.f, 0.f, 0.f}, {0.f, 0.f, 0.f, 0.f}};
        { const bf16_t* wh = rwt + (size_t)(16 * nt + li) * D + kh * 1024 + g * 8; const bf16_t* wl = wh + (size_t)NE * D;
          const LAS bf16_t* xr = xsh + li * XS + kh * 1024 + g * 8;
#pragma unroll 8
          for (int ks = 0; ks < 32; ++ks) { const bf16x8 bh = *(const bf16x8*)(wh + ks * 32), bl = *(const bf16x8*)(wl + ks * 32);
#pragma unroll
              for (int mt = 0; mt < 2; ++mt) { const bf16x8 xh = *(const LAS bf16x8*)(xr + mt * 16 * XS + ks * 32);
                  acc[mt] = __builtin_amdgcn_mfma_f32_16x16x32_bf16(xh, bh, acc[mt], 0, 0, 0); acc[mt] = __builtin_amdgcn_mfma_f32_16x16x32_bf16(xh, bl, acc[mt], 0, 0, 0); } } }
        __syncthreads();
#pragma unroll
        for (int mt = 0; mt < 2; ++mt)
#pragma unroll
            for (int r = 0; r < 4; ++r) part[(kh * RB + 16 * mt + 4 * g + r) * 64 + 16 * nt + li] = acc[mt][r];
        __syncthreads();
        const int e = F.lane;
        const float bias = rb[e];
        for (int rr = 0; rr < 4; ++rr) {
            const int lr = F.wave * 4 + rr, row = blk * RB + lr;
            const float sc = sigmoidf_(part[lr * 64 + e] + part[(RB + lr) * 64 + e]), bs = sc + bias;
            float m1 = bs; m1 = fmaxf(m1, __shfl_xor(m1, 1)); m1 = fmaxf(m1, __shfl_xor(m1, 2)); m1 = fmaxf(m1, __shfl_xor(m1, 4));
            const unsigned long long eq = __ballot(bs == m1); const int gq = e >> 3; const unsigned gm = (unsigned)(eq >> (gq * 8)) & 0xffu; const int first = gq * 8 + __builtin_ctz(gm);
            float m2 = (e == first) ? -INFINITY : bs; m2 = fmaxf(m2, __shfl_xor(m2, 1)); m2 = fmaxf(m2, __shfl_xor(m2, 2)); m2 = fmaxf(m2, __shfl_xor(m2, 4));
            const float gs = m1 + m2;
            int grank = 0;
#pragma unroll
            for (int g2 = 0; g2 < 8; ++g2) { const float o = __shfl(gs, g2 * 8); grank += (o > gs || (o == gs && g2 < gq)) ? 1 : 0; }
            const bool gsel = grank < 4;
            const float val = gsel ? bs : -INFINITY;
            int rank = 0;
            for (int e2 = 0; e2 < 64; ++e2) { const float o = __shfl(val, e2); rank += (o > val || (o == val && e2 < e)) ? 1 : 0; }
            const bool sel = gsel && rank < TOPK;
            const float wsum = wave_sum(sel ? sc : 0.f);
            const unsigned long long sm = __ballot(sel);
            if (sel) { const int k = __builtin_popcountll(sm & ((1ull << e) - 1ull));
                const int pos = __hip_atomic_fetch_add((int*)lcnt + e, 1, __ATOMIC_RELAXED, __HIP_MEMORY_SCOPE_WORKGROUP);
                eid[(size_t)row * 8 + k] = e; ew[(size_t)row * 8 + k] = sc / wsum * ROUTE_SCALE; epos[(size_t)row * 8 + k] = pos; }
        }
        __syncthreads();
    }
    if (F.tid < 64) { const int n = lcnt[F.tid]; lcnt[64 + F.tid] = n > 0 ? (int)__hip_atomic_fetch_add(counts + F.tid, (unsigned)n, __ATOMIC_RELAXED, __HIP_MEMORY_SCOPE_AGENT) : 0; }
    asm volatile("s_waitcnt vmcnt(0)" ::: "memory");
    __syncthreads();
    for (int blk = F.wg; blk < T / RB; blk += F.nwg) { if (F.tid < RB * 8) { const size_t i = (size_t)blk * (RB * 8) + F.tid; epos[i] += lcnt[64 + eid[i]]; } }
    __syncthreads();
}
__device__ __forceinline__ void build_pstart(const Frame& F, int l, LAS int* pst) {
    const unsigned* counts = (const unsigned*)(F.ws_() + WS_CTL) + CW_COUNTS + l * 64;
    if (F.tid < 64) {
        const int c = (int)__hip_atomic_load(counts + F.tid, __ATOMIC_RELAXED, __HIP_MEMORY_SCOPE_AGENT); const int pc = (c + 255) & ~255; int inc = pc;
#pragma unroll
        for (int o = 1; o < 64; o <<= 1) { const int n = __shfl_up(inc, o); if (F.tid >= o) inc += n; }
        pst[F.tid] = inc - pc; if (F.tid == 63) { pst[NE] = inc; pst[NE + 1] = inc + T; } }
    __syncthreads();
    { LAS unsigned char* texp = (LAS unsigned char*)(pst + 68);
      for (int rt = F.tid; rt < (pst[NE + 1] >> 8); rt += NTHR) { int e = 0; while (e < NE && pst[e + 1] <= rt * 256) ++e; texp[rt] = (unsigned char)e; } }
    __syncthreads();
}
__device__ __forceinline__ void phase_slots(const Frame& F, int l) {
    unsigned char* ws = F.ws_();
    LAS int* pst = (LAS int*)F.lds;
    build_pstart(F, l, pst);
    const unsigned* counts = (const unsigned*)(ws + WS_CTL) + CW_COUNTS + l * 64;
    const int* eid = (const int*)(ws + WS_EID); const float* ew = (const float*)(ws + WS_EW); const int* epos = (const int*)(ws + WS_EPOS);
    int* slotof = (int*)(ws + WS_SLOTOF); int* tok = (int*)(ws + WS_TOK); float* wsl = (float*)(ws + WS_WSL);
    const size_t gtid = (size_t)F.wg * NTHR + F.tid, gn = (size_t)F.nwg * NTHR;
    for (size_t i = gtid; i < (size_t)T * 8; i += gn) { const int e = eid[i]; const int slot = pst[e] + epos[i]; slotof[i] = slot; tok[slot] = (int)(i >> 3); wsl[slot] = ew[i]; }
    for (size_t i = gtid; i < (size_t)NE * 256; i += gn) { const int e = (int)(i >> 8), r = (int)(i & 255); const int c = (int)counts[e]; const int slot = pst[e] + c + r; if (slot < pst[e + 1]) { tok[slot] = 0; wsl[slot] = 0.f; } }
    for (size_t i = gtid; i < (size_t)T; i += gn) { tok[pst[NE] + i] = (int)i; wsl[pst[NE] + i] = 1.0f; }
    __syncthreads();
}
__device__ __forceinline__ void phase_combine_ln(const Frame& F, int l, bf16_t* xb, float* out) {
    const KArgs a = F.ka;
    unsigned char* ws = F.ws_();
    LAS int* pst = (LAS int*)F.lds;
    build_pstart(F, l, pst);
    const int sh0 = pst[NE];
    const int* slotof = (const int*)(ws + WS_SLOTOF); const unsigned char* yb = ws + WS_YB;
    const float* lw = ((const float*)a->in[IN_LNW]) + ((size_t)l * 3 + 2) * D; const float* lb = ((const float*)a->in[IN_LNB]) + ((size_t)l * 3 + 2) * D;
    for (int row = F.wg * 8 + F.wave; row < T; row += F.nwg * 8) {
        float v[32]; ld_row32(xb + (size_t)row * D, F.lane, v);
#pragma unroll
        for (int j = 0; j < 32; ++j) v[j] *= ALPHA;
        float ys[32];
#pragma unroll
        for (int j = 0; j < 32; ++j) ys[j] = 0.f;
#pragma unroll 3
        for (int k = 0; k < 9; ++k) { const int slot = k < 8 ? slotof[(size_t)row * 8 + k] : sh0 + row; const unsigned char* yr = yb + (size_t)slot * D;
#pragma unroll
            for (int j = 0; j < 4; ++j) { const u32x2 w = *(const u32x2*)(yr + j * 512 + F.lane * 8);
                const f32x2 p0 = __builtin_amdgcn_cvt_pk_f32_fp8((int)w.x, false), p1 = __builtin_amdgcn_cvt_pk_f32_fp8((int)w.x, true), p2 = __builtin_amdgcn_cvt_pk_f32_fp8((int)w.y, false), p3 = __builtin_amdgcn_cvt_pk_f32_fp8((int)w.y, true);
                ys[j * 8] += p0.x; ys[j * 8 + 1] += p0.y; ys[j * 8 + 2] += p1.x; ys[j * 8 + 3] += p1.y; ys[j * 8 + 4] += p2.x; ys[j * 8 + 5] += p2.y; ys[j * 8 + 6] += p3.x; ys[j * 8 + 7] += p3.y; } }
#pragma unroll
        for (int j = 0; j < 32; ++j) v[j] += ys[j] * (1.0f / Y8_SCALE);
        ln_row(v, lw, lb, F.lane);
        if (out) {
#pragma unroll
            for (int j = 0; j < 4; ++j) { *(f32x4*)(out + (size_t)row * D + j * 512 + F.lane * 8) = (f32x4){v[j * 8], v[j * 8 + 1], v[j * 8 + 2], v[j * 8 + 3]}; *(f32x4*)(out + (size_t)row * D + j * 512 + F.lane * 8 + 4) = (f32x4){v[j * 8 + 4], v[j * 8 + 5], v[j * 8 + 6], v[j * 8 + 7]}; }
        } else { st_row32(xb + (size_t)row * D, F.lane, v); st_row32_fp8(ws + WS_XB8 + (size_t)row * D, F.lane, v); st_row32_i8(ws + WS_XQ8 + (size_t)row * D, (float*)(ws + WS_XSC) + row, F.lane, v); }
    }
    __syncthreads();
}

__device__ __forceinline__ void phase_attn_mfma(const Frame& F, int l) {
    unsigned char* ws = F.ws_();
    constexpr int KS = 136, VS = 144;
    LAS bf16_t* Ks = (LAS bf16_t*)F.lds; LAS bf16_t* Vs = Ks + 256 * KS;
    const bf16_t* q = (const bf16_t*)(ws + WS_Q); const bf16_t* km = (const bf16_t*)(ws + WS_KM) + (size_t)l * TM * W; const bf16_t* vm = (const bf16_t*)(ws + WS_VM) + (size_t)l * TM * W;
    bf16_t* o = (bf16_t*)(ws + WS_O);
    const int nunit = (T / 128) * 4, upw = (nunit + F.nwg - 1) / F.nwg;
    const int lane = F.lane, g = lane >> 4, li = lane & 15;
    int loaded = -1;
    const int u_end = (F.wg + 1) * upw < nunit ? (F.wg + 1) * upw : nunit;
    for (int u = F.wg * upw; u < u_end; ++u) {
        const int bh = u >> 5, blk = u & 31, b = bh >> 2, hh = bh & 3;
        if (bh != loaded) {
            __syncthreads();
            const int m = F.tid >> 1, half = F.tid & 1;
            const bf16_t* kr = km + (size_t)(b * MEM + m) * W + hh * HD + half * 64; const bf16_t* vr = vm + (size_t)(b * MEM + m) * W + hh * HD + half * 64;
#pragma unroll
            for (int j = 0; j < 8; ++j) { *(LAS u32x4*)(Ks + m * KS + half * 64 + j * 8) = *(const u32x4*)(kr + j * 8); *(LAS u32x4*)(Vs + m * VS + half * 64 + j * 8) = *(const u32x4*)(vr + j * 8); }
            __syncthreads(); loaded = bh;
        }
        const int t0 = b * SEQ + blk * 128 + F.wave * 16;
        bf16x8 qf[4];
#pragma unroll
        for (int kk = 0; kk < 4; ++kk) qf[kk] = *(const bf16x8*)(q + (size_t)(t0 + li) * W + hh * HD + kk * 32 + g * 8);
        f32x4 sacc[16];
#pragma unroll
        for (int tt = 0; tt < 16; ++tt) { f32x4 acc = {0.f, 0.f, 0.f, 0.f};
#pragma unroll
            for (int kk = 0; kk < 4; ++kk) { const bf16x8 kf = *(const LAS bf16x8*)(Ks + (16 * tt + li) * KS + kk * 32 + g * 8); acc = __builtin_amdgcn_mfma_f32_16x16x32_bf16(kf, qf[kk], acc, 0, 0, 0); }
            sacc[tt] = acc; }
        float mx = -INFINITY;
#pragma unroll
        for (int tt = 0; tt < 16; ++tt) mx = fmaxf(mx, fmaxf(fmaxf(sacc[tt][0], sacc[tt][1]), fmaxf(sacc[tt][2], sacc[tt][3])));
        mx = fmaxf(mx, __shfl_xor(mx, 16)); mx = fmaxf(mx, __shfl_xor(mx, 32));
        const float c2 = 0.08838834764831845f * 1.4426950408889634f; float sum = 0.f;
#pragma unroll
        for (int tt = 0; tt < 16; ++tt)
#pragma unroll
            for (int r = 0; r < 4; ++r) { const float p = exp2f((sacc[tt][r] - mx) * c2); sacc[tt][r] = p; sum += p; }
        sum += __shfl_xor(sum, 16); sum += __shfl_xor(sum, 32);
        const float rs = 1.0f / sum;
        bf16x8 pk[8];
#pragma unroll
        for (int u8 = 0; u8 < 8; ++u8) pk[u8] = pack8(sacc[2 * u8], sacc[2 * u8 + 1]);
#pragma unroll
        for (int dvt = 0; dvt < 8; ++dvt) { f32x4 acc = {0.f, 0.f, 0.f, 0.f};
#pragma unroll
            for (int u8 = 0; u8 < 8; ++u8) { const s16x4 a0 = lds_tr(Vs + (32 * u8 + 4 * g + (li >> 2)) * VS + dvt * 16 + 4 * (li & 3)); const s16x4 a1 = lds_tr(Vs + (32 * u8 + 16 + 4 * g + (li >> 2)) * VS + dvt * 16 + 4 * (li & 3));
                acc = __builtin_amdgcn_mfma_f32_16x16x32_bf16(cat4(a0, a1), pk[u8], acc, 0, 0, 0); }
            st_bf16x4(o + (size_t)(t0 + li) * W + hh * HD + dvt * 16 + 4 * g, acc * rs); }
    }
    __syncthreads();
}

template <class Epi>
__device__ __forceinline__ void gemm_dense_mfma(const Frame& F, const bf16_t* A, const bf16_t* Bt, int M, int N, int K, const Epi& E) {
    DenseSched S; S.A = A; S.Bt = Bt; S.K = K; S.nM = M / 256; S.nN = N / 256; S.nwg = S.nM * S.nN; S.G = F.nwg; S.c = F.wg; S.i0 = 0; S.i1 = 1 << 30; S.pnoff = 0;
    gemm_phase_mfma(F, K, S, E);
}
constexpr int NPL = 15, NPHASE = 1 + DEPTH * NPL;
#ifndef NCONV
#define NCONV 40
#endif
#if MK_PER_PHASE
#define IN(k) (lo <= (k) && (k) < hi)
#define SEAM(k) do { if (IN((k) + 1)) { XcdBarrier b2_ = bar; asm volatile("" : "+s"(b2_.bar)); asm volatile("" : "+s"(b2_.x)); xcd_barrier(b2_); } } while (0)
#else
#define IN(k) true
#define SEAM(k) do { if ((k) + 1 < NPHASE) for (int rb_ = 0; rb_ < ((PROBE_DBL & 4096) ? 3 : 1); ++rb_) { XcdBarrier b2_ = bar; asm volatile("" : "+s"(b2_.bar)); asm volatile("" : "+s"(b2_.x)); xcd_barrier(b2_); } } while (0)
#endif
template <int l> __device__ __forceinline__ void run_layer(const Frame& F0, const XcdBarrier& bar, int lo, int hi) {
    const int pb = 1 + l * NPL;
    if (IN(pb + 0)) { const Frame F = fresh(F0); unsigned char* ws = F.ws_();
        EpiProj E{(bf16_t*)(ws + WS_PROJ), (bf16_t*)(ws + WS_GATES)};
        { DenseSched S; S.A = (const bf16_t*)(ws + WS_XQ8); S.Bt = (const bf16_t*)(ws + WS_WINQ + l * SZ_WINQ); S.K = D / 2; S.nM = T / 256; S.nN = NBR / 256; S.nwg = S.nM * S.nN; S.G = F.nwg; S.c = F.wg; S.i0 = 0; S.i1 = 1 << 30; S.pnoff = 0;
          const float wsc = __uint_as_float(((const unsigned*)(ws + WS_CTL))[CW_WABS + l]) * (1.0f / 127.0f);
          gemm_phase_mfma<EpiProj, DenseSched, 2>(F, D, S, E, wsc, (const float*)(ws + WS_XSC)); }
        { const Frame F2 = fresh(F0); unsigned char* ws2 = F2.ws_(); EpiProj E2{(bf16_t*)(ws2 + WS_PROJ), (bf16_t*)(ws2 + WS_GATES)};
          DenseSched S; S.A = (const bf16_t*)(ws2 + WS_XB8); S.Bt = (const bf16_t*)(ws2 + WS_WIN8 + l * SZ_WIN8 + (size_t)NBR * D); S.K = D / 2; S.nM = T / 256; S.nN = (NPROJ - NBR) / 256; S.nwg = S.nM * S.nN; S.G = F2.nwg; S.c = F2.wg; S.i0 = 0; S.i1 = 1 << 30; S.pnoff = NBR / 256;
          gemm_phase_mfma<EpiProj, DenseSched, 1>(F2, D, S, E2, 1.0f / (X8_SCALE * W8_SCALE)); if (PROBE_DBL & 64) gemm_phase_mfma<EpiProj, DenseSched, 1>(F2, D, S, E2, 1.0f / (X8_SCALE * W8_SCALE)); }
        SEAM(pb + 0); }
    if (IN(pb + 1)) { const Frame F = fresh(F0); phase_mix1v2(F, l, (const bf16_t*)(F.ws_() + WS_XB)); if (PROBE_DBL & 8192) { const Frame G = fresh(F0); phase_mix1v2<false>(G, l, (const bf16_t*)(G.ws_() + WS_XB)); } SEAM(pb + 1); }
    if (IN(pb + 2)) { const Frame F = fresh(F0); phase_scan_mfma(F); if (PROBE_DBL & 2) { const Frame G = fresh(F0); phase_scan_mfma(G); } SEAM(pb + 2); }
    if (IN(pb + 3)) { const Frame F = fresh(F0); phase_chunk_mfma(F, l); if (PROBE_DBL & 4) { const Frame G = fresh(F0); phase_chunk_mfma(G, l); } SEAM(pb + 3); }
    if (IN(pb + 4)) { const Frame F = fresh(F0); unsigned char* ws = F.ws_();
        EpiBranch E{ws + WS_GATES, (bf16_t*)(ws + WS_MRG)}; gemm_dense_mfma(F, (const bf16_t*)(ws + WS_BR), (const bf16_t*)(ws + WS_WB + l * SZ_DD), T, D, D, E); if (PROBE_DBL & 128) gemm_dense_mfma(F, (const bf16_t*)(ws + WS_BR), (const bf16_t*)(ws + WS_WB + l * SZ_DD), T, D, D, E); SEAM(pb + 4); }
    if (IN(pb + 5)) { const Frame F = fresh(F0); unsigned char* ws = F.ws_();
        EpiResid E{(const bf16_t*)(ws + WS_XB), (bf16_t*)(ws + WS_Y)}; gemm_dense_mfma(F, (const bf16_t*)(ws + WS_MRG), (const bf16_t*)(ws + WS_WOUT + l * SZ_DD), T, D, D, E); if (PROBE_DBL & 256) gemm_dense_mfma(F, (const bf16_t*)(ws + WS_MRG), (const bf16_t*)(ws + WS_WOUT + l * SZ_DD), T, D, D, E); SEAM(pb + 5); }
    if (IN(pb + 6)) { const Frame F = fresh(F0); unsigned char* ws = F.ws_();
        phase_ln(F, (const bf16_t*)(ws + WS_Y), ((const float*)F.ka->in[IN_LNW]) + (size_t)l * 3 * D, ((const float*)F.ka->in[IN_LNB]) + (size_t)l * 3 * D, (bf16_t*)(ws + WS_XB)); if (PROBE_DBL & 1) { const Frame G = fresh(F0); unsigned char* wsg = G.ws_(); phase_ln(G, (const bf16_t*)(wsg + WS_Y), ((const float*)G.ka->in[IN_LNW]) + (size_t)l * 3 * D, ((const float*)G.ka->in[IN_LNB]) + (size_t)l * 3 * D, (bf16_t*)(wsg + WS_XB)); } SEAM(pb + 6); }
    if (IN(pb + 7)) { const Frame F = fresh(F0);
        EpiQKV E{}; QkvSched S; S.ws = F.ws_(); S.l = l; S.G = F.nwg; S.c = F.wg; gemm_phase_mfma(F, D, S, E); if (PROBE_DBL & 1024) gemm_phase_mfma(F, D, S, E); SEAM(pb + 7); }
    if (IN(pb + 8)) { const Frame F = fresh(F0); phase_attn_mfma(F, l); if (PROBE_DBL & 8) { const Frame G = fresh(F0); phase_attn_mfma(G, l); } SEAM(pb + 8); }
    if (IN(pb + 9)) { const Frame F = fresh(F0); unsigned char* ws = F.ws_();
        EpiResid E{(const bf16_t*)(ws + WS_XB), (bf16_t*)(ws + WS_Y)}; gemm_dense_mfma(F, (const bf16_t*)(ws + WS_O), (const bf16_t*)(ws + WS_WO + l * SZ_WQ), T, D, W, E); if (PROBE_DBL & 2048) gemm_dense_mfma(F, (const bf16_t*)(ws + WS_O), (const bf16_t*)(ws + WS_WO + l * SZ_WQ), T, D, W, E); SEAM(pb + 9); }
    if (IN(pb + 10)) { const Frame F = fresh(F0); unsigned char* ws = F.ws_(); phase_ln_router(F, l, (const bf16_t*)(ws + WS_Y), (bf16_t*)(ws + WS_XB)); SEAM(pb + 10); }
    if (IN(pb + 11)) { const Frame F = fresh(F0); phase_slots(F, l); if (PROBE_DBL & 16) { const Frame G = fresh(F0); phase_slots(G, l); } SEAM(pb + 11); }
    if (IN(pb + 12)) { const Frame F = fresh(F0); unsigned char* ws = F.ws_();
        LAS int* pst = (LAS int*)(F.lds + LDS_BYTES - 1024); build_pstart(F, l, pst);
        const int nrt = pst[NE + 1] >> 8; EpiSwiglu E{(const float*)(ws + WS_WSL), ws + WS_HB};
        MoeSched<4, true> S; S.ws = ws; S.pst = pst; S.l = l; S.G = F.nwg; S.c = F.wg; S.nunits = nrt * 4; gemm_phase_mfma<EpiSwiglu, MoeSched<4, true>, 1>(F, D, S, E, 1.0f / (X8_SCALE * W8_SCALE)); SEAM(pb + 12); }
    if (IN(pb + 13)) { const Frame F = fresh(F0); unsigned char* ws = F.ws_();
        LAS int* pst = (LAS int*)(F.lds + LDS_BYTES - 1024); build_pstart(F, l, pst);
        const int nrt = pst[NE + 1] >> 8; EpiDown E{ws + WS_YB};
        MoeSched<8, false> S; S.ws = ws; S.pst = pst; S.l = l; S.G = F.nwg; S.c = F.wg; S.nunits = nrt * 8; gemm_phase_mfma<EpiDown, MoeSched<8, false>, 1>(F, ED, S, E, Y8_SCALE / (H8_SCALE * W8_SCALE)); SEAM(pb + 13); }
    if (IN(pb + 14)) { const Frame F = fresh(F0); phase_combine_ln(F, l, (bf16_t*)(F.ws_() + WS_XB), l == DEPTH - 1 ? ((float*)F.ka->out) : (float*)nullptr); if ((PROBE_DBL & 16384) && l == DEPTH - 1) { const Frame G = fresh(F0); phase_combine_ln(G, l, (bf16_t*)(G.ws_() + WS_XB), ((float*)G.ka->out)); } SEAM(pb + 14); }
}

__global__ void __launch_bounds__(NTHR, 2) fwd(Args args_unused) {
    extern __shared__ __attribute__((aligned(16))) unsigned char lds_raw[];
    Frame F0; F0.lds = (LAS unsigned char*)lds_raw; F0.tid = threadIdx.x; F0.lane = F0.tid & 63; F0.wave = __builtin_amdgcn_readfirstlane(F0.tid >> 6); F0.wg = blockIdx.x; F0.nwg = gridDim.x;
    F0.ka = (KArgs)__builtin_amdgcn_kernarg_segment_ptr(); F0.wsg = F0.ka->ws;
    volatile LAS unsigned* xbw = (volatile LAS unsigned*)(F0.lds + LDS_BYTES - 16);
    if (F0.tid == 0) { xbw[0] = 0u; xbw[1] = 0u; }
    __syncthreads();
    XcdBarrier bar; bar.bar = (unsigned*)(F0.ws_() + WS_CTL); bar.x = 0; bar.st = xbw;
#if MK_PER_PHASE
    const int lo = F0.ka->ph_lo, hi = F0.ka->ph_hi;
    if (hi - lo > 1) bar = xcd_barrier_post((unsigned*)(F0.ws_() + WS_CTL), xbw);
#else
    const int lo = 0, hi = NPHASE;
    bar = xcd_barrier_post((unsigned*)(F0.ws_() + WS_CTL), xbw);
#endif
    if (IN(0)) { { const Frame F = fresh(F0); phase_wabs(F); } { XcdBarrier b2_ = bar; asm volatile("" : "+s"(b2_.bar)); asm volatile("" : "+s"(b2_.x)); xcd_barrier(b2_); }
        const Frame F = fresh(F0); phase_prologue(F); { const Frame G = fresh(F0); prologue_deferred(G, G.wg, G.nwg); } SEAM(0); }
    run_layer<0>(F0, bar, lo, hi);
    run_layer<1>(F0, bar, lo, hi);
#undef IN
#undef SEAM
}

extern "C" void kernel_launch(void* const* d_in, const int* in_sizes, int n_in, void* d_out, int out_size, void* d_ws, size_t ws_size, hipStream_t stream) {
    static int grid = 0;
    if (grid == 0) {
        if (n_in != 23 || ws_size < WS_END) { fprintf(stderr, "kernel_launch: unexpected inputs (n_in %d, ws %zu < %zu)\n", n_in, ws_size, (size_t)WS_END); grid = -1; return; }
        int dev = 0, cus = 0, per_cu = 0;
        if (hipGetDevice(&dev) != hipSuccess || hipDeviceGetAttribute(&cus, hipDeviceAttributeMultiprocessorCount, dev) != hipSuccess) { grid = -1; return; }
        if (hipFuncSetAttribute((const void*)fwd, hipFuncAttributeMaxDynamicSharedMemorySize, LDS_BYTES) != hipSuccess) { fprintf(stderr, "kernel_launch: hipFuncSetAttribute failed\n"); grid = -1; return; }
        if (hipOccupancyMaxActiveBlocksPerMultiprocessor(&per_cu, (const void*)fwd, NTHR, LDS_BYTES) != hipSuccess || per_cu < 1) { fprintf(stderr, "kernel_launch: occupancy query says %d\n", per_cu); }
        (void)hipGetLastError();
        grid = cus;
    }
    if (grid < 0) return;
    (void)hipMemsetAsync((char*)d_ws + WS_CTL, 0, CTL_BYTES, stream);
    Args a{};
    for (int i = 0; i < 23; ++i) a.in[i] = (const float*)d_in[i];
    a.out = (float*)d_out; a.ws = (unsigned char*)d_ws;
#if MK_PER_PHASE
    for (int p = 0; p < NPHASE; ++p) { a.ph_lo = p; a.ph_hi = p + 1; hipLaunchKernelGGL(fwd, dim3(grid), dim3(NTHR), LDS_BYTES, stream, a); }
#else
    a.ph_lo = 0; a.ph_hi = NPHASE;
    hipLaunchKernelGGL(fwd, dim3(grid), dim3(NTHR), LDS_BYTES, stream, a);
#endif
    const hipError_t le = hipPeekAtLastError();
    if (le != hipSuccess) fprintf(stderr, "kernel_launch: launch failed: %s\n", hipGetErrorName(le));
}
```

```cpp
#include <hip/hip_runtime.h>
#include <cstdio>
#include <cstdint>

#ifndef PROBE_DBL
#define PROBE_DBL 0
#endif
#ifndef MK_PER_PHASE
#define MK_PER_PHASE 0
#endif

typedef unsigned short bf16_t;
typedef float f32x4 __attribute__((ext_vector_type(4)));
typedef float f32x2 __attribute__((ext_vector_type(2)));
typedef unsigned u32x4 __attribute__((ext_vector_type(4)));
typedef unsigned u32x2 __attribute__((ext_vector_type(2)));
#define LAS __attribute__((address_space(3)))

constexpr int BATCH = 4, SEQ = 4096, T = BATCH * SEQ, D = 2048, DEPTH = 2;
constexpr int W = 512, NH = 4, HD = 128, CH = 64, NCH = SEQ / CH, NBH = BATCH * NH;
constexpr int PROJ_W = 14344, NBR = 6144, NPROJ = 14336;
constexpr int MEM = 256, TM = BATCH * MEM;
constexpr int NE = 64, NEX = 65, TOPK = 8, ED = 512;
constexpr int NSLOT = 164096;
constexpr float LN_EPS = 1e-5f, ALPHA = 1.41421356237f, ROUTE_SCALE = 2.5f;
constexpr int NTHR = 512;

constexpr int PC_U = 0, PC_CH = 512, PC_CB = 1024, PC_CC = 1536, PC_MQ = 2048, PC_MK = 2560, PC_MV = 3072, PC_MO = 3584, PC_RQ = 4096, PC_RK = 4608, PC_RV = 5120, PC_RG = 5632;

constexpr size_t al256(size_t x) { return (x + 255) & ~(size_t)255; }
constexpr size_t WS_CTL = 0;
constexpr size_t CTL_BYTES = 65536;
constexpr int CW_COUNTS = 8192;
constexpr size_t WS_WIN = WS_CTL + CTL_BYTES;
constexpr size_t SZ_WIN = (size_t)NPROJ * D * 2;
constexpr size_t WS_WIF = WS_WIN + DEPTH * SZ_WIN;
constexpr size_t SZ_WIF = 8 * D * 4;
constexpr size_t WS_WB = WS_WIF + DEPTH * SZ_WIF;
constexpr size_t SZ_DD = (size_t)D * D * 2;
constexpr size_t WS_WOUT = WS_WB + DEPTH * SZ_DD;
constexpr size_t WS_WQ = WS_WOUT + DEPTH * SZ_DD;
constexpr size_t SZ_WQ = (size_t)W * D * 2;
constexpr size_t WS_WK = WS_WQ + DEPTH * SZ_WQ;
constexpr size_t WS_WV = WS_WK + DEPTH * SZ_WQ;
constexpr size_t WS_WO = WS_WV + DEPTH * SZ_WQ;
constexpr size_t WS_WGU = WS_WO + DEPTH * SZ_WQ;
constexpr size_t SZ_WGU1 = (size_t)1024 * D * 2;
constexpr size_t WS_WDN = WS_WGU + (size_t)DEPTH * NEX * SZ_WGU1;
constexpr size_t SZ_WDN1 = (size_t)D * ED * 2;
constexpr size_t WS_ROPE = WS_WDN + (size_t)DEPTH * NEX * SZ_WDN1;
constexpr size_t WS_X = WS_ROPE + (size_t)SEQ * 64 * 4 * 2;
constexpr size_t SZ_TD4 = (size_t)T * D * 4;
constexpr size_t WS_Y = WS_X + SZ_TD4;
constexpr size_t WS_XB = WS_Y + SZ_TD4;
constexpr size_t SZ_TD2 = (size_t)T * D * 2;
constexpr size_t WS_MEMB = WS_XB + SZ_TD2;
constexpr size_t WS_KM = WS_MEMB + (size_t)TM * D * 2;
constexpr size_t WS_VM = WS_KM + (size_t)DEPTH * TM * W * 2;
constexpr size_t WS_PROJ = WS_VM + (size_t)DEPTH * TM * W * 2;
constexpr size_t WS_GATES = WS_PROJ + (size_t)T * NBR * 2;
constexpr size_t WS_CUMF = WS_GATES + (size_t)T * 8192 * 2;
constexpr size_t WS_IPRE = WS_CUMF + (size_t)NBH * SEQ * 4;
constexpr size_t WS_SUMM = WS_IPRE + (size_t)NBH * SEQ * 4;
constexpr size_t WS_CST = WS_SUMM + al256((size_t)NBH * NCH * 2 * 4);
constexpr size_t WS_NST = WS_CST + (size_t)2 * NBH * NCH * HD * HD * 2;
constexpr size_t WS_BR = WS_NST + (size_t)NBH * NCH * HD * 4;
constexpr size_t WS_MRG = WS_BR + SZ_TD2;
constexpr size_t WS_Q = WS_MRG + SZ_TD2;
constexpr size_t WS_O = WS_Q + (size_t)T * W * 2;
constexpr size_t WS_EID = WS_O + (size_t)T * W * 2;
constexpr size_t WS_EW = WS_EID + (size_t)T * 8 * 4;
constexpr size_t WS_EPOS = WS_EW + (size_t)T * 8 * 4;
constexpr size_t WS_SLOTOF = WS_EPOS + (size_t)T * 8 * 4;
constexpr size_t WS_TOK = WS_SLOTOF + (size_t)T * 8 * 4;
constexpr size_t WS_WSL = WS_TOK + al256((size_t)NSLOT * 4);
constexpr size_t WS_HB = WS_WSL + al256((size_t)NSLOT * 4);
constexpr size_t WS_YB = WS_HB + (size_t)NSLOT * ED * 2;
constexpr size_t WS_AV = WS_YB + (size_t)NSLOT * D * 2;
constexpr size_t WS_PM = WS_AV + (size_t)NBH * SEQ * 4;
constexpr size_t WS_MSEQ = WS_PM + (size_t)NBH * SEQ * 4;
constexpr size_t WS_XB8 = WS_MSEQ + al256((size_t)NBH * 80 * 4);
constexpr size_t WS_WGU8 = WS_XB8 + (size_t)T * D;
constexpr size_t SZ_WGU8 = (size_t)1024 * D;
constexpr size_t WS_WIN8 = WS_WGU8 + (size_t)DEPTH * NEX * SZ_WGU8;
constexpr size_t SZ_WIN8 = (size_t)NPROJ * D;
constexpr size_t WS_RWT = WS_WIN8 + DEPTH * SZ_WIN8;
constexpr size_t WS_XQ8 = WS_RWT + (size_t)DEPTH * 2 * NE * D * 2;
constexpr size_t WS_XSC = WS_XQ8 + (size_t)T * D;
constexpr size_t WS_WINQ = WS_XSC + al256((size_t)T * 4);
constexpr size_t SZ_WINQ = (size_t)NBR * D;
constexpr size_t WS_END = WS_WINQ + DEPTH * SZ_WINQ;
constexpr int CW_WABS = 8320;
constexpr float X8_SCALE = 16.0f, W8_SCALE = 256.0f, H8_SCALE = 8.0f, Y8_SCALE = 64.0f;

constexpr int LDS_BYTES = 147456;

__device__ __forceinline__ bf16_t f2bf(float f) { unsigned u = __float_as_uint(f); u += 0x7FFFu + ((u >> 16) & 1u); return (bf16_t)(u >> 16); }
__device__ __forceinline__ float bf2f(bf16_t b) { return __uint_as_float(((unsigned)b) << 16); }
__device__ __forceinline__ unsigned pack2(float lo, float hi) { unsigned r; asm("v_cvt_pk_bf16_f32 %0, %1, %2" : "=v"(r) : "v"(lo), "v"(hi)); return r; }
__device__ __forceinline__ float sigmoidf_(float x) { return __builtin_amdgcn_rcpf(1.0f + __builtin_amdgcn_exp2f(-1.4426950408889634f * x)); }
__device__ __forceinline__ unsigned pack_fp8x4(float a, float b, float c, float d) {
    a = __builtin_amdgcn_fmed3f(a, -448.f, 448.f); b = __builtin_amdgcn_fmed3f(b, -448.f, 448.f); c = __builtin_amdgcn_fmed3f(c, -448.f, 448.f); d = __builtin_amdgcn_fmed3f(d, -448.f, 448.f);
    int w = 0; w = __builtin_amdgcn_cvt_pk_fp8_f32(a, b, w, false); w = __builtin_amdgcn_cvt_pk_fp8_f32(c, d, w, true); return (unsigned)w; }
__device__ __forceinline__ unsigned pack_i8x4(float a, float b, float c, float d) {
    const int ia = (int)__builtin_amdgcn_fmed3f(rintf(a), -127.f, 127.f), ib = (int)__builtin_amdgcn_fmed3f(rintf(b), -127.f, 127.f), ic = (int)__builtin_amdgcn_fmed3f(rintf(c), -127.f, 127.f), id = (int)__builtin_amdgcn_fmed3f(rintf(d), -127.f, 127.f);
    return (unsigned)(ia & 255) | ((unsigned)(ib & 255) << 8) | ((unsigned)(ic & 255) << 16) | ((unsigned)(id & 255) << 24); }
__device__ __forceinline__ unsigned pack_u8x4(float a, float b, float c, float d) {
    return (unsigned)rintf(a) | ((unsigned)rintf(b) << 8) | ((unsigned)rintf(c) << 16) | ((unsigned)rintf(d) << 24); }
__device__ __forceinline__ void un8u(u32x2 w, f32x4& a, f32x4& b) { a[0] = (float)(w.x & 255u); a[1] = (float)((w.x >> 8) & 255u); a[2] = (float)((w.x >> 16) & 255u); a[3] = (float)(w.x >> 24);
    b[0] = (float)(w.y & 255u); b[1] = (float)((w.y >> 8) & 255u); b[2] = (float)((w.y >> 16) & 255u); b[3] = (float)(w.y >> 24); }
__device__ __forceinline__ float wave_sum(float v) { for (int o = 32; o >= 1; o >>= 1) v += __shfl_xor(v, o); return v; }
__device__ __forceinline__ float wave_max(float v) { for (int o = 32; o >= 1; o >>= 1) v = fmaxf(v, __shfl_xor(v, o)); return v; }

#define XB_TMO      128
#define XB_XCNT(j)  (256  + 64 * (j))
#define XB_XSUB(j)  (1280 + 64 * (j))
#define XB_XGEN(j)  (2304 + 64 * (j))
#define XB_TOP      3328
#define XB_TOPGEN   3392
#define XCD_BAR_WORDS 3456
#define XB_SPIN_CAP (1u << 27)
__device__ __forceinline__ unsigned xb_ld(unsigned* p)              { return __hip_atomic_load(p, __ATOMIC_RELAXED, __HIP_MEMORY_SCOPE_AGENT); }
__device__ __forceinline__ unsigned xb_add(unsigned* p, unsigned v) { return __hip_atomic_fetch_add(p, v, __ATOMIC_RELAXED, __HIP_MEMORY_SCOPE_AGENT); }
__device__ __forceinline__ unsigned xb_xcc_id() { return (unsigned)__builtin_amdgcn_s_getreg((3 << 11) | 20) & 0xFu; }
#define XB_SPIN(cond, bar) do { unsigned _sp = 0; while (cond) { __builtin_amdgcn_s_sleep(1); \
    if ((++_sp & 255u) == 0u) { if (xb_ld(&(bar)[XB_TMO])) break; if (_sp > XB_SPIN_CAP) { atomicAdd(&(bar)[XB_TMO], 1u); break; } } } } while (0)
struct XcdBarrier { unsigned* bar; unsigned x; volatile LAS unsigned* st; };
__device__ __forceinline__ XcdBarrier xcd_barrier_post(unsigned* bar, volatile LAS unsigned* st) {
    XcdBarrier b; b.bar = bar; b.x = xb_xcc_id(); b.st = st;
    if (threadIdx.x == 0) (void)xb_add(&bar[XB_XCNT(b.x)], 1u);
    return b;
}
__device__ __forceinline__ void xcd_barrier_complete(unsigned* bar, unsigned x, unsigned& nloc, unsigned& nx) {
    const unsigned G = gridDim.x * gridDim.y * gridDim.z;
    unsigned sum, cnt, mine, sp = 0u;
    for (;;) {
        sum = 0u; cnt = 0u; mine = 0u;
#pragma unroll
        for (unsigned j = 0; j < 16; ++j) { const unsigned c = xb_ld(&bar[XB_XCNT(j)]); sum += c; cnt += (c > 0u) ? 1u : 0u; mine = (j == x) ? c : mine; }
        if (sum == G) break;
        __builtin_amdgcn_s_sleep(1);
        if ((++sp & 255u) == 0u) { if (xb_ld(&bar[XB_TMO])) break; if (sp > XB_SPIN_CAP) { atomicAdd(&bar[XB_TMO], 1u); break; } }
    }
    nloc = mine > 0u ? mine : 1u; nx = cnt > 0u ? cnt : 1u;
}
__device__ __forceinline__ void xcd_barrier(const XcdBarrier& b) {
    asm volatile("s_waitcnt vmcnt(0)" ::: "memory");
    __syncthreads();
    if (threadIdx.x == 0) {
        unsigned* bar = b.bar;
        __builtin_amdgcn_s_waitcnt(0);
        unsigned nloc = b.st[0], nx = b.st[1];
        if (nloc == 0u) { xcd_barrier_complete(bar, b.x, nloc, nx); b.st[0] = nloc; b.st[1] = nx; }
        const unsigned old = xb_add(&bar[XB_XSUB(b.x)], 1u);
        const unsigned gen = old / nloc;
        if (old + 1u == (gen + 1u) * nloc) {
            __builtin_amdgcn_fence(__ATOMIC_RELEASE, "agent");
            asm volatile("s_waitcnt vmcnt(0)" ::: "memory");
            const unsigned og = xb_add(&bar[XB_TOP], 1u);
            const unsigned tg = og / nx;
            if (og + 1u == (tg + 1u) * nx) xb_add(&bar[XB_TOPGEN], 1u);
            else XB_SPIN(xb_ld(&bar[XB_TOPGEN]) == tg, bar);
            __builtin_amdgcn_fence(__ATOMIC_ACQUIRE, "agent");
            xb_add(&bar[XB_XGEN(b.x)], 1u);
            asm volatile("s_waitcnt vmcnt(0)" ::: "memory");
        } else {
            XB_SPIN(xb_ld(&bar[XB_XGEN(b.x)]) == gen, bar);
            __builtin_amdgcn_fence(__ATOMIC_ACQUIRE, "agent");
            asm volatile("s_waitcnt vmcnt(0)" ::: "memory");
        }
    }
    __syncthreads();
}

struct Args { const float* in[23]; float* out; unsigned char* ws; int ph_lo, ph_hi; };
enum { IN_X = 0, IN_MEM, IN_WIN, IN_GATEB, IN_POOLW, IN_POOLS, IN_CONVW, IN_MNORM, IN_RNORM, IN_WBR, IN_WMIX, IN_WQ, IN_WK, IN_WV, IN_WO, IN_RW, IN_RB, IN_WGU, IN_WDN, IN_SGU, IN_SDN, IN_LNW, IN_LNB };

#define GAS __attribute__((address_space(1)))
struct DArgs { const GAS float* in[23]; GAS float* out; GAS unsigned char* ws; int ph_lo, ph_hi; };
typedef const __attribute__((address_space(4))) DArgs* KArgs;
struct Frame {
    LAS unsigned char* lds; int tid, lane, wave, wg, nwg;
    GAS unsigned char* wsg; KArgs ka;
    __device__ __forceinline__ unsigned char* ws_() const { return (unsigned char*)wsg; }
};
__device__ __forceinline__ Frame fresh(const Frame& F) { Frame G = F; asm volatile("" : "+s"(G.wsg)); asm volatile("" : "+s"(G.ka)); asm volatile("" : "+v"(G.tid)); asm volatile("" : "+s"(G.wg));
    G.lane = G.tid & 63; G.wave = __builtin_amdgcn_readfirstlane(G.tid >> 6); return G; }

struct GUnit {
    const bf16_t* Bt;
    const bf16_t* A;
    const int* gather;
    int row0;
    int pn;
    int e;
    bf16_t* dst;
};

__device__ __forceinline__ void un8(u32x4 w, f32x4& a, f32x4& b) { a[0] = __uint_as_float(w[0] << 16); a[1] = __uint_as_float(w[0] & 0xffff0000u); a[2] = __uint_as_float(w[1] << 16); a[3] = __uint_as_float(w[1] & 0xffff0000u);
    b[0] = __uint_as_float(w[2] << 16); b[1] = __uint_as_float(w[2] & 0xffff0000u); b[2] = __uint_as_float(w[3] << 16); b[3] = __uint_as_float(w[3] & 0xffff0000u); }
__device__ __forceinline__ void st_bf16x8(bf16_t* p, f32x4 a, f32x4 b) { u32x4 w; w[0] = pack2(a[0], a[1]); w[1] = pack2(a[2], a[3]); w[2] = pack2(b[0], b[1]); w[3] = pack2(b[2], b[3]); *(u32x4*)p = w; }
__device__ __forceinline__ void st_bf16x4(bf16_t* p, f32x4 v) { u32x2 w; w.x = pack2(v[0], v[1]); w.y = pack2(v[2], v[3]); *(u32x2*)p = w; }
__device__ __forceinline__ void ld_row32(const bf16_t* row, int lane, float (&v)[32]) {
#pragma unroll
    for (int j = 0; j < 4; ++j) { const u32x4 w = *(const u32x4*)(row + j * 512 + lane * 8);
#pragma unroll
        for (int e = 0; e < 4; ++e) { v[j * 8 + 2 * e] = __uint_as_float(w[e] << 16); v[j * 8 + 2 * e + 1] = __uint_as_float(w[e] & 0xffff0000u); } } }
__device__ __forceinline__ void st_row32(bf16_t* row, int lane, const float (&v)[32]) {
#pragma unroll
    for (int j = 0; j < 4; ++j) { u32x4 w;
#pragma unroll
        for (int e = 0; e < 4; ++e) w[e] = pack2(v[j * 8 + 2 * e], v[j * 8 + 2 * e + 1]);
        *(u32x4*)(row + j * 512 + lane * 8) = w; } }
__device__ __forceinline__ void st_row32_i8(unsigned char* row, float* sc, int lane, const float (&v)[32]) {
    float am = 0.f;
#pragma unroll
    for (int j = 0; j < 32; ++j) am = fmaxf(am, fabsf(v[j]));
    am = fmaxf(wave_max(am), 1e-30f); const float q = 127.0f / am;
#pragma unroll
    for (int j = 0; j < 4; ++j) { u32x2 w; w.x = pack_i8x4(v[j * 8] * q, v[j * 8 + 1] * q, v[j * 8 + 2] * q, v[j * 8 + 3] * q); w.y = pack_i8x4(v[j * 8 + 4] * q, v[j * 8 + 5] * q, v[j * 8 + 6] * q, v[j * 8 + 7] * q);
        *(u32x2*)(row + j * 512 + lane * 8) = w; }
    if (lane == 0) *sc = am * (1.0f / 127.0f); }
__device__ __forceinline__ void st_row32_fp8(unsigned char* row, int lane, const float (&v)[32]) {
#pragma unroll
    for (int j = 0; j < 4; ++j) { u32x2 w; w.x = pack_fp8x4(v[j * 8] * X8_SCALE, v[j * 8 + 1] * X8_SCALE, v[j * 8 + 2] * X8_SCALE, v[j * 8 + 3] * X8_SCALE); w.y = pack_fp8x4(v[j * 8 + 4] * X8_SCALE, v[j * 8 + 5] * X8_SCALE, v[j * 8 + 6] * X8_SCALE, v[j * 8 + 7] * X8_SCALE);
        *(u32x2*)(row + j * 512 + lane * 8) = w; } }
struct NoPre { };
struct EpiProj {
    static constexpr bool PAIR_M = false; static constexpr bool SEG = false; typedef NoPre Pre;
    bf16_t* proj; bf16_t* gates;
    static __device__ __forceinline__ float unit_scale(const GUnit& u) { return (u.pn == PC_MK / 256 || u.pn == PC_MK / 256 + 1 || u.pn == PC_RK / 256 || u.pn == PC_RK / 256 + 1) ? 0.08838834764831845f : 1.0f; }
    __device__ __forceinline__ void pre(const GUnit&, int, int, Pre&) const {}
    __device__ __forceinline__ void fin(const GUnit& u, int r, int c, const f32x4 (&a)[2][2], const Pre&) const {
        const int col = u.pn * 256 + c; const size_t row = (size_t)(u.row0 + r);
        if (col < NBR) { st_bf16x8(proj + row * NBR + col, a[0][0], a[0][1]); st_bf16x8(proj + row * NBR + col + 128, a[1][0], a[1][1]); }
        else { f32x4 s[2][2];
#pragma unroll
            for (int h = 0; h < 2; ++h)
#pragma unroll
                for (int n = 0; n < 2; ++n)
#pragma unroll
                    for (int j = 0; j < 4; ++j) s[h][n][j] = __builtin_amdgcn_fmed3f(sigmoidf_(a[h][n][j]) * 255.0f, 1.0f, 255.0f);
            u32x2 w0, w1; w0.x = pack_u8x4(s[0][0][0], s[0][0][1], s[0][0][2], s[0][0][3]); w0.y = pack_u8x4(s[0][1][0], s[0][1][1], s[0][1][2], s[0][1][3]);
            w1.x = pack_u8x4(s[1][0][0], s[1][0][1], s[1][0][2], s[1][0][3]); w1.y = pack_u8x4(s[1][1][0], s[1][1][1], s[1][1][2], s[1][1][3]);
            { const auto rx = __builtin_amdgcn_permlane32_swap(w0.x, w1.x, false, false); w0.x = rx[0]; w1.x = rx[1]; const auto ry = __builtin_amdgcn_permlane32_swap(w0.y, w1.y, false, false); w0.y = ry[0]; w1.y = ry[1]; }
            const bool up = (threadIdx.x & 32u) != 0u; const int gc = col - NBR;
            unsigned char* gp = (unsigned char*)gates + row * 8192 + (up ? gc + 128 - 8 : gc);
            u32x4 w; w[0] = w0.x; w[1] = w0.y; w[2] = w1.x; w[3] = w1.y; *(u32x4*)gp = w; }
    }
};
struct EpiBranch {
    static constexpr bool PAIR_M = false; static constexpr bool SEG = true;
    struct Pre { u32x2 g0, g1; };
    struct SPre { u32x2 a0, a1, b0, b1; };
    const unsigned char* gates; bf16_t* out;
    __device__ __forceinline__ void pre(const GUnit& u, int r, int c, Pre& p) const { const unsigned char* g = gates + (size_t)(u.row0 + r) * 8192 + 3 * 2048 + u.pn * 256 + c; p.g0 = *(const u32x2*)g; p.g1 = *(const u32x2*)(g + 128); }
    __device__ __forceinline__ void fin(const GUnit& u, int r, int c, const f32x4 (&a)[2][2], const Pre& p) const {
        f32x4 x0, x1, y0, y1; un8u(p.g0, x0, x1); un8u(p.g1, y0, y1); const float k = 1.0f / 255.0f;
        bf16_t* o = out + (size_t)(u.row0 + r) * D + u.pn * 256 + c; st_bf16x8(o, a[0][0] * x0 * k, a[0][1] * x1 * k); st_bf16x8(o + 128, a[1][0] * y0 * k, a[1][1] * y1 * k); }
    __device__ __forceinline__ void seg_pre(const GUnit& u, int r, int c, int s, SPre& p) const { const unsigned char* g = gates + (size_t)(u.row0 + r) * 8192 + s * 2048 + u.pn * 256 + c;
        p.a0 = *(const u32x2*)g; p.a1 = *(const u32x2*)(g + 128); p.b0 = *(const u32x2*)(g + 2048); p.b1 = *(const u32x2*)(g + 2048 + 128); }
    __device__ __forceinline__ void seg_fin(f32x4 (&h0)[2], f32x4 (&h1)[2], const SPre& p) const {
        f32x4 a0, a1, b0, b1; un8u(p.a0, a0, a1); un8u(p.b0, b0, b1);
#pragma unroll
        for (int j = 0; j < 4; ++j) { h0[0][j] *= a0[j] * __builtin_amdgcn_rcpf(b0[j]); h0[1][j] *= a1[j] * __builtin_amdgcn_rcpf(b1[j]); }
        un8u(p.a1, a0, a1); un8u(p.b1, b0, b1);
#pragma unroll
        for (int j = 0; j < 4; ++j) { h1[0][j] *= a0[j] * __builtin_amdgcn_rcpf(b0[j]); h1[1][j] *= a1[j] * __builtin_amdgcn_rcpf(b1[j]); }
    }
};
struct EpiResid {
    static constexpr bool PAIR_M = false; static constexpr bool SEG = false;
    struct Pre { u32x4 x0, x1; };
    const bf16_t* x; bf16_t* y;
    __device__ __forceinline__ void pre(const GUnit& u, int r, int c, Pre& p) const { const bf16_t* xp = x + (size_t)(u.row0 + r) * D + u.pn * 256 + c; p.x0 = *(const u32x4*)xp; p.x1 = *(const u32x4*)(xp + 128); }
    __device__ __forceinline__ void fin(const GUnit& u, int r, int c, const f32x4 (&a)[2][2], const Pre& p) const {
        f32x4 x0, x1, y0, y1; un8(p.x0, x0, x1); un8(p.x1, y0, y1);
        bf16_t* o = y + (size_t)(u.row0 + r) * D + u.pn * 256 + c; st_bf16x8(o, x0 * ALPHA + a[0][0], x1 * ALPHA + a[0][1]); st_bf16x8(o + 128, y0 * ALPHA + a[1][0], y1 * ALPHA + a[1][1]); }
};
struct EpiQKV {
    static constexpr bool PAIR_M = false; static constexpr bool SEG = false; typedef NoPre Pre; int pad_;
    __device__ __forceinline__ void pre(const GUnit&, int, int, Pre&) const {}
    __device__ __forceinline__ void fin(const GUnit& u, int r, int c, const f32x4 (&a)[2][2], const Pre&) const {
        bf16_t* o = u.dst + (size_t)(u.row0 + r) * W + u.pn * 256 + c; st_bf16x8(o, a[0][0], a[0][1]); st_bf16x8(o + 128, a[1][0], a[1][1]); }
};
struct EpiSwiglu {
    static constexpr bool SEG = false; static constexpr bool PAIR_M = true;
    struct Pre { float w; };
    const float* wsl; unsigned char* hb;
    __device__ __forceinline__ void pre(const GUnit& u, int r, int, Pre& p) const { p.w = wsl[u.row0 + r] * H8_SCALE; }
    __device__ __forceinline__ u32x2 act(const f32x4 (&a)[2][2], float w) const { f32x4 o[2];
#pragma unroll
        for (int n = 0; n < 2; ++n)
#pragma unroll
            for (int j = 0; j < 4; ++j) o[n][j] = a[0][n][j] * sigmoidf_(a[0][n][j]) * a[1][n][j] * w;
        u32x2 w8; w8.x = pack_fp8x4(o[0][0], o[0][1], o[0][2], o[0][3]); w8.y = pack_fp8x4(o[1][0], o[1][1], o[1][2], o[1][3]); return w8; }
    __device__ __forceinline__ void fin2(const GUnit& u, int r0, int r1, int c, const f32x4 (&a0)[2][2], const f32x4 (&a1)[2][2], const Pre& p0, const Pre& p1) const {
        u32x2 v0 = act(a0, p0.w), v1 = act(a1, p1.w);
        { const auto rx = __builtin_amdgcn_permlane32_swap(v0.x, v1.x, false, false); v0.x = rx[0]; v1.x = rx[1]; const auto ry = __builtin_amdgcn_permlane32_swap(v0.y, v1.y, false, false); v0.y = ry[0]; v1.y = ry[1]; }
        const bool up = (threadIdx.x & 32u) != 0u;
        unsigned char* o = hb + (size_t)(u.row0 + (up ? r1 : r0)) * ED + u.pn * 128 + (up ? c - 8 : c);
        u32x4 w; w[0] = v0.x; w[1] = v0.y; w[2] = v1.x; w[3] = v1.y; *(u32x4*)o = w; }
    __device__ __forceinline__ void fin(const GUnit&, int, int, const f32x4 (&)[2][2], const Pre&) const {}
};
struct EpiDown {
    static constexpr bool PAIR_M = false; static constexpr bool SEG = false; typedef NoPre Pre;
    unsigned char* yb;
    __device__ __forceinline__ void pre(const GUnit&, int, int, Pre&) const {}
    __device__ __forceinline__ void fin(const GUnit& u, int r, int c, const f32x4 (&a)[2][2], const Pre&) const {
        u32x2 w0, w1; w0.x = pack_fp8x4(a[0][0][0], a[0][0][1], a[0][0][2], a[0][0][3]); w0.y = pack_fp8x4(a[0][1][0], a[0][1][1], a[0][1][2], a[0][1][3]);
        w1.x = pack_fp8x4(a[1][0][0], a[1][0][1], a[1][0][2], a[1][0][3]); w1.y = pack_fp8x4(a[1][1][0], a[1][1][1], a[1][1][2], a[1][1][3]);
        { const auto rx = __builtin_amdgcn_permlane32_swap(w0.x, w1.x, false, false); w0.x = rx[0]; w1.x = rx[1]; const auto ry = __builtin_amdgcn_permlane32_swap(w0.y, w1.y, false, false); w0.y = ry[0]; w1.y = ry[1]; }
        const bool up = (threadIdx.x & 32u) != 0u;
        unsigned char* o = yb + (size_t)(u.row0 + r) * D + u.pn * 256 + (up ? 128 + c - 8 : c);
        u32x4 w; w[0] = w0.x; w[1] = w0.y; w[2] = w1.x; w[3] = w1.y; *(u32x4*)o = w; }
};

typedef short bf16x8 __attribute__((ext_vector_type(8)));
typedef short s16x4 __attribute__((ext_vector_type(4)));
__device__ __forceinline__ s16x4 lds_tr(const LAS bf16_t* p) { return __builtin_amdgcn_ds_read_tr16_b64_v4i16((LAS s16x4*)p); }
__device__ __forceinline__ bf16x8 cat4(s16x4 a, s16x4 b) { bf16x8 r; r[0] = a[0]; r[1] = a[1]; r[2] = a[2]; r[3] = a[3]; r[4] = b[0]; r[5] = b[1]; r[6] = b[2]; r[7] = b[3]; return r; }
__device__ __forceinline__ bf16x8 pack8(f32x4 a, f32x4 b) { union { u32x4 u; bf16x8 h; } c; c.u[0] = pack2(a[0], a[1]); c.u[1] = pack2(a[2], a[3]); c.u[2] = pack2(b[0], b[1]); c.u[3] = pack2(b[2], b[3]); return c.h; }
constexpr int BK = 64, HTB = 128 * BK * 2;
__device__ __forceinline__ int lds_byte(int r, int c) { const int st = (r >> 4) * 2 + (c >> 5), rr = r & 15, cc = c & 31, ob = rr * 64 + cc * 2; return st * 1024 + (ob ^ (((ob >> 9) & 1) << 5)); }
__device__ __forceinline__ void stage_rc(int b, int& R, int& C) { const int st = b / 1024, sb = b % 1024, swz = sb ^ (((sb >> 9) & 1) << 5); R = (st >> 1) * 16 + swz / 64; C = (st & 1) * 32 + (swz % 64) / 2; }

typedef int i32x8 __attribute__((ext_vector_type(8)));
typedef int i32x4 __attribute__((ext_vector_type(4)));
template <class Epi, class Sched, int MODE = 0>
__device__ __forceinline__ void gemm_phase_mfma(const Frame& F, const int K, const Sched& S, const Epi& E, const float oscale = 1.0f, const float* rowscale = nullptr) {
    constexpr bool FP8 = (MODE == 1), I8 = (MODE == 2);
    LAS unsigned char* lds = F.lds;
    const int tid = F.tid, wid = F.wave, lane = F.lane, wr = wid >> 2, wc = wid & 3, fr = lane & 15, fq = lane >> 4;
    const int KB = MODE ? K : 2 * K;
    const int nt = KB / 128;
    unsigned voffB[2];
#pragma unroll
    for (int i = 0; i < 2; ++i) { int R, C; stage_rc(tid * 16 + i * 8192, R, C); const int rho = R & 31, q4 = (rho & 15) >> 2, Rb = (R & ~31) + 8 * (((q4 & 1) << 1) | (q4 >> 1)) + 4 * (rho >> 4) + (rho & 3); voffB[i] = (unsigned)(Rb * KB + C * 2); }
    const size_t kstep = (size_t)(BK * 2);
    const size_t hstepB = (size_t)128 * KB;
    const unsigned ldsw = (unsigned)wid * 1024u;
    const int aoff = FP8 ? lds_byte(wr * 64 + fr, fq * 16) : lds_byte(wr * 64 + fr, fq * 8), boff = FP8 ? lds_byte(wc * 32 + fr, fq * 16) : lds_byte(wc * 32 + fr, fq * 8);
#define SA_(b, h) (((b) * 2 + (h)) * HTB)
#define SB_(b, h) ((4 + (b) * 2 + (h)) * HTB)
#define STAGE_(bufoff, gbase, voff) do { _Pragma("unroll") for (int _i = 0; _i < 2; ++_i) \
        __builtin_amdgcn_global_load_lds((const unsigned*)((const char*)(gbase) + (voff)[_i]), (LAS unsigned*)(lds + (bufoff) + ldsw + _i * 8192), 16, 0, 0); } while (0)
#define LDA_(dst, b, h) do { _Pragma("unroll") for (int m = 0; m < 4; ++m) { if constexpr (FP8) { const i32x4 _lo = *(const LAS i32x4*)(lds + SA_(b, h) + aoff + m * 2048), _hi = *(const LAS i32x4*)(lds + SA_(b, h) + aoff + m * 2048 + 16); \
            dst##8[m] = __builtin_shufflevector(_lo, _hi, 0, 1, 2, 3, 4, 5, 6, 7); } \
        else { _Pragma("unroll") for (int k = 0; k < 2; ++k) dst[m][k] = *(const LAS bf16x8*)(lds + SA_(b, h) + aoff + m * 2048 + k * 1024); } } } while (0)
#define LDB_(dst, b, h) do { _Pragma("unroll") for (int n = 0; n < 2; ++n) { if constexpr (FP8) { const i32x4 _lo = *(const LAS i32x4*)(lds + SB_(b, h) + boff + n * 2048), _hi = *(const LAS i32x4*)(lds + SB_(b, h) + boff + n * 2048 + 16); \
            dst##8[n] = __builtin_shufflevector(_lo, _hi, 0, 1, 2, 3, 4, 5, 6, 7); } \
        else { _Pragma("unroll") for (int k = 0; k < 2; ++k) dst[n][k] = *(const LAS bf16x8*)(lds + SB_(b, h) + boff + n * 2048 + k * 1024); } } } while (0)
#define MMA_(ai, bj, At, Bt) do { __builtin_amdgcn_s_setprio(1); _Pragma("unroll") for (int m = 0; m < 4; ++m) _Pragma("unroll") for (int n = 0; n < 2; ++n) { \
        if constexpr (FP8) asm volatile("v_mfma_scale_f32_16x16x128_f8f6f4 %0, %1, %2, %0, %3, %3 op_sel_hi:[0,0,0]" : "+v"(acc[ai][bj][m][n]) : "v"(Bt##8[n]), "v"(At##8[m]), "v"(sc8)); \
        else if constexpr (I8) { _Pragma("unroll") for (int k = 0; k < 2; ++k) acci[ai][bj][m][n] = __builtin_amdgcn_mfma_i32_16x16x64_i8(__builtin_bit_cast(i32x4, Bt[n][k]), __builtin_bit_cast(i32x4, At[m][k]), acci[ai][bj][m][n], 0, 0, 0); } \
        else { _Pragma("unroll") for (int k = 0; k < 2; ++k) acc[ai][bj][m][n] = __builtin_amdgcn_mfma_f32_16x16x32_bf16(Bt[n][k], At[m][k], acc[ai][bj][m][n], 0, 0, 0); } } \
        __builtin_amdgcn_s_setprio(0); } while (0)
#define WAIT_V_(n) asm volatile("s_waitcnt vmcnt(" #n ")" ::: "memory")
#define WAIT_L_(n) asm volatile("s_waitcnt lgkmcnt(" #n ")" ::: "memory")
#define BAR_ __builtin_amdgcn_s_barrier()
#define SCHED_ __builtin_amdgcn_sched_barrier(0)
#define VOFFS_(dst, u) do { int _tz = tid; asm volatile("" : "+v"(_tz)); _Pragma("unroll") for (int _i = 0; _i < 2; ++_i) { int _R, _C; stage_rc(_tz * 16 + _i * 8192, _R, _C); \
        _Pragma("unroll") for (int _h = 0; _h < 2; ++_h) { const int _r = _h * 128 + _R; \
        const unsigned _row = (u).gather ? (unsigned)(u).gather[_r] : (unsigned)((u).row0 + _r); dst[_h][_i] = _row * (unsigned)KB + (unsigned)_C * 2u; } } } while (0)
    GUnit cur, nxt; int ui = 0;
    if (!S.get(0, cur)) return;
    f32x4 acc[2][2][4][2]; i32x4 acci[2][2][4][2];
#pragma unroll
    for (int a = 0; a < 2; ++a)
#pragma unroll
        for (int b = 0; b < 2; ++b)
#pragma unroll
            for (int m = 0; m < 4; ++m)
#pragma unroll
                for (int n = 0; n < 2; ++n) { acc[a][b][m][n] = (f32x4){0.f, 0.f, 0.f, 0.f}; acci[a][b][m][n] = (i32x4){0, 0, 0, 0}; }
    bf16x8 At[4][2], B0[2][2], B1[2][2]; i32x8 At8[4], B08[2], B18[2];
    int sc8 = 0x7f7f7f7f; asm volatile("" : "+v"(sc8));
    unsigned vA[2][2], vN[2][2];
    VOFFS_(vA, cur);
    const char* cA = (const char*)cur.A; const char* cB = (const char*)cur.Bt;
    STAGE_(SB_(0, 0), cB, voffB); STAGE_(SA_(0, 0), cA, vA[0]); STAGE_(SB_(0, 1), cB + hstepB, voffB); STAGE_(SA_(0, 1), cA, vA[1]);
    if (wr == 1) BAR_;
    WAIT_V_(4); BAR_;
    STAGE_(SB_(1, 0), cB + kstep, voffB); STAGE_(SA_(1, 0), cA + kstep, vA[0]); STAGE_(SB_(1, 1), cB + hstepB + kstep, voffB);
    WAIT_V_(6); BAR_;
    for (;;) {
        const bool has_next = S.get(ui + 1, nxt);
        const char* nA = has_next ? (const char*)nxt.A : cA; const char* nB = has_next ? (const char*)nxt.Bt : cB;
        if (has_next) { VOFFS_(vN, nxt); }
        for (int t = 0; t < nt; t += 2) {
            const bool last = (t == nt - 2);
            if constexpr (Epi::SEG) { if (t > 0 && (t & 7) == 0) {
                int tz = tid; asm volatile("" : "+v"(tz)); const int er = ((tz >> 8) & 1) * 64 + (tz & 15), ec = ((tz >> 6) & 3) * 32 + ((((tz >> 4) & 1) << 1) | ((tz >> 5) & 1)) * 8;
#pragma unroll
                for (int ai = 0; ai < 2; ++ai) { typename Epi::SPre sp[4];
#pragma unroll
                    for (int m = 0; m < 4; ++m) E.seg_pre(cur, ai * 128 + m * 16 + er, ec, (t >> 3) - 1, sp[m]);
#pragma unroll
                    for (int m = 0; m < 4; ++m) E.seg_fin(acc[ai][0][m], acc[ai][1][m], sp[m]);
                    asm volatile("" ::: "memory"); }
            } }
            const char* a1 = cA + (size_t)(t + 1) * kstep;
            const char* a2 = last ? nA : cA + (size_t)(t + 2) * kstep; const char* b2 = last ? nB : cB + (size_t)(t + 2) * kstep;
            const char* a3 = a2 + kstep; const char* b3 = b2 + kstep;
            unsigned w0[2], w1[2];
#pragma unroll
            for (int i = 0; i < 2; ++i) { w0[i] = (last && has_next) ? vN[0][i] : vA[0][i]; w1[i] = (last && has_next) ? vN[1][i] : vA[1][i]; }
            LDB_(B0, 0, 0); SCHED_; LDA_(At, 0, 0); STAGE_(SA_(1, 1), a1, vA[1]);
            WAIT_L_(8); BAR_; WAIT_L_(0); MMA_(0, 0, At, B0); BAR_; SCHED_;
            LDB_(B1, 0, 1); STAGE_(SB_(0, 0), b2, voffB);
            BAR_; WAIT_L_(0); MMA_(0, 1, At, B1); BAR_;
            LDA_(At, 0, 1); STAGE_(SA_(0, 0), a2, w0);
            BAR_; WAIT_L_(0); MMA_(1, 0, At, B0); BAR_; SCHED_;
            STAGE_(SB_(0, 1), b2 + hstepB, voffB);
            WAIT_V_(6); BAR_; MMA_(1, 1, At, B1); BAR_;
            LDB_(B0, 1, 0); SCHED_; LDA_(At, 1, 0); STAGE_(SA_(0, 1), a2, w1);
            WAIT_L_(8); BAR_; WAIT_L_(0); MMA_(0, 0, At, B0); BAR_; SCHED_;
            LDB_(B1, 1, 1); STAGE_(SB_(1, 0), b3, voffB);
            BAR_; WAIT_L_(0); MMA_(0, 1, At, B1); BAR_;
            LDA_(At, 1, 1); STAGE_(SA_(1, 0), a3, w0);
            BAR_; WAIT_L_(0); MMA_(1, 0, At, B0); BAR_; SCHED_;
            STAGE_(SB_(1, 1), b3 + hstepB, voffB);
            WAIT_V_(6); BAR_; MMA_(1, 1, At, B1); BAR_;
        }
        { int tz = tid; asm volatile("" : "+v"(tz)); const int er = ((tz >> 8) & 1) * 64 + (tz & 15), ec = ((tz >> 6) & 3) * 32 + ((((tz >> 4) & 1) << 1) | ((tz >> 5) & 1)) * 8;
          typename Epi::Pre pre[2][4];
#pragma unroll
          for (int ai = 0; ai < 2; ++ai)
#pragma unroll
              for (int m = 0; m < 4; ++m) E.pre(cur, ai * 128 + m * 16 + er, ec, pre[ai][m]);
          if constexpr (I8) {
#pragma unroll
              for (int ai = 0; ai < 2; ++ai)
#pragma unroll
                  for (int m = 0; m < 4; ++m) { const float rs = rowscale[cur.row0 + ai * 128 + m * 16 + er] * oscale * Epi::unit_scale(cur);
#pragma unroll
                      for (int bj = 0; bj < 2; ++bj)
#pragma unroll
                          for (int n = 0; n < 2; ++n)
#pragma unroll
                              for (int j = 0; j < 4; ++j) acc[ai][bj][m][n][j] = (float)acci[ai][bj][m][n][j] * rs; } }
          if constexpr (FP8) {
#pragma unroll
              for (int ai = 0; ai < 2; ++ai)
#pragma unroll
                  for (int bj = 0; bj < 2; ++bj)
#pragma unroll
                      for (int m = 0; m < 4; ++m)
#pragma unroll
                          for (int n = 0; n < 2; ++n) acc[ai][bj][m][n] *= oscale; }
          if constexpr (Epi::PAIR_M) {
#pragma unroll
          for (int ai = 0; ai < 2; ++ai)
#pragma unroll
              for (int m = 0; m < 4; m += 2) { const f32x4 a4[2][2] = {{acc[ai][0][m][0], acc[ai][0][m][1]}, {acc[ai][1][m][0], acc[ai][1][m][1]}}; const f32x4 b4[2][2] = {{acc[ai][0][m + 1][0], acc[ai][0][m + 1][1]}, {acc[ai][1][m + 1][0], acc[ai][1][m + 1][1]}};
                  E.fin2(cur, ai * 128 + m * 16 + er, ai * 128 + (m + 1) * 16 + er, ec, a4, b4, pre[ai][m], pre[ai][m + 1]); }
          } else {
#pragma unroll
          for (int ai = 0; ai < 2; ++ai)
#pragma unroll
              for (int m = 0; m < 4; ++m) { const f32x4 a4[2][2] = {{acc[ai][0][m][0], acc[ai][0][m][1]}, {acc[ai][1][m][0], acc[ai][1][m][1]}}; E.fin(cur, ai * 128 + m * 16 + er, ec, a4, pre[ai][m]); } } }
        if (!has_next) break;
#pragma unroll
        for (int a = 0; a < 2; ++a)
#pragma unroll
            for (int b = 0; b < 2; ++b)
#pragma unroll
                for (int m = 0; m < 4; ++m)
#pragma unroll
                    for (int n = 0; n < 2; ++n) { acc[a][b][m][n] = (f32x4){0.f, 0.f, 0.f, 0.f}; acci[a][b][m][n] = (i32x4){0, 0, 0, 0}; }
        cur = nxt; cA = nA; cB = nB; ++ui;
#pragma unroll
        for (int h = 0; h < 2; ++h)
#pragma unroll
            for (int i = 0; i < 2; ++i) vA[h][i] = vN[h][i];
    }
    WAIT_V_(0);
    if (wr == 0) BAR_;
    BAR_;
#undef SA_
#undef SB_
#undef STAGE_
#undef LDA_
#undef LDB_
#undef MMA_
#undef WAIT_V_
#undef WAIT_L_
#undef BAR_
#undef SCHED_
#undef VOFFS_
}

struct DenseSched {
    const bf16_t* A; const bf16_t* Bt; int K, nM, nN, nwg, G, c, i0, i1, split, pnoff;
    __device__ __forceinline__ void segment(int sg) { i0 = sg == 0 ? 0 : split; i1 = sg == 0 ? split : (1 << 30); }
    __device__ __forceinline__ bool get(int ii, GUnit& u) const {
        const int i = ii + i0; if (i >= i1) return false;
        const long L = (long)i * G + c; if (L >= nwg) return false;
        int wgid = (int)L; { const int q = nwg / 8, r = nwg % 8, xcd = wgid % 8, off = wgid / 8; wgid = (xcd < r ? xcd * (q + 1) : r * (q + 1) + (xcd - r) * q) + off; }
        const int nig = 8 * nN, gid = wgid / nig, fm = gid * 8, gsz = (nM - fm) < 8 ? (nM - fm) : 8;
        const int pm = fm + ((wgid % nig) % gsz), pn = (wgid % nig) / gsz;
        u.pn = pn + pnoff; u.row0 = pm * 256; u.A = A; u.gather = nullptr; u.Bt = Bt + (size_t)pn * 256 * K; u.e = 0; return true;
    }
};
struct QkvSched {
    unsigned char* ws; int l, G, c;
    __device__ __forceinline__ bool get(int i, GUnit& g) const {
        const int u = i * G + c; if (u >= 144) return false; g.gather = nullptr;
        if (u < 128) { g.e = 0; g.pn = u & 1; g.row0 = (u >> 1) * 256; g.A = (const bf16_t*)(ws + WS_XB); g.Bt = (const bf16_t*)(ws + WS_WQ + l * SZ_WQ) + (size_t)g.pn * 256 * D; g.dst = (bf16_t*)(ws + WS_Q); }
        else { const int v = u - 128; g.e = 1 + (v >> 3); g.pn = v & 1; g.row0 = ((v >> 1) & 3) * 256; g.A = (const bf16_t*)(ws + WS_MEMB); g.Bt = (const bf16_t*)(ws + (g.e == 1 ? WS_WK : WS_WV) + l * SZ_WQ) + (size_t)g.pn * 256 * D; g.dst = (bf16_t*)(ws + (g.e == 1 ? WS_KM : WS_VM)) + (size_t)l * TM * W; }
        return true;
    }
};
template <int NCT, bool GATEUP> struct MoeSched {
    unsigned char* ws; const LAS int* pst; int l, G, c, nunits;
    __device__ __forceinline__ bool get(int i, GUnit& g) const {
        const int u = i * G + c; if (u >= nunits) return false;
        const int rt = u / NCT; g.pn = u % NCT; g.row0 = rt * 256; const int e = __builtin_amdgcn_readfirstlane((int)((const LAS unsigned char*)(pst + 68))[rt]); g.e = e;
        if (GATEUP) { g.A = (const bf16_t*)(ws + WS_XB8); g.gather = (const int*)(ws + WS_TOK) + g.row0; g.Bt = (const bf16_t*)(ws + WS_WGU8 + ((size_t)l * NEX + e) * SZ_WGU8 + (size_t)g.pn * 256 * D); }
        else { g.A = (const bf16_t*)(ws + WS_HB); g.gather = nullptr; g.Bt = (const bf16_t*)(ws + WS_WDN + ((size_t)l * NEX + e) * SZ_WDN1 + (size_t)g.pn * 256 * ED); }
        return true;
    }
};

struct TDesc { const float* sp; int sld; unsigned char* dp; int dldb; int fp8; float qs; };
constexpr int TK_WINA = 1024, TK_WINB = 2560, TK_BR = 384, TK_WOUT = 512, TK_QKV = 384, TK_WO = 128, TK_GU = NEX * 8 * 32, TK_DN = NEX * 128;
constexpr int TK_L0DEF = TK_BR + TK_WOUT + TK_QKV + TK_WO + TK_GU + TK_DN, TK_LAYER = TK_WINA + TK_WINB + TK_L0DEF;
__device__ __forceinline__ void tile_desc(const Frame& F, int l, int t, TDesc& d) {
    const KArgs a = F.ka; unsigned char* ws = F.ws_(); d.fp8 = 0; d.qs = W8_SCALE;
    if (t < TK_WINA) { const int tk = t >> 6, tc = t & 63; d.sp = ((const float*)a->in[IN_WIN]) + (size_t)l * D * PROJ_W + (size_t)tk * 128 * PROJ_W + tc * 64; d.sld = PROJ_W; d.dldb = D; d.fp8 = 2; d.qs = 127.0f / fmaxf(__uint_as_float(((const unsigned*)(ws + WS_CTL))[CW_WABS + l]), 1e-30f); d.dp = ws + WS_WINQ + l * SZ_WINQ + (size_t)tc * 64 * D + tk * 128; return; }
    t -= TK_WINA;
    if (t < TK_WINB) { const int tk = t / 160, tc = t % 160; d.sp = ((const float*)a->in[IN_WIN]) + (size_t)l * D * PROJ_W + (size_t)tk * 128 * PROJ_W + 4104 + tc * 64; d.sld = PROJ_W;
        if (tc < 32) { d.dldb = D; d.fp8 = 2; d.qs = 127.0f / fmaxf(__uint_as_float(((const unsigned*)(ws + WS_CTL))[CW_WABS + l]), 1e-30f); d.dp = ws + WS_WINQ + l * SZ_WINQ + (size_t)(4096 + tc * 64) * D + tk * 128; }
        else { d.dldb = D; d.fp8 = 1; d.dp = ws + WS_WIN8 + l * SZ_WIN8 + (size_t)(4096 + tc * 64) * D + tk * 128; }
        return; }
    t -= TK_WINB;
    if (t < TK_BR) { const int n = 1 + (t >> 7), tt = t & 127, tk = tt >> 5, tc = tt & 31; d.sp = ((const float*)a->in[IN_WBR]) + ((size_t)l * 4 + n) * W * D + (size_t)tk * 128 * D + tc * 64; d.sld = D; d.dldb = D * 2; d.dp = ws + WS_WB + l * SZ_DD + ((size_t)tc * 64 * D + n * W + tk * 128) * 2; return; }
    t -= TK_BR;
    if (t < TK_WOUT) { const int tk = t >> 5, tc = t & 31; d.sp = ((const float*)a->in[IN_WMIX]) + (size_t)l * D * D + (size_t)tk * 128 * D + tc * 64; d.sld = D; d.dldb = D * 2; d.dp = ws + WS_WOUT + l * SZ_DD + ((size_t)tc * 64 * D + tk * 128) * 2; return; }
    t -= TK_WOUT;
    if (t < TK_QKV) { const int which = t >> 7, tt = t & 127, tk = tt >> 3, tc = tt & 7; d.sp = (const float*)a->in[which == 0 ? IN_WQ : (which == 1 ? IN_WK : IN_WV)] + (size_t)l * D * W + (size_t)tk * 128 * W + tc * 64; d.sld = W; d.dldb = D * 2;
        d.dp = ws + (which == 0 ? WS_WQ : (which == 1 ? WS_WK : WS_WV)) + l * SZ_WQ + ((size_t)tc * 64 * D + tk * 128) * 2; return; }
    t -= TK_QKV;
    if (t < TK_WO) { const int tk = t >> 5, tc = t & 31; d.sp = ((const float*)a->in[IN_WO]) + (size_t)l * W * D + (size_t)tk * 128 * D + tc * 64; d.sld = D; d.dldb = W * 2; d.dp = ws + WS_WO + l * SZ_WQ + ((size_t)tc * 64 * W + tk * 128) * 2; return; }
    t -= TK_WO;
    if (t < TK_GU) { const int tt = t & 31, job = t >> 5, half = job & 1, j = (job >> 1) & 3, e = job >> 3, tk = tt >> 1, tc = tt & 1;
        d.sp = (e < NE ? ((const float*)a->in[IN_WGU]) + ((size_t)l * NE + e) * D * 1024 : ((const float*)a->in[IN_SGU]) + (size_t)l * D * 1024) + half * 512 + j * 128 + (size_t)tk * 128 * 1024 + tc * 64; d.sld = 1024; d.dldb = D; d.fp8 = 1;
        d.dp = ws + WS_WGU8 + ((size_t)l * NEX + e) * SZ_WGU8 + (size_t)(j * 256 + half * 128 + tc * 64) * D + tk * 128; return; }
    t -= TK_GU;
    { const int tt = t & 127, e = t >> 7, tk = tt >> 5, tc = tt & 31;
      d.sp = (e < NE ? ((const float*)a->in[IN_WDN]) + ((size_t)l * NE + e) * ED * D : ((const float*)a->in[IN_SDN]) + (size_t)l * ED * D) + (size_t)tk * 128 * D + tc * 64; d.sld = D; d.dldb = ED; d.fp8 = 1;
      d.dp = ws + WS_WDN + ((size_t)l * NEX + e) * SZ_WDN1 + (size_t)tc * 64 * ED + tk * 128; }
}
constexpr int XP_SLOT = 64 * 256;
template <int NB> struct XRegs { f32x4 r[NB][4]; };
template <int NB> __device__ __forceinline__ void xpose_load(const Frame& F, int l, int t0, int tstep, int n, XRegs<NB>& X) {
    const int tid = F.tid, row4 = (tid >> 4) * 4, cq = (tid & 15) * 4;
#pragma unroll
    for (int b = 0; b < NB; ++b) if (b < n) { TDesc d; tile_desc(F, l, t0 + b * tstep, d); const float* sp = d.sp + (size_t)row4 * d.sld + cq;
#pragma unroll
        for (int q = 0; q < 4; ++q) X.r[b][q] = __builtin_nontemporal_load((const f32x4*)(sp + (size_t)q * d.sld)); }
}
template <int NB> __device__ __forceinline__ void xpose_finish(const Frame& F, int l, int t0, int tstep, int n, const XRegs<NB>& X) {
    const int tid = F.tid, row4 = (tid >> 4) * 4, cq = (tid & 15) * 4;
    int t1 = t0; asm volatile("" : "+s"(t1));
#pragma unroll
    for (int b = 0; b < NB; ++b) if (b < n) { TDesc d; tile_desc(F, l, t1 + b * tstep, d); LAS unsigned char* L = F.lds + b * XP_SLOT;
        if (d.fp8) { const int sw = ((cq >> 2) & 7) << 4;
#pragma unroll
            for (int j = 0; j < 4; ++j) *(LAS unsigned*)(L + (cq + j) * 128 + (row4 ^ sw)) = (d.fp8 == 2) ? pack_i8x4(X.r[b][0][j] * d.qs, X.r[b][1][j] * d.qs, X.r[b][2][j] * d.qs, X.r[b][3][j] * d.qs) : pack_fp8x4(X.r[b][0][j] * W8_SCALE, X.r[b][1][j] * W8_SCALE, X.r[b][2][j] * W8_SCALE, X.r[b][3][j] * W8_SCALE);
        } else { const int sw = ((cq >> 2) & 15) << 4;
#pragma unroll
            for (int j = 0; j < 4; ++j) { u32x2 w; w.x = pack2(X.r[b][0][j], X.r[b][1][j]); w.y = pack2(X.r[b][2][j], X.r[b][3][j]); *(LAS u32x2*)(L + (cq + j) * 256 + ((row4 * 2) ^ sw)) = w; } } }
    __syncthreads();
    int t2 = t0; asm volatile("" : "+s"(t2));
#pragma unroll
    for (int b = 0; b < NB; ++b) if (b < n) { TDesc d; tile_desc(F, l, t2 + b * tstep, d); const LAS unsigned char* L = F.lds + b * XP_SLOT; const int c = tid >> 3, kq = tid & 7;
        if (d.fp8) *(u32x4*)(d.dp + (size_t)c * d.dldb + kq * 16) = *(const LAS u32x4*)(L + c * 128 + ((kq * 16) ^ (((c >> 2) & 7) << 4)));
        else { const int sw = ((c >> 2) & 15) << 4; *(u32x4*)(d.dp + (size_t)c * d.dldb + kq * 16) = *(const LAS u32x4*)(L + c * 256 + ((kq * 16) ^ sw)); *(u32x4*)(d.dp + (size_t)c * d.dldb + 128 + kq * 16) = *(const LAS u32x4*)(L + c * 256 + ((128 + kq * 16) ^ sw)); } }
    __syncthreads();
}
__device__ __forceinline__ void xpose_range(const Frame& F, int l, int tlo, int thi, int rank, int nranks) {
    constexpr int NB = 4; const int step = nranks * NB;
    XRegs<NB> A, B;
    int t = tlo + rank * NB; if (t >= thi) return;
#define XP_CNT(tt) (((thi) - (tt)) < NB ? ((thi) - (tt)) : NB)
    xpose_load<NB>(F, l, t, 1, XP_CNT(t), A);
    for (;;) {
        const int tb = t + step; const bool hb = tb < thi; if (hb) xpose_load<NB>(F, l, tb, 1, XP_CNT(tb), B);
        xpose_finish<NB>(F, l, t, 1, XP_CNT(t), A);
        if (!hb) break;
        const int ta = tb + step; const bool ha = ta < thi; if (ha) xpose_load<NB>(F, l, ta, 1, XP_CNT(ta), A);
        xpose_finish<NB>(F, l, tb, 1, XP_CNT(tb), B);
        if (!ha) break;
        t = ta;
    }
#undef XP_CNT
}
__device__ __forceinline__ void pool_fold(const Frame& F, int l, int rank, int nranks) {
    const KArgs a = F.ka; unsigned char* ws = F.ws_();
    for (size_t i = (size_t)rank * NTHR + F.tid; i < (size_t)W * D; i += (size_t)nranks * NTHR) {
        const int d = (int)(i % D), gc = (int)(i / D), g = gc >> 7;
        const float* pw = ((const float*)a->in[IN_POOLW]) + ((size_t)l * W + gc) * 128; const float* ps = ((const float*)a->in[IN_POOLS]) + l * W + g * 128;
        const float* wb = ((const float*)a->in[IN_WBR]) + ((size_t)l * 4 * W + g * 128) * D + d;
        float s = 0.f;
        for (int e = 0; e < 128; ++e) s += pw[e] * ps[e] * wb[(size_t)e * D];
        ((bf16_t*)(ws + WS_WB + l * SZ_DD))[(size_t)d * D + gc] = f2bf(s);
    }
}
__device__ __forceinline__ void phase_wabs(const Frame& F) {
    const KArgs a = F.ka; unsigned char* ws = F.ws_();
    for (int l = 0; l < DEPTH; ++l) { float m = 0.f; const float* w = ((const float*)a->in[IN_WIN]) + (size_t)l * D * PROJ_W;
        for (size_t i = (size_t)F.wg * NTHR + F.tid; i < (size_t)D * (NBR / 4); i += (size_t)F.nwg * NTHR) { const int c4 = (int)(i % (NBR / 4)), k = (int)(i / (NBR / 4)); const int col = c4 * 4 < 4096 ? c4 * 4 : c4 * 4 + 8;
            const f32x4 v = *(const f32x4*)(w + (size_t)k * PROJ_W + col); m = fmaxf(m, fmaxf(fmaxf(fabsf(v[0]), fabsf(v[1])), fmaxf(fabsf(v[2]), fabsf(v[3])))); }
        m = wave_max(m);
        if (F.lane == 0) __hip_atomic_fetch_max((unsigned*)(ws + WS_CTL) + CW_WABS + l, __float_as_uint(m), __ATOMIC_RELAXED, __HIP_MEMORY_SCOPE_AGENT); }
}
__device__ __forceinline__ void phase_prologue(const Frame& F) {
    const KArgs a = F.ka;
    unsigned char* ws = F.ws_();
    xpose_range(F, 0, 0, TK_WINA + TK_WINB, F.wg, F.nwg);
    const size_t gtid = (size_t)F.wg * NTHR + F.tid, gn = (size_t)F.nwg * NTHR;
    for (size_t i = gtid; i < (size_t)DEPTH * 8 * D; i += gn) { const int k = (int)(i % D), c = (int)((i / D) % 8), l = (int)(i / (8 * D));
        ((float*)(ws + WS_WIF))[i] = ((const float*)a->in[IN_WIN])[(size_t)l * D * PROJ_W + (size_t)k * PROJ_W + 4096 + c]; }
    for (size_t i = gtid; i < (size_t)DEPTH * NE * D; i += gn) { const int k = (int)(i % D), e = (int)((i / D) % NE), l = (int)(i / ((size_t)NE * D));
        const float w = ((const float*)a->in[IN_RW])[((size_t)l * D + k) * NE + e]; const bf16_t hi = f2bf(w); const bf16_t lo = f2bf(w - bf2f(hi));
        bf16_t* o = (bf16_t*)(ws + WS_RWT) + (size_t)l * 2 * NE * D; o[(size_t)e * D + k] = hi; o[(size_t)(NE + e) * D + k] = lo; }
    for (size_t i = gtid; i < (size_t)SEQ * 64; i += gn) { const int f = (int)(i & 63), s = (int)(i >> 6);
        const float inv = powf(10000.0f, -(float)f / 64.0f); const float ang = (float)s * inv;
        ((float*)(ws + WS_ROPE))[i] = cosf(ang); ((float*)(ws + WS_ROPE))[(size_t)SEQ * 64 + i] = sinf(ang); }
    for (int row = F.wg * 8 + F.wave; row < T; row += F.nwg * 8) { float v[32]; const float* xr = ((const float*)a->in[IN_X]) + (size_t)row * D;
#pragma unroll
        for (int j = 0; j < 4; ++j) { const f32x4 p = *(const f32x4*)(xr + j * 512 + F.lane * 8), q = *(const f32x4*)(xr + j * 512 + F.lane * 8 + 4); v[j * 8] = p[0]; v[j * 8 + 1] = p[1]; v[j * 8 + 2] = p[2]; v[j * 8 + 3] = p[3]; v[j * 8 + 4] = q[0]; v[j * 8 + 5] = q[1]; v[j * 8 + 6] = q[2]; v[j * 8 + 7] = q[3]; }
        st_row32((bf16_t*)(ws + WS_XB) + (size_t)row * D, F.lane, v); st_row32_fp8(ws + WS_XB8 + (size_t)row * D, F.lane, v); st_row32_i8(ws + WS_XQ8 + (size_t)row * D, (float*)(ws + WS_XSC) + row, F.lane, v); }
    for (size_t i = gtid; i < (size_t)TM * D / 4; i += gn) { const f32x4 v = ((const f32x4*)((const float*)a->in[IN_MEM]))[i]; st_bf16x4((bf16_t*)(ws + WS_MEMB) + i * 4, v); }
    __syncthreads();
}
__device__ __forceinline__ void prologue_deferred(const Frame& F, int rank, int nranks) {
    xpose_range(F, 0, TK_WINA + TK_WINB, TK_LAYER, rank, nranks);
    xpose_range(F, 1, 0, TK_LAYER, rank, nranks);
    pool_fold(F, 0, rank, nranks); pool_fold(F, 1, rank, nranks);
    __syncthreads();
}

__device__ __forceinline__ void unpack8(u32x4 w, float (&f)[8]) {
#pragma unroll
    for (int j = 0; j < 4; ++j) { f[2 * j] = __uint_as_float(w[j] << 16); f[2 * j + 1] = __uint_as_float(w[j] & 0xffff0000u); } }
__device__ __forceinline__ u32x4 pack8f(const float (&f)[8]) { u32x4 w;
#pragma unroll
    for (int j = 0; j < 4; ++j) w[j] = pack2(f[2 * j], f[2 * j + 1]); return w; }
template <int WIN> __device__ __forceinline__ void pool_block(const bf16_t* pu, bf16_t* out, int s0) {
    float sum[8];
#pragma unroll
    for (int e = 0; e < 8; ++e) sum[e] = 0.f;
    u32x4 hist[WIN - 1 + 8];
#pragma unroll
    for (int j = 0; j < WIN - 1 + 8; ++j) { const int ds = j - (WIN - 1); hist[j] = (s0 + ds >= 0) ? *(const u32x4*)(pu + (ptrdiff_t)ds * NBR) : (u32x4){0u, 0u, 0u, 0u}; }
#pragma unroll
    for (int j = 0; j < WIN - 1; ++j) { float f[8]; unpack8(hist[j], f);
#pragma unroll
        for (int e = 0; e < 8; ++e) sum[e] += f[e]; }
#pragma unroll
    for (int i = 0; i < 8; ++i) { float f[8]; unpack8(hist[WIN - 1 + i], f); const int cnt = (s0 + i + 1 < WIN) ? s0 + i + 1 : WIN; const float rc = 1.0f / (float)cnt; float o[8];
#pragma unroll
        for (int e = 0; e < 8; ++e) { sum[e] += f[e]; o[e] = sum[e] * rc - f[e]; }
        *(u32x4*)(out + (size_t)i * D) = pack8f(o);
        float fo[8]; unpack8(hist[i], fo);
#pragma unroll
        for (int e = 0; e < 8; ++e) sum[e] -= fo[e]; }
}
template <bool WITH_D = true> __device__ __forceinline__ void phase_mix1v2(const Frame& F, int l, const bf16_t* xcur) {
    const KArgs a = F.ka;
    unsigned char* ws = F.ws_();
    LAS float* dots = (LAS float*)(F.lds + 65536);
    LAS float* wl = (LAS float*)F.lds;
    const float* wif = (const float*)(ws + WS_WIF) + (size_t)l * 8 * D;
    const float* gb = ((const float*)a->in[IN_GATEB]) + l * 8;
    float* cumf = (float*)(ws + WS_CUMF); float* ipre = (float*)(ws + WS_IPRE); float* summ = (float*)(ws + WS_SUMM); float* av = (float*)(ws + WS_AV); float* pm = (float*)(ws + WS_PM);
    if (F.wg < BATCH * NCH) { for (int i = F.tid; i < 8 * D / 4; i += NTHR) *(LAS f32x4*)(wl + i * 4) = *(const f32x4*)(wif + i * 4); __syncthreads(); }
    for (int item = F.wg; item < BATCH * NCH; item += F.nwg) {
        const int b = item / NCH, c = item % NCH; const int t0 = b * SEQ + c * CH;
        for (int i = 0; i < 8; i += 2) {
            const int tok = F.wave * 8 + i; const bf16_t* xr = xcur + (size_t)(t0 + tok) * D;
            float d0[8], d1[8];
#pragma unroll
            for (int q = 0; q < 8; ++q) { d0[q] = 0.f; d1[q] = 0.f; }
#pragma unroll 1
            for (int j = 0; j < 4; ++j) { float x0[8], x1[8]; unpack8(*(const u32x4*)(xr + j * 512 + F.lane * 8), x0); unpack8(*(const u32x4*)(xr + D + j * 512 + F.lane * 8), x1);
#pragma unroll
                for (int q = 0; q < 8; ++q) { const f32x4 wa = *(const LAS f32x4*)(wl + q * D + j * 512 + F.lane * 8), wb = *(const LAS f32x4*)(wl + q * D + j * 512 + F.lane * 8 + 4);
#pragma unroll
                    for (int e = 0; e < 4; ++e) { d0[q] += x0[e] * wa[e] + x0[4 + e] * wb[e]; d1[q] += x1[e] * wa[e] + x1[4 + e] * wb[e]; } } }
#pragma unroll
            for (int q = 0; q < 8; ++q) { const float s0 = wave_sum(d0[q]), s1 = wave_sum(d1[q]); if (F.lane == 0) { dots[tok * 8 + q] = s0; dots[(tok + 1) * 8 + q] = s1; } }
        }
        __syncthreads();
        if (F.wave < NH) {
            const int h = F.wave, s = F.lane; const float ip = dots[s * 8 + h] + gb[h], fp = dots[s * 8 + 4 + h] + gb[4 + h];
            const float lf = fminf(fp, 0.f) - log1pf(__expf(-fabsf(fp)));
            float cs = lf;
#pragma unroll
            for (int o = 1; o < 64; o <<= 1) { const float n = __shfl_up(cs, o); if (s >= o) cs += n; }
            const float ftot = __shfl(cs, 63); const float aa = ip - cs;
            float px = aa;
#pragma unroll
            for (int o = 1; o < 64; o <<= 1) { const float n = __shfl_up(px, o); if (s >= o) px = fmaxf(px, n); }
            const float gm = ftot + __shfl(px, 63);
            const size_t o = (size_t)(b * NH + h) * SEQ + c * CH + s; cumf[o] = cs; ipre[o] = ip; av[o] = aa; pm[o] = px;
            if (s == 0) { summ[((size_t)(b * NH + h) * NCH + c) * 2] = ftot; summ[((size_t)(b * NH + h) * NCH + c) * 2 + 1] = gm; }
        }
        __syncthreads();
    }
    bf16_t* proj = (bf16_t*)(ws + WS_PROJ); bf16_t* br = (bf16_t*)(ws + WS_BR);
    for (int it = F.wg * 8 + F.wave; it < (T / 32) * 4; it += F.nwg * 8) {
        const int grp = it & 3, tbq = it >> 2; const int tb = tbq * 4 + (F.lane >> 4), co = grp * 16 + (F.lane & 15);
        const int t0 = tb * 8, s0 = t0 % SEQ; const bf16_t* pu = proj + (size_t)t0 * NBR + PC_U + co * 8; bf16_t* out = br + (size_t)t0 * D + co * 8;
        if (grp == 0) pool_block<2>(pu, out, s0); else if (grp == 1) pool_block<4>(pu, out, s0); else if (grp == 2) pool_block<8>(pu, out, s0); else pool_block<16>(pu, out, s0);
    }
    { const float* cw = ((const float*)a->in[IN_CONVW]) + (size_t)l * 3 * W;
      for (size_t it = (size_t)F.wg * NTHR + F.tid; it < (size_t)(T / 8) * 64; it += (size_t)F.nwg * NTHR) {
        const int co = (int)(it & 63), tb = (int)(it >> 6), t0 = tb * 8, s0 = t0 % SEQ;
        const bf16_t* pr = proj + (size_t)t0 * NBR + co * 8;
        float w0[8], w1[8], w2[8];
#pragma unroll
        for (int e = 0; e < 8; ++e) { w0[e] = cw[co * 8 + e]; w1[e] = cw[W + co * 8 + e]; w2[e] = cw[2 * W + co * 8 + e]; }
        float z1[8], z2[8];
#pragma unroll
        for (int e = 0; e < 8; ++e) { z1[e] = 0.f; z2[e] = 0.f; }
        if (s0 >= 2) { float c_[8], h_[8]; unpack8(*(const u32x4*)(pr + PC_CC - 2 * NBR), c_); unpack8(*(const u32x4*)(pr + PC_CH - 2 * NBR), h_);
#pragma unroll
            for (int e = 0; e < 8; ++e) z2[e] = c_[e] * h_[e]; }
        if (s0 >= 1) { float c_[8], h_[8]; unpack8(*(const u32x4*)(pr + PC_CC - NBR), c_); unpack8(*(const u32x4*)(pr + PC_CH - NBR), h_);
#pragma unroll
            for (int e = 0; e < 8; ++e) z1[e] = c_[e] * h_[e]; }
#pragma unroll
        for (int i = 0; i < 8; ++i) { float c_[8], h_[8], b_[8], o[8]; unpack8(*(const u32x4*)(pr + PC_CC + (size_t)i * NBR), c_); unpack8(*(const u32x4*)(pr + PC_CH + (size_t)i * NBR), h_); unpack8(*(const u32x4*)(pr + PC_CB + (size_t)i * NBR), b_);
#pragma unroll
            for (int e = 0; e < 8; ++e) { const float z0 = c_[e] * h_[e]; o[e] = b_[e] * (w0[e] * z0 + w1[e] * z1[e] + w2[e] * z2[e]); z2[e] = z1[e]; z1[e] = z0; }
            *(u32x4*)(br + (size_t)(t0 + i) * D + W + co * 8) = pack8f(o); }
      } }
    if constexpr (WITH_D) { const float* ropec = (const float*)(ws + WS_ROPE); const float* ropes = ropec + (size_t)SEQ * 64;
      for (size_t it = (size_t)F.wg * NTHR + F.tid; it < (size_t)T * 64; it += (size_t)F.nwg * NTHR) {
        const int oc = (int)(it & 7), hh = (int)((it >> 3) & 3), isk = (int)((it >> 5) & 1), t = (int)(it >> 6), s = t % SEQ;
        bf16_t* p = proj + (size_t)t * NBR + (isk ? PC_RK : PC_RQ) + hh * HD + oc * 8;
        float x1[8], x2[8], o1[8], o2[8]; unpack8(*(const u32x4*)p, x1); unpack8(*(const u32x4*)(p + 64), x2);
#pragma unroll
        for (int e = 0; e < 8; ++e) { const float cs = ropec[(size_t)s * 64 + oc * 8 + e], sn = ropes[(size_t)s * 64 + oc * 8 + e]; o1[e] = x1[e] * cs - x2[e] * sn; o2[e] = x1[e] * sn + x2[e] * cs; }
        *(u32x4*)p = pack8f(o1); *(u32x4*)(p + 64) = pack8f(o2);
      } }
}

__device__ __forceinline__ float ret_gamma_log2(int h) { return log2f(1.0f - exp2f(-5.0f - (float)h)); }

__device__ __forceinline__ void phase_scan_mfma(const Frame& F) {
    unsigned char* ws = F.ws_();
    constexpr int KS2 = 144, WS2 = 48;
    LAS bf16_t* Kb = (LAS bf16_t*)F.lds;
    LAS bf16_t* Wb = Kb + 2 * 64 * KS2;
    LAS float* mS = (LAS float*)(Wb + 2 * 64 * WS2);
    LAS float* fT = mS + 80;
    const bf16_t* proj = (const bf16_t*)(ws + WS_PROJ);
    const float* av = (const float*)(ws + WS_AV); const float* summ = (const float*)(ws + WS_SUMM);
    const int lane = F.lane, g = lane >> 4, li = lane & 15, w = F.wave, tid = F.tid;
    for (int item = F.wg; item < 2 * NBH * 8; item += F.nwg) {
        const int type = item >> 7, bh = (item >> 3) & 15, vs = item & 7, b = bh >> 2, h = bh & 3;
        if (tid == 0) { float m = 0.f; mS[0] = 0.f; for (int c = 0; c < NCH; ++c) { m = fmaxf(summ[((size_t)bh * NCH + c) * 2] + m, summ[((size_t)bh * NCH + c) * 2 + 1]); mS[c + 1] = m; }
            if (type == 0 && vs == 0) { float* ms = (float*)(ws + WS_MSEQ) + bh * 80; for (int c = 0; c <= NCH; ++c) ms[c] = mS[c]; } }
        if (tid >= 64 && tid < 128) fT[tid - 64] = summ[((size_t)bh * NCH + (tid - 64)) * 2];
        __syncthreads();
        const float lg2 = ret_gamma_log2(h);
        const int kcol = (type == 0 ? PC_MK : PC_RK) + h * HD, vcol = (type == 0 ? PC_MV : PC_RV) + h * HD + vs * 16;
        bf16_t* cst = (bf16_t*)(ws + WS_CST) + ((size_t)(type * NBH + bh) * NCH) * HD * HD;
        float* nsv = (float*)(ws + WS_NST) + (size_t)bh * NCH * HD;
        const int krow = tid >> 3, koct = tid & 7, vrow = (tid >> 1) & 63, vhalf = tid & 1;
        const bf16_t* kbase = proj + (size_t)(b * SEQ + krow) * NBR + kcol + koct * 8;
        const bf16_t* vbase = proj + (size_t)(b * SEQ + vrow) * NBR + vcol + vhalf * 8;
        const float* abase = av + (size_t)bh * SEQ + vrow;
        u32x4 kr[2][2], vr[2]; float ar[2];
#define SCAN_LOAD(c, sl) do { const size_t _o = (size_t)(c) * CH * NBR; kr[sl][0] = *(const u32x4*)(kbase + _o); kr[sl][1] = *(const u32x4*)(kbase + _o + 64); \
        if (tid < 128) { vr[sl] = *(const u32x4*)(vbase + _o); ar[sl] = (type == 0) ? abase[(c) * CH] : 0.f; } } while (0)
#define SCAN_WRITE(c, sl, bf) do { LAS bf16_t* _k = Kb + (bf) * 64 * KS2 + krow * KS2 + koct * 8; *(LAS u32x4*)_k = kr[sl][0]; *(LAS u32x4*)(_k + 64) = kr[sl][1]; \
        if (tid < 128) { const float _w = (type == 0) ? __expf(ar[sl] + fT[c] - mS[(c) + 1]) : exp2f((float)(63 - vrow) * lg2); float _f[8]; unpack8(vr[sl], _f); \
            _Pragma("unroll") for (int _e = 0; _e < 8; ++_e) _f[_e] *= _w; LAS bf16_t* _p = Wb + (bf) * 64 * WS2 + vrow * WS2; *(LAS u32x4*)(_p + vhalf * 8) = pack8f(_f); \
            u32x4 _x = {0u, 0u, 0u, 0u}; if (vhalf == 0) _x[0] = (unsigned)f2bf(_w); *(LAS u32x4*)(_p + 16 + vhalf * 8) = _x; } } while (0)
        f32x4 st = {0.f, 0.f, 0.f, 0.f}, na = {0.f, 0.f, 0.f, 0.f};
#define SCAN_BODY(c, bf) do { { u32x2 _pw; _pw.x = pack2(st[0], st[1]); _pw.y = pack2(st[2], st[3]); *(u32x2*)(cst + (size_t)(c) * HD * HD + (size_t)(vs * 16 + li) * HD + 16 * w + 4 * g) = _pw; } \
        if (type == 0 && vs == 0 && li == 0) *(f32x4*)(nsv + (c) * HD + 16 * w + 4 * g) = na; \
        const float _d = (type == 0) ? __expf(fT[c] + mS[c] - mS[(c) + 1]) : exp2f(64.0f * lg2); st *= _d; na *= _d; \
        _Pragma("unroll") for (int _u = 0; _u < 2; ++_u) { const LAS bf16_t* _kp = Kb + (bf) * 64 * KS2 + (32 * _u + 8 * g + (li >> 2)) * KS2 + 16 * w + 4 * (li & 3); \
            const LAS bf16_t* _wp = Wb + (bf) * 64 * WS2 + (32 * _u + 8 * g + (li >> 2)) * WS2 + 4 * (li & 3); \
            const bf16x8 _A = cat4(lds_tr(_kp), lds_tr(_kp + 4 * KS2)); const bf16x8 _B = cat4(lds_tr(_wp), lds_tr(_wp + 4 * WS2)); \
            st = __builtin_amdgcn_mfma_f32_16x16x32_bf16(_A, _B, st, 0, 0, 0); \
            if (type == 0) { const bf16x8 _B2 = cat4(lds_tr(_wp + 16), lds_tr(_wp + 4 * WS2 + 16)); na = __builtin_amdgcn_mfma_f32_16x16x32_bf16(_A, _B2, na, 0, 0, 0); } } } while (0)
        SCAN_LOAD(0, 0); SCAN_WRITE(0, 0, 0); SCAN_LOAD(1, 1); SCAN_LOAD(2, 0);
        __syncthreads();
        for (int c = 0; c < NCH; c += 2) {
            SCAN_BODY(c, 0);
            SCAN_WRITE(c + 1, 1, 1);
            if (c + 3 < NCH) SCAN_LOAD(c + 3, 1);
            __syncthreads();
            SCAN_BODY(c + 1, 1);
            if (c + 2 < NCH) { SCAN_WRITE(c + 2, 0, 0); }
            if (c + 4 < NCH) SCAN_LOAD(c + 4, 0);
            __syncthreads();
        }
#undef SCAN_LOAD
#undef SCAN_WRITE
#undef SCAN_BODY
    }
}

__device__ __forceinline__ void phase_chunk_mfma(const Frame& F, int l) {
    const KArgs a = F.ka; unsigned char* ws = F.ws_();
    constexpr int QS = 136, VS = 144, PS = 72;
    LAS bf16_t* Qs = (LAS bf16_t*)F.lds; LAS bf16_t* Ks = Qs + 64 * QS; LAS bf16_t* Vs = Ks + 64 * QS; LAS bf16_t* Ps = Vs + 64 * VS;
    LAS float* rv = (LAS float*)(Ps + 64 * PS);
    LAS float* hp = rv + 256;
    const bf16_t* proj = (const bf16_t*)(ws + WS_PROJ); bf16_t* br = (bf16_t*)(ws + WS_BR);
    const float* cumf = (const float*)(ws + WS_CUMF); const float* av = (const float*)(ws + WS_AV); const float* pm = (const float*)(ws + WS_PM); const float* mseq = (const float*)(ws + WS_MSEQ);
    const int lane = F.lane, g = lane >> 4, li = lane & 15, w = F.wave;
    bf16x8 ones;
#pragma unroll
    for (int j = 0; j < 8; ++j) ones[j] = (short)0x3F80;
    u32x4 pq[2], pk[2], pvv[2]; float prv[4] = {0.f, 0.f, 0.f, 0.f};
#define CH_LOAD(it) do { const int _ty = (it) / (NBH * NCH), _bh = ((it) / NCH) % NBH, _c = (it) % NCH, _h = _bh & 3; const int _t0 = (_bh >> 2) * SEQ + _c * CH; \
        const bf16_t* _pr = proj + (size_t)(_t0 + (F.tid >> 3)) * NBR + (F.tid & 7) * 8 + _h * HD; \
        pq[0] = *(const u32x4*)(_pr + (_ty == 0 ? PC_MQ : PC_RQ)); pq[1] = *(const u32x4*)(_pr + (_ty == 0 ? PC_MQ : PC_RQ) + 64); \
        pk[0] = *(const u32x4*)(_pr + (_ty == 0 ? PC_MK : PC_RK)); pk[1] = *(const u32x4*)(_pr + (_ty == 0 ? PC_MK : PC_RK) + 64); \
        pvv[0] = *(const u32x4*)(_pr + (_ty == 0 ? PC_MV : PC_RV)); pvv[1] = *(const u32x4*)(_pr + (_ty == 0 ? PC_MV : PC_RV) + 64); \
        if (_ty == 0 && F.tid < 64) { const size_t _go = (size_t)_bh * SEQ + _c * CH + F.tid; prv[0] = av[_go]; prv[1] = pm[_go]; prv[2] = cumf[_go]; prv[3] = mseq[_bh * 80 + _c]; } } while (0)
    if (F.wg < 2 * NBH * NCH) CH_LOAD(F.wg);
    for (int item = F.wg; item < 2 * NBH * NCH; item += F.nwg) {
        const int type = item / (NBH * NCH), bh = (item / NCH) % NBH, c = item % NCH, b = bh >> 2, h = bh & 3;
        const int t0 = b * SEQ + c * CH; const size_t go = (size_t)bh * SEQ + c * CH;
        const float lg2 = ret_gamma_log2(h);
        const int vc = h * HD + 16 * w + 4 * g;
        u32x2 gate[4]; bf16x8 cfr[4]; f32x4 nr[4][2];
        const f32x4 nw4 = *(const f32x4*)((type == 0 ? ((const float*)a->in[IN_MNORM]) : ((const float*)a->in[IN_RNORM])) + l * W + vc);
#pragma unroll
        for (int tt = 0; tt < 4; ++tt) gate[tt] = *(const u32x2*)(proj + (size_t)(t0 + 16 * tt + li) * NBR + (type == 0 ? PC_MO : PC_RG) + vc);
        if (c > 0) { const bf16_t* cst = (const bf16_t*)(ws + WS_CST) + ((size_t)(type * NBH + bh) * NCH + c) * HD * HD; const float* nsv = (const float*)(ws + WS_NST) + ((size_t)bh * NCH + c) * HD;
#pragma unroll
            for (int kk = 0; kk < 4; ++kk) { cfr[kk] = *(const bf16x8*)(cst + (size_t)(16 * w + li) * HD + kk * 32 + g * 8);
                if (type == 0) { nr[kk][0] = *(const f32x4*)(nsv + kk * 32 + g * 8); nr[kk][1] = *(const f32x4*)(nsv + kk * 32 + g * 8 + 4); } } }
        { const int row = F.tid >> 3, oct = F.tid & 7;
          *(LAS u32x4*)(Qs + row * QS + oct * 8) = pq[0]; *(LAS u32x4*)(Qs + row * QS + 64 + oct * 8) = pq[1];
          *(LAS u32x4*)(Ks + row * QS + oct * 8) = pk[0]; *(LAS u32x4*)(Ks + row * QS + 64 + oct * 8) = pk[1];
          *(LAS u32x4*)(Vs + row * VS + oct * 8) = pvv[0]; *(LAS u32x4*)(Vs + row * VS + 64 + oct * 8) = pvv[1]; }
        if (F.tid < 64) { const int t = F.tid;
            if (type == 0) { const float mp = prv[3]; const float bt = fmaxf(mp, prv[1]); rv[t] = prv[0]; rv[64 + t] = bt; rv[128 + t] = __expf(mp - bt); rv[192 + t] = __expf(-prv[2] - bt); }
            else rv[128 + t] = exp2f((float)(t + 1) * lg2); }
        if (item + F.nwg < 2 * NBH * NCH) CH_LOAD(item + F.nwg);
        __syncthreads();
        { const int tt = w >> 1, t = 16 * tt + li;
#pragma unroll
          for (int sti = 0; sti < 2; ++sti) { const int st = (w & 1) * 2 + sti; f32x4 acc = {0.f, 0.f, 0.f, 0.f};
            if (st <= tt) {
#pragma unroll
                for (int kk = 0; kk < 4; ++kk) { const bf16x8 kf = *(const LAS bf16x8*)(Ks + (16 * st + li) * QS + kk * 32 + g * 8), qf = *(const LAS bf16x8*)(Qs + (16 * tt + li) * QS + kk * 32 + g * 8);
                    acc = __builtin_amdgcn_mfma_f32_16x16x32_bf16(kf, qf, acc, 0, 0, 0); }
#pragma unroll
                for (int r = 0; r < 4; ++r) { const int sx = 16 * st + 4 * g + r; float wgt;
                    if (type == 0) wgt = __expf(rv[sx] - rv[64 + t]); else wgt = exp2f((float)(t - sx) * lg2);
                    acc[r] = (sx <= t) ? acc[r] * wgt : 0.f; } }
            u32x2 pw; pw.x = pack2(acc[0], acc[1]); pw.y = pack2(acc[2], acc[3]); *(LAS u32x2*)(Ps + t * PS + 16 * st + 4 * g) = pw; } }
        __syncthreads();
        f32x4 pv[4], qc[4], dn[4], qn[4];
#pragma unroll
        for (int tt = 0; tt < 4; ++tt) { pv[tt] = (f32x4){0.f, 0.f, 0.f, 0.f}; qc[tt] = pv[tt]; dn[tt] = pv[tt]; qn[tt] = pv[tt]; }
#pragma unroll
        for (int u = 0; u < 2; ++u) {
            const bf16x8 vf = cat4(lds_tr(Vs + (32 * u + 8 * g + (li >> 2)) * VS + 16 * w + 4 * (li & 3)), lds_tr(Vs + (32 * u + 8 * g + 4 + (li >> 2)) * VS + 16 * w + 4 * (li & 3)));
#pragma unroll
            for (int tt = 0; tt < 4; ++tt) { const bf16x8 pf = *(const LAS bf16x8*)(Ps + (16 * tt + li) * PS + 32 * u + 8 * g);
                pv[tt] = __builtin_amdgcn_mfma_f32_16x16x32_bf16(vf, pf, pv[tt], 0, 0, 0);
                if (type == 0) dn[tt] = __builtin_amdgcn_mfma_f32_16x16x32_bf16(ones, pf, dn[tt], 0, 0, 0); } }
        if (c > 0) {
#pragma unroll
            for (int kk = 0; kk < 4; ++kk) { const bf16x8 cf = cfr[kk];
                bf16x8 nf = ones;
                if (type == 0) nf = pack8(nr[kk][0], nr[kk][1]);
#pragma unroll
                for (int tt = 0; tt < 4; ++tt) { const bf16x8 qf = *(const LAS bf16x8*)(Qs + (16 * tt + li) * QS + kk * 32 + g * 8);
                    qc[tt] = __builtin_amdgcn_mfma_f32_16x16x32_bf16(cf, qf, qc[tt], 0, 0, 0);
                    if (type == 0) qn[tt] = __builtin_amdgcn_mfma_f32_16x16x32_bf16(nf, qf, qn[tt], 0, 0, 0); } } }
#pragma unroll
        for (int tt = 0; tt < 4; ++tt) { const int t = 16 * tt + li; const float inter = rv[128 + t]; f32x4 hv;
            if (type == 0) { const float den = inter * qn[tt][0] + dn[tt][0]; const float rd = 1.0f / fmaxf(fabsf(den), rv[192 + t]);
                const u32x2 ow = gate[tt];
                const float o0 = __uint_as_float(ow.x << 16), o1 = __uint_as_float(ow.x & 0xffff0000u), o2 = __uint_as_float(ow.y << 16), o3 = __uint_as_float(ow.y & 0xffff0000u);
                hv[0] = sigmoidf_(o0) * (inter * qc[tt][0] + pv[tt][0]) * rd; hv[1] = sigmoidf_(o1) * (inter * qc[tt][1] + pv[tt][1]) * rd;
                hv[2] = sigmoidf_(o2) * (inter * qc[tt][2] + pv[tt][2]) * rd; hv[3] = sigmoidf_(o3) * (inter * qc[tt][3] + pv[tt][3]) * rd; }
            else hv = pv[tt] + qc[tt] * inter;
            pv[tt] = hv;
            float s1 = (hv[0] + hv[1]) + (hv[2] + hv[3]), s2 = (hv[0] * hv[0] + hv[1] * hv[1]) + (hv[2] * hv[2] + hv[3] * hv[3]);
            s1 += __shfl_xor(s1, 16); s1 += __shfl_xor(s1, 32); s2 += __shfl_xor(s2, 16); s2 += __shfl_xor(s2, 32);
            if (g == 0) { hp[(w * 64 + t) * 2] = s1; hp[(w * 64 + t) * 2 + 1] = s2; } }
        __syncthreads();
#pragma unroll
        for (int tt = 0; tt < 4; ++tt) { const int t = 16 * tt + li; float s1 = 0.f, s2 = 0.f;
#pragma unroll
            for (int ww = 0; ww < 8; ++ww) { const f32x2 p2 = *(const LAS f32x2*)(hp + (ww * 64 + t) * 2); s1 += p2.x; s2 += p2.y; }
            const float mu = s1 * (1.0f / 128.0f), var = fmaxf(s2 * (1.0f / 128.0f) - mu * mu, 0.f), rstd = rsqrtf(var + LN_EPS);
            f32x4 y = (pv[tt] - mu) * rstd * nw4;
            if (type == 1) { const u32x2 gw = gate[tt];
                const float g0 = __uint_as_float(gw.x << 16), g1 = __uint_as_float(gw.x & 0xffff0000u), g2 = __uint_as_float(gw.y << 16), g3 = __uint_as_float(gw.y & 0xffff0000u);
                y[0] *= g0 * sigmoidf_(g0); y[1] *= g1 * sigmoidf_(g1); y[2] *= g2 * sigmoidf_(g2); y[3] *= g3 * sigmoidf_(g3); }
            st_bf16x4(br + (size_t)(t0 + t) * D + (type == 0 ? 1024 : 1536) + vc, y); }
        __syncthreads();
    }
#undef CH_LOAD
}

__device__ __forceinline__ void ln_row(float (&v)[32], const float* lw, const float* lb, int lane) {
    float s = 0.f;
#pragma unroll
    for (int j = 0; j < 32; ++j) s += v[j];
    const float mu = wave_sum(s) * (1.0f / D); float q = 0.f;
#pragma unroll
    for (int j = 0; j < 32; ++j) { const float d = v[j] - mu; q += d * d; }
    const float rstd = rsqrtf(wave_sum(q) * (1.0f / D) + LN_EPS);
#pragma unroll
    for (int j = 0; j < 4; ++j)
#pragma unroll
        for (int h = 0; h < 2; ++h) { const f32x4 w4 = *(const f32x4*)(lw + j * 512 + lane * 8 + h * 4), b4 = *(const f32x4*)(lb + j * 512 + lane * 8 + h * 4);
#pragma unroll
            for (int e = 0; e < 4; ++e) v[j * 8 + h * 4 + e] = (v[j * 8 + h * 4 + e] - mu) * rstd * w4[e] + b4[e]; }
}
__device__ __forceinline__ void phase_ln(const Frame& F, const bf16_t* y, const float* lw, const float* lb, bf16_t* xb) {
    for (int row = F.wg * 8 + F.wave; row < T; row += F.nwg * 8) {
        float v[32]; ld_row32(y + (size_t)row * D, F.lane, v);
        ln_row(v, lw, lb, F.lane);
        st_row32(xb + (size_t)row * D, F.lane, v);
    }
}
__device__ __forceinline__ void split8(f32x4 a, f32x4 b, bf16x8& hi, bf16x8& lo) {
    union { u32x4 u; bf16x8 h; } H, L;
#pragma unroll
    for (int j = 0; j < 2; ++j) { const bf16_t h0 = f2bf(a[2 * j]), h1 = f2bf(a[2 * j + 1]); H.u[j] = (unsigned)h0 | ((unsigned)h1 << 16); L.u[j] = pack2(a[2 * j] - bf2f(h0), a[2 * j + 1] - bf2f(h1)); }
#pragma unroll
    for (int j = 0; j < 2; ++j) { const bf16_t h0 = f2bf(b[2 * j]), h1 = f2bf(b[2 * j + 1]); H.u[2 + j] = (unsigned)h0 | ((unsigned)h1 << 16); L.u[2 + j] = pack2(b[2 * j] - bf2f(h0), b[2 * j + 1] - bf2f(h1)); }
    hi = H.h; lo = L.h; }
__device__ __forceinline__ void phase_ln_router(const Frame& F, int l, const bf16_t* y, bf16_t* xb) {
    const KArgs a = F.ka;
    unsigned char* ws = F.ws_();
    constexpr int XS = D + 8, RB = 32;
    LAS bf16_t* xsh = (LAS bf16_t*)F.lds;
    LAS float* part = (LAS float*)F.lds;
    LAS int* lcnt = (LAS int*)(xsh + RB * XS);
    if (F.tid < 128) lcnt[F.tid] = 0;
    __syncthreads();
    const float* lw = ((const float*)a->in[IN_LNW]) + ((size_t)l * 3 + 1) * D; const float* lb = ((const float*)a->in[IN_LNB]) + ((size_t)l * 3 + 1) * D;
    const bf16_t* rwt = (const bf16_t*)(ws + WS_RWT) + (size_t)l * 2 * NE * D; const float* rb = ((const float*)a->in[IN_RB]) + l * NE;
    unsigned* counts = (unsigned*)(ws + WS_CTL) + CW_COUNTS + l * 64;
    int* eid = (int*)(ws + WS_EID); float* ew = (float*)(ws + WS_EW); int* epos = (int*)(ws + WS_EPOS);
    const int lane = F.lane, g = lane >> 4, li = lane & 15, nt = F.wave & 3, kh = F.wave >> 2;
    for (int blk = F.wg; blk < T / RB; blk += F.nwg) {
        for (int rr = 0; rr < 4; ++rr) {
            const int lr = F.wave * 4 + rr, row = blk * RB + lr;
            float v[32]; ld_row32(y + (size_t)row * D, F.lane, v);
            ln_row(v, lw, lb, F.lane);
            st_row32(xb + (size_t)row * D, F.lane, v); st_row32_fp8(ws + WS_XB8 + (size_t)row * D, F.lane, v);
#pragma unroll
            for (int j = 0; j < 4; ++j) { u32x4 hi;
#pragma unroll
                for (int e2 = 0; e2 < 4; ++e2) hi[e2] = pack2(v[j * 8 + 2 * e2], v[j * 8 + 2 * e2 + 1]);
                *(LAS u32x4*)(xsh + lr * XS + j * 512 + F.lane * 8) = hi; }
        }
        __syncthreads();
        f32x4 acc[2] = {{0.f, 0.f, 0.f, 0.f}, {0.f, 0.f, 0.f, 0.f}};
        { const bf16_t* wh = rwt + (size_t)(16 * nt + li) * D + kh * 1024 + g * 8; const bf16_t* wl = wh + (size_t)NE * D;
          const LAS bf16_t* xr = xsh + li * XS + kh * 1024 + g * 8;
#pragma unroll 8
          for (int ks = 0; ks < 32; ++ks) { const bf16x8 bh = *(const bf16x8*)(wh + ks * 32), bl = *(const bf16x8*)(wl + ks * 32);
#pragma unroll
              for (int mt = 0; mt < 2; ++mt) { const bf16x8 xh = *(const LAS bf16x8*)(xr + mt * 16 * XS + ks * 32);
                  acc[mt] = __builtin_amdgcn_mfma_f32_16x16x32_bf16(xh, bh, acc[mt], 0, 0, 0); acc[mt] = __builtin_amdgcn_mfma_f32_16x16x32_bf16(xh, bl, acc[mt], 0, 0, 0); } } }
        __syncthreads();
#pragma unroll
        for (int mt = 0; mt < 2; ++mt)
#pragma unroll
            for (int r = 0; r < 4; ++r) part[(kh * RB + 16 * mt + 4 * g + r) * 64 + 16 * nt + li] = acc[mt][r];
        __syncthreads();
        const int e = F.lane;
        const float bias = rb[e];
        for (int rr = 0; rr < 4; ++rr) {
            const int lr = F.wave * 4 + rr, row = blk * RB + lr;
            const float sc = sigmoidf_(part[lr * 64 + e] + part[(RB + lr) * 64 + e]), bs = sc + bias;
            float m1 = bs; m1 = fmaxf(m1, __shfl_xor(m1, 1)); m1 = fmaxf(m1, __shfl_xor(m1, 2)); m1 = fmaxf(m1, __shfl_xor(m1, 4));
            const unsigned long long eq = __ballot(bs == m1); const int gq = e >> 3; const unsigned gm = (unsigned)(eq >> (gq * 8)) & 0xffu; const int first = gq * 8 + __builtin_ctz(gm);
            float m2 = (e == first) ? -INFINITY : bs; m2 = fmaxf(m2, __shfl_xor(m2, 1)); m2 = fmaxf(m2, __shfl_xor(m2, 2)); m2 = fmaxf(m2, __shfl_xor(m2, 4));
            const float gs = m1 + m2;
            int grank = 0;
#pragma unroll
            for (int g2 = 0; g2 < 8; ++g2) { const float o = __shfl(gs, g2 * 8); grank += (o > gs || (o == gs && g2 < gq)) ? 1 : 0; }
            const bool gsel = grank < 4;
            const float val = gsel ? bs : -INFINITY;
            int rank = 0;
            for (int e2 = 0; e2 < 64; ++e2) { const float o = __shfl(val, e2); rank += (o > val || (o == val && e2 < e)) ? 1 : 0; }
            const bool sel = gsel && rank < TOPK;
            const float wsum = wave_sum(sel ? sc : 0.f);
            const unsigned long long sm = __ballot(sel);
            if (sel) { const int k = __builtin_popcountll(sm & ((1ull << e) - 1ull));
                const int pos = __hip_atomic_fetch_add((int*)lcnt + e, 1, __ATOMIC_RELAXED, __HIP_MEMORY_SCOPE_WORKGROUP);
                eid[(size_t)row * 8 + k] = e; ew[(size_t)row * 8 + k] = sc / wsum * ROUTE_SCALE; epos[(size_t)row * 8 + k] = pos; }
        }
        __syncthreads();
    }
    if (F.tid < 64) { const int n = lcnt[F.tid]; lcnt[64 + F.tid] = n > 0 ? (int)__hip_atomic_fetch_add(counts + F.tid, (unsigned)n, __ATOMIC_RELAXED, __HIP_MEMORY_SCOPE_AGENT) : 0; }
    asm volatile("s_waitcnt vmcnt(0)" ::: "memory");
    __syncthreads();
    for (int blk = F.wg; blk < T / RB; blk += F.nwg) { if (F.tid < RB * 8) { const size_t i = (size_t)blk * (RB * 8) + F.tid; epos[i] += lcnt[64 + eid[i]]; } }
    __syncthreads();
}
__device__ __forceinline__ void build_pstart(const Frame& F, int l, LAS int* pst) {
    const unsigned* counts = (const unsigned*)(F.ws_() + WS_CTL) + CW_COUNTS + l * 64;
    if (F.tid < 64) {
        const int c = (int)__hip_atomic_load(counts + F.tid, __ATOMIC_RELAXED, __HIP_MEMORY_SCOPE_AGENT); const int pc = (c + 255) & ~255; int inc = pc;
#pragma unroll
        for (int o = 1; o < 64; o <<= 1) { const int n = __shfl_up(inc, o); if (F.tid >= o) inc += n; }
        pst[F.tid] = inc - pc; if (F.tid == 63) { pst[NE] = inc; pst[NE + 1] = inc + T; } }
    __syncthreads();
    { LAS unsigned char* texp = (LAS unsigned char*)(pst + 68);
      for (int rt = F.tid; rt < (pst[NE + 1] >> 8); rt += NTHR) { int e = 0; while (e < NE && pst[e + 1] <= rt * 256) ++e; texp[rt] = (unsigned char)e; } }
    __syncthreads();
}
__device__ __forceinline__ void phase_slots(const Frame& F, int l) {
    unsigned char* ws = F.ws_();
    LAS int* pst = (LAS int*)F.lds;
    build_pstart(F, l, pst);
    const unsigned* counts = (const unsigned*)(ws + WS_CTL) + CW_COUNTS + l * 64;
    const int* eid = (const int*)(ws + WS_EID); const float* ew = (const float*)(ws + WS_EW); const int* epos = (const int*)(ws + WS_EPOS);
    int* slotof = (int*)(ws + WS_SLOTOF); int* tok = (int*)(ws + WS_TOK); float* wsl = (float*)(ws + WS_WSL);
    const size_t gtid = (size_t)F.wg * NTHR + F.tid, gn = (size_t)F.nwg * NTHR;
    for (size_t i = gtid; i < (size_t)T * 8; i += gn) { const int e = eid[i]; const int slot = pst[e] + epos[i]; slotof[i] = slot; tok[slot] = (int)(i >> 3); wsl[slot] = ew[i]; }
    for (size_t i = gtid; i < (size_t)NE * 256; i += gn) { const int e = (int)(i >> 8), r = (int)(i & 255); const int c = (int)counts[e]; const int slot = pst[e] + c + r; if (slot < pst[e + 1]) { tok[slot] = 0; wsl[slot] = 0.f; } }
    for (size_t i = gtid; i < (size_t)T; i += gn) { tok[pst[NE] + i] = (int)i; wsl[pst[NE] + i] = 1.0f; }
    __syncthreads();
}
__device__ __forceinline__ void phase_combine_ln(const Frame& F, int l, bf16_t* xb, float* out) {
    const KArgs a = F.ka;
    unsigned char* ws = F.ws_();
    LAS int* pst = (LAS int*)F.lds;
    build_pstart(F, l, pst);
    const int sh0 = pst[NE];
    const int* slotof = (const int*)(ws + WS_SLOTOF); const unsigned char* yb = ws + WS_YB;
    const float* lw = ((const float*)a->in[IN_LNW]) + ((size_t)l * 3 + 2) * D; const float* lb = ((const float*)a->in[IN_LNB]) + ((size_t)l * 3 + 2) * D;
    for (int row = F.wg * 8 + F.wave; row < T; row += F.nwg * 8) {
        float v[32]; ld_row32(xb + (size_t)row * D, F.lane, v);
#pragma unroll
        for (int j = 0; j < 32; ++j) v[j] *= ALPHA;
        float ys[32];
#pragma unroll
        for (int j = 0; j < 32; ++j) ys[j] = 0.f;
#pragma unroll 3
        for (int k = 0; k < 9; ++k) { const int slot = k < 8 ? slotof[(size_t)row * 8 + k] : sh0 + row; const unsigned char* yr = yb + (size_t)slot * D;
#pragma unroll
            for (int j = 0; j < 4; ++j) { const u32x2 w = *(const u32x2*)(yr + j * 512 + F.lane * 8);
                const f32x2 p0 = __builtin_amdgcn_cvt_pk_f32_fp8((int)w.x, false), p1 = __builtin_amdgcn_cvt_pk_f32_fp8((int)w.x, true), p2 = __builtin_amdgcn_cvt_pk_f32_fp8((int)w.y, false), p3 = __builtin_amdgcn_cvt_pk_f32_fp8((int)w.y, true);
                ys[j * 8] += p0.x; ys[j * 8 + 1] += p0.y; ys[j * 8 + 2] += p1.x; ys[j * 8 + 3] += p1.y; ys[j * 8 + 4] += p2.x; ys[j * 8 + 5] += p2.y; ys[j * 8 + 6] += p3.x; ys[j * 8 + 7] += p3.y; } }
#pragma unroll
        for (int j = 0; j < 32; ++j) v[j] += ys[j] * (1.0f / Y8_SCALE);
        ln_row(v, lw, lb, F.lane);
        if (out) {
#pragma unroll
            for (int j = 0; j < 4; ++j) { *(f32x4*)(out + (size_t)row * D + j * 512 + F.lane * 8) = (f32x4){v[j * 8], v[j * 8 + 1], v[j * 8 + 2], v[j * 8 + 3]}; *(f32x4*)(out + (size_t)row * D + j * 512 + F.lane * 8 + 4) = (f32x4){v[j * 8 + 4], v[j * 8 + 5], v[j * 8 + 6], v[j * 8 + 7]}; }
        } else { st_row32(xb + (size_t)row * D, F.lane, v); st_row32_fp8(ws + WS_XB8 + (size_t)row * D, F.lane, v); st_row32_i8(ws + WS_XQ8 + (size_t)row * D, (float*)(ws + WS_XSC) + row, F.lane, v); }
    }
    __syncthreads();
}

__device__ __forceinline__ void phase_attn_mfma(const Frame& F, int l) {
    unsigned char* ws = F.ws_();
    constexpr int KS = 136, VS = 144;
    LAS bf16_t* Ks = (LAS bf16_t*)F.lds; LAS bf16_t* Vs = Ks + 256 * KS;
    const bf16_t* q = (const bf16_t*)(ws + WS_Q); const bf16_t* km = (const bf16_t*)(ws + WS_KM) + (size_t)l * TM * W; const bf16_t* vm = (const bf16_t*)(ws + WS_VM) + (size_t)l * TM * W;
    bf16_t* o = (bf16_t*)(ws + WS_O);
    const int nunit = (T / 128) * 4, upw = (nunit + F.nwg - 1) / F.nwg;
    const int lane = F.lane, g = lane >> 4, li = lane & 15;
    int loaded = -1;
    const int u_end = (F.wg + 1) * upw < nunit ? (F.wg + 1) * upw : nunit;
    for (int u = F.wg * upw; u < u_end; ++u) {
        const int bh = u >> 5, blk = u & 31, b = bh >> 2, hh = bh & 3;
        if (bh != loaded) {
            __syncthreads();
            const int m = F.tid >> 1, half = F.tid & 1;
            const bf16_t* kr = km + (size_t)(b * MEM + m) * W + hh * HD + half * 64; const bf16_t* vr = vm + (size_t)(b * MEM + m) * W + hh * HD + half * 64;
#pragma unroll
            for (int j = 0; j < 8; ++j) { *(LAS u32x4*)(Ks + m * KS + half * 64 + j * 8) = *(const u32x4*)(kr + j * 8); *(LAS u32x4*)(Vs + m * VS + half * 64 + j * 8) = *(const u32x4*)(vr + j * 8); }
            __syncthreads(); loaded = bh;
        }
        const int t0 = b * SEQ + blk * 128 + F.wave * 16;
        bf16x8 qf[4];
#pragma unroll
        for (int kk = 0; kk < 4; ++kk) qf[kk] = *(const bf16x8*)(q + (size_t)(t0 + li) * W + hh * HD + kk * 32 + g * 8);
        f32x4 sacc[16];
#pragma unroll
        for (int tt = 0; tt < 16; ++tt) { f32x4 acc = {0.f, 0.f, 0.f, 0.f};
#pragma unroll
            for (int kk = 0; kk < 4; ++kk) { const bf16x8 kf = *(const LAS bf16x8*)(Ks + (16 * tt + li) * KS + kk * 32 + g * 8); acc = __builtin_amdgcn_mfma_f32_16x16x32_bf16(kf, qf[kk], acc, 0, 0, 0); }
            sacc[tt] = acc; }
        float mx = -INFINITY;
#pragma unroll
        for (int tt = 0; tt < 16; ++tt) mx = fmaxf(mx, fmaxf(fmaxf(sacc[tt][0], sacc[tt][1]), fmaxf(sacc[tt][2], sacc[tt][3])));
        mx = fmaxf(mx, __shfl_xor(mx, 16)); mx = fmaxf(mx, __shfl_xor(mx, 32));
        const float c2 = 0.08838834764831845f * 1.4426950408889634f; float sum = 0.f;
#pragma unroll
        for (int tt = 0; tt < 16; ++tt)
#pragma unroll
            for (int r = 0; r < 4; ++r) { const float p = exp2f((sacc[tt][r] - mx) * c2); sacc[tt][r] = p; sum += p; }
        sum += __shfl_xor(sum, 16); sum += __shfl_xor(sum, 32);
        const float rs = 1.0f / sum;
        bf16x8 pk[8];
#pragma unroll
        for (int u8 = 0; u8 < 8; ++u8) pk[u8] = pack8(sacc[2 * u8], sacc[2 * u8 + 1]);
#pragma unroll
        for (int dvt = 0; dvt < 8; ++dvt) { f32x4 acc = {0.f, 0.f, 0.f, 0.f};
#pragma unroll
            for (int u8 = 0; u8 < 8; ++u8) { const s16x4 a0 = lds_tr(Vs + (32 * u8 + 4 * g + (li >> 2)) * VS + dvt * 16 + 4 * (li & 3)); const s16x4 a1 = lds_tr(Vs + (32 * u8 + 16 + 4 * g + (li >> 2)) * VS + dvt * 16 + 4 * (li & 3));
                acc = __builtin_amdgcn_mfma_f32_16x16x32_bf16(cat4(a0, a1), pk[u8], acc, 0, 0, 0); }
            st_bf16x4(o + (size_t)(t0 + li) * W + hh * HD + dvt * 16 + 4 * g, acc * rs); }
    }
    __syncthreads();
}

template <class Epi>
__device__ __forceinline__ void gemm_dense_mfma(const Frame& F, const bf16_t* A, const bf16_t* Bt, int M, int N, int K, const Epi& E) {
    DenseSched S; S.A = A; S.Bt = Bt; S.K = K; S.nM = M / 256; S.nN = N / 256; S.nwg = S.nM * S.nN; S.G = F.nwg; S.c = F.wg; S.i0 = 0; S.i1 = 1 << 30; S.pnoff = 0;
    gemm_phase_mfma(F, K, S, E);
}
constexpr int NPL = 15, NPHASE = 1 + DEPTH * NPL;
#ifndef NCONV
#define NCONV 40
#endif
#if MK_PER_PHASE
#define IN(k) (lo <= (k) && (k) < hi)
#define SEAM(k) do { if (IN((k) + 1)) { XcdBarrier b2_ = bar; asm volatile("" : "+s"(b2_.bar)); asm volatile("" : "+s"(b2_.x)); xcd_barrier(b2_); } } while (0)
#else
#define IN(k) true
#define SEAM(k) do { if ((k) + 1 < NPHASE) for (int rb_ = 0; rb_ < ((PROBE_DBL & 4096) ? 3 : 1); ++rb_) { XcdBarrier b2_ = bar; asm volatile("" : "+s"(b2_.bar)); asm volatile("" : "+s"(b2_.x)); xcd_barrier(b2_); } } while (0)
#endif
template <int l> __device__ __forceinline__ void run_layer(const Frame& F0, const XcdBarrier& bar, int lo, int hi) {
    const int pb = 1 + l * NPL;
    if (IN(pb + 0)) { const Frame F = fresh(F0); unsigned char* ws = F.ws_();
        EpiProj E{(bf16_t*)(ws + WS_PROJ), (bf16_t*)(ws + WS_GATES)};
        { DenseSched S; S.A = (const bf16_t*)(ws + WS_XQ8); S.Bt = (const bf16_t*)(ws + WS_WINQ + l * SZ_WINQ); S.K = D / 2; S.nM = T / 256; S.nN = NBR / 256; S.nwg = S.nM * S.nN; S.G = F.nwg; S.c = F.wg; S.i0 = 0; S.i1 = 1 << 30; S.pnoff = 0;
          const float wsc = __uint_as_float(((const unsigned*)(ws + WS_CTL))[CW_WABS + l]) * (1.0f / 127.0f);
          gemm_phase_mfma<EpiProj, DenseSched, 2>(F, D, S, E, wsc, (const float*)(ws + WS_XSC)); }
        { const Frame F2 = fresh(F0); unsigned char* ws2 = F2.ws_(); EpiProj E2{(bf16_t*)(ws2 + WS_PROJ), (bf16_t*)(ws2 + WS_GATES)};
          DenseSched S; S.A = (const bf16_t*)(ws2 + WS_XB8); S.Bt = (const bf16_t*)(ws2 + WS_WIN8 + l * SZ_WIN8 + (size_t)NBR * D); S.K = D / 2; S.nM = T / 256; S.nN = (NPROJ - NBR) / 256; S.nwg = S.nM * S.nN; S.G = F2.nwg; S.c = F2.wg; S.i0 = 0; S.i1 = 1 << 30; S.pnoff = NBR / 256;
          gemm_phase_mfma<EpiProj, DenseSched, 1>(F2, D, S, E2, 1.0f / (X8_SCALE * W8_SCALE)); if (PROBE_DBL & 64) gemm_phase_mfma<EpiProj, DenseSched, 1>(F2, D, S, E2, 1.0f / (X8_SCALE * W8_SCALE)); }
        SEAM(pb + 0); }
    if (IN(pb + 1)) { const Frame F = fresh(F0); phase_mix1v2(F, l, (const bf16_t*)(F.ws_() + WS_XB)); if (PROBE_DBL & 8192) { const Frame G = fresh(F0); phase_mix1v2<false>(G, l, (const bf16_t*)(G.ws_() + WS_XB)); } SEAM(pb + 1); }
    if (IN(pb + 2)) { const Frame F = fresh(F0); phase_scan_mfma(F); if (PROBE_DBL & 2) { const Frame G = fresh(F0); phase_scan_mfma(G); } SEAM(pb + 2); }
    if (IN(pb + 3)) { const Frame F = fresh(F0); phase_chunk_mfma(F, l); if (PROBE_DBL & 4) { const Frame G = fresh(F0); phase_chunk_mfma(G, l); } SEAM(pb + 3); }
    if (IN(pb + 4)) { const Frame F = fresh(F0); unsigned char* ws = F.ws_();
        EpiBranch E{ws + WS_GATES, (bf16_t*)(ws + WS_MRG)}; gemm_dense_mfma(F, (const bf16_t*)(ws + WS_BR), (const bf16_t*)(ws + WS_WB + l * SZ_DD), T, D, D, E); if (PROBE_DBL & 128) gemm_dense_mfma(F, (const bf16_t*)(ws + WS_BR), (const bf16_t*)(ws + WS_WB + l * SZ_DD), T, D, D, E); SEAM(pb + 4); }
    if (IN(pb + 5)) { const Frame F = fresh(F0); unsigned char* ws = F.ws_();
        EpiResid E{(const bf16_t*)(ws + WS_XB), (bf16_t*)(ws + WS_Y)}; gemm_dense_mfma(F, (const bf16_t*)(ws + WS_MRG), (const bf16_t*)(ws + WS_WOUT + l * SZ_DD), T, D, D, E); if (PROBE_DBL & 256) gemm_dense_mfma(F, (const bf16_t*)(ws + WS_MRG), (const bf16_t*)(ws + WS_WOUT + l * SZ_DD), T, D, D, E); SEAM(pb + 5); }
    if (IN(pb + 6)) { const Frame F = fresh(F0); unsigned char* ws = F.ws_();
        phase_ln(F, (const bf16_t*)(ws + WS_Y), ((const float*)F.ka->in[IN_LNW]) + (size_t)l * 3 * D, ((const float*)F.ka->in[IN_LNB]) + (size_t)l * 3 * D, (bf16_t*)(ws + WS_XB)); if (PROBE_DBL & 1) { const Frame G = fresh(F0); unsigned char* wsg = G.ws_(); phase_ln(G, (const bf16_t*)(wsg + WS_Y), ((const float*)G.ka->in[IN_LNW]) + (size_t)l * 3 * D, ((const float*)G.ka->in[IN_LNB]) + (size_t)l * 3 * D, (bf16_t*)(wsg + WS_XB)); } SEAM(pb + 6); }
    if (IN(pb + 7)) { const Frame F = fresh(F0);
        EpiQKV E{}; QkvSched S; S.ws = F.ws_(); S.l = l; S.G = F.nwg; S.c = F.wg; gemm_phase_mfma(F, D, S, E); if (PROBE_DBL & 1024) gemm_phase_mfma(F, D, S, E); SEAM(pb + 7); }
    if (IN(pb + 8)) { const Frame F = fresh(F0); phase_attn_mfma(F, l); if (PROBE_DBL & 8) { const Frame G = fresh(F0); phase_attn_mfma(G, l); } SEAM(pb + 8); }
    if (IN(pb + 9)) { const Frame F = fresh(F0); unsigned char* ws = F.ws_();
        EpiResid E{(const bf16_t*)(ws + WS_XB), (bf16_t*)(ws + WS_Y)}; gemm_dense_mfma(F, (const bf16_t*)(ws + WS_O), (const bf16_t*)(ws + WS_WO + l * SZ_WQ), T, D, W, E); if (PROBE_DBL & 2048) gemm_dense_mfma(F, (const bf16_t*)(ws + WS_O), (const bf16_t*)(ws + WS_WO + l * SZ_WQ), T, D, W, E); SEAM(pb + 9); }
    if (IN(pb + 10)) { const Frame F = fresh(F0); unsigned char* ws = F.ws_(); phase_ln_router(F, l, (const bf16_t*)(ws + WS_Y), (bf16_t*)(ws + WS_XB)); SEAM(pb + 10); }
    if (IN(pb + 11)) { const Frame F = fresh(F0); phase_slots(F, l); if (PROBE_DBL & 16) { const Frame G = fresh(F0); phase_slots(G, l); } SEAM(pb + 11); }
    if (IN(pb + 12)) { const Frame F = fresh(F0); unsigned char* ws = F.ws_();
        LAS int* pst = (LAS int*)(F.lds + LDS_BYTES - 1024); build_pstart(F, l, pst);
        const int nrt = pst[NE + 1] >> 8; EpiSwiglu E{(const float*)(ws + WS_WSL), ws + WS_HB};
        MoeSched<4, true> S; S.ws = ws; S.pst = pst; S.l = l; S.G = F.nwg; S.c = F.wg; S.nunits = nrt * 4; gemm_phase_mfma<EpiSwiglu, MoeSched<4, true>, 1>(F, D, S, E, 1.0f / (X8_SCALE * W8_SCALE)); SEAM(pb + 12); }
    if (IN(pb + 13)) { const Frame F = fresh(F0); unsigned char* ws = F.ws_();
        LAS int* pst = (LAS int*)(F.lds + LDS_BYTES - 1024); build_pstart(F, l, pst);
        const int nrt = pst[NE + 1] >> 8; EpiDown E{ws + WS_YB};
        MoeSched<8, false> S; S.ws = ws; S.pst = pst; S.l = l; S.G = F.nwg; S.c = F.wg; S.nunits = nrt * 8; gemm_phase_mfma<EpiDown, MoeSched<8, false>, 1>(F, ED, S, E, Y8_SCALE / (H8_SCALE * W8_SCALE)); SEAM(pb + 13); }
    if (IN(pb + 14)) { const Frame F = fresh(F0); phase_combine_ln(F, l, (bf16_t*)(F.ws_() + WS_XB), l == DEPTH - 1 ? ((float*)F.ka->out) : (float*)nullptr); if ((PROBE_DBL & 16384) && l == DEPTH - 1) { const Frame G = fresh(F0); phase_combine_ln(G, l, (bf16_t*)(G.ws_() + WS_XB), ((float*)G.ka->out)); } SEAM(pb + 14); }
}

__global__ void __launch_bounds__(NTHR, 2) fwd(Args args_unused) {
    extern __shared__ __attribute__((aligned(16))) unsigned char lds_raw[];
    Frame F0; F0.lds = (LAS unsigned char*)lds_raw; F0.tid = threadIdx.x; F0.lane = F0.tid & 63; F0.wave = __builtin_amdgcn_readfirstlane(F0.tid >> 6); F0.wg = blockIdx.x; F0.nwg = gridDim.x;
    F0.ka = (KArgs)__builtin_amdgcn_kernarg_segment_ptr(); F0.wsg = F0.ka->ws;
    volatile LAS unsigned* xbw = (volatile LAS unsigned*)(F0.lds + LDS_BYTES - 16);
    if (F0.tid == 0) { xbw[0] = 0u; xbw[1] = 0u; }
    __syncthreads();
    XcdBarrier bar; bar.bar = (unsigned*)(F0.ws_() + WS_CTL); bar.x = 0; bar.st = xbw;
#if MK_PER_PHASE
    const int lo = F0.ka->ph_lo, hi = F0.ka->ph_hi;
    if (hi - lo > 1) bar = xcd_barrier_post((unsigned*)(F0.ws_() + WS_CTL), xbw);
#else
    const int lo = 0, hi = NPHASE;
    bar = xcd_barrier_post((unsigned*)(F0.ws_() + WS_CTL), xbw);
#endif
    if (IN(0)) { { const Frame F = fresh(F0); phase_wabs(F); } { XcdBarrier b2_ = bar; asm volatile("" : "+s"(b2_.bar)); asm volatile("" : "+s"(b2_.x)); xcd_barrier(b2_); }
        const Frame F = fresh(F0); phase_prologue(F); { const Frame G = fresh(F0); prologue_deferred(G, G.wg, G.nwg); } SEAM(0); }
    run_layer<0>(F0, bar, lo, hi);
    run_layer<1>(F0, bar, lo, hi);
#undef IN
#undef SEAM
}

extern "C" void kernel_launch(void* const* d_in, const int* in_sizes, int n_in, void* d_out, int out_size, void* d_ws, size_t ws_size, hipStream_t stream) {
    static int grid = 0;
    if (grid == 0) {
        if (n_in != 23 || ws_size < WS_END) { fprintf(stderr, "kernel_launch: unexpected inputs (n_in %d, ws %zu < %zu)\n", n_in, ws_size, (size_t)WS_END); grid = -1; return; }
        int dev = 0, cus = 0, per_cu = 0;
        if (hipGetDevice(&dev) != hipSuccess || hipDeviceGetAttribute(&cus, hipDeviceAttributeMultiprocessorCount, dev) != hipSuccess) { grid = -1; return; }
        if (hipFuncSetAttribute((const void*)fwd, hipFuncAttributeMaxDynamicSharedMemorySize, LDS_BYTES) != hipSuccess) { fprintf(stderr, "kernel_launch: hipFuncSetAttribute failed\n"); grid = -1; return; }
        if (hipOccupancyMaxActiveBlocksPerMultiprocessor(&per_cu, (const void*)fwd, NTHR, LDS_BYTES) != hipSuccess || per_cu < 1) { fprintf(stderr, "kernel_launch: occupancy query says %d\n", per_cu); }
        (void)hipGetLastError();
        grid = cus;
    }
    if (grid < 0) return;
    (void)hipMemsetAsync((char*)d_ws + WS_CTL, 0, CTL_BYTES, stream);
    Args a{};
    for (int i = 0; i < 23; ++i) a.in[i] = (const float*)d_in[i];
    a.out = (float*)d_out; a.ws = (unsigned char*)d_ws;
#if MK_PER_PHASE
    for (int p = 0; p < NPHASE; ++p) { a.ph_lo = p; a.ph_hi = p + 1; hipLaunchKernelGGL(fwd, dim3(grid), dim3(NTHR), LDS_BYTES, stream, a); }
#else
    a.ph_lo = 0; a.ph_hi = NPHASE;
    hipLaunchKernelGGL(fwd, dim3(grid), dim3(NTHR), LDS_BYTES, stream, a);
#endif
    const hipError_t le = hipPeekAtLastError();
    if (le != hipSuccess) fprintf(stderr, "kernel_launch: launch failed: %s\n", hipGetErrorName(le));
}
```

```cpp
#include <hip/hip_runtime.h>
#include <cstdio>
#include <cstdint>

#ifndef PROBE_DBL
#define PROBE_DBL 0
#endif
#ifndef MK_PER_PHASE
#define MK_PER_PHASE 0
#endif

typedef unsigned short bf16_t;
typedef float f32x4 __attribute__((ext_vector_type(4)));
typedef float f32x2 __attribute__((ext_vector_type(2)));
typedef unsigned u32x4 __attribute__((ext_vector_type(4)));
typedef unsigned u32x2 __attribute__((ext_vector_type(2)));
#define LAS __attribute__((address_space(3)))

constexpr int BATCH = 4, SEQ = 4096, T = BATCH * SEQ, D = 2048, DEPTH = 2;
constexpr int W = 512, NH = 4, HD = 128, CH = 64, NCH = SEQ / CH, NBH = BATCH * NH;
constexpr int PROJ_W = 14344, NBR = 6144, NPROJ = 14336;
constexpr int MEM = 256, TM = BATCH * MEM;
constexpr int NE = 64, NEX = 65, TOPK = 8, ED = 512;
constexpr int NSLOT = 164096;
constexpr float LN_EPS = 1e-5f, ALPHA = 1.41421356237f, ROUTE_SCALE = 2.5f;
constexpr int NTHR = 512;

constexpr int PC_U = 0, PC_CH = 512, PC_CB = 1024, PC_CC = 1536, PC_MQ = 2048, PC_MK = 2560, PC_MV = 3072, PC_MO = 3584, PC_RQ = 4096, PC_RK = 4608, PC_RV = 5120, PC_RG = 5632;

constexpr size_t al256(size_t x) { return (x + 255) & ~(size_t)255; }
constexpr size_t WS_CTL = 0;
constexpr size_t CTL_BYTES = 65536;
constexpr int CW_COUNTS = 8192;
constexpr size_t WS_WIN = WS_CTL + CTL_BYTES;
constexpr size_t SZ_WIN = (size_t)NPROJ * D * 2;
constexpr size_t WS_WIF = WS_WIN + DEPTH * SZ_WIN;
constexpr size_t SZ_WIF = 8 * D * 4;
constexpr size_t WS_WB = WS_WIF + DEPTH * SZ_WIF;
constexpr size_t SZ_DD = (size_t)D * D * 2;
constexpr size_t WS_WOUT = WS_WB + DEPTH * SZ_DD;
constexpr size_t WS_WQ = WS_WOUT + DEPTH * SZ_DD;
constexpr size_t SZ_WQ = (size_t)W * D * 2;
constexpr size_t WS_WK = WS_WQ + DEPTH * SZ_WQ;
constexpr size_t WS_WV = WS_WK + DEPTH * SZ_WQ;
constexpr size_t WS_WO = WS_WV + DEPTH * SZ_WQ;
constexpr size_t WS_WGU = WS_WO + DEPTH * SZ_WQ;
constexpr size_t SZ_WGU1 = (size_t)1024 * D * 2;
constexpr size_t WS_WDN = WS_WGU + (size_t)DEPTH * NEX * SZ_WGU1;
constexpr size_t SZ_WDN1 = (size_t)D * ED * 2;
constexpr size_t WS_ROPE = WS_WDN + (size_t)DEPTH * NEX * SZ_WDN1;
constexpr size_t WS_X = WS_ROPE + (size_t)SEQ * 64 * 4 * 2;
constexpr size_t SZ_TD4 = (size_t)T * D * 4;
constexpr size_t WS_Y = WS_X + SZ_TD4;
constexpr size_t WS_XB = WS_Y + SZ_TD4;
constexpr size_t SZ_TD2 = (size_t)T * D * 2;
constexpr size_t WS_MEMB = WS_XB + SZ_TD2;
constexpr size_t WS_KM = WS_MEMB + (size_t)TM * D * 2;
constexpr size_t WS_VM = WS_KM + (size_t)DEPTH * TM * W * 2;
constexpr size_t WS_PROJ = WS_VM + (size_t)DEPTH * TM * W * 2;
constexpr size_t WS_GATES = WS_PROJ + (size_t)T * NBR * 2;
constexpr size_t WS_CUMF = WS_GATES + (size_t)T * 8192 * 2;
constexpr size_t WS_IPRE = WS_CUMF + (size_t)NBH * SEQ * 4;
constexpr size_t WS_SUMM = WS_IPRE + (size_t)NBH * SEQ * 4;
constexpr size_t WS_CST = WS_SUMM + al256((size_t)NBH * NCH * 2 * 4);
constexpr size_t WS_NST = WS_CST + (size_t)2 * NBH * NCH * HD * HD * 2;
constexpr size_t WS_BR = WS_NST + (size_t)NBH * NCH * HD * 4;
constexpr size_t WS_MRG = WS_BR + SZ_TD2;
constexpr size_t WS_Q = WS_MRG + SZ_TD2;
constexpr size_t WS_O = WS_Q + (size_t)T * W * 2;
constexpr size_t WS_EID = WS_O + (size_t)T * W * 2;
constexpr size_t WS_EW = WS_EID + (size_t)T * 8 * 4;
constexpr size_t WS_EPOS = WS_EW + (size_t)T * 8 * 4;
constexpr size_t WS_SLOTOF = WS_EPOS + (size_t)T * 8 * 4;
constexpr size_t WS_TOK = WS_SLOTOF + (size_t)T * 8 * 4;
constexpr size_t WS_WSL = WS_TOK + al256((size_t)NSLOT * 4);
constexpr size_t WS_HB = WS_WSL + al256((size_t)NSLOT * 4);
constexpr size_t WS_YB = WS_HB + (size_t)NSLOT * ED * 2;
constexpr size_t WS_AV = WS_YB + (size_t)NSLOT * D * 2;
constexpr size_t WS_PM = WS_AV + (size_t)NBH * SEQ * 4;
constexpr size_t WS_MSEQ = WS_PM + (size_t)NBH * SEQ * 4;
constexpr size_t WS_XB8 = WS_MSEQ + al256((size_t)NBH * 80 * 4);
constexpr size_t WS_WGU8 = WS_XB8 + (size_t)T * D;
constexpr size_t SZ_WGU8 = (size_t)1024 * D;
constexpr size_t WS_WIN8 = WS_WGU8 + (size_t)DEPTH * NEX * SZ_WGU8;
constexpr size_t SZ_WIN8 = (size_t)NPROJ * D;
constexpr size_t WS_RWT = WS_WIN8 + DEPTH * SZ_WIN8;
constexpr size_t WS_XQ8 = WS_RWT + (size_t)DEPTH * 2 * NE * D * 2;
constexpr size_t WS_XSC = WS_XQ8 + (size_t)T * D;
constexpr size_t WS_WINQ = WS_XSC + al256((size_t)T * 4);
constexpr size_t SZ_WINQ = (size_t)NBR * D;
constexpr size_t WS_WIFB = WS_WINQ + DEPTH * SZ_WINQ;
constexpr size_t WS_END = WS_WIFB + (size_t)DEPTH * 2 * 16 * D * 2;
constexpr int CW_WABS = 8320;
constexpr float X8_SCALE = 16.0f, W8_SCALE = 256.0f, H8_SCALE = 8.0f, Y8_SCALE = 64.0f;

constexpr int LDS_BYTES = 147456;

__device__ __forceinline__ bf16_t f2bf(float f) { unsigned u = __float_as_uint(f); u += 0x7FFFu + ((u >> 16) & 1u); return (bf16_t)(u >> 16); }
__device__ __forceinline__ float bf2f(bf16_t b) { return __uint_as_float(((unsigned)b) << 16); }
__device__ __forceinline__ unsigned pack2(float lo, float hi) { unsigned r; asm("v_cvt_pk_bf16_f32 %0, %1, %2" : "=v"(r) : "v"(lo), "v"(hi)); return r; }
__device__ __forceinline__ float sigmoidf_(float x) { return __builtin_amdgcn_rcpf(1.0f + __builtin_amdgcn_exp2f(-1.4426950408889634f * x)); }
__device__ __forceinline__ unsigned pack_fp8x4(float a, float b, float c, float d) {
    a = __builtin_amdgcn_fmed3f(a, -448.f, 448.f); b = __builtin_amdgcn_fmed3f(b, -448.f, 448.f); c = __builtin_amdgcn_fmed3f(c, -448.f, 448.f); d = __builtin_amdgcn_fmed3f(d, -448.f, 448.f);
    int w = 0; w = __builtin_amdgcn_cvt_pk_fp8_f32(a, b, w, false); w = __builtin_amdgcn_cvt_pk_fp8_f32(c, d, w, true); return (unsigned)w; }
__device__ __forceinline__ unsigned pack_i8x4(float a, float b, float c, float d) {
    const int ia = (int)__builtin_amdgcn_fmed3f(rintf(a), -127.f, 127.f), ib = (int)__builtin_amdgcn_fmed3f(rintf(b), -127.f, 127.f), ic = (int)__builtin_amdgcn_fmed3f(rintf(c), -127.f, 127.f), id = (int)__builtin_amdgcn_fmed3f(rintf(d), -127.f, 127.f);
    return (unsigned)(ia & 255) | ((unsigned)(ib & 255) << 8) | ((unsigned)(ic & 255) << 16) | ((unsigned)(id & 255) << 24); }
__device__ __forceinline__ unsigned pack_u8x4(float a, float b, float c, float d) {
    return (unsigned)rintf(a) | ((unsigned)rintf(b) << 8) | ((unsigned)rintf(c) << 16) | ((unsigned)rintf(d) << 24); }
__device__ __forceinline__ void un8u(u32x2 w, f32x4& a, f32x4& b) { a[0] = (float)(w.x & 255u); a[1] = (float)((w.x >> 8) & 255u); a[2] = (float)((w.x >> 16) & 255u); a[3] = (float)(w.x >> 24);
    b[0] = (float)(w.y & 255u); b[1] = (float)((w.y >> 8) & 255u); b[2] = (float)((w.y >> 16) & 255u); b[3] = (float)(w.y >> 24); }
__device__ __forceinline__ float wave_sum(float v) { for (int o = 32; o >= 1; o >>= 1) v += __shfl_xor(v, o); return v; }
__device__ __forceinline__ float wave_max(float v) { for (int o = 32; o >= 1; o >>= 1) v = fmaxf(v, __shfl_xor(v, o)); return v; }

#define XB_TMO      128
#define XB_XCNT(j)  (256  + 64 * (j))
#define XB_XSUB(j)  (1280 + 64 * (j))
#define XB_XGEN(j)  (2304 + 64 * (j))
#define XB_TOP      3328
#define XB_TOPGEN   3392
#define XCD_BAR_WORDS 3456
#define XB_SPIN_CAP (1u << 27)
__device__ __forceinline__ unsigned xb_ld(unsigned* p)              { return __hip_atomic_load(p, __ATOMIC_RELAXED, __HIP_MEMORY_SCOPE_AGENT); }
__device__ __forceinline__ unsigned xb_add(unsigned* p, unsigned v) { return __hip_atomic_fetch_add(p, v, __ATOMIC_RELAXED, __HIP_MEMORY_SCOPE_AGENT); }
__device__ __forceinline__ unsigned xb_xcc_id() { return (unsigned)__builtin_amdgcn_s_getreg((3 << 11) | 20) & 0xFu; }
#define XB_SPIN(cond, bar) do { unsigned _sp = 0; while (cond) { __builtin_amdgcn_s_sleep(1); \
    if ((++_sp & 255u) == 0u) { if (xb_ld(&(bar)[XB_TMO])) break; if (_sp > XB_SPIN_CAP) { atomicAdd(&(bar)[XB_TMO], 1u); break; } } } } while (0)
struct XcdBarrier { unsigned* bar; unsigned x; volatile LAS unsigned* st; };
__device__ __forceinline__ XcdBarrier xcd_barrier_post(unsigned* bar, volatile LAS unsigned* st) {
    XcdBarrier b; b.bar = bar; b.x = xb_xcc_id(); b.st = st;
    if (threadIdx.x == 0) (void)xb_add(&bar[XB_XCNT(b.x)], 1u);
    return b;
}
__device__ __forceinline__ void xcd_barrier_complete(unsigned* bar, unsigned x, unsigned& nloc, unsigned& nx) {
    const unsigned G = gridDim.x * gridDim.y * gridDim.z;
    unsigned sum, cnt, mine, sp = 0u;
    for (;;) {
        sum = 0u; cnt = 0u; mine = 0u;
#pragma unroll
        for (unsigned j = 0; j < 16; ++j) { const unsigned c = xb_ld(&bar[XB_XCNT(j)]); sum += c; cnt += (c > 0u) ? 1u : 0u; mine = (j == x) ? c : mine; }
        if (sum == G) break;
        __builtin_amdgcn_s_sleep(1);
        if ((++sp & 255u) == 0u) { if (xb_ld(&bar[XB_TMO])) break; if (sp > XB_SPIN_CAP) { atomicAdd(&bar[XB_TMO], 1u); break; } }
    }
    nloc = mine > 0u ? mine : 1u; nx = cnt > 0u ? cnt : 1u;
}
__device__ __forceinline__ void xcd_barrier(const XcdBarrier& b) {
    asm volatile("s_waitcnt vmcnt(0)" ::: "memory");
    __syncthreads();
    if (threadIdx.x == 0) {
        unsigned* bar = b.bar;
        __builtin_amdgcn_s_waitcnt(0);
        unsigned nloc = b.st[0], nx = b.st[1];
        if (nloc == 0u) { xcd_barrier_complete(bar, b.x, nloc, nx); b.st[0] = nloc; b.st[1] = nx; }
        const unsigned old = xb_add(&bar[XB_XSUB(b.x)], 1u);
        const unsigned gen = old / nloc;
        if (old + 1u == (gen + 1u) * nloc) {
            __builtin_amdgcn_fence(__ATOMIC_RELEASE, "agent");
            asm volatile("s_waitcnt vmcnt(0)" ::: "memory");
            const unsigned og = xb_add(&bar[XB_TOP], 1u);
            const unsigned tg = og / nx;
            if (og + 1u == (tg + 1u) * nx) xb_add(&bar[XB_TOPGEN], 1u);
            else XB_SPIN(xb_ld(&bar[XB_TOPGEN]) == tg, bar);
            __builtin_amdgcn_fence(__ATOMIC_ACQUIRE, "agent");
            xb_add(&bar[XB_XGEN(b.x)], 1u);
            asm volatile("s_waitcnt vmcnt(0)" ::: "memory");
        } else {
            XB_SPIN(xb_ld(&bar[XB_XGEN(b.x)]) == gen, bar);
            __builtin_amdgcn_fence(__ATOMIC_ACQUIRE, "agent");
            asm volatile("s_waitcnt vmcnt(0)" ::: "memory");
        }
    }
    __syncthreads();
}

struct Args { const float* in[23]; float* out; unsigned char* ws; int ph_lo, ph_hi; };
enum { IN_X = 0, IN_MEM, IN_WIN, IN_GATEB, IN_POOLW, IN_POOLS, IN_CONVW, IN_MNORM, IN_RNORM, IN_WBR, IN_WMIX, IN_WQ, IN_WK, IN_WV, IN_WO, IN_RW, IN_RB, IN_WGU, IN_WDN, IN_SGU, IN_SDN, IN_LNW, IN_LNB };

#define GAS __attribute__((address_space(1)))
struct DArgs { const GAS float* in[23]; GAS float* out; GAS unsigned char* ws; int ph_lo, ph_hi; };
typedef const __attribute__((address_space(4))) DArgs* KArgs;
struct Frame {
    LAS unsigned char* lds; int tid, lane, wave, wg, nwg;
    GAS unsigned char* wsg; KArgs ka;
    __device__ __forceinline__ unsigned char* ws_() const { return (unsigned char*)wsg; }
};
__device__ __forceinline__ Frame fresh(const Frame& F) { Frame G = F; asm volatile("" : "+s"(G.wsg)); asm volatile("" : "+s"(G.ka)); asm volatile("" : "+v"(G.tid)); asm volatile("" : "+s"(G.wg));
    G.lane = G.tid & 63; G.wave = __builtin_amdgcn_readfirstlane(G.tid >> 6); return G; }

struct GUnit {
    const bf16_t* Bt;
    const bf16_t* A;
    const int* gather;
    int row0;
    int pn;
    int e;
    bf16_t* dst;
};

__device__ __forceinline__ void un8(u32x4 w, f32x4& a, f32x4& b) { a[0] = __uint_as_float(w[0] << 16); a[1] = __uint_as_float(w[0] & 0xffff0000u); a[2] = __uint_as_float(w[1] << 16); a[3] = __uint_as_float(w[1] & 0xffff0000u);
    b[0] = __uint_as_float(w[2] << 16); b[1] = __uint_as_float(w[2] & 0xffff0000u); b[2] = __uint_as_float(w[3] << 16); b[3] = __uint_as_float(w[3] & 0xffff0000u); }
__device__ __forceinline__ void st_bf16x8(bf16_t* p, f32x4 a, f32x4 b) { u32x4 w; w[0] = pack2(a[0], a[1]); w[1] = pack2(a[2], a[3]); w[2] = pack2(b[0], b[1]); w[3] = pack2(b[2], b[3]); *(u32x4*)p = w; }
__device__ __forceinline__ void st_bf16x4(bf16_t* p, f32x4 v) { u32x2 w; w.x = pack2(v[0], v[1]); w.y = pack2(v[2], v[3]); *(u32x2*)p = w; }
__device__ __forceinline__ void ld_row32(const bf16_t* row, int lane, float (&v)[32]) {
#pragma unroll
    for (int j = 0; j < 4; ++j) { const u32x4 w = *(const u32x4*)(row + j * 512 + lane * 8);
#pragma unroll
        for (int e = 0; e < 4; ++e) { v[j * 8 + 2 * e] = __uint_as_float(w[e] << 16); v[j * 8 + 2 * e + 1] = __uint_as_float(w[e] & 0xffff0000u); } } }
__device__ __forceinline__ void st_row32(bf16_t* row, int lane, const float (&v)[32]) {
#pragma unroll
    for (int j = 0; j < 4; ++j) { u32x4 w;
#pragma unroll
        for (int e = 0; e < 4; ++e) w[e] = pack2(v[j * 8 + 2 * e], v[j * 8 + 2 * e + 1]);
        *(u32x4*)(row + j * 512 + lane * 8) = w; } }
__device__ __forceinline__ void st_row32_i8(unsigned char* row, float* sc, int lane, const float (&v)[32]) {
    float am = 0.f;
#pragma unroll
    for (int j = 0; j < 32; ++j) am = fmaxf(am, fabsf(v[j]));
    am = fmaxf(wave_max(am), 1e-30f); const float q = 127.0f / am;
#pragma unroll
    for (int j = 0; j < 4; ++j) { u32x2 w; w.x = pack_i8x4(v[j * 8] * q, v[j * 8 + 1] * q, v[j * 8 + 2] * q, v[j * 8 + 3] * q); w.y = pack_i8x4(v[j * 8 + 4] * q, v[j * 8 + 5] * q, v[j * 8 + 6] * q, v[j * 8 + 7] * q);
        *(u32x2*)(row + j * 512 + lane * 8) = w; }
    if (lane == 0) *sc = am * (1.0f / 127.0f); }
__device__ __forceinline__ void st_row32_fp8(unsigned char* row, int lane, const float (&v)[32]) {
#pragma unroll
    for (int j = 0; j < 4; ++j) { u32x2 w; w.x = pack_fp8x4(v[j * 8] * X8_SCALE, v[j * 8 + 1] * X8_SCALE, v[j * 8 + 2] * X8_SCALE, v[j * 8 + 3] * X8_SCALE); w.y = pack_fp8x4(v[j * 8 + 4] * X8_SCALE, v[j * 8 + 5] * X8_SCALE, v[j * 8 + 6] * X8_SCALE, v[j * 8 + 7] * X8_SCALE);
        *(u32x2*)(row + j * 512 + lane * 8) = w; } }
struct NoPre { };
struct EpiProj {
    static constexpr bool PAIR_M = false; static constexpr bool SEG = false; typedef NoPre Pre; static constexpr int NST = 8;
    bf16_t* proj; bf16_t* gates;
    static __device__ __forceinline__ float unit_scale(const GUnit& u) { return (u.pn == PC_MK / 256 || u.pn == PC_MK / 256 + 1 || u.pn == PC_RK / 256 || u.pn == PC_RK / 256 + 1) ? 0.08838834764831845f : 1.0f; }
    __device__ __forceinline__ void pre(const GUnit&, int, int, Pre&) const {}
    __device__ __forceinline__ void fin(const GUnit& u, int r, int c, const f32x4 (&a)[2][2], const Pre&) const {
        const int col = u.pn * 256 + c; const size_t row = (size_t)(u.row0 + r);
        if (col < NBR) { st_bf16x8(proj + row * NBR + col, a[0][0], a[0][1]); st_bf16x8(proj + row * NBR + col + 128, a[1][0], a[1][1]); }
        else { f32x4 s[2][2];
#pragma unroll
            for (int h = 0; h < 2; ++h)
#pragma unroll
                for (int n = 0; n < 2; ++n)
#pragma unroll
                    for (int j = 0; j < 4; ++j) s[h][n][j] = __builtin_amdgcn_fmed3f(sigmoidf_(a[h][n][j]) * 255.0f, 1.0f, 255.0f);
            u32x2 w0, w1; w0.x = pack_u8x4(s[0][0][0], s[0][0][1], s[0][0][2], s[0][0][3]); w0.y = pack_u8x4(s[0][1][0], s[0][1][1], s[0][1][2], s[0][1][3]);
            w1.x = pack_u8x4(s[1][0][0], s[1][0][1], s[1][0][2], s[1][0][3]); w1.y = pack_u8x4(s[1][1][0], s[1][1][1], s[1][1][2], s[1][1][3]);
            { const auto rx = __builtin_amdgcn_permlane32_swap(w0.x, w1.x, false, false); w0.x = rx[0]; w1.x = rx[1]; const auto ry = __builtin_amdgcn_permlane32_swap(w0.y, w1.y, false, false); w0.y = ry[0]; w1.y = ry[1]; }
            const bool up = (threadIdx.x & 32u) != 0u; const int gc = col - NBR;
            unsigned char* gp = (unsigned char*)gates + row * 8192 + (up ? gc + 128 - 8 : gc);
            u32x4 w; w[0] = w0.x; w[1] = w0.y; w[2] = w1.x; w[3] = w1.y; *(u32x4*)gp = w; }
    }
};
struct EpiBranch {
    static constexpr bool PAIR_M = false; static constexpr bool SEG = true; static constexpr int NST = 8;
    struct Pre { u32x2 g0, g1; };
    struct SPre { u32x2 a0, a1, b0, b1; };
    const unsigned char* gates; unsigned char* out;
    __device__ __forceinline__ void pre(const GUnit& u, int r, int c, Pre& p) const { const unsigned char* g = gates + (size_t)(u.row0 + r) * 8192 + 3 * 2048 + u.pn * 256 + c; p.g0 = *(const u32x2*)g; p.g1 = *(const u32x2*)(g + 128); }
    __device__ __forceinline__ void fin(const GUnit& u, int r, int c, const f32x4 (&a)[2][2], const Pre& p) const {
        f32x4 x0, x1, y0, y1; un8u(p.g0, x0, x1); un8u(p.g1, y0, y1); const float k = X8_SCALE / 255.0f;
        const f32x4 v00 = a[0][0] * x0 * k, v01 = a[0][1] * x1 * k, v10 = a[1][0] * y0 * k, v11 = a[1][1] * y1 * k;
        u32x2 w0, w1; w0.x = pack_fp8x4(v00[0], v00[1], v00[2], v00[3]); w0.y = pack_fp8x4(v01[0], v01[1], v01[2], v01[3]); w1.x = pack_fp8x4(v10[0], v10[1], v10[2], v10[3]); w1.y = pack_fp8x4(v11[0], v11[1], v11[2], v11[3]);
        { const auto rx = __builtin_amdgcn_permlane32_swap(w0.x, w1.x, false, false); w0.x = rx[0]; w1.x = rx[1]; const auto ry = __builtin_amdgcn_permlane32_swap(w0.y, w1.y, false, false); w0.y = ry[0]; w1.y = ry[1]; }
        const bool up = (threadIdx.x & 32u) != 0u;
        unsigned char* o = out + (size_t)(u.row0 + r) * D + u.pn * 256 + (up ? 128 + c - 8 : c);
        u32x4 w; w[0] = w0.x; w[1] = w0.y; w[2] = w1.x; w[3] = w1.y; *(u32x4*)o = w; }
    __device__ __forceinline__ void seg_pre(const GUnit& u, int r, int c, int s, SPre& p) const { const unsigned char* g = gates + (size_t)(u.row0 + r) * 8192 + s * 2048 + u.pn * 256 + c;
        p.a0 = *(const u32x2*)g; p.a1 = *(const u32x2*)(g + 128); p.b0 = *(const u32x2*)(g + 2048); p.b1 = *(const u32x2*)(g + 2048 + 128); }
    __device__ __forceinline__ void seg_fin(f32x4 (&h0)[2], f32x4 (&h1)[2], const SPre& p) const {
        f32x4 a0, a1, b0, b1; un8u(p.a0, a0, a1); un8u(p.b0, b0, b1);
#pragma unroll
        for (int j = 0; j < 4; ++j) { h0[0][j] *= a0[j] * __builtin_amdgcn_rcpf(b0[j]); h0[1][j] *= a1[j] * __builtin_amdgcn_rcpf(b1[j]); }
        un8u(p.a1, a0, a1); un8u(p.b1, b0, b1);
#pragma unroll
        for (int j = 0; j < 4; ++j) { h1[0][j] *= a0[j] * __builtin_amdgcn_rcpf(b0[j]); h1[1][j] *= a1[j] * __builtin_amdgcn_rcpf(b1[j]); }
    }
};
struct EpiResid {
    static constexpr bool PAIR_M = false; static constexpr bool SEG = false; static constexpr int NST = 16;
    struct Pre { u32x4 x0, x1; };
    const bf16_t* x; bf16_t* y;
    __device__ __forceinline__ void pre(const GUnit& u, int r, int c, Pre& p) const { const bf16_t* xp = x + (size_t)(u.row0 + r) * D + u.pn * 256 + c; p.x0 = *(const u32x4*)xp; p.x1 = *(const u32x4*)(xp + 128); }
    __device__ __forceinline__ void fin(const GUnit& u, int r, int c, const f32x4 (&a)[2][2], const Pre& p) const {
        f32x4 x0, x1, y0, y1; un8(p.x0, x0, x1); un8(p.x1, y0, y1);
        bf16_t* o = y + (size_t)(u.row0 + r) * D + u.pn * 256 + c; st_bf16x8(o, x0 * ALPHA + a[0][0], x1 * ALPHA + a[0][1]); st_bf16x8(o + 128, y0 * ALPHA + a[1][0], y1 * ALPHA + a[1][1]); }
};
struct EpiQKV {
    static constexpr bool PAIR_M = false; static constexpr bool SEG = false; typedef NoPre Pre; int pad_; static constexpr int NST = 16;
    __device__ __forceinline__ void pre(const GUnit&, int, int, Pre&) const {}
    __device__ __forceinline__ void fin(const GUnit& u, int r, int c, const f32x4 (&a)[2][2], const Pre&) const {
        bf16_t* o = u.dst + (size_t)(u.row0 + r) * W + u.pn * 256 + c; st_bf16x8(o, a[0][0], a[0][1]); st_bf16x8(o + 128, a[1][0], a[1][1]); }
};
struct EpiSwiglu {
    static constexpr bool SEG = false; static constexpr bool PAIR_M = true; static constexpr int NST = 4;
    struct Pre { float w; };
    const float* wsl; unsigned char* hb;
    __device__ __forceinline__ void pre(const GUnit& u, int r, int, Pre& p) const { p.w = wsl[u.row0 + r] * H8_SCALE; }
    __device__ __forceinline__ u32x2 act(const f32x4 (&a)[2][2], float w) const { f32x4 o[2];
#pragma unroll
        for (int n = 0; n < 2; ++n)
#pragma unroll
            for (int j = 0; j < 4; ++j) o[n][j] = a[0][n][j] * sigmoidf_(a[0][n][j]) * a[1][n][j] * w;
        u32x2 w8; w8.x = pack_fp8x4(o[0][0], o[0][1], o[0][2], o[0][3]); w8.y = pack_fp8x4(o[1][0], o[1][1], o[1][2], o[1][3]); return w8; }
    __device__ __forceinline__ void fin2(const GUnit& u, int r0, int r1, int c, const f32x4 (&a0)[2][2], const f32x4 (&a1)[2][2], const Pre& p0, const Pre& p1) const {
        u32x2 v0 = act(a0, p0.w), v1 = act(a1, p1.w);
        { const auto rx = __builtin_amdgcn_permlane32_swap(v0.x, v1.x, false, false); v0.x = rx[0]; v1.x = rx[1]; const auto ry = __builtin_amdgcn_permlane32_swap(v0.y, v1.y, false, false); v0.y = ry[0]; v1.y = ry[1]; }
        const bool up = (threadIdx.x & 32u) != 0u;
        unsigned char* o = hb + (size_t)(u.row0 + (up ? r1 : r0)) * ED + u.pn * 128 + (up ? c - 8 : c);
        u32x4 w; w[0] = v0.x; w[1] = v0.y; w[2] = v1.x; w[3] = v1.y; *(u32x4*)o = w; }
    __device__ __forceinline__ void fin(const GUnit&, int, int, const f32x4 (&)[2][2], const Pre&) const {}
};
struct EpiDown {
    static constexpr bool PAIR_M = false; static constexpr bool SEG = false; typedef NoPre Pre; static constexpr int NST = 8;
    unsigned char* yb;
    __device__ __forceinline__ void pre(const GUnit&, int, int, Pre&) const {}
    __device__ __forceinline__ void fin(const GUnit& u, int r, int c, const f32x4 (&a)[2][2], const Pre&) const {
        u32x2 w0, w1; w0.x = pack_fp8x4(a[0][0][0], a[0][0][1], a[0][0][2], a[0][0][3]); w0.y = pack_fp8x4(a[0][1][0], a[0][1][1], a[0][1][2], a[0][1][3]);
        w1.x = pack_fp8x4(a[1][0][0], a[1][0][1], a[1][0][2], a[1][0][3]); w1.y = pack_fp8x4(a[1][1][0], a[1][1][1], a[1][1][2], a[1][1][3]);
        { const auto rx = __builtin_amdgcn_permlane32_swap(w0.x, w1.x, false, false); w0.x = rx[0]; w1.x = rx[1]; const auto ry = __builtin_amdgcn_permlane32_swap(w0.y, w1.y, false, false); w0.y = ry[0]; w1.y = ry[1]; }
        const bool up = (threadIdx.x & 32u) != 0u;
        unsigned char* o = yb + (size_t)(u.row0 + r) * D + u.pn * 256 + (up ? 128 + c - 8 : c);
        u32x4 w; w[0] = w0.x; w[1] = w0.y; w[2] = w1.x; w[3] = w1.y; *(u32x4*)o = w; }
};

typedef short bf16x8 __attribute__((ext_vector_type(8)));
typedef short s16x4 __attribute__((ext_vector_type(4)));
__device__ __forceinline__ s16x4 lds_tr(const LAS bf16_t* p) { return __builtin_amdgcn_ds_read_tr16_b64_v4i16((LAS s16x4*)p); }
__device__ __forceinline__ bf16x8 cat4(s16x4 a, s16x4 b) { bf16x8 r; r[0] = a[0]; r[1] = a[1]; r[2] = a[2]; r[3] = a[3]; r[4] = b[0]; r[5] = b[1]; r[6] = b[2]; r[7] = b[3]; return r; }
__device__ __forceinline__ bf16x8 pack8(f32x4 a, f32x4 b) { union { u32x4 u; bf16x8 h; } c; c.u[0] = pack2(a[0], a[1]); c.u[1] = pack2(a[2], a[3]); c.u[2] = pack2(b[0], b[1]); c.u[3] = pack2(b[2], b[3]); return c.h; }
constexpr int BK = 64, HTB = 128 * BK * 2;
__device__ __forceinline__ int lds_byte(int r, int c) { const int st = (r >> 4) * 2 + (c >> 5), rr = r & 15, cc = c & 31, ob = rr * 64 + cc * 2; return st * 1024 + (ob ^ (((ob >> 9) & 1) << 5)); }
__device__ __forceinline__ void stage_rc(int b, int& R, int& C) { const int st = b / 1024, sb = b % 1024, swz = sb ^ (((sb >> 9) & 1) << 5); R = (st >> 1) * 16 + swz / 64; C = (st & 1) * 32 + (swz % 64) / 2; }

typedef int i32x8 __attribute__((ext_vector_type(8)));
typedef int i32x4 __attribute__((ext_vector_type(4)));
template <class Epi, class Sched, int MODE = 0>
__device__ __forceinline__ void gemm_phase_mfma(const Frame& F, const int K, const Sched& S, const Epi& E, const float oscale = 1.0f, const float* rowscale = nullptr) {
    constexpr bool FP8 = (MODE == 1), I8 = (MODE == 2);
    LAS unsigned char* lds = F.lds;
    const int tid = F.tid, wid = F.wave, lane = F.lane, wr = wid >> 2, wc = wid & 3, fr = lane & 15, fq = lane >> 4;
    const int KB = MODE ? K : 2 * K;
    const int nt = KB / 128;
    unsigned voffB[2];
#pragma unroll
    for (int i = 0; i < 2; ++i) { int R, C; stage_rc(tid * 16 + i * 8192, R, C); const int rho = R & 31, q4 = (rho & 15) >> 2, Rb = (R & ~31) + 8 * (((q4 & 1) << 1) | (q4 >> 1)) + 4 * (rho >> 4) + (rho & 3); voffB[i] = (unsigned)(Rb * KB + C * 2); }
    const size_t kstep = (size_t)(BK * 2);
    const size_t hstepB = (size_t)128 * KB;
    const unsigned ldsw = (unsigned)wid * 1024u;
    const int aoff = FP8 ? lds_byte(wr * 64 + fr, fq * 16) : lds_byte(wr * 64 + fr, fq * 8), boff = FP8 ? lds_byte(wc * 32 + fr, fq * 16) : lds_byte(wc * 32 + fr, fq * 8);
#define SA_(b, h) (((b) * 2 + (h)) * HTB)
#define SB_(b, h) ((4 + (b) * 2 + (h)) * HTB)
#define STAGE_(bufoff, gbase, voff) do { _Pragma("unroll") for (int _i = 0; _i < 2; ++_i) \
        __builtin_amdgcn_global_load_lds((const unsigned*)((const char*)(gbase) + (voff)[_i]), (LAS unsigned*)(lds + (bufoff) + ldsw + _i * 8192), 16, 0, 0); } while (0)
#define LDA_(dst, b, h) do { _Pragma("unroll") for (int m = 0; m < 4; ++m) { if constexpr (FP8) { const i32x4 _lo = *(const LAS i32x4*)(lds + SA_(b, h) + aoff + m * 2048), _hi = *(const LAS i32x4*)(lds + SA_(b, h) + aoff + m * 2048 + 16); \
            dst##8[m] = __builtin_shufflevector(_lo, _hi, 0, 1, 2, 3, 4, 5, 6, 7); } \
        else { _Pragma("unroll") for (int k = 0; k < 2; ++k) dst[m][k] = *(const LAS bf16x8*)(lds + SA_(b, h) + aoff + m * 2048 + k * 1024); } } } while (0)
#define LDB_(dst, b, h) do { _Pragma("unroll") for (int n = 0; n < 2; ++n) { if constexpr (FP8) { const i32x4 _lo = *(const LAS i32x4*)(lds + SB_(b, h) + boff + n * 2048), _hi = *(const LAS i32x4*)(lds + SB_(b, h) + boff + n * 2048 + 16); \
            dst##8[n] = __builtin_shufflevector(_lo, _hi, 0, 1, 2, 3, 4, 5, 6, 7); } \
        else { _Pragma("unroll") for (int k = 0; k < 2; ++k) dst[n][k] = *(const LAS bf16x8*)(lds + SB_(b, h) + boff + n * 2048 + k * 1024); } } } while (0)
#define MMA_(ai, bj, At, Bt) do { __builtin_amdgcn_s_setprio(1); _Pragma("unroll") for (int m = 0; m < 4; ++m) _Pragma("unroll") for (int n = 0; n < 2; ++n) { \
        if constexpr (FP8) asm volatile("v_mfma_scale_f32_16x16x128_f8f6f4 %0, %1, %2, %0, %3, %3 op_sel_hi:[0,0,0]" : "+v"(acc[ai][bj][m][n]) : "v"(Bt##8[n]), "v"(At##8[m]), "v"(sc8)); \
        else if constexpr (I8) { _Pragma("unroll") for (int k = 0; k < 2; ++k) acci[ai][bj][m][n] = __builtin_amdgcn_mfma_i32_16x16x64_i8(__builtin_bit_cast(i32x4, Bt[n][k]), __builtin_bit_cast(i32x4, At[m][k]), acci[ai][bj][m][n], 0, 0, 0); } \
        else { _Pragma("unroll") for (int k = 0; k < 2; ++k) acc[ai][bj][m][n] = __builtin_amdgcn_mfma_f32_16x16x32_bf16(Bt[n][k], At[m][k], acc[ai][bj][m][n], 0, 0, 0); } } \
        __builtin_amdgcn_s_setprio(0); } while (0)
#define WAIT_V_(n) asm volatile("s_waitcnt vmcnt(" #n ")" ::: "memory")
#define WAIT_L_(n) asm volatile("s_waitcnt lgkmcnt(" #n ")" ::: "memory")
#define BAR_ __builtin_amdgcn_s_barrier()
#define SCHED_ __builtin_amdgcn_sched_barrier(0)
#define VOFFS_(dst, u) do { int _tz = tid; asm volatile("" : "+v"(_tz)); _Pragma("unroll") for (int _i = 0; _i < 2; ++_i) { int _R, _C; stage_rc(_tz * 16 + _i * 8192, _R, _C); \
        _Pragma("unroll") for (int _h = 0; _h < 2; ++_h) { const int _r = _h * 128 + _R; \
        const unsigned _row = (u).gather ? (unsigned)(u).gather[_r] : (unsigned)((u).row0 + _r); dst[_h][_i] = _row * (unsigned)KB + (unsigned)_C * 2u; } } } while (0)
    GUnit cur, nxt; int ui = 0;
    if (!S.get(0, cur)) return;
    f32x4 acc[2][2][4][2]; i32x4 acci[2][2][4][2];
#pragma unroll
    for (int a = 0; a < 2; ++a)
#pragma unroll
        for (int b = 0; b < 2; ++b)
#pragma unroll
            for (int m = 0; m < 4; ++m)
#pragma unroll
                for (int n = 0; n < 2; ++n) { acc[a][b][m][n] = (f32x4){0.f, 0.f, 0.f, 0.f}; acci[a][b][m][n] = (i32x4){0, 0, 0, 0}; }
    bf16x8 At[4][2], B0[2][2], B1[2][2]; i32x8 At8[4], B08[2], B18[2];
    int sc8 = 0x7f7f7f7f; asm volatile("" : "+v"(sc8));
    unsigned vA[2][2], vN[2][2];
    VOFFS_(vA, cur);
    const char* cA = (const char*)cur.A; const char* cB = (const char*)cur.Bt;
    STAGE_(SB_(0, 0), cB, voffB); STAGE_(SA_(0, 0), cA, vA[0]); STAGE_(SB_(0, 1), cB + hstepB, voffB); STAGE_(SA_(0, 1), cA, vA[1]);
    if (wr == 1) BAR_;
    WAIT_V_(4); BAR_;
    STAGE_(SB_(1, 0), cB + kstep, voffB); STAGE_(SA_(1, 0), cA + kstep, vA[0]); STAGE_(SB_(1, 1), cB + hstepB + kstep, voffB); STAGE_(SA_(1, 1), cA + kstep, vA[1]);
    WAIT_V_(8); BAR_;
    for (;;) {
        const bool has_next = S.get(ui + 1, nxt);
        const char* nA = has_next ? (const char*)nxt.A : cA; const char* nB = has_next ? (const char*)nxt.Bt : cB;
        if (has_next) { VOFFS_(vN, nxt); }
        for (int t = 0; t < nt; t += 2) {
            const bool last = (t == nt - 2);
            if constexpr (Epi::SEG) { if (t > 0 && (t & 7) == 0) {
                int tz = tid; asm volatile("" : "+v"(tz)); const int er = ((tz >> 8) & 1) * 64 + (tz & 15), ec = ((tz >> 6) & 3) * 32 + ((((tz >> 4) & 1) << 1) | ((tz >> 5) & 1)) * 8;
#pragma unroll
                for (int ai = 0; ai < 2; ++ai) { typename Epi::SPre sp[4];
#pragma unroll
                    for (int m = 0; m < 4; ++m) E.seg_pre(cur, ai * 128 + m * 16 + er, ec, (t >> 3) - 1, sp[m]);
#pragma unroll
                    for (int m = 0; m < 4; ++m) E.seg_fin(acc[ai][0][m], acc[ai][1][m], sp[m]);
                    asm volatile("" ::: "memory"); }
            } }
            const char* a2 = last ? nA : cA + (size_t)(t + 2) * kstep; const char* b2 = last ? nB : cB + (size_t)(t + 2) * kstep;
            const char* a3 = a2 + kstep; const char* b3 = b2 + kstep;
            unsigned w0[2], w1[2];
#pragma unroll
            for (int i = 0; i < 2; ++i) { w0[i] = (last && has_next) ? vN[0][i] : vA[0][i]; w1[i] = (last && has_next) ? vN[1][i] : vA[1][i]; }
            LDB_(B0, 0, 0); SCHED_; LDA_(At, 0, 0);
            WAIT_L_(8); BAR_; WAIT_L_(0); MMA_(0, 0, At, B0); BAR_; SCHED_;
            LDB_(B1, 0, 1); STAGE_(SB_(0, 0), b2, voffB);
            BAR_; WAIT_L_(0); MMA_(0, 1, At, B1); BAR_;
            LDA_(At, 0, 1); STAGE_(SA_(0, 0), a2, w0);
            BAR_; WAIT_L_(0); MMA_(1, 0, At, B0); BAR_; SCHED_;
            STAGE_(SB_(0, 1), b2 + hstepB, voffB);
            { const int lax = __builtin_amdgcn_readfirstlane((t == 0 && ui > 0) ? 1 : 0); asm volatile("s_waitcnt vmcnt(%1)\n\ts_cmp_lg_u32 %0, 0\n\ts_cbranch_scc1 .Llax_%=\n\ts_waitcnt vmcnt(6)\n.Llax_%=:" :: "s"(lax), "n"(6 + Epi::NST) : "memory", "scc"); }
            BAR_; MMA_(1, 1, At, B1); BAR_;
            LDB_(B0, 1, 0); SCHED_; LDA_(At, 1, 0); STAGE_(SA_(0, 1), a2, w1);
            WAIT_L_(8); BAR_; WAIT_L_(0); MMA_(0, 0, At, B0); BAR_; SCHED_;
            LDB_(B1, 1, 1); STAGE_(SB_(1, 0), b3, voffB);
            BAR_; WAIT_L_(0); MMA_(0, 1, At, B1); BAR_;
            LDA_(At, 1, 1); STAGE_(SA_(1, 0), a3, w0);
            BAR_; WAIT_L_(0); MMA_(1, 0, At, B0); BAR_; SCHED_;
            STAGE_(SB_(1, 1), b3 + hstepB, voffB); STAGE_(SA_(1, 1), a3, w1);
            WAIT_V_(8); BAR_; MMA_(1, 1, At, B1); BAR_;
        }
        { int tz = tid; asm volatile("" : "+v"(tz)); const int er = ((tz >> 8) & 1) * 64 + (tz & 15), ec = ((tz >> 6) & 3) * 32 + ((((tz >> 4) & 1) << 1) | ((tz >> 5) & 1)) * 8;
          typename Epi::Pre pre[2][4];
#pragma unroll
          for (int ai = 0; ai < 2; ++ai)
#pragma unroll
              for (int m = 0; m < 4; ++m) E.pre(cur, ai * 128 + m * 16 + er, ec, pre[ai][m]);
          if constexpr (I8) {
#pragma unroll
              for (int ai = 0; ai < 2; ++ai)
#pragma unroll
                  for (int m = 0; m < 4; ++m) { const float rs = rowscale[cur.row0 + ai * 128 + m * 16 + er] * oscale * Epi::unit_scale(cur);
#pragma unroll
                      for (int bj = 0; bj < 2; ++bj)
#pragma unroll
                          for (int n = 0; n < 2; ++n)
#pragma unroll
                              for (int j = 0; j < 4; ++j) acc[ai][bj][m][n][j] = (float)acci[ai][bj][m][n][j] * rs; } }
          if constexpr (FP8) {
#pragma unroll
              for (int ai = 0; ai < 2; ++ai)
#pragma unroll
                  for (int bj = 0; bj < 2; ++bj)
#pragma unroll
                      for (int m = 0; m < 4; ++m)
#pragma unroll
                          for (int n = 0; n < 2; ++n) acc[ai][bj][m][n] *= oscale; }
          if constexpr (Epi::PAIR_M) {
#pragma unroll
          for (int ai = 0; ai < 2; ++ai)
#pragma unroll
              for (int m = 0; m < 4; m += 2) { const f32x4 a4[2][2] = {{acc[ai][0][m][0], acc[ai][0][m][1]}, {acc[ai][1][m][0], acc[ai][1][m][1]}}; const f32x4 b4[2][2] = {{acc[ai][0][m + 1][0], acc[ai][0][m + 1][1]}, {acc[ai][1][m + 1][0], acc[ai][1][m + 1][1]}};
                  E.fin2(cur, ai * 128 + m * 16 + er, ai * 128 + (m + 1) * 16 + er, ec, a4, b4, pre[ai][m], pre[ai][m + 1]); }
          } else {
#pragma unroll
          for (int ai = 0; ai < 2; ++ai)
#pragma unroll
              for (int m = 0; m < 4; ++m) { const f32x4 a4[2][2] = {{acc[ai][0][m][0], acc[ai][0][m][1]}, {acc[ai][1][m][0], acc[ai][1][m][1]}}; E.fin(cur, ai * 128 + m * 16 + er, ec, a4, pre[ai][m]); } } }
        if (!has_next) break;
#pragma unroll
        for (int a = 0; a < 2; ++a)
#pragma unroll
            for (int b = 0; b < 2; ++b)
#pragma unroll
                for (int m = 0; m < 4; ++m)
#pragma unroll
                    for (int n = 0; n < 2; ++n) { acc[a][b][m][n] = (f32x4){0.f, 0.f, 0.f, 0.f}; acci[a][b][m][n] = (i32x4){0, 0, 0, 0}; }
        cur = nxt; cA = nA; cB = nB; ++ui;
#pragma unroll
        for (int h = 0; h < 2; ++h)
#pragma unroll
            for (int i = 0; i < 2; ++i) vA[h][i] = vN[h][i];
    }
    WAIT_V_(0);
    if (wr == 0) BAR_;
    BAR_;
#undef SA_
#undef SB_
#undef STAGE_
#undef LDA_
#undef LDB_
#undef MMA_
#undef WAIT_V_
#undef WAIT_L_
#undef BAR_
#undef SCHED_
#undef VOFFS_
}

struct DenseSched {
    const bf16_t* A; const bf16_t* Bt; int K, nM, nN, nwg, G, c, i0, i1, split, pnoff;
    __device__ __forceinline__ void segment(int sg) { i0 = sg == 0 ? 0 : split; i1 = sg == 0 ? split : (1 << 30); }
    __device__ __forceinline__ bool get(int ii, GUnit& u) const {
        const int i = ii + i0; if (i >= i1) return false;
        const long L = (long)i * G + c; if (L >= nwg) return false;
        int wgid = (int)L; { const int q = nwg / 8, r = nwg % 8, xcd = wgid % 8, off = wgid / 8; wgid = (xcd < r ? xcd * (q + 1) : r * (q + 1) + (xcd - r) * q) + off; }
        const int nig = 8 * nN, gid = wgid / nig, fm = gid * 8, gsz = (nM - fm) < 8 ? (nM - fm) : 8;
        const int pm = fm + ((wgid % nig) % gsz), pn = (wgid % nig) / gsz;
        u.pn = pn + pnoff; u.row0 = pm * 256; u.A = A; u.gather = nullptr; u.Bt = Bt + (size_t)pn * 256 * K; u.e = 0; return true;
    }
};
struct QSched {
    unsigned char* ws; int l, G, c;
    __device__ __forceinline__ bool get(int i, GUnit& g) const {
        const int u = i * G + c; if (u >= 128) return false; g.gather = nullptr;
        g.e = 0; g.pn = u & 1; g.row0 = (u >> 1) * 256; g.A = (const bf16_t*)(ws + WS_XB8); g.Bt = (const bf16_t*)(ws + WS_WQ + l * SZ_WQ + (size_t)g.pn * 256 * D); g.dst = (bf16_t*)(ws + WS_Q);
        return true;
    }
};
struct KvSched {
    unsigned char* ws; int l, G, c;
    __device__ __forceinline__ bool get(int i, GUnit& g) const {
        const int v = i * G + c - 128; if (c < 128 || v >= 16) return false; g.gather = nullptr;
        g.e = 1 + (v >> 3); g.pn = v & 1; g.row0 = ((v >> 1) & 3) * 256; g.A = (const bf16_t*)(ws + WS_MEMB); g.Bt = (const bf16_t*)(ws + (g.e == 1 ? WS_WK : WS_WV) + l * SZ_WQ) + (size_t)g.pn * 256 * D; g.dst = (bf16_t*)(ws + (g.e == 1 ? WS_KM : WS_VM)) + (size_t)l * TM * W;
        return true;
    }
};
template <int NCT, bool GATEUP> struct MoeSched {
    unsigned char* ws; const LAS int* pst; int l, G, c, nunits;
    __device__ __forceinline__ bool get(int i, GUnit& g) const {
        const int u = i * G + c; if (u >= nunits) return false;
        const int rt = u / NCT; g.pn = u % NCT; g.row0 = rt * 256; const int e = __builtin_amdgcn_readfirstlane((int)((const LAS unsigned char*)(pst + 68))[rt]); g.e = e;
        if (GATEUP) { g.A = (const bf16_t*)(ws + WS_XB8); g.gather = (const int*)(ws + WS_TOK) + g.row0; g.Bt = (const bf16_t*)(ws + WS_WGU8 + ((size_t)l * NEX + e) * SZ_WGU8 + (size_t)g.pn * 256 * D); }
        else { g.A = (const bf16_t*)(ws + WS_HB); g.gather = nullptr; g.Bt = (const bf16_t*)(ws + WS_WDN + ((size_t)l * NEX + e) * SZ_WDN1 + (size_t)g.pn * 256 * ED); }
        return true;
    }
};

struct TDesc { const float* sp; int sld; unsigned char* dp; int dldb; int fp8; float qs; };
constexpr int TK_WINA = 1024, TK_WINB = 2560, TK_BR = 384, TK_WOUT = 512, TK_QKV = 384, TK_WO = 128, TK_GU = NEX * 8 * 32, TK_DN = NEX * 128;
constexpr int TK_L0DEF = TK_BR + TK_WOUT + TK_QKV + TK_WO + TK_GU + TK_DN, TK_LAYER = TK_WINA + TK_WINB + TK_L0DEF;
__device__ __forceinline__ void tile_desc(const Frame& F, int l, int t, TDesc& d) {
    const KArgs a = F.ka; unsigned char* ws = F.ws_(); d.fp8 = 0; d.qs = W8_SCALE;
    if (t < TK_WINA) { const int tk = t >> 6, tc = t & 63; d.sp = ((const float*)a->in[IN_WIN]) + (size_t)l * D * PROJ_W + (size_t)tk * 128 * PROJ_W + tc * 64; d.sld = PROJ_W; d.dldb = D; d.fp8 = 2; d.qs = 127.0f / fmaxf(__uint_as_float(((const unsigned*)(ws + WS_CTL))[CW_WABS + l]), 1e-30f); d.dp = ws + WS_WINQ + l * SZ_WINQ + (size_t)tc * 64 * D + tk * 128; return; }
    t -= TK_WINA;
    if (t < TK_WINB) { const int tk = t / 160, tc = t % 160; d.sp = ((const float*)a->in[IN_WIN]) + (size_t)l * D * PROJ_W + (size_t)tk * 128 * PROJ_W + 4104 + tc * 64; d.sld = PROJ_W;
        if (tc < 32) { d.dldb = D; d.fp8 = 2; d.qs = 127.0f / fmaxf(__uint_as_float(((const unsigned*)(ws + WS_CTL))[CW_WABS + l]), 1e-30f); d.dp = ws + WS_WINQ + l * SZ_WINQ + (size_t)(4096 + tc * 64) * D + tk * 128; }
        else { d.dldb = D; d.fp8 = 1; d.dp = ws + WS_WIN8 + l * SZ_WIN8 + (size_t)(4096 + tc * 64) * D + tk * 128; }
        return; }
    t -= TK_WINB;
    if (t < TK_BR) { const int n = 1 + (t >> 7), tt = t & 127, tk = tt >> 5, tc = tt & 31; d.sp = ((const float*)a->in[IN_WBR]) + ((size_t)l * 4 + n) * W * D + (size_t)tk * 128 * D + tc * 64; d.sld = D; d.dldb = D * 2; d.dp = ws + WS_WB + l * SZ_DD + ((size_t)tc * 64 * D + n * W + tk * 128) * 2; return; }
    t -= TK_BR;
    if (t < TK_WOUT) { const int tk = t >> 5, tc = t & 31; d.sp = ((const float*)a->in[IN_WMIX]) + (size_t)l * D * D + (size_t)tk * 128 * D + tc * 64; d.sld = D; d.dldb = D; d.fp8 = 1; d.dp = ws + WS_WOUT + l * SZ_DD + ((size_t)tc * 64 * D + tk * 128); return; }
    t -= TK_WOUT;
    if (t < TK_QKV) { const int which = t >> 7, tt = t & 127, tk = tt >> 3, tc = tt & 7; d.sp = (const float*)a->in[which == 0 ? IN_WQ : (which == 1 ? IN_WK : IN_WV)] + (size_t)l * D * W + (size_t)tk * 128 * W + tc * 64; d.sld = W; d.dldb = D * 2;
        d.dp = ws + (which == 0 ? WS_WQ : (which == 1 ? WS_WK : WS_WV)) + l * SZ_WQ + ((size_t)tc * 64 * D + tk * 128) * 2;
        if (which == 0) { d.fp8 = 1; d.dldb = D; d.dp = ws + WS_WQ + l * SZ_WQ + ((size_t)tc * 64 * D + tk * 128); }
        return; }
    t -= TK_QKV;
    if (t < TK_WO) { const int tk = t >> 5, tc = t & 31; d.sp = ((const float*)a->in[IN_WO]) + (size_t)l * W * D + (size_t)tk * 128 * D + tc * 64; d.sld = D; d.dldb = W * 2; d.dp = ws + WS_WO + l * SZ_WQ + ((size_t)tc * 64 * W + tk * 128) * 2; return; }
    t -= TK_WO;
    if (t < TK_GU) { const int tt = t & 31, job = t >> 5, half = job & 1, j = (job >> 1) & 3, e = job >> 3, tk = tt >> 1, tc = tt & 1;
        d.sp = (e < NE ? ((const float*)a->in[IN_WGU]) + ((size_t)l * NE + e) * D * 1024 : ((const float*)a->in[IN_SGU]) + (size_t)l * D * 1024) + half * 512 + j * 128 + (size_t)tk * 128 * 1024 + tc * 64; d.sld = 1024; d.dldb = D; d.fp8 = 1;
        d.dp = ws + WS_WGU8 + ((size_t)l * NEX + e) * SZ_WGU8 + (size_t)(j * 256 + half * 128 + tc * 64) * D + tk * 128; return; }
    t -= TK_GU;
    { const int tt = t & 127, e = t >> 7, tk = tt >> 5, tc = tt & 31;
      d.sp = (e < NE ? ((const float*)a->in[IN_WDN]) + ((size_t)l * NE + e) * ED * D : ((const float*)a->in[IN_SDN]) + (size_t)l * ED * D) + (size_t)tk * 128 * D + tc * 64; d.sld = D; d.dldb = ED; d.fp8 = 1;
      d.dp = ws + WS_WDN + ((size_t)l * NEX + e) * SZ_WDN1 + (size_t)tc * 64 * ED + tk * 128; }
}
constexpr int XP_SLOT = 64 * 256;
template <int NB> struct XRegs { f32x4 r[NB][4]; };
template <int NB> __device__ __forceinline__ void xpose_load(const Frame& F, int l, int t0, int tstep, int n, XRegs<NB>& X) {
    const int tid = F.tid, row4 = (tid >> 4) * 4, cq = (tid & 15) * 4;
#pragma unroll
    for (int b = 0; b < NB; ++b) if (b < n) { TDesc d; tile_desc(F, l, t0 + b * tstep, d); const float* sp = d.sp + (size_t)row4 * d.sld + cq;
#pragma unroll
        for (int q = 0; q < 4; ++q) X.r[b][q] = __builtin_nontemporal_load((const f32x4*)(sp + (size_t)q * d.sld)); }
}
template <int NB> __device__ __forceinline__ void xpose_finish(const Frame& F, int l, int t0, int tstep, int n, const XRegs<NB>& X) {
    const int tid = F.tid, row4 = (tid >> 4) * 4, cq = (tid & 15) * 4;
    int t1 = t0; asm volatile("" : "+s"(t1));
#pragma unroll
    for (int b = 0; b < NB; ++b) if (b < n) { TDesc d; tile_desc(F, l, t1 + b * tstep, d); LAS unsigned char* L = F.lds + b * XP_SLOT;
        if (d.fp8) { const int sw = ((cq >> 2) & 7) << 4;
#pragma unroll
            for (int j = 0; j < 4; ++j) *(LAS unsigned*)(L + (cq + j) * 128 + (row4 ^ sw)) = (d.fp8 == 2) ? pack_i8x4(X.r[b][0][j] * d.qs, X.r[b][1][j] * d.qs, X.r[b][2][j] * d.qs, X.r[b][3][j] * d.qs) : pack_fp8x4(X.r[b][0][j] * W8_SCALE, X.r[b][1][j] * W8_SCALE, X.r[b][2][j] * W8_SCALE, X.r[b][3][j] * W8_SCALE);
        } else { const int sw = ((cq >> 2) & 15) << 4;
#pragma unroll
            for (int j = 0; j < 4; ++j) { u32x2 w; w.x = pack2(X.r[b][0][j], X.r[b][1][j]); w.y = pack2(X.r[b][2][j], X.r[b][3][j]); *(LAS u32x2*)(L + (cq + j) * 256 + ((row4 * 2) ^ sw)) = w; } } }
    __syncthreads();
    int t2 = t0; asm volatile("" : "+s"(t2));
#pragma unroll
    for (int b = 0; b < NB; ++b) if (b < n) { TDesc d; tile_desc(F, l, t2 + b * tstep, d); const LAS unsigned char* L = F.lds + b * XP_SLOT; const int c = tid >> 3, kq = tid & 7;
        if (d.fp8) *(u32x4*)(d.dp + (size_t)c * d.dldb + kq * 16) = *(const LAS u32x4*)(L + c * 128 + ((kq * 16) ^ (((c >> 2) & 7) << 4)));
        else { const int sw = ((c >> 2) & 15) << 4; *(u32x4*)(d.dp + (size_t)c * d.dldb + kq * 16) = *(const LAS u32x4*)(L + c * 256 + ((kq * 16) ^ sw)); *(u32x4*)(d.dp + (size_t)c * d.dldb + 128 + kq * 16) = *(const LAS u32x4*)(L + c * 256 + ((128 + kq * 16) ^ sw)); } }
    __syncthreads();
}
__device__ __forceinline__ void xpose_range(const Frame& F, int l, int tlo, int thi, int rank, int nranks) {
    constexpr int NB = 4; const int step = nranks * NB;
    XRegs<NB> A, B;
    int t = tlo + rank * NB; if (t >= thi) return;
#define XP_CNT(tt) (((thi) - (tt)) < NB ? ((thi) - (tt)) : NB)
    xpose_load<NB>(F, l, t, 1, XP_CNT(t), A);
    for (;;) {
        const int tb = t + step; const bool hb = tb < thi; if (hb) xpose_load<NB>(F, l, tb, 1, XP_CNT(tb), B);
        xpose_finish<NB>(F, l, t, 1, XP_CNT(t), A);
        if (!hb) break;
        const int ta = tb + step; const bool ha = ta < thi; if (ha) xpose_load<NB>(F, l, ta, 1, XP_CNT(ta), A);
        xpose_finish<NB>(F, l, tb, 1, XP_CNT(tb), B);
        if (!ha) break;
        t = ta;
    }
#undef XP_CNT
}
__device__ __forceinline__ void pool_fold(const Frame& F, int l, int rank, int nranks) {
    const KArgs a = F.ka; unsigned char* ws = F.ws_();
    for (size_t i = (size_t)rank * NTHR + F.tid; i < (size_t)W * D; i += (size_t)nranks * NTHR) {
        const int d = (int)(i % D), gc = (int)(i / D), g = gc >> 7;
        const float* pw = ((const float*)a->in[IN_POOLW]) + ((size_t)l * W + gc) * 128; const float* ps = ((const float*)a->in[IN_POOLS]) + l * W + g * 128;
        const float* wb = ((const float*)a->in[IN_WBR]) + ((size_t)l * 4 * W + g * 128) * D + d;
        float s = 0.f;
        for (int e = 0; e < 128; ++e) s += pw[e] * ps[e] * wb[(size_t)e * D];
        ((bf16_t*)(ws + WS_WB + l * SZ_DD))[(size_t)d * D + gc] = f2bf(s);
    }
}
__device__ __forceinline__ void phase_wabs(const Frame& F) {
    const KArgs a = F.ka; unsigned char* ws = F.ws_();
    for (int l = 0; l < DEPTH; ++l) { float m = 0.f; const float* w = ((const float*)a->in[IN_WIN]) + (size_t)l * D * PROJ_W;
        for (size_t i = (size_t)F.wg * NTHR + F.tid; i < (size_t)D * (NBR / 4); i += (size_t)F.nwg * NTHR) { const int c4 = (int)(i % (NBR / 4)), k = (int)(i / (NBR / 4)); const int col = c4 * 4 < 4096 ? c4 * 4 : c4 * 4 + 8;
            const f32x4 v = *(const f32x4*)(w + (size_t)k * PROJ_W + col); m = fmaxf(m, fmaxf(fmaxf(fabsf(v[0]), fabsf(v[1])), fmaxf(fabsf(v[2]), fabsf(v[3])))); }
        m = wave_max(m);
        if (F.lane == 0) __hip_atomic_fetch_max((unsigned*)(ws + WS_CTL) + CW_WABS + l, __float_as_uint(m), __ATOMIC_RELAXED, __HIP_MEMORY_SCOPE_AGENT); }
}
__device__ __forceinline__ void phase_prologue(const Frame& F) {
    const KArgs a = F.ka;
    unsigned char* ws = F.ws_();
    xpose_range(F, 0, 0, TK_WINA + TK_WINB, F.wg, F.nwg);
    const size_t gtid = (size_t)F.wg * NTHR + F.tid, gn = (size_t)F.nwg * NTHR;
    for (size_t i = gtid; i < (size_t)DEPTH * 8 * D; i += gn) { const int k = (int)(i % D), c = (int)((i / D) % 8), l = (int)(i / (8 * D));
        ((float*)(ws + WS_WIF))[i] = ((const float*)a->in[IN_WIN])[(size_t)l * D * PROJ_W + (size_t)k * PROJ_W + 4096 + c]; }
    for (size_t i = gtid; i < (size_t)DEPTH * 16 * D; i += gn) { const int k = (int)(i % D), c = (int)((i / D) % 16), l = (int)(i / (16 * D));
        const float wv = c < 8 ? ((const float*)a->in[IN_WIN])[(size_t)l * D * PROJ_W + (size_t)k * PROJ_W + 4096 + c] : 0.f; const bf16_t hi = f2bf(wv), lo = f2bf(wv - bf2f(hi));
        bf16_t* o = (bf16_t*)(ws + WS_WIFB) + (size_t)l * 2 * 16 * D; o[(size_t)c * D + k] = hi; o[(size_t)(16 + c) * D + k] = lo; }
    for (size_t i = gtid; i < (size_t)DEPTH * NE * D; i += gn) { const int k = (int)(i % D), e = (int)((i / D) % NE), l = (int)(i / ((size_t)NE * D));
        const float w = ((const float*)a->in[IN_RW])[((size_t)l * D + k) * NE + e]; const bf16_t hi = f2bf(w); const bf16_t lo = f2bf(w - bf2f(hi));
        bf16_t* o = (bf16_t*)(ws + WS_RWT) + (size_t)l * 2 * NE * D; o[(size_t)e * D + k] = hi; o[(size_t)(NE + e) * D + k] = lo; }
    for (size_t i = gtid; i < (size_t)SEQ * 64; i += gn) { const int f = (int)(i & 63), s = (int)(i >> 6);
        const float inv = powf(10000.0f, -(float)f / 64.0f); const float ang = (float)s * inv;
        ((float*)(ws + WS_ROPE))[i] = cosf(ang); ((float*)(ws + WS_ROPE))[(size_t)SEQ * 64 + i] = sinf(ang); }
    for (int row = F.wg * 8 + F.wave; row < T; row += F.nwg * 8) { float v[32]; const float* xr = ((const float*)a->in[IN_X]) + (size_t)row * D;
#pragma unroll
        for (int j = 0; j < 4; ++j) { const f32x4 p = *(const f32x4*)(xr + j * 512 + F.lane * 8), q = *(const f32x4*)(xr + j * 512 + F.lane * 8 + 4); v[j * 8] = p[0]; v[j * 8 + 1] = p[1]; v[j * 8 + 2] = p[2]; v[j * 8 + 3] = p[3]; v[j * 8 + 4] = q[0]; v[j * 8 + 5] = q[1]; v[j * 8 + 6] = q[2]; v[j * 8 + 7] = q[3]; }
        st_row32((bf16_t*)(ws + WS_XB) + (size_t)row * D, F.lane, v); st_row32_fp8(ws + WS_XB8 + (size_t)row * D, F.lane, v); st_row32_i8(ws + WS_XQ8 + (size_t)row * D, (float*)(ws + WS_XSC) + row, F.lane, v); }
    for (size_t i = gtid; i < (size_t)TM * D / 4; i += gn) { const f32x4 v = ((const f32x4*)((const float*)a->in[IN_MEM]))[i]; st_bf16x4((bf16_t*)(ws + WS_MEMB) + i * 4, v); }
    __syncthreads();
}
__device__ __forceinline__ void prologue_deferred(const Frame& F, int rank, int nranks) {
    xpose_range(F, 0, TK_WINA + TK_WINB, TK_LAYER, rank, nranks);
    xpose_range(F, 1, 0, TK_LAYER, rank, nranks);
    pool_fold(F, 0, rank, nranks); pool_fold(F, 1, rank, nranks);
    __syncthreads();
}

__device__ __forceinline__ void unpack8(u32x4 w, float (&f)[8]) {
#pragma unroll
    for (int j = 0; j < 4; ++j) { f[2 * j] = __uint_as_float(w[j] << 16); f[2 * j + 1] = __uint_as_float(w[j] & 0xffff0000u); } }
__device__ __forceinline__ u32x4 pack8f(const float (&f)[8]) { u32x4 w;
#pragma unroll
    for (int j = 0; j < 4; ++j) w[j] = pack2(f[2 * j], f[2 * j + 1]); return w; }
template <int WIN> __device__ __forceinline__ void pool_block(const bf16_t* pu, bf16_t* out, int s0) {
    float sum[8];
#pragma unroll
    for (int e = 0; e < 8; ++e) sum[e] = 0.f;
    u32x4 hist[WIN - 1 + 8];
#pragma unroll
    for (int j = 0; j < WIN - 1 + 8; ++j) { const int ds = j - (WIN - 1); hist[j] = (s0 + ds >= 0) ? *(const u32x4*)(pu + (ptrdiff_t)ds * NBR) : (u32x4){0u, 0u, 0u, 0u}; }
#pragma unroll
    for (int j = 0; j < WIN - 1; ++j) { float f[8]; unpack8(hist[j], f);
#pragma unroll
        for (int e = 0; e < 8; ++e) sum[e] += f[e]; }
#pragma unroll
    for (int i = 0; i < 8; ++i) { float f[8]; unpack8(hist[WIN - 1 + i], f); const int cnt = (s0 + i + 1 < WIN) ? s0 + i + 1 : WIN; const float rc = 1.0f / (float)cnt; float o[8];
#pragma unroll
        for (int e = 0; e < 8; ++e) { sum[e] += f[e]; o[e] = sum[e] * rc - f[e]; }
        *(u32x4*)(out + (size_t)i * D) = pack8f(o);
        float fo[8]; unpack8(hist[i], fo);
#pragma unroll
        for (int e = 0; e < 8; ++e) sum[e] -= fo[e]; }
}
template <bool WITH_D = true> __device__ __forceinline__ void phase_mix1v2(const Frame& F, int l, const bf16_t* xcur) {
    const KArgs a = F.ka;
    unsigned char* ws = F.ws_();
    LAS float* dots = (LAS float*)(F.lds + 65536);
    LAS float* wl = (LAS float*)F.lds;
    const float* wif = (const float*)(ws + WS_WIF) + (size_t)l * 8 * D;
    const float* gb = ((const float*)a->in[IN_GATEB]) + l * 8;
    float* cumf = (float*)(ws + WS_CUMF); float* ipre = (float*)(ws + WS_IPRE); float* summ = (float*)(ws + WS_SUMM); float* av = (float*)(ws + WS_AV); float* pm = (float*)(ws + WS_PM);
    const bf16_t* wifb = (const bf16_t*)(ws + WS_WIFB) + (size_t)l * 2 * 16 * D;
    for (int item = F.wg; item < BATCH * NCH; item += F.nwg) {
        const int b = item / NCH, c = item % NCH; const int t0 = b * SEQ + c * CH;
        { const int lane = F.lane, g = lane >> 4, li = lane & 15, w = F.wave;
          f32x4 acc[4] = {{0.f, 0.f, 0.f, 0.f}, {0.f, 0.f, 0.f, 0.f}, {0.f, 0.f, 0.f, 0.f}, {0.f, 0.f, 0.f, 0.f}};
#pragma unroll 4
          for (int ks = 8 * w; ks < 8 * w + 8; ++ks) { const bf16x8 bh = *(const bf16x8*)(wifb + (size_t)li * D + ks * 32 + g * 8), bl = *(const bf16x8*)(wifb + (size_t)(16 + li) * D + ks * 32 + g * 8);
#pragma unroll
              for (int mt = 0; mt < 4; ++mt) { const bf16x8 xa = *(const bf16x8*)(xcur + (size_t)(t0 + 16 * mt + li) * D + ks * 32 + g * 8);
                  acc[mt] = __builtin_amdgcn_mfma_f32_16x16x32_bf16(xa, bh, acc[mt], 0, 0, 0); acc[mt] = __builtin_amdgcn_mfma_f32_16x16x32_bf16(xa, bl, acc[mt], 0, 0, 0); } }
          LAS float* part = (LAS float*)F.lds;
          if (li < 8) {
#pragma unroll
              for (int mt = 0; mt < 4; ++mt)
#pragma unroll
                  for (int r = 0; r < 4; ++r) part[((w * 64) + 16 * mt + 4 * g + r) * 8 + li] = acc[mt][r]; }
          __syncthreads();
          if (F.tid < 512) { const int tok = F.tid >> 3, q = F.tid & 7; float sacc = 0.f;
#pragma unroll
              for (int ww = 0; ww < 8; ++ww) sacc += part[(ww * 64 + tok) * 8 + q];
              dots[tok * 8 + q] = sacc; } }
        __syncthreads();
        if (F.wave < NH) {
            const int h = F.wave, s = F.lane; const float ip = dots[s * 8 + h] + gb[h], fp = dots[s * 8 + 4 + h] + gb[4 + h];
            const float lf = fminf(fp, 0.f) - log1pf(__expf(-fabsf(fp)));
            float cs = lf;
#pragma unroll
            for (int o = 1; o < 64; o <<= 1) { const float n = __shfl_up(cs, o); if (s >= o) cs += n; }
            const float ftot = __shfl(cs, 63); const float aa = ip - cs;
            float px = aa;
#pragma unroll
            for (int o = 1; o < 64; o <<= 1) { const float n = __shfl_up(px, o); if (s >= o) px = fmaxf(px, n); }
            const float gm = ftot + __shfl(px, 63);
            const size_t o = (size_t)(b * NH + h) * SEQ + c * CH + s; cumf[o] = cs; ipre[o] = ip; av[o] = aa; pm[o] = px;
            if (s == 0) { summ[((size_t)(b * NH + h) * NCH + c) * 2] = ftot; summ[((size_t)(b * NH + h) * NCH + c) * 2 + 1] = gm; }
        }
        __syncthreads();
    }
    bf16_t* proj = (bf16_t*)(ws + WS_PROJ); bf16_t* br = (bf16_t*)(ws + WS_BR);
    for (int it = F.wg * 8 + F.wave; it < (T / 32) * 4; it += F.nwg * 8) {
        const int grp = it & 3, tbq = it >> 2; const int tb = tbq * 4 + (F.lane >> 4), co = grp * 16 + (F.lane & 15);
        const int t0 = tb * 8, s0 = t0 % SEQ; const bf16_t* pu = proj + (size_t)t0 * NBR + PC_U + co * 8; bf16_t* out = br + (size_t)t0 * D + co * 8;
        if (grp == 0) pool_block<2>(pu, out, s0); else if (grp == 1) pool_block<4>(pu, out, s0); else if (grp == 2) pool_block<8>(pu, out, s0); else pool_block<16>(pu, out, s0);
    }
    { const float* cw = ((const float*)a->in[IN_CONVW]) + (size_t)l * 3 * W;
      for (size_t it = (size_t)F.wg * NTHR + F.tid; it < (size_t)(T / 8) * 64; it += (size_t)F.nwg * NTHR) {
        const int co = (int)(it & 63), tb = (int)(it >> 6), t0 = tb * 8, s0 = t0 % SEQ;
        const bf16_t* pr = proj + (size_t)t0 * NBR + co * 8;
        float w0[8], w1[8], w2[8];
#pragma unroll
        for (int e = 0; e < 8; ++e) { w0[e] = cw[co * 8 + e]; w1[e] = cw[W + co * 8 + e]; w2[e] = cw[2 * W + co * 8 + e]; }
        float z1[8], z2[8];
#pragma unroll
        for (int e = 0; e < 8; ++e) { z1[e] = 0.f; z2[e] = 0.f; }
        if (s0 >= 2) { float c_[8], h_[8]; unpack8(*(const u32x4*)(pr + PC_CC - 2 * NBR), c_); unpack8(*(const u32x4*)(pr + PC_CH - 2 * NBR), h_);
#pragma unroll
            for (int e = 0; e < 8; ++e) z2[e] = c_[e] * h_[e]; }
        if (s0 >= 1) { float c_[8], h_[8]; unpack8(*(const u32x4*)(pr + PC_CC - NBR), c_); unpack8(*(const u32x4*)(pr + PC_CH - NBR), h_);
#pragma unroll
            for (int e = 0; e < 8; ++e) z1[e] = c_[e] * h_[e]; }
#pragma unroll
        for (int i = 0; i < 8; ++i) { float c_[8], h_[8], b_[8], o[8]; unpack8(*(const u32x4*)(pr + PC_CC + (size_t)i * NBR), c_); unpack8(*(const u32x4*)(pr + PC_CH + (size_t)i * NBR), h_); unpack8(*(const u32x4*)(pr + PC_CB + (size_t)i * NBR), b_);
#pragma unroll
            for (int e = 0; e < 8; ++e) { const float z0 = c_[e] * h_[e]; o[e] = b_[e] * (w0[e] * z0 + w1[e] * z1[e] + w2[e] * z2[e]); z2[e] = z1[e]; z1[e] = z0; }
            *(u32x4*)(br + (size_t)(t0 + i) * D + W + co * 8) = pack8f(o); }
      } }
    if constexpr (WITH_D) { const float* ropec = (const float*)(ws + WS_ROPE); const float* ropes = ropec + (size_t)SEQ * 64;
      for (size_t it = (size_t)F.wg * NTHR + F.tid; it < (size_t)T * 64; it += (size_t)F.nwg * NTHR) {
        const int oc = (int)(it & 7), hh = (int)((it >> 3) & 3), isk = (int)((it >> 5) & 1), t = (int)(it >> 6), s = t % SEQ;
        bf16_t* p = proj + (size_t)t * NBR + (isk ? PC_RK : PC_RQ) + hh * HD + oc * 8;
        float x1[8], x2[8], o1[8], o2[8]; unpack8(*(const u32x4*)p, x1); unpack8(*(const u32x4*)(p + 64), x2);
#pragma unroll
        for (int e = 0; e < 8; ++e) { const float cs = ropec[(size_t)s * 64 + oc * 8 + e], sn = ropes[(size_t)s * 64 + oc * 8 + e]; o1[e] = x1[e] * cs - x2[e] * sn; o2[e] = x1[e] * sn + x2[e] * cs; }
        *(u32x4*)p = pack8f(o1); *(u32x4*)(p + 64) = pack8f(o2);
      } }
}

__device__ __forceinline__ float ret_gamma_log2(int h) { return log2f(1.0f - exp2f(-5.0f - (float)h)); }

__device__ __forceinline__ void phase_scan_mfma(const Frame& F) {
    unsigned char* ws = F.ws_();
    constexpr int KS2 = 144, WS2 = 48;
    LAS bf16_t* Kb = (LAS bf16_t*)F.lds;
    LAS bf16_t* Wb = Kb + 2 * 64 * KS2;
    LAS float* mS = (LAS float*)(Wb + 2 * 64 * WS2);
    LAS float* fT = mS + 80;
    const bf16_t* proj = (const bf16_t*)(ws + WS_PROJ);
    const float* av = (const float*)(ws + WS_AV); const float* summ = (const float*)(ws + WS_SUMM);
    const int lane = F.lane, g = lane >> 4, li = lane & 15, w = F.wave, tid = F.tid;
    for (int item = F.wg; item < 2 * NBH * 8; item += F.nwg) {
        const int type = item >> 7, bh = (item >> 3) & 15, vs = item & 7, b = bh >> 2, h = bh & 3;
        if (tid == 0) { float m = 0.f; mS[0] = 0.f; for (int c = 0; c < NCH; ++c) { m = fmaxf(summ[((size_t)bh * NCH + c) * 2] + m, summ[((size_t)bh * NCH + c) * 2 + 1]); mS[c + 1] = m; }
            if (type == 0 && vs == 0) { float* ms = (float*)(ws + WS_MSEQ) + bh * 80; for (int c = 0; c <= NCH; ++c) ms[c] = mS[c]; } }
        if (tid >= 64 && tid < 128) fT[tid - 64] = summ[((size_t)bh * NCH + (tid - 64)) * 2];
        __syncthreads();
        const float lg2 = ret_gamma_log2(h);
        const int kcol = (type == 0 ? PC_MK : PC_RK) + h * HD, vcol = (type == 0 ? PC_MV : PC_RV) + h * HD + vs * 16;
        bf16_t* cst = (bf16_t*)(ws + WS_CST) + ((size_t)(type * NBH + bh) * NCH) * HD * HD;
        float* nsv = (float*)(ws + WS_NST) + (size_t)bh * NCH * HD;
        const int krow = tid >> 3, koct = tid & 7, vrow = (tid >> 1) & 63, vhalf = tid & 1;
        const bf16_t* kbase = proj + (size_t)(b * SEQ + krow) * NBR + kcol + koct * 8;
        const bf16_t* vbase = proj + (size_t)(b * SEQ + vrow) * NBR + vcol + vhalf * 8;
        const float* abase = av + (size_t)bh * SEQ + vrow;
        u32x4 kr[2][2], vr[2]; float ar[2];
#define SCAN_LOAD(c, sl) do { const size_t _o = (size_t)(c) * CH * NBR; kr[sl][0] = *(const u32x4*)(kbase + _o); kr[sl][1] = *(const u32x4*)(kbase + _o + 64); \
        if (tid < 128) { vr[sl] = *(const u32x4*)(vbase + _o); ar[sl] = (type == 0) ? abase[(c) * CH] : 0.f; } } while (0)
#define SCAN_WRITE(c, sl, bf) do { LAS bf16_t* _k = Kb + (bf) * 64 * KS2 + krow * KS2 + koct * 8; *(LAS u32x4*)_k = kr[sl][0]; *(LAS u32x4*)(_k + 64) = kr[sl][1]; \
        if (tid < 128) { const float _w = (type == 0) ? __expf(ar[sl] + fT[c] - mS[(c) + 1]) : exp2f((float)(63 - vrow) * lg2); float _f[8]; unpack8(vr[sl], _f); \
            _Pragma("unroll") for (int _e = 0; _e < 8; ++_e) _f[_e] *= _w; LAS bf16_t* _p = Wb + (bf) * 64 * WS2 + vrow * WS2; *(LAS u32x4*)(_p + vhalf * 8) = pack8f(_f); \
            u32x4 _x = {0u, 0u, 0u, 0u}; if (vhalf == 0) _x[0] = (unsigned)f2bf(_w); *(LAS u32x4*)(_p + 16 + vhalf * 8) = _x; } } while (0)
        f32x4 st = {0.f, 0.f, 0.f, 0.f}, na = {0.f, 0.f, 0.f, 0.f};
#define SCAN_BODY(c, bf) do { { u32x2 _pw; _pw.x = pack2(st[0], st[1]); _pw.y = pack2(st[2], st[3]); *(u32x2*)(cst + (size_t)(c) * HD * HD + (size_t)(vs * 16 + li) * HD + 16 * w + 4 * g) = _pw; } \
        if (type == 0 && vs == 0 && li == 0) *(f32x4*)(nsv + (c) * HD + 16 * w + 4 * g) = na; \
        const float _d = (type == 0) ? __expf(fT[c] + mS[c] - mS[(c) + 1]) : exp2f(64.0f * lg2); st *= _d; na *= _d; \
        _Pragma("unroll") for (int _u = 0; _u < 2; ++_u) { const LAS bf16_t* _kp = Kb + (bf) * 64 * KS2 + (32 * _u + 8 * g + (li >> 2)) * KS2 + 16 * w + 4 * (li & 3); \
            const LAS bf16_t* _wp = Wb + (bf) * 64 * WS2 + (32 * _u + 8 * g + (li >> 2)) * WS2 + 4 * (li & 3); \
            const bf16x8 _A = cat4(lds_tr(_kp), lds_tr(_kp + 4 * KS2)); const bf16x8 _B = cat4(lds_tr(_wp), lds_tr(_wp + 4 * WS2)); \
            st = __builtin_amdgcn_mfma_f32_16x16x32_bf16(_A, _B, st, 0, 0, 0); \
            if (type == 0) { const bf16x8 _B2 = cat4(lds_tr(_wp + 16), lds_tr(_wp + 4 * WS2 + 16)); na = __builtin_amdgcn_mfma_f32_16x16x32_bf16(_A, _B2, na, 0, 0, 0); } } } while (0)
        SCAN_LOAD(0, 0); SCAN_WRITE(0, 0, 0); SCAN_LOAD(1, 1); SCAN_LOAD(2, 0);
        __syncthreads();
        for (int c = 0; c < NCH; c += 2) {
            SCAN_BODY(c, 0);
            SCAN_WRITE(c + 1, 1, 1);
            if (c + 3 < NCH) SCAN_LOAD(c + 3, 1);
            __syncthreads();
            SCAN_BODY(c + 1, 1);
            if (c + 2 < NCH) { SCAN_WRITE(c + 2, 0, 0); }
            if (c + 4 < NCH) SCAN_LOAD(c + 4, 0);
            __syncthreads();
        }
#undef SCAN_LOAD
#undef SCAN_WRITE
#undef SCAN_BODY
    }
}

__device__ __forceinline__ void phase_chunk_mfma(const Frame& F, int l) {
    const KArgs a = F.ka; unsigned char* ws = F.ws_();
    constexpr int QS = 136, VS = 144, PS = 72;
    LAS bf16_t* Qs = (LAS bf16_t*)F.lds; LAS bf16_t* Ks = Qs + 64 * QS; LAS bf16_t* Vs = Ks + 64 * QS; LAS bf16_t* Ps = Vs + 64 * VS;
    LAS float* rv = (LAS float*)(Ps + 64 * PS);
    LAS float* hp = rv + 256;
    const bf16_t* proj = (const bf16_t*)(ws + WS_PROJ); bf16_t* br = (bf16_t*)(ws + WS_BR);
    const float* cumf = (const float*)(ws + WS_CUMF); const float* av = (const float*)(ws + WS_AV); const float* pm = (const float*)(ws + WS_PM); const float* mseq = (const float*)(ws + WS_MSEQ);
    const int lane = F.lane, g = lane >> 4, li = lane & 15, w = F.wave;
    bf16x8 ones;
#pragma unroll
    for (int j = 0; j < 8; ++j) ones[j] = (short)0x3F80;
    u32x4 pq[2], pk[2], pvv[2]; float prv[4] = {0.f, 0.f, 0.f, 0.f};
#define CH_LOAD(it) do { const int _ty = (it) / (NBH * NCH), _bh = ((it) / NCH) % NBH, _c = (it) % NCH, _h = _bh & 3; const int _t0 = (_bh >> 2) * SEQ + _c * CH; \
        const bf16_t* _pr = proj + (size_t)(_t0 + (F.tid >> 3)) * NBR + (F.tid & 7) * 8 + _h * HD; \
        pq[0] = *(const u32x4*)(_pr + (_ty == 0 ? PC_MQ : PC_RQ)); pq[1] = *(const u32x4*)(_pr + (_ty == 0 ? PC_MQ : PC_RQ) + 64); \
        pk[0] = *(const u32x4*)(_pr + (_ty == 0 ? PC_MK : PC_RK)); pk[1] = *(const u32x4*)(_pr + (_ty == 0 ? PC_MK : PC_RK) + 64); \
        pvv[0] = *(const u32x4*)(_pr + (_ty == 0 ? PC_MV : PC_RV)); pvv[1] = *(const u32x4*)(_pr + (_ty == 0 ? PC_MV : PC_RV) + 64); \
        if (_ty == 0 && F.tid < 64) { const size_t _go = (size_t)_bh * SEQ + _c * CH + F.tid; prv[0] = av[_go]; prv[1] = pm[_go]; prv[2] = cumf[_go]; prv[3] = mseq[_bh * 80 + _c]; } } while (0)
    if (F.wg < 2 * NBH * NCH) CH_LOAD(F.wg);
    for (int item = F.wg; item < 2 * NBH * NCH; item += F.nwg) {
        const int type = item / (NBH * NCH), bh = (item / NCH) % NBH, c = item % NCH, b = bh >> 2, h = bh & 3;
        const int t0 = b * SEQ + c * CH; const size_t go = (size_t)bh * SEQ + c * CH;
        const float lg2 = ret_gamma_log2(h);
        const int vc = h * HD + 16 * w + 4 * g;
        u32x2 gate[4]; bf16x8 cfr[4]; f32x4 nr[4][2];
        const f32x4 nw4 = *(const f32x4*)((type == 0 ? ((const float*)a->in[IN_MNORM]) : ((const float*)a->in[IN_RNORM])) + l * W + vc);
#pragma unroll
        for (int tt = 0; tt < 4; ++tt) gate[tt] = *(const u32x2*)(proj + (size_t)(t0 + 16 * tt + li) * NBR + (type == 0 ? PC_MO : PC_RG) + vc);
        if (c > 0) { const bf16_t* cst = (const bf16_t*)(ws + WS_CST) + ((size_t)(type * NBH + bh) * NCH + c) * HD * HD; const float* nsv = (const float*)(ws + WS_NST) + ((size_t)bh * NCH + c) * HD;
#pragma unroll
            for (int kk = 0; kk < 4; ++kk) { cfr[kk] = *(const bf16x8*)(cst + (size_t)(16 * w + li) * HD + kk * 32 + g * 8);
                if (type == 0) { nr[kk][0] = *(const f32x4*)(nsv + kk * 32 + g * 8); nr[kk][1] = *(const f32x4*)(nsv + kk * 32 + g * 8 + 4); } } }
        { const int row = F.tid >> 3, oct = F.tid & 7;
          *(LAS u32x4*)(Qs + row * QS + oct * 8) = pq[0]; *(LAS u32x4*)(Qs + row * QS + 64 + oct * 8) = pq[1];
          *(LAS u32x4*)(Ks + row * QS + oct * 8) = pk[0]; *(LAS u32x4*)(Ks + row * QS + 64 + oct * 8) = pk[1];
          *(LAS u32x4*)(Vs + row * VS + oct * 8) = pvv[0]; *(LAS u32x4*)(Vs + row * VS + 64 + oct * 8) = pvv[1]; }
        if (F.tid < 64) { const int t = F.tid;
            if (type == 0) { const float mp = prv[3]; const float bt = fmaxf(mp, prv[1]); rv[t] = prv[0]; rv[64 + t] = bt; rv[128 + t] = __expf(mp - bt); rv[192 + t] = __expf(-prv[2] - bt); }
            else rv[128 + t] = exp2f((float)(t + 1) * lg2); }
        if (item + F.nwg < 2 * NBH * NCH) CH_LOAD(item + F.nwg);
        __syncthreads();
        { const int tt = w >> 1, t = 16 * tt + li;
#pragma unroll
          for (int sti = 0; sti < 2; ++sti) { const int st = (w & 1) * 2 + sti; f32x4 acc = {0.f, 0.f, 0.f, 0.f};
            if (st <= tt) {
#pragma unroll
                for (int kk = 0; kk < 4; ++kk) { const bf16x8 kf = *(const LAS bf16x8*)(Ks + (16 * st + li) * QS + kk * 32 + g * 8), qf = *(const LAS bf16x8*)(Qs + (16 * tt + li) * QS + kk * 32 + g * 8);
                    acc = __builtin_amdgcn_mfma_f32_16x16x32_bf16(kf, qf, acc, 0, 0, 0); }
#pragma unroll
                for (int r = 0; r < 4; ++r) { const int sx = 16 * st + 4 * g + r; float wgt;
                    if (type == 0) wgt = __expf(rv[sx] - rv[64 + t]); else wgt = exp2f((float)(t - sx) * lg2);
                    acc[r] = (sx <= t) ? acc[r] * wgt : 0.f; } }
            u32x2 pw; pw.x = pack2(acc[0], acc[1]); pw.y = pack2(acc[2], acc[3]); *(LAS u32x2*)(Ps + t * PS + 16 * st + 4 * g) = pw; } }
        __syncthreads();
        f32x4 pv[4], qc[4], dn[4], qn[4];
#pragma unroll
        for (int tt = 0; tt < 4; ++tt) { pv[tt] = (f32x4){0.f, 0.f, 0.f, 0.f}; qc[tt] = pv[tt]; dn[tt] = pv[tt]; qn[tt] = pv[tt]; }
#pragma unroll
        for (int u = 0; u < 2; ++u) {
            const bf16x8 vf = cat4(lds_tr(Vs + (32 * u + 8 * g + (li >> 2)) * VS + 16 * w + 4 * (li & 3)), lds_tr(Vs + (32 * u + 8 * g + 4 + (li >> 2)) * VS + 16 * w + 4 * (li & 3)));
#pragma unroll
            for (int tt = 0; tt < 4; ++tt) { const bf16x8 pf = *(const LAS bf16x8*)(Ps + (16 * tt + li) * PS + 32 * u + 8 * g);
                pv[tt] = __builtin_amdgcn_mfma_f32_16x16x32_bf16(vf, pf, pv[tt], 0, 0, 0);
                if (type == 0) dn[tt] = __builtin_amdgcn_mfma_f32_16x16x32_bf16(ones, pf, dn[tt], 0, 0, 0); } }
        if (c > 0) {
#pragma unroll
            for (int kk = 0; kk < 4; ++kk) { const bf16x8 cf = cfr[kk];
                bf16x8 nf = ones;
                if (type == 0) nf = pack8(nr[kk][0], nr[kk][1]);
#pragma unroll
                for (int tt = 0; tt < 4; ++tt) { const bf16x8 qf = *(const LAS bf16x8*)(Qs + (16 * tt + li) * QS + kk * 32 + g * 8);
                    qc[tt] = __builtin_amdgcn_mfma_f32_16x16x32_bf16(cf, qf, qc[tt], 0, 0, 0);
                    if (type == 0) qn[tt] = __builtin_amdgcn_mfma_f32_16x16x32_bf16(nf, qf, qn[tt], 0, 0, 0); } } }
#pragma unroll
        for (int tt = 0; tt < 4; ++tt) { const int t = 16 * tt + li; const float inter = rv[128 + t]; f32x4 hv;
            if (type == 0) { const float den = inter * qn[tt][0] + dn[tt][0]; const float rd = 1.0f / fmaxf(fabsf(den), rv[192 + t]);
                const u32x2 ow = gate[tt];
                const float o0 = __uint_as_float(ow.x << 16), o1 = __uint_as_float(ow.x & 0xffff0000u), o2 = __uint_as_float(ow.y << 16), o3 = __uint_as_float(ow.y & 0xffff0000u);
                hv[0] = sigmoidf_(o0) * (inter * qc[tt][0] + pv[tt][0]) * rd; hv[1] = sigmoidf_(o1) * (inter * qc[tt][1] + pv[tt][1]) * rd;
                hv[2] = sigmoidf_(o2) * (inter * qc[tt][2] + pv[tt][2]) * rd; hv[3] = sigmoidf_(o3) * (inter * qc[tt][3] + pv[tt][3]) * rd; }
            else hv = pv[tt] + qc[tt] * inter;
            pv[tt] = hv;
            float s1 = (hv[0] + hv[1]) + (hv[2] + hv[3]), s2 = (hv[0] * hv[0] + hv[1] * hv[1]) + (hv[2] * hv[2] + hv[3] * hv[3]);
            s1 += __shfl_xor(s1, 16); s1 += __shfl_xor(s1, 32); s2 += __shfl_xor(s2, 16); s2 += __shfl_xor(s2, 32);
            if (g == 0) { hp[(w * 64 + t) * 2] = s1; hp[(w * 64 + t) * 2 + 1] = s2; } }
        __syncthreads();
#pragma unroll
        for (int tt = 0; tt < 4; ++tt) { const int t = 16 * tt + li; float s1 = 0.f, s2 = 0.f;
#pragma unroll
            for (int ww = 0; ww < 8; ++ww) { const f32x2 p2 = *(const LAS f32x2*)(hp + (ww * 64 + t) * 2); s1 += p2.x; s2 += p2.y; }
            const float mu = s1 * (1.0f / 128.0f), var = fmaxf(s2 * (1.0f / 128.0f) - mu * mu, 0.f), rstd = rsqrtf(var + LN_EPS);
            f32x4 y = (pv[tt] - mu) * rstd * nw4;
            if (type == 1) { const u32x2 gw = gate[tt];
                const float g0 = __uint_as_float(gw.x << 16), g1 = __uint_as_float(gw.x & 0xffff0000u), g2 = __uint_as_float(gw.y << 16), g3 = __uint_as_float(gw.y & 0xffff0000u);
                y[0] *= g0 * sigmoidf_(g0); y[1] *= g1 * sigmoidf_(g1); y[2] *= g2 * sigmoidf_(g2); y[3] *= g3 * sigmoidf_(g3); }
            st_bf16x4(br + (size_t)(t0 + t) * D + (type == 0 ? 1024 : 1536) + vc, y); }
        __syncthreads();
    }
#undef CH_LOAD
}

__device__ __forceinline__ void ln_row(float (&v)[32], const float* lw, const float* lb, int lane) {
    float s = 0.f;
#pragma unroll
    for (int j = 0; j < 32; ++j) s += v[j];
    const float mu = wave_sum(s) * (1.0f / D); float q = 0.f;
#pragma unroll
    for (int j = 0; j < 32; ++j) { const float d = v[j] - mu; q += d * d; }
    const float rstd = rsqrtf(wave_sum(q) * (1.0f / D) + LN_EPS);
#pragma unroll
    for (int j = 0; j < 4; ++j)
#pragma unroll
        for (int h = 0; h < 2; ++h) { const f32x4 w4 = *(const f32x4*)(lw + j * 512 + lane * 8 + h * 4), b4 = *(const f32x4*)(lb + j * 512 + lane * 8 + h * 4);
#pragma unroll
            for (int e = 0; e < 4; ++e) v[j * 8 + h * 4 + e] = (v[j * 8 + h * 4 + e] - mu) * rstd * w4[e] + b4[e]; }
}
__device__ __forceinline__ void phase_ln(const Frame& F, const bf16_t* y, const float* lw, const float* lb, bf16_t* xb, unsigned char* xb8) {
    for (int row = F.wg * 8 + F.wave; row < T; row += F.nwg * 8) {
        float v[32]; ld_row32(y + (size_t)row * D, F.lane, v);
        ln_row(v, lw, lb, F.lane);
        st_row32(xb + (size_t)row * D, F.lane, v); st_row32_fp8(xb8 + (size_t)row * D, F.lane, v);
    }
}
__device__ __forceinline__ void split8(f32x4 a, f32x4 b, bf16x8& hi, bf16x8& lo) {
    union { u32x4 u; bf16x8 h; } H, L;
#pragma unroll
    for (int j = 0; j < 2; ++j) { const bf16_t h0 = f2bf(a[2 * j]), h1 = f2bf(a[2 * j + 1]); H.u[j] = (unsigned)h0 | ((unsigned)h1 << 16); L.u[j] = pack2(a[2 * j] - bf2f(h0), a[2 * j + 1] - bf2f(h1)); }
#pragma unroll
    for (int j = 0; j < 2; ++j) { const bf16_t h0 = f2bf(b[2 * j]), h1 = f2bf(b[2 * j + 1]); H.u[2 + j] = (unsigned)h0 | ((unsigned)h1 << 16); L.u[2 + j] = pack2(b[2 * j] - bf2f(h0), b[2 * j + 1] - bf2f(h1)); }
    hi = H.h; lo = L.h; }
__device__ __forceinline__ void phase_ln_router(const Frame& F, int l, const bf16_t* y, bf16_t* xb) {
    const KArgs a = F.ka;
    unsigned char* ws = F.ws_();
    constexpr int XS = D + 8, RB = 32;
    LAS bf16_t* xsh = (LAS bf16_t*)F.lds;
    LAS float* part = (LAS float*)F.lds;
    LAS int* lcnt = (LAS int*)(xsh + RB * XS);
    if (F.tid < 128) lcnt[F.tid] = 0;
    __syncthreads();
    const float* lw = ((const float*)a->in[IN_LNW]) + ((size_t)l * 3 + 1) * D; const float* lb = ((const float*)a->in[IN_LNB]) + ((size_t)l * 3 + 1) * D;
    const bf16_t* rwt = (const bf16_t*)(ws + WS_RWT) + (size_t)l * 2 * NE * D; const float* rb = ((const float*)a->in[IN_RB]) + l * NE;
    unsigned* counts = (unsigned*)(ws + WS_CTL) + CW_COUNTS + l * 64;
    int* eid = (int*)(ws + WS_EID); float* ew = (float*)(ws + WS_EW); int* epos = (int*)(ws + WS_EPOS);
    const int lane = F.lane, g = lane >> 4, li = lane & 15, nt = F.wave & 3, kh = F.wave >> 2;
    for (int blk = F.wg; blk < T / RB; blk += F.nwg) {
        for (int rr = 0; rr < 4; ++rr) {
            const int lr = F.wave * 4 + rr, row = blk * RB + lr;
            float v[32]; ld_row32(y + (size_t)row * D, F.lane, v);
            ln_row(v, lw, lb, F.lane);
            st_row32(xb + (size_t)row * D, F.lane, v); st_row32_fp8(ws + WS_XB8 + (size_t)row * D, F.lane, v);
#pragma unroll
            for (int j = 0; j < 4; ++j) { u32x4 hi;
#pragma unroll
                for (int e2 = 0; e2 < 4; ++e2) hi[e2] = pack2(v[j * 8 + 2 * e2], v[j * 8 + 2 * e2 + 1]);
                *(LAS u32x4*)(xsh + lr * XS + j * 512 + F.lane * 8) = hi; }
        }
        __syncthreads();
        f32x4 acc[2] = {{0.f, 0.f, 0.f, 0.f}, {0.f, 0.f, 0.f, 0.f}};
        { const bf16_t* wh = rwt + (size_t)(16 * nt + li) * D + kh * 1024 + g * 8; const bf16_t* wl = wh + (size_t)NE * D;
          const LAS bf16_t* xr = xsh + li * XS + kh * 1024 + g * 8;
#pragma unroll 8
          for (int ks = 0; ks < 32; ++ks) { const bf16x8 bh = *(const bf16x8*)(wh + ks * 32), bl = *(const bf16x8*)(wl + ks * 32);
#pragma unroll
              for (int mt = 0; mt < 2; ++mt) { const bf16x8 xh = *(const LAS bf16x8*)(xr + mt * 16 * XS + ks * 32);
                  acc[mt] = __builtin_amdgcn_mfma_f32_16x16x32_bf16(xh, bh, acc[mt], 0, 0, 0); acc[mt] = __builtin_amdgcn_mfma_f32_16x16x32_bf16(xh, bl, acc[mt], 0, 0, 0); } } }
        __syncthreads();
#pragma unroll
        for (int mt = 0; mt < 2; ++mt)
#pragma unroll
            for (int r = 0; r < 4; ++r) part[(kh * RB + 16 * mt + 4 * g + r) * 64 + 16 * nt + li] = acc[mt][r];
        __syncthreads();
        const int e = F.lane;
        const float bias = rb[e];
        for (int rr = 0; rr < 4; ++rr) {
            const int lr = F.wave * 4 + rr, row = blk * RB + lr;
            const float sc = sigmoidf_(part[lr * 64 + e] + part[(RB + lr) * 64 + e]), bs = sc + bias;
            float m1 = bs; m1 = fmaxf(m1, __shfl_xor(m1, 1)); m1 = fmaxf(m1, __shfl_xor(m1, 2)); m1 = fmaxf(m1, __shfl_xor(m1, 4));
            const unsigned long long eq = __ballot(bs == m1); const int gq = e >> 3; const unsigned gm = (unsigned)(eq >> (gq * 8)) & 0xffu; const int first = gq * 8 + __builtin_ctz(gm);
            float m2 = (e == first) ? -INFINITY : bs; m2 = fmaxf(m2, __shfl_xor(m2, 1)); m2 = fmaxf(m2, __shfl_xor(m2, 2)); m2 = fmaxf(m2, __shfl_xor(m2, 4));
            const float gs = m1 + m2;
            int grank = 0;
#pragma unroll
            for (int g2 = 0; g2 < 8; ++g2) { const float o = __shfl(gs, g2 * 8); grank += (o > gs || (o == gs && g2 < gq)) ? 1 : 0; }
            const bool gsel = grank < 4;
            const float val = gsel ? bs : -INFINITY;
            int rank = 0;
            for (int e2 = 0; e2 < 64; ++e2) { const float o = __shfl(val, e2); rank += (o > val || (o == val && e2 < e)) ? 1 : 0; }
            const bool sel = gsel && rank < TOPK;
            const float wsum = wave_sum(sel ? sc : 0.f);
            const unsigned long long sm = __ballot(sel);
            if (sel) { const int k = __builtin_popcountll(sm & ((1ull << e) - 1ull));
                const int pos = __hip_atomic_fetch_add((int*)lcnt + e, 1, __ATOMIC_RELAXED, __HIP_MEMORY_SCOPE_WORKGROUP);
                eid[(size_t)row * 8 + k] = e; ew[(size_t)row * 8 + k] = sc / wsum * ROUTE_SCALE; epos[(size_t)row * 8 + k] = pos; }
        }
        __syncthreads();
    }
    if (F.tid < 64) { const int n = lcnt[F.tid]; lcnt[64 + F.tid] = n > 0 ? (int)__hip_atomic_fetch_add(counts + F.tid, (unsigned)n, __ATOMIC_RELAXED, __HIP_MEMORY_SCOPE_AGENT) : 0; }
    asm volatile("s_waitcnt vmcnt(0)" ::: "memory");
    __syncthreads();
    for (int blk = F.wg; blk < T / RB; blk += F.nwg) { if (F.tid < RB * 8) { const size_t i = (size_t)blk * (RB * 8) + F.tid; epos[i] += lcnt[64 + eid[i]]; } }
    __syncthreads();
}
__device__ __forceinline__ void build_pstart(const Frame& F, int l, LAS int* pst) {
    const unsigned* counts = (const unsigned*)(F.ws_() + WS_CTL) + CW_COUNTS + l * 64;
    if (F.tid < 64) {
        const int c = (int)__hip_atomic_load(counts + F.tid, __ATOMIC_RELAXED, __HIP_MEMORY_SCOPE_AGENT); const int pc = (c + 255) & ~255; int inc = pc;
#pragma unroll
        for (int o = 1; o < 64; o <<= 1) { const int n = __shfl_up(inc, o); if (F.tid >= o) inc += n; }
        pst[F.tid] = inc - pc; if (F.tid == 63) { pst[NE] = inc; pst[NE + 1] = inc + T; } }
    __syncthreads();
    { LAS unsigned char* texp = (LAS unsigned char*)(pst + 68);
      for (int rt = F.tid; rt < (pst[NE + 1] >> 8); rt += NTHR) { int e = 0; while (e < NE && pst[e + 1] <= rt * 256) ++e; texp[rt] = (unsigned char)e; } }
    __syncthreads();
}
__device__ __forceinline__ void phase_slots(const Frame& F, int l) {
    unsigned char* ws = F.ws_();
    LAS int* pst = (LAS int*)F.lds;
    build_pstart(F, l, pst);
    const unsigned* counts = (const unsigned*)(ws + WS_CTL) + CW_COUNTS + l * 64;
    const int* eid = (const int*)(ws + WS_EID); const float* ew = (const float*)(ws + WS_EW); const int* epos = (const int*)(ws + WS_EPOS);
    int* slotof = (int*)(ws + WS_SLOTOF); int* tok = (int*)(ws + WS_TOK); float* wsl = (float*)(ws + WS_WSL);
    const size_t gtid = (size_t)F.wg * NTHR + F.tid, gn = (size_t)F.nwg * NTHR;
    for (size_t i = gtid; i < (size_t)T * 8; i += gn) { const int e = eid[i]; const int slot = pst[e] + epos[i]; slotof[i] = slot; tok[slot] = (int)(i >> 3); wsl[slot] = ew[i]; }
    for (size_t i = gtid; i < (size_t)NE * 256; i += gn) { const int e = (int)(i >> 8), r = (int)(i & 255); const int c = (int)counts[e]; const int slot = pst[e] + c + r; if (slot < pst[e + 1]) { tok[slot] = 0; wsl[slot] = 0.f; } }
    for (size_t i = gtid; i < (size_t)T; i += gn) { tok[pst[NE] + i] = (int)i; wsl[pst[NE] + i] = 1.0f; }
    __syncthreads();
}
__device__ __forceinline__ void phase_combine_ln(const Frame& F, int l, bf16_t* xb, float* out) {
    const KArgs a = F.ka;
    unsigned char* ws = F.ws_();
    LAS int* pst = (LAS int*)F.lds;
    build_pstart(F, l, pst);
    const int sh0 = pst[NE];
    const int* slotof = (const int*)(ws + WS_SLOTOF); const unsigned char* yb = ws + WS_YB;
    const float* lw = ((const float*)a->in[IN_LNW]) + ((size_t)l * 3 + 2) * D; const float* lb = ((const float*)a->in[IN_LNB]) + ((size_t)l * 3 + 2) * D;
    for (int row = F.wg * 8 + F.wave; row < T; row += F.nwg * 8) {
        float v[32]; ld_row32(xb + (size_t)row * D, F.lane, v);
#pragma unroll
        for (int j = 0; j < 32; ++j) v[j] *= ALPHA;
        float ys[32];
#pragma unroll
        for (int j = 0; j < 32; ++j) ys[j] = 0.f;
#pragma unroll 3
        for (int k = 0; k < 9; ++k) { const int slot = k < 8 ? slotof[(size_t)row * 8 + k] : sh0 + row; const unsigned char* yr = yb + (size_t)slot * D;
#pragma unroll
            for (int j = 0; j < 4; ++j) { const u32x2 w = *(const u32x2*)(yr + j * 512 + F.lane * 8);
                const f32x2 p0 = __builtin_amdgcn_cvt_pk_f32_fp8((int)w.x, false), p1 = __builtin_amdgcn_cvt_pk_f32_fp8((int)w.x, true), p2 = __builtin_amdgcn_cvt_pk_f32_fp8((int)w.y, false), p3 = __builtin_amdgcn_cvt_pk_f32_fp8((int)w.y, true);
                ys[j * 8] += p0.x; ys[j * 8 + 1] += p0.y; ys[j * 8 + 2] += p1.x; ys[j * 8 + 3] += p1.y; ys[j * 8 + 4] += p2.x; ys[j * 8 + 5] += p2.y; ys[j * 8 + 6] += p3.x; ys[j * 8 + 7] += p3.y; } }
#pragma unroll
        for (int j = 0; j < 32; ++j) v[j] += ys[j] * (1.0f / Y8_SCALE);
        ln_row(v, lw, lb, F.lane);
        if (out) {
#pragma unroll
            for (int j = 0; j < 4; ++j) { *(f32x4*)(out + (size_t)row * D + j * 512 + F.lane * 8) = (f32x4){v[j * 8], v[j * 8 + 1], v[j * 8 + 2], v[j * 8 + 3]}; *(f32x4*)(out + (size_t)row * D + j * 512 + F.lane * 8 + 4) = (f32x4){v[j * 8 + 4], v[j * 8 + 5], v[j * 8 + 6], v[j * 8 + 7]}; }
        } else { st_row32(xb + (size_t)row * D, F.lane, v); st_row32_fp8(ws + WS_XB8 + (size_t)row * D, F.lane, v); st_row32_i8(ws + WS_XQ8 + (size_t)row * D, (float*)(ws + WS_XSC) + row, F.lane, v); }
    }
    __syncthreads();
}

__device__ __forceinline__ void phase_attn_mfma(const Frame& F, int l) {
    unsigned char* ws = F.ws_();
    constexpr int KS = 136, VS = 144;
    LAS bf16_t* Ks = (LAS bf16_t*)F.lds; LAS bf16_t* Vs = Ks + 256 * KS;
    const bf16_t* q = (const bf16_t*)(ws + WS_Q); const bf16_t* km = (const bf16_t*)(ws + WS_KM) + (size_t)l * TM * W; const bf16_t* vm = (const bf16_t*)(ws + WS_VM) + (size_t)l * TM * W;
    bf16_t* o = (bf16_t*)(ws + WS_O);
    const int nunit = (T / 128) * 4, upw = (nunit + F.nwg - 1) / F.nwg;
    const int lane = F.lane, g = lane >> 4, li = lane & 15;
    int loaded = -1;
    const int u_end = (F.wg + 1) * upw < nunit ? (F.wg + 1) * upw : nunit;
    for (int u = F.wg * upw; u < u_end; ++u) {
        const int bh = u >> 5, blk = u & 31, b = bh >> 2, hh = bh & 3;
        if (bh != loaded) {
            __syncthreads();
            const int m = F.tid >> 1, half = F.tid & 1;
            const bf16_t* kr = km + (size_t)(b * MEM + m) * W + hh * HD + half * 64; const bf16_t* vr = vm + (size_t)(b * MEM + m) * W + hh * HD + half * 64;
#pragma unroll
            for (int j = 0; j < 8; ++j) { *(LAS u32x4*)(Ks + m * KS + half * 64 + j * 8) = *(const u32x4*)(kr + j * 8); *(LAS u32x4*)(Vs + m * VS + half * 64 + j * 8) = *(const u32x4*)(vr + j * 8); }
            __syncthreads(); loaded = bh;
        }
        const int t0 = b * SEQ + blk * 128 + F.wave * 16;
        bf16x8 qf[4];
#pragma unroll
        for (int kk = 0; kk < 4; ++kk) qf[kk] = *(const bf16x8*)(q + (size_t)(t0 + li) * W + hh * HD + kk * 32 + g * 8);
        f32x4 sacc[16];
#pragma unroll
        for (int tt = 0; tt < 16; ++tt) { f32x4 acc = {0.f, 0.f, 0.f, 0.f};
#pragma unroll
            for (int kk = 0; kk < 4; ++kk) { const bf16x8 kf = *(const LAS bf16x8*)(Ks + (16 * tt + li) * KS + kk * 32 + g * 8); acc = __builtin_amdgcn_mfma_f32_16x16x32_bf16(kf, qf[kk], acc, 0, 0, 0); }
            sacc[tt] = acc; }
        float mx = -INFINITY;
#pragma unroll
        for (int tt = 0; tt < 16; ++tt) mx = fmaxf(mx, fmaxf(fmaxf(sacc[tt][0], sacc[tt][1]), fmaxf(sacc[tt][2], sacc[tt][3])));
        mx = fmaxf(mx, __shfl_xor(mx, 16)); mx = fmaxf(mx, __shfl_xor(mx, 32));
        const float c2 = 0.08838834764831845f * 1.4426950408889634f; float sum = 0.f;
#pragma unroll
        for (int tt = 0; tt < 16; ++tt)
#pragma unroll
            for (int r = 0; r < 4; ++r) { const float p = exp2f((sacc[tt][r] - mx) * c2); sacc[tt][r] = p; sum += p; }
        sum += __shfl_xor(sum, 16); sum += __shfl_xor(sum, 32);
        const float rs = 1.0f / sum;
        bf16x8 pk[8];
#pragma unroll
        for (int u8 = 0; u8 < 8; ++u8) pk[u8] = pack8(sacc[2 * u8], sacc[2 * u8 + 1]);
#pragma unroll
        for (int dvt = 0; dvt < 8; ++dvt) { f32x4 acc = {0.f, 0.f, 0.f, 0.f};
#pragma unroll
            for (int u8 = 0; u8 < 8; ++u8) { const s16x4 a0 = lds_tr(Vs + (32 * u8 + 4 * g + (li >> 2)) * VS + dvt * 16 + 4 * (li & 3)); const s16x4 a1 = lds_tr(Vs + (32 * u8 + 16 + 4 * g + (li >> 2)) * VS + dvt * 16 + 4 * (li & 3));
                acc = __builtin_amdgcn_mfma_f32_16x16x32_bf16(cat4(a0, a1), pk[u8], acc, 0, 0, 0); }
            st_bf16x4(o + (size_t)(t0 + li) * W + hh * HD + dvt * 16 + 4 * g, acc * rs); }
    }
    __syncthreads();
}

template <class Epi>
__device__ __forceinline__ void gemm_dense_mfma(const Frame& F, const bf16_t* A, const bf16_t* Bt, int M, int N, int K, const Epi& E) {
    DenseSched S; S.A = A; S.Bt = Bt; S.K = K; S.nM = M / 256; S.nN = N / 256; S.nwg = S.nM * S.nN; S.G = F.nwg; S.c = F.wg; S.i0 = 0; S.i1 = 1 << 30; S.pnoff = 0;
    gemm_phase_mfma(F, K, S, E);
}
constexpr int NPL = 15, NPHASE = 1 + DEPTH * NPL;
#ifndef NCONV
#define NCONV 40
#endif
#if MK_PER_PHASE
#define IN(k) (lo <= (k) && (k) < hi)
#define SEAM(k) do { if (IN((k) + 1)) { XcdBarrier b2_ = bar; asm volatile("" : "+s"(b2_.bar)); asm volatile("" : "+s"(b2_.x)); xcd_barrier(b2_); } } while (0)
#else
#define IN(k) true
#define SEAM(k) do { if ((k) + 1 < NPHASE) for (int rb_ = 0; rb_ < ((PROBE_DBL & 4096) ? 3 : 1); ++rb_) { XcdBarrier b2_ = bar; asm volatile("" : "+s"(b2_.bar)); asm volatile("" : "+s"(b2_.x)); xcd_barrier(b2_); } } while (0)
#endif
template <int l> __device__ __forceinline__ void run_layer(const Frame& F0, const XcdBarrier& bar, int lo, int hi) {
    const int pb = 1 + l * NPL;
    if (IN(pb + 0)) { const Frame F = fresh(F0); unsigned char* ws = F.ws_();
        EpiProj E{(bf16_t*)(ws + WS_PROJ), (bf16_t*)(ws + WS_GATES)};
        { DenseSched S; S.A = (const bf16_t*)(ws + WS_XQ8); S.Bt = (const bf16_t*)(ws + WS_WINQ + l * SZ_WINQ); S.K = D / 2; S.nM = T / 256; S.nN = NBR / 256; S.nwg = S.nM * S.nN; S.G = F.nwg; S.c = F.wg; S.i0 = 0; S.i1 = 1 << 30; S.pnoff = 0;
          const float wsc = __uint_as_float(((const unsigned*)(ws + WS_CTL))[CW_WABS + l]) * (1.0f / 127.0f);
          gemm_phase_mfma<EpiProj, DenseSched, 2>(F, D, S, E, wsc, (const float*)(ws + WS_XSC)); }
        { const Frame F2 = fresh(F0); unsigned char* ws2 = F2.ws_(); EpiProj E2{(bf16_t*)(ws2 + WS_PROJ), (bf16_t*)(ws2 + WS_GATES)};
          DenseSched S; S.A = (const bf16_t*)(ws2 + WS_XB8); S.Bt = (const bf16_t*)(ws2 + WS_WIN8 + l * SZ_WIN8 + (size_t)NBR * D); S.K = D / 2; S.nM = T / 256; S.nN = (NPROJ - NBR) / 256; S.nwg = S.nM * S.nN; S.G = F2.nwg; S.c = F2.wg; S.i0 = 0; S.i1 = 1 << 30; S.pnoff = NBR / 256;
          gemm_phase_mfma<EpiProj, DenseSched, 1>(F2, D, S, E2, 1.0f / (X8_SCALE * W8_SCALE)); if (PROBE_DBL & 64) gemm_phase_mfma<EpiProj, DenseSched, 1>(F2, D, S, E2, 1.0f / (X8_SCALE * W8_SCALE)); }
        SEAM(pb + 0); }
    if (IN(pb + 1)) { const Frame F = fresh(F0); phase_mix1v2(F, l, (const bf16_t*)(F.ws_() + WS_XB)); if (PROBE_DBL & 8192) { const Frame G = fresh(F0); phase_mix1v2<false>(G, l, (const bf16_t*)(G.ws_() + WS_XB)); } SEAM(pb + 1); }
    if (IN(pb + 2)) { const Frame F = fresh(F0); phase_scan_mfma(F); if (PROBE_DBL & 2) { const Frame G = fresh(F0); phase_scan_mfma(G); } SEAM(pb + 2); }
    if (IN(pb + 3)) { const Frame F = fresh(F0); phase_chunk_mfma(F, l); if (PROBE_DBL & 4) { const Frame G = fresh(F0); phase_chunk_mfma(G, l); } SEAM(pb + 3); }
    if (IN(pb + 4)) { const Frame F = fresh(F0); unsigned char* ws = F.ws_();
        EpiBranch E{ws + WS_GATES, ws + WS_MRG}; gemm_dense_mfma(F, (const bf16_t*)(ws + WS_BR), (const bf16_t*)(ws + WS_WB + l * SZ_DD), T, D, D, E); SEAM(pb + 4); }
    if (IN(pb + 5)) { const Frame F = fresh(F0); unsigned char* ws = F.ws_();
        EpiResid E{(const bf16_t*)(ws + WS_XB), (bf16_t*)(ws + WS_Y)};
        DenseSched S; S.A = (const bf16_t*)(ws + WS_MRG); S.Bt = (const bf16_t*)(ws + WS_WOUT + l * SZ_DD); S.K = D / 2; S.nM = T / 256; S.nN = D / 256; S.nwg = S.nM * S.nN; S.G = F.nwg; S.c = F.wg; S.i0 = 0; S.i1 = 1 << 30; S.pnoff = 0;
        gemm_phase_mfma<EpiResid, DenseSched, 1>(F, D, S, E, 1.0f / (X8_SCALE * W8_SCALE)); SEAM(pb + 5); }
    if (IN(pb + 6)) { const Frame F = fresh(F0); unsigned char* ws = F.ws_();
        phase_ln(F, (const bf16_t*)(ws + WS_Y), ((const float*)F.ka->in[IN_LNW]) + (size_t)l * 3 * D, ((const float*)F.ka->in[IN_LNB]) + (size_t)l * 3 * D, (bf16_t*)(ws + WS_XB), ws + WS_XB8); SEAM(pb + 6); }
    if (IN(pb + 7)) { const Frame F = fresh(F0);
        EpiQKV E{}; { QSched S; S.ws = F.ws_(); S.l = l; S.G = F.nwg; S.c = F.wg; gemm_phase_mfma<EpiQKV, QSched, 1>(F, D, S, E, 1.0f / (X8_SCALE * W8_SCALE)); }
        { KvSched S; S.ws = F.ws_(); S.l = l; S.G = F.nwg; S.c = F.wg; gemm_phase_mfma(F, D, S, E); } SEAM(pb + 7); }
    if (IN(pb + 8)) { const Frame F = fresh(F0); phase_attn_mfma(F, l); if (PROBE_DBL & 8) { const Frame G = fresh(F0); phase_attn_mfma(G, l); } SEAM(pb + 8); }
    if (IN(pb + 9)) { const Frame F = fresh(F0); unsigned char* ws = F.ws_();
        EpiResid E{(const bf16_t*)(ws + WS_XB), (bf16_t*)(ws + WS_Y)}; gemm_dense_mfma(F, (const bf16_t*)(ws + WS_O), (const bf16_t*)(ws + WS_WO + l * SZ_WQ), T, D, W, E); if (PROBE_DBL & 2048) gemm_dense_mfma(F, (const bf16_t*)(ws + WS_O), (const bf16_t*)(ws + WS_WO + l * SZ_WQ), T, D, W, E); SEAM(pb + 9); }
    if (IN(pb + 10)) { const Frame F = fresh(F0); unsigned char* ws = F.ws_(); phase_ln_router(F, l, (const bf16_t*)(ws + WS_Y), (bf16_t*)(ws + WS_XB)); SEAM(pb + 10); }
    if (IN(pb + 11)) { const Frame F = fresh(F0); phase_slots(F, l); if (PROBE_DBL & 16) { const Frame G = fresh(F0); phase_slots(G, l); } SEAM(pb + 11); }
    if (IN(pb + 12)) { const Frame F = fresh(F0); unsigned char* ws = F.ws_();
        LAS int* pst = (LAS int*)(F.lds + LDS_BYTES - 1024); build_pstart(F, l, pst);
        const int nrt = pst[NE + 1] >> 8; EpiSwiglu E{(const float*)(ws + WS_WSL), ws + WS_HB};
        MoeSched<4, true> S; S.ws = ws; S.pst = pst; S.l = l; S.G = F.nwg; S.c = F.wg; S.nunits = nrt * 4; gemm_phase_mfma<EpiSwiglu, MoeSched<4, true>, 1>(F, D, S, E, 1.0f / (X8_SCALE * W8_SCALE)); SEAM(pb + 12); }
    if (IN(pb + 13)) { const Frame F = fresh(F0); unsigned char* ws = F.ws_();
        LAS int* pst = (LAS int*)(F.lds + LDS_BYTES - 1024); build_pstart(F, l, pst);
        const int nrt = pst[NE + 1] >> 8; EpiDown E{ws + WS_YB};
        MoeSched<8, false> S; S.ws = ws; S.pst = pst; S.l = l; S.G = F.nwg; S.c = F.wg; S.nunits = nrt * 8; gemm_phase_mfma<EpiDown, MoeSched<8, false>, 1>(F, ED, S, E, Y8_SCALE / (H8_SCALE * W8_SCALE)); SEAM(pb + 13); }
    if (IN(pb + 14)) { const Frame F = fresh(F0); phase_combine_ln(F, l, (bf16_t*)(F.ws_() + WS_XB), l == DEPTH - 1 ? ((float*)F.ka->out) : (float*)nullptr); if ((PROBE_DBL & 16384) && l == DEPTH - 1) { const Frame G = fresh(F0); phase_combine_ln(G, l, (bf16_t*)(G.ws_() + WS_XB), ((float*)G.ka->out)); } SEAM(pb + 14); }
}

__global__ void __launch_bounds__(NTHR, 2) fwd(Args args_unused) {
    extern __shared__ __attribute__((aligned(16))) unsigned char lds_raw[];
    Frame F0; F0.lds = (LAS unsigned char*)lds_raw; F0.tid = threadIdx.x; F0.lane = F0.tid & 63; F0.wave = __builtin_amdgcn_readfirstlane(F0.tid >> 6); F0.wg = blockIdx.x; F0.nwg = gridDim.x;
    F0.ka = (KArgs)__builtin_amdgcn_kernarg_segment_ptr(); F0.wsg = F0.ka->ws;
    volatile LAS unsigned* xbw = (volatile LAS unsigned*)(F0.lds + LDS_BYTES - 16);
    if (F0.tid == 0) { xbw[0] = 0u; xbw[1] = 0u; }
    __syncthreads();
    XcdBarrier bar; bar.bar = (unsigned*)(F0.ws_() + WS_CTL); bar.x = 0; bar.st = xbw;
#if MK_PER_PHASE
    const int lo = F0.ka->ph_lo, hi = F0.ka->ph_hi;
    if (hi - lo > 1) bar = xcd_barrier_post((unsigned*)(F0.ws_() + WS_CTL), xbw);
#else
    const int lo = 0, hi = NPHASE;
    bar = xcd_barrier_post((unsigned*)(F0.ws_() + WS_CTL), xbw);
#endif
    if (IN(0)) { { const Frame F = fresh(F0); phase_wabs(F); } { XcdBarrier b2_ = bar; asm volatile("" : "+s"(b2_.bar)); asm volatile("" : "+s"(b2_.x)); xcd_barrier(b2_); }
        const Frame F = fresh(F0); phase_prologue(F); { const Frame G = fresh(F0); prologue_deferred(G, G.wg, G.nwg); } SEAM(0); }
    run_layer<0>(F0, bar, lo, hi);
    run_layer<1>(F0, bar, lo, hi);
#undef IN
#undef SEAM
}

extern "C" void kernel_launch(void* const* d_in, const int* in_sizes, int n_in, void* d_out, int out_size, void* d_ws, size_t ws_size, hipStream_t stream) {
    static int grid = 0;
    if (grid == 0) {
        if (n_in != 23 || ws_size < WS_END) { fprintf(stderr, "kernel_launch: unexpected inputs (n_in %d, ws %zu < %zu)\n", n_in, ws_size, (size_t)WS_END); grid = -1; return; }
        int dev = 0, cus = 0, per_cu = 0;
        if (hipGetDevice(&dev) != hipSuccess || hipDeviceGetAttribute(&cus, hipDeviceAttributeMultiprocessorCount, dev) != hipSuccess) { grid = -1; return; }
        if (hipFuncSetAttribute((const void*)fwd, hipFuncAttributeMaxDynamicSharedMemorySize, LDS_BYTES) != hipSuccess) { fprintf(stderr, "kernel_launch: hipFuncSetAttribute failed\n"); grid = -1; return; }
        if (hipOccupancyMaxActiveBlocksPerMultiprocessor(&per_cu, (const void*)fwd, NTHR, LDS_BYTES) != hipSuccess || per_cu < 1) { fprintf(stderr, "kernel_launch: occupancy query says %d\n", per_cu); }
        (void)hipGetLastError();
        grid = cus;
    }
    if (grid < 0) return;
    (void)hipMemsetAsync((char*)d_ws + WS_CTL, 0, CTL_BYTES, stream);
    Args a{};
    for (int i = 0; i < 23; ++i) a.in[i] = (const float*)d_in[i];
    a.out = (float*)d_out; a.ws = (unsigned char*)d_ws;
#if MK_PER_PHASE
    for (int p = 0; p < NPHASE; ++p) { a.ph_lo = p; a.ph_hi = p + 1; hipLaunchKernelGGL(fwd, dim3(grid), dim3(NTHR), LDS_BYTES, stream, a); }
#else
    a.ph_lo = 0; a.ph_hi = NPHASE;
    hipLaunchKernelGGL(fwd, dim3(grid), dim3(NTHR), LDS_BYTES, stream, a);
#endif
    const hipError_t le = hipPeekAtLastError();
    if (le != hipSuccess) fprintf(stderr, "kernel_launch: launch failed: %s\n", hipGetErrorName(le));
}
```

```cpp
#include <hip/hip_runtime.h>
#include <cstdio>
#include <cstdint>

#ifndef PROBE_DBL
#define PROBE_DBL 0
#endif
#ifndef MK_PER_PHASE
#define MK_PER_PHASE 0
#endif

typedef unsigned short bf16_t;
typedef float f32x4 __attribute__((ext_vector_type(4)));
typedef float f32x2 __attribute__((ext_vector_type(2)));
typedef unsigned u32x4 __attribute__((ext_vector_type(4)));
typedef unsigned u32x2 __attribute__((ext_vector_type(2)));
#define LAS __attribute__((address_space(3)))

constexpr int BATCH = 4, SEQ = 4096, T = BATCH * SEQ, D = 2048, DEPTH = 2;
constexpr int W = 512, NH = 4, HD = 128, CH = 64, NCH = SEQ / CH, NBH = BATCH * NH;
constexpr int PROJ_W = 14344, NBR = 6144, NPROJ = 14336;
constexpr int MEM = 256, TM = BATCH * MEM;
constexpr int NE = 64, NEX = 65, TOPK = 8, ED = 512;
constexpr int NSLOT = 164096;
constexpr float LN_EPS = 1e-5f, ALPHA = 1.41421356237f, ROUTE_SCALE = 2.5f;
constexpr int NTHR = 512;

constexpr int PC_U = 0, PC_CH = 512, PC_CB = 1024, PC_CC = 1536, PC_MQ = 2048, PC_MK = 2560, PC_MV = 3072, PC_MO = 3584, PC_RQ = 4096, PC_RK = 4608, PC_RV = 5120, PC_RG = 5632;

constexpr size_t al256(size_t x) { return (x + 255) & ~(size_t)255; }
constexpr size_t WS_CTL = 0;
constexpr size_t CTL_BYTES = 65536;
constexpr int CW_COUNTS = 8192;
constexpr size_t WS_WIN = WS_CTL + CTL_BYTES;
constexpr size_t SZ_WIN = (size_t)NPROJ * D * 2;
constexpr size_t WS_WIF = WS_WIN + DEPTH * SZ_WIN;
constexpr size_t SZ_WIF = 8 * D * 4;
constexpr size_t WS_WB = WS_WIF + DEPTH * SZ_WIF;
constexpr size_t SZ_DD = (size_t)D * D * 2;
constexpr size_t WS_WOUT = WS_WB + DEPTH * SZ_DD;
constexpr size_t WS_WQ = WS_WOUT + DEPTH * SZ_DD;
constexpr size_t SZ_WQ = (size_t)W * D * 2;
constexpr size_t WS_WK = WS_WQ + DEPTH * SZ_WQ;
constexpr size_t WS_WV = WS_WK + DEPTH * SZ_WQ;
constexpr size_t WS_WO = WS_WV + DEPTH * SZ_WQ;
constexpr size_t WS_WGU = WS_WO + DEPTH * SZ_WQ;
constexpr size_t SZ_WGU1 = (size_t)1024 * D * 2;
constexpr size_t WS_WDN = WS_WGU + (size_t)DEPTH * NEX * SZ_WGU1;
constexpr size_t SZ_WDN1 = (size_t)D * ED * 2;
constexpr size_t WS_ROPE = WS_WDN + (size_t)DEPTH * NEX * SZ_WDN1;
constexpr size_t WS_X = WS_ROPE + (size_t)SEQ * 64 * 4 * 2;
constexpr size_t SZ_TD4 = (size_t)T * D * 4;
constexpr size_t WS_Y = WS_X + SZ_TD4;
constexpr size_t WS_XB = WS_Y + SZ_TD4;
constexpr size_t SZ_TD2 = (size_t)T * D * 2;
constexpr size_t WS_MEMB = WS_XB + SZ_TD2;
constexpr size_t WS_KM = WS_MEMB + (size_t)TM * D * 2;
constexpr size_t WS_VM = WS_KM + (size_t)DEPTH * TM * W * 2;
constexpr size_t WS_PROJ = WS_VM + (size_t)DEPTH * TM * W * 2;
constexpr size_t WS_GATES = WS_PROJ + (size_t)T * NBR * 2;
constexpr size_t WS_CUMF = WS_GATES + (size_t)T * 8192 * 2;
constexpr size_t WS_IPRE = WS_CUMF + (size_t)NBH * SEQ * 4;
constexpr size_t WS_SUMM = WS_IPRE + (size_t)NBH * SEQ * 4;
constexpr size_t WS_CST = WS_SUMM + al256((size_t)NBH * NCH * 2 * 4);
constexpr size_t WS_NST = WS_CST + (size_t)2 * NBH * NCH * HD * HD * 2;
constexpr size_t WS_BR = WS_NST + (size_t)NBH * NCH * HD * 4;
constexpr size_t WS_MRG = WS_BR + SZ_TD2;
constexpr size_t WS_Q = WS_MRG + SZ_TD2;
constexpr size_t WS_O = WS_Q + (size_t)T * W * 2;
constexpr size_t WS_EID = WS_O + (size_t)T * W * 2;
constexpr size_t WS_EW = WS_EID + (size_t)T * 8 * 4;
constexpr size_t WS_EPOS = WS_EW + (size_t)T * 8 * 4;
constexpr size_t WS_SLOTOF = WS_EPOS + (size_t)T * 8 * 4;
constexpr size_t WS_TOK = WS_SLOTOF + (size_t)T * 8 * 4;
constexpr size_t WS_WSL = WS_TOK + al256((size_t)NSLOT * 4);
constexpr size_t WS_HB = WS_WSL + al256((size_t)NSLOT * 4);
constexpr size_t WS_YB = WS_HB + (size_t)NSLOT * ED * 2;
constexpr size_t WS_AV = WS_YB + (size_t)NSLOT * D * 2;
constexpr size_t WS_PM = WS_AV + (size_t)NBH * SEQ * 4;
constexpr size_t WS_MSEQ = WS_PM + (size_t)NBH * SEQ * 4;
constexpr size_t WS_XB8 = WS_MSEQ + al256((size_t)NBH * 80 * 4);
constexpr size_t WS_WGU8 = WS_XB8 + (size_t)T * D;
constexpr size_t SZ_WGU8 = (size_t)1024 * D;
constexpr size_t WS_WIN8 = WS_WGU8 + (size_t)DEPTH * NEX * SZ_WGU8;
constexpr size_t SZ_WIN8 = (size_t)NPROJ * D;
constexpr size_t WS_RWT = WS_WIN8 + DEPTH * SZ_WIN8;
constexpr size_t WS_XQ8 = WS_RWT + (size_t)DEPTH * 2 * NE * D * 2;
constexpr size_t WS_XSC = WS_XQ8 + (size_t)T * D;
constexpr size_t WS_WINQ = WS_XSC + al256((size_t)T * 4);
constexpr size_t SZ_WINQ = (size_t)NBR * D;
constexpr size_t WS_WIFB = WS_WINQ + DEPTH * SZ_WINQ;
constexpr size_t WS_MEMB8 = WS_WIFB + (size_t)DEPTH * 2 * 16 * D * 2;
constexpr size_t WS_END = WS_MEMB8 + (size_t)TM * D;
constexpr int CW_WABS = 8320;
constexpr float X8_SCALE = 16.0f, W8_SCALE = 256.0f, H8_SCALE = 8.0f, Y8_SCALE = 64.0f;

constexpr int LDS_BYTES = 147456;

__device__ __forceinline__ bf16_t f2bf(float f) { unsigned u = __float_as_uint(f); u += 0x7FFFu + ((u >> 16) & 1u); return (bf16_t)(u >> 16); }
__device__ __forceinline__ float bf2f(bf16_t b) { return __uint_as_float(((unsigned)b) << 16); }
__device__ __forceinline__ unsigned pack2(float lo, float hi) { unsigned r; asm("v_cvt_pk_bf16_f32 %0, %1, %2" : "=v"(r) : "v"(lo), "v"(hi)); return r; }
__device__ __forceinline__ float sigmoidf_(float x) { return __builtin_amdgcn_rcpf(1.0f + __builtin_amdgcn_exp2f(-1.4426950408889634f * x)); }
__device__ __forceinline__ unsigned pack_fp8x4(float a, float b, float c, float d) {
    a = __builtin_amdgcn_fmed3f(a, -448.f, 448.f); b = __builtin_amdgcn_fmed3f(b, -448.f, 448.f); c = __builtin_amdgcn_fmed3f(c, -448.f, 448.f); d = __builtin_amdgcn_fmed3f(d, -448.f, 448.f);
    int w = 0; w = __builtin_amdgcn_cvt_pk_fp8_f32(a, b, w, false); w = __builtin_amdgcn_cvt_pk_fp8_f32(c, d, w, true); return (unsigned)w; }
__device__ __forceinline__ unsigned pack_i8x4(float a, float b, float c, float d) {
    const int ia = (int)__builtin_amdgcn_fmed3f(rintf(a), -127.f, 127.f), ib = (int)__builtin_amdgcn_fmed3f(rintf(b), -127.f, 127.f), ic = (int)__builtin_amdgcn_fmed3f(rintf(c), -127.f, 127.f), id = (int)__builtin_amdgcn_fmed3f(rintf(d), -127.f, 127.f);
    return (unsigned)(ia & 255) | ((unsigned)(ib & 255) << 8) | ((unsigned)(ic & 255) << 16) | ((unsigned)(id & 255) << 24); }
__device__ __forceinline__ unsigned pack_u8x4(float a, float b, float c, float d) {
    return (unsigned)rintf(a) | ((unsigned)rintf(b) << 8) | ((unsigned)rintf(c) << 16) | ((unsigned)rintf(d) << 24); }
__device__ __forceinline__ void un8u(u32x2 w, f32x4& a, f32x4& b) { a[0] = (float)(w.x & 255u); a[1] = (float)((w.x >> 8) & 255u); a[2] = (float)((w.x >> 16) & 255u); a[3] = (float)(w.x >> 24);
    b[0] = (float)(w.y & 255u); b[1] = (float)((w.y >> 8) & 255u); b[2] = (float)((w.y >> 16) & 255u); b[3] = (float)(w.y >> 24); }
__device__ __forceinline__ float wave_sum(float v) { for (int o = 32; o >= 1; o >>= 1) v += __shfl_xor(v, o); return v; }
__device__ __forceinline__ float wave_max(float v) { for (int o = 32; o >= 1; o >>= 1) v = fmaxf(v, __shfl_xor(v, o)); return v; }

#define XB_TMO      128
#define XB_XCNT(j)  (256  + 64 * (j))
#define XB_XSUB(j)  (1280 + 64 * (j))
#define XB_XGEN(j)  (2304 + 64 * (j))
#define XB_TOP      3328
#define XB_TOPGEN   3392
#define XCD_BAR_WORDS 3456
#define XB_SPIN_CAP (1u << 27)
__device__ __forceinline__ unsigned xb_ld(unsigned* p)              { return __hip_atomic_load(p, __ATOMIC_RELAXED, __HIP_MEMORY_SCOPE_AGENT); }
__device__ __forceinline__ unsigned xb_add(unsigned* p, unsigned v) { return __hip_atomic_fetch_add(p, v, __ATOMIC_RELAXED, __HIP_MEMORY_SCOPE_AGENT); }
__device__ __forceinline__ unsigned xb_xcc_id() { return (unsigned)__builtin_amdgcn_s_getreg((3 << 11) | 20) & 0xFu; }
#define XB_SPIN(cond, bar) do { unsigned _sp = 0; while (cond) { __builtin_amdgcn_s_sleep(1); \
    if ((++_sp & 255u) == 0u) { if (xb_ld(&(bar)[XB_TMO])) break; if (_sp > XB_SPIN_CAP) { atomicAdd(&(bar)[XB_TMO], 1u); break; } } } } while (0)
struct XcdBarrier { unsigned* bar; unsigned x; volatile LAS unsigned* st; };
__device__ __forceinline__ XcdBarrier xcd_barrier_post(unsigned* bar, volatile LAS unsigned* st) {
    XcdBarrier b; b.bar = bar; b.x = xb_xcc_id(); b.st = st;
    if (threadIdx.x == 0) (void)xb_add(&bar[XB_XCNT(b.x)], 1u);
    return b;
}
__device__ __forceinline__ void xcd_barrier_complete(unsigned* bar, unsigned x, unsigned& nloc, unsigned& nx) {
    const unsigned G = gridDim.x * gridDim.y * gridDim.z;
    unsigned sum, cnt, mine, sp = 0u;
    for (;;) {
        sum = 0u; cnt = 0u; mine = 0u;
#pragma unroll
        for (unsigned j = 0; j < 16; ++j) { const unsigned c = xb_ld(&bar[XB_XCNT(j)]); sum += c; cnt += (c > 0u) ? 1u : 0u; mine = (j == x) ? c : mine; }
        if (sum == G) break;
        __builtin_amdgcn_s_sleep(1);
        if ((++sp & 255u) == 0u) { if (xb_ld(&bar[XB_TMO])) break; if (sp > XB_SPIN_CAP) { atomicAdd(&bar[XB_TMO], 1u); break; } }
    }
    nloc = mine > 0u ? mine : 1u; nx = cnt > 0u ? cnt : 1u;
}
__device__ __forceinline__ void xcd_barrier(const XcdBarrier& b) {
    asm volatile("s_waitcnt vmcnt(0)" ::: "memory");
    __syncthreads();
    if (threadIdx.x == 0) {
        unsigned* bar = b.bar;
        __builtin_amdgcn_s_waitcnt(0);
        unsigned nloc = b.st[0], nx = b.st[1];
        if (nloc == 0u) { xcd_barrier_complete(bar, b.x, nloc, nx); b.st[0] = nloc; b.st[1] = nx; }
        const unsigned old = xb_add(&bar[XB_XSUB(b.x)], 1u);
        const unsigned gen = old / nloc;
        if (old + 1u == (gen + 1u) * nloc) {
            __builtin_amdgcn_fence(__ATOMIC_RELEASE, "agent");
            asm volatile("s_waitcnt vmcnt(0)" ::: "memory");
            const unsigned og = xb_add(&bar[XB_TOP], 1u);
            const unsigned tg = og / nx;
            if (og + 1u == (tg + 1u) * nx) xb_add(&bar[XB_TOPGEN], 1u);
            else XB_SPIN(xb_ld(&bar[XB_TOPGEN]) == tg, bar);
            __builtin_amdgcn_fence(__ATOMIC_ACQUIRE, "agent");
            xb_add(&bar[XB_XGEN(b.x)], 1u);
            asm volatile("s_waitcnt vmcnt(0)" ::: "memory");
        } else {
            XB_SPIN(xb_ld(&bar[XB_XGEN(b.x)]) == gen, bar);
            __builtin_amdgcn_fence(__ATOMIC_ACQUIRE, "agent");
            asm volatile("s_waitcnt vmcnt(0)" ::: "memory");
        }
    }
    __syncthreads();
}

struct Args { const float* in[23]; float* out; unsigned char* ws; int ph_lo, ph_hi; };
enum { IN_X = 0, IN_MEM, IN_WIN, IN_GATEB, IN_POOLW, IN_POOLS, IN_CONVW, IN_MNORM, IN_RNORM, IN_WBR, IN_WMIX, IN_WQ, IN_WK, IN_WV, IN_WO, IN_RW, IN_RB, IN_WGU, IN_WDN, IN_SGU, IN_SDN, IN_LNW, IN_LNB };

#define GAS __attribute__((address_space(1)))
struct DArgs { const GAS float* in[23]; GAS float* out; GAS unsigned char* ws; int ph_lo, ph_hi; };
typedef const __attribute__((address_space(4))) DArgs* KArgs;
struct Frame {
    LAS unsigned char* lds; int tid, lane, wave, wg, nwg;
    GAS unsigned char* wsg; KArgs ka;
    __device__ __forceinline__ unsigned char* ws_() const { return (unsigned char*)wsg; }
};
__device__ __forceinline__ Frame fresh(const Frame& F) { Frame G = F; asm volatile("" : "+s"(G.wsg)); asm volatile("" : "+s"(G.ka)); asm volatile("" : "+v"(G.tid)); asm volatile("" : "+s"(G.wg));
    G.lane = G.tid & 63; G.wave = __builtin_amdgcn_readfirstlane(G.tid >> 6); return G; }

struct GUnit {
    const bf16_t* Bt;
    const bf16_t* A;
    const int* gather;
    int row0;
    int pn;
    int e;
    bf16_t* dst;
};

__device__ __forceinline__ void un8(u32x4 w, f32x4& a, f32x4& b) { a[0] = __uint_as_float(w[0] << 16); a[1] = __uint_as_float(w[0] & 0xffff0000u); a[2] = __uint_as_float(w[1] << 16); a[3] = __uint_as_float(w[1] & 0xffff0000u);
    b[0] = __uint_as_float(w[2] << 16); b[1] = __uint_as_float(w[2] & 0xffff0000u); b[2] = __uint_as_float(w[3] << 16); b[3] = __uint_as_float(w[3] & 0xffff0000u); }
__device__ __forceinline__ void st_bf16x8(bf16_t* p, f32x4 a, f32x4 b) { u32x4 w; w[0] = pack2(a[0], a[1]); w[1] = pack2(a[2], a[3]); w[2] = pack2(b[0], b[1]); w[3] = pack2(b[2], b[3]); *(u32x4*)p = w; }
__device__ __forceinline__ void st_bf16x4(bf16_t* p, f32x4 v) { u32x2 w; w.x = pack2(v[0], v[1]); w.y = pack2(v[2], v[3]); *(u32x2*)p = w; }
__device__ __forceinline__ void ld_row32(const bf16_t* row, int lane, float (&v)[32]) {
#pragma unroll
    for (int j = 0; j < 4; ++j) { const u32x4 w = *(const u32x4*)(row + j * 512 + lane * 8);
#pragma unroll
        for (int e = 0; e < 4; ++e) { v[j * 8 + 2 * e] = __uint_as_float(w[e] << 16); v[j * 8 + 2 * e + 1] = __uint_as_float(w[e] & 0xffff0000u); } } }
__device__ __forceinline__ void st_row32(bf16_t* row, int lane, const float (&v)[32]) {
#pragma unroll
    for (int j = 0; j < 4; ++j) { u32x4 w;
#pragma unroll
        for (int e = 0; e < 4; ++e) w[e] = pack2(v[j * 8 + 2 * e], v[j * 8 + 2 * e + 1]);
        *(u32x4*)(row + j * 512 + lane * 8) = w; } }
__device__ __forceinline__ void st_row32_i8(unsigned char* row, float* sc, int lane, const float (&v)[32]) {
    float am = 0.f;
#pragma unroll
    for (int j = 0; j < 32; ++j) am = fmaxf(am, fabsf(v[j]));
    am = fmaxf(wave_max(am), 1e-30f); const float q = 127.0f / am;
#pragma unroll
    for (int j = 0; j < 4; ++j) { u32x2 w; w.x = pack_i8x4(v[j * 8] * q, v[j * 8 + 1] * q, v[j * 8 + 2] * q, v[j * 8 + 3] * q); w.y = pack_i8x4(v[j * 8 + 4] * q, v[j * 8 + 5] * q, v[j * 8 + 6] * q, v[j * 8 + 7] * q);
        *(u32x2*)(row + j * 512 + lane * 8) = w; }
    if (lane == 0) *sc = am * (1.0f / 127.0f); }
__device__ __forceinline__ void st_row32_fp8(unsigned char* row, int lane, const float (&v)[32]) {
#pragma unroll
    for (int j = 0; j < 4; ++j) { u32x2 w; w.x = pack_fp8x4(v[j * 8] * X8_SCALE, v[j * 8 + 1] * X8_SCALE, v[j * 8 + 2] * X8_SCALE, v[j * 8 + 3] * X8_SCALE); w.y = pack_fp8x4(v[j * 8 + 4] * X8_SCALE, v[j * 8 + 5] * X8_SCALE, v[j * 8 + 6] * X8_SCALE, v[j * 8 + 7] * X8_SCALE);
        *(u32x2*)(row + j * 512 + lane * 8) = w; } }
struct NoPre { };
struct EpiProj {
    static constexpr bool PAIR_M = false; static constexpr bool SEG = false; typedef NoPre Pre; static constexpr int NST = 8;
    bf16_t* proj; bf16_t* gates;
    static __device__ __forceinline__ float unit_scale(const GUnit& u) { return (u.pn == PC_MK / 256 || u.pn == PC_MK / 256 + 1 || u.pn == PC_RK / 256 || u.pn == PC_RK / 256 + 1) ? 0.08838834764831845f : 1.0f; }
    __device__ __forceinline__ void pre(const GUnit&, int, int, Pre&) const {}
    __device__ __forceinline__ void fin(const GUnit& u, int r, int c, const f32x4 (&a)[2][2], const Pre&) const {
        const int col = u.pn * 256 + c; const size_t row = (size_t)(u.row0 + r);
        if (col < NBR) { st_bf16x8(proj + row * NBR + col, a[0][0], a[0][1]); st_bf16x8(proj + row * NBR + col + 128, a[1][0], a[1][1]); }
        else { f32x4 s[2][2];
#pragma unroll
            for (int h = 0; h < 2; ++h)
#pragma unroll
                for (int n = 0; n < 2; ++n)
#pragma unroll
                    for (int j = 0; j < 4; ++j) s[h][n][j] = __builtin_amdgcn_fmed3f(sigmoidf_(a[h][n][j]) * 255.0f, 1.0f, 255.0f);
            u32x2 w0, w1; w0.x = pack_u8x4(s[0][0][0], s[0][0][1], s[0][0][2], s[0][0][3]); w0.y = pack_u8x4(s[0][1][0], s[0][1][1], s[0][1][2], s[0][1][3]);
            w1.x = pack_u8x4(s[1][0][0], s[1][0][1], s[1][0][2], s[1][0][3]); w1.y = pack_u8x4(s[1][1][0], s[1][1][1], s[1][1][2], s[1][1][3]);
            { const auto rx = __builtin_amdgcn_permlane32_swap(w0.x, w1.x, false, false); w0.x = rx[0]; w1.x = rx[1]; const auto ry = __builtin_amdgcn_permlane32_swap(w0.y, w1.y, false, false); w0.y = ry[0]; w1.y = ry[1]; }
            const bool up = (threadIdx.x & 32u) != 0u; const int gc = col - NBR;
            unsigned char* gp = (unsigned char*)gates + row * 8192 + (up ? gc + 128 - 8 : gc);
            u32x4 w; w[0] = w0.x; w[1] = w0.y; w[2] = w1.x; w[3] = w1.y; *(u32x4*)gp = w; }
    }
};
struct EpiBranch {
    static constexpr bool PAIR_M = false; static constexpr bool SEG = true; static constexpr int NST = 8;
    struct Pre { u32x2 g0, g1; };
    struct SPre { u32x2 a0, a1, b0, b1; };
    const unsigned char* gates; unsigned char* out;
    __device__ __forceinline__ void pre(const GUnit& u, int r, int c, Pre& p) const { const unsigned char* g = gates + (size_t)(u.row0 + r) * 8192 + 3 * 2048 + u.pn * 256 + c; p.g0 = *(const u32x2*)g; p.g1 = *(const u32x2*)(g + 128); }
    __device__ __forceinline__ void fin(const GUnit& u, int r, int c, const f32x4 (&a)[2][2], const Pre& p) const {
        f32x4 x0, x1, y0, y1; un8u(p.g0, x0, x1); un8u(p.g1, y0, y1); const float k = X8_SCALE / 255.0f;
        const f32x4 v00 = a[0][0] * x0 * k, v01 = a[0][1] * x1 * k, v10 = a[1][0] * y0 * k, v11 = a[1][1] * y1 * k;
        u32x2 w0, w1; w0.x = pack_fp8x4(v00[0], v00[1], v00[2], v00[3]); w0.y = pack_fp8x4(v01[0], v01[1], v01[2], v01[3]); w1.x = pack_fp8x4(v10[0], v10[1], v10[2], v10[3]); w1.y = pack_fp8x4(v11[0], v11[1], v11[2], v11[3]);
        { const auto rx = __builtin_amdgcn_permlane32_swap(w0.x, w1.x, false, false); w0.x = rx[0]; w1.x = rx[1]; const auto ry = __builtin_amdgcn_permlane32_swap(w0.y, w1.y, false, false); w0.y = ry[0]; w1.y = ry[1]; }
        const bool up = (threadIdx.x & 32u) != 0u;
        unsigned char* o = out + (size_t)(u.row0 + r) * D + u.pn * 256 + (up ? 128 + c - 8 : c);
        u32x4 w; w[0] = w0.x; w[1] = w0.y; w[2] = w1.x; w[3] = w1.y; *(u32x4*)o = w; }
    __device__ __forceinline__ void seg_pre(const GUnit& u, int r, int c, int s, SPre& p) const { const unsigned char* g = gates + (size_t)(u.row0 + r) * 8192 + s * 2048 + u.pn * 256 + c;
        p.a0 = *(const u32x2*)g; p.a1 = *(const u32x2*)(g + 128); p.b0 = *(const u32x2*)(g + 2048); p.b1 = *(const u32x2*)(g + 2048 + 128); }
    __device__ __forceinline__ void seg_fin(f32x4 (&h0)[2], f32x4 (&h1)[2], const SPre& p) const {
        f32x4 a0, a1, b0, b1; un8u(p.a0, a0, a1); un8u(p.b0, b0, b1);
#pragma unroll
        for (int j = 0; j < 4; ++j) { h0[0][j] *= a0[j] * __builtin_amdgcn_rcpf(b0[j]); h0[1][j] *= a1[j] * __builtin_amdgcn_rcpf(b1[j]); }
        un8u(p.a1, a0, a1); un8u(p.b1, b0, b1);
#pragma unroll
        for (int j = 0; j < 4; ++j) { h1[0][j] *= a0[j] * __builtin_amdgcn_rcpf(b0[j]); h1[1][j] *= a1[j] * __builtin_amdgcn_rcpf(b1[j]); }
    }
};
struct EpiResid {
    static constexpr bool PAIR_M = false; static constexpr bool SEG = false; static constexpr int NST = 16;
    struct Pre { u32x4 x0, x1; };
    const bf16_t* x; bf16_t* y;
    __device__ __forceinline__ void pre(const GUnit& u, int r, int c, Pre& p) const { const bf16_t* xp = x + (size_t)(u.row0 + r) * D + u.pn * 256 + c; p.x0 = *(const u32x4*)xp; p.x1 = *(const u32x4*)(xp + 128); }
    __device__ __forceinline__ void fin(const GUnit& u, int r, int c, const f32x4 (&a)[2][2], const Pre& p) const {
        f32x4 x0, x1, y0, y1; un8(p.x0, x0, x1); un8(p.x1, y0, y1);
        bf16_t* o = y + (size_t)(u.row0 + r) * D + u.pn * 256 + c; st_bf16x8(o, x0 * ALPHA + a[0][0], x1 * ALPHA + a[0][1]); st_bf16x8(o + 128, y0 * ALPHA + a[1][0], y1 * ALPHA + a[1][1]); }
};
struct EpiQKV {
    static constexpr bool PAIR_M = false; static constexpr bool SEG = false; typedef NoPre Pre; int pad_; static constexpr int NST = 16;
    __device__ __forceinline__ void pre(const GUnit&, int, int, Pre&) const {}
    __device__ __forceinline__ void fin(const GUnit& u, int r, int c, const f32x4 (&a)[2][2], const Pre&) const {
        bf16_t* o = u.dst + (size_t)(u.row0 + r) * W + u.pn * 256 + c; st_bf16x8(o, a[0][0], a[0][1]); st_bf16x8(o + 128, a[1][0], a[1][1]); }
};
struct EpiSwiglu {
    static constexpr bool SEG = false; static constexpr bool PAIR_M = true; static constexpr int NST = 4;
    struct Pre { float w; };
    const float* wsl; unsigned char* hb;
    __device__ __forceinline__ void pre(const GUnit& u, int r, int, Pre& p) const { p.w = wsl[u.row0 + r] * H8_SCALE; }
    __device__ __forceinline__ u32x2 act(const f32x4 (&a)[2][2], float w) const { f32x4 o[2];
#pragma unroll
        for (int n = 0; n < 2; ++n)
#pragma unroll
            for (int j = 0; j < 4; ++j) o[n][j] = a[0][n][j] * sigmoidf_(a[0][n][j]) * a[1][n][j] * w;
        u32x2 w8; w8.x = pack_fp8x4(o[0][0], o[0][1], o[0][2], o[0][3]); w8.y = pack_fp8x4(o[1][0], o[1][1], o[1][2], o[1][3]); return w8; }
    __device__ __forceinline__ void fin2(const GUnit& u, int r0, int r1, int c, const f32x4 (&a0)[2][2], const f32x4 (&a1)[2][2], const Pre& p0, const Pre& p1) const {
        u32x2 v0 = act(a0, p0.w), v1 = act(a1, p1.w);
        { const auto rx = __builtin_amdgcn_permlane32_swap(v0.x, v1.x, false, false); v0.x = rx[0]; v1.x = rx[1]; const auto ry = __builtin_amdgcn_permlane32_swap(v0.y, v1.y, false, false); v0.y = ry[0]; v1.y = ry[1]; }
        const bool up = (threadIdx.x & 32u) != 0u;
        unsigned char* o = hb + (size_t)(u.row0 + (up ? r1 : r0)) * ED + u.pn * 128 + (up ? c - 8 : c);
        u32x4 w; w[0] = v0.x; w[1] = v0.y; w[2] = v1.x; w[3] = v1.y; *(u32x4*)o = w; }
    __device__ __forceinline__ void fin(const GUnit&, int, int, const f32x4 (&)[2][2], const Pre&) const {}
};
struct EpiDown {
    static constexpr bool PAIR_M = false; static constexpr bool SEG = false; typedef NoPre Pre; static constexpr int NST = 8;
    unsigned char* yb;
    __device__ __forceinline__ void pre(const GUnit&, int, int, Pre&) const {}
    __device__ __forceinline__ void fin(const GUnit& u, int r, int c, const f32x4 (&a)[2][2], const Pre&) const {
        u32x2 w0, w1; w0.x = pack_fp8x4(a[0][0][0], a[0][0][1], a[0][0][2], a[0][0][3]); w0.y = pack_fp8x4(a[0][1][0], a[0][1][1], a[0][1][2], a[0][1][3]);
        w1.x = pack_fp8x4(a[1][0][0], a[1][0][1], a[1][0][2], a[1][0][3]); w1.y = pack_fp8x4(a[1][1][0], a[1][1][1], a[1][1][2], a[1][1][3]);
        { const auto rx = __builtin_amdgcn_permlane32_swap(w0.x, w1.x, false, false); w0.x = rx[0]; w1.x = rx[1]; const auto ry = __builtin_amdgcn_permlane32_swap(w0.y, w1.y, false, false); w0.y = ry[0]; w1.y = ry[1]; }
        const bool up = (threadIdx.x & 32u) != 0u;
        unsigned char* o = yb + (size_t)(u.row0 + r) * D + u.pn * 256 + (up ? 128 + c - 8 : c);
        u32x4 w; w[0] = w0.x; w[1] = w0.y; w[2] = w1.x; w[3] = w1.y; *(u32x4*)o = w; }
};

typedef short bf16x8 __attribute__((ext_vector_type(8)));
typedef short s16x4 __attribute__((ext_vector_type(4)));
__device__ __forceinline__ s16x4 lds_tr(const LAS bf16_t* p) { return __builtin_amdgcn_ds_read_tr16_b64_v4i16((LAS s16x4*)p); }
__device__ __forceinline__ bf16x8 cat4(s16x4 a, s16x4 b) { bf16x8 r; r[0] = a[0]; r[1] = a[1]; r[2] = a[2]; r[3] = a[3]; r[4] = b[0]; r[5] = b[1]; r[6] = b[2]; r[7] = b[3]; return r; }
__device__ __forceinline__ bf16x8 pack8(f32x4 a, f32x4 b) { union { u32x4 u; bf16x8 h; } c; c.u[0] = pack2(a[0], a[1]); c.u[1] = pack2(a[2], a[3]); c.u[2] = pack2(b[0], b[1]); c.u[3] = pack2(b[2], b[3]); return c.h; }
constexpr int BK = 64, HTB = 128 * BK * 2;
__device__ __forceinline__ int lds_byte(int r, int c) { const int st = (r >> 4) * 2 + (c >> 5), rr = r & 15, cc = c & 31, ob = rr * 64 + cc * 2; return st * 1024 + (ob ^ (((ob >> 9) & 1) << 5)); }
__device__ __forceinline__ void stage_rc(int b, int& R, int& C) { const int st = b / 1024, sb = b % 1024, swz = sb ^ (((sb >> 9) & 1) << 5); R = (st >> 1) * 16 + swz / 64; C = (st & 1) * 32 + (swz % 64) / 2; }

typedef int i32x8 __attribute__((ext_vector_type(8)));
typedef int i32x4 __attribute__((ext_vector_type(4)));
template <class Epi, class Sched, int MODE = 0>
__device__ __forceinline__ void gemm_phase_mfma(const Frame& F, const int K, const Sched& S, const Epi& E, const float oscale = 1.0f, const float* rowscale = nullptr) {
    constexpr bool FP8 = (MODE == 1), I8 = (MODE == 2);
    LAS unsigned char* lds = F.lds;
    const int tid = F.tid, wid = F.wave, lane = F.lane, wr = wid >> 2, wc = wid & 3, fr = lane & 15, fq = lane >> 4;
    const int KB = MODE ? K : 2 * K;
    const int nt = KB / 128;
    unsigned voffB[2];
#pragma unroll
    for (int i = 0; i < 2; ++i) { int R, C; stage_rc(tid * 16 + i * 8192, R, C); const int rho = R & 31, q4 = (rho & 15) >> 2, Rb = (R & ~31) + 8 * (((q4 & 1) << 1) | (q4 >> 1)) + 4 * (rho >> 4) + (rho & 3); voffB[i] = (unsigned)(Rb * KB + C * 2); }
    const size_t kstep = (size_t)(BK * 2);
    const size_t hstepB = (size_t)128 * KB;
    const unsigned ldsw = (unsigned)wid * 1024u;
    const int aoff = FP8 ? lds_byte(wr * 64 + fr, fq * 16) : lds_byte(wr * 64 + fr, fq * 8), boff = FP8 ? lds_byte(wc * 32 + fr, fq * 16) : lds_byte(wc * 32 + fr, fq * 8);
#define SA_(b, h) (((b) * 2 + (h)) * HTB)
#define SB_(b, h) ((4 + (b) * 2 + (h)) * HTB)
#define STAGE_(bufoff, gbase, voff) do { _Pragma("unroll") for (int _i = 0; _i < 2; ++_i) \
        __builtin_amdgcn_global_load_lds((const unsigned*)((const char*)(gbase) + (voff)[_i]), (LAS unsigned*)(lds + (bufoff) + ldsw + _i * 8192), 16, 0, 0); } while (0)
#define LDA_(dst, b, h) do { _Pragma("unroll") for (int m = 0; m < 4; ++m) { if constexpr (FP8) { const i32x4 _lo = *(const LAS i32x4*)(lds + SA_(b, h) + aoff + m * 2048), _hi = *(const LAS i32x4*)(lds + SA_(b, h) + aoff + m * 2048 + 16); \
            dst##8[m] = __builtin_shufflevector(_lo, _hi, 0, 1, 2, 3, 4, 5, 6, 7); } \
        else { _Pragma("unroll") for (int k = 0; k < 2; ++k) dst[m][k] = *(const LAS bf16x8*)(lds + SA_(b, h) + aoff + m * 2048 + k * 1024); } } } while (0)
#define LDB_(dst, b, h) do { _Pragma("unroll") for (int n = 0; n < 2; ++n) { if constexpr (FP8) { const i32x4 _lo = *(const LAS i32x4*)(lds + SB_(b, h) + boff + n * 2048), _hi = *(const LAS i32x4*)(lds + SB_(b, h) + boff + n * 2048 + 16); \
            dst##8[n] = __builtin_shufflevector(_lo, _hi, 0, 1, 2, 3, 4, 5, 6, 7); } \
        else { _Pragma("unroll") for (int k = 0; k < 2; ++k) dst[n][k] = *(const LAS bf16x8*)(lds + SB_(b, h) + boff + n * 2048 + k * 1024); } } } while (0)
#define MMA_(ai, bj, At, Bt) do { __builtin_amdgcn_s_setprio(1); _Pragma("unroll") for (int m = 0; m < 4; ++m) _Pragma("unroll") for (int n = 0; n < 2; ++n) { \
        if constexpr (FP8) asm volatile("v_mfma_scale_f32_16x16x128_f8f6f4 %0, %1, %2, %0, %3, %3 op_sel_hi:[0,0,0]" : "+v"(acc[ai][bj][m][n]) : "v"(Bt##8[n]), "v"(At##8[m]), "v"(sc8)); \
        else if constexpr (I8) { _Pragma("unroll") for (int k = 0; k < 2; ++k) acci[ai][bj][m][n] = __builtin_amdgcn_mfma_i32_16x16x64_i8(__builtin_bit_cast(i32x4, Bt[n][k]), __builtin_bit_cast(i32x4, At[m][k]), acci[ai][bj][m][n], 0, 0, 0); } \
        else { _Pragma("unroll") for (int k = 0; k < 2; ++k) acc[ai][bj][m][n] = __builtin_amdgcn_mfma_f32_16x16x32_bf16(Bt[n][k], At[m][k], acc[ai][bj][m][n], 0, 0, 0); } } \
        __builtin_amdgcn_s_setprio(0); } while (0)
#define WAIT_V_(n) asm volatile("s_waitcnt vmcnt(" #n ")" ::: "memory")
#define WAIT_L_(n) asm volatile("s_waitcnt lgkmcnt(" #n ")" ::: "memory")
#define BAR_ __builtin_amdgcn_s_barrier()
#define SCHED_ __builtin_amdgcn_sched_barrier(0)
#define VOFFS_(dst, u) do { int _tz = tid; asm volatile("" : "+v"(_tz)); _Pragma("unroll") for (int _i = 0; _i < 2; ++_i) { int _R, _C; stage_rc(_tz * 16 + _i * 8192, _R, _C); \
        _Pragma("unroll") for (int _h = 0; _h < 2; ++_h) { const int _r = _h * 128 + _R; \
        const unsigned _row = (u).gather ? (unsigned)(u).gather[_r] : (unsigned)((u).row0 + _r); dst[_h][_i] = _row * (unsigned)KB + (unsigned)_C * 2u; } } } while (0)
    GUnit cur, nxt; int ui = 0;
    if (!S.get(0, cur)) return;
    f32x4 acc[2][2][4][2]; i32x4 acci[2][2][4][2];
#pragma unroll
    for (int a = 0; a < 2; ++a)
#pragma unroll
        for (int b = 0; b < 2; ++b)
#pragma unroll
            for (int m = 0; m < 4; ++m)
#pragma unroll
                for (int n = 0; n < 2; ++n) { acc[a][b][m][n] = (f32x4){0.f, 0.f, 0.f, 0.f}; acci[a][b][m][n] = (i32x4){0, 0, 0, 0}; }
    bf16x8 At[4][2], B0[2][2], B1[2][2]; i32x8 At8[4], B08[2], B18[2];
    int sc8 = 0x7f7f7f7f; asm volatile("" : "+v"(sc8));
    unsigned vA[2][2], vN[2][2];
    VOFFS_(vA, cur);
    const char* cA = (const char*)cur.A; const char* cB = (const char*)cur.Bt;
    STAGE_(SB_(0, 0), cB, voffB); STAGE_(SA_(0, 0), cA, vA[0]); STAGE_(SB_(0, 1), cB + hstepB, voffB); STAGE_(SA_(0, 1), cA, vA[1]);
    if (wr == 1) BAR_;
    WAIT_V_(4); BAR_;
    STAGE_(SB_(1, 0), cB + kstep, voffB); STAGE_(SA_(1, 0), cA + kstep, vA[0]); STAGE_(SB_(1, 1), cB + hstepB + kstep, voffB); STAGE_(SA_(1, 1), cA + kstep, vA[1]);
    WAIT_V_(8); BAR_;
    for (;;) {
        const bool has_next = S.get(ui + 1, nxt);
        const char* nA = has_next ? (const char*)nxt.A : cA; const char* nB = has_next ? (const char*)nxt.Bt : cB;
        if (has_next) { VOFFS_(vN, nxt); }
        for (int t = 0; t < nt; t += 2) {
            const bool last = (t == nt - 2);
            if constexpr (Epi::SEG) { if (t > 0 && (t & 7) == 0) {
                int tz = tid; asm volatile("" : "+v"(tz)); const int er = ((tz >> 8) & 1) * 64 + (tz & 15), ec = ((tz >> 6) & 3) * 32 + ((((tz >> 4) & 1) << 1) | ((tz >> 5) & 1)) * 8;
#pragma unroll
                for (int ai = 0; ai < 2; ++ai) { typename Epi::SPre sp[4];
#pragma unroll
                    for (int m = 0; m < 4; ++m) E.seg_pre(cur, ai * 128 + m * 16 + er, ec, (t >> 3) - 1, sp[m]);
#pragma unroll
                    for (int m = 0; m < 4; ++m) E.seg_fin(acc[ai][0][m], acc[ai][1][m], sp[m]);
                    asm volatile("" ::: "memory"); }
            } }
            const char* a2 = last ? nA : cA + (size_t)(t + 2) * kstep; const char* b2 = last ? nB : cB + (size_t)(t + 2) * kstep;
            const char* a3 = a2 + kstep; const char* b3 = b2 + kstep;
            unsigned w0[2], w1[2];
#pragma unroll
            for (int i = 0; i < 2; ++i) { w0[i] = (last && has_next) ? vN[0][i] : vA[0][i]; w1[i] = (last && has_next) ? vN[1][i] : vA[1][i]; }
            LDB_(B0, 0, 0); SCHED_; LDA_(At, 0, 0);
            WAIT_L_(8); BAR_; WAIT_L_(0); MMA_(0, 0, At, B0); BAR_; SCHED_;
            LDB_(B1, 0, 1); STAGE_(SB_(0, 0), b2, voffB);
            BAR_; WAIT_L_(0); MMA_(0, 1, At, B1); BAR_;
            LDA_(At, 0, 1); STAGE_(SA_(0, 0), a2, w0);
            BAR_; WAIT_L_(0); MMA_(1, 0, At, B0); BAR_; SCHED_;
            STAGE_(SB_(0, 1), b2 + hstepB, voffB);
            { const int lax = __builtin_amdgcn_readfirstlane((t == 0 && ui > 0) ? 1 : 0); asm volatile("s_waitcnt vmcnt(%1)\n\ts_cmp_lg_u32 %0, 0\n\ts_cbranch_scc1 .Llax_%=\n\ts_waitcnt vmcnt(6)\n.Llax_%=:" :: "s"(lax), "n"(6 + Epi::NST) : "memory", "scc"); }
            BAR_; MMA_(1, 1, At, B1); BAR_;
            LDB_(B0, 1, 0); SCHED_; LDA_(At, 1, 0); STAGE_(SA_(0, 1), a2, w1);
            WAIT_L_(8); BAR_; WAIT_L_(0); MMA_(0, 0, At, B0); BAR_; SCHED_;
            LDB_(B1, 1, 1); STAGE_(SB_(1, 0), b3, voffB);
            BAR_; WAIT_L_(0); MMA_(0, 1, At, B1); BAR_;
            LDA_(At, 1, 1); STAGE_(SA_(1, 0), a3, w0);
            BAR_; WAIT_L_(0); MMA_(1, 0, At, B0); BAR_; SCHED_;
            STAGE_(SB_(1, 1), b3 + hstepB, voffB); STAGE_(SA_(1, 1), a3, w1);
            WAIT_V_(8); BAR_; MMA_(1, 1, At, B1); BAR_;
        }
        { int tz = tid; asm volatile("" : "+v"(tz)); const int er = ((tz >> 8) & 1) * 64 + (tz & 15), ec = ((tz >> 6) & 3) * 32 + ((((tz >> 4) & 1) << 1) | ((tz >> 5) & 1)) * 8;
          typename Epi::Pre pre[2][4];
#pragma unroll
          for (int ai = 0; ai < 2; ++ai)
#pragma unroll
              for (int m = 0; m < 4; ++m) E.pre(cur, ai * 128 + m * 16 + er, ec, pre[ai][m]);
          if constexpr (I8) {
#pragma unroll
              for (int ai = 0; ai < 2; ++ai)
#pragma unroll
                  for (int m = 0; m < 4; ++m) { const float rs = rowscale[cur.row0 + ai * 128 + m * 16 + er] * oscale * Epi::unit_scale(cur);
#pragma unroll
                      for (int bj = 0; bj < 2; ++bj)
#pragma unroll
                          for (int n = 0; n < 2; ++n)
#pragma unroll
                              for (int j = 0; j < 4; ++j) acc[ai][bj][m][n][j] = (float)acci[ai][bj][m][n][j] * rs; } }
          if constexpr (FP8) {
#pragma unroll
              for (int ai = 0; ai < 2; ++ai)
#pragma unroll
                  for (int bj = 0; bj < 2; ++bj)
#pragma unroll
                      for (int m = 0; m < 4; ++m)
#pragma unroll
                          for (int n = 0; n < 2; ++n) acc[ai][bj][m][n] *= oscale; }
          if constexpr (Epi::PAIR_M) {
#pragma unroll
          for (int ai = 0; ai < 2; ++ai)
#pragma unroll
              for (int m = 0; m < 4; m += 2) { const f32x4 a4[2][2] = {{acc[ai][0][m][0], acc[ai][0][m][1]}, {acc[ai][1][m][0], acc[ai][1][m][1]}}; const f32x4 b4[2][2] = {{acc[ai][0][m + 1][0], acc[ai][0][m + 1][1]}, {acc[ai][1][m + 1][0], acc[ai][1][m + 1][1]}};
                  E.fin2(cur, ai * 128 + m * 16 + er, ai * 128 + (m + 1) * 16 + er, ec, a4, b4, pre[ai][m], pre[ai][m + 1]); }
          } else {
#pragma unroll
          for (int ai = 0; ai < 2; ++ai)
#pragma unroll
              for (int m = 0; m < 4; ++m) { const f32x4 a4[2][2] = {{acc[ai][0][m][0], acc[ai][0][m][1]}, {acc[ai][1][m][0], acc[ai][1][m][1]}}; E.fin(cur, ai * 128 + m * 16 + er, ec, a4, pre[ai][m]); } } }
        if (!has_next) break;
#pragma unroll
        for (int a = 0; a < 2; ++a)
#pragma unroll
            for (int b = 0; b < 2; ++b)
#pragma unroll
                for (int m = 0; m < 4; ++m)
#pragma unroll
                    for (int n = 0; n < 2; ++n) { acc[a][b][m][n] = (f32x4){0.f, 0.f, 0.f, 0.f}; acci[a][b][m][n] = (i32x4){0, 0, 0, 0}; }
        cur = nxt; cA = nA; cB = nB; ++ui;
#pragma unroll
        for (int h = 0; h < 2; ++h)
#pragma unroll
            for (int i = 0; i < 2; ++i) vA[h][i] = vN[h][i];
    }
    WAIT_V_(0);
    if (wr == 0) BAR_;
    BAR_;
#undef SA_
#undef SB_
#undef STAGE_
#undef LDA_
#undef LDB_
#undef MMA_
#undef WAIT_V_
#undef WAIT_L_
#undef BAR_
#undef SCHED_
#undef VOFFS_
}

struct DenseSched {
    const bf16_t* A; const bf16_t* Bt; int K, nM, nN, nwg, G, c, i0, i1, split, pnoff;
    __device__ __forceinline__ void segment(int sg) { i0 = sg == 0 ? 0 : split; i1 = sg == 0 ? split : (1 << 30); }
    __device__ __forceinline__ bool get(int ii, GUnit& u) const {
        const int i = ii + i0; if (i >= i1) return false;
        const long L = (long)i * G + c; if (L >= nwg) return false;
        int wgid = (int)L; { const int q = nwg / 8, r = nwg % 8, xcd = wgid % 8, off = wgid / 8; wgid = (xcd < r ? xcd * (q + 1) : r * (q + 1) + (xcd - r) * q) + off; }
        const int nig = 8 * nN, gid = wgid / nig, fm = gid * 8, gsz = (nM - fm) < 8 ? (nM - fm) : 8;
        const int pm = fm + ((wgid % nig) % gsz), pn = (wgid % nig) / gsz;
        u.pn = pn + pnoff; u.row0 = pm * 256; u.A = A; u.gather = nullptr; u.Bt = Bt + (size_t)pn * 256 * K; u.e = 0; return true;
    }
};
struct QkvSched {
    unsigned char* ws; int l, G, c;
    __device__ __forceinline__ bool get(int i, GUnit& g) const {
        const int u = i * G + c; if (u >= 144) return false; g.gather = nullptr;
        if (u < 128) { g.e = 0; g.pn = u & 1; g.row0 = (u >> 1) * 256; g.A = (const bf16_t*)(ws + WS_XB8); g.Bt = (const bf16_t*)(ws + WS_WQ + l * SZ_WQ + (size_t)g.pn * 256 * D); g.dst = (bf16_t*)(ws + WS_Q); }
        else { const int v = u - 128; g.e = 1 + (v >> 3); g.pn = v & 1; g.row0 = ((v >> 1) & 3) * 256; g.A = (const bf16_t*)(ws + WS_MEMB8); g.Bt = (const bf16_t*)(ws + (g.e == 1 ? WS_WK : WS_WV) + l * SZ_WQ + (size_t)g.pn * 256 * D); g.dst = (bf16_t*)(ws + (g.e == 1 ? WS_KM : WS_VM)) + (size_t)l * TM * W; }
        return true;
    }
};
template <int NCT, bool GATEUP> struct MoeSched {
    unsigned char* ws; const LAS int* pst; int l, G, c, nunits;
    __device__ __forceinline__ bool get(int i, GUnit& g) const {
        const int u = i * G + c; if (u >= nunits) return false;
        const int rt = u / NCT; g.pn = u % NCT; g.row0 = rt * 256; const int e = __builtin_amdgcn_readfirstlane((int)((const LAS unsigned char*)(pst + 68))[rt]); g.e = e;
        if (GATEUP) { g.A = (const bf16_t*)(ws + WS_XB8); g.gather = (const int*)(ws + WS_TOK) + g.row0; g.Bt = (const bf16_t*)(ws + WS_WGU8 + ((size_t)l * NEX + e) * SZ_WGU8 + (size_t)g.pn * 256 * D); }
        else { g.A = (const bf16_t*)(ws + WS_HB); g.gather = nullptr; g.Bt = (const bf16_t*)(ws + WS_WDN + ((size_t)l * NEX + e) * SZ_WDN1 + (size_t)g.pn * 256 * ED); }
        return true;
    }
};

struct TDesc { const float* sp; int sld; unsigned char* dp; int dldb; int fp8; float qs; };
constexpr int TK_WINA = 1024, TK_WINB = 2560, TK_BR = 384, TK_WOUT = 512, TK_QKV = 384, TK_WO = 128, TK_GU = NEX * 8 * 32, TK_DN = NEX * 128;
constexpr int TK_L0DEF = TK_BR + TK_WOUT + TK_QKV + TK_WO + TK_GU + TK_DN, TK_LAYER = TK_WINA + TK_WINB + TK_L0DEF;
__device__ __forceinline__ void tile_desc(const Frame& F, int l, int t, TDesc& d) {
    const KArgs a = F.ka; unsigned char* ws = F.ws_(); d.fp8 = 0; d.qs = W8_SCALE;
    if (t < TK_WINA) { const int tk = t >> 6, tc = t & 63; d.sp = ((const float*)a->in[IN_WIN]) + (size_t)l * D * PROJ_W + (size_t)tk * 128 * PROJ_W + tc * 64; d.sld = PROJ_W; d.dldb = D; d.fp8 = 2; d.qs = 127.0f / fmaxf(__uint_as_float(((const unsigned*)(ws + WS_CTL))[CW_WABS + l]), 1e-30f); d.dp = ws + WS_WINQ + l * SZ_WINQ + (size_t)tc * 64 * D + tk * 128; return; }
    t -= TK_WINA;
    if (t < TK_WINB) { const int tk = t / 160, tc = t % 160; d.sp = ((const float*)a->in[IN_WIN]) + (size_t)l * D * PROJ_W + (size_t)tk * 128 * PROJ_W + 4104 + tc * 64; d.sld = PROJ_W;
        if (tc < 32) { d.dldb = D; d.fp8 = 2; d.qs = 127.0f / fmaxf(__uint_as_float(((const unsigned*)(ws + WS_CTL))[CW_WABS + l]), 1e-30f); d.dp = ws + WS_WINQ + l * SZ_WINQ + (size_t)(4096 + tc * 64) * D + tk * 128; }
        else { d.dldb = D; d.fp8 = 1; d.dp = ws + WS_WIN8 + l * SZ_WIN8 + (size_t)(4096 + tc * 64) * D + tk * 128; }
        return; }
    t -= TK_WINB;
    if (t < TK_BR) { const int n = 1 + (t >> 7), tt = t & 127, tk = tt >> 5, tc = tt & 31; d.sp = ((const float*)a->in[IN_WBR]) + ((size_t)l * 4 + n) * W * D + (size_t)tk * 128 * D + tc * 64; d.sld = D; d.dldb = D * 2; d.dp = ws + WS_WB + l * SZ_DD + ((size_t)tc * 64 * D + n * W + tk * 128) * 2; return; }
    t -= TK_BR;
    if (t < TK_WOUT) { const int tk = t >> 5, tc = t & 31; d.sp = ((const float*)a->in[IN_WMIX]) + (size_t)l * D * D + (size_t)tk * 128 * D + tc * 64; d.sld = D; d.dldb = D; d.fp8 = 1; d.dp = ws + WS_WOUT + l * SZ_DD + ((size_t)tc * 64 * D + tk * 128); return; }
    t -= TK_WOUT;
    if (t < TK_QKV) { const int which = t >> 7, tt = t & 127, tk = tt >> 3, tc = tt & 7; d.sp = (const float*)a->in[which == 0 ? IN_WQ : (which == 1 ? IN_WK : IN_WV)] + (size_t)l * D * W + (size_t)tk * 128 * W + tc * 64; d.sld = W; d.dldb = D * 2;
        d.dp = ws + (which == 0 ? WS_WQ : (which == 1 ? WS_WK : WS_WV)) + l * SZ_WQ + ((size_t)tc * 64 * D + tk * 128) * 2;
        d.fp8 = 1; d.dldb = D; d.dp = ws + (which == 0 ? WS_WQ : (which == 1 ? WS_WK : WS_WV)) + l * SZ_WQ + ((size_t)tc * 64 * D + tk * 128);
        return; }
    t -= TK_QKV;
    if (t < TK_WO) { const int tk = t >> 5, tc = t & 31; d.sp = ((const float*)a->in[IN_WO]) + (size_t)l * W * D + (size_t)tk * 128 * D + tc * 64; d.sld = D; d.dldb = W * 2; d.dp = ws + WS_WO + l * SZ_WQ + ((size_t)tc * 64 * W + tk * 128) * 2; return; }
    t -= TK_WO;
    if (t < TK_GU) { const int tt = t & 31, job = t >> 5, half = job & 1, j = (job >> 1) & 3, e = job >> 3, tk = tt >> 1, tc = tt & 1;
        d.sp = (e < NE ? ((const float*)a->in[IN_WGU]) + ((size_t)l * NE + e) * D * 1024 : ((const float*)a->in[IN_SGU]) + (size_t)l * D * 1024) + half * 512 + j * 128 + (size_t)tk * 128 * 1024 + tc * 64; d.sld = 1024; d.dldb = D; d.fp8 = 1;
        d.dp = ws + WS_WGU8 + ((size_t)l * NEX + e) * SZ_WGU8 + (size_t)(j * 256 + half * 128 + tc * 64) * D + tk * 128; return; }
    t -= TK_GU;
    { const int tt = t & 127, e = t >> 7, tk = tt >> 5, tc = tt & 31;
      d.sp = (e < NE ? ((const float*)a->in[IN_WDN]) + ((size_t)l * NE + e) * ED * D : ((const float*)a->in[IN_SDN]) + (size_t)l * ED * D) + (size_t)tk * 128 * D + tc * 64; d.sld = D; d.dldb = ED; d.fp8 = 1;
      d.dp = ws + WS_WDN + ((size_t)l * NEX + e) * SZ_WDN1 + (size_t)tc * 64 * ED + tk * 128; }
}
constexpr int XP_SLOT = 64 * 256;
template <int NB> struct XRegs { f32x4 r[NB][4]; };
template <int NB> __device__ __forceinline__ void xpose_load(const Frame& F, int l, int t0, int tstep, int n, XRegs<NB>& X) {
    const int tid = F.tid, row4 = (tid >> 4) * 4, cq = (tid & 15) * 4;
#pragma unroll
    for (int b = 0; b < NB; ++b) if (b < n) { TDesc d; tile_desc(F, l, t0 + b * tstep, d); const float* sp = d.sp + (size_t)row4 * d.sld + cq;
#pragma unroll
        for (int q = 0; q < 4; ++q) X.r[b][q] = __builtin_nontemporal_load((const f32x4*)(sp + (size_t)q * d.sld)); }
}
template <int NB> __device__ __forceinline__ void xpose_finish(const Frame& F, int l, int t0, int tstep, int n, const XRegs<NB>& X) {
    const int tid = F.tid, row4 = (tid >> 4) * 4, cq = (tid & 15) * 4;
    int t1 = t0; asm volatile("" : "+s"(t1));
#pragma unroll
    for (int b = 0; b < NB; ++b) if (b < n) { TDesc d; tile_desc(F, l, t1 + b * tstep, d); LAS unsigned char* L = F.lds + b * XP_SLOT;
        if (d.fp8) { const int sw = ((cq >> 2) & 7) << 4;
#pragma unroll
            for (int j = 0; j < 4; ++j) *(LAS unsigned*)(L + (cq + j) * 128 + (row4 ^ sw)) = (d.fp8 == 2) ? pack_i8x4(X.r[b][0][j] * d.qs, X.r[b][1][j] * d.qs, X.r[b][2][j] * d.qs, X.r[b][3][j] * d.qs) : pack_fp8x4(X.r[b][0][j] * W8_SCALE, X.r[b][1][j] * W8_SCALE, X.r[b][2][j] * W8_SCALE, X.r[b][3][j] * W8_SCALE);
        } else { const int sw = ((cq >> 2) & 15) << 4;
#pragma unroll
            for (int j = 0; j < 4; ++j) { u32x2 w; w.x = pack2(X.r[b][0][j], X.r[b][1][j]); w.y = pack2(X.r[b][2][j], X.r[b][3][j]); *(LAS u32x2*)(L + (cq + j) * 256 + ((row4 * 2) ^ sw)) = w; } } }
    __syncthreads();
    int t2 = t0; asm volatile("" : "+s"(t2));
#pragma unroll
    for (int b = 0; b < NB; ++b) if (b < n) { TDesc d; tile_desc(F, l, t2 + b * tstep, d); const LAS unsigned char* L = F.lds + b * XP_SLOT; const int c = tid >> 3, kq = tid & 7;
        if (d.fp8) *(u32x4*)(d.dp + (size_t)c * d.dldb + kq * 16) = *(const LAS u32x4*)(L + c * 128 + ((kq * 16) ^ (((c >> 2) & 7) << 4)));
        else { const int sw = ((c >> 2) & 15) << 4; *(u32x4*)(d.dp + (size_t)c * d.dldb + kq * 16) = *(const LAS u32x4*)(L + c * 256 + ((kq * 16) ^ sw)); *(u32x4*)(d.dp + (size_t)c * d.dldb + 128 + kq * 16) = *(const LAS u32x4*)(L + c * 256 + ((128 + kq * 16) ^ sw)); } }
    __syncthreads();
}
__device__ __forceinline__ void xpose_range(const Frame& F, int l, int tlo, int thi, int rank, int nranks) {
    constexpr int NB = 4; const int step = nranks * NB;
    XRegs<NB> A, B;
    int t = tlo + rank * NB; if (t >= thi) return;
#define XP_CNT(tt) (((thi) - (tt)) < NB ? ((thi) - (tt)) : NB)
    xpose_load<NB>(F, l, t, 1, XP_CNT(t), A);
    for (;;) {
        const int tb = t + step; const bool hb = tb < thi; if (hb) xpose_load<NB>(F, l, tb, 1, XP_CNT(tb), B);
        xpose_finish<NB>(F, l, t, 1, XP_CNT(t), A);
        if (!hb) break;
        const int ta = tb + step; const bool ha = ta < thi; if (ha) xpose_load<NB>(F, l, ta, 1, XP_CNT(ta), A);
        xpose_finish<NB>(F, l, tb, 1, XP_CNT(tb), B);
        if (!ha) break;
        t = ta;
    }
#undef XP_CNT
}
__device__ __forceinline__ void pool_fold(const Frame& F, int l, int rank, int nranks) {
    const KArgs a = F.ka; unsigned char* ws = F.ws_();
    for (size_t i = (size_t)rank * NTHR + F.tid; i < (size_t)W * D; i += (size_t)nranks * NTHR) {
        const int d = (int)(i % D), gc = (int)(i / D), g = gc >> 7;
        const float* pw = ((const float*)a->in[IN_POOLW]) + ((size_t)l * W + gc) * 128; const float* ps = ((const float*)a->in[IN_POOLS]) + l * W + g * 128;
        const float* wb = ((const float*)a->in[IN_WBR]) + ((size_t)l * 4 * W + g * 128) * D + d;
        float s = 0.f;
        for (int e = 0; e < 128; ++e) s += pw[e] * ps[e] * wb[(size_t)e * D];
        ((bf16_t*)(ws + WS_WB + l * SZ_DD))[(size_t)d * D + gc] = f2bf(s);
    }
}
__device__ __forceinline__ void phase_wabs(const Frame& F) {
    const KArgs a = F.ka; unsigned char* ws = F.ws_();
    for (int l = 0; l < DEPTH; ++l) { float m = 0.f; const float* w = ((const float*)a->in[IN_WIN]) + (size_t)l * D * PROJ_W;
        for (size_t i = (size_t)F.wg * NTHR + F.tid; i < (size_t)D * (NBR / 4); i += (size_t)F.nwg * NTHR) { const int c4 = (int)(i % (NBR / 4)), k = (int)(i / (NBR / 4)); const int col = c4 * 4 < 4096 ? c4 * 4 : c4 * 4 + 8;
            const f32x4 v = *(const f32x4*)(w + (size_t)k * PROJ_W + col); m = fmaxf(m, fmaxf(fmaxf(fabsf(v[0]), fabsf(v[1])), fmaxf(fabsf(v[2]), fabsf(v[3])))); }
        m = wave_max(m);
        if (F.lane == 0) __hip_atomic_fetch_max((unsigned*)(ws + WS_CTL) + CW_WABS + l, __float_as_uint(m), __ATOMIC_RELAXED, __HIP_MEMORY_SCOPE_AGENT); }
}
__device__ __forceinline__ void phase_prologue(const Frame& F) {
    const KArgs a = F.ka;
    unsigned char* ws = F.ws_();
    xpose_range(F, 0, 0, TK_WINA + TK_WINB, F.wg, F.nwg);
    const size_t gtid = (size_t)F.wg * NTHR + F.tid, gn = (size_t)F.nwg * NTHR;
    for (size_t i = gtid; i < (size_t)DEPTH * 8 * D; i += gn) { const int k = (int)(i % D), c = (int)((i / D) % 8), l = (int)(i / (8 * D));
        ((float*)(ws + WS_WIF))[i] = ((const float*)a->in[IN_WIN])[(size_t)l * D * PROJ_W + (size_t)k * PROJ_W + 4096 + c]; }
    for (size_t i = gtid; i < (size_t)DEPTH * 16 * D; i += gn) { const int k = (int)(i % D), c = (int)((i / D) % 16), l = (int)(i / (16 * D));
        const float wv = c < 8 ? ((const float*)a->in[IN_WIN])[(size_t)l * D * PROJ_W + (size_t)k * PROJ_W + 4096 + c] : 0.f; const bf16_t hi = f2bf(wv), lo = f2bf(wv - bf2f(hi));
        bf16_t* o = (bf16_t*)(ws + WS_WIFB) + (size_t)l * 2 * 16 * D; o[(size_t)c * D + k] = hi; o[(size_t)(16 + c) * D + k] = lo; }
    for (size_t i = gtid; i < (size_t)DEPTH * NE * D; i += gn) { const int k = (int)(i % D), e = (int)((i / D) % NE), l = (int)(i / ((size_t)NE * D));
        const float w = ((const float*)a->in[IN_RW])[((size_t)l * D + k) * NE + e]; const bf16_t hi = f2bf(w); const bf16_t lo = f2bf(w - bf2f(hi));
        bf16_t* o = (bf16_t*)(ws + WS_RWT) + (size_t)l * 2 * NE * D; o[(size_t)e * D + k] = hi; o[(size_t)(NE + e) * D + k] = lo; }
    for (size_t i = gtid; i < (size_t)SEQ * 64; i += gn) { const int f = (int)(i & 63), s = (int)(i >> 6);
        const float inv = powf(10000.0f, -(float)f / 64.0f); const float ang = (float)s * inv;
        ((float*)(ws + WS_ROPE))[i] = cosf(ang); ((float*)(ws + WS_ROPE))[(size_t)SEQ * 64 + i] = sinf(ang); }
    for (int row = F.wg * 8 + F.wave; row < T; row += F.nwg * 8) { float v[32]; const float* xr = ((const float*)a->in[IN_X]) + (size_t)row * D;
#pragma unroll
        for (int j = 0; j < 4; ++j) { const f32x4 p = *(const f32x4*)(xr + j * 512 + F.lane * 8), q = *(const f32x4*)(xr + j * 512 + F.lane * 8 + 4); v[j * 8] = p[0]; v[j * 8 + 1] = p[1]; v[j * 8 + 2] = p[2]; v[j * 8 + 3] = p[3]; v[j * 8 + 4] = q[0]; v[j * 8 + 5] = q[1]; v[j * 8 + 6] = q[2]; v[j * 8 + 7] = q[3]; }
        st_row32((bf16_t*)(ws + WS_XB) + (size_t)row * D, F.lane, v); st_row32_fp8(ws + WS_XB8 + (size_t)row * D, F.lane, v); st_row32_i8(ws + WS_XQ8 + (size_t)row * D, (float*)(ws + WS_XSC) + row, F.lane, v); }
    for (size_t i = gtid; i < (size_t)TM * D / 4; i += gn) { const f32x4 v = ((const f32x4*)((const float*)a->in[IN_MEM]))[i]; st_bf16x4((bf16_t*)(ws + WS_MEMB) + i * 4, v);
        ((unsigned*)(ws + WS_MEMB8))[i] = pack_fp8x4(v[0] * X8_SCALE, v[1] * X8_SCALE, v[2] * X8_SCALE, v[3] * X8_SCALE); }
    __syncthreads();
}
__device__ __forceinline__ void prologue_deferred(const Frame& F, int rank, int nranks) {
    xpose_range(F, 0, TK_WINA + TK_WINB, TK_LAYER, rank, nranks);
    xpose_range(F, 1, 0, TK_LAYER, rank, nranks);
    pool_fold(F, 0, rank, nranks); pool_fold(F, 1, rank, nranks);
    __syncthreads();
}

__device__ __forceinline__ void unpack8(u32x4 w, float (&f)[8]) {
#pragma unroll
    for (int j = 0; j < 4; ++j) { f[2 * j] = __uint_as_float(w[j] << 16); f[2 * j + 1] = __uint_as_float(w[j] & 0xffff0000u); } }
__device__ __forceinline__ u32x4 pack8f(const float (&f)[8]) { u32x4 w;
#pragma unroll
    for (int j = 0; j < 4; ++j) w[j] = pack2(f[2 * j], f[2 * j + 1]); return w; }
template <int WIN> __device__ __forceinline__ void pool_block(const bf16_t* pu, bf16_t* out, int s0) {
    float sum[8];
#pragma unroll
    for (int e = 0; e < 8; ++e) sum[e] = 0.f;
    u32x4 hist[WIN - 1 + 8];
#pragma unroll
    for (int j = 0; j < WIN - 1 + 8; ++j) { const int ds = j - (WIN - 1); hist[j] = (s0 + ds >= 0) ? *(const u32x4*)(pu + (ptrdiff_t)ds * NBR) : (u32x4){0u, 0u, 0u, 0u}; }
#pragma unroll
    for (int j = 0; j < WIN - 1; ++j) { float f[8]; unpack8(hist[j], f);
#pragma unroll
        for (int e = 0; e < 8; ++e) sum[e] += f[e]; }
#pragma unroll
    for (int i = 0; i < 8; ++i) { float f[8]; unpack8(hist[WIN - 1 + i], f); const int cnt = (s0 + i + 1 < WIN) ? s0 + i + 1 : WIN; const float rc = 1.0f / (float)cnt; float o[8];
#pragma unroll
        for (int e = 0; e < 8; ++e) { sum[e] += f[e]; o[e] = sum[e] * rc - f[e]; }
        *(u32x4*)(out + (size_t)i * D) = pack8f(o);
        float fo[8]; unpack8(hist[i], fo);
#pragma unroll
        for (int e = 0; e < 8; ++e) sum[e] -= fo[e]; }
}
template <bool WITH_D = true> __device__ __forceinline__ void phase_mix1v2(const Frame& F, int l, const bf16_t* xcur) {
    const KArgs a = F.ka;
    unsigned char* ws = F.ws_();
    LAS float* dots = (LAS float*)(F.lds + 65536);
    LAS float* wl = (LAS float*)F.lds;
    const float* wif = (const float*)(ws + WS_WIF) + (size_t)l * 8 * D;
    const float* gb = ((const float*)a->in[IN_GATEB]) + l * 8;
    float* cumf = (float*)(ws + WS_CUMF); float* ipre = (float*)(ws + WS_IPRE); float* summ = (float*)(ws + WS_SUMM); float* av = (float*)(ws + WS_AV); float* pm = (float*)(ws + WS_PM);
    const bf16_t* wifb = (const bf16_t*)(ws + WS_WIFB) + (size_t)l * 2 * 16 * D;
    for (int item = F.wg; item < BATCH * NCH; item += F.nwg) {
        const int b = item / NCH, c = item % NCH; const int t0 = b * SEQ + c * CH;
        { const int lane = F.lane, g = lane >> 4, li = lane & 15, w = F.wave;
          f32x4 acc[4] = {{0.f, 0.f, 0.f, 0.f}, {0.f, 0.f, 0.f, 0.f}, {0.f, 0.f, 0.f, 0.f}, {0.f, 0.f, 0.f, 0.f}};
#pragma unroll 4
          for (int ks = 8 * w; ks < 8 * w + 8; ++ks) { const bf16x8 bh = *(const bf16x8*)(wifb + (size_t)li * D + ks * 32 + g * 8), bl = *(const bf16x8*)(wifb + (size_t)(16 + li) * D + ks * 32 + g * 8);
#pragma unroll
              for (int mt = 0; mt < 4; ++mt) { const bf16x8 xa = *(const bf16x8*)(xcur + (size_t)(t0 + 16 * mt + li) * D + ks * 32 + g * 8);
                  acc[mt] = __builtin_amdgcn_mfma_f32_16x16x32_bf16(xa, bh, acc[mt], 0, 0, 0); acc[mt] = __builtin_amdgcn_mfma_f32_16x16x32_bf16(xa, bl, acc[mt], 0, 0, 0); } }
          LAS float* part = (LAS float*)F.lds;
          if (li < 8) {
#pragma unroll
              for (int mt = 0; mt < 4; ++mt)
#pragma unroll
                  for (int r = 0; r < 4; ++r) part[((w * 64) + 16 * mt + 4 * g + r) * 8 + li] = acc[mt][r]; }
          __syncthreads();
          if (F.tid < 512) { const int tok = F.tid >> 3, q = F.tid & 7; float sacc = 0.f;
#pragma unroll
              for (int ww = 0; ww < 8; ++ww) sacc += part[(ww * 64 + tok) * 8 + q];
              dots[tok * 8 + q] = sacc; } }
        __syncthreads();
        if (F.wave < NH) {
            const int h = F.wave, s = F.lane; const float ip = dots[s * 8 + h] + gb[h], fp = dots[s * 8 + 4 + h] + gb[4 + h];
            const float lf = fminf(fp, 0.f) - log1pf(__expf(-fabsf(fp)));
            float cs = lf;
#pragma unroll
            for (int o = 1; o < 64; o <<= 1) { const float n = __shfl_up(cs, o); if (s >= o) cs += n; }
            const float ftot = __shfl(cs, 63); const float aa = ip - cs;
            float px = aa;
#pragma unroll
            for (int o = 1; o < 64; o <<= 1) { const float n = __shfl_up(px, o); if (s >= o) px = fmaxf(px, n); }
            const float gm = ftot + __shfl(px, 63);
            const size_t o = (size_t)(b * NH + h) * SEQ + c * CH + s; cumf[o] = cs; ipre[o] = ip; av[o] = aa; pm[o] = px;
            if (s == 0) { summ[((size_t)(b * NH + h) * NCH + c) * 2] = ftot; summ[((size_t)(b * NH + h) * NCH + c) * 2 + 1] = gm; }
        }
        __syncthreads();
    }
    bf16_t* proj = (bf16_t*)(ws + WS_PROJ); bf16_t* br = (bf16_t*)(ws + WS_BR);
    for (int it = F.wg * 8 + F.wave; it < (T / 32) * 4; it += F.nwg * 8) {
        const int grp = it & 3, tbq = it >> 2; const int tb = tbq * 4 + (F.lane >> 4), co = grp * 16 + (F.lane & 15);
        const int t0 = tb * 8, s0 = t0 % SEQ; const bf16_t* pu = proj + (size_t)t0 * NBR + PC_U + co * 8; bf16_t* out = br + (size_t)t0 * D + co * 8;
        if (grp == 0) pool_block<2>(pu, out, s0); else if (grp == 1) pool_block<4>(pu, out, s0); else if (grp == 2) pool_block<8>(pu, out, s0); else pool_block<16>(pu, out, s0);
    }
    { const float* cw = ((const float*)a->in[IN_CONVW]) + (size_t)l * 3 * W;
      for (size_t it = (size_t)F.wg * NTHR + F.tid; it < (size_t)(T / 8) * 64; it += (size_t)F.nwg * NTHR) {
        const int co = (int)(it & 63), tb = (int)(it >> 6), t0 = tb * 8, s0 = t0 % SEQ;
        const bf16_t* pr = proj + (size_t)t0 * NBR + co * 8;
        float w0[8], w1[8], w2[8];
#pragma unroll
        for (int e = 0; e < 8; ++e) { w0[e] = cw[co * 8 + e]; w1[e] = cw[W + co * 8 + e]; w2[e] = cw[2 * W + co * 8 + e]; }
        float z1[8], z2[8];
#pragma unroll
        for (int e = 0; e < 8; ++e) { z1[e] = 0.f; z2[e] = 0.f; }
        if (s0 >= 2) { float c_[8], h_[8]; unpack8(*(const u32x4*)(pr + PC_CC - 2 * NBR), c_); unpack8(*(const u32x4*)(pr + PC_CH - 2 * NBR), h_);
#pragma unroll
            for (int e = 0; e < 8; ++e) z2[e] = c_[e] * h_[e]; }
        if (s0 >= 1) { float c_[8], h_[8]; unpack8(*(const u32x4*)(pr + PC_CC - NBR), c_); unpack8(*(const u32x4*)(pr + PC_CH - NBR), h_);
#pragma unroll
            for (int e = 0; e < 8; ++e) z1[e] = c_[e] * h_[e]; }
#pragma unroll
        for (int i = 0; i < 8; ++i) { float c_[8], h_[8], b_[8], o[8]; unpack8(*(const u32x4*)(pr + PC_CC + (size_t)i * NBR), c_); unpack8(*(const u32x4*)(pr + PC_CH + (size_t)i * NBR), h_); unpack8(*(const u32x4*)(pr + PC_CB + (size_t)i * NBR), b_);
#pragma unroll
            for (int e = 0; e < 8; ++e) { const float z0 = c_[e] * h_[e]; o[e] = b_[e] * (w0[e] * z0 + w1[e] * z1[e] + w2[e] * z2[e]); z2[e] = z1[e]; z1[e] = z0; }
            *(u32x4*)(br + (size_t)(t0 + i) * D + W + co * 8) = pack8f(o); }
      } }
    if constexpr (WITH_D) { const float* ropec = (const float*)(ws + WS_ROPE); const float* ropes = ropec + (size_t)SEQ * 64;
      for (size_t it = (size_t)F.wg * NTHR + F.tid; it < (size_t)T * 64; it += (size_t)F.nwg * NTHR) {
        const int oc = (int)(it & 7), hh = (int)((it >> 3) & 3), isk = (int)((it >> 5) & 1), t = (int)(it >> 6), s = t % SEQ;
        bf16_t* p = proj + (size_t)t * NBR + (isk ? PC_RK : PC_RQ) + hh * HD + oc * 8;
        float x1[8], x2[8], o1[8], o2[8]; unpack8(*(const u32x4*)p, x1); unpack8(*(const u32x4*)(p + 64), x2);
#pragma unroll
        for (int e = 0; e < 8; ++e) { const float cs = ropec[(size_t)s * 64 + oc * 8 + e], sn = ropes[(size_t)s * 64 + oc * 8 + e]; o1[e] = x1[e] * cs - x2[e] * sn; o2[e] = x1[e] * sn + x2[e] * cs; }
        *(u32x4*)p = pack8f(o1); *(u32x4*)(p + 64) = pack8f(o2);
      } }
}

__device__ __forceinline__ float ret_gamma_log2(int h) { return log2f(1.0f - exp2f(-5.0f - (float)h)); }

__device__ __forceinline__ void phase_scan_mfma(const Frame& F) {
    unsigned char* ws = F.ws_();
    constexpr int KS2 = 144, WS2 = 48;
    LAS bf16_t* Kb = (LAS bf16_t*)F.lds;
    LAS bf16_t* Wb = Kb + 2 * 64 * KS2;
    LAS float* mS = (LAS float*)(Wb + 2 * 64 * WS2);
    LAS float* fT = mS + 80;
    const bf16_t* proj = (const bf16_t*)(ws + WS_PROJ);
    const float* av = (const float*)(ws + WS_AV); const float* summ = (const float*)(ws + WS_SUMM);
    const int lane = F.lane, g = lane >> 4, li = lane & 15, w = F.wave, tid = F.tid;
    for (int item = F.wg; item < 2 * NBH * 8; item += F.nwg) {
        const int type = item >> 7, bh = (item >> 3) & 15, vs = item & 7, b = bh >> 2, h = bh & 3;
        if (tid == 0) { float m = 0.f; mS[0] = 0.f; for (int c = 0; c < NCH; ++c) { m = fmaxf(summ[((size_t)bh * NCH + c) * 2] + m, summ[((size_t)bh * NCH + c) * 2 + 1]); mS[c + 1] = m; }
            if (type == 0 && vs == 0) { float* ms = (float*)(ws + WS_MSEQ) + bh * 80; for (int c = 0; c <= NCH; ++c) ms[c] = mS[c]; } }
        if (tid >= 64 && tid < 128) fT[tid - 64] = summ[((size_t)bh * NCH + (tid - 64)) * 2];
        __syncthreads();
        const float lg2 = ret_gamma_log2(h);
        const int kcol = (type == 0 ? PC_MK : PC_RK) + h * HD, vcol = (type == 0 ? PC_MV : PC_RV) + h * HD + vs * 16;
        bf16_t* cst = (bf16_t*)(ws + WS_CST) + ((size_t)(type * NBH + bh) * NCH) * HD * HD;
        float* nsv = (float*)(ws + WS_NST) + (size_t)bh * NCH * HD;
        const int krow = tid >> 3, koct = tid & 7, vrow = (tid >> 1) & 63, vhalf = tid & 1;
        const bf16_t* kbase = proj + (size_t)(b * SEQ + krow) * NBR + kcol + koct * 8;
        const bf16_t* vbase = proj + (size_t)(b * SEQ + vrow) * NBR + vcol + vhalf * 8;
        const float* abase = av + (size_t)bh * SEQ + vrow;
        u32x4 kr[2][2], vr[2]; float ar[2];
#define SCAN_LOAD(c, sl) do { const size_t _o = (size_t)(c) * CH * NBR; kr[sl][0] = *(const u32x4*)(kbase + _o); kr[sl][1] = *(const u32x4*)(kbase + _o + 64); \
        if (tid < 128) { vr[sl] = *(const u32x4*)(vbase + _o); ar[sl] = (type == 0) ? abase[(c) * CH] : 0.f; } } while (0)
#define SCAN_WRITE(c, sl, bf) do { LAS bf16_t* _k = Kb + (bf) * 64 * KS2 + krow * KS2 + koct * 8; *(LAS u32x4*)_k = kr[sl][0]; *(LAS u32x4*)(_k + 64) = kr[sl][1]; \
        if (tid < 128) { const float _w = (type == 0) ? __expf(ar[sl] + fT[c] - mS[(c) + 1]) : exp2f((float)(63 - vrow) * lg2); float _f[8]; unpack8(vr[sl], _f); \
            _Pragma("unroll") for (int _e = 0; _e < 8; ++_e) _f[_e] *= _w; LAS bf16_t* _p = Wb + (bf) * 64 * WS2 + vrow * WS2; *(LAS u32x4*)(_p + vhalf * 8) = pack8f(_f); \
            u32x4 _x = {0u, 0u, 0u, 0u}; if (vhalf == 0) _x[0] = (unsigned)f2bf(_w); *(LAS u32x4*)(_p + 16 + vhalf * 8) = _x; } } while (0)
        f32x4 st = {0.f, 0.f, 0.f, 0.f}, na = {0.f, 0.f, 0.f, 0.f};
#define SCAN_BODY(c, bf) do { { u32x2 _pw; _pw.x = pack2(st[0], st[1]); _pw.y = pack2(st[2], st[3]); *(u32x2*)(cst + (size_t)(c) * HD * HD + (size_t)(vs * 16 + li) * HD + 16 * w + 4 * g) = _pw; } \
        if (type == 0 && vs == 0 && li == 0) *(f32x4*)(nsv + (c) * HD + 16 * w + 4 * g) = na; \
        const float _d = (type == 0) ? __expf(fT[c] + mS[c] - mS[(c) + 1]) : exp2f(64.0f * lg2); st *= _d; na *= _d; \
        _Pragma("unroll") for (int _u = 0; _u < 2; ++_u) { const LAS bf16_t* _kp = Kb + (bf) * 64 * KS2 + (32 * _u + 8 * g + (li >> 2)) * KS2 + 16 * w + 4 * (li & 3); \
            const LAS bf16_t* _wp = Wb + (bf) * 64 * WS2 + (32 * _u + 8 * g + (li >> 2)) * WS2 + 4 * (li & 3); \
            const bf16x8 _A = cat4(lds_tr(_kp), lds_tr(_kp + 4 * KS2)); const bf16x8 _B = cat4(lds_tr(_wp), lds_tr(_wp + 4 * WS2)); \
            st = __builtin_amdgcn_mfma_f32_16x16x32_bf16(_A, _B, st, 0, 0, 0); \
            if (type == 0) { const bf16x8 _B2 = cat4(lds_tr(_wp + 16), lds_tr(_wp + 4 * WS2 + 16)); na = __builtin_amdgcn_mfma_f32_16x16x32_bf16(_A, _B2, na, 0, 0, 0); } } } while (0)
        SCAN_LOAD(0, 0); SCAN_WRITE(0, 0, 0); SCAN_LOAD(1, 1); SCAN_LOAD(2, 0);
        __syncthreads();
        for (int c = 0; c < NCH; c += 2) {
            SCAN_BODY(c, 0);
            SCAN_WRITE(c + 1, 1, 1);
            if (c + 3 < NCH) SCAN_LOAD(c + 3, 1);
            __syncthreads();
            SCAN_BODY(c + 1, 1);
            if (c + 2 < NCH) { SCAN_WRITE(c + 2, 0, 0); }
            if (c + 4 < NCH) SCAN_LOAD(c + 4, 0);
            __syncthreads();
        }
#undef SCAN_LOAD
#undef SCAN_WRITE
#undef SCAN_BODY
    }
}

__device__ __forceinline__ void phase_chunk_mfma(const Frame& F, int l) {
    const KArgs a = F.ka; unsigned char* ws = F.ws_();
    constexpr int QS = 136, VS = 144, PS = 72;
    LAS bf16_t* Qs = (LAS bf16_t*)F.lds; LAS bf16_t* Ks = Qs + 64 * QS; LAS bf16_t* Vs = Ks + 64 * QS; LAS bf16_t* Ps = Vs + 64 * VS;
    LAS float* rv = (LAS float*)(Ps + 64 * PS);
    LAS float* hp = rv + 256;
    const bf16_t* proj = (const bf16_t*)(ws + WS_PROJ); bf16_t* br = (bf16_t*)(ws + WS_BR);
    const float* cumf = (const float*)(ws + WS_CUMF); const float* av = (const float*)(ws + WS_AV); const float* pm = (const float*)(ws + WS_PM); const float* mseq = (const float*)(ws + WS_MSEQ);
    const int lane = F.lane, g = lane >> 4, li = lane & 15, w = F.wave;
    bf16x8 ones;
#pragma unroll
    for (int j = 0; j < 8; ++j) ones[j] = (short)0x3F80;
    u32x4 pq[2], pk[2], pvv[2]; float prv[4] = {0.f, 0.f, 0.f, 0.f};
#define CH_LOAD(it) do { const int _ty = (it) / (NBH * NCH), _bh = ((it) / NCH) % NBH, _c = (it) % NCH, _h = _bh & 3; const int _t0 = (_bh >> 2) * SEQ + _c * CH; \
        const bf16_t* _pr = proj + (size_t)(_t0 + (F.tid >> 3)) * NBR + (F.tid & 7) * 8 + _h * HD; \
        pq[0] = *(const u32x4*)(_pr + (_ty == 0 ? PC_MQ : PC_RQ)); pq[1] = *(const u32x4*)(_pr + (_ty == 0 ? PC_MQ : PC_RQ) + 64); \
        pk[0] = *(const u32x4*)(_pr + (_ty == 0 ? PC_MK : PC_RK)); pk[1] = *(const u32x4*)(_pr + (_ty == 0 ? PC_MK : PC_RK) + 64); \
        pvv[0] = *(const u32x4*)(_pr + (_ty == 0 ? PC_MV : PC_RV)); pvv[1] = *(const u32x4*)(_pr + (_ty == 0 ? PC_MV : PC_RV) + 64); \
        if (_ty == 0 && F.tid < 64) { const size_t _go = (size_t)_bh * SEQ + _c * CH + F.tid; prv[0] = av[_go]; prv[1] = pm[_go]; prv[2] = cumf[_go]; prv[3] = mseq[_bh * 80 + _c]; } } while (0)
    if (F.wg < 2 * NBH * NCH) CH_LOAD(F.wg);
    for (int item = F.wg; item < 2 * NBH * NCH; item += F.nwg) {
        const int type = item / (NBH * NCH), bh = (item / NCH) % NBH, c = item % NCH, b = bh >> 2, h = bh & 3;
        const int t0 = b * SEQ + c * CH; const size_t go = (size_t)bh * SEQ + c * CH;
        const float lg2 = ret_gamma_log2(h);
        const int vc = h * HD + 16 * w + 4 * g;
        u32x2 gate[4]; bf16x8 cfr[4]; f32x4 nr[4][2];
        const f32x4 nw4 = *(const f32x4*)((type == 0 ? ((const float*)a->in[IN_MNORM]) : ((const float*)a->in[IN_RNORM])) + l * W + vc);
#pragma unroll
        for (int tt = 0; tt < 4; ++tt) gate[tt] = *(const u32x2*)(proj + (size_t)(t0 + 16 * tt + li) * NBR + (type == 0 ? PC_MO : PC_RG) + vc);
        if (c > 0) { const bf16_t* cst = (const bf16_t*)(ws + WS_CST) + ((size_t)(type * NBH + bh) * NCH + c) * HD * HD; const float* nsv = (const float*)(ws + WS_NST) + ((size_t)bh * NCH + c) * HD;
#pragma unroll
            for (int kk = 0; kk < 4; ++kk) { cfr[kk] = *(const bf16x8*)(cst + (size_t)(16 * w + li) * HD + kk * 32 + g * 8);
                if (type == 0) { nr[kk][0] = *(const f32x4*)(nsv + kk * 32 + g * 8); nr[kk][1] = *(const f32x4*)(nsv + kk * 32 + g * 8 + 4); } } }
        { const int row = F.tid >> 3, oct = F.tid & 7;
          *(LAS u32x4*)(Qs + row * QS + oct * 8) = pq[0]; *(LAS u32x4*)(Qs + row * QS + 64 + oct * 8) = pq[1];
          *(LAS u32x4*)(Ks + row * QS + oct * 8) = pk[0]; *(LAS u32x4*)(Ks + row * QS + 64 + oct * 8) = pk[1];
          *(LAS u32x4*)(Vs + row * VS + oct * 8) = pvv[0]; *(LAS u32x4*)(Vs + row * VS + 64 + oct * 8) = pvv[1]; }
        if (F.tid < 64) { const int t = F.tid;
            if (type == 0) { const float mp = prv[3]; const float bt = fmaxf(mp, prv[1]); rv[t] = prv[0]; rv[64 + t] = bt; rv[128 + t] = __expf(mp - bt); rv[192 + t] = __expf(-prv[2] - bt); }
            else rv[128 + t] = exp2f((float)(t + 1) * lg2); }
        if (item + F.nwg < 2 * NBH * NCH) CH_LOAD(item + F.nwg);
        __syncthreads();
        { const int tt = w >> 1, t = 16 * tt + li;
#pragma unroll
          for (int sti = 0; sti < 2; ++sti) { const int st = (w & 1) * 2 + sti; f32x4 acc = {0.f, 0.f, 0.f, 0.f};
            if (st <= tt) {
#pragma unroll
                for (int kk = 0; kk < 4; ++kk) { const bf16x8 kf = *(const LAS bf16x8*)(Ks + (16 * st + li) * QS + kk * 32 + g * 8), qf = *(const LAS bf16x8*)(Qs + (16 * tt + li) * QS + kk * 32 + g * 8);
                    acc = __builtin_amdgcn_mfma_f32_16x16x32_bf16(kf, qf, acc, 0, 0, 0); }
#pragma unroll
                for (int r = 0; r < 4; ++r) { const int sx = 16 * st + 4 * g + r; float wgt;
                    if (type == 0) wgt = __expf(rv[sx] - rv[64 + t]); else wgt = exp2f((float)(t - sx) * lg2);
                    acc[r] = (sx <= t) ? acc[r] * wgt : 0.f; } }
            u32x2 pw; pw.x = pack2(acc[0], acc[1]); pw.y = pack2(acc[2], acc[3]); *(LAS u32x2*)(Ps + t * PS + 16 * st + 4 * g) = pw; } }
        __syncthreads();
        f32x4 pv[4], qc[4], dn[4], qn[4];
#pragma unroll
        for (int tt = 0; tt < 4; ++tt) { pv[tt] = (f32x4){0.f, 0.f, 0.f, 0.f}; qc[tt] = pv[tt]; dn[tt] = pv[tt]; qn[tt] = pv[tt]; }
#pragma unroll
        for (int u = 0; u < 2; ++u) {
            const bf16x8 vf = cat4(lds_tr(Vs + (32 * u + 8 * g + (li >> 2)) * VS + 16 * w + 4 * (li & 3)), lds_tr(Vs + (32 * u + 8 * g + 4 + (li >> 2)) * VS + 16 * w + 4 * (li & 3)));
#pragma unroll
            for (int tt = 0; tt < 4; ++tt) { const bf16x8 pf = *(const LAS bf16x8*)(Ps + (16 * tt + li) * PS + 32 * u + 8 * g);
                pv[tt] = __builtin_amdgcn_mfma_f32_16x16x32_bf16(vf, pf, pv[tt], 0, 0, 0);
                if (type == 0) dn[tt] = __builtin_amdgcn_mfma_f32_16x16x32_bf16(ones, pf, dn[tt], 0, 0, 0); } }
        if (c > 0) {
#pragma unroll
            for (int kk = 0; kk < 4; ++kk) { const bf16x8 cf = cfr[kk];
                bf16x8 nf = ones;
                if (type == 0) nf = pack8(nr[kk][0], nr[kk][1]);
#pragma unroll
                for (int tt = 0; tt < 4; ++tt) { const bf16x8 qf = *(const LAS bf16x8*)(Qs + (16 * tt + li) * QS + kk * 32 + g * 8);
                    qc[tt] = __builtin_amdgcn_mfma_f32_16x16x32_bf16(cf, qf, qc[tt], 0, 0, 0);
                    if (type == 0) qn[tt] = __builtin_amdgcn_mfma_f32_16x16x32_bf16(nf, qf, qn[tt], 0, 0, 0); } } }
#pragma unroll
        for (int tt = 0; tt < 4; ++tt) { const int t = 16 * tt + li; const float inter = rv[128 + t]; f32x4 hv;
            if (type == 0) { const float den = inter * qn[tt][0] + dn[tt][0]; const float rd = 1.0f / fmaxf(fabsf(den), rv[192 + t]);
                const u32x2 ow = gate[tt];
                const float o0 = __uint_as_float(ow.x << 16), o1 = __uint_as_float(ow.x & 0xffff0000u), o2 = __uint_as_float(ow.y << 16), o3 = __uint_as_float(ow.y & 0xffff0000u);
                hv[0] = sigmoidf_(o0) * (inter * qc[tt][0] + pv[tt][0]) * rd; hv[1] = sigmoidf_(o1) * (inter * qc[tt][1] + pv[tt][1]) * rd;
                hv[2] = sigmoidf_(o2) * (inter * qc[tt][2] + pv[tt][2]) * rd; hv[3] = sigmoidf_(o3) * (inter * qc[tt][3] + pv[tt][3]) * rd; }
            else hv = pv[tt] + qc[tt] * inter;
            pv[tt] = hv;
            float s1 = (hv[0] + hv[1]) + (hv[2] + hv[3]), s2 = (hv[0] * hv[0] + hv[1] * hv[1]) + (hv[2] * hv[2] + hv[3] * hv[3]);
            s1 += __shfl_xor(s1, 16); s1 += __shfl_xor(s1, 32); s2 += __shfl_xor(s2, 16); s2 += __shfl_xor(s2, 32);
            if (g == 0) { hp[(w * 64 + t) * 2] = s1; hp[(w * 64 + t) * 2 + 1] = s2; } }
        __syncthreads();
#pragma unroll
        for (int tt = 0; tt < 4; ++tt) { const int t = 16 * tt + li; float s1 = 0.f, s2 = 0.f;
#pragma unroll
            for (int ww = 0; ww < 8; ++ww) { const f32x2 p2 = *(const LAS f32x2*)(hp + (ww * 64 + t) * 2); s1 += p2.x; s2 += p2.y; }
            const float mu = s1 * (1.0f / 128.0f), var = fmaxf(s2 * (1.0f / 128.0f) - mu * mu, 0.f), rstd = rsqrtf(var + LN_EPS);
            f32x4 y = (pv[tt] - mu) * rstd * nw4;
            if (type == 1) { const u32x2 gw = gate[tt];
                const float g0 = __uint_as_float(gw.x << 16), g1 = __uint_as_float(gw.x & 0xffff0000u), g2 = __uint_as_float(gw.y << 16), g3 = __uint_as_float(gw.y & 0xffff0000u);
                y[0] *= g0 * sigmoidf_(g0); y[1] *= g1 * sigmoidf_(g1); y[2] *= g2 * sigmoidf_(g2); y[3] *= g3 * sigmoidf_(g3); }
            st_bf16x4(br + (size_t)(t0 + t) * D + (type == 0 ? 1024 : 1536) + vc, y); }
        __syncthreads();
    }
#undef CH_LOAD
}

__device__ __forceinline__ void ln_row(float (&v)[32], const float* lw, const float* lb, int lane) {
    float s = 0.f;
#pragma unroll
    for (int j = 0; j < 32; ++j) s += v[j];
    const float mu = wave_sum(s) * (1.0f / D); float q = 0.f;
#pragma unroll
    for (int j = 0; j < 32; ++j) { const float d = v[j] - mu; q += d * d; }
    const float rstd = rsqrtf(wave_sum(q) * (1.0f / D) + LN_EPS);
#pragma unroll
    for (int j = 0; j < 4; ++j)
#pragma unroll
        for (int h = 0; h < 2; ++h) { const f32x4 w4 = *(const f32x4*)(lw + j * 512 + lane * 8 + h * 4), b4 = *(const f32x4*)(lb + j * 512 + lane * 8 + h * 4);
#pragma unroll
            for (int e = 0; e < 4; ++e) v[j * 8 + h * 4 + e] = (v[j * 8 + h * 4 + e] - mu) * rstd * w4[e] + b4[e]; }
}
__device__ __forceinline__ void phase_ln(const Frame& F, const bf16_t* y, const float* lw, const float* lb, bf16_t* xb, unsigned char* xb8) {
    for (int row = F.wg * 8 + F.wave; row < T; row += F.nwg * 8) {
        float v[32]; ld_row32(y + (size_t)row * D, F.lane, v);
        ln_row(v, lw, lb, F.lane);
        st_row32(xb + (size_t)row * D, F.lane, v); st_row32_fp8(xb8 + (size_t)row * D, F.lane, v);
    }
}
__device__ __forceinline__ void split8(f32x4 a, f32x4 b, bf16x8& hi, bf16x8& lo) {
    union { u32x4 u; bf16x8 h; } H, L;
#pragma unroll
    for (int j = 0; j < 2; ++j) { const bf16_t h0 = f2bf(a[2 * j]), h1 = f2bf(a[2 * j + 1]); H.u[j] = (unsigned)h0 | ((unsigned)h1 << 16); L.u[j] = pack2(a[2 * j] - bf2f(h0), a[2 * j + 1] - bf2f(h1)); }
#pragma unroll
    for (int j = 0; j < 2; ++j) { const bf16_t h0 = f2bf(b[2 * j]), h1 = f2bf(b[2 * j + 1]); H.u[2 + j] = (unsigned)h0 | ((unsigned)h1 << 16); L.u[2 + j] = pack2(b[2 * j] - bf2f(h0), b[2 * j + 1] - bf2f(h1)); }
    hi = H.h; lo = L.h; }
__device__ __forceinline__ void phase_ln_router(const Frame& F, int l, const bf16_t* y, bf16_t* xb) {
    const KArgs a = F.ka;
    unsigned char* ws = F.ws_();
    constexpr int XS = D + 8, RB = 32;
    LAS bf16_t* xsh = (LAS bf16_t*)F.lds;
    LAS float* part = (LAS float*)F.lds;
    LAS int* lcnt = (LAS int*)(xsh + RB * XS);
    if (F.tid < 128) lcnt[F.tid] = 0;
    __syncthreads();
    const float* lw = ((const float*)a->in[IN_LNW]) + ((size_t)l * 3 + 1) * D; const float* lb = ((const float*)a->in[IN_LNB]) + ((size_t)l * 3 + 1) * D;
    const bf16_t* rwt = (const bf16_t*)(ws + WS_RWT) + (size_t)l * 2 * NE * D; const float* rb = ((const float*)a->in[IN_RB]) + l * NE;
    unsigned* counts = (unsigned*)(ws + WS_CTL) + CW_COUNTS + l * 64;
    int* eid = (int*)(ws + WS_EID); float* ew = (float*)(ws + WS_EW); int* epos = (int*)(ws + WS_EPOS);
    const int lane = F.lane, g = lane >> 4, li = lane & 15, nt = F.wave & 3, kh = F.wave >> 2;
    for (int blk = F.wg; blk < T / RB; blk += F.nwg) {
        for (int rr = 0; rr < 4; ++rr) {
            const int lr = F.wave * 4 + rr, row = blk * RB + lr;
            float v[32]; ld_row32(y + (size_t)row * D, F.lane, v);
            ln_row(v, lw, lb, F.lane);
            st_row32(xb + (size_t)row * D, F.lane, v); st_row32_fp8(ws + WS_XB8 + (size_t)row * D, F.lane, v);
#pragma unroll
            for (int j = 0; j < 4; ++j) { u32x4 hi;
#pragma unroll
                for (int e2 = 0; e2 < 4; ++e2) hi[e2] = pack2(v[j * 8 + 2 * e2], v[j * 8 + 2 * e2 + 1]);
                *(LAS u32x4*)(xsh + lr * XS + j * 512 + F.lane * 8) = hi; }
        }
        __syncthreads();
        f32x4 acc[2] = {{0.f, 0.f, 0.f, 0.f}, {0.f, 0.f, 0.f, 0.f}};
        { const bf16_t* wh = rwt + (size_t)(16 * nt + li) * D + kh * 1024 + g * 8; const bf16_t* wl = wh + (size_t)NE * D;
          const LAS bf16_t* xr = xsh + li * XS + kh * 1024 + g * 8;
#pragma unroll 8
          for (int ks = 0; ks < 32; ++ks) { const bf16x8 bh = *(const bf16x8*)(wh + ks * 32), bl = *(const bf16x8*)(wl + ks * 32);
#pragma unroll
              for (int mt = 0; mt < 2; ++mt) { const bf16x8 xh = *(const LAS bf16x8*)(xr + mt * 16 * XS + ks * 32);
                  acc[mt] = __builtin_amdgcn_mfma_f32_16x16x32_bf16(xh, bh, acc[mt], 0, 0, 0); acc[mt] = __builtin_amdgcn_mfma_f32_16x16x32_bf16(xh, bl, acc[mt], 0, 0, 0); } } }
        __syncthreads();
#pragma unroll
        for (int mt = 0; mt < 2; ++mt)
#pragma unroll
            for (int r = 0; r < 4; ++r) part[(kh * RB + 16 * mt + 4 * g + r) * 64 + 16 * nt + li] = acc[mt][r];
        __syncthreads();
        const int e = F.lane;
        const float bias = rb[e];
        for (int rr = 0; rr < 4; ++rr) {
            const int lr = F.wave * 4 + rr, row = blk * RB + lr;
            const float sc = sigmoidf_(part[lr * 64 + e] + part[(RB + lr) * 64 + e]), bs = sc + bias;
            float m1 = bs; m1 = fmaxf(m1, __shfl_xor(m1, 1)); m1 = fmaxf(m1, __shfl_xor(m1, 2)); m1 = fmaxf(m1, __shfl_xor(m1, 4));
            const unsigned long long eq = __ballot(bs == m1); const int gq = e >> 3; const unsigned gm = (unsigned)(eq >> (gq * 8)) & 0xffu; const int first = gq * 8 + __builtin_ctz(gm);
            float m2 = (e == first) ? -INFINITY : bs; m2 = fmaxf(m2, __shfl_xor(m2, 1)); m2 = fmaxf(m2, __shfl_xor(m2, 2)); m2 = fmaxf(m2, __shfl_xor(m2, 4));
            const float gs = m1 + m2;
            int grank = 0;
#pragma unroll
            for (int g2 = 0; g2 < 8; ++g2) { const float o = __shfl(gs, g2 * 8); grank += (o > gs || (o == gs && g2 < gq)) ? 1 : 0; }
            const bool gsel = grank < 4;
            const float val = gsel ? bs : -INFINITY;
            int rank = 0;
            for (int e2 = 0; e2 < 64; ++e2) { const float o = __shfl(val, e2); rank += (o > val || (o == val && e2 < e)) ? 1 : 0; }
            const bool sel = gsel && rank < TOPK;
            const float wsum = wave_sum(sel ? sc : 0.f);
            const unsigned long long sm = __ballot(sel);
            if (sel) { const int k = __builtin_popcountll(sm & ((1ull << e) - 1ull));
                const int pos = __hip_atomic_fetch_add((int*)lcnt + e, 1, __ATOMIC_RELAXED, __HIP_MEMORY_SCOPE_WORKGROUP);
                eid[(size_t)row * 8 + k] = e; ew[(size_t)row * 8 + k] = sc / wsum * ROUTE_SCALE; epos[(size_t)row * 8 + k] = pos; }
        }
        __syncthreads();
    }
    if (F.tid < 64) { const int n = lcnt[F.tid]; lcnt[64 + F.tid] = n > 0 ? (int)__hip_atomic_fetch_add(counts + F.tid, (unsigned)n, __ATOMIC_RELAXED, __HIP_MEMORY_SCOPE_AGENT) : 0; }
    asm volatile("s_waitcnt vmcnt(0)" ::: "memory");
    __syncthreads();
    for (int blk = F.wg; blk < T / RB; blk += F.nwg) { if (F.tid < RB * 8) { const size_t i = (size_t)blk * (RB * 8) + F.tid; epos[i] += lcnt[64 + eid[i]]; } }
    __syncthreads();
}
__device__ __forceinline__ void build_pstart(const Frame& F, int l, LAS int* pst) {
    const unsigned* counts = (const unsigned*)(F.ws_() + WS_CTL) + CW_COUNTS + l * 64;
    if (F.tid < 64) {
        const int c = (int)__hip_atomic_load(counts + F.tid, __ATOMIC_RELAXED, __HIP_MEMORY_SCOPE_AGENT); const int pc = (c + 255) & ~255; int inc = pc;
#pragma unroll
        for (int o = 1; o < 64; o <<= 1) { const int n = __shfl_up(inc, o); if (F.tid >= o) inc += n; }
        pst[F.tid] = inc - pc; if (F.tid == 63) { pst[NE] = inc; pst[NE + 1] = inc + T; } }
    __syncthreads();
    { LAS unsigned char* texp = (LAS unsigned char*)(pst + 68);
      for (int rt = F.tid; rt < (pst[NE + 1] >> 8); rt += NTHR) { int e = 0; while (e < NE && pst[e + 1] <= rt * 256) ++e; texp[rt] = (unsigned char)e; } }
    __syncthreads();
}
__device__ __forceinline__ void phase_slots(const Frame& F, int l) {
    unsigned char* ws = F.ws_();
    LAS int* pst = (LAS int*)F.lds;
    build_pstart(F, l, pst);
    const unsigned* counts = (const unsigned*)(ws + WS_CTL) + CW_COUNTS + l * 64;
    const int* eid = (const int*)(ws + WS_EID); const float* ew = (const float*)(ws + WS_EW); const int* epos = (const int*)(ws + WS_EPOS);
    int* slotof = (int*)(ws + WS_SLOTOF); int* tok = (int*)(ws + WS_TOK); float* wsl = (float*)(ws + WS_WSL);
    const size_t gtid = (size_t)F.wg * NTHR + F.tid, gn = (size_t)F.nwg * NTHR;
    for (size_t i = gtid; i < (size_t)T * 8; i += gn) { const int e = eid[i]; const int slot = pst[e] + epos[i]; slotof[i] = slot; tok[slot] = (int)(i >> 3); wsl[slot] = ew[i]; }
    for (size_t i = gtid; i < (size_t)NE * 256; i += gn) { const int e = (int)(i >> 8), r = (int)(i & 255); const int c = (int)counts[e]; const int slot = pst[e] + c + r; if (slot < pst[e + 1]) { tok[slot] = 0; wsl[slot] = 0.f; } }
    for (size_t i = gtid; i < (size_t)T; i += gn) { tok[pst[NE] + i] = (int)i; wsl[pst[NE] + i] = 1.0f; }
    __syncthreads();
}
__device__ __forceinline__ void phase_combine_ln(const Frame& F, int l, bf16_t* xb, float* out) {
    const KArgs a = F.ka;
    unsigned char* ws = F.ws_();
    LAS int* pst = (LAS int*)F.lds;
    build_pstart(F, l, pst);
    const int sh0 = pst[NE];
    const int* slotof = (const int*)(ws + WS_SLOTOF); const unsigned char* yb = ws + WS_YB;
    const float* lw = ((const float*)a->in[IN_LNW]) + ((size_t)l * 3 + 2) * D; const float* lb = ((const float*)a->in[IN_LNB]) + ((size_t)l * 3 + 2) * D;
    for (int row = F.wg * 8 + F.wave; row < T; row += F.nwg * 8) {
        float v[32]; ld_row32(xb + (size_t)row * D, F.lane, v);
#pragma unroll
        for (int j = 0; j < 32; ++j) v[j] *= ALPHA;
        float ys[32];
#pragma unroll
        for (int j = 0; j < 32; ++j) ys[j] = 0.f;
#pragma unroll 3
        for (int k = 0; k < 9; ++k) { const int slot = k < 8 ? slotof[(size_t)row * 8 + k] : sh0 + row; const unsigned char* yr = yb + (size_t)slot * D;
#pragma unroll
            for (int j = 0; j < 4; ++j) { const u32x2 w = *(const u32x2*)(yr + j * 512 + F.lane * 8);
                const f32x2 p0 = __builtin_amdgcn_cvt_pk_f32_fp8((int)w.x, false), p1 = __builtin_amdgcn_cvt_pk_f32_fp8((int)w.x, true), p2 = __builtin_amdgcn_cvt_pk_f32_fp8((int)w.y, false), p3 = __builtin_amdgcn_cvt_pk_f32_fp8((int)w.y, true);
                ys[j * 8] += p0.x; ys[j * 8 + 1] += p0.y; ys[j * 8 + 2] += p1.x; ys[j * 8 + 3] += p1.y; ys[j * 8 + 4] += p2.x; ys[j * 8 + 5] += p2.y; ys[j * 8 + 6] += p3.x; ys[j * 8 + 7] += p3.y; } }
#pragma unroll
        for (int j = 0; j < 32; ++j) v[j] += ys[j] * (1.0f / Y8_SCALE);
        ln_row(v, lw, lb, F.lane);
        if (out) {
#pragma unroll
            for (int j = 0; j < 4; ++j) { *(f32x4*)(out + (size_t)row * D + j * 512 + F.lane * 8) = (f32x4){v[j * 8], v[j * 8 + 1], v[j * 8 + 2], v[j * 8 + 3]}; *(f32x4*)(out + (size_t)row * D + j * 512 + F.lane * 8 + 4) = (f32x4){v[j * 8 + 4], v[j * 8 + 5], v[j * 8 + 6], v[j * 8 + 7]}; }
        } else { st_row32(xb + (size_t)row * D, F.lane, v); st_row32_fp8(ws + WS_XB8 + (size_t)row * D, F.lane, v); st_row32_i8(ws + WS_XQ8 + (size_t)row * D, (float*)(ws + WS_XSC) + row, F.lane, v); }
    }
    __syncthreads();
}

__device__ __forceinline__ void phase_attn_mfma(const Frame& F, int l) {
    unsigned char* ws = F.ws_();
    constexpr int KS = 136, VS = 144;
    LAS bf16_t* Ks = (LAS bf16_t*)F.lds; LAS bf16_t* Vs = Ks + 256 * KS;
    const bf16_t* q = (const bf16_t*)(ws + WS_Q); const bf16_t* km = (const bf16_t*)(ws + WS_KM) + (size_t)l * TM * W; const bf16_t* vm = (const bf16_t*)(ws + WS_VM) + (size_t)l * TM * W;
    bf16_t* o = (bf16_t*)(ws + WS_O);
    const int nunit = (T / 128) * 4, upw = (nunit + F.nwg - 1) / F.nwg;
    const int lane = F.lane, g = lane >> 4, li = lane & 15;
    int loaded = -1;
    const int u_end = (F.wg + 1) * upw < nunit ? (F.wg + 1) * upw : nunit;
    for (int u = F.wg * upw; u < u_end; ++u) {
        const int bh = u >> 5, blk = u & 31, b = bh >> 2, hh = bh & 3;
        if (bh != loaded) {
            __syncthreads();
            const int m = F.tid >> 1, half = F.tid & 1;
            const bf16_t* kr = km + (size_t)(b * MEM + m) * W + hh * HD + half * 64; const bf16_t* vr = vm + (size_t)(b * MEM + m) * W + hh * HD + half * 64;
#pragma unroll
            for (int j = 0; j < 8; ++j) { *(LAS u32x4*)(Ks + m * KS + half * 64 + j * 8) = *(const u32x4*)(kr + j * 8); *(LAS u32x4*)(Vs + m * VS + half * 64 + j * 8) = *(const u32x4*)(vr + j * 8); }
            __syncthreads(); loaded = bh;
        }
        const int t0 = b * SEQ + blk * 128 + F.wave * 16;
        bf16x8 qf[4];
#pragma unroll
        for (int kk = 0; kk < 4; ++kk) qf[kk] = *(const bf16x8*)(q + (size_t)(t0 + li) * W + hh * HD + kk * 32 + g * 8);
        f32x4 sacc[16];
#pragma unroll
        for (int tt = 0; tt < 16; ++tt) { f32x4 acc = {0.f, 0.f, 0.f, 0.f};
#pragma unroll
            for (int kk = 0; kk < 4; ++kk) { const bf16x8 kf = *(const LAS bf16x8*)(Ks + (16 * tt + li) * KS + kk * 32 + g * 8); acc = __builtin_amdgcn_mfma_f32_16x16x32_bf16(kf, qf[kk], acc, 0, 0, 0); }
            sacc[tt] = acc; }
        float mx = -INFINITY;
#pragma unroll
        for (int tt = 0; tt < 16; ++tt) mx = fmaxf(mx, fmaxf(fmaxf(sacc[tt][0], sacc[tt][1]), fmaxf(sacc[tt][2], sacc[tt][3])));
        mx = fmaxf(mx, __shfl_xor(mx, 16)); mx = fmaxf(mx, __shfl_xor(mx, 32));
        const float c2 = 0.08838834764831845f * 1.4426950408889634f; float sum = 0.f;
#pragma unroll
        for (int tt = 0; tt < 16; ++tt)
#pragma unroll
            for (int r = 0; r < 4; ++r) { const float p = exp2f((sacc[tt][r] - mx) * c2); sacc[tt][r] = p; sum += p; }
        sum += __shfl_xor(sum, 16); sum += __shfl_xor(sum, 32);
        const float rs = 1.0f / sum;
        bf16x8 pk[8];
#pragma unroll
        for (int u8 = 0; u8 < 8; ++u8) pk[u8] = pack8(sacc[2 * u8], sacc[2 * u8 + 1]);
#pragma unroll
        for (int dvt = 0; dvt < 8; ++dvt) { f32x4 acc = {0.f, 0.f, 0.f, 0.f};
#pragma unroll
            for (int u8 = 0; u8 < 8; ++u8) { const s16x4 a0 = lds_tr(Vs + (32 * u8 + 4 * g + (li >> 2)) * VS + dvt * 16 + 4 * (li & 3)); const s16x4 a1 = lds_tr(Vs + (32 * u8 + 16 + 4 * g + (li >> 2)) * VS + dvt * 16 + 4 * (li & 3));
                acc = __builtin_amdgcn_mfma_f32_16x16x32_bf16(cat4(a0, a1), pk[u8], acc, 0, 0, 0); }
            st_bf16x4(o + (size_t)(t0 + li) * W + hh * HD + dvt * 16 + 4 * g, acc * rs); }
    }
    __syncthreads();
}

template <class Epi>
__device__ __forceinline__ void gemm_dense_mfma(const Frame& F, const bf16_t* A, const bf16_t* Bt, int M, int N, int K, const Epi& E) {
    DenseSched S; S.A = A; S.Bt = Bt; S.K = K; S.nM = M / 256; S.nN = N / 256; S.nwg = S.nM * S.nN; S.G = F.nwg; S.c = F.wg; S.i0 = 0; S.i1 = 1 << 30; S.pnoff = 0;
    gemm_phase_mfma(F, K, S, E);
}
constexpr int NPL = 15, NPHASE = 1 + DEPTH * NPL;
#ifndef NCONV
#define NCONV 40
#endif
#if MK_PER_PHASE
#define IN(k) (lo <= (k) && (k) < hi)
#define SEAM(k) do { if (IN((k) + 1)) { XcdBarrier b2_ = bar; asm volatile("" : "+s"(b2_.bar)); asm volatile("" : "+s"(b2_.x)); xcd_barrier(b2_); } } while (0)
#else
#define IN(k) true
#define SEAM(k) do { if ((k) + 1 < NPHASE) for (int rb_ = 0; rb_ < ((PROBE_DBL & 4096) ? 3 : 1); ++rb_) { XcdBarrier b2_ = bar; asm volatile("" : "+s"(b2_.bar)); asm volatile("" : "+s"(b2_.x)); xcd_barrier(b2_); } } while (0)
#endif
template <int l> __device__ __forceinline__ void run_layer(const Frame& F0, const XcdBarrier& bar, int lo, int hi) {
    const int pb = 1 + l * NPL;
    if (IN(pb + 0)) { const Frame F = fresh(F0); unsigned char* ws = F.ws_();
        EpiProj E{(bf16_t*)(ws + WS_PROJ), (bf16_t*)(ws + WS_GATES)};
        { DenseSched S; S.A = (const bf16_t*)(ws + WS_XQ8); S.Bt = (const bf16_t*)(ws + WS_WINQ + l * SZ_WINQ); S.K = D / 2; S.nM = T / 256; S.nN = NBR / 256; S.nwg = S.nM * S.nN; S.G = F.nwg; S.c = F.wg; S.i0 = 0; S.i1 = 1 << 30; S.pnoff = 0;
          const float wsc = __uint_as_float(((const unsigned*)(ws + WS_CTL))[CW_WABS + l]) * (1.0f / 127.0f);
          gemm_phase_mfma<EpiProj, DenseSched, 2>(F, D, S, E, wsc, (const float*)(ws + WS_XSC)); }
        { const Frame F2 = fresh(F0); unsigned char* ws2 = F2.ws_(); EpiProj E2{(bf16_t*)(ws2 + WS_PROJ), (bf16_t*)(ws2 + WS_GATES)};
          DenseSched S; S.A = (const bf16_t*)(ws2 + WS_XB8); S.Bt = (const bf16_t*)(ws2 + WS_WIN8 + l * SZ_WIN8 + (size_t)NBR * D); S.K = D / 2; S.nM = T / 256; S.nN = (NPROJ - NBR) / 256; S.nwg = S.nM * S.nN; S.G = F2.nwg; S.c = F2.wg; S.i0 = 0; S.i1 = 1 << 30; S.pnoff = NBR / 256;
          gemm_phase_mfma<EpiProj, DenseSched, 1>(F2, D, S, E2, 1.0f / (X8_SCALE * W8_SCALE)); if (PROBE_DBL & 64) gemm_phase_mfma<EpiProj, DenseSched, 1>(F2, D, S, E2, 1.0f / (X8_SCALE * W8_SCALE)); }
        SEAM(pb + 0); }
    if (IN(pb + 1)) { const Frame F = fresh(F0); phase_mix1v2(F, l, (const bf16_t*)(F.ws_() + WS_XB)); if (PROBE_DBL & 8192) { const Frame G = fresh(F0); phase_mix1v2<false>(G, l, (const bf16_t*)(G.ws_() + WS_XB)); } SEAM(pb + 1); }
    if (IN(pb + 2)) { const Frame F = fresh(F0); phase_scan_mfma(F); if (PROBE_DBL & 2) { const Frame G = fresh(F0); phase_scan_mfma(G); } SEAM(pb + 2); }
    if (IN(pb + 3)) { const Frame F = fresh(F0); phase_chunk_mfma(F, l); if (PROBE_DBL & 4) { const Frame G = fresh(F0); phase_chunk_mfma(G, l); } SEAM(pb + 3); }
    if (IN(pb + 4)) { const Frame F = fresh(F0); unsigned char* ws = F.ws_();
        EpiBranch E{ws + WS_GATES, ws + WS_MRG}; gemm_dense_mfma(F, (const bf16_t*)(ws + WS_BR), (const bf16_t*)(ws + WS_WB + l * SZ_DD), T, D, D, E); SEAM(pb + 4); }
    if (IN(pb + 5)) { const Frame F = fresh(F0); unsigned char* ws = F.ws_();
        EpiResid E{(const bf16_t*)(ws + WS_XB), (bf16_t*)(ws + WS_Y)};
        DenseSched S; S.A = (const bf16_t*)(ws + WS_MRG); S.Bt = (const bf16_t*)(ws + WS_WOUT + l * SZ_DD); S.K = D / 2; S.nM = T / 256; S.nN = D / 256; S.nwg = S.nM * S.nN; S.G = F.nwg; S.c = F.wg; S.i0 = 0; S.i1 = 1 << 30; S.pnoff = 0;
        gemm_phase_mfma<EpiResid, DenseSched, 1>(F, D, S, E, 1.0f / (X8_SCALE * W8_SCALE)); SEAM(pb + 5); }
    if (IN(pb + 6)) { const Frame F = fresh(F0); unsigned char* ws = F.ws_();
        phase_ln(F, (const bf16_t*)(ws + WS_Y), ((const float*)F.ka->in[IN_LNW]) + (size_t)l * 3 * D, ((const float*)F.ka->in[IN_LNB]) + (size_t)l * 3 * D, (bf16_t*)(ws + WS_XB), ws + WS_XB8); SEAM(pb + 6); }
    if (IN(pb + 7)) { const Frame F = fresh(F0);
        EpiQKV E{}; QkvSched S; S.ws = F.ws_(); S.l = l; S.G = F.nwg; S.c = F.wg; gemm_phase_mfma<EpiQKV, QkvSched, 1>(F, D, S, E, 1.0f / (X8_SCALE * W8_SCALE)); SEAM(pb + 7); }
    if (IN(pb + 8)) { const Frame F = fresh(F0); phase_attn_mfma(F, l); if (PROBE_DBL & 8) { const Frame G = fresh(F0); phase_attn_mfma(G, l); } SEAM(pb + 8); }
    if (IN(pb + 9)) { const Frame F = fresh(F0); unsigned char* ws = F.ws_();
        EpiResid E{(const bf16_t*)(ws + WS_XB), (bf16_t*)(ws + WS_Y)}; gemm_dense_mfma(F, (const bf16_t*)(ws + WS_O), (const bf16_t*)(ws + WS_WO + l * SZ_WQ), T, D, W, E); if (PROBE_DBL & 2048) gemm_dense_mfma(F, (const bf16_t*)(ws + WS_O), (const bf16_t*)(ws + WS_WO + l * SZ_WQ), T, D, W, E); SEAM(pb + 9); }
    if (IN(pb + 10)) { const Frame F = fresh(F0); unsigned char* ws = F.ws_(); phase_ln_router(F, l, (const bf16_t*)(ws + WS_Y), (bf16_t*)(ws + WS_XB)); SEAM(pb + 10); }
    if (IN(pb + 11)) { const Frame F = fresh(F0); phase_slots(F, l); if (PROBE_DBL & 16) { const Frame G = fresh(F0); phase_slots(G, l); } SEAM(pb + 11); }
    if (IN(pb + 12)) { const Frame F = fresh(F0); unsigned char* ws = F.ws_();
        LAS int* pst = (LAS int*)(F.lds + LDS_BYTES - 1024); build_pstart(F, l, pst);
        const int nrt = pst[NE + 1] >> 8; EpiSwiglu E{(const float*)(ws + WS_WSL), ws + WS_HB};
        MoeSched<4, true> S; S.ws = ws; S.pst = pst; S.l = l; S.G = F.nwg; S.c = F.wg; S.nunits = nrt * 4; gemm_phase_mfma<EpiSwiglu, MoeSched<4, true>, 1>(F, D, S, E, 1.0f / (X8_SCALE * W8_SCALE)); SEAM(pb + 12); }
    if (IN(pb + 13)) { const Frame F = fresh(F0); unsigned char* ws = F.ws_();
        LAS int* pst = (LAS int*)(F.lds + LDS_BYTES - 1024); build_pstart(F, l, pst);
        const int nrt = pst[NE + 1] >> 8; EpiDown E{ws + WS_YB};
        MoeSched<8, false> S; S.ws = ws; S.pst = pst; S.l = l; S.G = F.nwg; S.c = F.wg; S.nunits = nrt * 8; gemm_phase_mfma<EpiDown, MoeSched<8, false>, 1>(F, ED, S, E, Y8_SCALE / (H8_SCALE * W8_SCALE)); SEAM(pb + 13); }
    if (IN(pb + 14)) { const Frame F = fresh(F0); phase_combine_ln(F, l, (bf16_t*)(F.ws_() + WS_XB), l == DEPTH - 1 ? ((float*)F.ka->out) : (float*)nullptr); if ((PROBE_DBL & 16384) && l == DEPTH - 1) { const Frame G = fresh(F0); phase_combine_ln(G, l, (bf16_t*)(G.ws_() + WS_XB), ((float*)G.ka->out)); } SEAM(pb + 14); }
}

__global__ void __launch_bounds__(NTHR, 2) fwd(Args args_unused) {
    extern __shared__ __attribute__((aligned(16))) unsigned char lds_raw[];
    Frame F0; F0.lds = (LAS unsigned char*)lds_raw; F0.tid = threadIdx.x; F0.lane = F0.tid & 63; F0.wave = __builtin_amdgcn_readfirstlane(F0.tid >> 6); F0.wg = blockIdx.x; F0.nwg = gridDim.x;
    F0.ka = (KArgs)__builtin_amdgcn_kernarg_segment_ptr(); F0.wsg = F0.ka->ws;
    volatile LAS unsigned* xbw = (volatile LAS unsigned*)(F0.lds + LDS_BYTES - 16);
    if (F0.tid == 0) { xbw[0] = 0u; xbw[1] = 0u; }
    __syncthreads();
    XcdBarrier bar; bar.bar = (unsigned*)(F0.ws_() + WS_CTL); bar.x = 0; bar.st = xbw;
#if MK_PER_PHASE
    const int lo = F0.ka->ph_lo, hi = F0.ka->ph_hi;
    if (hi - lo > 1) bar = xcd_barrier_post((unsigned*)(F0.ws_() + WS_CTL), xbw);
#else
    const int lo = 0, hi = NPHASE;
    bar = xcd_barrier_post((unsigned*)(F0.ws_() + WS_CTL), xbw);
#endif
    if (IN(0)) { { const Frame F = fresh(F0); phase_wabs(F); } { XcdBarrier b2_ = bar; asm volatile("" : "+s"(b2_.bar)); asm volatile("" : "+s"(b2_.x)); xcd_barrier(b2_); }
        const Frame F = fresh(F0); phase_prologue(F); { const Frame G = fresh(F0); prologue_deferred(G, G.wg, G.nwg); } SEAM(0); }
    run_layer<0>(F0, bar, lo, hi);
    run_layer<1>(F0, bar, lo, hi);
#undef IN
#undef SEAM
}

extern "C" void kernel_launch(void* const* d_in, const int* in_sizes, int n_in, void* d_out, int out_size, void* d_ws, size_t ws_size, hipStream_t stream) {
    static int grid = 0;
    if (grid == 0) {
        if (n_in != 23 || ws_size < WS_END) { fprintf(stderr, "kernel_launch: unexpected inputs (n_in %d, ws %zu < %zu)\n", n_in, ws_size, (size_t)WS_END); grid = -1; return; }
        int dev = 0, cus = 0, per_cu = 0;
        if (hipGetDevice(&dev) != hipSuccess || hipDeviceGetAttribute(&cus, hipDeviceAttributeMultiprocessorCount, dev) != hipSuccess) { grid = -1; return; }
        if (hipFuncSetAttribute((const void*)fwd, hipFuncAttributeMaxDynamicSharedMemorySize, LDS_BYTES) != hipSuccess) { fprintf(stderr, "kernel_launch: hipFuncSetAttribute failed\n"); grid = -1; return; }
        if (hipOccupancyMaxActiveBlocksPerMultiprocessor(&per_cu, (const void*)fwd, NTHR, LDS_BYTES) != hipSuccess || per_cu < 1) { fprintf(stderr, "kernel_launch: occupancy query says %d\n", per_cu); }
        (void)hipGetLastError();
        grid = cus;
    }
    if (grid < 0) return;
    (void)hipMemsetAsync((char*)d_ws + WS_CTL, 0, CTL_BYTES, stream);
    Args a{};
    for (int i = 0; i < 23; ++i) a.in[i] = (const float*)d_in[i];
    a.out = (float*)d_out; a.ws = (unsigned char*)d_ws;
#if MK_PER_PHASE
    for (int p = 0; p < NPHASE; ++p) { a.ph_lo = p; a.ph_hi = p + 1; hipLaunchKernelGGL(fwd, dim3(grid), dim3(NTHR), LDS_BYTES, stream, a); }
#else
    a.ph_lo = 0; a.ph_hi = NPHASE;
    hipLaunchKernelGGL(fwd, dim3(grid), dim3(NTHR), LDS_BYTES, stream, a);
#endif
    const hipError_t le = hipPeekAtLastError();
    if (le != hipSuccess) fprintf(stderr, "kernel_launch: launch failed: %s\n", hipGetErrorName(le));
}
```

```cpp
#include <hip/hip_runtime.h>
#include <cstdio>
#include <cstdint>

#ifndef PROBE_DBL
#define PROBE_DBL 0
#endif
#ifndef MK_PER_PHASE
#define MK_PER_PHASE 0
#endif

typedef unsigned short bf16_t;
typedef float f32x4 __attribute__((ext_vector_type(4)));
typedef float f32x2 __attribute__((ext_vector_type(2)));
typedef unsigned u32x4 __attribute__((ext_vector_type(4)));
typedef unsigned u32x2 __attribute__((ext_vector_type(2)));
#define LAS __attribute__((address_space(3)))

constexpr int BATCH = 4, SEQ = 4096, T = BATCH * SEQ, D = 2048, DEPTH = 2;
constexpr int W = 512, NH = 4, HD = 128, CH = 64, NCH = SEQ / CH, NBH = BATCH * NH;
constexpr int PROJ_W = 14344, NBR = 6144, NPROJ = 14336;
constexpr int MEM = 256, TM = BATCH * MEM;
constexpr int NE = 64, NEX = 65, TOPK = 8, ED = 512;
constexpr int NSLOT = 164096;
constexpr float LN_EPS = 1e-5f, ALPHA = 1.41421356237f, ROUTE_SCALE = 2.5f;
constexpr int NTHR = 512;

constexpr int PC_U = 0, PC_CH = 512, PC_CB = 1024, PC_CC = 1536, PC_MQ = 2048, PC_MK = 2560, PC_MV = 3072, PC_MO = 3584, PC_RQ = 4096, PC_RK = 4608, PC_RV = 5120, PC_RG = 5632;

constexpr size_t al256(size_t x) { return (x + 255) & ~(size_t)255; }
constexpr size_t WS_CTL = 0;
constexpr size_t CTL_BYTES = 65536;
constexpr int CW_COUNTS = 8192;
constexpr size_t WS_WIN = WS_CTL + CTL_BYTES;
constexpr size_t SZ_WIN = (size_t)NPROJ * D * 2;
constexpr size_t WS_WIF = WS_WIN + DEPTH * SZ_WIN;
constexpr size_t SZ_WIF = 8 * D * 4;
constexpr size_t WS_WB = WS_WIF + DEPTH * SZ_WIF;
constexpr size_t SZ_DD = (size_t)D * D * 2;
constexpr size_t WS_WOUT = WS_WB + DEPTH * SZ_DD;
constexpr size_t WS_WQ = WS_WOUT + DEPTH * SZ_DD;
constexpr size_t SZ_WQ = (size_t)W * D * 2;
constexpr size_t WS_WK = WS_WQ + DEPTH * SZ_WQ;
constexpr size_t WS_WV = WS_WK + DEPTH * SZ_WQ;
constexpr size_t WS_WO = WS_WV + DEPTH * SZ_WQ;
constexpr size_t WS_WGU = WS_WO + DEPTH * SZ_WQ;
constexpr size_t SZ_WGU1 = (size_t)1024 * D * 2;
constexpr size_t WS_WDN = WS_WGU + (size_t)DEPTH * NEX * SZ_WGU1;
constexpr size_t SZ_WDN1 = (size_t)D * ED * 2;
constexpr size_t WS_ROPE = WS_WDN + (size_t)DEPTH * NEX * SZ_WDN1;
constexpr size_t WS_X = WS_ROPE + (size_t)SEQ * 64 * 4 * 2;
constexpr size_t SZ_TD4 = (size_t)T * D * 4;
constexpr size_t WS_Y = WS_X + SZ_TD4;
constexpr size_t WS_XB = WS_Y + SZ_TD4;
constexpr size_t SZ_TD2 = (size_t)T * D * 2;
constexpr size_t WS_MEMB = WS_XB + SZ_TD2;
constexpr size_t WS_KM = WS_MEMB + (size_t)TM * D * 2;
constexpr size_t WS_VM = WS_KM + (size_t)DEPTH * TM * W * 2;
constexpr size_t WS_PROJ = WS_VM + (size_t)DEPTH * TM * W * 2;
constexpr size_t WS_GATES = WS_PROJ + (size_t)T * NBR * 2;
constexpr size_t WS_CUMF = WS_GATES + (size_t)T * 8192 * 2;
constexpr size_t WS_IPRE = WS_CUMF + (size_t)NBH * SEQ * 4;
constexpr size_t WS_SUMM = WS_IPRE + (size_t)NBH * SEQ * 4;
constexpr size_t WS_CST = WS_SUMM + al256((size_t)NBH * NCH * 2 * 4);
constexpr size_t WS_NST = WS_CST + (size_t)2 * NBH * NCH * HD * HD * 2;
constexpr size_t WS_BR = WS_NST + (size_t)NBH * NCH * HD * 4;
constexpr size_t WS_MRG = WS_BR + SZ_TD2;
constexpr size_t WS_Q = WS_MRG + SZ_TD2;
constexpr size_t WS_O = WS_Q + (size_t)T * W * 2;
constexpr size_t WS_EID = WS_O + (size_t)T * W * 2;
constexpr size_t WS_EW = WS_EID + (size_t)T * 8 * 4;
constexpr size_t WS_EPOS = WS_EW + (size_t)T * 8 * 4;
constexpr size_t WS_SLOTOF = WS_EPOS + (size_t)T * 8 * 4;
constexpr size_t WS_TOK = WS_SLOTOF + (size_t)T * 8 * 4;
constexpr size_t WS_WSL = WS_TOK + al256((size_t)NSLOT * 4);
constexpr size_t WS_HB = WS_WSL + al256((size_t)NSLOT * 4);
constexpr size_t WS_YB = WS_HB + (size_t)NSLOT * ED * 2;
constexpr size_t WS_AV = WS_YB + (size_t)NSLOT * D * 2;
constexpr size_t WS_PM = WS_AV + (size_t)NBH * SEQ * 4;
constexpr size_t WS_MSEQ = WS_PM + (size_t)NBH * SEQ * 4;
constexpr size_t WS_XB8 = WS_MSEQ + al256((size_t)NBH * 80 * 4);
constexpr size_t WS_WGU8 = WS_XB8 + (size_t)T * D;
constexpr size_t SZ_WGU8 = (size_t)1024 * D;
constexpr size_t WS_WIN8 = WS_WGU8 + (size_t)DEPTH * NEX * SZ_WGU8;
constexpr size_t SZ_WIN8 = (size_t)NPROJ * D;
constexpr size_t WS_RWT = WS_WIN8 + DEPTH * SZ_WIN8;
constexpr size_t WS_XQ8 = WS_RWT + (size_t)DEPTH * 2 * NE * D * 2;
constexpr size_t WS_XSC = WS_XQ8 + (size_t)T * D;
constexpr size_t WS_WINQ = WS_XSC + al256((size_t)T * 4);
constexpr size_t SZ_WINQ = (size_t)NBR * D;
constexpr size_t WS_WIFB = WS_WINQ + DEPTH * SZ_WINQ;
constexpr size_t WS_MEMB8 = WS_WIFB + (size_t)DEPTH * 2 * 16 * D * 2;
constexpr size_t WS_END = WS_MEMB8 + (size_t)TM * D;
constexpr int CW_WABS = 8320;
constexpr float O8_SCALE = 32.0f;
constexpr float X8_SCALE = 16.0f, W8_SCALE = 256.0f, H8_SCALE = 8.0f, Y8_SCALE = 64.0f;

constexpr int LDS_BYTES = 147456;

__device__ __forceinline__ bf16_t f2bf(float f) { unsigned u = __float_as_uint(f); u += 0x7FFFu + ((u >> 16) & 1u); return (bf16_t)(u >> 16); }
__device__ __forceinline__ float bf2f(bf16_t b) { return __uint_as_float(((unsigned)b) << 16); }
__device__ __forceinline__ unsigned pack2(float lo, float hi) { unsigned r; asm("v_cvt_pk_bf16_f32 %0, %1, %2" : "=v"(r) : "v"(lo), "v"(hi)); return r; }
__device__ __forceinline__ float sigmoidf_(float x) { return __builtin_amdgcn_rcpf(1.0f + __builtin_amdgcn_exp2f(-1.4426950408889634f * x)); }
__device__ __forceinline__ unsigned pack_fp8x4(float a, float b, float c, float d) {
    a = __builtin_amdgcn_fmed3f(a, -448.f, 448.f); b = __builtin_amdgcn_fmed3f(b, -448.f, 448.f); c = __builtin_amdgcn_fmed3f(c, -448.f, 448.f); d = __builtin_amdgcn_fmed3f(d, -448.f, 448.f);
    int w = 0; w = __builtin_amdgcn_cvt_pk_fp8_f32(a, b, w, false); w = __builtin_amdgcn_cvt_pk_fp8_f32(c, d, w, true); return (unsigned)w; }
__device__ __forceinline__ unsigned pack_i8x4(float a, float b, float c, float d) {
    const int ia = (int)__builtin_amdgcn_fmed3f(rintf(a), -127.f, 127.f), ib = (int)__builtin_amdgcn_fmed3f(rintf(b), -127.f, 127.f), ic = (int)__builtin_amdgcn_fmed3f(rintf(c), -127.f, 127.f), id = (int)__builtin_amdgcn_fmed3f(rintf(d), -127.f, 127.f);
    return (unsigned)(ia & 255) | ((unsigned)(ib & 255) << 8) | ((unsigned)(ic & 255) << 16) | ((unsigned)(id & 255) << 24); }
__device__ __forceinline__ unsigned pack_u8x4(float a, float b, float c, float d) {
    return (unsigned)rintf(a) | ((unsigned)rintf(b) << 8) | ((unsigned)rintf(c) << 16) | ((unsigned)rintf(d) << 24); }
__device__ __forceinline__ void un8u(u32x2 w, f32x4& a, f32x4& b) { a[0] = (float)(w.x & 255u); a[1] = (float)((w.x >> 8) & 255u); a[2] = (float)((w.x >> 16) & 255u); a[3] = (float)(w.x >> 24);
    b[0] = (float)(w.y & 255u); b[1] = (float)((w.y >> 8) & 255u); b[2] = (float)((w.y >> 16) & 255u); b[3] = (float)(w.y >> 24); }
__device__ __forceinline__ float wave_sum(float v) { for (int o = 32; o >= 1; o >>= 1) v += __shfl_xor(v, o); return v; }
__device__ __forceinline__ float wave_max(float v) { for (int o = 32; o >= 1; o >>= 1) v = fmaxf(v, __shfl_xor(v, o)); return v; }

#define XB_TMO      128
#define XB_XCNT(j)  (256  + 64 * (j))
#define XB_XSUB(j)  (1280 + 64 * (j))
#define XB_XGEN(j)  (2304 + 64 * (j))
#define XB_TOP      3328
#define XB_TOPGEN   3392
#define XCD_BAR_WORDS 3456
#define XB_SPIN_CAP (1u << 27)
__device__ __forceinline__ unsigned xb_ld(unsigned* p)              { return __hip_atomic_load(p, __ATOMIC_RELAXED, __HIP_MEMORY_SCOPE_AGENT); }
__device__ __forceinline__ unsigned xb_add(unsigned* p, unsigned v) { return __hip_atomic_fetch_add(p, v, __ATOMIC_RELAXED, __HIP_MEMORY_SCOPE_AGENT); }
__device__ __forceinline__ unsigned xb_xcc_id() { return (unsigned)__builtin_amdgcn_s_getreg((3 << 11) | 20) & 0xFu; }
#define XB_SPIN(cond, bar) do { unsigned _sp = 0; while (cond) { __builtin_amdgcn_s_sleep(1); \
    if ((++_sp & 255u) == 0u) { if (xb_ld(&(bar)[XB_TMO])) break; if (_sp > XB_SPIN_CAP) { atomicAdd(&(bar)[XB_TMO], 1u); break; } } } } while (0)
struct XcdBarrier { unsigned* bar; unsigned x; volatile LAS unsigned* st; };
__device__ __forceinline__ XcdBarrier xcd_barrier_post(unsigned* bar, volatile LAS unsigned* st) {
    XcdBarrier b; b.bar = bar; b.x = xb_xcc_id(); b.st = st;
    if (threadIdx.x == 0) (void)xb_add(&bar[XB_XCNT(b.x)], 1u);
    return b;
}
__device__ __forceinline__ void xcd_barrier_complete(unsigned* bar, unsigned x, unsigned& nloc, unsigned& nx) {
    const unsigned G = gridDim.x * gridDim.y * gridDim.z;
    unsigned sum, cnt, mine, sp = 0u;
    for (;;) {
        sum = 0u; cnt = 0u; mine = 0u;
#pragma unroll
        for (unsigned j = 0; j < 16; ++j) { const unsigned c = xb_ld(&bar[XB_XCNT(j)]); sum += c; cnt += (c > 0u) ? 1u : 0u; mine = (j == x) ? c : mine; }
        if (sum == G) break;
        __builtin_amdgcn_s_sleep(1);
        if ((++sp & 255u) == 0u) { if (xb_ld(&bar[XB_TMO])) break; if (sp > XB_SPIN_CAP) { atomicAdd(&bar[XB_TMO], 1u); break; } }
    }
    nloc = mine > 0u ? mine : 1u; nx = cnt > 0u ? cnt : 1u;
}
__device__ __forceinline__ void xcd_barrier(const XcdBarrier& b) {
    asm volatile("s_waitcnt vmcnt(0)" ::: "memory");
    __syncthreads();
    if (threadIdx.x == 0) {
        unsigned* bar = b.bar;
        __builtin_amdgcn_s_waitcnt(0);
        unsigned nloc = b.st[0], nx = b.st[1];
        if (nloc == 0u) { xcd_barrier_complete(bar, b.x, nloc, nx); b.st[0] = nloc; b.st[1] = nx; }
        const unsigned old = xb_add(&bar[XB_XSUB(b.x)], 1u);
        const unsigned gen = old / nloc;
        if (old + 1u == (gen + 1u) * nloc) {
            __builtin_amdgcn_fence(__ATOMIC_RELEASE, "agent");
            asm volatile("s_waitcnt vmcnt(0)" ::: "memory");
            const unsigned og = xb_add(&bar[XB_TOP], 1u);
            const unsigned tg = og / nx;
            if (og + 1u == (tg + 1u) * nx) xb_add(&bar[XB_TOPGEN], 1u);
            else XB_SPIN(xb_ld(&bar[XB_TOPGEN]) == tg, bar);
            __builtin_amdgcn_fence(__ATOMIC_ACQUIRE, "agent");
            xb_add(&bar[XB_XGEN(b.x)], 1u);
            asm volatile("s_waitcnt vmcnt(0)" ::: "memory");
        } else {
            XB_SPIN(xb_ld(&bar[XB_XGEN(b.x)]) == gen, bar);
            __builtin_amdgcn_fence(__ATOMIC_ACQUIRE, "agent");
            asm volatile("s_waitcnt vmcnt(0)" ::: "memory");
        }
    }
    __syncthreads();
}

struct Args { const float* in[23]; float* out; unsigned char* ws; int ph_lo, ph_hi; };
enum { IN_X = 0, IN_MEM, IN_WIN, IN_GATEB, IN_POOLW, IN_POOLS, IN_CONVW, IN_MNORM, IN_RNORM, IN_WBR, IN_WMIX, IN_WQ, IN_WK, IN_WV, IN_WO, IN_RW, IN_RB, IN_WGU, IN_WDN, IN_SGU, IN_SDN, IN_LNW, IN_LNB };

#define GAS __attribute__((address_space(1)))
struct DArgs { const GAS float* in[23]; GAS float* out; GAS unsigned char* ws; int ph_lo, ph_hi; };
typedef const __attribute__((address_space(4))) DArgs* KArgs;
struct Frame {
    LAS unsigned char* lds; int tid, lane, wave, wg, nwg;
    GAS unsigned char* wsg; KArgs ka;
    __device__ __forceinline__ unsigned char* ws_() const { return (unsigned char*)wsg; }
};
__device__ __forceinline__ Frame fresh(const Frame& F) { Frame G = F; asm volatile("" : "+s"(G.wsg)); asm volatile("" : "+s"(G.ka)); asm volatile("" : "+v"(G.tid)); asm volatile("" : "+s"(G.wg));
    G.lane = G.tid & 63; G.wave = __builtin_amdgcn_readfirstlane(G.tid >> 6); return G; }

struct GUnit {
    const bf16_t* Bt;
    const bf16_t* A;
    const int* gather;
    int row0;
    int pn;
    int e;
    bf16_t* dst;
};

__device__ __forceinline__ void un8(u32x4 w, f32x4& a, f32x4& b) { a[0] = __uint_as_float(w[0] << 16); a[1] = __uint_as_float(w[0] & 0xffff0000u); a[2] = __uint_as_float(w[1] << 16); a[3] = __uint_as_float(w[1] & 0xffff0000u);
    b[0] = __uint_as_float(w[2] << 16); b[1] = __uint_as_float(w[2] & 0xffff0000u); b[2] = __uint_as_float(w[3] << 16); b[3] = __uint_as_float(w[3] & 0xffff0000u); }
__device__ __forceinline__ void st_bf16x8(bf16_t* p, f32x4 a, f32x4 b) { u32x4 w; w[0] = pack2(a[0], a[1]); w[1] = pack2(a[2], a[3]); w[2] = pack2(b[0], b[1]); w[3] = pack2(b[2], b[3]); *(u32x4*)p = w; }
__device__ __forceinline__ void st_bf16x4(bf16_t* p, f32x4 v) { u32x2 w; w.x = pack2(v[0], v[1]); w.y = pack2(v[2], v[3]); *(u32x2*)p = w; }
__device__ __forceinline__ void ld_row32(const bf16_t* row, int lane, float (&v)[32]) {
#pragma unroll
    for (int j = 0; j < 4; ++j) { const u32x4 w = *(const u32x4*)(row + j * 512 + lane * 8);
#pragma unroll
        for (int e = 0; e < 4; ++e) { v[j * 8 + 2 * e] = __uint_as_float(w[e] << 16); v[j * 8 + 2 * e + 1] = __uint_as_float(w[e] & 0xffff0000u); } } }
__device__ __forceinline__ void st_row32(bf16_t* row, int lane, const float (&v)[32]) {
#pragma unroll
    for (int j = 0; j < 4; ++j) { u32x4 w;
#pragma unroll
        for (int e = 0; e < 4; ++e) w[e] = pack2(v[j * 8 + 2 * e], v[j * 8 + 2 * e + 1]);
        *(u32x4*)(row + j * 512 + lane * 8) = w; } }
__device__ __forceinline__ void st_row32_i8(unsigned char* row, float* sc, int lane, const float (&v)[32]) {
    float am = 0.f;
#pragma unroll
    for (int j = 0; j < 32; ++j) am = fmaxf(am, fabsf(v[j]));
    am = fmaxf(wave_max(am), 1e-30f); const float q = 127.0f / am;
#pragma unroll
    for (int j = 0; j < 4; ++j) { u32x2 w; w.x = pack_i8x4(v[j * 8] * q, v[j * 8 + 1] * q, v[j * 8 + 2] * q, v[j * 8 + 3] * q); w.y = pack_i8x4(v[j * 8 + 4] * q, v[j * 8 + 5] * q, v[j * 8 + 6] * q, v[j * 8 + 7] * q);
        *(u32x2*)(row + j * 512 + lane * 8) = w; }
    if (lane == 0) *sc = am * (1.0f / 127.0f); }
__device__ __forceinline__ void st_row32_fp8(unsigned char* row, int lane, const float (&v)[32]) {
#pragma unroll
    for (int j = 0; j < 4; ++j) { u32x2 w; w.x = pack_fp8x4(v[j * 8] * X8_SCALE, v[j * 8 + 1] * X8_SCALE, v[j * 8 + 2] * X8_SCALE, v[j * 8 + 3] * X8_SCALE); w.y = pack_fp8x4(v[j * 8 + 4] * X8_SCALE, v[j * 8 + 5] * X8_SCALE, v[j * 8 + 6] * X8_SCALE, v[j * 8 + 7] * X8_SCALE);
        *(u32x2*)(row + j * 512 + lane * 8) = w; } }
struct NoPre { };
struct EpiProj {
    static constexpr bool PAIR_M = false; static constexpr bool SEG = false; typedef NoPre Pre; static constexpr int NST = 8;
    bf16_t* proj; bf16_t* gates;
    static __device__ __forceinline__ float unit_scale(const GUnit& u) { return (u.pn == PC_MK / 256 || u.pn == PC_MK / 256 + 1 || u.pn == PC_RK / 256 || u.pn == PC_RK / 256 + 1) ? 0.08838834764831845f : 1.0f; }
    __device__ __forceinline__ void pre(const GUnit&, int, int, Pre&) const {}
    __device__ __forceinline__ void fin(const GUnit& u, int r, int c, const f32x4 (&a)[2][2], const Pre&) const {
        const int col = u.pn * 256 + c; const size_t row = (size_t)(u.row0 + r);
        if (col < NBR) { st_bf16x8(proj + row * NBR + col, a[0][0], a[0][1]); st_bf16x8(proj + row * NBR + col + 128, a[1][0], a[1][1]); }
        else { f32x4 s[2][2];
#pragma unroll
            for (int h = 0; h < 2; ++h)
#pragma unroll
                for (int n = 0; n < 2; ++n)
#pragma unroll
                    for (int j = 0; j < 4; ++j) s[h][n][j] = __builtin_amdgcn_fmed3f(sigmoidf_(a[h][n][j]) * 255.0f, 1.0f, 255.0f);
            u32x2 w0, w1; w0.x = pack_u8x4(s[0][0][0], s[0][0][1], s[0][0][2], s[0][0][3]); w0.y = pack_u8x4(s[0][1][0], s[0][1][1], s[0][1][2], s[0][1][3]);
            w1.x = pack_u8x4(s[1][0][0], s[1][0][1], s[1][0][2], s[1][0][3]); w1.y = pack_u8x4(s[1][1][0], s[1][1][1], s[1][1][2], s[1][1][3]);
            { const auto rx = __builtin_amdgcn_permlane32_swap(w0.x, w1.x, false, false); w0.x = rx[0]; w1.x = rx[1]; const auto ry = __builtin_amdgcn_permlane32_swap(w0.y, w1.y, false, false); w0.y = ry[0]; w1.y = ry[1]; }
            const bool up = (threadIdx.x & 32u) != 0u; const int gc = col - NBR;
            unsigned char* gp = (unsigned char*)gates + row * 8192 + (up ? gc + 128 - 8 : gc);
            u32x4 w; w[0] = w0.x; w[1] = w0.y; w[2] = w1.x; w[3] = w1.y; *(u32x4*)gp = w; }
    }
};
struct EpiBranch {
    static constexpr bool PAIR_M = false; static constexpr bool SEG = true; static constexpr int NST = 8;
    struct Pre { u32x2 g0, g1; };
    struct SPre { u32x2 a0, a1, b0, b1; };
    const unsigned char* gates; unsigned char* out;
    __device__ __forceinline__ void pre(const GUnit& u, int r, int c, Pre& p) const { const unsigned char* g = gates + (size_t)(u.row0 + r) * 8192 + 3 * 2048 + u.pn * 256 + c; p.g0 = *(const u32x2*)g; p.g1 = *(const u32x2*)(g + 128); }
    __device__ __forceinline__ void fin(const GUnit& u, int r, int c, const f32x4 (&a)[2][2], const Pre& p) const {
        f32x4 x0, x1, y0, y1; un8u(p.g0, x0, x1); un8u(p.g1, y0, y1); const float k = X8_SCALE / 255.0f;
        const f32x4 v00 = a[0][0] * x0 * k, v01 = a[0][1] * x1 * k, v10 = a[1][0] * y0 * k, v11 = a[1][1] * y1 * k;
        u32x2 w0, w1; w0.x = pack_fp8x4(v00[0], v00[1], v00[2], v00[3]); w0.y = pack_fp8x4(v01[0], v01[1], v01[2], v01[3]); w1.x = pack_fp8x4(v10[0], v10[1], v10[2], v10[3]); w1.y = pack_fp8x4(v11[0], v11[1], v11[2], v11[3]);
        { const auto rx = __builtin_amdgcn_permlane32_swap(w0.x, w1.x, false, false); w0.x = rx[0]; w1.x = rx[1]; const auto ry = __builtin_amdgcn_permlane32_swap(w0.y, w1.y, false, false); w0.y = ry[0]; w1.y = ry[1]; }
        const bool up = (threadIdx.x & 32u) != 0u;
        unsigned char* o = out + (size_t)(u.row0 + r) * D + u.pn * 256 + (up ? 128 + c - 8 : c);
        u32x4 w; w[0] = w0.x; w[1] = w0.y; w[2] = w1.x; w[3] = w1.y; *(u32x4*)o = w; }
    __device__ __forceinline__ void seg_pre(const GUnit& u, int r, int c, int s, SPre& p) const { const unsigned char* g = gates + (size_t)(u.row0 + r) * 8192 + s * 2048 + u.pn * 256 + c;
        p.a0 = *(const u32x2*)g; p.a1 = *(const u32x2*)(g + 128); p.b0 = *(const u32x2*)(g + 2048); p.b1 = *(const u32x2*)(g + 2048 + 128); }
    __device__ __forceinline__ void seg_fin(f32x4 (&h0)[2], f32x4 (&h1)[2], const SPre& p) const {
        f32x4 a0, a1, b0, b1; un8u(p.a0, a0, a1); un8u(p.b0, b0, b1);
#pragma unroll
        for (int j = 0; j < 4; ++j) { h0[0][j] *= a0[j] * __builtin_amdgcn_rcpf(b0[j]); h0[1][j] *= a1[j] * __builtin_amdgcn_rcpf(b1[j]); }
        un8u(p.a1, a0, a1); un8u(p.b1, b0, b1);
#pragma unroll
        for (int j = 0; j < 4; ++j) { h1[0][j] *= a0[j] * __builtin_amdgcn_rcpf(b0[j]); h1[1][j] *= a1[j] * __builtin_amdgcn_rcpf(b1[j]); }
    }
};
struct EpiResid {
    static constexpr bool PAIR_M = false; static constexpr bool SEG = false; static constexpr int NST = 16;
    struct Pre { u32x4 x0, x1; };
    const bf16_t* x; bf16_t* y;
    __device__ __forceinline__ void pre(const GUnit& u, int r, int c, Pre& p) const { const bf16_t* xp = x + (size_t)(u.row0 + r) * D + u.pn * 256 + c; p.x0 = *(const u32x4*)xp; p.x1 = *(const u32x4*)(xp + 128); }
    __device__ __forceinline__ void fin(const GUnit& u, int r, int c, const f32x4 (&a)[2][2], const Pre& p) const {
        f32x4 x0, x1, y0, y1; un8(p.x0, x0, x1); un8(p.x1, y0, y1);
        bf16_t* o = y + (size_t)(u.row0 + r) * D + u.pn * 256 + c; st_bf16x8(o, x0 * ALPHA + a[0][0], x1 * ALPHA + a[0][1]); st_bf16x8(o + 128, y0 * ALPHA + a[1][0], y1 * ALPHA + a[1][1]); }
};
struct EpiQKV {
    static constexpr bool PAIR_M = false; static constexpr bool SEG = false; typedef NoPre Pre; int pad_; static constexpr int NST = 16;
    __device__ __forceinline__ void pre(const GUnit&, int, int, Pre&) const {}
    __device__ __forceinline__ void fin(const GUnit& u, int r, int c, const f32x4 (&a)[2][2], const Pre&) const {
        bf16_t* o = u.dst + (size_t)(u.row0 + r) * W + u.pn * 256 + c; st_bf16x8(o, a[0][0], a[0][1]); st_bf16x8(o + 128, a[1][0], a[1][1]); }
};
struct EpiSwiglu {
    static constexpr bool SEG = false; static constexpr bool PAIR_M = true; static constexpr int NST = 4;
    struct Pre { float w; };
    const float* wsl; unsigned char* hb;
    __device__ __forceinline__ void pre(const GUnit& u, int r, int, Pre& p) const { p.w = wsl[u.row0 + r] * H8_SCALE; }
    __device__ __forceinline__ u32x2 act(const f32x4 (&a)[2][2], float w) const { f32x4 o[2];
#pragma unroll
        for (int n = 0; n < 2; ++n)
#pragma unroll
            for (int j = 0; j < 4; ++j) o[n][j] = a[0][n][j] * sigmoidf_(a[0][n][j]) * a[1][n][j] * w;
        u32x2 w8; w8.x = pack_fp8x4(o[0][0], o[0][1], o[0][2], o[0][3]); w8.y = pack_fp8x4(o[1][0], o[1][1], o[1][2], o[1][3]); return w8; }
    __device__ __forceinline__ void fin2(const GUnit& u, int r0, int r1, int c, const f32x4 (&a0)[2][2], const f32x4 (&a1)[2][2], const Pre& p0, const Pre& p1) const {
        u32x2 v0 = act(a0, p0.w), v1 = act(a1, p1.w);
        { const auto rx = __builtin_amdgcn_permlane32_swap(v0.x, v1.x, false, false); v0.x = rx[0]; v1.x = rx[1]; const auto ry = __builtin_amdgcn_permlane32_swap(v0.y, v1.y, false, false); v0.y = ry[0]; v1.y = ry[1]; }
        const bool up = (threadIdx.x & 32u) != 0u;
        unsigned char* o = hb + (size_t)(u.row0 + (up ? r1 : r0)) * ED + u.pn * 128 + (up ? c - 8 : c);
        u32x4 w; w[0] = v0.x; w[1] = v0.y; w[2] = v1.x; w[3] = v1.y; *(u32x4*)o = w; }
    __device__ __forceinline__ void fin(const GUnit&, int, int, const f32x4 (&)[2][2], const Pre&) const {}
};
struct EpiDown {
    static constexpr bool PAIR_M = false; static constexpr bool SEG = false; typedef NoPre Pre; static constexpr int NST = 8;
    unsigned char* yb;
    __device__ __forceinline__ void pre(const GUnit&, int, int, Pre&) const {}
    __device__ __forceinline__ void fin(const GUnit& u, int r, int c, const f32x4 (&a)[2][2], const Pre&) const {
        u32x2 w0, w1; w0.x = pack_fp8x4(a[0][0][0], a[0][0][1], a[0][0][2], a[0][0][3]); w0.y = pack_fp8x4(a[0][1][0], a[0][1][1], a[0][1][2], a[0][1][3]);
        w1.x = pack_fp8x4(a[1][0][0], a[1][0][1], a[1][0][2], a[1][0][3]); w1.y = pack_fp8x4(a[1][1][0], a[1][1][1], a[1][1][2], a[1][1][3]);
        { const auto rx = __builtin_amdgcn_permlane32_swap(w0.x, w1.x, false, false); w0.x = rx[0]; w1.x = rx[1]; const auto ry = __builtin_amdgcn_permlane32_swap(w0.y, w1.y, false, false); w0.y = ry[0]; w1.y = ry[1]; }
        const bool up = (threadIdx.x & 32u) != 0u;
        unsigned char* o = yb + (size_t)(u.row0 + r) * D + u.pn * 256 + (up ? 128 + c - 8 : c);
        u32x4 w; w[0] = w0.x; w[1] = w0.y; w[2] = w1.x; w[3] = w1.y; *(u32x4*)o = w; }
};

typedef short bf16x8 __attribute__((ext_vector_type(8)));
typedef short s16x4 __attribute__((ext_vector_type(4)));
__device__ __forceinline__ s16x4 lds_tr(const LAS bf16_t* p) { return __builtin_amdgcn_ds_read_tr16_b64_v4i16((LAS s16x4*)p); }
__device__ __forceinline__ bf16x8 cat4(s16x4 a, s16x4 b) { bf16x8 r; r[0] = a[0]; r[1] = a[1]; r[2] = a[2]; r[3] = a[3]; r[4] = b[0]; r[5] = b[1]; r[6] = b[2]; r[7] = b[3]; return r; }
__device__ __forceinline__ bf16x8 pack8(f32x4 a, f32x4 b) { union { u32x4 u; bf16x8 h; } c; c.u[0] = pack2(a[0], a[1]); c.u[1] = pack2(a[2], a[3]); c.u[2] = pack2(b[0], b[1]); c.u[3] = pack2(b[2], b[3]); return c.h; }
constexpr int BK = 64, HTB = 128 * BK * 2;
__device__ __forceinline__ int lds_byte(int r, int c) { const int st = (r >> 4) * 2 + (c >> 5), rr = r & 15, cc = c & 31, ob = rr * 64 + cc * 2; return st * 1024 + (ob ^ (((ob >> 9) & 1) << 5)); }
__device__ __forceinline__ void stage_rc(int b, int& R, int& C) { const int st = b / 1024, sb = b % 1024, swz = sb ^ (((sb >> 9) & 1) << 5); R = (st >> 1) * 16 + swz / 64; C = (st & 1) * 32 + (swz % 64) / 2; }

typedef int i32x8 __attribute__((ext_vector_type(8)));
typedef int i32x4 __attribute__((ext_vector_type(4)));
template <class Epi, class Sched, int MODE = 0>
__device__ __forceinline__ void gemm_phase_mfma(const Frame& F, const int K, const Sched& S, const Epi& E, const float oscale = 1.0f, const float* rowscale = nullptr) {
    constexpr bool FP8 = (MODE == 1), I8 = (MODE == 2);
    LAS unsigned char* lds = F.lds;
    const int tid = F.tid, wid = F.wave, lane = F.lane, wr = wid >> 2, wc = wid & 3, fr = lane & 15, fq = lane >> 4;
    const int KB = MODE ? K : 2 * K;
    const int nt = KB / 128;
    unsigned voffB[2];
#pragma unroll
    for (int i = 0; i < 2; ++i) { int R, C; stage_rc(tid * 16 + i * 8192, R, C); const int rho = R & 31, q4 = (rho & 15) >> 2, Rb = (R & ~31) + 8 * (((q4 & 1) << 1) | (q4 >> 1)) + 4 * (rho >> 4) + (rho & 3); voffB[i] = (unsigned)(Rb * KB + C * 2); }
    const size_t kstep = (size_t)(BK * 2);
    const size_t hstepB = (size_t)128 * KB;
    const unsigned ldsw = (unsigned)wid * 1024u;
    const int aoff = FP8 ? lds_byte(wr * 64 + fr, fq * 16) : lds_byte(wr * 64 + fr, fq * 8), boff = FP8 ? lds_byte(wc * 32 + fr, fq * 16) : lds_byte(wc * 32 + fr, fq * 8);
#define SA_(b, h) (((b) * 2 + (h)) * HTB)
#define SB_(b, h) ((4 + (b) * 2 + (h)) * HTB)
#define STAGE_(bufoff, gbase, voff) do { _Pragma("unroll") for (int _i = 0; _i < 2; ++_i) \
        __builtin_amdgcn_global_load_lds((const unsigned*)((const char*)(gbase) + (voff)[_i]), (LAS unsigned*)(lds + (bufoff) + ldsw + _i * 8192), 16, 0, 0); } while (0)
#define LDA_(dst, b, h) do { _Pragma("unroll") for (int m = 0; m < 4; ++m) { if constexpr (FP8) { const i32x4 _lo = *(const LAS i32x4*)(lds + SA_(b, h) + aoff + m * 2048), _hi = *(const LAS i32x4*)(lds + SA_(b, h) + aoff + m * 2048 + 16); \
            dst##8[m] = __builtin_shufflevector(_lo, _hi, 0, 1, 2, 3, 4, 5, 6, 7); } \
        else { _Pragma("unroll") for (int k = 0; k < 2; ++k) dst[m][k] = *(const LAS bf16x8*)(lds + SA_(b, h) + aoff + m * 2048 + k * 1024); } } } while (0)
#define LDB_(dst, b, h) do { _Pragma("unroll") for (int n = 0; n < 2; ++n) { if constexpr (FP8) { const i32x4 _lo = *(const LAS i32x4*)(lds + SB_(b, h) + boff + n * 2048), _hi = *(const LAS i32x4*)(lds + SB_(b, h) + boff + n * 2048 + 16); \
            dst##8[n] = __builtin_shufflevector(_lo, _hi, 0, 1, 2, 3, 4, 5, 6, 7); } \
        else { _Pragma("unroll") for (int k = 0; k < 2; ++k) dst[n][k] = *(const LAS bf16x8*)(lds + SB_(b, h) + boff + n * 2048 + k * 1024); } } } while (0)
#define MMA_(ai, bj, At, Bt) do { __builtin_amdgcn_s_setprio(1); _Pragma("unroll") for (int m = 0; m < 4; ++m) _Pragma("unroll") for (int n = 0; n < 2; ++n) { \
        if constexpr (FP8) asm volatile("v_mfma_scale_f32_16x16x128_f8f6f4 %0, %1, %2, %0, %3, %3 op_sel_hi:[0,0,0]" : "+v"(acc[ai][bj][m][n]) : "v"(Bt##8[n]), "v"(At##8[m]), "v"(sc8)); \
        else if constexpr (I8) { _Pragma("unroll") for (int k = 0; k < 2; ++k) acci[ai][bj][m][n] = __builtin_amdgcn_mfma_i32_16x16x64_i8(__builtin_bit_cast(i32x4, Bt[n][k]), __builtin_bit_cast(i32x4, At[m][k]), acci[ai][bj][m][n], 0, 0, 0); } \
        else { _Pragma("unroll") for (int k = 0; k < 2; ++k) acc[ai][bj][m][n] = __builtin_amdgcn_mfma_f32_16x16x32_bf16(Bt[n][k], At[m][k], acc[ai][bj][m][n], 0, 0, 0); } } \
        __builtin_amdgcn_s_setprio(0); } while (0)
#define WAIT_V_(n) asm volatile("s_waitcnt vmcnt(" #n ")" ::: "memory")
#define WAIT_L_(n) asm volatile("s_waitcnt lgkmcnt(" #n ")" ::: "memory")
#define BAR_ __builtin_amdgcn_s_barrier()
#define SCHED_ __builtin_amdgcn_sched_barrier(0)
#define VOFFS_(dst, u) do { int _tz = tid; asm volatile("" : "+v"(_tz)); _Pragma("unroll") for (int _i = 0; _i < 2; ++_i) { int _R, _C; stage_rc(_tz * 16 + _i * 8192, _R, _C); \
        _Pragma("unroll") for (int _h = 0; _h < 2; ++_h) { const int _r = _h * 128 + _R; \
        const unsigned _row = (u).gather ? (unsigned)(u).gather[_r] : (unsigned)((u).row0 + _r); dst[_h][_i] = _row * (unsigned)KB + (unsigned)_C * 2u; } } } while (0)
    GUnit cur, nxt; int ui = 0;
    if (!S.get(0, cur)) return;
    f32x4 acc[2][2][4][2]; i32x4 acci[2][2][4][2];
#pragma unroll
    for (int a = 0; a < 2; ++a)
#pragma unroll
        for (int b = 0; b < 2; ++b)
#pragma unroll
            for (int m = 0; m < 4; ++m)
#pragma unroll
                for (int n = 0; n < 2; ++n) { acc[a][b][m][n] = (f32x4){0.f, 0.f, 0.f, 0.f}; acci[a][b][m][n] = (i32x4){0, 0, 0, 0}; }
    bf16x8 At[4][2], B0[2][2], B1[2][2]; i32x8 At8[4], B08[2], B18[2];
    int sc8 = 0x7f7f7f7f; asm volatile("" : "+v"(sc8));
    unsigned vA[2][2], vN[2][2];
    VOFFS_(vA, cur);
    const char* cA = (const char*)cur.A; const char* cB = (const char*)cur.Bt;
    STAGE_(SB_(0, 0), cB, voffB); STAGE_(SA_(0, 0), cA, vA[0]); STAGE_(SB_(0, 1), cB + hstepB, voffB); STAGE_(SA_(0, 1), cA, vA[1]);
    if (wr == 1) BAR_;
    WAIT_V_(4); BAR_;
    STAGE_(SB_(1, 0), cB + kstep, voffB); STAGE_(SA_(1, 0), cA + kstep, vA[0]); STAGE_(SB_(1, 1), cB + hstepB + kstep, voffB); STAGE_(SA_(1, 1), cA + kstep, vA[1]);
    WAIT_V_(8); BAR_;
    for (;;) {
        const bool has_next = S.get(ui + 1, nxt);
        const char* nA = has_next ? (const char*)nxt.A : cA; const char* nB = has_next ? (const char*)nxt.Bt : cB;
        if (has_next) { VOFFS_(vN, nxt); }
        for (int t = 0; t < nt; t += 2) {
            const bool last = (t == nt - 2);
            if constexpr (Epi::SEG) { if (t > 0 && (t & 7) == 0) {
                int tz = tid; asm volatile("" : "+v"(tz)); const int er = ((tz >> 8) & 1) * 64 + (tz & 15), ec = ((tz >> 6) & 3) * 32 + ((((tz >> 4) & 1) << 1) | ((tz >> 5) & 1)) * 8;
#pragma unroll
                for (int ai = 0; ai < 2; ++ai) { typename Epi::SPre sp[4];
#pragma unroll
                    for (int m = 0; m < 4; ++m) E.seg_pre(cur, ai * 128 + m * 16 + er, ec, (t >> 3) - 1, sp[m]);
#pragma unroll
                    for (int m = 0; m < 4; ++m) E.seg_fin(acc[ai][0][m], acc[ai][1][m], sp[m]);
                    asm volatile("" ::: "memory"); }
            } }
            const char* a2 = last ? nA : cA + (size_t)(t + 2) * kstep; const char* b2 = last ? nB : cB + (size_t)(t + 2) * kstep;
            const char* a3 = a2 + kstep; const char* b3 = b2 + kstep;
            unsigned w0[2], w1[2];
#pragma unroll
            for (int i = 0; i < 2; ++i) { w0[i] = (last && has_next) ? vN[0][i] : vA[0][i]; w1[i] = (last && has_next) ? vN[1][i] : vA[1][i]; }
            LDB_(B0, 0, 0); SCHED_; LDA_(At, 0, 0);
            WAIT_L_(8); BAR_; WAIT_L_(0); MMA_(0, 0, At, B0); BAR_; SCHED_;
            LDB_(B1, 0, 1); STAGE_(SB_(0, 0), b2, voffB);
            BAR_; WAIT_L_(0); MMA_(0, 1, At, B1); BAR_;
            LDA_(At, 0, 1); STAGE_(SA_(0, 0), a2, w0);
            BAR_; WAIT_L_(0); MMA_(1, 0, At, B0); BAR_; SCHED_;
            STAGE_(SB_(0, 1), b2 + hstepB, voffB);
            { const int lax = __builtin_amdgcn_readfirstlane((t == 0 && ui > 0) ? 1 : 0); asm volatile("s_waitcnt vmcnt(%1)\n\ts_cmp_lg_u32 %0, 0\n\ts_cbranch_scc1 .Llax_%=\n\ts_waitcnt vmcnt(6)\n.Llax_%=:" :: "s"(lax), "n"(6 + Epi::NST) : "memory", "scc"); }
            BAR_; MMA_(1, 1, At, B1); BAR_;
            LDB_(B0, 1, 0); SCHED_; LDA_(At, 1, 0); STAGE_(SA_(0, 1), a2, w1);
            WAIT_L_(8); BAR_; WAIT_L_(0); MMA_(0, 0, At, B0); BAR_; SCHED_;
            LDB_(B1, 1, 1); STAGE_(SB_(1, 0), b3, voffB);
            BAR_; WAIT_L_(0); MMA_(0, 1, At, B1); BAR_;
            LDA_(At, 1, 1); STAGE_(SA_(1, 0), a3, w0);
            BAR_; WAIT_L_(0); MMA_(1, 0, At, B0); BAR_; SCHED_;
            STAGE_(SB_(1, 1), b3 + hstepB, voffB); STAGE_(SA_(1, 1), a3, w1);
            WAIT_V_(8); BAR_; MMA_(1, 1, At, B1); BAR_;
        }
        { int tz = tid; asm volatile("" : "+v"(tz)); const int er = ((tz >> 8) & 1) * 64 + (tz & 15), ec = ((tz >> 6) & 3) * 32 + ((((tz >> 4) & 1) << 1) | ((tz >> 5) & 1)) * 8;
          typename Epi::Pre pre[2][4];
#pragma unroll
          for (int ai = 0; ai < 2; ++ai)
#pragma unroll
              for (int m = 0; m < 4; ++m) E.pre(cur, ai * 128 + m * 16 + er, ec, pre[ai][m]);
          if constexpr (I8) {
#pragma unroll
              for (int ai = 0; ai < 2; ++ai)
#pragma unroll
                  for (int m = 0; m < 4; ++m) { const float rs = rowscale[cur.row0 + ai * 128 + m * 16 + er] * oscale * Epi::unit_scale(cur);
#pragma unroll
                      for (int bj = 0; bj < 2; ++bj)
#pragma unroll
                          for (int n = 0; n < 2; ++n)
#pragma unroll
                              for (int j = 0; j < 4; ++j) acc[ai][bj][m][n][j] = (float)acci[ai][bj][m][n][j] * rs; } }
          if constexpr (FP8) {
#pragma unroll
              for (int ai = 0; ai < 2; ++ai)
#pragma unroll
                  for (int bj = 0; bj < 2; ++bj)
#pragma unroll
                      for (int m = 0; m < 4; ++m)
#pragma unroll
                          for (int n = 0; n < 2; ++n) acc[ai][bj][m][n] *= oscale; }
          if constexpr (Epi::PAIR_M) {
#pragma unroll
          for (int ai = 0; ai < 2; ++ai)
#pragma unroll
              for (int m = 0; m < 4; m += 2) { const f32x4 a4[2][2] = {{acc[ai][0][m][0], acc[ai][0][m][1]}, {acc[ai][1][m][0], acc[ai][1][m][1]}}; const f32x4 b4[2][2] = {{acc[ai][0][m + 1][0], acc[ai][0][m + 1][1]}, {acc[ai][1][m + 1][0], acc[ai][1][m + 1][1]}};
                  E.fin2(cur, ai * 128 + m * 16 + er, ai * 128 + (m + 1) * 16 + er, ec, a4, b4, pre[ai][m], pre[ai][m + 1]); }
          } else {
#pragma unroll
          for (int ai = 0; ai < 2; ++ai)
#pragma unroll
              for (int m = 0; m < 4; ++m) { const f32x4 a4[2][2] = {{acc[ai][0][m][0], acc[ai][0][m][1]}, {acc[ai][1][m][0], acc[ai][1][m][1]}}; E.fin(cur, ai * 128 + m * 16 + er, ec, a4, pre[ai][m]); } } }
        if (!has_next) break;
#pragma unroll
        for (int a = 0; a < 2; ++a)
#pragma unroll
            for (int b = 0; b < 2; ++b)
#pragma unroll
                for (int m = 0; m < 4; ++m)
#pragma unroll
                    for (int n = 0; n < 2; ++n) { acc[a][b][m][n] = (f32x4){0.f, 0.f, 0.f, 0.f}; acci[a][b][m][n] = (i32x4){0, 0, 0, 0}; }
        cur = nxt; cA = nA; cB = nB; ++ui;
#pragma unroll
        for (int h = 0; h < 2; ++h)
#pragma unroll
            for (int i = 0; i < 2; ++i) vA[h][i] = vN[h][i];
    }
    WAIT_V_(0);
    if (wr == 0) BAR_;
    BAR_;
#undef SA_
#undef SB_
#undef STAGE_
#undef LDA_
#undef LDB_
#undef MMA_
#undef WAIT_V_
#undef WAIT_L_
#undef BAR_
#undef SCHED_
#undef VOFFS_
}

struct DenseSched {
    const bf16_t* A; const bf16_t* Bt; int K, nM, nN, nwg, G, c, i0, i1, split, pnoff;
    __device__ __forceinline__ void segment(int sg) { i0 = sg == 0 ? 0 : split; i1 = sg == 0 ? split : (1 << 30); }
    __device__ __forceinline__ bool get(int ii, GUnit& u) const {
        const int i = ii + i0; if (i >= i1) return false;
        const long L = (long)i * G + c; if (L >= nwg) return false;
        int wgid = (int)L; { const int q = nwg / 8, r = nwg % 8, xcd = wgid % 8, off = wgid / 8; wgid = (xcd < r ? xcd * (q + 1) : r * (q + 1) + (xcd - r) * q) + off; }
        const int nig = 8 * nN, gid = wgid / nig, fm = gid * 8, gsz = (nM - fm) < 8 ? (nM - fm) : 8;
        const int pm = fm + ((wgid % nig) % gsz), pn = (wgid % nig) / gsz;
        u.pn = pn + pnoff; u.row0 = pm * 256; u.A = A; u.gather = nullptr; u.Bt = Bt + (size_t)pn * 256 * K; u.e = 0; return true;
    }
};
struct QkvSched {
    unsigned char* ws; int l, G, c;
    __device__ __forceinline__ bool get(int i, GUnit& g) const {
        const int u = i * G + c; if (u >= 144) return false; g.gather = nullptr;
        if (u < 128) { g.e = 0; g.pn = u & 1; g.row0 = (u >> 1) * 256; g.A = (const bf16_t*)(ws + WS_XB8); g.Bt = (const bf16_t*)(ws + WS_WQ + l * SZ_WQ + (size_t)g.pn * 256 * D); g.dst = (bf16_t*)(ws + WS_Q); }
        else { const int v = u - 128; g.e = 1 + (v >> 3); g.pn = v & 1; g.row0 = ((v >> 1) & 3) * 256; g.A = (const bf16_t*)(ws + WS_MEMB8); g.Bt = (const bf16_t*)(ws + (g.e == 1 ? WS_WK : WS_WV) + l * SZ_WQ + (size_t)g.pn * 256 * D); g.dst = (bf16_t*)(ws + (g.e == 1 ? WS_KM : WS_VM)) + (size_t)l * TM * W; }
        return true;
    }
};
template <int NCT, bool GATEUP> struct MoeSched {
    unsigned char* ws; const LAS int* pst; int l, G, c, nunits;
    __device__ __forceinline__ bool get(int i, GUnit& g) const {
        const int u = i * G + c; if (u >= nunits) return false;
        const int rt = u / NCT; g.pn = u % NCT; g.row0 = rt * 256; const int e = __builtin_amdgcn_readfirstlane((int)((const LAS unsigned char*)(pst + 68))[rt]); g.e = e;
        if (GATEUP) { g.A = (const bf16_t*)(ws + WS_XB8); g.gather = (const int*)(ws + WS_TOK) + g.row0; g.Bt = (const bf16_t*)(ws + WS_WGU8 + ((size_t)l * NEX + e) * SZ_WGU8 + (size_t)g.pn * 256 * D); }
        else { g.A = (const bf16_t*)(ws + WS_HB); g.gather = nullptr; g.Bt = (const bf16_t*)(ws + WS_WDN + ((size_t)l * NEX + e) * SZ_WDN1 + (size_t)g.pn * 256 * ED); }
        return true;
    }
};

struct TDesc { const float* sp; int sld; unsigned char* dp; int dldb; int fp8; float qs; };
constexpr int TK_WINA = 1024, TK_WINB = 2560, TK_BR = 384, TK_WOUT = 512, TK_QKV = 384, TK_WO = 128, TK_GU = NEX * 8 * 32, TK_DN = NEX * 128;
constexpr int TK_L0DEF = TK_BR + TK_WOUT + TK_QKV + TK_WO + TK_GU + TK_DN, TK_LAYER = TK_WINA + TK_WINB + TK_L0DEF;
__device__ __forceinline__ void tile_desc(const Frame& F, int l, int t, TDesc& d) {
    const KArgs a = F.ka; unsigned char* ws = F.ws_(); d.fp8 = 0; d.qs = W8_SCALE;
    if (t < TK_WINA) { const int tk = t >> 6, tc = t & 63; d.sp = ((const float*)a->in[IN_WIN]) + (size_t)l * D * PROJ_W + (size_t)tk * 128 * PROJ_W + tc * 64; d.sld = PROJ_W; d.dldb = D; d.fp8 = 2; d.qs = 127.0f / fmaxf(__uint_as_float(((const unsigned*)(ws + WS_CTL))[CW_WABS + l]), 1e-30f); d.dp = ws + WS_WINQ + l * SZ_WINQ + (size_t)tc * 64 * D + tk * 128; return; }
    t -= TK_WINA;
    if (t < TK_WINB) { const int tk = t / 160, tc = t % 160; d.sp = ((const float*)a->in[IN_WIN]) + (size_t)l * D * PROJ_W + (size_t)tk * 128 * PROJ_W + 4104 + tc * 64; d.sld = PROJ_W;
        if (tc < 32) { d.dldb = D; d.fp8 = 2; d.qs = 127.0f / fmaxf(__uint_as_float(((const unsigned*)(ws + WS_CTL))[CW_WABS + l]), 1e-30f); d.dp = ws + WS_WINQ + l * SZ_WINQ + (size_t)(4096 + tc * 64) * D + tk * 128; }
        else { d.dldb = D; d.fp8 = 1; d.dp = ws + WS_WIN8 + l * SZ_WIN8 + (size_t)(4096 + tc * 64) * D + tk * 128; }
        return; }
    t -= TK_WINB;
    if (t < TK_BR) { const int n = 1 + (t >> 7), tt = t & 127, tk = tt >> 5, tc = tt & 31; d.sp = ((const float*)a->in[IN_WBR]) + ((size_t)l * 4 + n) * W * D + (size_t)tk * 128 * D + tc * 64; d.sld = D; d.dldb = D * 2; d.dp = ws + WS_WB + l * SZ_DD + ((size_t)tc * 64 * D + n * W + tk * 128) * 2; return; }
    t -= TK_BR;
    if (t < TK_WOUT) { const int tk = t >> 5, tc = t & 31; d.sp = ((const float*)a->in[IN_WMIX]) + (size_t)l * D * D + (size_t)tk * 128 * D + tc * 64; d.sld = D; d.dldb = D; d.fp8 = 1; d.dp = ws + WS_WOUT + l * SZ_DD + ((size_t)tc * 64 * D + tk * 128); return; }
    t -= TK_WOUT;
    if (t < TK_QKV) { const int which = t >> 7, tt = t & 127, tk = tt >> 3, tc = tt & 7; d.sp = (const float*)a->in[which == 0 ? IN_WQ : (which == 1 ? IN_WK : IN_WV)] + (size_t)l * D * W + (size_t)tk * 128 * W + tc * 64; d.sld = W; d.dldb = D * 2;
        d.dp = ws + (which == 0 ? WS_WQ : (which == 1 ? WS_WK : WS_WV)) + l * SZ_WQ + ((size_t)tc * 64 * D + tk * 128) * 2;
        d.fp8 = 1; d.dldb = D; d.dp = ws + (which == 0 ? WS_WQ : (which == 1 ? WS_WK : WS_WV)) + l * SZ_WQ + ((size_t)tc * 64 * D + tk * 128);
        return; }
    t -= TK_QKV;
    if (t < TK_WO) { const int tk = t >> 5, tc = t & 31; d.sp = ((const float*)a->in[IN_WO]) + (size_t)l * W * D + (size_t)tk * 128 * D + tc * 64; d.sld = D; d.dldb = W; d.fp8 = 1; d.dp = ws + WS_WO + l * SZ_WQ + ((size_t)tc * 64 * W + tk * 128); return; }
    t -= TK_WO;
    if (t < TK_GU) { const int tt = t & 31, job = t >> 5, half = job & 1, j = (job >> 1) & 3, e = job >> 3, tk = tt >> 1, tc = tt & 1;
        d.sp = (e < NE ? ((const float*)a->in[IN_WGU]) + ((size_t)l * NE + e) * D * 1024 : ((const float*)a->in[IN_SGU]) + (size_t)l * D * 1024) + half * 512 + j * 128 + (size_t)tk * 128 * 1024 + tc * 64; d.sld = 1024; d.dldb = D; d.fp8 = 1;
        d.dp = ws + WS_WGU8 + ((size_t)l * NEX + e) * SZ_WGU8 + (size_t)(j * 256 + half * 128 + tc * 64) * D + tk * 128; return; }
    t -= TK_GU;
    { const int tt = t & 127, e = t >> 7, tk = tt >> 5, tc = tt & 31;
      d.sp = (e < NE ? ((const float*)a->in[IN_WDN]) + ((size_t)l * NE + e) * ED * D : ((const float*)a->in[IN_SDN]) + (size_t)l * ED * D) + (size_t)tk * 128 * D + tc * 64; d.sld = D; d.dldb = ED; d.fp8 = 1;
      d.dp = ws + WS_WDN + ((size_t)l * NEX + e) * SZ_WDN1 + (size_t)tc * 64 * ED + tk * 128; }
}
constexpr int XP_SLOT = 64 * 256;
template <int NB> struct XRegs { f32x4 r[NB][4]; };
template <int NB> __device__ __forceinline__ void xpose_load(const Frame& F, int l, int t0, int tstep, int n, XRegs<NB>& X) {
    const int tid = F.tid, row4 = (tid >> 4) * 4, cq = (tid & 15) * 4;
#pragma unroll
    for (int b = 0; b < NB; ++b) if (b < n) { TDesc d; tile_desc(F, l, t0 + b * tstep, d); const float* sp = d.sp + (size_t)row4 * d.sld + cq;
#pragma unroll
        for (int q = 0; q < 4; ++q) X.r[b][q] = __builtin_nontemporal_load((const f32x4*)(sp + (size_t)q * d.sld)); }
}
template <int NB> __device__ __forceinline__ void xpose_finish(const Frame& F, int l, int t0, int tstep, int n, const XRegs<NB>& X) {
    const int tid = F.tid, row4 = (tid >> 4) * 4, cq = (tid & 15) * 4;
    int t1 = t0; asm volatile("" : "+s"(t1));
#pragma unroll
    for (int b = 0; b < NB; ++b) if (b < n) { TDesc d; tile_desc(F, l, t1 + b * tstep, d); LAS unsigned char* L = F.lds + b * XP_SLOT;
        if (d.fp8) { const int sw = ((cq >> 2) & 7) << 4;
#pragma unroll
            for (int j = 0; j < 4; ++j) *(LAS unsigned*)(L + (cq + j) * 128 + (row4 ^ sw)) = (d.fp8 == 2) ? pack_i8x4(X.r[b][0][j] * d.qs, X.r[b][1][j] * d.qs, X.r[b][2][j] * d.qs, X.r[b][3][j] * d.qs) : pack_fp8x4(X.r[b][0][j] * W8_SCALE, X.r[b][1][j] * W8_SCALE, X.r[b][2][j] * W8_SCALE, X.r[b][3][j] * W8_SCALE);
        } else { const int sw = ((cq >> 2) & 15) << 4;
#pragma unroll
            for (int j = 0; j < 4; ++j) { u32x2 w; w.x = pack2(X.r[b][0][j], X.r[b][1][j]); w.y = pack2(X.r[b][2][j], X.r[b][3][j]); *(LAS u32x2*)(L + (cq + j) * 256 + ((row4 * 2) ^ sw)) = w; } } }
    __syncthreads();
    int t2 = t0; asm volatile("" : "+s"(t2));
#pragma unroll
    for (int b = 0; b < NB; ++b) if (b < n) { TDesc d; tile_desc(F, l, t2 + b * tstep, d); const LAS unsigned char* L = F.lds + b * XP_SLOT; const int c = tid >> 3, kq = tid & 7;
        if (d.fp8) *(u32x4*)(d.dp + (size_t)c * d.dldb + kq * 16) = *(const LAS u32x4*)(L + c * 128 + ((kq * 16) ^ (((c >> 2) & 7) << 4)));
        else { const int sw = ((c >> 2) & 15) << 4; *(u32x4*)(d.dp + (size_t)c * d.dldb + kq * 16) = *(const LAS u32x4*)(L + c * 256 + ((kq * 16) ^ sw)); *(u32x4*)(d.dp + (size_t)c * d.dldb + 128 + kq * 16) = *(const LAS u32x4*)(L + c * 256 + ((128 + kq * 16) ^ sw)); } }
    __syncthreads();
}
__device__ __forceinline__ void xpose_range(const Frame& F, int l, int tlo, int thi, int rank, int nranks) {
    constexpr int NB = 4; const int step = nranks * NB;
    XRegs<NB> A, B;
    int t = tlo + rank * NB; if (t >= thi) return;
#define XP_CNT(tt) (((thi) - (tt)) < NB ? ((thi) - (tt)) : NB)
    xpose_load<NB>(F, l, t, 1, XP_CNT(t), A);
    for (;;) {
        const int tb = t + step; const bool hb = tb < thi; if (hb) xpose_load<NB>(F, l, tb, 1, XP_CNT(tb), B);
        xpose_finish<NB>(F, l, t, 1, XP_CNT(t), A);
        if (!hb) break;
        const int ta = tb + step; const bool ha = ta < thi; if (ha) xpose_load<NB>(F, l, ta, 1, XP_CNT(ta), A);
        xpose_finish<NB>(F, l, tb, 1, XP_CNT(tb), B);
        if (!ha) break;
        t = ta;
    }
#undef XP_CNT
}
__device__ __forceinline__ void pool_fold(const Frame& F, int l, int rank, int nranks) {
    const KArgs a = F.ka; unsigned char* ws = F.ws_();
    for (size_t i = (size_t)rank * NTHR + F.tid; i < (size_t)W * D; i += (size_t)nranks * NTHR) {
        const int d = (int)(i % D), gc = (int)(i / D), g = gc >> 7;
        const float* pw = ((const float*)a->in[IN_POOLW]) + ((size_t)l * W + gc) * 128; const float* ps = ((const float*)a->in[IN_POOLS]) + l * W + g * 128;
        const float* wb = ((const float*)a->in[IN_WBR]) + ((size_t)l * 4 * W + g * 128) * D + d;
        float s = 0.f;
        for (int e = 0; e < 128; ++e) s += pw[e] * ps[e] * wb[(size_t)e * D];
        ((bf16_t*)(ws + WS_WB + l * SZ_DD))[(size_t)d * D + gc] = f2bf(s);
    }
}
__device__ __forceinline__ void phase_wabs(const Frame& F) {
    const KArgs a = F.ka; unsigned char* ws = F.ws_();
    for (int l = 0; l < DEPTH; ++l) { float m = 0.f; const float* w = ((const float*)a->in[IN_WIN]) + (size_t)l * D * PROJ_W;
        for (size_t i = (size_t)F.wg * NTHR + F.tid; i < (size_t)D * (NBR / 4); i += (size_t)F.nwg * NTHR) { const int c4 = (int)(i % (NBR / 4)), k = (int)(i / (NBR / 4)); const int col = c4 * 4 < 4096 ? c4 * 4 : c4 * 4 + 8;
            const f32x4 v = *(const f32x4*)(w + (size_t)k * PROJ_W + col); m = fmaxf(m, fmaxf(fmaxf(fabsf(v[0]), fabsf(v[1])), fmaxf(fabsf(v[2]), fabsf(v[3])))); }
        m = wave_max(m);
        if (F.lane == 0) __hip_atomic_fetch_max((unsigned*)(ws + WS_CTL) + CW_WABS + l, __float_as_uint(m), __ATOMIC_RELAXED, __HIP_MEMORY_SCOPE_AGENT); }
}
__device__ __forceinline__ void phase_prologue(const Frame& F) {
    const KArgs a = F.ka;
    unsigned char* ws = F.ws_();
    xpose_range(F, 0, 0, TK_WINA + TK_WINB, F.wg, F.nwg);
    const size_t gtid = (size_t)F.wg * NTHR + F.tid, gn = (size_t)F.nwg * NTHR;
    for (size_t i = gtid; i < (size_t)DEPTH * 8 * D; i += gn) { const int k = (int)(i % D), c = (int)((i / D) % 8), l = (int)(i / (8 * D));
        ((float*)(ws + WS_WIF))[i] = ((const float*)a->in[IN_WIN])[(size_t)l * D * PROJ_W + (size_t)k * PROJ_W + 4096 + c]; }
    for (size_t i = gtid; i < (size_t)DEPTH * 16 * D; i += gn) { const int k = (int)(i % D), c = (int)((i / D) % 16), l = (int)(i / (16 * D));
        const float wv = c < 8 ? ((const float*)a->in[IN_WIN])[(size_t)l * D * PROJ_W + (size_t)k * PROJ_W + 4096 + c] : 0.f; const bf16_t hi = f2bf(wv), lo = f2bf(wv - bf2f(hi));
        bf16_t* o = (bf16_t*)(ws + WS_WIFB) + (size_t)l * 2 * 16 * D; o[(size_t)c * D + k] = hi; o[(size_t)(16 + c) * D + k] = lo; }
    for (size_t i = gtid; i < (size_t)DEPTH * NE * D; i += gn) { const int k = (int)(i % D), e = (int)((i / D) % NE), l = (int)(i / ((size_t)NE * D));
        const float w = ((const float*)a->in[IN_RW])[((size_t)l * D + k) * NE + e]; const bf16_t hi = f2bf(w); const bf16_t lo = f2bf(w - bf2f(hi));
        bf16_t* o = (bf16_t*)(ws + WS_RWT) + (size_t)l * 2 * NE * D; o[(size_t)e * D + k] = hi; o[(size_t)(NE + e) * D + k] = lo; }
    for (size_t i = gtid; i < (size_t)SEQ * 64; i += gn) { const int f = (int)(i & 63), s = (int)(i >> 6);
        const float inv = powf(10000.0f, -(float)f / 64.0f); const float ang = (float)s * inv;
        ((float*)(ws + WS_ROPE))[i] = cosf(ang); ((float*)(ws + WS_ROPE))[(size_t)SEQ * 64 + i] = sinf(ang); }
    for (int row = F.wg * 8 + F.wave; row < T; row += F.nwg * 8) { float v[32]; const float* xr = ((const float*)a->in[IN_X]) + (size_t)row * D;
#pragma unroll
        for (int j = 0; j < 4; ++j) { const f32x4 p = *(const f32x4*)(xr + j * 512 + F.lane * 8), q = *(const f32x4*)(xr + j * 512 + F.lane * 8 + 4); v[j * 8] = p[0]; v[j * 8 + 1] = p[1]; v[j * 8 + 2] = p[2]; v[j * 8 + 3] = p[3]; v[j * 8 + 4] = q[0]; v[j * 8 + 5] = q[1]; v[j * 8 + 6] = q[2]; v[j * 8 + 7] = q[3]; }
        st_row32((bf16_t*)(ws + WS_XB) + (size_t)row * D, F.lane, v); st_row32_fp8(ws + WS_XB8 + (size_t)row * D, F.lane, v); st_row32_i8(ws + WS_XQ8 + (size_t)row * D, (float*)(ws + WS_XSC) + row, F.lane, v); }
    for (size_t i = gtid; i < (size_t)TM * D / 4; i += gn) { const f32x4 v = ((const f32x4*)((const float*)a->in[IN_MEM]))[i]; st_bf16x4((bf16_t*)(ws + WS_MEMB) + i * 4, v);
        ((unsigned*)(ws + WS_MEMB8))[i] = pack_fp8x4(v[0] * X8_SCALE, v[1] * X8_SCALE, v[2] * X8_SCALE, v[3] * X8_SCALE); }
    __syncthreads();
}
__device__ __forceinline__ void prologue_deferred(const Frame& F, int rank, int nranks) {
    xpose_range(F, 0, TK_WINA + TK_WINB, TK_LAYER, rank, nranks);
    xpose_range(F, 1, 0, TK_LAYER, rank, nranks);
    pool_fold(F, 0, rank, nranks); pool_fold(F, 1, rank, nranks);
    __syncthreads();
}

__device__ __forceinline__ void unpack8(u32x4 w, float (&f)[8]) {
#pragma unroll
    for (int j = 0; j < 4; ++j) { f[2 * j] = __uint_as_float(w[j] << 16); f[2 * j + 1] = __uint_as_float(w[j] & 0xffff0000u); } }
__device__ __forceinline__ u32x4 pack8f(const float (&f)[8]) { u32x4 w;
#pragma unroll
    for (int j = 0; j < 4; ++j) w[j] = pack2(f[2 * j], f[2 * j + 1]); return w; }
template <int WIN> __device__ __forceinline__ void pool_block(const bf16_t* pu, bf16_t* out, int s0) {
    float sum[8];
#pragma unroll
    for (int e = 0; e < 8; ++e) sum[e] = 0.f;
    u32x4 hist[WIN - 1 + 8];
#pragma unroll
    for (int j = 0; j < WIN - 1 + 8; ++j) { const int ds = j - (WIN - 1); hist[j] = (s0 + ds >= 0) ? *(const u32x4*)(pu + (ptrdiff_t)ds * NBR) : (u32x4){0u, 0u, 0u, 0u}; }
#pragma unroll
    for (int j = 0; j < WIN - 1; ++j) { float f[8]; unpack8(hist[j], f);
#pragma unroll
        for (int e = 0; e < 8; ++e) sum[e] += f[e]; }
#pragma unroll
    for (int i = 0; i < 8; ++i) { float f[8]; unpack8(hist[WIN - 1 + i], f); const int cnt = (s0 + i + 1 < WIN) ? s0 + i + 1 : WIN; const float rc = 1.0f / (float)cnt; float o[8];
#pragma unroll
        for (int e = 0; e < 8; ++e) { sum[e] += f[e]; o[e] = sum[e] * rc - f[e]; }
        *(u32x4*)(out + (size_t)i * D) = pack8f(o);
        float fo[8]; unpack8(hist[i], fo);
#pragma unroll
        for (int e = 0; e < 8; ++e) sum[e] -= fo[e]; }
}
template <bool WITH_D = true> __device__ __forceinline__ void phase_mix1v2(const Frame& F, int l, const bf16_t* xcur) {
    const KArgs a = F.ka;
    unsigned char* ws = F.ws_();
    LAS float* dots = (LAS float*)(F.lds + 65536);
    LAS float* wl = (LAS float*)F.lds;
    const float* wif = (const float*)(ws + WS_WIF) + (size_t)l * 8 * D;
    const float* gb = ((const float*)a->in[IN_GATEB]) + l * 8;
    float* cumf = (float*)(ws + WS_CUMF); float* ipre = (float*)(ws + WS_IPRE); float* summ = (float*)(ws + WS_SUMM); float* av = (float*)(ws + WS_AV); float* pm = (float*)(ws + WS_PM);
    const bf16_t* wifb = (const bf16_t*)(ws + WS_WIFB) + (size_t)l * 2 * 16 * D;
    for (int item = F.wg; item < BATCH * NCH; item += F.nwg) {
        const int b = item / NCH, c = item % NCH; const int t0 = b * SEQ + c * CH;
        { const int lane = F.lane, g = lane >> 4, li = lane & 15, w = F.wave;
          f32x4 acc[4] = {{0.f, 0.f, 0.f, 0.f}, {0.f, 0.f, 0.f, 0.f}, {0.f, 0.f, 0.f, 0.f}, {0.f, 0.f, 0.f, 0.f}};
#pragma unroll 4
          for (int ks = 8 * w; ks < 8 * w + 8; ++ks) { const bf16x8 bh = *(const bf16x8*)(wifb + (size_t)li * D + ks * 32 + g * 8), bl = *(const bf16x8*)(wifb + (size_t)(16 + li) * D + ks * 32 + g * 8);
#pragma unroll
              for (int mt = 0; mt < 4; ++mt) { const bf16x8 xa = *(const bf16x8*)(xcur + (size_t)(t0 + 16 * mt + li) * D + ks * 32 + g * 8);
                  acc[mt] = __builtin_amdgcn_mfma_f32_16x16x32_bf16(xa, bh, acc[mt], 0, 0, 0); acc[mt] = __builtin_amdgcn_mfma_f32_16x16x32_bf16(xa, bl, acc[mt], 0, 0, 0); } }
          LAS float* part = (LAS float*)F.lds;
          if (li < 8) {
#pragma unroll
              for (int mt = 0; mt < 4; ++mt)
#pragma unroll
                  for (int r = 0; r < 4; ++r) part[((w * 64) + 16 * mt + 4 * g + r) * 8 + li] = acc[mt][r]; }
          __syncthreads();
          if (F.tid < 512) { const int tok = F.tid >> 3, q = F.tid & 7; float sacc = 0.f;
#pragma unroll
              for (int ww = 0; ww < 8; ++ww) sacc += part[(ww * 64 + tok) * 8 + q];
              dots[tok * 8 + q] = sacc; } }
        __syncthreads();
        if (F.wave < NH) {
            const int h = F.wave, s = F.lane; const float ip = dots[s * 8 + h] + gb[h], fp = dots[s * 8 + 4 + h] + gb[4 + h];
            const float lf = fminf(fp, 0.f) - log1pf(__expf(-fabsf(fp)));
            float cs = lf;
#pragma unroll
            for (int o = 1; o < 64; o <<= 1) { const float n = __shfl_up(cs, o); if (s >= o) cs += n; }
            const float ftot = __shfl(cs, 63); const float aa = ip - cs;
            float px = aa;
#pragma unroll
            for (int o = 1; o < 64; o <<= 1) { const float n = __shfl_up(px, o); if (s >= o) px = fmaxf(px, n); }
            const float gm = ftot + __shfl(px, 63);
            const size_t o = (size_t)(b * NH + h) * SEQ + c * CH + s; cumf[o] = cs; ipre[o] = ip; av[o] = aa; pm[o] = px;
            if (s == 0) { summ[((size_t)(b * NH + h) * NCH + c) * 2] = ftot; summ[((size_t)(b * NH + h) * NCH + c) * 2 + 1] = gm; }
        }
        __syncthreads();
    }
    bf16_t* proj = (bf16_t*)(ws + WS_PROJ); bf16_t* br = (bf16_t*)(ws + WS_BR);
    for (int it = F.wg * 8 + F.wave; it < (T / 32) * 4; it += F.nwg * 8) {
        const int grp = it & 3, tbq = it >> 2; const int tb = tbq * 4 + (F.lane >> 4), co = grp * 16 + (F.lane & 15);
        const int t0 = tb * 8, s0 = t0 % SEQ; const bf16_t* pu = proj + (size_t)t0 * NBR + PC_U + co * 8; bf16_t* out = br + (size_t)t0 * D + co * 8;
        if (grp == 0) pool_block<2>(pu, out, s0); else if (grp == 1) pool_block<4>(pu, out, s0); else if (grp == 2) pool_block<8>(pu, out, s0); else pool_block<16>(pu, out, s0);
    }
    { const float* cw = ((const float*)a->in[IN_CONVW]) + (size_t)l * 3 * W;
      for (size_t it = (size_t)F.wg * NTHR + F.tid; it < (size_t)(T / 8) * 64; it += (size_t)F.nwg * NTHR) {
        const int co = (int)(it & 63), tb = (int)(it >> 6), t0 = tb * 8, s0 = t0 % SEQ;
        const bf16_t* pr = proj + (size_t)t0 * NBR + co * 8;
        float w0[8], w1[8], w2[8];
#pragma unroll
        for (int e = 0; e < 8; ++e) { w0[e] = cw[co * 8 + e]; w1[e] = cw[W + co * 8 + e]; w2[e] = cw[2 * W + co * 8 + e]; }
        float z1[8], z2[8];
#pragma unroll
        for (int e = 0; e < 8; ++e) { z1[e] = 0.f; z2[e] = 0.f; }
        if (s0 >= 2) { float c_[8], h_[8]; unpack8(*(const u32x4*)(pr + PC_CC - 2 * NBR), c_); unpack8(*(const u32x4*)(pr + PC_CH - 2 * NBR), h_);
#pragma unroll
            for (int e = 0; e < 8; ++e) z2[e] = c_[e] * h_[e]; }
        if (s0 >= 1) { float c_[8], h_[8]; unpack8(*(const u32x4*)(pr + PC_CC - NBR), c_); unpack8(*(const u32x4*)(pr + PC_CH - NBR), h_);
#pragma unroll
            for (int e = 0; e < 8; ++e) z1[e] = c_[e] * h_[e]; }
#pragma unroll
        for (int i = 0; i < 8; ++i) { float c_[8], h_[8], b_[8], o[8]; unpack8(*(const u32x4*)(pr + PC_CC + (size_t)i * NBR), c_); unpack8(*(const u32x4*)(pr + PC_CH + (size_t)i * NBR), h_); unpack8(*(const u32x4*)(pr + PC_CB + (size_t)i * NBR), b_);
#pragma unroll
            for (int e = 0; e < 8; ++e) { const float z0 = c_[e] * h_[e]; o[e] = b_[e] * (w0[e] * z0 + w1[e] * z1[e] + w2[e] * z2[e]); z2[e] = z1[e]; z1[e] = z0; }
            *(u32x4*)(br + (size_t)(t0 + i) * D + W + co * 8) = pack8f(o); }
      } }
    if constexpr (WITH_D) { const float* ropec = (const float*)(ws + WS_ROPE); const float* ropes = ropec + (size_t)SEQ * 64;
      for (size_t it = (size_t)F.wg * NTHR + F.tid; it < (size_t)T * 64; it += (size_t)F.nwg * NTHR) {
        const int oc = (int)(it & 7), hh = (int)((it >> 3) & 3), isk = (int)((it >> 5) & 1), t = (int)(it >> 6), s = t % SEQ;
        bf16_t* p = proj + (size_t)t * NBR + (isk ? PC_RK : PC_RQ) + hh * HD + oc * 8;
        float x1[8], x2[8], o1[8], o2[8]; unpack8(*(const u32x4*)p, x1); unpack8(*(const u32x4*)(p + 64), x2);
#pragma unroll
        for (int e = 0; e < 8; ++e) { const float cs = ropec[(size_t)s * 64 + oc * 8 + e], sn = ropes[(size_t)s * 64 + oc * 8 + e]; o1[e] = x1[e] * cs - x2[e] * sn; o2[e] = x1[e] * sn + x2[e] * cs; }
        *(u32x4*)p = pack8f(o1); *(u32x4*)(p + 64) = pack8f(o2);
      } }
}

__device__ __forceinline__ float ret_gamma_log2(int h) { return log2f(1.0f - exp2f(-5.0f - (float)h)); }

__device__ __forceinline__ void phase_scan_mfma(const Frame& F) {
    unsigned char* ws = F.ws_();
    constexpr int KS2 = 144, WS2 = 48;
    LAS bf16_t* Kb = (LAS bf16_t*)F.lds;
    LAS bf16_t* Wb = Kb + 2 * 64 * KS2;
    LAS float* mS = (LAS float*)(Wb + 2 * 64 * WS2);
    LAS float* fT = mS + 80;
    const bf16_t* proj = (const bf16_t*)(ws + WS_PROJ);
    const float* av = (const float*)(ws + WS_AV); const float* summ = (const float*)(ws + WS_SUMM);
    const int lane = F.lane, g = lane >> 4, li = lane & 15, w = F.wave, tid = F.tid;
    for (int item = F.wg; item < 2 * NBH * 8; item += F.nwg) {
        const int type = item >> 7, bh = (item >> 3) & 15, vs = item & 7, b = bh >> 2, h = bh & 3;
        if (tid == 0) { float m = 0.f; mS[0] = 0.f; for (int c = 0; c < NCH; ++c) { m = fmaxf(summ[((size_t)bh * NCH + c) * 2] + m, summ[((size_t)bh * NCH + c) * 2 + 1]); mS[c + 1] = m; }
            if (type == 0 && vs == 0) { float* ms = (float*)(ws + WS_MSEQ) + bh * 80; for (int c = 0; c <= NCH; ++c) ms[c] = mS[c]; } }
        if (tid >= 64 && tid < 128) fT[tid - 64] = summ[((size_t)bh * NCH + (tid - 64)) * 2];
        __syncthreads();
        const float lg2 = ret_gamma_log2(h);
        const int kcol = (type == 0 ? PC_MK : PC_RK) + h * HD, vcol = (type == 0 ? PC_MV : PC_RV) + h * HD + vs * 16;
        bf16_t* cst = (bf16_t*)(ws + WS_CST) + ((size_t)(type * NBH + bh) * NCH) * HD * HD;
        float* nsv = (float*)(ws + WS_NST) + (size_t)bh * NCH * HD;
        const int krow = tid >> 3, koct = tid & 7, vrow = (tid >> 1) & 63, vhalf = tid & 1;
        const bf16_t* kbase = proj + (size_t)(b * SEQ + krow) * NBR + kcol + koct * 8;
        const bf16_t* vbase = proj + (size_t)(b * SEQ + vrow) * NBR + vcol + vhalf * 8;
        const float* abase = av + (size_t)bh * SEQ + vrow;
        u32x4 kr[2][2], vr[2]; float ar[2];
#define SCAN_LOAD(c, sl) do { const size_t _o = (size_t)(c) * CH * NBR; kr[sl][0] = *(const u32x4*)(kbase + _o); kr[sl][1] = *(const u32x4*)(kbase + _o + 64); \
        if (tid < 128) { vr[sl] = *(const u32x4*)(vbase + _o); ar[sl] = (type == 0) ? abase[(c) * CH] : 0.f; } } while (0)
#define SCAN_WRITE(c, sl, bf) do { LAS bf16_t* _k = Kb + (bf) * 64 * KS2 + krow * KS2 + koct * 8; *(LAS u32x4*)_k = kr[sl][0]; *(LAS u32x4*)(_k + 64) = kr[sl][1]; \
        if (tid < 128) { const float _w = (type == 0) ? __expf(ar[sl] + fT[c] - mS[(c) + 1]) : exp2f((float)(63 - vrow) * lg2); float _f[8]; unpack8(vr[sl], _f); \
            _Pragma("unroll") for (int _e = 0; _e < 8; ++_e) _f[_e] *= _w; LAS bf16_t* _p = Wb + (bf) * 64 * WS2 + vrow * WS2; *(LAS u32x4*)(_p + vhalf * 8) = pack8f(_f); \
            u32x4 _x = {0u, 0u, 0u, 0u}; if (vhalf == 0) _x[0] = (unsigned)f2bf(_w); *(LAS u32x4*)(_p + 16 + vhalf * 8) = _x; } } while (0)
        f32x4 st = {0.f, 0.f, 0.f, 0.f}, na = {0.f, 0.f, 0.f, 0.f};
#define SCAN_BODY(c, bf) do { { u32x2 _pw; _pw.x = pack2(st[0], st[1]); _pw.y = pack2(st[2], st[3]); *(u32x2*)(cst + (size_t)(c) * HD * HD + (size_t)(vs * 16 + li) * HD + 16 * w + 4 * g) = _pw; } \
        if (type == 0 && vs == 0 && li == 0) *(f32x4*)(nsv + (c) * HD + 16 * w + 4 * g) = na; \
        const float _d = (type == 0) ? __expf(fT[c] + mS[c] - mS[(c) + 1]) : exp2f(64.0f * lg2); st *= _d; na *= _d; \
        _Pragma("unroll") for (int _u = 0; _u < 2; ++_u) { const LAS bf16_t* _kp = Kb + (bf) * 64 * KS2 + (32 * _u + 8 * g + (li >> 2)) * KS2 + 16 * w + 4 * (li & 3); \
            const LAS bf16_t* _wp = Wb + (bf) * 64 * WS2 + (32 * _u + 8 * g + (li >> 2)) * WS2 + 4 * (li & 3); \
            const bf16x8 _A = cat4(lds_tr(_kp), lds_tr(_kp + 4 * KS2)); const bf16x8 _B = cat4(lds_tr(_wp), lds_tr(_wp + 4 * WS2)); \
            st = __builtin_amdgcn_mfma_f32_16x16x32_bf16(_A, _B, st, 0, 0, 0); \
            if (type == 0) { const bf16x8 _B2 = cat4(lds_tr(_wp + 16), lds_tr(_wp + 4 * WS2 + 16)); na = __builtin_amdgcn_mfma_f32_16x16x32_bf16(_A, _B2, na, 0, 0, 0); } } } while (0)
        SCAN_LOAD(0, 0); SCAN_WRITE(0, 0, 0); SCAN_LOAD(1, 1); SCAN_LOAD(2, 0);
        __syncthreads();
        for (int c = 0; c < NCH; c += 2) {
            SCAN_BODY(c, 0);
            SCAN_WRITE(c + 1, 1, 1);
            if (c + 3 < NCH) SCAN_LOAD(c + 3, 1);
            __syncthreads();
            SCAN_BODY(c + 1, 1);
            if (c + 2 < NCH) { SCAN_WRITE(c + 2, 0, 0); }
            if (c + 4 < NCH) SCAN_LOAD(c + 4, 0);
            __syncthreads();
        }
#undef SCAN_LOAD
#undef SCAN_WRITE
#undef SCAN_BODY
    }
}

__device__ __forceinline__ void phase_chunk_mfma(const Frame& F, int l) {
    const KArgs a = F.ka; unsigned char* ws = F.ws_();
    constexpr int QS = 136, VS = 144, PS = 72;
    LAS bf16_t* Qs = (LAS bf16_t*)F.lds; LAS bf16_t* Ks = Qs + 64 * QS; LAS bf16_t* Vs = Ks + 64 * QS; LAS bf16_t* Ps = Vs + 64 * VS;
    LAS float* rv = (LAS float*)(Ps + 64 * PS);
    LAS float* hp = rv + 256;
    const bf16_t* proj = (const bf16_t*)(ws + WS_PROJ); bf16_t* br = (bf16_t*)(ws + WS_BR);
    const float* cumf = (const float*)(ws + WS_CUMF); const float* av = (const float*)(ws + WS_AV); const float* pm = (const float*)(ws + WS_PM); const float* mseq = (const float*)(ws + WS_MSEQ);
    const int lane = F.lane, g = lane >> 4, li = lane & 15, w = F.wave;
    bf16x8 ones;
#pragma unroll
    for (int j = 0; j < 8; ++j) ones[j] = (short)0x3F80;
    u32x4 pq[2], pk[2], pvv[2]; float prv[4] = {0.f, 0.f, 0.f, 0.f};
#define CH_LOAD(it) do { const int _ty = (it) / (NBH * NCH), _bh = ((it) / NCH) % NBH, _c = (it) % NCH, _h = _bh & 3; const int _t0 = (_bh >> 2) * SEQ + _c * CH; \
        const bf16_t* _pr = proj + (size_t)(_t0 + (F.tid >> 3)) * NBR + (F.tid & 7) * 8 + _h * HD; \
        pq[0] = *(const u32x4*)(_pr + (_ty == 0 ? PC_MQ : PC_RQ)); pq[1] = *(const u32x4*)(_pr + (_ty == 0 ? PC_MQ : PC_RQ) + 64); \
        pk[0] = *(const u32x4*)(_pr + (_ty == 0 ? PC_MK : PC_RK)); pk[1] = *(const u32x4*)(_pr + (_ty == 0 ? PC_MK : PC_RK) + 64); \
        pvv[0] = *(const u32x4*)(_pr + (_ty == 0 ? PC_MV : PC_RV)); pvv[1] = *(const u32x4*)(_pr + (_ty == 0 ? PC_MV : PC_RV) + 64); \
        if (_ty == 0 && F.tid < 64) { const size_t _go = (size_t)_bh * SEQ + _c * CH + F.tid; prv[0] = av[_go]; prv[1] = pm[_go]; prv[2] = cumf[_go]; prv[3] = mseq[_bh * 80 + _c]; } } while (0)
    if (F.wg < 2 * NBH * NCH) CH_LOAD(F.wg);
    for (int item = F.wg; item < 2 * NBH * NCH; item += F.nwg) {
        const int type = item / (NBH * NCH), bh = (item / NCH) % NBH, c = item % NCH, b = bh >> 2, h = bh & 3;
        const int t0 = b * SEQ + c * CH; const size_t go = (size_t)bh * SEQ + c * CH;
        const float lg2 = ret_gamma_log2(h);
        const int vc = h * HD + 16 * w + 4 * g;
        u32x2 gate[4]; bf16x8 cfr[4]; f32x4 nr[4][2];
        const f32x4 nw4 = *(const f32x4*)((type == 0 ? ((const float*)a->in[IN_MNORM]) : ((const float*)a->in[IN_RNORM])) + l * W + vc);
#pragma unroll
        for (int tt = 0; tt < 4; ++tt) gate[tt] = *(const u32x2*)(proj + (size_t)(t0 + 16 * tt + li) * NBR + (type == 0 ? PC_MO : PC_RG) + vc);
        if (c > 0) { const bf16_t* cst = (const bf16_t*)(ws + WS_CST) + ((size_t)(type * NBH + bh) * NCH + c) * HD * HD; const float* nsv = (const float*)(ws + WS_NST) + ((size_t)bh * NCH + c) * HD;
#pragma unroll
            for (int kk = 0; kk < 4; ++kk) { cfr[kk] = *(const bf16x8*)(cst + (size_t)(16 * w + li) * HD + kk * 32 + g * 8);
                if (type == 0) { nr[kk][0] = *(const f32x4*)(nsv + kk * 32 + g * 8); nr[kk][1] = *(const f32x4*)(nsv + kk * 32 + g * 8 + 4); } } }
        { const int row = F.tid >> 3, oct = F.tid & 7;
          *(LAS u32x4*)(Qs + row * QS + oct * 8) = pq[0]; *(LAS u32x4*)(Qs + row * QS + 64 + oct * 8) = pq[1];
          *(LAS u32x4*)(Ks + row * QS + oct * 8) = pk[0]; *(LAS u32x4*)(Ks + row * QS + 64 + oct * 8) = pk[1];
          *(LAS u32x4*)(Vs + row * VS + oct * 8) = pvv[0]; *(LAS u32x4*)(Vs + row * VS + 64 + oct * 8) = pvv[1]; }
        if (F.tid < 64) { const int t = F.tid;
            if (type == 0) { const float mp = prv[3]; const float bt = fmaxf(mp, prv[1]); rv[t] = prv[0]; rv[64 + t] = bt; rv[128 + t] = __expf(mp - bt); rv[192 + t] = __expf(-prv[2] - bt); }
            else rv[128 + t] = exp2f((float)(t + 1) * lg2); }
        if (item + F.nwg < 2 * NBH * NCH) CH_LOAD(item + F.nwg);
        __syncthreads();
        { const int tt = w >> 1, t = 16 * tt + li;
#pragma unroll
          for (int sti = 0; sti < 2; ++sti) { const int st = (w & 1) * 2 + sti; f32x4 acc = {0.f, 0.f, 0.f, 0.f};
            if (st <= tt) {
#pragma unroll
                for (int kk = 0; kk < 4; ++kk) { const bf16x8 kf = *(const LAS bf16x8*)(Ks + (16 * st + li) * QS + kk * 32 + g * 8), qf = *(const LAS bf16x8*)(Qs + (16 * tt + li) * QS + kk * 32 + g * 8);
                    acc = __builtin_amdgcn_mfma_f32_16x16x32_bf16(kf, qf, acc, 0, 0, 0); }
#pragma unroll
                for (int r = 0; r < 4; ++r) { const int sx = 16 * st + 4 * g + r; float wgt;
                    if (type == 0) wgt = __expf(rv[sx] - rv[64 + t]); else wgt = exp2f((float)(t - sx) * lg2);
                    acc[r] = (sx <= t) ? acc[r] * wgt : 0.f; } }
            u32x2 pw; pw.x = pack2(acc[0], acc[1]); pw.y = pack2(acc[2], acc[3]); *(LAS u32x2*)(Ps + t * PS + 16 * st + 4 * g) = pw; } }
        __syncthreads();
        f32x4 pv[4], qc[4], dn[4], qn[4];
#pragma unroll
        for (int tt = 0; tt < 4; ++tt) { pv[tt] = (f32x4){0.f, 0.f, 0.f, 0.f}; qc[tt] = pv[tt]; dn[tt] = pv[tt]; qn[tt] = pv[tt]; }
#pragma unroll
        for (int u = 0; u < 2; ++u) {
            const bf16x8 vf = cat4(lds_tr(Vs + (32 * u + 8 * g + (li >> 2)) * VS + 16 * w + 4 * (li & 3)), lds_tr(Vs + (32 * u + 8 * g + 4 + (li >> 2)) * VS + 16 * w + 4 * (li & 3)));
#pragma unroll
            for (int tt = 0; tt < 4; ++tt) { const bf16x8 pf = *(const LAS bf16x8*)(Ps + (16 * tt + li) * PS + 32 * u + 8 * g);
                pv[tt] = __builtin_amdgcn_mfma_f32_16x16x32_bf16(vf, pf, pv[tt], 0, 0, 0);
                if (type == 0) dn[tt] = __builtin_amdgcn_mfma_f32_16x16x32_bf16(ones, pf, dn[tt], 0, 0, 0); } }
        if (c > 0) {
#pragma unroll
            for (int kk = 0; kk < 4; ++kk) { const bf16x8 cf = cfr[kk];
                bf16x8 nf = ones;
                if (type == 0) nf = pack8(nr[kk][0], nr[kk][1]);
#pragma unroll
                for (int tt = 0; tt < 4; ++tt) { const bf16x8 qf = *(const LAS bf16x8*)(Qs + (16 * tt + li) * QS + kk * 32 + g * 8);
                    qc[tt] = __builtin_amdgcn_mfma_f32_16x16x32_bf16(cf, qf, qc[tt], 0, 0, 0);
                    if (type == 0) qn[tt] = __builtin_amdgcn_mfma_f32_16x16x32_bf16(nf, qf, qn[tt], 0, 0, 0); } } }
#pragma unroll
        for (int tt = 0; tt < 4; ++tt) { const int t = 16 * tt + li; const float inter = rv[128 + t]; f32x4 hv;
            if (type == 0) { const float den = inter * qn[tt][0] + dn[tt][0]; const float rd = 1.0f / fmaxf(fabsf(den), rv[192 + t]);
                const u32x2 ow = gate[tt];
                const float o0 = __uint_as_float(ow.x << 16), o1 = __uint_as_float(ow.x & 0xffff0000u), o2 = __uint_as_float(ow.y << 16), o3 = __uint_as_float(ow.y & 0xffff0000u);
                hv[0] = sigmoidf_(o0) * (inter * qc[tt][0] + pv[tt][0]) * rd; hv[1] = sigmoidf_(o1) * (inter * qc[tt][1] + pv[tt][1]) * rd;
                hv[2] = sigmoidf_(o2) * (inter * qc[tt][2] + pv[tt][2]) * rd; hv[3] = sigmoidf_(o3) * (inter * qc[tt][3] + pv[tt][3]) * rd; }
            else hv = pv[tt] + qc[tt] * inter;
            pv[tt] = hv;
            float s1 = (hv[0] + hv[1]) + (hv[2] + hv[3]), s2 = (hv[0] * hv[0] + hv[1] * hv[1]) + (hv[2] * hv[2] + hv[3] * hv[3]);
            s1 += __shfl_xor(s1, 16); s1 += __shfl_xor(s1, 32); s2 += __shfl_xor(s2, 16); s2 += __shfl_xor(s2, 32);
            if (g == 0) { hp[(w * 64 + t) * 2] = s1; hp[(w * 64 + t) * 2 + 1] = s2; } }
        __syncthreads();
#pragma unroll
        for (int tt = 0; tt < 4; ++tt) { const int t = 16 * tt + li; float s1 = 0.f, s2 = 0.f;
#pragma unroll
            for (int ww = 0; ww < 8; ++ww) { const f32x2 p2 = *(const LAS f32x2*)(hp + (ww * 64 + t) * 2); s1 += p2.x; s2 += p2.y; }
            const float mu = s1 * (1.0f / 128.0f), var = fmaxf(s2 * (1.0f / 128.0f) - mu * mu, 0.f), rstd = rsqrtf(var + LN_EPS);
            f32x4 y = (pv[tt] - mu) * rstd * nw4;
            if (type == 1) { const u32x2 gw = gate[tt];
                const float g0 = __uint_as_float(gw.x << 16), g1 = __uint_as_float(gw.x & 0xffff0000u), g2 = __uint_as_float(gw.y << 16), g3 = __uint_as_float(gw.y & 0xffff0000u);
                y[0] *= g0 * sigmoidf_(g0); y[1] *= g1 * sigmoidf_(g1); y[2] *= g2 * sigmoidf_(g2); y[3] *= g3 * sigmoidf_(g3); }
            st_bf16x4(br + (size_t)(t0 + t) * D + (type == 0 ? 1024 : 1536) + vc, y); }
        __syncthreads();
    }
#undef CH_LOAD
}

__device__ __forceinline__ void ln_row(float (&v)[32], const float* lw, const float* lb, int lane) {
    float s = 0.f;
#pragma unroll
    for (int j = 0; j < 32; ++j) s += v[j];
    const float mu = wave_sum(s) * (1.0f / D); float q = 0.f;
#pragma unroll
    for (int j = 0; j < 32; ++j) { const float d = v[j] - mu; q += d * d; }
    const float rstd = rsqrtf(wave_sum(q) * (1.0f / D) + LN_EPS);
#pragma unroll
    for (int j = 0; j < 4; ++j)
#pragma unroll
        for (int h = 0; h < 2; ++h) { const f32x4 w4 = *(const f32x4*)(lw + j * 512 + lane * 8 + h * 4), b4 = *(const f32x4*)(lb + j * 512 + lane * 8 + h * 4);
#pragma unroll
            for (int e = 0; e < 4; ++e) v[j * 8 + h * 4 + e] = (v[j * 8 + h * 4 + e] - mu) * rstd * w4[e] + b4[e]; }
}
__device__ __forceinline__ void phase_ln(const Frame& F, const bf16_t* y, const float* lw, const float* lb, bf16_t* xb, unsigned char* xb8) {
    for (int row = F.wg * 8 + F.wave; row < T; row += F.nwg * 8) {
        float v[32]; ld_row32(y + (size_t)row * D, F.lane, v);
        ln_row(v, lw, lb, F.lane);
        st_row32(xb + (size_t)row * D, F.lane, v); st_row32_fp8(xb8 + (size_t)row * D, F.lane, v);
    }
}
__device__ __forceinline__ void split8(f32x4 a, f32x4 b, bf16x8& hi, bf16x8& lo) {
    union { u32x4 u; bf16x8 h; } H, L;
#pragma unroll
    for (int j = 0; j < 2; ++j) { const bf16_t h0 = f2bf(a[2 * j]), h1 = f2bf(a[2 * j + 1]); H.u[j] = (unsigned)h0 | ((unsigned)h1 << 16); L.u[j] = pack2(a[2 * j] - bf2f(h0), a[2 * j + 1] - bf2f(h1)); }
#pragma unroll
    for (int j = 0; j < 2; ++j) { const bf16_t h0 = f2bf(b[2 * j]), h1 = f2bf(b[2 * j + 1]); H.u[2 + j] = (unsigned)h0 | ((unsigned)h1 << 16); L.u[2 + j] = pack2(b[2 * j] - bf2f(h0), b[2 * j + 1] - bf2f(h1)); }
    hi = H.h; lo = L.h; }
__device__ __forceinline__ void phase_ln_router(const Frame& F, int l, const bf16_t* y, bf16_t* xb) {
    const KArgs a = F.ka;
    unsigned char* ws = F.ws_();
    constexpr int XS = D + 8, RB = 32;
    LAS bf16_t* xsh = (LAS bf16_t*)F.lds;
    LAS float* part = (LAS float*)F.lds;
    LAS int* lcnt = (LAS int*)(xsh + RB * XS);
    if (F.tid < 128) lcnt[F.tid] = 0;
    __syncthreads();
    const float* lw = ((const float*)a->in[IN_LNW]) + ((size_t)l * 3 + 1) * D; const float* lb = ((const float*)a->in[IN_LNB]) + ((size_t)l * 3 + 1) * D;
    const bf16_t* rwt = (const bf16_t*)(ws + WS_RWT) + (size_t)l * 2 * NE * D; const float* rb = ((const float*)a->in[IN_RB]) + l * NE;
    unsigned* counts = (unsigned*)(ws + WS_CTL) + CW_COUNTS + l * 64;
    int* eid = (int*)(ws + WS_EID); float* ew = (float*)(ws + WS_EW); int* epos = (int*)(ws + WS_EPOS);
    const int lane = F.lane, g = lane >> 4, li = lane & 15, nt = F.wave & 3, kh = F.wave >> 2;
    for (int blk = F.wg; blk < T / RB; blk += F.nwg) {
        for (int rr = 0; rr < 4; ++rr) {
            const int lr = F.wave * 4 + rr, row = blk * RB + lr;
            float v[32]; ld_row32(y + (size_t)row * D, F.lane, v);
            ln_row(v, lw, lb, F.lane);
            st_row32(xb + (size_t)row * D, F.lane, v); st_row32_fp8(ws + WS_XB8 + (size_t)row * D, F.lane, v);
#pragma unroll
            for (int j = 0; j < 4; ++j) { u32x4 hi;
#pragma unroll
                for (int e2 = 0; e2 < 4; ++e2) hi[e2] = pack2(v[j * 8 + 2 * e2], v[j * 8 + 2 * e2 + 1]);
                *(LAS u32x4*)(xsh + lr * XS + j * 512 + F.lane * 8) = hi; }
        }
        __syncthreads();
        f32x4 acc[2] = {{0.f, 0.f, 0.f, 0.f}, {0.f, 0.f, 0.f, 0.f}};
        { const bf16_t* wh = rwt + (size_t)(16 * nt + li) * D + kh * 1024 + g * 8; const bf16_t* wl = wh + (size_t)NE * D;
          const LAS bf16_t* xr = xsh + li * XS + kh * 1024 + g * 8;
#pragma unroll 8
          for (int ks = 0; ks < 32; ++ks) { const bf16x8 bh = *(const bf16x8*)(wh + ks * 32), bl = *(const bf16x8*)(wl + ks * 32);
#pragma unroll
              for (int mt = 0; mt < 2; ++mt) { const bf16x8 xh = *(const LAS bf16x8*)(xr + mt * 16 * XS + ks * 32);
                  acc[mt] = __builtin_amdgcn_mfma_f32_16x16x32_bf16(xh, bh, acc[mt], 0, 0, 0); acc[mt] = __builtin_amdgcn_mfma_f32_16x16x32_bf16(xh, bl, acc[mt], 0, 0, 0); } } }
        __syncthreads();
#pragma unroll
        for (int mt = 0; mt < 2; ++mt)
#pragma unroll
            for (int r = 0; r < 4; ++r) part[(kh * RB + 16 * mt + 4 * g + r) * 64 + 16 * nt + li] = acc[mt][r];
        __syncthreads();
        const int e = F.lane;
        const float bias = rb[e];
        for (int rr = 0; rr < 4; ++rr) {
            const int lr = F.wave * 4 + rr, row = blk * RB + lr;
            const float sc = sigmoidf_(part[lr * 64 + e] + part[(RB + lr) * 64 + e]), bs = sc + bias;
            float m1 = bs; m1 = fmaxf(m1, __shfl_xor(m1, 1)); m1 = fmaxf(m1, __shfl_xor(m1, 2)); m1 = fmaxf(m1, __shfl_xor(m1, 4));
            const unsigned long long eq = __ballot(bs == m1); const int gq = e >> 3; const unsigned gm = (unsigned)(eq >> (gq * 8)) & 0xffu; const int first = gq * 8 + __builtin_ctz(gm);
            float m2 = (e == first) ? -INFINITY : bs; m2 = fmaxf(m2, __shfl_xor(m2, 1)); m2 = fmaxf(m2, __shfl_xor(m2, 2)); m2 = fmaxf(m2, __shfl_xor(m2, 4));
            const float gs = m1 + m2;
            int grank = 0;
#pragma unroll
            for (int g2 = 0; g2 < 8; ++g2) { const float o = __shfl(gs, g2 * 8); grank += (o > gs || (o == gs && g2 < gq)) ? 1 : 0; }
            const bool gsel = grank < 4;
            const float val = gsel ? bs : -INFINITY;
            int rank = 0;
            for (int e2 = 0; e2 < 64; ++e2) { const float o = __shfl(val, e2); rank += (o > val || (o == val && e2 < e)) ? 1 : 0; }
            const bool sel = gsel && rank < TOPK;
            const float wsum = wave_sum(sel ? sc : 0.f);
            const unsigned long long sm = __ballot(sel);
            if (sel) { const int k = __builtin_popcountll(sm & ((1ull << e) - 1ull));
                const int pos = __hip_atomic_fetch_add((int*)lcnt + e, 1, __ATOMIC_RELAXED, __HIP_MEMORY_SCOPE_WORKGROUP);
                eid[(size_t)row * 8 + k] = e; ew[(size_t)row * 8 + k] = sc / wsum * ROUTE_SCALE; epos[(size_t)row * 8 + k] = pos; }
        }
        __syncthreads();
    }
    if (F.tid < 64) { const int n = lcnt[F.tid]; lcnt[64 + F.tid] = n > 0 ? (int)__hip_atomic_fetch_add(counts + F.tid, (unsigned)n, __ATOMIC_RELAXED, __HIP_MEMORY_SCOPE_AGENT) : 0; }
    asm volatile("s_waitcnt vmcnt(0)" ::: "memory");
    __syncthreads();
    for (int blk = F.wg; blk < T / RB; blk += F.nwg) { if (F.tid < RB * 8) { const size_t i = (size_t)blk * (RB * 8) + F.tid; epos[i] += lcnt[64 + eid[i]]; } }
    __syncthreads();
}
__device__ __forceinline__ void build_pstart(const Frame& F, int l, LAS int* pst) {
    const unsigned* counts = (const unsigned*)(F.ws_() + WS_CTL) + CW_COUNTS + l * 64;
    if (F.tid < 64) {
        const int c = (int)__hip_atomic_load(counts + F.tid, __ATOMIC_RELAXED, __HIP_MEMORY_SCOPE_AGENT); const int pc = (c + 255) & ~255; int inc = pc;
#pragma unroll
        for (int o = 1; o < 64; o <<= 1) { const int n = __shfl_up(inc, o); if (F.tid >= o) inc += n; }
        pst[F.tid] = inc - pc; if (F.tid == 63) { pst[NE] = inc; pst[NE + 1] = inc + T; } }
    __syncthreads();
    { LAS unsigned char* texp = (LAS unsigned char*)(pst + 68);
      for (int rt = F.tid; rt < (pst[NE + 1] >> 8); rt += NTHR) { int e = 0; while (e < NE && pst[e + 1] <= rt * 256) ++e; texp[rt] = (unsigned char)e; } }
    __syncthreads();
}
__device__ __forceinline__ void phase_slots(const Frame& F, int l) {
    unsigned char* ws = F.ws_();
    LAS int* pst = (LAS int*)F.lds;
    build_pstart(F, l, pst);
    const unsigned* counts = (const unsigned*)(ws + WS_CTL) + CW_COUNTS + l * 64;
    const int* eid = (const int*)(ws + WS_EID); const float* ew = (const float*)(ws + WS_EW); const int* epos = (const int*)(ws + WS_EPOS);
    int* slotof = (int*)(ws + WS_SLOTOF); int* tok = (int*)(ws + WS_TOK); float* wsl = (float*)(ws + WS_WSL);
    const size_t gtid = (size_t)F.wg * NTHR + F.tid, gn = (size_t)F.nwg * NTHR;
    for (size_t i = gtid; i < (size_t)T * 8; i += gn) { const int e = eid[i]; const int slot = pst[e] + epos[i]; slotof[i] = slot; tok[slot] = (int)(i >> 3); wsl[slot] = ew[i]; }
    for (size_t i = gtid; i < (size_t)NE * 256; i += gn) { const int e = (int)(i >> 8), r = (int)(i & 255); const int c = (int)counts[e]; const int slot = pst[e] + c + r; if (slot < pst[e + 1]) { tok[slot] = 0; wsl[slot] = 0.f; } }
    for (size_t i = gtid; i < (size_t)T; i += gn) { tok[pst[NE] + i] = (int)i; wsl[pst[NE] + i] = 1.0f; }
    __syncthreads();
}
__device__ __forceinline__ void phase_combine_ln(const Frame& F, int l, bf16_t* xb, float* out) {
    const KArgs a = F.ka;
    unsigned char* ws = F.ws_();
    LAS int* pst = (LAS int*)F.lds;
    build_pstart(F, l, pst);
    const int sh0 = pst[NE];
    const int* slotof = (const int*)(ws + WS_SLOTOF); const unsigned char* yb = ws + WS_YB;
    const float* lw = ((const float*)a->in[IN_LNW]) + ((size_t)l * 3 + 2) * D; const float* lb = ((const float*)a->in[IN_LNB]) + ((size_t)l * 3 + 2) * D;
    for (int row = F.wg * 8 + F.wave; row < T; row += F.nwg * 8) {
        float v[32]; ld_row32(xb + (size_t)row * D, F.lane, v);
#pragma unroll
        for (int j = 0; j < 32; ++j) v[j] *= ALPHA;
        float ys[32];
#pragma unroll
        for (int j = 0; j < 32; ++j) ys[j] = 0.f;
#pragma unroll 3
        for (int k = 0; k < 9; ++k) { const int slot = k < 8 ? slotof[(size_t)row * 8 + k] : sh0 + row; const unsigned char* yr = yb + (size_t)slot * D;
#pragma unroll
            for (int j = 0; j < 4; ++j) { const u32x2 w = *(const u32x2*)(yr + j * 512 + F.lane * 8);
                const f32x2 p0 = __builtin_amdgcn_cvt_pk_f32_fp8((int)w.x, false), p1 = __builtin_amdgcn_cvt_pk_f32_fp8((int)w.x, true), p2 = __builtin_amdgcn_cvt_pk_f32_fp8((int)w.y, false), p3 = __builtin_amdgcn_cvt_pk_f32_fp8((int)w.y, true);
                ys[j * 8] += p0.x; ys[j * 8 + 1] += p0.y; ys[j * 8 + 2] += p1.x; ys[j * 8 + 3] += p1.y; ys[j * 8 + 4] += p2.x; ys[j * 8 + 5] += p2.y; ys[j * 8 + 6] += p3.x; ys[j * 8 + 7] += p3.y; } }
#pragma unroll
        for (int j = 0; j < 32; ++j) v[j] += ys[j] * (1.0f / Y8_SCALE);
        ln_row(v, lw, lb, F.lane);
        if (out) {
#pragma unroll
            for (int j = 0; j < 4; ++j) { *(f32x4*)(out + (size_t)row * D + j * 512 + F.lane * 8) = (f32x4){v[j * 8], v[j * 8 + 1], v[j * 8 + 2], v[j * 8 + 3]}; *(f32x4*)(out + (size_t)row * D + j * 512 + F.lane * 8 + 4) = (f32x4){v[j * 8 + 4], v[j * 8 + 5], v[j * 8 + 6], v[j * 8 + 7]}; }
        } else { st_row32(xb + (size_t)row * D, F.lane, v); st_row32_fp8(ws + WS_XB8 + (size_t)row * D, F.lane, v); st_row32_i8(ws + WS_XQ8 + (size_t)row * D, (float*)(ws + WS_XSC) + row, F.lane, v); }
    }
    __syncthreads();
}

__device__ __forceinline__ void phase_attn_mfma(const Frame& F, int l) {
    unsigned char* ws = F.ws_();
    constexpr int KS = 136, VS = 144;
    LAS bf16_t* Ks = (LAS bf16_t*)F.lds; LAS bf16_t* Vs = Ks + 256 * KS;
    const bf16_t* q = (const bf16_t*)(ws + WS_Q); const bf16_t* km = (const bf16_t*)(ws + WS_KM) + (size_t)l * TM * W; const bf16_t* vm = (const bf16_t*)(ws + WS_VM) + (size_t)l * TM * W;
    unsigned char* o = ws + WS_O;
    const int nunit = (T / 128) * 4, upw = (nunit + F.nwg - 1) / F.nwg;
    const int lane = F.lane, g = lane >> 4, li = lane & 15;
    int loaded = -1;
    const int u_end = (F.wg + 1) * upw < nunit ? (F.wg + 1) * upw : nunit;
    for (int u = F.wg * upw; u < u_end; ++u) {
        const int bh = u >> 5, blk = u & 31, b = bh >> 2, hh = bh & 3;
        if (bh != loaded) {
            __syncthreads();
            const int m = F.tid >> 1, half = F.tid & 1;
            const bf16_t* kr = km + (size_t)(b * MEM + m) * W + hh * HD + half * 64; const bf16_t* vr = vm + (size_t)(b * MEM + m) * W + hh * HD + half * 64;
#pragma unroll
            for (int j = 0; j < 8; ++j) { *(LAS u32x4*)(Ks + m * KS + half * 64 + j * 8) = *(const u32x4*)(kr + j * 8); *(LAS u32x4*)(Vs + m * VS + half * 64 + j * 8) = *(const u32x4*)(vr + j * 8); }
            __syncthreads(); loaded = bh;
        }
        const int t0 = b * SEQ + blk * 128 + F.wave * 16;
        bf16x8 qf[4];
#pragma unroll
        for (int kk = 0; kk < 4; ++kk) qf[kk] = *(const bf16x8*)(q + (size_t)(t0 + li) * W + hh * HD + kk * 32 + g * 8);
        f32x4 sacc[16];
#pragma unroll
        for (int tt = 0; tt < 16; ++tt) { f32x4 acc = {0.f, 0.f, 0.f, 0.f};
#pragma unroll
            for (int kk = 0; kk < 4; ++kk) { const bf16x8 kf = *(const LAS bf16x8*)(Ks + (16 * tt + li) * KS + kk * 32 + g * 8); acc = __builtin_amdgcn_mfma_f32_16x16x32_bf16(kf, qf[kk], acc, 0, 0, 0); }
            sacc[tt] = acc; }
        float mx = -INFINITY;
#pragma unroll
        for (int tt = 0; tt < 16; ++tt) mx = fmaxf(mx, fmaxf(fmaxf(sacc[tt][0], sacc[tt][1]), fmaxf(sacc[tt][2], sacc[tt][3])));
        mx = fmaxf(mx, __shfl_xor(mx, 16)); mx = fmaxf(mx, __shfl_xor(mx, 32));
        const float c2 = 0.08838834764831845f * 1.4426950408889634f; float sum = 0.f;
#pragma unroll
        for (int tt = 0; tt < 16; ++tt)
#pragma unroll
            for (int r = 0; r < 4; ++r) { const float p = exp2f((sacc[tt][r] - mx) * c2); sacc[tt][r] = p; sum += p; }
        sum += __shfl_xor(sum, 16); sum += __shfl_xor(sum, 32);
        const float rs = 1.0f / sum;
        bf16x8 pk[8];
#pragma unroll
        for (int u8 = 0; u8 < 8; ++u8) pk[u8] = pack8(sacc[2 * u8], sacc[2 * u8 + 1]);
#pragma unroll
        for (int dvt = 0; dvt < 8; ++dvt) { f32x4 acc = {0.f, 0.f, 0.f, 0.f};
#pragma unroll
            for (int u8 = 0; u8 < 8; ++u8) { const s16x4 a0 = lds_tr(Vs + (32 * u8 + 4 * g + (li >> 2)) * VS + dvt * 16 + 4 * (li & 3)); const s16x4 a1 = lds_tr(Vs + (32 * u8 + 16 + 4 * g + (li >> 2)) * VS + dvt * 16 + 4 * (li & 3));
                acc = __builtin_amdgcn_mfma_f32_16x16x32_bf16(cat4(a0, a1), pk[u8], acc, 0, 0, 0); }
            { const f32x4 ov = acc * (rs * O8_SCALE); *(unsigned*)(o + (size_t)(t0 + li) * W + hh * HD + dvt * 16 + 4 * g) = pack_fp8x4(ov[0], ov[1], ov[2], ov[3]); } }
    }
    __syncthreads();
}

template <class Epi>
__device__ __forceinline__ void gemm_dense_mfma(const Frame& F, const bf16_t* A, const bf16_t* Bt, int M, int N, int K, const Epi& E) {
    DenseSched S; S.A = A; S.Bt = Bt; S.K = K; S.nM = M / 256; S.nN = N / 256; S.nwg = S.nM * S.nN; S.G = F.nwg; S.c = F.wg; S.i0 = 0; S.i1 = 1 << 30; S.pnoff = 0;
    gemm_phase_mfma(F, K, S, E);
}
constexpr int NPL = 15, NPHASE = 1 + DEPTH * NPL;
#ifndef NCONV
#define NCONV 40
#endif
#if MK_PER_PHASE
#define IN(k) (lo <= (k) && (k) < hi)
#define SEAM(k) do { if (IN((k) + 1)) { XcdBarrier b2_ = bar; asm volatile("" : "+s"(b2_.bar)); asm volatile("" : "+s"(b2_.x)); xcd_barrier(b2_); } } while (0)
#else
#define IN(k) true
#define SEAM(k) do { if ((k) + 1 < NPHASE) for (int rb_ = 0; rb_ < ((PROBE_DBL & 4096) ? 3 : 1); ++rb_) { XcdBarrier b2_ = bar; asm volatile("" : "+s"(b2_.bar)); asm volatile("" : "+s"(b2_.x)); xcd_barrier(b2_); } } while (0)
#endif
template <int l> __device__ __forceinline__ void run_layer(const Frame& F0, const XcdBarrier& bar, int lo, int hi) {
    const int pb = 1 + l * NPL;
    if (IN(pb + 0)) { const Frame F = fresh(F0); unsigned char* ws = F.ws_();
        EpiProj E{(bf16_t*)(ws + WS_PROJ), (bf16_t*)(ws + WS_GATES)};
        { DenseSched S; S.A = (const bf16_t*)(ws + WS_XQ8); S.Bt = (const bf16_t*)(ws + WS_WINQ + l * SZ_WINQ); S.K = D / 2; S.nM = T / 256; S.nN = NBR / 256; S.nwg = S.nM * S.nN; S.G = F.nwg; S.c = F.wg; S.i0 = 0; S.i1 = 1 << 30; S.pnoff = 0;
          const float wsc = __uint_as_float(((const unsigned*)(ws + WS_CTL))[CW_WABS + l]) * (1.0f / 127.0f);
          gemm_phase_mfma<EpiProj, DenseSched, 2>(F, D, S, E, wsc, (const float*)(ws + WS_XSC)); }
        { const Frame F2 = fresh(F0); unsigned char* ws2 = F2.ws_(); EpiProj E2{(bf16_t*)(ws2 + WS_PROJ), (bf16_t*)(ws2 + WS_GATES)};
          DenseSched S; S.A = (const bf16_t*)(ws2 + WS_XB8); S.Bt = (const bf16_t*)(ws2 + WS_WIN8 + l * SZ_WIN8 + (size_t)NBR * D); S.K = D / 2; S.nM = T / 256; S.nN = (NPROJ - NBR) / 256; S.nwg = S.nM * S.nN; S.G = F2.nwg; S.c = F2.wg; S.i0 = 0; S.i1 = 1 << 30; S.pnoff = NBR / 256;
          gemm_phase_mfma<EpiProj, DenseSched, 1>(F2, D, S, E2, 1.0f / (X8_SCALE * W8_SCALE)); if (PROBE_DBL & 64) gemm_phase_mfma<EpiProj, DenseSched, 1>(F2, D, S, E2, 1.0f / (X8_SCALE * W8_SCALE)); }
        SEAM(pb + 0); }
    if (IN(pb + 1)) { const Frame F = fresh(F0); phase_mix1v2(F, l, (const bf16_t*)(F.ws_() + WS_XB)); if (PROBE_DBL & 8192) { const Frame G = fresh(F0); phase_mix1v2<false>(G, l, (const bf16_t*)(G.ws_() + WS_XB)); } SEAM(pb + 1); }
    if (IN(pb + 2)) { const Frame F = fresh(F0); phase_scan_mfma(F); if (PROBE_DBL & 2) { const Frame G = fresh(F0); phase_scan_mfma(G); } SEAM(pb + 2); }
    if (IN(pb + 3)) { const Frame F = fresh(F0); phase_chunk_mfma(F, l); if (PROBE_DBL & 4) { const Frame G = fresh(F0); phase_chunk_mfma(G, l); } SEAM(pb + 3); }
    if (IN(pb + 4)) { const Frame F = fresh(F0); unsigned char* ws = F.ws_();
        EpiBranch E{ws + WS_GATES, ws + WS_MRG}; gemm_dense_mfma(F, (const bf16_t*)(ws + WS_BR), (const bf16_t*)(ws + WS_WB + l * SZ_DD), T, D, D, E); SEAM(pb + 4); }
    if (IN(pb + 5)) { const Frame F = fresh(F0); unsigned char* ws = F.ws_();
        EpiResid E{(const bf16_t*)(ws + WS_XB), (bf16_t*)(ws + WS_Y)};
        DenseSched S; S.A = (const bf16_t*)(ws + WS_MRG); S.Bt = (const bf16_t*)(ws + WS_WOUT + l * SZ_DD); S.K = D / 2; S.nM = T / 256; S.nN = D / 256; S.nwg = S.nM * S.nN; S.G = F.nwg; S.c = F.wg; S.i0 = 0; S.i1 = 1 << 30; S.pnoff = 0;
        gemm_phase_mfma<EpiResid, DenseSched, 1>(F, D, S, E, 1.0f / (X8_SCALE * W8_SCALE)); SEAM(pb + 5); }
    if (IN(pb + 6)) { const Frame F = fresh(F0); unsigned char* ws = F.ws_();
        phase_ln(F, (const bf16_t*)(ws + WS_Y), ((const float*)F.ka->in[IN_LNW]) + (size_t)l * 3 * D, ((const float*)F.ka->in[IN_LNB]) + (size_t)l * 3 * D, (bf16_t*)(ws + WS_XB), ws + WS_XB8); SEAM(pb + 6); }
    if (IN(pb + 7)) { const Frame F = fresh(F0);
        EpiQKV E{}; QkvSched S; S.ws = F.ws_(); S.l = l; S.G = F.nwg; S.c = F.wg; gemm_phase_mfma<EpiQKV, QkvSched, 1>(F, D, S, E, 1.0f / (X8_SCALE * W8_SCALE)); SEAM(pb + 7); }
    if (IN(pb + 8)) { const Frame F = fresh(F0); phase_attn_mfma(F, l); if (PROBE_DBL & 8) { const Frame G = fresh(F0); phase_attn_mfma(G, l); } SEAM(pb + 8); }
    if (IN(pb + 9)) { const Frame F = fresh(F0); unsigned char* ws = F.ws_();
        EpiResid E{(const bf16_t*)(ws + WS_XB), (bf16_t*)(ws + WS_Y)};
        DenseSched S; S.A = (const bf16_t*)(ws + WS_O); S.Bt = (const bf16_t*)(ws + WS_WO + l * SZ_WQ); S.K = W / 2; S.nM = T / 256; S.nN = D / 256; S.nwg = S.nM * S.nN; S.G = F.nwg; S.c = F.wg; S.i0 = 0; S.i1 = 1 << 30; S.pnoff = 0;
        gemm_phase_mfma<EpiResid, DenseSched, 1>(F, W, S, E, 1.0f / (O8_SCALE * W8_SCALE)); SEAM(pb + 9); }
    if (IN(pb + 10)) { const Frame F = fresh(F0); unsigned char* ws = F.ws_(); phase_ln_router(F, l, (const bf16_t*)(ws + WS_Y), (bf16_t*)(ws + WS_XB)); SEAM(pb + 10); }
    if (IN(pb + 11)) { const Frame F = fresh(F0); phase_slots(F, l); if (PROBE_DBL & 16) { const Frame G = fresh(F0); phase_slots(G, l); } SEAM(pb + 11); }
    if (IN(pb + 12)) { const Frame F = fresh(F0); unsigned char* ws = F.ws_();
        LAS int* pst = (LAS int*)(F.lds + LDS_BYTES - 1024); build_pstart(F, l, pst);
        const int nrt = pst[NE + 1] >> 8; EpiSwiglu E{(const float*)(ws + WS_WSL), ws + WS_HB};
        MoeSched<4, true> S; S.ws = ws; S.pst = pst; S.l = l; S.G = F.nwg; S.c = F.wg; S.nunits = nrt * 4; gemm_phase_mfma<EpiSwiglu, MoeSched<4, true>, 1>(F, D, S, E, 1.0f / (X8_SCALE * W8_SCALE)); SEAM(pb + 12); }
    if (IN(pb + 13)) { const Frame F = fresh(F0); unsigned char* ws = F.ws_();
        LAS int* pst = (LAS int*)(F.lds + LDS_BYTES - 1024); build_pstart(F, l, pst);
        const int nrt = pst[NE + 1] >> 8; EpiDown E{ws + WS_YB};
        MoeSched<8, false> S; S.ws = ws; S.pst = pst; S.l = l; S.G = F.nwg; S.c = F.wg; S.nunits = nrt * 8; gemm_phase_mfma<EpiDown, MoeSched<8, false>, 1>(F, ED, S, E, Y8_SCALE / (H8_SCALE * W8_SCALE)); SEAM(pb + 13); }
    if (IN(pb + 14)) { const Frame F = fresh(F0); phase_combine_ln(F, l, (bf16_t*)(F.ws_() + WS_XB), l == DEPTH - 1 ? ((float*)F.ka->out) : (float*)nullptr); if ((PROBE_DBL & 16384) && l == DEPTH - 1) { const Frame G = fresh(F0); phase_combine_ln(G, l, (bf16_t*)(G.ws_() + WS_XB), ((float*)G.ka->out)); } SEAM(pb + 14); }
}

__global__ void __launch_bounds__(NTHR, 2) fwd(Args args_unused) {
    extern __shared__ __attribute__((aligned(16))) unsigned char lds_raw[];
    Frame F0; F0.lds = (LAS unsigned char*)lds_raw; F0.tid = threadIdx.x; F0.lane = F0.tid & 63; F0.wave = __builtin_amdgcn_readfirstlane(F0.tid >> 6); F0.wg = blockIdx.x; F0.nwg = gridDim.x;
    F0.ka = (KArgs)__builtin_amdgcn_kernarg_segment_ptr(); F0.wsg = F0.ka->ws;
    volatile LAS unsigned* xbw = (volatile LAS unsigned*)(F0.lds + LDS_BYTES - 16);
    if (F0.tid == 0) { xbw[0] = 0u; xbw[1] = 0u; }
    __syncthreads();
    XcdBarrier bar; bar.bar = (unsigned*)(F0.ws_() + WS_CTL); bar.x = 0; bar.st = xbw;
#if MK_PER_PHASE
    const int lo = F0.ka->ph_lo, hi = F0.ka->ph_hi;
    if (hi - lo > 1) bar = xcd_barrier_post((unsigned*)(F0.ws_() + WS_CTL), xbw);
#else
    const int lo = 0, hi = NPHASE;
    bar = xcd_barrier_post((unsigned*)(F0.ws_() + WS_CTL), xbw);
#endif
    if (IN(0)) { { const Frame F = fresh(F0); phase_wabs(F); } { XcdBarrier b2_ = bar; asm volatile("" : "+s"(b2_.bar)); asm volatile("" : "+s"(b2_.x)); xcd_barrier(b2_); }
        const Frame F = fresh(F0); phase_prologue(F); { const Frame G = fresh(F0); prologue_deferred(G, G.wg, G.nwg); } SEAM(0); }
    run_layer<0>(F0, bar, lo, hi);
    run_layer<1>(F0, bar, lo, hi);
#undef IN
#undef SEAM
}

extern "C" void kernel_launch(void* const* d_in, const int* in_sizes, int n_in, void* d_out, int out_size, void* d_ws, size_t ws_size, hipStream_t stream) {
    static int grid = 0;
    if (grid == 0) {
        if (n_in != 23 || ws_size < WS_END) { fprintf(stderr, "kernel_launch: unexpected inputs (n_in %d, ws %zu < %zu)\n", n_in, ws_size, (size_t)WS_END); grid = -1; return; }
        int dev = 0, cus = 0, per_cu = 0;
        if (hipGetDevice(&dev) != hipSuccess || hipDeviceGetAttribute(&cus, hipDeviceAttributeMultiprocessorCount, dev) != hipSuccess) { grid = -1; return; }
        if (hipFuncSetAttribute((const void*)fwd, hipFuncAttributeMaxDynamicSharedMemorySize, LDS_BYTES) != hipSuccess) { fprintf(stderr, "kernel_launch: hipFuncSetAttribute failed\n"); grid = -1; return; }
        if (hipOccupancyMaxActiveBlocksPerMultiprocessor(&per_cu, (const void*)fwd, NTHR, LDS_BYTES) != hipSuccess || per_cu < 1) { fprintf(stderr, "kernel_launch: occupancy query says %d\n", per_cu); }
        (void)hipGetLastError();
        grid = cus;
    }
    if (grid < 0) return;
    (void)hipMemsetAsync((char*)d_ws + WS_CTL, 0, CTL_BYTES, stream);
    Args a{};
    for (int i = 0; i < 23; ++i) a.in[i] = (const float*)d_in[i];
    a.out = (float*)d_out; a.ws = (unsigned char*)d_ws;
#if MK_PER_PHASE
    for (int p = 0; p < NPHASE; ++p) { a.ph_lo = p; a.ph_hi = p + 1; hipLaunchKernelGGL(fwd, dim3(grid), dim3(NTHR), LDS_BYTES, stream, a); }
#else
    a.ph_lo = 0; a.ph_hi = NPHASE;
    hipLaunchKernelGGL(fwd, dim3(grid), dim3(NTHR), LDS_BYTES, stream, a);
#endif
    const hipError_t le = hipPeekAtLastError();
    if (le != hipSuccess) fprintf(stderr, "kernel_launch: launch failed: %s\n", hipGetErrorName(le));
}
```

```cpp
#include <hip/hip_runtime.h>
#include <cstdio>
#include <cstdint>

#ifndef PROBE_DBL
#define PROBE_DBL 0
#endif
#ifndef MK_PER_PHASE
#define MK_PER_PHASE 0
#endif

typedef unsigned short bf16_t;
typedef float f32x4 __attribute__((ext_vector_type(4)));
typedef float f32x2 __attribute__((ext_vector_type(2)));
typedef unsigned u32x4 __attribute__((ext_vector_type(4)));
typedef unsigned u32x2 __attribute__((ext_vector_type(2)));
#define LAS __attribute__((address_space(3)))

constexpr int BATCH = 4, SEQ = 4096, T = BATCH * SEQ, D = 2048, DEPTH = 2;
constexpr int W = 512, NH = 4, HD = 128, CH = 64, NCH = SEQ / CH, NBH = BATCH * NH;
constexpr int PROJ_W = 14344, NBR = 6144, NPROJ = 14336;
constexpr int MEM = 256, TM = BATCH * MEM;
constexpr int NE = 64, NEX = 65, TOPK = 8, ED = 512;
constexpr int NSLOT = 164096;
constexpr float LN_EPS = 1e-5f, ALPHA = 1.41421356237f, ROUTE_SCALE = 2.5f;
constexpr int NTHR = 512;

constexpr int PC_U = 0, PC_CH = 512, PC_CB = 1024, PC_CC = 1536, PC_MQ = 2048, PC_MK = 2560, PC_MV = 3072, PC_MO = 3584, PC_RQ = 4096, PC_RK = 4608, PC_RV = 5120, PC_RG = 5632;

constexpr size_t al256(size_t x) { return (x + 255) & ~(size_t)255; }
constexpr size_t WS_CTL = 0;
constexpr size_t CTL_BYTES = 65536;
constexpr int CW_COUNTS = 8192, CW_CSTRIDE = 32;
constexpr size_t WS_WIN = WS_CTL + CTL_BYTES;
constexpr size_t SZ_WIN = (size_t)NPROJ * D * 2;
constexpr size_t WS_WIF = WS_WIN + DEPTH * SZ_WIN;
constexpr size_t SZ_WIF = 8 * D * 4;
constexpr size_t WS_WB = WS_WIF + DEPTH * SZ_WIF;
constexpr size_t SZ_DD = (size_t)D * D * 2;
constexpr size_t WS_WOUT = WS_WB + DEPTH * SZ_DD;
constexpr size_t WS_WQ = WS_WOUT + DEPTH * SZ_DD;
constexpr size_t SZ_WQ = (size_t)W * D * 2;
constexpr size_t WS_WK = WS_WQ + DEPTH * SZ_WQ;
constexpr size_t WS_WV = WS_WK + DEPTH * SZ_WQ;
constexpr size_t WS_WO = WS_WV + DEPTH * SZ_WQ;
constexpr size_t WS_WGU = WS_WO + DEPTH * SZ_WQ;
constexpr size_t SZ_WGU1 = (size_t)1024 * D * 2;
constexpr size_t WS_WDN = WS_WGU + (size_t)DEPTH * NEX * SZ_WGU1;
constexpr size_t SZ_WDN1 = (size_t)D * ED * 2;
constexpr size_t WS_ROPE = WS_WDN + (size_t)DEPTH * NEX * SZ_WDN1;
constexpr size_t WS_X = WS_ROPE + (size_t)SEQ * 64 * 4 * 2;
constexpr size_t SZ_TD4 = (size_t)T * D * 4;
constexpr size_t WS_Y = WS_X + SZ_TD4;
constexpr size_t WS_XB = WS_Y + SZ_TD4;
constexpr size_t SZ_TD2 = (size_t)T * D * 2;
constexpr size_t WS_MEMB = WS_XB + SZ_TD2;
constexpr size_t WS_KM = WS_MEMB + (size_t)TM * D * 2;
constexpr size_t WS_VM = WS_KM + (size_t)DEPTH * TM * W * 2;
constexpr size_t WS_PROJ = WS_VM + (size_t)DEPTH * TM * W * 2;
constexpr size_t WS_GATES = WS_PROJ + (size_t)T * NBR * 2;
constexpr size_t WS_CUMF = WS_GATES + (size_t)T * 8192 * 2;
constexpr size_t WS_IPRE = WS_CUMF + (size_t)NBH * SEQ * 4;
constexpr size_t WS_SUMM = WS_IPRE + (size_t)NBH * SEQ * 4;
constexpr size_t WS_CST = WS_SUMM + al256((size_t)NBH * NCH * 2 * 4);
constexpr size_t WS_NST = WS_CST + (size_t)2 * NBH * NCH * HD * HD * 2;
constexpr size_t WS_BR = WS_NST + (size_t)NBH * NCH * HD * 4;
constexpr size_t WS_MRG = WS_BR + SZ_TD2;
constexpr size_t WS_Q = WS_MRG + SZ_TD2;
constexpr size_t WS_O = WS_Q + (size_t)T * W * 2;
constexpr size_t WS_EID = WS_O + (size_t)T * W * 2;
constexpr size_t WS_EW = WS_EID + (size_t)T * 8 * 4;
constexpr size_t WS_EPOS = WS_EW + (size_t)T * 8 * 4;
constexpr size_t WS_SLOTOF = WS_EPOS + (size_t)T * 8 * 4;
constexpr size_t WS_TOK = WS_SLOTOF + (size_t)T * 8 * 4;
constexpr size_t WS_WSL = WS_TOK + al256((size_t)NSLOT * 4);
constexpr size_t WS_HB = WS_WSL + al256((size_t)NSLOT * 4);
constexpr size_t WS_YB = WS_HB + (size_t)NSLOT * ED * 2;
constexpr size_t WS_AV = WS_YB + (size_t)NSLOT * D * 2;
constexpr size_t WS_PM = WS_AV + (size_t)NBH * SEQ * 4;
constexpr size_t WS_MSEQ = WS_PM + (size_t)NBH * SEQ * 4;
constexpr size_t WS_XB8 = WS_MSEQ + al256((size_t)NBH * 80 * 4);
constexpr size_t WS_WGU8 = WS_XB8 + (size_t)T * D;
constexpr size_t SZ_WGU8 = (size_t)1024 * D;
constexpr size_t WS_WIN8 = WS_WGU8 + (size_t)DEPTH * NEX * SZ_WGU8;
constexpr size_t SZ_WIN8 = (size_t)NPROJ * D;
constexpr size_t WS_RWT = WS_WIN8 + DEPTH * SZ_WIN8;
constexpr size_t WS_XQ8 = WS_RWT + (size_t)DEPTH * 2 * NE * D * 2;
constexpr size_t WS_XSC = WS_XQ8 + (size_t)T * D;
constexpr size_t WS_WINQ = WS_XSC + al256((size_t)T * 4);
constexpr size_t SZ_WINQ = (size_t)NBR * D;
constexpr size_t WS_WIFB = WS_WINQ + DEPTH * SZ_WINQ;
constexpr size_t WS_MEMB8 = WS_WIFB + (size_t)DEPTH * 2 * 16 * D * 2;
constexpr size_t WS_TOKL = WS_MEMB8 + (size_t)TM * D;
constexpr size_t WS_WL = WS_TOKL + (size_t)NE * T * 4;
constexpr size_t WS_END = WS_WL + (size_t)NE * T * 4 + 4096;
constexpr int CW_WABS = 12800;
constexpr float O8_SCALE = 32.0f;
constexpr float X8_SCALE = 16.0f, W8_SCALE = 256.0f, H8_SCALE = 8.0f, Y8_SCALE = 64.0f;

constexpr int LDS_BYTES = 147456;

__device__ __forceinline__ bf16_t f2bf(float f) { unsigned u = __float_as_uint(f); u += 0x7FFFu + ((u >> 16) & 1u); return (bf16_t)(u >> 16); }
__device__ __forceinline__ float bf2f(bf16_t b) { return __uint_as_float(((unsigned)b) << 16); }
__device__ __forceinline__ unsigned pack2(float lo, float hi) { unsigned r; asm("v_cvt_pk_bf16_f32 %0, %1, %2" : "=v"(r) : "v"(lo), "v"(hi)); return r; }
__device__ __forceinline__ float sigmoidf_(float x) { return __builtin_amdgcn_rcpf(1.0f + __builtin_amdgcn_exp2f(-1.4426950408889634f * x)); }
__device__ __forceinline__ unsigned pack_fp8x4(float a, float b, float c, float d) {
    int w = 0; w = __builtin_amdgcn_cvt_pk_fp8_f32(a, b, w, false); w = __builtin_amdgcn_cvt_pk_fp8_f32(c, d, w, true); return (unsigned)w; }
__device__ __forceinline__ u32x2 pack_fp8x8s(const float (&o)[8], float sc) { u32x2 w; w.x = pack_fp8x4(o[0] * sc, o[1] * sc, o[2] * sc, o[3] * sc); w.y = pack_fp8x4(o[4] * sc, o[5] * sc, o[6] * sc, o[7] * sc); return w; }
__device__ __forceinline__ unsigned pack_i8x4(float a, float b, float c, float d) {
    const int ia = (int)__builtin_amdgcn_fmed3f(rintf(a), -127.f, 127.f), ib = (int)__builtin_amdgcn_fmed3f(rintf(b), -127.f, 127.f), ic = (int)__builtin_amdgcn_fmed3f(rintf(c), -127.f, 127.f), id = (int)__builtin_amdgcn_fmed3f(rintf(d), -127.f, 127.f);
    return (unsigned)(ia & 255) | ((unsigned)(ib & 255) << 8) | ((unsigned)(ic & 255) << 16) | ((unsigned)(id & 255) << 24); }
__device__ __forceinline__ unsigned pack_u8x4(float a, float b, float c, float d) {
    return (unsigned)rintf(a) | ((unsigned)rintf(b) << 8) | ((unsigned)rintf(c) << 16) | ((unsigned)rintf(d) << 24); }
__device__ __forceinline__ void un8u(u32x2 w, f32x4& a, f32x4& b) { a[0] = (float)(w.x & 255u); a[1] = (float)((w.x >> 8) & 255u); a[2] = (float)((w.x >> 16) & 255u); a[3] = (float)(w.x >> 24);
    b[0] = (float)(w.y & 255u); b[1] = (float)((w.y >> 8) & 255u); b[2] = (float)((w.y >> 16) & 255u); b[3] = (float)(w.y >> 24); }
__device__ __forceinline__ float wave_sum(float v) { for (int o = 32; o >= 1; o >>= 1) v += __shfl_xor(v, o); return v; }
__device__ __forceinline__ float wave_max(float v) { for (int o = 32; o >= 1; o >>= 1) v = fmaxf(v, __shfl_xor(v, o)); return v; }

#define XB_TMO      128
#define XB_XCNT(j)  (256  + 64 * (j))
#define XB_XSUB(j)  (1280 + 64 * (j))
#define XB_XGEN(j)  (2304 + 64 * (j))
#define XB_TOP      3328
#define XB_TOPGEN   3392
#define XCD_BAR_WORDS 3456
#define XB_SPIN_CAP (1u << 27)
__device__ __forceinline__ unsigned xb_ld(unsigned* p)              { return __hip_atomic_load(p, __ATOMIC_RELAXED, __HIP_MEMORY_SCOPE_AGENT); }
__device__ __forceinline__ unsigned xb_add(unsigned* p, unsigned v) { return __hip_atomic_fetch_add(p, v, __ATOMIC_RELAXED, __HIP_MEMORY_SCOPE_AGENT); }
__device__ __forceinline__ unsigned xb_xcc_id() { return (unsigned)__builtin_amdgcn_s_getreg((3 << 11) | 20) & 0xFu; }
#define XB_SPIN(cond, bar) do { unsigned _sp = 0; while (cond) { __builtin_amdgcn_s_sleep(1); \
    if ((++_sp & 255u) == 0u) { if (xb_ld(&(bar)[XB_TMO])) break; if (_sp > XB_SPIN_CAP) { atomicAdd(&(bar)[XB_TMO], 1u); break; } } } } while (0)
struct XcdBarrier { unsigned* bar; unsigned x; volatile LAS unsigned* st; };
__device__ __forceinline__ XcdBarrier xcd_barrier_post(unsigned* bar, volatile LAS unsigned* st) {
    XcdBarrier b; b.bar = bar; b.x = xb_xcc_id(); b.st = st;
    if (threadIdx.x == 0) (void)xb_add(&bar[XB_XCNT(b.x)], 1u);
    return b;
}
__device__ __forceinline__ void xcd_barrier_complete(unsigned* bar, unsigned x, unsigned& nloc, unsigned& nx) {
    const unsigned G = gridDim.x * gridDim.y * gridDim.z;
    unsigned sum, cnt, mine, sp = 0u;
    for (;;) {
        sum = 0u; cnt = 0u; mine = 0u;
#pragma unroll
        for (unsigned j = 0; j < 16; ++j) { const unsigned c = xb_ld(&bar[XB_XCNT(j)]); sum += c; cnt += (c > 0u) ? 1u : 0u; mine = (j == x) ? c : mine; }
        if (sum == G) break;
        __builtin_amdgcn_s_sleep(1);
        if ((++sp & 255u) == 0u) { if (xb_ld(&bar[XB_TMO])) break; if (sp > XB_SPIN_CAP) { atomicAdd(&bar[XB_TMO], 1u); break; } }
    }
    nloc = mine > 0u ? mine : 1u; nx = cnt > 0u ? cnt : 1u;
}
__device__ __forceinline__ void xcd_barrier(const XcdBarrier& b) {
    asm volatile("s_waitcnt vmcnt(0)" ::: "memory");
    __syncthreads();
    if (threadIdx.x == 0) {
        unsigned* bar = b.bar;
        __builtin_amdgcn_s_waitcnt(0);
        unsigned nloc = b.st[0], nx = b.st[1];
        if (nloc == 0u) { xcd_barrier_complete(bar, b.x, nloc, nx); b.st[0] = nloc; b.st[1] = nx; }
        const unsigned old = xb_add(&bar[XB_XSUB(b.x)], 1u);
        const unsigned gen = old / nloc;
        if (old + 1u == (gen + 1u) * nloc) {
            __builtin_amdgcn_fence(__ATOMIC_RELEASE, "agent");
            asm volatile("s_waitcnt vmcnt(0)" ::: "memory");
            const unsigned og = xb_add(&bar[XB_TOP], 1u);
            const unsigned tg = og / nx;
            if (og + 1u == (tg + 1u) * nx) xb_add(&bar[XB_TOPGEN], 1u);
            else XB_SPIN(xb_ld(&bar[XB_TOPGEN]) == tg, bar);
            __builtin_amdgcn_fence(__ATOMIC_ACQUIRE, "agent");
            xb_add(&bar[XB_XGEN(b.x)], 1u);
            asm volatile("s_waitcnt vmcnt(0)" ::: "memory");
        } else {
            XB_SPIN(xb_ld(&bar[XB_XGEN(b.x)]) == gen, bar);
            __builtin_amdgcn_fence(__ATOMIC_ACQUIRE, "agent");
            asm volatile("s_waitcnt vmcnt(0)" ::: "memory");
        }
    }
    __syncthreads();
}

struct Args { const float* in[23]; float* out; unsigned char* ws; int ph_lo, ph_hi; };
enum { IN_X = 0, IN_MEM, IN_WIN, IN_GATEB, IN_POOLW, IN_POOLS, IN_CONVW, IN_MNORM, IN_RNORM, IN_WBR, IN_WMIX, IN_WQ, IN_WK, IN_WV, IN_WO, IN_RW, IN_RB, IN_WGU, IN_WDN, IN_SGU, IN_SDN, IN_LNW, IN_LNB };

#define GAS __attribute__((address_space(1)))
struct DArgs { const GAS float* in[23]; GAS float* out; GAS unsigned char* ws; int ph_lo, ph_hi; };
typedef const __attribute__((address_space(4))) DArgs* KArgs;
struct Frame {
    LAS unsigned char* lds; int tid, lane, wave, wg, nwg;
    GAS unsigned char* wsg; KArgs ka;
    __device__ __forceinline__ unsigned char* ws_() const { return (unsigned char*)wsg; }
};
__device__ __forceinline__ Frame fresh(const Frame& F) { Frame G = F; asm volatile("" : "+s"(G.wsg)); asm volatile("" : "+s"(G.ka)); asm volatile("" : "+v"(G.tid)); asm volatile("" : "+s"(G.wg));
    G.lane = G.tid & 63; G.wave = __builtin_amdgcn_readfirstlane(G.tid >> 6); return G; }

struct GUnit {
    const bf16_t* Bt;
    const bf16_t* A;
    const int* gather;
    int row0;
    int pn;
    int e;
    bf16_t* dst;
    int nv;
    const float* wrow;
};

__device__ __forceinline__ void un8(u32x4 w, f32x4& a, f32x4& b) { a[0] = __uint_as_float(w[0] << 16); a[1] = __uint_as_float(w[0] & 0xffff0000u); a[2] = __uint_as_float(w[1] << 16); a[3] = __uint_as_float(w[1] & 0xffff0000u);
    b[0] = __uint_as_float(w[2] << 16); b[1] = __uint_as_float(w[2] & 0xffff0000u); b[2] = __uint_as_float(w[3] << 16); b[3] = __uint_as_float(w[3] & 0xffff0000u); }
__device__ __forceinline__ void st_bf16x8(bf16_t* p, f32x4 a, f32x4 b) { u32x4 w; w[0] = pack2(a[0], a[1]); w[1] = pack2(a[2], a[3]); w[2] = pack2(b[0], b[1]); w[3] = pack2(b[2], b[3]); *(u32x4*)p = w; }
__device__ __forceinline__ void st_bf16x4(bf16_t* p, f32x4 v) { u32x2 w; w.x = pack2(v[0], v[1]); w.y = pack2(v[2], v[3]); *(u32x2*)p = w; }
struct RawRow { u32x4 w[4]; };
__device__ __forceinline__ void ld_raw32(const bf16_t* row, int lane, RawRow& r) {
#pragma unroll
    for (int j = 0; j < 4; ++j) r.w[j] = *(const u32x4*)(row + j * 512 + lane * 8); }
__device__ __forceinline__ void un_raw32(const RawRow& r, float (&v)[32]) {
#pragma unroll
    for (int j = 0; j < 4; ++j)
#pragma unroll
        for (int e = 0; e < 4; ++e) { v[j * 8 + 2 * e] = __uint_as_float(r.w[j][e] << 16); v[j * 8 + 2 * e + 1] = __uint_as_float(r.w[j][e] & 0xffff0000u); } }
__device__ __forceinline__ void ld_row32(const bf16_t* row, int lane, float (&v)[32]) {
#pragma unroll
    for (int j = 0; j < 4; ++j) { const u32x4 w = *(const u32x4*)(row + j * 512 + lane * 8);
#pragma unroll
        for (int e = 0; e < 4; ++e) { v[j * 8 + 2 * e] = __uint_as_float(w[e] << 16); v[j * 8 + 2 * e + 1] = __uint_as_float(w[e] & 0xffff0000u); } } }
__device__ __forceinline__ void st_row32(bf16_t* row, int lane, const float (&v)[32]) {
#pragma unroll
    for (int j = 0; j < 4; ++j) { u32x4 w;
#pragma unroll
        for (int e = 0; e < 4; ++e) w[e] = pack2(v[j * 8 + 2 * e], v[j * 8 + 2 * e + 1]);
        *(u32x4*)(row + j * 512 + lane * 8) = w; } }
__device__ __forceinline__ void st_row32_i8(unsigned char* row, float* sc, int lane, const float (&v)[32]) {
    float am = 0.f;
#pragma unroll
    for (int j = 0; j < 32; ++j) am = fmaxf(am, fabsf(v[j]));
    am = fmaxf(wave_max(am), 1e-30f); const float q = 127.0f / am;
#pragma unroll
    for (int j = 0; j < 4; ++j) { u32x2 w; w.x = pack_i8x4(v[j * 8] * q, v[j * 8 + 1] * q, v[j * 8 + 2] * q, v[j * 8 + 3] * q); w.y = pack_i8x4(v[j * 8 + 4] * q, v[j * 8 + 5] * q, v[j * 8 + 6] * q, v[j * 8 + 7] * q);
        *(u32x2*)(row + j * 512 + lane * 8) = w; }
    if (lane == 0) *sc = am * (1.0f / 127.0f); }
__device__ __forceinline__ void st_row32_fp8(unsigned char* row, int lane, const float (&v)[32]) {
#pragma unroll
    for (int j = 0; j < 4; ++j) { u32x2 w; w.x = pack_fp8x4(v[j * 8] * X8_SCALE, v[j * 8 + 1] * X8_SCALE, v[j * 8 + 2] * X8_SCALE, v[j * 8 + 3] * X8_SCALE); w.y = pack_fp8x4(v[j * 8 + 4] * X8_SCALE, v[j * 8 + 5] * X8_SCALE, v[j * 8 + 6] * X8_SCALE, v[j * 8 + 7] * X8_SCALE);
        *(u32x2*)(row + j * 512 + lane * 8) = w; } }
struct NoPre { };
struct EpiProj {
    static constexpr bool PAIR_M = false; static constexpr bool SEG = false; typedef NoPre Pre; static constexpr int NST = 8;
    bf16_t* proj; bf16_t* gates;
    static __device__ __forceinline__ float unit_scale(const GUnit& u) { return (u.pn == PC_MK / 256 || u.pn == PC_MK / 256 + 1 || u.pn == PC_RK / 256 || u.pn == PC_RK / 256 + 1) ? 0.08838834764831845f : 1.0f; }
    __device__ __forceinline__ void pre(const GUnit&, int, int, Pre&) const {}
    __device__ __forceinline__ void fin(const GUnit& u, int r, int c, const f32x4 (&a)[2][2], const Pre&) const {
        const int col = u.pn * 256 + c; const size_t row = (size_t)(u.row0 + r);
        if (col < NBR) { st_bf16x8(proj + row * NBR + col, a[0][0], a[0][1]); st_bf16x8(proj + row * NBR + col + 128, a[1][0], a[1][1]); }
        else { f32x4 s[2][2];
#pragma unroll
            for (int h = 0; h < 2; ++h)
#pragma unroll
                for (int n = 0; n < 2; ++n)
#pragma unroll
                    for (int j = 0; j < 4; ++j) s[h][n][j] = __builtin_amdgcn_fmed3f(sigmoidf_(a[h][n][j]) * 255.0f, 1.0f, 255.0f);
            u32x2 w0, w1; w0.x = pack_u8x4(s[0][0][0], s[0][0][1], s[0][0][2], s[0][0][3]); w0.y = pack_u8x4(s[0][1][0], s[0][1][1], s[0][1][2], s[0][1][3]);
            w1.x = pack_u8x4(s[1][0][0], s[1][0][1], s[1][0][2], s[1][0][3]); w1.y = pack_u8x4(s[1][1][0], s[1][1][1], s[1][1][2], s[1][1][3]);
            { const auto rx = __builtin_amdgcn_permlane32_swap(w0.x, w1.x, false, false); w0.x = rx[0]; w1.x = rx[1]; const auto ry = __builtin_amdgcn_permlane32_swap(w0.y, w1.y, false, false); w0.y = ry[0]; w1.y = ry[1]; }
            const bool up = (threadIdx.x & 32u) != 0u; const int gc = col - NBR;
            unsigned char* gp = (unsigned char*)gates + row * 8192 + (up ? gc + 128 - 8 : gc);
            u32x4 w; w[0] = w0.x; w[1] = w0.y; w[2] = w1.x; w[3] = w1.y; *(u32x4*)gp = w; }
    }
};
struct EpiBranch {
    static constexpr bool PAIR_M = false; static constexpr bool SEG = true; static constexpr int NST = 8;
    struct Pre { u32x2 g0, g1; };
    struct SPre { u32x2 a0, a1, b0, b1; };
    const unsigned char* gates; unsigned char* out;
    __device__ __forceinline__ void pre(const GUnit& u, int r, int c, Pre& p) const { const unsigned char* g = gates + (size_t)(u.row0 + r) * 8192 + 3 * 2048 + u.pn * 256 + c; p.g0 = *(const u32x2*)g; p.g1 = *(const u32x2*)(g + 128); }
    __device__ __forceinline__ void fin(const GUnit& u, int r, int c, const f32x4 (&a)[2][2], const Pre& p) const {
        f32x4 x0, x1, y0, y1; un8u(p.g0, x0, x1); un8u(p.g1, y0, y1); const float k = X8_SCALE / 255.0f;
        const f32x4 v00 = a[0][0] * x0 * k, v01 = a[0][1] * x1 * k, v10 = a[1][0] * y0 * k, v11 = a[1][1] * y1 * k;
        u32x2 w0, w1; w0.x = pack_fp8x4(v00[0], v00[1], v00[2], v00[3]); w0.y = pack_fp8x4(v01[0], v01[1], v01[2], v01[3]); w1.x = pack_fp8x4(v10[0], v10[1], v10[2], v10[3]); w1.y = pack_fp8x4(v11[0], v11[1], v11[2], v11[3]);
        { const auto rx = __builtin_amdgcn_permlane32_swap(w0.x, w1.x, false, false); w0.x = rx[0]; w1.x = rx[1]; const auto ry = __builtin_amdgcn_permlane32_swap(w0.y, w1.y, false, false); w0.y = ry[0]; w1.y = ry[1]; }
        const bool up = (threadIdx.x & 32u) != 0u;
        unsigned char* o = out + (size_t)(u.row0 + r) * D + u.pn * 256 + (up ? 128 + c - 8 : c);
        u32x4 w; w[0] = w0.x; w[1] = w0.y; w[2] = w1.x; w[3] = w1.y; *(u32x4*)o = w; }
    __device__ __forceinline__ void seg_pre(const GUnit& u, int r, int c, int s, SPre& p) const { const unsigned char* g = gates + (size_t)(u.row0 + r) * 8192 + s * 2048 + u.pn * 256 + c;
        p.a0 = *(const u32x2*)g; p.a1 = *(const u32x2*)(g + 128); p.b0 = *(const u32x2*)(g + 2048); p.b1 = *(const u32x2*)(g + 2048 + 128); }
    __device__ __forceinline__ void seg_fin(f32x4 (&h0)[2], f32x4 (&h1)[2], const SPre& p) const {
        f32x4 a0, a1, b0, b1; un8u(p.a0, a0, a1); un8u(p.b0, b0, b1);
#pragma unroll
        for (int j = 0; j < 4; ++j) { h0[0][j] *= a0[j] * __builtin_amdgcn_rcpf(b0[j]); h0[1][j] *= a1[j] * __builtin_amdgcn_rcpf(b1[j]); }
        un8u(p.a1, a0, a1); un8u(p.b1, b0, b1);
#pragma unroll
        for (int j = 0; j < 4; ++j) { h1[0][j] *= a0[j] * __builtin_amdgcn_rcpf(b0[j]); h1[1][j] *= a1[j] * __builtin_amdgcn_rcpf(b1[j]); }
    }
};
struct EpiResid {
    static constexpr bool PAIR_M = false; static constexpr bool SEG = false; static constexpr int NST = 16;
    struct Pre { u32x4 x0, x1; };
    const bf16_t* x; bf16_t* y;
    __device__ __forceinline__ void pre(const GUnit& u, int r, int c, Pre& p) const { const bf16_t* xp = x + (size_t)(u.row0 + r) * D + u.pn * 256 + c; p.x0 = *(const u32x4*)xp; p.x1 = *(const u32x4*)(xp + 128); }
    __device__ __forceinline__ void fin(const GUnit& u, int r, int c, const f32x4 (&a)[2][2], const Pre& p) const {
        f32x4 x0, x1, y0, y1; un8(p.x0, x0, x1); un8(p.x1, y0, y1);
        bf16_t* o = y + (size_t)(u.row0 + r) * D + u.pn * 256 + c; st_bf16x8(o, x0 * ALPHA + a[0][0], x1 * ALPHA + a[0][1]); st_bf16x8(o + 128, y0 * ALPHA + a[1][0], y1 * ALPHA + a[1][1]); }
};
struct EpiQKV {
    static constexpr bool PAIR_M = false; static constexpr bool SEG = false; typedef NoPre Pre; int pad_; static constexpr int NST = 16;
    __device__ __forceinline__ void pre(const GUnit&, int, int, Pre&) const {}
    __device__ __forceinline__ void fin(const GUnit& u, int r, int c, const f32x4 (&a)[2][2], const Pre&) const {
        bf16_t* o = u.dst + (size_t)(u.row0 + r) * W + u.pn * 256 + c; st_bf16x8(o, a[0][0], a[0][1]); st_bf16x8(o + 128, a[1][0], a[1][1]); }
};
struct EpiSwiglu {
    static constexpr bool SEG = false; static constexpr bool PAIR_M = true; static constexpr int NST = 4;
    struct Pre { float w; };
    unsigned char* hb;
    __device__ __forceinline__ void pre(const GUnit& u, int r, int, Pre& p) const { p.w = H8_SCALE * (u.wrow ? (r < u.nv ? u.wrow[r] : 0.f) : 1.0f); }
    __device__ __forceinline__ u32x2 act(const f32x4 (&a)[2][2], float w) const { f32x4 o[2];
#pragma unroll
        for (int n = 0; n < 2; ++n)
#pragma unroll
            for (int j = 0; j < 4; ++j) o[n][j] = a[0][n][j] * sigmoidf_(a[0][n][j]) * a[1][n][j] * w;
        u32x2 w8; w8.x = pack_fp8x4(o[0][0], o[0][1], o[0][2], o[0][3]); w8.y = pack_fp8x4(o[1][0], o[1][1], o[1][2], o[1][3]); return w8; }
    __device__ __forceinline__ void fin2(const GUnit& u, int r0, int r1, int c, const f32x4 (&a0)[2][2], const f32x4 (&a1)[2][2], const Pre& p0, const Pre& p1) const {
        u32x2 v0 = act(a0, p0.w), v1 = act(a1, p1.w);
        { const auto rx = __builtin_amdgcn_permlane32_swap(v0.x, v1.x, false, false); v0.x = rx[0]; v1.x = rx[1]; const auto ry = __builtin_amdgcn_permlane32_swap(v0.y, v1.y, false, false); v0.y = ry[0]; v1.y = ry[1]; }
        const bool up = (threadIdx.x & 32u) != 0u;
        unsigned char* o = hb + (size_t)(u.row0 + (up ? r1 : r0)) * ED + u.pn * 128 + (up ? c - 8 : c);
        u32x4 w; w[0] = v0.x; w[1] = v0.y; w[2] = v1.x; w[3] = v1.y; *(u32x4*)o = w; }
    __device__ __forceinline__ void fin(const GUnit&, int, int, const f32x4 (&)[2][2], const Pre&) const {}
};
struct EpiDown {
    static constexpr bool PAIR_M = false; static constexpr bool SEG = false; typedef NoPre Pre; static constexpr int NST = 8;
    unsigned char* yb;
    __device__ __forceinline__ void pre(const GUnit&, int, int, Pre&) const {}
    __device__ __forceinline__ void fin(const GUnit& u, int r, int c, const f32x4 (&a)[2][2], const Pre&) const {
        u32x2 w0, w1; w0.x = pack_fp8x4(a[0][0][0], a[0][0][1], a[0][0][2], a[0][0][3]); w0.y = pack_fp8x4(a[0][1][0], a[0][1][1], a[0][1][2], a[0][1][3]);
        w1.x = pack_fp8x4(a[1][0][0], a[1][0][1], a[1][0][2], a[1][0][3]); w1.y = pack_fp8x4(a[1][1][0], a[1][1][1], a[1][1][2], a[1][1][3]);
        { const auto rx = __builtin_amdgcn_permlane32_swap(w0.x, w1.x, false, false); w0.x = rx[0]; w1.x = rx[1]; const auto ry = __builtin_amdgcn_permlane32_swap(w0.y, w1.y, false, false); w0.y = ry[0]; w1.y = ry[1]; }
        const bool up = (threadIdx.x & 32u) != 0u;
        unsigned char* o = yb + (size_t)(u.row0 + r) * D + u.pn * 256 + (up ? 128 + c - 8 : c);
        u32x4 w; w[0] = w0.x; w[1] = w0.y; w[2] = w1.x; w[3] = w1.y; *(u32x4*)o = w; }
};

typedef short bf16x8 __attribute__((ext_vector_type(8)));
typedef short s16x4 __attribute__((ext_vector_type(4)));
__device__ __forceinline__ s16x4 lds_tr(const LAS bf16_t* p) { return __builtin_amdgcn_ds_read_tr16_b64_v4i16((LAS s16x4*)p); }
__device__ __forceinline__ bf16x8 cat4(s16x4 a, s16x4 b) { bf16x8 r; r[0] = a[0]; r[1] = a[1]; r[2] = a[2]; r[3] = a[3]; r[4] = b[0]; r[5] = b[1]; r[6] = b[2]; r[7] = b[3]; return r; }
__device__ __forceinline__ bf16x8 pack8(f32x4 a, f32x4 b) { union { u32x4 u; bf16x8 h; } c; c.u[0] = pack2(a[0], a[1]); c.u[1] = pack2(a[2], a[3]); c.u[2] = pack2(b[0], b[1]); c.u[3] = pack2(b[2], b[3]); return c.h; }
constexpr int BK = 64, HTB = 128 * BK * 2;
__device__ __forceinline__ int lds_byte(int r, int c) { const int st = (r >> 4) * 2 + (c >> 5), rr = r & 15, cc = c & 31, ob = rr * 64 + cc * 2; return st * 1024 + (ob ^ (((ob >> 9) & 1) << 5)); }
__device__ __forceinline__ void stage_rc(int b, int& R, int& C) { const int st = b / 1024, sb = b % 1024, swz = sb ^ (((sb >> 9) & 1) << 5); R = (st >> 1) * 16 + swz / 64; C = (st & 1) * 32 + (swz % 64) / 2; }

typedef int i32x8 __attribute__((ext_vector_type(8)));
typedef int i32x4 __attribute__((ext_vector_type(4)));
template <class Epi, class Sched, int MODE = 0>
__device__ __forceinline__ void gemm_phase_mfma(const Frame& F, const int K, const Sched& S, const Epi& E, const float oscale = 1.0f, const float* rowscale = nullptr) {
    constexpr bool FP8 = (MODE == 1), I8 = (MODE == 2);
    LAS unsigned char* lds = F.lds;
    const int tid = F.tid, wid = F.wave, lane = F.lane, wr = wid >> 2, wc = wid & 3, fr = lane & 15, fq = lane >> 4;
    const int KB = MODE ? K : 2 * K;
    const int nt = KB / 128;
    unsigned voffB[2];
#pragma unroll
    for (int i = 0; i < 2; ++i) { int R, C; stage_rc(tid * 16 + i * 8192, R, C); const int rho = R & 31, q4 = (rho & 15) >> 2, Rb = (R & ~31) + 8 * (((q4 & 1) << 1) | (q4 >> 1)) + 4 * (rho >> 4) + (rho & 3); voffB[i] = (unsigned)(Rb * KB + C * 2); }
    const size_t kstep = (size_t)(BK * 2);
    const size_t hstepB = (size_t)128 * KB;
    const unsigned ldsw = (unsigned)wid * 1024u;
    const int aoff = FP8 ? lds_byte(wr * 64 + fr, fq * 16) : lds_byte(wr * 64 + fr, fq * 8), boff = FP8 ? lds_byte(wc * 32 + fr, fq * 16) : lds_byte(wc * 32 + fr, fq * 8);
#define SA_(b, h) (((b) * 2 + (h)) * HTB)
#define SB_(b, h) ((4 + (b) * 2 + (h)) * HTB)
#define STAGE_(bufoff, gbase, voff) do { _Pragma("unroll") for (int _i = 0; _i < 2; ++_i) \
        __builtin_amdgcn_global_load_lds((const unsigned*)((const char*)(gbase) + (voff)[_i]), (LAS unsigned*)(lds + (bufoff) + ldsw + _i * 8192), 16, 0, 0); } while (0)
#define LDA_(dst, b, h) do { _Pragma("unroll") for (int m = 0; m < 4; ++m) { if constexpr (FP8) { const i32x4 _lo = *(const LAS i32x4*)(lds + SA_(b, h) + aoff + m * 2048), _hi = *(const LAS i32x4*)(lds + SA_(b, h) + aoff + m * 2048 + 16); \
            dst##8[m] = __builtin_shufflevector(_lo, _hi, 0, 1, 2, 3, 4, 5, 6, 7); } \
        else { _Pragma("unroll") for (int k = 0; k < 2; ++k) dst[m][k] = *(const LAS bf16x8*)(lds + SA_(b, h) + aoff + m * 2048 + k * 1024); } } } while (0)
#define LDB_(dst, b, h) do { _Pragma("unroll") for (int n = 0; n < 2; ++n) { if constexpr (FP8) { const i32x4 _lo = *(const LAS i32x4*)(lds + SB_(b, h) + boff + n * 2048), _hi = *(const LAS i32x4*)(lds + SB_(b, h) + boff + n * 2048 + 16); \
            dst##8[n] = __builtin_shufflevector(_lo, _hi, 0, 1, 2, 3, 4, 5, 6, 7); } \
        else { _Pragma("unroll") for (int k = 0; k < 2; ++k) dst[n][k] = *(const LAS bf16x8*)(lds + SB_(b, h) + boff + n * 2048 + k * 1024); } } } while (0)
#define MMA_(ai, bj, At, Bt) do { __builtin_amdgcn_s_setprio(1); _Pragma("unroll") for (int m = 0; m < 4; ++m) _Pragma("unroll") for (int n = 0; n < 2; ++n) { \
        if constexpr (FP8) asm volatile("v_mfma_scale_f32_16x16x128_f8f6f4 %0, %1, %2, %0, %3, %4 op_sel_hi:[0,0,0]" : "+v"(acc[ai][bj][m][n]) : "v"(Bt##8[n]), "v"(At##8[m]), "v"(sc8), "v"(sc8o)); \
        else if constexpr (I8) { _Pragma("unroll") for (int k = 0; k < 2; ++k) acci[ai][bj][m][n] = __builtin_amdgcn_mfma_i32_16x16x64_i8(__builtin_bit_cast(i32x4, Bt[n][k]), __builtin_bit_cast(i32x4, At[m][k]), acci[ai][bj][m][n], 0, 0, 0); } \
        else { _Pragma("unroll") for (int k = 0; k < 2; ++k) acc[ai][bj][m][n] = __builtin_amdgcn_mfma_f32_16x16x32_bf16(Bt[n][k], At[m][k], acc[ai][bj][m][n], 0, 0, 0); } } \
        __builtin_amdgcn_s_setprio(0); } while (0)
#define WAIT_V_(n) asm volatile("s_waitcnt vmcnt(" #n ")" ::: "memory")
#define WAIT_L_(n) asm volatile("s_waitcnt lgkmcnt(" #n ")" ::: "memory")
#define BAR_ __builtin_amdgcn_s_barrier()
#define SCHED_ __builtin_amdgcn_sched_barrier(0)
#define VOFFS_(dst, u) do { int _tz = tid; asm volatile("" : "+v"(_tz)); _Pragma("unroll") for (int _i = 0; _i < 2; ++_i) { int _R, _C; stage_rc(_tz * 16 + _i * 8192, _R, _C); \
        _Pragma("unroll") for (int _h = 0; _h < 2; ++_h) { const int _r = _h * 128 + _R; \
        const unsigned _row = (u).gather ? (_r < (u).nv ? (unsigned)(u).gather[_r] : 0u) : (unsigned)((u).row0 + _r); dst[_h][_i] = _row * (unsigned)KB + (unsigned)_C * 2u; } } } while (0)
    GUnit cur, nxt; int ui = 0;
    if (!S.get(0, cur)) return;
    f32x4 acc[2][2][4][2]; i32x4 acci[2][2][4][2];
#pragma unroll
    for (int a = 0; a < 2; ++a)
#pragma unroll
        for (int b = 0; b < 2; ++b)
#pragma unroll
            for (int m = 0; m < 4; ++m)
#pragma unroll
                for (int n = 0; n < 2; ++n) { acc[a][b][m][n] = (f32x4){0.f, 0.f, 0.f, 0.f}; acci[a][b][m][n] = (i32x4){0, 0, 0, 0}; }
    bf16x8 At[4][2], B0[2][2], B1[2][2]; i32x8 At8[4], B08[2], B18[2];
    int sc8 = 0x7f7f7f7f; asm volatile("" : "+v"(sc8));
    int sc8o = (int)(((__float_as_uint(oscale) >> 23) & 255u) * 0x01010101u); asm volatile("" : "+v"(sc8o));
    unsigned vA[2][2], vN[2][2];
    VOFFS_(vA, cur);
    const char* cA = (const char*)cur.A; const char* cB = (const char*)cur.Bt;
    STAGE_(SB_(0, 0), cB, voffB); STAGE_(SA_(0, 0), cA, vA[0]); STAGE_(SB_(0, 1), cB + hstepB, voffB); STAGE_(SA_(0, 1), cA, vA[1]);
    if (wr == 1) BAR_;
    WAIT_V_(4); BAR_;
    STAGE_(SB_(1, 0), cB + kstep, voffB); STAGE_(SA_(1, 0), cA + kstep, vA[0]); STAGE_(SB_(1, 1), cB + hstepB + kstep, voffB); STAGE_(SA_(1, 1), cA + kstep, vA[1]);
    WAIT_V_(8); BAR_;
    for (;;) {
        const bool has_next = S.get(ui + 1, nxt);
        const char* nA = has_next ? (const char*)nxt.A : cA; const char* nB = has_next ? (const char*)nxt.Bt : cB;
        if (has_next) { VOFFS_(vN, nxt); }
        for (int t = 0; t < nt; t += 2) {
            const bool last = (t == nt - 2);
            if constexpr (Epi::SEG) { constexpr int SGT = MODE ? 4 : 8;
              if (t > 0 && (t & (SGT - 1)) == 0) {
                int tz = tid; asm volatile("" : "+v"(tz)); const int er = ((tz >> 8) & 1) * 64 + (tz & 15), ec = ((tz >> 6) & 3) * 32 + ((((tz >> 4) & 1) << 1) | ((tz >> 5) & 1)) * 8;
#pragma unroll
                for (int ai = 0; ai < 2; ++ai) { typename Epi::SPre sp[4];
#pragma unroll
                    for (int m = 0; m < 4; ++m) E.seg_pre(cur, ai * 128 + m * 16 + er, ec, t / SGT - 1, sp[m]);
#pragma unroll
                    for (int m = 0; m < 4; ++m) E.seg_fin(acc[ai][0][m], acc[ai][1][m], sp[m]);
                    asm volatile("" ::: "memory"); }
            } }
            const char* a2 = last ? nA : cA + (size_t)(t + 2) * kstep; const char* b2 = last ? nB : cB + (size_t)(t + 2) * kstep;
            const char* a3 = a2 + kstep; const char* b3 = b2 + kstep;
            unsigned w0[2], w1[2];
#pragma unroll
            for (int i = 0; i < 2; ++i) { w0[i] = (last && has_next) ? vN[0][i] : vA[0][i]; w1[i] = (last && has_next) ? vN[1][i] : vA[1][i]; }
            LDB_(B0, 0, 0); SCHED_; LDA_(At, 0, 0);
            WAIT_L_(8); BAR_; WAIT_L_(0); MMA_(0, 0, At, B0); BAR_; SCHED_;
            LDB_(B1, 0, 1); STAGE_(SB_(0, 0), b2, voffB);
            BAR_; WAIT_L_(0); MMA_(0, 1, At, B1); BAR_;
            LDA_(At, 0, 1); STAGE_(SA_(0, 0), a2, w0);
            BAR_; WAIT_L_(0); MMA_(1, 0, At, B0); BAR_; SCHED_;
            STAGE_(SB_(0, 1), b2 + hstepB, voffB);
            { const int lax = __builtin_amdgcn_readfirstlane((t == 0 && ui > 0) ? 1 : 0); asm volatile("s_waitcnt vmcnt(%1)\n\ts_cmp_lg_u32 %0, 0\n\ts_cbranch_scc1 .Llax_%=\n\ts_waitcnt vmcnt(6)\n.Llax_%=:" :: "s"(lax), "n"(6 + Epi::NST) : "memory", "scc"); }
            BAR_; MMA_(1, 1, At, B1); BAR_;
            LDB_(B0, 1, 0); SCHED_; LDA_(At, 1, 0); STAGE_(SA_(0, 1), a2, w1);
            WAIT_L_(8); BAR_; WAIT_L_(0); MMA_(0, 0, At, B0); BAR_; SCHED_;
            LDB_(B1, 1, 1); STAGE_(SB_(1, 0), b3, voffB);
            BAR_; WAIT_L_(0); MMA_(0, 1, At, B1); BAR_;
            LDA_(At, 1, 1); STAGE_(SA_(1, 0), a3, w0);
            BAR_; WAIT_L_(0); MMA_(1, 0, At, B0); BAR_; SCHED_;
            STAGE_(SB_(1, 1), b3 + hstepB, voffB); STAGE_(SA_(1, 1), a3, w1);
            WAIT_V_(8); BAR_; MMA_(1, 1, At, B1); BAR_;
        }
        { int tz = tid; asm volatile("" : "+v"(tz)); const int er = ((tz >> 8) & 1) * 64 + (tz & 15), ec = ((tz >> 6) & 3) * 32 + ((((tz >> 4) & 1) << 1) | ((tz >> 5) & 1)) * 8;
          typename Epi::Pre pre[2][4];
#pragma unroll
          for (int ai = 0; ai < 2; ++ai)
#pragma unroll
              for (int m = 0; m < 4; ++m) E.pre(cur, ai * 128 + m * 16 + er, ec, pre[ai][m]);
          if constexpr (I8) {
#pragma unroll
              for (int ai = 0; ai < 2; ++ai)
#pragma unroll
                  for (int m = 0; m < 4; ++m) { const float rs = rowscale[cur.row0 + ai * 128 + m * 16 + er] * oscale * Epi::unit_scale(cur);
#pragma unroll
                      for (int bj = 0; bj < 2; ++bj)
#pragma unroll
                          for (int n = 0; n < 2; ++n)
#pragma unroll
                              for (int j = 0; j < 4; ++j) acc[ai][bj][m][n][j] = (float)acci[ai][bj][m][n][j] * rs; } }
          if constexpr (Epi::PAIR_M) {
#pragma unroll
          for (int ai = 0; ai < 2; ++ai)
#pragma unroll
              for (int m = 0; m < 4; m += 2) { const f32x4 a4[2][2] = {{acc[ai][0][m][0], acc[ai][0][m][1]}, {acc[ai][1][m][0], acc[ai][1][m][1]}}; const f32x4 b4[2][2] = {{acc[ai][0][m + 1][0], acc[ai][0][m + 1][1]}, {acc[ai][1][m + 1][0], acc[ai][1][m + 1][1]}};
                  E.fin2(cur, ai * 128 + m * 16 + er, ai * 128 + (m + 1) * 16 + er, ec, a4, b4, pre[ai][m], pre[ai][m + 1]); }
          } else {
#pragma unroll
          for (int ai = 0; ai < 2; ++ai)
#pragma unroll
              for (int m = 0; m < 4; ++m) { const f32x4 a4[2][2] = {{acc[ai][0][m][0], acc[ai][0][m][1]}, {acc[ai][1][m][0], acc[ai][1][m][1]}}; E.fin(cur, ai * 128 + m * 16 + er, ec, a4, pre[ai][m]); } } }
        if (!has_next) break;
#pragma unroll
        for (int a = 0; a < 2; ++a)
#pragma unroll
            for (int b = 0; b < 2; ++b)
#pragma unroll
                for (int m = 0; m < 4; ++m)
#pragma unroll
                    for (int n = 0; n < 2; ++n) { acc[a][b][m][n] = (f32x4){0.f, 0.f, 0.f, 0.f}; acci[a][b][m][n] = (i32x4){0, 0, 0, 0}; }
        cur = nxt; cA = nA; cB = nB; ++ui;
#pragma unroll
        for (int h = 0; h < 2; ++h)
#pragma unroll
            for (int i = 0; i < 2; ++i) vA[h][i] = vN[h][i];
    }
    WAIT_V_(0);
    if (wr == 0) BAR_;
    BAR_;
#undef SA_
#undef SB_
#undef STAGE_
#undef LDA_
#undef LDB_
#undef MMA_
#undef WAIT_V_
#undef WAIT_L_
#undef BAR_
#undef SCHED_
#undef VOFFS_
}

struct DenseSched {
    const bf16_t* A; const bf16_t* Bt; int K, nM, nN, nwg, G, c, i0, i1, split, pnoff;
    __device__ __forceinline__ void segment(int sg) { i0 = sg == 0 ? 0 : split; i1 = sg == 0 ? split : (1 << 30); }
    __device__ __forceinline__ bool get(int ii, GUnit& u) const {
        const int i = ii + i0; if (i >= i1) return false;
        const long L = (long)i * G + c; if (L >= nwg) return false;
        int wgid = (int)L; { const int q = nwg / 8, r = nwg % 8, xcd = wgid % 8, off = wgid / 8; wgid = (xcd < r ? xcd * (q + 1) : r * (q + 1) + (xcd - r) * q) + off; }
        const int nig = 8 * nN, gid = wgid / nig, fm = gid * 8, gsz = (nM - fm) < 8 ? (nM - fm) : 8;
        const int pm = fm + ((wgid % nig) % gsz), pn = (wgid % nig) / gsz;
        u.pn = pn + pnoff; u.row0 = pm * 256; u.A = A; u.gather = nullptr; u.Bt = Bt + (size_t)pn * 256 * K; u.e = 0; return true;
    }
};
struct QkvSched {
    unsigned char* ws; int l, G, c;
    __device__ __forceinline__ bool get(int i, GUnit& g) const {
        const int u = i * G + c; if (u >= 144) return false; g.gather = nullptr;
        if (u < 128) { g.e = 0; g.pn = u & 1; g.row0 = (u >> 1) * 256; g.A = (const bf16_t*)(ws + WS_XB8); g.Bt = (const bf16_t*)(ws + WS_WQ + l * SZ_WQ + (size_t)g.pn * 256 * D); g.dst = (bf16_t*)(ws + WS_Q); }
        else { const int v = u - 128; g.e = 1 + (v >> 3); g.pn = v & 1; g.row0 = ((v >> 1) & 3) * 256; g.A = (const bf16_t*)(ws + WS_MEMB8); g.Bt = (const bf16_t*)(ws + (g.e == 1 ? WS_WK : WS_WV) + l * SZ_WQ + (size_t)g.pn * 256 * D); g.dst = (bf16_t*)(ws + (g.e == 1 ? WS_KM : WS_VM)) + (size_t)l * TM * W; }
        return true;
    }
};
constexpr int PST_CNT = 240;
template <int NCT, bool GATEUP> struct MoeSched {
    unsigned char* ws; const LAS int* pst; int l, G, c, nunits;
    __device__ __forceinline__ bool get(int i, GUnit& g) const {
        int rt;
        if (!GATEUP && G == 256) {
            const int x = c & 7, j = c >> 3; rt = 2 * (16 * i + (j >> 1)) + (x & 1); g.pn = 2 * (x >> 1) + (j & 1); if (rt * NCT >= nunits) return false; }
        else { const int u = i * G + c; if (u >= nunits) return false; rt = u / NCT; g.pn = u % NCT; }
        g.row0 = rt * 256; const int e = __builtin_amdgcn_readfirstlane((int)((const LAS unsigned char*)(pst + 68))[rt]); g.e = e;
        if (GATEUP) { if (e < NE) { const int l0 = g.row0 - pst[e]; g.A = (const bf16_t*)(ws + WS_XB8); g.gather = (const int*)(ws + WS_TOKL) + (size_t)e * T + l0; g.wrow = (const float*)(ws + WS_WL) + (size_t)e * T + l0; g.nv = pst[PST_CNT + e] - l0; }
            else { g.A = (const bf16_t*)(ws + WS_XB8 - (size_t)pst[NE] * D); g.gather = nullptr; g.wrow = nullptr; g.nv = 256; }
            g.Bt = (const bf16_t*)(ws + WS_WGU8 + ((size_t)l * NEX + e) * SZ_WGU8 + (size_t)g.pn * 256 * D); }
        else { g.A = (const bf16_t*)(ws + WS_HB); g.gather = nullptr; g.Bt = (const bf16_t*)(ws + WS_WDN + ((size_t)l * NEX + e) * SZ_WDN1 + (size_t)g.pn * 256 * ED); }
        return true;
    }
};

struct TDesc { const float* sp; int sld; unsigned char* dp; int dldb; int fp8; float qs; };
constexpr int TK_WINA = 1024, TK_WINB = 2560, TK_BR = 384, TK_WOUT = 512, TK_QKV = 384, TK_WO = 128, TK_GU = NEX * 8 * 32, TK_DN = NEX * 128;
constexpr int TK_L0DEF = TK_BR + TK_WOUT + TK_QKV + TK_WO + TK_GU + TK_DN, TK_LAYER = TK_WINA + TK_WINB + TK_L0DEF;
__device__ __forceinline__ void tile_desc(const Frame& F, int l, int t, TDesc& d) {
    const KArgs a = F.ka; unsigned char* ws = F.ws_(); d.fp8 = 0; d.qs = W8_SCALE;
    if (t < TK_WINA) { const int tk = t >> 6, tc = t & 63; d.sp = ((const float*)a->in[IN_WIN]) + (size_t)l * D * PROJ_W + (size_t)tk * 128 * PROJ_W + tc * 64; d.sld = PROJ_W; d.dldb = D; d.fp8 = 2; d.qs = 127.0f / fmaxf(__uint_as_float(((const unsigned*)(ws + WS_CTL))[CW_WABS + l * 32]), 1e-30f); d.dp = ws + WS_WINQ + l * SZ_WINQ + (size_t)tc * 64 * D + tk * 128; return; }
    t -= TK_WINA;
    if (t < TK_WINB) { const int tk = t / 160, tc = t % 160; d.sp = ((const float*)a->in[IN_WIN]) + (size_t)l * D * PROJ_W + (size_t)tk * 128 * PROJ_W + 4104 + tc * 64; d.sld = PROJ_W;
        if (tc < 32) { d.dldb = D; d.fp8 = 2; d.qs = 127.0f / fmaxf(__uint_as_float(((const unsigned*)(ws + WS_CTL))[CW_WABS + l * 32]), 1e-30f); d.dp = ws + WS_WINQ + l * SZ_WINQ + (size_t)(4096 + tc * 64) * D + tk * 128; }
        else { d.dldb = D; d.fp8 = 1; d.dp = ws + WS_WIN8 + l * SZ_WIN8 + (size_t)(4096 + tc * 64) * D + tk * 128; }
        return; }
    t -= TK_WINB;
    if (t < TK_BR) { const int n = 1 + (t >> 7), tt = t & 127, tk = tt >> 5, tc = tt & 31; d.sp = ((const float*)a->in[IN_WBR]) + ((size_t)l * 4 + n) * W * D + (size_t)tk * 128 * D + tc * 64; d.sld = D; d.dldb = D; d.fp8 = 1; d.dp = ws + WS_WB + l * SZ_DD + ((size_t)tc * 64 * D + n * W + tk * 128); return; }
    t -= TK_BR;
    if (t < TK_WOUT) { const int tk = t >> 5, tc = t & 31; d.sp = ((const float*)a->in[IN_WMIX]) + (size_t)l * D * D + (size_t)tk * 128 * D + tc * 64; d.sld = D; d.dldb = D; d.fp8 = 1; d.dp = ws + WS_WOUT + l * SZ_DD + ((size_t)tc * 64 * D + tk * 128); return; }
    t -= TK_WOUT;
    if (t < TK_QKV) { const int which = t >> 7, tt = t & 127, tk = tt >> 3, tc = tt & 7; d.sp = (const float*)a->in[which == 0 ? IN_WQ : (which == 1 ? IN_WK : IN_WV)] + (size_t)l * D * W + (size_t)tk * 128 * W + tc * 64; d.sld = W; d.dldb = D * 2;
        d.dp = ws + (which == 0 ? WS_WQ : (which == 1 ? WS_WK : WS_WV)) + l * SZ_WQ + ((size_t)tc * 64 * D + tk * 128) * 2;
        d.fp8 = 1; d.dldb = D; d.dp = ws + (which == 0 ? WS_WQ : (which == 1 ? WS_WK : WS_WV)) + l * SZ_WQ + ((size_t)tc * 64 * D + tk * 128);
        return; }
    t -= TK_QKV;
    if (t < TK_WO) { const int tk = t >> 5, tc = t & 31; d.sp = ((const float*)a->in[IN_WO]) + (size_t)l * W * D + (size_t)tk * 128 * D + tc * 64; d.sld = D; d.dldb = W; d.fp8 = 1; d.dp = ws + WS_WO + l * SZ_WQ + ((size_t)tc * 64 * W + tk * 128); return; }
    t -= TK_WO;
    if (t < TK_GU) { const int tc = t & 1, tk = (t >> 2) & 15, half = (t >> 6) & 1, j = ((t >> 7) & 1) * 2 + ((t >> 1) & 1), e = t >> 8;
        d.sp = (e < NE ? ((const float*)a->in[IN_WGU]) + ((size_t)l * NE + e) * D * 1024 : ((const float*)a->in[IN_SGU]) + (size_t)l * D * 1024) + half * 512 + j * 128 + (size_t)tk * 128 * 1024 + tc * 64; d.sld = 1024; d.dldb = D; d.fp8 = 1;
        d.dp = ws + WS_WGU8 + ((size_t)l * NEX + e) * SZ_WGU8 + (size_t)(j * 256 + half * 128 + tc * 64) * D + tk * 128; return; }
    t -= TK_GU;
    { const int tt = t & 127, e = t >> 7, tk = tt >> 5, tc = tt & 31;
      d.sp = (e < NE ? ((const float*)a->in[IN_WDN]) + ((size_t)l * NE + e) * ED * D : ((const float*)a->in[IN_SDN]) + (size_t)l * ED * D) + (size_t)tk * 128 * D + tc * 64; d.sld = D; d.dldb = ED; d.fp8 = 1;
      d.dp = ws + WS_WDN + ((size_t)l * NEX + e) * SZ_WDN1 + (size_t)tc * 64 * ED + tk * 128; }
}
constexpr int XP_SLOT = 64 * 256;
template <int NB> struct XRegs { f32x4 r[NB][4]; };
template <int NB> __device__ __forceinline__ void xpose_load(const Frame& F, int l, int t0, int tstep, int n, XRegs<NB>& X) {
    const int tid = F.tid, row4 = (tid >> 4) * 4, cq = (tid & 15) * 4;
#pragma unroll
    for (int b = 0; b < NB; ++b) if (b < n) { TDesc d; tile_desc(F, l, t0 + b * tstep, d); const float* sp = d.sp + (size_t)row4 * d.sld + cq;
#pragma unroll
        for (int q = 0; q < 4; ++q) X.r[b][q] = __builtin_nontemporal_load((const f32x4*)(sp + (size_t)q * d.sld)); }
}
template <int NB> __device__ __forceinline__ void xpose_finish(const Frame& F, int l, int t0, int tstep, int n, const XRegs<NB>& X) {
    const int tid = F.tid, row4 = (tid >> 4) * 4, cq = (tid & 15) * 4;
    int t1 = t0; asm volatile("" : "+s"(t1));
#pragma unroll
    for (int b = 0; b < NB; ++b) if (b < n) { TDesc d; tile_desc(F, l, t1 + b * tstep, d); LAS unsigned char* L = F.lds + b * XP_SLOT;
        if (d.fp8) { const int sw = ((cq >> 2) & 7) << 4;
#pragma unroll
            for (int j = 0; j < 4; ++j) *(LAS unsigned*)(L + (cq + j) * 128 + (row4 ^ sw)) = (d.fp8 == 2) ? pack_i8x4(X.r[b][0][j] * d.qs, X.r[b][1][j] * d.qs, X.r[b][2][j] * d.qs, X.r[b][3][j] * d.qs) : pack_fp8x4(X.r[b][0][j] * W8_SCALE, X.r[b][1][j] * W8_SCALE, X.r[b][2][j] * W8_SCALE, X.r[b][3][j] * W8_SCALE);
        } else { const int sw = ((cq >> 2) & 15) << 4;
#pragma unroll
            for (int j = 0; j < 4; ++j) { u32x2 w; w.x = pack2(X.r[b][0][j], X.r[b][1][j]); w.y = pack2(X.r[b][2][j], X.r[b][3][j]); *(LAS u32x2*)(L + (cq + j) * 256 + ((row4 * 2) ^ sw)) = w; } } }
    __syncthreads();
    int t2 = t0; asm volatile("" : "+s"(t2));
#pragma unroll
    for (int b = 0; b < NB; ++b) if (b < n) { TDesc d; tile_desc(F, l, t2 + b * tstep, d); const LAS unsigned char* L = F.lds + b * XP_SLOT; const int c = tid >> 3, kq = tid & 7;
        if (d.fp8) *(u32x4*)(d.dp + (size_t)c * d.dldb + kq * 16) = *(const LAS u32x4*)(L + c * 128 + ((kq * 16) ^ (((c >> 2) & 7) << 4)));
        else { const int sw = ((c >> 2) & 15) << 4; *(u32x4*)(d.dp + (size_t)c * d.dldb + kq * 16) = *(const LAS u32x4*)(L + c * 256 + ((kq * 16) ^ sw)); *(u32x4*)(d.dp + (size_t)c * d.dldb + 128 + kq * 16) = *(const LAS u32x4*)(L + c * 256 + ((128 + kq * 16) ^ sw)); } }
    __syncthreads();
}
__device__ __forceinline__ void xpose_range(const Frame& F, int l, int tlo, int thi, int rank, int nranks) {
    constexpr int NB = 4; const int step = nranks * NB;
    XRegs<NB> A, B;
    int t = tlo + rank * NB; if (t >= thi) return;
#define XP_CNT(tt) (((thi) - (tt)) < NB ? ((thi) - (tt)) : NB)
    xpose_load<NB>(F, l, t, 1, XP_CNT(t), A);
    for (;;) {
        const int tb = t + step; const bool hb = tb < thi; if (hb) xpose_load<NB>(F, l, tb, 1, XP_CNT(tb), B);
        xpose_finish<NB>(F, l, t, 1, XP_CNT(t), A);
        if (!hb) break;
        const int ta = tb + step; const bool ha = ta < thi; if (ha) xpose_load<NB>(F, l, ta, 1, XP_CNT(ta), A);
        xpose_finish<NB>(F, l, tb, 1, XP_CNT(tb), B);
        if (!ha) break;
        t = ta;
    }
#undef XP_CNT
}
__device__ __forceinline__ void pool_fold(const Frame& F, int l, int rank, int nranks) {
    const KArgs a = F.ka; unsigned char* ws = F.ws_();
    for (size_t i = (size_t)rank * NTHR + F.tid; i < (size_t)W * D; i += (size_t)nranks * NTHR) {
        const int d = (int)(i % D), gc = (int)(i / D), g = gc >> 7;
        const float* pw = ((const float*)a->in[IN_POOLW]) + ((size_t)l * W + gc) * 128; const float* ps = ((const float*)a->in[IN_POOLS]) + l * W + g * 128;
        const float* wb = ((const float*)a->in[IN_WBR]) + ((size_t)l * 4 * W + g * 128) * D + d;
        float s = 0.f;
        for (int e = 0; e < 128; ++e) s += pw[e] * ps[e] * wb[(size_t)e * D];
        (ws + WS_WB + l * SZ_DD)[(size_t)d * D + gc] = (unsigned char)(pack_fp8x4(s * W8_SCALE, 0.f, 0.f, 0.f) & 255u);
    }
}
__device__ __forceinline__ void phase_wabs(const Frame& F) {
    const KArgs a = F.ka; unsigned char* ws = F.ws_();
    for (int l = 0; l < DEPTH; ++l) { float m = 0.f; const float* w = ((const float*)a->in[IN_WIN]) + (size_t)l * D * PROJ_W;
        for (size_t i = (size_t)F.wg * NTHR + F.tid; i < (size_t)D * (NBR / 4); i += (size_t)F.nwg * NTHR) { const int c4 = (int)(i % (NBR / 4)), k = (int)(i / (NBR / 4)); const int col = c4 * 4 < 4096 ? c4 * 4 : c4 * 4 + 8;
            const f32x4 v = *(const f32x4*)(w + (size_t)k * PROJ_W + col); m = fmaxf(m, fmaxf(fmaxf(fabsf(v[0]), fabsf(v[1])), fmaxf(fabsf(v[2]), fabsf(v[3])))); }
        m = wave_max(m);
        if (F.lane == 0) ((LAS float*)F.lds)[l * 8 + F.wave] = m; }
    __syncthreads();
    if (F.tid < DEPTH) { const LAS float* r = (const LAS float*)F.lds + F.tid * 8; float m = r[0];
#pragma unroll
        for (int w = 1; w < 8; ++w) m = fmaxf(m, r[w]);
        __hip_atomic_fetch_max((unsigned*)(ws + WS_CTL) + CW_WABS + F.tid * 32, __float_as_uint(m), __ATOMIC_RELAXED, __HIP_MEMORY_SCOPE_AGENT); }
    __syncthreads();
}
__device__ __forceinline__ void phase_prologue(const Frame& F) {
    const KArgs a = F.ka;
    unsigned char* ws = F.ws_();
    xpose_range(F, 0, 0, TK_WINA + TK_WINB, F.wg, F.nwg);
    const size_t gtid = (size_t)F.wg * NTHR + F.tid, gn = (size_t)F.nwg * NTHR;
    for (size_t i = gtid; i < (size_t)DEPTH * 8 * D; i += gn) { const int k = (int)(i % D), c = (int)((i / D) % 8), l = (int)(i / (8 * D));
        ((float*)(ws + WS_WIF))[i] = ((const float*)a->in[IN_WIN])[(size_t)l * D * PROJ_W + (size_t)k * PROJ_W + 4096 + c]; }
    for (size_t i = gtid; i < (size_t)DEPTH * 16 * D; i += gn) { const int k = (int)(i % D), c = (int)((i / D) % 16), l = (int)(i / (16 * D));
        const float wv = c < 8 ? ((const float*)a->in[IN_WIN])[(size_t)l * D * PROJ_W + (size_t)k * PROJ_W + 4096 + c] : 0.f; const bf16_t hi = f2bf(wv), lo = f2bf(wv - bf2f(hi));
        bf16_t* o = (bf16_t*)(ws + WS_WIFB) + (size_t)l * 2 * 16 * D; o[(size_t)c * D + k] = hi; o[(size_t)(16 + c) * D + k] = lo; }
    for (size_t i = gtid; i < (size_t)DEPTH * NE * D; i += gn) { const int k = (int)(i % D), e = (int)((i / D) % NE), l = (int)(i / ((size_t)NE * D));
        const float w = ((const float*)a->in[IN_RW])[((size_t)l * D + k) * NE + e]; const bf16_t hi = f2bf(w); const bf16_t lo = f2bf(w - bf2f(hi));
        bf16_t* o = (bf16_t*)(ws + WS_RWT) + (size_t)l * 2 * NE * D; o[(size_t)e * D + k] = hi; o[(size_t)(NE + e) * D + k] = lo; }
    for (size_t i = gtid; i < (size_t)SEQ * 64; i += gn) { const int f = (int)(i & 63), s = (int)(i >> 6);
        const float inv = powf(10000.0f, -(float)f / 64.0f); const float ang = (float)s * inv;
        ((float*)(ws + WS_ROPE))[i] = cosf(ang); ((float*)(ws + WS_ROPE))[(size_t)SEQ * 64 + i] = sinf(ang); }
    for (int row = F.wg * 8 + F.wave; row < T; row += F.nwg * 8) { float v[32]; const float* xr = ((const float*)a->in[IN_X]) + (size_t)row * D;
#pragma unroll
        for (int j = 0; j < 4; ++j) { const f32x4 p = *(const f32x4*)(xr + j * 512 + F.lane * 8), q = *(const f32x4*)(xr + j * 512 + F.lane * 8 + 4); v[j * 8] = p[0]; v[j * 8 + 1] = p[1]; v[j * 8 + 2] = p[2]; v[j * 8 + 3] = p[3]; v[j * 8 + 4] = q[0]; v[j * 8 + 5] = q[1]; v[j * 8 + 6] = q[2]; v[j * 8 + 7] = q[3]; }
        st_row32((bf16_t*)(ws + WS_XB) + (size_t)row * D, F.lane, v); st_row32_fp8(ws + WS_XB8 + (size_t)row * D, F.lane, v); st_row32_i8(ws + WS_XQ8 + (size_t)row * D, (float*)(ws + WS_XSC) + row, F.lane, v); }
    for (size_t i = gtid; i < (size_t)TM * D / 4; i += gn) { const f32x4 v = ((const f32x4*)((const float*)a->in[IN_MEM]))[i]; st_bf16x4((bf16_t*)(ws + WS_MEMB) + i * 4, v);
        ((unsigned*)(ws + WS_MEMB8))[i] = pack_fp8x4(v[0] * X8_SCALE, v[1] * X8_SCALE, v[2] * X8_SCALE, v[3] * X8_SCALE); }
    __syncthreads();
}
__device__ __forceinline__ void prologue_deferred(const Frame& F, int rank, int nranks) {
    xpose_range(F, 0, TK_WINA + TK_WINB, TK_LAYER, rank, nranks);
    xpose_range(F, 1, 0, TK_LAYER, rank, nranks);
    pool_fold(F, 0, rank, nranks); pool_fold(F, 1, rank, nranks);
    __syncthreads();
}

__device__ __forceinline__ void unpack8(u32x4 w, float (&f)[8]) {
#pragma unroll
    for (int j = 0; j < 4; ++j) { f[2 * j] = __uint_as_float(w[j] << 16); f[2 * j + 1] = __uint_as_float(w[j] & 0xffff0000u); } }
__device__ __forceinline__ u32x4 pack8f(const float (&f)[8]) { u32x4 w;
#pragma unroll
    for (int j = 0; j < 4; ++j) w[j] = pack2(f[2 * j], f[2 * j + 1]); return w; }
template <int WIN> __device__ __forceinline__ void pool_block(const bf16_t* pu, unsigned char* out, int s0) {
    float sum[8];
#pragma unroll
    for (int e = 0; e < 8; ++e) sum[e] = 0.f;
    u32x4 hist[WIN - 1 + 8];
#pragma unroll
    for (int j = 0; j < WIN - 1 + 8; ++j) { const int ds = j - (WIN - 1); hist[j] = (s0 + ds >= 0) ? *(const u32x4*)(pu + (ptrdiff_t)ds * NBR) : (u32x4){0u, 0u, 0u, 0u}; }
#pragma unroll
    for (int j = 0; j < WIN - 1; ++j) { float f[8]; unpack8(hist[j], f);
#pragma unroll
        for (int e = 0; e < 8; ++e) sum[e] += f[e]; }
#pragma unroll
    for (int i = 0; i < 8; ++i) { float f[8]; unpack8(hist[WIN - 1 + i], f); const int cnt = (s0 + i + 1 < WIN) ? s0 + i + 1 : WIN; const float rc = 1.0f / (float)cnt; float o[8];
#pragma unroll
        for (int e = 0; e < 8; ++e) { sum[e] += f[e]; o[e] = sum[e] * rc - f[e]; }
        *(u32x2*)(out + (size_t)i * D) = pack_fp8x8s(o, X8_SCALE);
        float fo[8]; unpack8(hist[i], fo);
#pragma unroll
        for (int e = 0; e < 8; ++e) sum[e] -= fo[e]; }
}
template <bool WITH_D = true> __device__ __forceinline__ void phase_mix1v2(const Frame& F, int l, const bf16_t* xcur) {
    const KArgs a = F.ka;
    unsigned char* ws = F.ws_();
    LAS float* dots = (LAS float*)(F.lds + 65536);
    LAS float* wl = (LAS float*)F.lds;
    const float* wif = (const float*)(ws + WS_WIF) + (size_t)l * 8 * D;
    const float* gb = ((const float*)a->in[IN_GATEB]) + l * 8;
    float* cumf = (float*)(ws + WS_CUMF); float* ipre = (float*)(ws + WS_IPRE); float* summ = (float*)(ws + WS_SUMM); float* av = (float*)(ws + WS_AV); float* pm = (float*)(ws + WS_PM);
    const bf16_t* wifb = (const bf16_t*)(ws + WS_WIFB) + (size_t)l * 2 * 16 * D;
    for (int item = F.wg; item < BATCH * NCH; item += F.nwg) {
        const int b = item / NCH, c = item % NCH; const int t0 = b * SEQ + c * CH;
        { const int lane = F.lane, g = lane >> 4, li = lane & 15, w = F.wave;
          f32x4 acc[4] = {{0.f, 0.f, 0.f, 0.f}, {0.f, 0.f, 0.f, 0.f}, {0.f, 0.f, 0.f, 0.f}, {0.f, 0.f, 0.f, 0.f}};
#pragma unroll 4
          for (int ks = 8 * w; ks < 8 * w + 8; ++ks) { const bf16x8 bh = *(const bf16x8*)(wifb + (size_t)li * D + ks * 32 + g * 8), bl = *(const bf16x8*)(wifb + (size_t)(16 + li) * D + ks * 32 + g * 8);
#pragma unroll
              for (int mt = 0; mt < 4; ++mt) { const bf16x8 xa = *(const bf16x8*)(xcur + (size_t)(t0 + 16 * mt + li) * D + ks * 32 + g * 8);
                  acc[mt] = __builtin_amdgcn_mfma_f32_16x16x32_bf16(xa, bh, acc[mt], 0, 0, 0); acc[mt] = __builtin_amdgcn_mfma_f32_16x16x32_bf16(xa, bl, acc[mt], 0, 0, 0); } }
          LAS float* part = (LAS float*)F.lds;
          if (li < 8) {
#pragma unroll
              for (int mt = 0; mt < 4; ++mt)
#pragma unroll
                  for (int r = 0; r < 4; ++r) part[((w * 64) + 16 * mt + 4 * g + r) * 8 + li] = acc[mt][r]; }
          __syncthreads();
          if (F.tid < 512) { const int tok = F.tid >> 3, q = F.tid & 7; float sacc = 0.f;
#pragma unroll
              for (int ww = 0; ww < 8; ++ww) sacc += part[(ww * 64 + tok) * 8 + q];
              dots[tok * 8 + q] = sacc; } }
        __syncthreads();
        if (F.wave < NH) {
            const int h = F.wave, s = F.lane; const float ip = dots[s * 8 + h] + gb[h], fp = dots[s * 8 + 4 + h] + gb[4 + h];
            const float lf = fminf(fp, 0.f) - log1pf(__expf(-fabsf(fp)));
            float cs = lf;
#pragma unroll
            for (int o = 1; o < 64; o <<= 1) { const float n = __shfl_up(cs, o); if (s >= o) cs += n; }
            const float ftot = __shfl(cs, 63); const float aa = ip - cs;
            float px = aa;
#pragma unroll
            for (int o = 1; o < 64; o <<= 1) { const float n = __shfl_up(px, o); if (s >= o) px = fmaxf(px, n); }
            const float gm = ftot + __shfl(px, 63);
            const size_t o = (size_t)(b * NH + h) * SEQ + c * CH + s; cumf[o] = cs; ipre[o] = ip; av[o] = aa; pm[o] = px;
            if (s == 0) { summ[((size_t)(b * NH + h) * NCH + c) * 2] = ftot; summ[((size_t)(b * NH + h) * NCH + c) * 2 + 1] = gm; }
        }
        __syncthreads();
    }
    bf16_t* proj = (bf16_t*)(ws + WS_PROJ); unsigned char* br = ws + WS_BR;
    for (int it = F.wg * 8 + F.wave; it < (T / 32) * 4; it += F.nwg * 8) {
        const int grp = it & 3, tbq = it >> 2; const int tb = tbq * 4 + (F.lane >> 4), co = grp * 16 + (F.lane & 15);
        const int t0 = tb * 8, s0 = t0 % SEQ; const bf16_t* pu = proj + (size_t)t0 * NBR + PC_U + co * 8; unsigned char* out = br + (size_t)t0 * D + co * 8;
        if (grp == 0) pool_block<2>(pu, out, s0); else if (grp == 1) pool_block<4>(pu, out, s0); else if (grp == 2) pool_block<8>(pu, out, s0); else pool_block<16>(pu, out, s0);
    }
    { const float* cw = ((const float*)a->in[IN_CONVW]) + (size_t)l * 3 * W;
      for (size_t it = (size_t)F.wg * NTHR + F.tid; it < (size_t)(T / 8) * 64; it += (size_t)F.nwg * NTHR) {
        const int co = (int)(it & 63), tb = (int)(it >> 6), t0 = tb * 8, s0 = t0 % SEQ;
        const bf16_t* pr = proj + (size_t)t0 * NBR + co * 8;
        float w0[8], w1[8], w2[8];
#pragma unroll
        for (int e = 0; e < 8; ++e) { w0[e] = cw[co * 8 + e]; w1[e] = cw[W + co * 8 + e]; w2[e] = cw[2 * W + co * 8 + e]; }
        float z1[8], z2[8];
#pragma unroll
        for (int e = 0; e < 8; ++e) { z1[e] = 0.f; z2[e] = 0.f; }
        if (s0 >= 2) { float c_[8], h_[8]; unpack8(*(const u32x4*)(pr + PC_CC - 2 * NBR), c_); unpack8(*(const u32x4*)(pr + PC_CH - 2 * NBR), h_);
#pragma unroll
            for (int e = 0; e < 8; ++e) z2[e] = c_[e] * h_[e]; }
        if (s0 >= 1) { float c_[8], h_[8]; unpack8(*(const u32x4*)(pr + PC_CC - NBR), c_); unpack8(*(const u32x4*)(pr + PC_CH - NBR), h_);
#pragma unroll
            for (int e = 0; e < 8; ++e) z1[e] = c_[e] * h_[e]; }
#pragma unroll
        for (int i = 0; i < 8; ++i) { float c_[8], h_[8], b_[8], o[8]; unpack8(*(const u32x4*)(pr + PC_CC + (size_t)i * NBR), c_); unpack8(*(const u32x4*)(pr + PC_CH + (size_t)i * NBR), h_); unpack8(*(const u32x4*)(pr + PC_CB + (size_t)i * NBR), b_);
#pragma unroll
            for (int e = 0; e < 8; ++e) { const float z0 = c_[e] * h_[e]; o[e] = b_[e] * (w0[e] * z0 + w1[e] * z1[e] + w2[e] * z2[e]); z2[e] = z1[e]; z1[e] = z0; }
            *(u32x2*)(br + (size_t)(t0 + i) * D + W + co * 8) = pack_fp8x8s(o, X8_SCALE); }
      } }
    if constexpr (WITH_D) { const float* ropec = (const float*)(ws + WS_ROPE); const float* ropes = ropec + (size_t)SEQ * 64;
      for (size_t it = (size_t)F.wg * NTHR + F.tid; it < (size_t)T * 64; it += (size_t)F.nwg * NTHR) {
        const int oc = (int)(it & 7), hh = (int)((it >> 3) & 3), isk = (int)((it >> 5) & 1), t = (int)(it >> 6), s = t % SEQ;
        bf16_t* p = proj + (size_t)t * NBR + (isk ? PC_RK : PC_RQ) + hh * HD + oc * 8;
        float x1[8], x2[8], o1[8], o2[8]; unpack8(*(const u32x4*)p, x1); unpack8(*(const u32x4*)(p + 64), x2);
#pragma unroll
        for (int e = 0; e < 8; ++e) { const float cs = ropec[(size_t)s * 64 + oc * 8 + e], sn = ropes[(size_t)s * 64 + oc * 8 + e]; o1[e] = x1[e] * cs - x2[e] * sn; o2[e] = x1[e] * sn + x2[e] * cs; }
        *(u32x4*)p = pack8f(o1); *(u32x4*)(p + 64) = pack8f(o2);
      } }
}

__device__ __forceinline__ float ret_gamma_log2(int h) { return log2f(1.0f - exp2f(-5.0f - (float)h)); }

__device__ __forceinline__ void phase_scan_mfma(const Frame& F) {
    unsigned char* ws = F.ws_();
    constexpr int KS2 = 144, WS2 = 48;
    LAS bf16_t* Kb = (LAS bf16_t*)F.lds;
    LAS bf16_t* Wb = Kb + 2 * 64 * KS2;
    LAS float* mS = (LAS float*)(Wb + 2 * 64 * WS2);
    LAS float* fT = mS + 80;
    const bf16_t* proj = (const bf16_t*)(ws + WS_PROJ);
    const float* av = (const float*)(ws + WS_AV); const float* summ = (const float*)(ws + WS_SUMM);
    const int lane = F.lane, g = lane >> 4, li = lane & 15, w = F.wave, tid = F.tid;
    for (int item = F.wg; item < 2 * NBH * 8; item += F.nwg) {
        const int type = item >> 7, bh = (item >> 3) & 15, vs = item & 7, b = bh >> 2, h = bh & 3;
        if (tid < 64) {
            float A = summ[((size_t)bh * NCH + tid) * 2], B = summ[((size_t)bh * NCH + tid) * 2 + 1];
#pragma unroll
            for (int o = 1; o < 64; o <<= 1) { const float Ap = __shfl_up(A, o), Bp = __shfl_up(B, o); if (tid >= o) { B = fmaxf(Bp + A, B); A = Ap + A; } }
            const float m = fmaxf(A, B); mS[tid + 1] = m; if (tid == 0) mS[0] = 0.f;
            if (type == 0 && vs == 0) { float* ms = (float*)(ws + WS_MSEQ) + bh * 80; ms[tid + 1] = m; if (tid == 0) ms[0] = 0.f; } }
        if (tid >= 64 && tid < 128) fT[tid - 64] = summ[((size_t)bh * NCH + (tid - 64)) * 2];
        __syncthreads();
        const float lg2 = ret_gamma_log2(h);
        const int kcol = (type == 0 ? PC_MK : PC_RK) + h * HD, vcol = (type == 0 ? PC_MV : PC_RV) + h * HD + vs * 16;
        bf16_t* cst = (bf16_t*)(ws + WS_CST) + ((size_t)(type * NBH + bh) * NCH) * HD * HD;
        float* nsv = (float*)(ws + WS_NST) + (size_t)bh * NCH * HD;
        const int krow = tid >> 3, koct = tid & 7, vrow = (tid >> 1) & 63, vhalf = tid & 1;
        const bf16_t* kbase = proj + (size_t)(b * SEQ + krow) * NBR + kcol + koct * 8;
        const bf16_t* vbase = proj + (size_t)(b * SEQ + vrow) * NBR + vcol + vhalf * 8;
        const float* abase = av + (size_t)bh * SEQ + vrow;
        u32x4 kr[2][2], vr[2]; float ar[2];
#define SCAN_LOAD(c, sl) do { const size_t _o = (size_t)(c) * CH * NBR; kr[sl][0] = *(const u32x4*)(kbase + _o); kr[sl][1] = *(const u32x4*)(kbase + _o + 64); \
        if (tid < 128) { vr[sl] = *(const u32x4*)(vbase + _o); ar[sl] = (type == 0) ? abase[(c) * CH] : 0.f; } } while (0)
#define SCAN_WRITE(c, sl, bf) do { LAS bf16_t* _k = Kb + (bf) * 64 * KS2 + krow * KS2 + koct * 8; *(LAS u32x4*)_k = kr[sl][0]; *(LAS u32x4*)(_k + 64) = kr[sl][1]; \
        if (tid < 128) { const float _w = (type == 0) ? __expf(ar[sl] + fT[c] - mS[(c) + 1]) : exp2f((float)(63 - vrow) * lg2); float _f[8]; unpack8(vr[sl], _f); \
            _Pragma("unroll") for (int _e = 0; _e < 8; ++_e) _f[_e] *= _w; LAS bf16_t* _p = Wb + (bf) * 64 * WS2 + vrow * WS2; *(LAS u32x4*)(_p + vhalf * 8) = pack8f(_f); \
            u32x4 _x = {0u, 0u, 0u, 0u}; if (vhalf == 0) _x[0] = (unsigned)f2bf(_w); *(LAS u32x4*)(_p + 16 + vhalf * 8) = _x; } } while (0)
        f32x4 st = {0.f, 0.f, 0.f, 0.f}, na = {0.f, 0.f, 0.f, 0.f};
#define SCAN_BODY(c, bf) do { { u32x2 _pw; _pw.x = pack2(st[0], st[1]); _pw.y = pack2(st[2], st[3]); *(u32x2*)(cst + (size_t)(c) * HD * HD + (size_t)(vs * 16 + li) * HD + 16 * w + 4 * g) = _pw; } \
        if (type == 0 && vs == 0 && li == 0) *(f32x4*)(nsv + (c) * HD + 16 * w + 4 * g) = na; \
        const float _d = (type == 0) ? __expf(fT[c] + mS[c] - mS[(c) + 1]) : exp2f(64.0f * lg2); st *= _d; na *= _d; \
        _Pragma("unroll") for (int _u = 0; _u < 2; ++_u) { const LAS bf16_t* _kp = Kb + (bf) * 64 * KS2 + (32 * _u + 8 * g + (li >> 2)) * KS2 + 16 * w + 4 * (li & 3); \
            const LAS bf16_t* _wp = Wb + (bf) * 64 * WS2 + (32 * _u + 8 * g + (li >> 2)) * WS2 + 4 * (li & 3); \
            const bf16x8 _A = cat4(lds_tr(_kp), lds_tr(_kp + 4 * KS2)); const bf16x8 _B = cat4(lds_tr(_wp), lds_tr(_wp + 4 * WS2)); \
            st = __builtin_amdgcn_mfma_f32_16x16x32_bf16(_A, _B, st, 0, 0, 0); \
            if (type == 0) { const bf16x8 _B2 = cat4(lds_tr(_wp + 16), lds_tr(_wp + 4 * WS2 + 16)); na = __builtin_amdgcn_mfma_f32_16x16x32_bf16(_A, _B2, na, 0, 0, 0); } } } while (0)
        SCAN_LOAD(0, 0); SCAN_WRITE(0, 0, 0); SCAN_LOAD(1, 1); SCAN_LOAD(2, 0);
        __syncthreads();
        for (int c = 0; c < NCH; c += 2) {
            SCAN_BODY(c, 0);
            SCAN_WRITE(c + 1, 1, 1);
            if (c + 3 < NCH) SCAN_LOAD(c + 3, 1);
            __syncthreads();
            SCAN_BODY(c + 1, 1);
            if (c + 2 < NCH) { SCAN_WRITE(c + 2, 0, 0); }
            if (c + 4 < NCH) SCAN_LOAD(c + 4, 0);
            __syncthreads();
        }
#undef SCAN_LOAD
#undef SCAN_WRITE
#undef SCAN_BODY
    }
}

__device__ __forceinline__ void phase_chunk_mfma(const Frame& F, int l) {
    const KArgs a = F.ka; unsigned char* ws = F.ws_();
    constexpr int QS = 136, VS = 144, PS = 72;
    LAS bf16_t* Qs = (LAS bf16_t*)F.lds; LAS bf16_t* Ks = Qs + 64 * QS; LAS bf16_t* Vs = Ks + 64 * QS; LAS bf16_t* Ps = Vs + 64 * VS;
    LAS float* rv = (LAS float*)(Ps + 64 * PS);
    LAS float* hp = rv + 256;
    const bf16_t* proj = (const bf16_t*)(ws + WS_PROJ); unsigned char* br = ws + WS_BR;
    const float* cumf = (const float*)(ws + WS_CUMF); const float* av = (const float*)(ws + WS_AV); const float* pm = (const float*)(ws + WS_PM); const float* mseq = (const float*)(ws + WS_MSEQ);
    const int lane = F.lane, g = lane >> 4, li = lane & 15, w = F.wave;
    bf16x8 ones;
#pragma unroll
    for (int j = 0; j < 8; ++j) ones[j] = (short)0x3F80;
    u32x4 pq[2], pk[2], pvv[2]; float prv[4] = {0.f, 0.f, 0.f, 0.f};
#define CH_LOAD(it) do { const int _ty = (it) / (NBH * NCH), _bh = ((it) / NCH) % NBH, _c = (it) % NCH, _h = _bh & 3; const int _t0 = (_bh >> 2) * SEQ + _c * CH; \
        const bf16_t* _pr = proj + (size_t)(_t0 + (F.tid >> 3)) * NBR + (F.tid & 7) * 8 + _h * HD; \
        pq[0] = *(const u32x4*)(_pr + (_ty == 0 ? PC_MQ : PC_RQ)); pq[1] = *(const u32x4*)(_pr + (_ty == 0 ? PC_MQ : PC_RQ) + 64); \
        pk[0] = *(const u32x4*)(_pr + (_ty == 0 ? PC_MK : PC_RK)); pk[1] = *(const u32x4*)(_pr + (_ty == 0 ? PC_MK : PC_RK) + 64); \
        pvv[0] = *(const u32x4*)(_pr + (_ty == 0 ? PC_MV : PC_RV)); pvv[1] = *(const u32x4*)(_pr + (_ty == 0 ? PC_MV : PC_RV) + 64); \
        if (_ty == 0 && F.tid < 64) { const size_t _go = (size_t)_bh * SEQ + _c * CH + F.tid; prv[0] = av[_go]; prv[1] = pm[_go]; prv[2] = cumf[_go]; prv[3] = mseq[_bh * 80 + _c]; } } while (0)
    if (F.wg < 2 * NBH * NCH) CH_LOAD(F.wg);
    for (int item = F.wg; item < 2 * NBH * NCH; item += F.nwg) {
        const int type = item / (NBH * NCH), bh = (item / NCH) % NBH, c = item % NCH, b = bh >> 2, h = bh & 3;
        const int t0 = b * SEQ + c * CH; const size_t go = (size_t)bh * SEQ + c * CH;
        const float lg2 = ret_gamma_log2(h);
        const int vc = h * HD + 16 * w + 4 * g;
        u32x2 gate[4]; bf16x8 cfr[4]; f32x4 nr[4][2];
        const f32x4 nw4 = *(const f32x4*)((type == 0 ? ((const float*)a->in[IN_MNORM]) : ((const float*)a->in[IN_RNORM])) + l * W + vc);
#pragma unroll
        for (int tt = 0; tt < 4; ++tt) gate[tt] = *(const u32x2*)(proj + (size_t)(t0 + 16 * tt + li) * NBR + (type == 0 ? PC_MO : PC_RG) + vc);
        if (c > 0) { const bf16_t* cst = (const bf16_t*)(ws + WS_CST) + ((size_t)(type * NBH + bh) * NCH + c) * HD * HD; const float* nsv = (const float*)(ws + WS_NST) + ((size_t)bh * NCH + c) * HD;
#pragma unroll
            for (int kk = 0; kk < 4; ++kk) { cfr[kk] = *(const bf16x8*)(cst + (size_t)(16 * w + li) * HD + kk * 32 + g * 8);
                if (type == 0) { nr[kk][0] = *(const f32x4*)(nsv + kk * 32 + g * 8); nr[kk][1] = *(const f32x4*)(nsv + kk * 32 + g * 8 + 4); } } }
        { const int row = F.tid >> 3, oct = F.tid & 7;
          *(LAS u32x4*)(Qs + row * QS + oct * 8) = pq[0]; *(LAS u32x4*)(Qs + row * QS + 64 + oct * 8) = pq[1];
          *(LAS u32x4*)(Ks + row * QS + oct * 8) = pk[0]; *(LAS u32x4*)(Ks + row * QS + 64 + oct * 8) = pk[1];
          *(LAS u32x4*)(Vs + row * VS + oct * 8) = pvv[0]; *(LAS u32x4*)(Vs + row * VS + 64 + oct * 8) = pvv[1]; }
        if (F.tid < 64) { const int t = F.tid;
            if (type == 0) { const float mp = prv[3]; const float bt = fmaxf(mp, prv[1]); rv[t] = prv[0]; rv[64 + t] = bt; rv[128 + t] = __expf(mp - bt); rv[192 + t] = __expf(-prv[2] - bt); }
            else rv[128 + t] = exp2f((float)(t + 1) * lg2); }
        if (item + F.nwg < 2 * NBH * NCH) CH_LOAD(item + F.nwg);
        __syncthreads();
        { const int tt = w >> 1, t = 16 * tt + li;
#pragma unroll
          for (int sti = 0; sti < 2; ++sti) { const int st = (w & 1) * 2 + sti; f32x4 acc = {0.f, 0.f, 0.f, 0.f};
            if (st <= tt) {
#pragma unroll
                for (int kk = 0; kk < 4; ++kk) { const bf16x8 kf = *(const LAS bf16x8*)(Ks + (16 * st + li) * QS + kk * 32 + g * 8), qf = *(const LAS bf16x8*)(Qs + (16 * tt + li) * QS + kk * 32 + g * 8);
                    acc = __builtin_amdgcn_mfma_f32_16x16x32_bf16(kf, qf, acc, 0, 0, 0); }
#pragma unroll
                for (int r = 0; r < 4; ++r) { const int sx = 16 * st + 4 * g + r; float wgt;
                    if (type == 0) wgt = __expf(rv[sx] - rv[64 + t]); else wgt = exp2f((float)(t - sx) * lg2);
                    acc[r] = (sx <= t) ? acc[r] * wgt : 0.f; } }
            u32x2 pw; pw.x = pack2(acc[0], acc[1]); pw.y = pack2(acc[2], acc[3]); *(LAS u32x2*)(Ps + t * PS + 16 * st + 4 * g) = pw; } }
        __syncthreads();
        f32x4 pv[4], qc[4], dn[4], qn[4];
#pragma unroll
        for (int tt = 0; tt < 4; ++tt) { pv[tt] = (f32x4){0.f, 0.f, 0.f, 0.f}; qc[tt] = pv[tt]; dn[tt] = pv[tt]; qn[tt] = pv[tt]; }
#pragma unroll
        for (int u = 0; u < 2; ++u) {
            const bf16x8 vf = cat4(lds_tr(Vs + (32 * u + 8 * g + (li >> 2)) * VS + 16 * w + 4 * (li & 3)), lds_tr(Vs + (32 * u + 8 * g + 4 + (li >> 2)) * VS + 16 * w + 4 * (li & 3)));
#pragma unroll
            for (int tt = 0; tt < 4; ++tt) { const bf16x8 pf = *(const LAS bf16x8*)(Ps + (16 * tt + li) * PS + 32 * u + 8 * g);
                pv[tt] = __builtin_amdgcn_mfma_f32_16x16x32_bf16(vf, pf, pv[tt], 0, 0, 0);
                if (type == 0) dn[tt] = __builtin_amdgcn_mfma_f32_16x16x32_bf16(ones, pf, dn[tt], 0, 0, 0); } }
        if (c > 0) {
#pragma unroll
            for (int kk = 0; kk < 4; ++kk) { const bf16x8 cf = cfr[kk];
                bf16x8 nf = ones;
                if (type == 0) nf = pack8(nr[kk][0], nr[kk][1]);
#pragma unroll
                for (int tt = 0; tt < 4; ++tt) { const bf16x8 qf = *(const LAS bf16x8*)(Qs + (16 * tt + li) * QS + kk * 32 + g * 8);
                    qc[tt] = __builtin_amdgcn_mfma_f32_16x16x32_bf16(cf, qf, qc[tt], 0, 0, 0);
                    if (type == 0) qn[tt] = __builtin_amdgcn_mfma_f32_16x16x32_bf16(nf, qf, qn[tt], 0, 0, 0); } } }
#pragma unroll
        for (int tt = 0; tt < 4; ++tt) { const int t = 16 * tt + li; const float inter = rv[128 + t]; f32x4 hv;
            if (type == 0) { const float den = inter * qn[tt][0] + dn[tt][0]; const float rd = 1.0f / fmaxf(fabsf(den), rv[192 + t]);
                const u32x2 ow = gate[tt];
                const float o0 = __uint_as_float(ow.x << 16), o1 = __uint_as_float(ow.x & 0xffff0000u), o2 = __uint_as_float(ow.y << 16), o3 = __uint_as_float(ow.y & 0xffff0000u);
                hv[0] = sigmoidf_(o0) * (inter * qc[tt][0] + pv[tt][0]) * rd; hv[1] = sigmoidf_(o1) * (inter * qc[tt][1] + pv[tt][1]) * rd;
                hv[2] = sigmoidf_(o2) * (inter * qc[tt][2] + pv[tt][2]) * rd; hv[3] = sigmoidf_(o3) * (inter * qc[tt][3] + pv[tt][3]) * rd; }
            else hv = pv[tt] + qc[tt] * inter;
            pv[tt] = hv;
            float s1 = (hv[0] + hv[1]) + (hv[2] + hv[3]), s2 = (hv[0] * hv[0] + hv[1] * hv[1]) + (hv[2] * hv[2] + hv[3] * hv[3]);
            s1 += __shfl_xor(s1, 16); s1 += __shfl_xor(s1, 32); s2 += __shfl_xor(s2, 16); s2 += __shfl_xor(s2, 32);
            if (g == 0) { hp[(w * 64 + t) * 2] = s1; hp[(w * 64 + t) * 2 + 1] = s2; } }
        __syncthreads();
#pragma unroll
        for (int tt = 0; tt < 4; ++tt) { const int t = 16 * tt + li; float s1 = 0.f, s2 = 0.f;
#pragma unroll
            for (int ww = 0; ww < 8; ++ww) { const f32x2 p2 = *(const LAS f32x2*)(hp + (ww * 64 + t) * 2); s1 += p2.x; s2 += p2.y; }
            const float mu = s1 * (1.0f / 128.0f), var = fmaxf(s2 * (1.0f / 128.0f) - mu * mu, 0.f), rstd = rsqrtf(var + LN_EPS);
            f32x4 y = (pv[tt] - mu) * rstd * nw4;
            if (type == 1) { const u32x2 gw = gate[tt];
                const float g0 = __uint_as_float(gw.x << 16), g1 = __uint_as_float(gw.x & 0xffff0000u), g2 = __uint_as_float(gw.y << 16), g3 = __uint_as_float(gw.y & 0xffff0000u);
                y[0] *= g0 * sigmoidf_(g0); y[1] *= g1 * sigmoidf_(g1); y[2] *= g2 * sigmoidf_(g2); y[3] *= g3 * sigmoidf_(g3); }
            *(unsigned*)(br + (size_t)(t0 + t) * D + (type == 0 ? 1024 : 1536) + vc) = pack_fp8x4(y[0] * X8_SCALE, y[1] * X8_SCALE, y[2] * X8_SCALE, y[3] * X8_SCALE); }
        __syncthreads();
    }
#undef CH_LOAD
}

__device__ __forceinline__ void ln_row(float (&v)[32], const float* lw, const float* lb, int lane) {
    float s = 0.f;
#pragma unroll
    for (int j = 0; j < 32; ++j) s += v[j];
    const float mu = wave_sum(s) * (1.0f / D); float q = 0.f;
#pragma unroll
    for (int j = 0; j < 32; ++j) { const float d = v[j] - mu; q += d * d; }
    const float rstd = rsqrtf(wave_sum(q) * (1.0f / D) + LN_EPS);
#pragma unroll
    for (int j = 0; j < 4; ++j)
#pragma unroll
        for (int h = 0; h < 2; ++h) { const f32x4 w4 = *(const f32x4*)(lw + j * 512 + lane * 8 + h * 4), b4 = *(const f32x4*)(lb + j * 512 + lane * 8 + h * 4);
#pragma unroll
            for (int e = 0; e < 4; ++e) v[j * 8 + h * 4 + e] = (v[j * 8 + h * 4 + e] - mu) * rstd * w4[e] + b4[e]; }
}
__device__ __forceinline__ void phase_ln(const Frame& F, const bf16_t* y, const float* lw, const float* lb, bf16_t* xb, unsigned char* xb8) {
    const int rstep = F.nwg * 8; int row = F.wg * 8 + F.wave; if (row >= T) return;
    RawRow cur, nxt; ld_raw32(y + (size_t)row * D, F.lane, cur);
    for (; row < T; row += rstep) {
        const bool hn = row + rstep < T; if (hn) ld_raw32(y + (size_t)(row + rstep) * D, F.lane, nxt);
        float v[32]; un_raw32(cur, v);
        ln_row(v, lw, lb, F.lane);
        st_row32(xb + (size_t)row * D, F.lane, v); st_row32_fp8(xb8 + (size_t)row * D, F.lane, v);
        cur = nxt;
    }
}
__device__ __forceinline__ void split8(f32x4 a, f32x4 b, bf16x8& hi, bf16x8& lo) {
    union { u32x4 u; bf16x8 h; } H, L;
#pragma unroll
    for (int j = 0; j < 2; ++j) { const bf16_t h0 = f2bf(a[2 * j]), h1 = f2bf(a[2 * j + 1]); H.u[j] = (unsigned)h0 | ((unsigned)h1 << 16); L.u[j] = pack2(a[2 * j] - bf2f(h0), a[2 * j + 1] - bf2f(h1)); }
#pragma unroll
    for (int j = 0; j < 2; ++j) { const bf16_t h0 = f2bf(b[2 * j]), h1 = f2bf(b[2 * j + 1]); H.u[2 + j] = (unsigned)h0 | ((unsigned)h1 << 16); L.u[2 + j] = pack2(b[2 * j] - bf2f(h0), b[2 * j + 1] - bf2f(h1)); }
    hi = H.h; lo = L.h; }
__device__ __forceinline__ void phase_ln_router(const Frame& F, int l, const bf16_t* y, bf16_t* xb) {
    const KArgs a = F.ka;
    unsigned char* ws = F.ws_();
    constexpr int XS = D + 8, RB = 32;
    LAS bf16_t* xsh = (LAS bf16_t*)F.lds;
    LAS float* part = (LAS float*)F.lds;
    LAS int* lcnt = (LAS int*)(xsh + RB * XS);
    if (F.tid < 128) lcnt[F.tid] = 0;
    __syncthreads();
    const float* lw = ((const float*)a->in[IN_LNW]) + ((size_t)l * 3 + 1) * D; const float* lb = ((const float*)a->in[IN_LNB]) + ((size_t)l * 3 + 1) * D;
    const bf16_t* rwt = (const bf16_t*)(ws + WS_RWT) + (size_t)l * 2 * NE * D; const float* rb = ((const float*)a->in[IN_RB]) + l * NE;
    unsigned* counts = (unsigned*)(ws + WS_CTL) + CW_COUNTS + l * 64 * CW_CSTRIDE;
    int* eid = (int*)(ws + WS_EID); float* ew = (float*)(ws + WS_EW); int* epos = (int*)(ws + WS_EPOS);
    const int lane = F.lane, g = lane >> 4, li = lane & 15, nt = F.wave & 3, kh = F.wave >> 2;
    for (int blk = F.wg; blk < T / RB; blk += F.nwg) {
        RawRow raw[4];
#pragma unroll
        for (int rr = 0; rr < 4; ++rr) ld_raw32(y + (size_t)(blk * RB + F.wave * 4 + rr) * D, F.lane, raw[rr]);
#pragma unroll
        for (int rr = 0; rr < 4; ++rr) {
            const int lr = F.wave * 4 + rr, row = blk * RB + lr;
            float v[32]; un_raw32(raw[rr], v);
            ln_row(v, lw, lb, F.lane);
            st_row32(xb + (size_t)row * D, F.lane, v); st_row32_fp8(ws + WS_XB8 + (size_t)row * D, F.lane, v);
#pragma unroll
            for (int j = 0; j < 4; ++j) { u32x4 hi;
#pragma unroll
                for (int e2 = 0; e2 < 4; ++e2) hi[e2] = pack2(v[j * 8 + 2 * e2], v[j * 8 + 2 * e2 + 1]);
                *(LAS u32x4*)(xsh + lr * XS + j * 512 + F.lane * 8) = hi; }
        }
        __syncthreads();
        f32x4 acc[2] = {{0.f, 0.f, 0.f, 0.f}, {0.f, 0.f, 0.f, 0.f}};
        { const bf16_t* wh = rwt + (size_t)(16 * nt + li) * D + kh * 1024 + g * 8; const bf16_t* wl = wh + (size_t)NE * D;
          const LAS bf16_t* xr = xsh + li * XS + kh * 1024 + g * 8;
#pragma unroll 8
          for (int ks = 0; ks < 32; ++ks) { const bf16x8 bh = *(const bf16x8*)(wh + ks * 32), bl = *(const bf16x8*)(wl + ks * 32);
#pragma unroll
              for (int mt = 0; mt < 2; ++mt) { const bf16x8 xh = *(const LAS bf16x8*)(xr + mt * 16 * XS + ks * 32);
                  acc[mt] = __builtin_amdgcn_mfma_f32_16x16x32_bf16(xh, bh, acc[mt], 0, 0, 0); acc[mt] = __builtin_amdgcn_mfma_f32_16x16x32_bf16(xh, bl, acc[mt], 0, 0, 0); } } }
        __syncthreads();
#pragma unroll
        for (int mt = 0; mt < 2; ++mt)
#pragma unroll
            for (int r = 0; r < 4; ++r) part[(kh * RB + 16 * mt + 4 * g + r) * 64 + 16 * nt + li] = acc[mt][r];
        __syncthreads();
        const int e = F.lane;
        const float bias = rb[e];
        for (int rr = 0; rr < 4; ++rr) {
            const int lr = F.wave * 4 + rr, row = blk * RB + lr;
            const float sc = sigmoidf_(part[lr * 64 + e] + part[(RB + lr) * 64 + e]), bs = sc + bias;
            float m1 = bs; m1 = fmaxf(m1, __shfl_xor(m1, 1)); m1 = fmaxf(m1, __shfl_xor(m1, 2)); m1 = fmaxf(m1, __shfl_xor(m1, 4));
            const unsigned long long eq = __ballot(bs == m1); const int gq = e >> 3; const unsigned gm = (unsigned)(eq >> (gq * 8)) & 0xffu; const int first = gq * 8 + __builtin_ctz(gm);
            float m2 = (e == first) ? -INFINITY : bs; m2 = fmaxf(m2, __shfl_xor(m2, 1)); m2 = fmaxf(m2, __shfl_xor(m2, 2)); m2 = fmaxf(m2, __shfl_xor(m2, 4));
            const float gs = m1 + m2;
            int grank = 0;
#pragma unroll
            for (int g2 = 0; g2 < 8; ++g2) { const float o = __shfl(gs, g2 * 8); grank += (o > gs || (o == gs && g2 < gq)) ? 1 : 0; }
            const bool gsel = grank < 4;
            const float val = gsel ? bs : -INFINITY;
            int rank = 0;
            for (int e2 = 0; e2 < 64; ++e2) { const float o = __shfl(val, e2); rank += (o > val || (o == val && e2 < e)) ? 1 : 0; }
            const bool sel = gsel && rank < TOPK;
            const float wsum = wave_sum(sel ? sc : 0.f);
            const unsigned long long sm = __ballot(sel);
            if (sel) { const int k = __builtin_popcountll(sm & ((1ull << e) - 1ull));
                const int pos = __hip_atomic_fetch_add((int*)lcnt + e, 1, __ATOMIC_RELAXED, __HIP_MEMORY_SCOPE_WORKGROUP);
                eid[(size_t)row * 8 + k] = e; ew[(size_t)row * 8 + k] = sc / wsum * ROUTE_SCALE; epos[(size_t)row * 8 + k] = pos; }
        }
        __syncthreads();
    }
    if (F.tid < 64) { const int n = lcnt[F.tid]; lcnt[64 + F.tid] = n > 0 ? (int)__hip_atomic_fetch_add(counts + F.tid * CW_CSTRIDE, (unsigned)n, __ATOMIC_RELAXED, __HIP_MEMORY_SCOPE_AGENT) : 0; }
    asm volatile("s_waitcnt vmcnt(0)" ::: "memory");
    __syncthreads();
    { int* tokl = (int*)(ws + WS_TOKL); float* wl = (float*)(ws + WS_WL);
      for (int blk = F.wg; blk < T / RB; blk += F.nwg) { if (F.tid < RB * 8) { const size_t i = (size_t)blk * (RB * 8) + F.tid; const int e = eid[i]; const int p = epos[i] + lcnt[64 + e]; epos[i] = p; tokl[(size_t)e * T + p] = (int)(i >> 3); wl[(size_t)e * T + p] = ew[i]; } } }
    __syncthreads();
}
template <bool TEXP = true> __device__ __forceinline__ void build_pstart(const Frame& F, int l, LAS int* pst) {
    const unsigned* counts = (const unsigned*)(F.ws_() + WS_CTL) + CW_COUNTS + l * 64 * CW_CSTRIDE;
    if (F.tid < 64) {
        const int c = (int)__hip_atomic_load(counts + F.tid * CW_CSTRIDE, __ATOMIC_RELAXED, __HIP_MEMORY_SCOPE_AGENT); const int pc = (c + 255) & ~255; int inc = pc;
#pragma unroll
        for (int o = 1; o < 64; o <<= 1) { const int n = __shfl_up(inc, o); if (F.tid >= o) inc += n; }
        pst[F.tid] = inc - pc; pst[PST_CNT + F.tid] = c; if (F.tid == 63) { pst[NE] = inc; pst[NE + 1] = inc + T; } }
    __syncthreads();
    if (TEXP) { LAS unsigned char* texp = (LAS unsigned char*)(pst + 68);
      for (int rt = F.tid; rt < (pst[NE + 1] >> 8); rt += NTHR) { int lo = 0, hi = NE;
#pragma unroll
          for (int it = 0; it < 7; ++it) { const int mid = (lo + hi) >> 1; const bool up = lo < hi && pst[mid + 1] <= rt * 256; const bool dn = lo < hi && !up; lo = up ? mid + 1 : lo; hi = dn ? mid : hi; }
          texp[rt] = (unsigned char)lo; } }
    __syncthreads();
}
__device__ __forceinline__ void phase_combine_ln(const Frame& F, int l, bf16_t* xb, float* out) {
    const KArgs a = F.ka;
    unsigned char* ws = F.ws_();
    LAS int* pst = (LAS int*)F.lds;
    build_pstart<false>(F, l, pst);
    const int sh0 = pst[NE];
    const int* eid = (const int*)(ws + WS_EID); const int* epos = (const int*)(ws + WS_EPOS); const unsigned char* yb = ws + WS_YB;
    const float* lw = ((const float*)a->in[IN_LNW]) + ((size_t)l * 3 + 2) * D; const float* lb = ((const float*)a->in[IN_LNB]) + ((size_t)l * 3 + 2) * D;
    const int rstep = F.nwg * 8;
    u32x4 ix[4];
    RawRow xraw;
    { const int r0 = F.wg * 8 + F.wave; if (r0 < T) { ld_raw32(xb + (size_t)r0 * D, F.lane, xraw); ix[0] = *(const u32x4*)(eid + (size_t)r0 * 8); ix[1] = *(const u32x4*)(eid + (size_t)r0 * 8 + 4); ix[2] = *(const u32x4*)(epos + (size_t)r0 * 8); ix[3] = *(const u32x4*)(epos + (size_t)r0 * 8 + 4); } }
    for (int row = F.wg * 8 + F.wave; row < T; row += rstep) {
        int slots[8];
#pragma unroll
        for (int k = 0; k < 8; ++k) slots[k] = pst[(int)ix[k >> 2][k & 3]] + (int)ix[2 + (k >> 2)][k & 3];
        if (row + rstep < T) { const size_t rn = (size_t)(row + rstep) * 8; ix[0] = *(const u32x4*)(eid + rn); ix[1] = *(const u32x4*)(eid + rn + 4); ix[2] = *(const u32x4*)(epos + rn); ix[3] = *(const u32x4*)(epos + rn + 4); }
        float v[32]; un_raw32(xraw, v);
        if (row + rstep < T) ld_raw32(xb + (size_t)(row + rstep) * D, F.lane, xraw);
#pragma unroll
        for (int j = 0; j < 32; ++j) v[j] *= ALPHA;
        float ys[32];
#pragma unroll
        for (int j = 0; j < 32; ++j) ys[j] = 0.f;
#pragma unroll 3
        for (int k = 0; k < 9; ++k) { const int slot = k < 8 ? slots[k < 8 ? k : 0] : sh0 + row; const unsigned char* yr = yb + (size_t)slot * D;
#pragma unroll
            for (int j = 0; j < 4; ++j) { const u32x2 w = *(const u32x2*)(yr + j * 512 + F.lane * 8);
                const f32x2 p0 = __builtin_amdgcn_cvt_pk_f32_fp8((int)w.x, false), p1 = __builtin_amdgcn_cvt_pk_f32_fp8((int)w.x, true), p2 = __builtin_amdgcn_cvt_pk_f32_fp8((int)w.y, false), p3 = __builtin_amdgcn_cvt_pk_f32_fp8((int)w.y, true);
                ys[j * 8] += p0.x; ys[j * 8 + 1] += p0.y; ys[j * 8 + 2] += p1.x; ys[j * 8 + 3] += p1.y; ys[j * 8 + 4] += p2.x; ys[j * 8 + 5] += p2.y; ys[j * 8 + 6] += p3.x; ys[j * 8 + 7] += p3.y; } }
#pragma unroll
        for (int j = 0; j < 32; ++j) v[j] += ys[j] * (1.0f / Y8_SCALE);
        ln_row(v, lw, lb, F.lane);
        if (out) {
#pragma unroll
            for (int j = 0; j < 4; ++j) { *(f32x4*)(out + (size_t)row * D + j * 512 + F.lane * 8) = (f32x4){v[j * 8], v[j * 8 + 1], v[j * 8 + 2], v[j * 8 + 3]}; *(f32x4*)(out + (size_t)row * D + j * 512 + F.lane * 8 + 4) = (f32x4){v[j * 8 + 4], v[j * 8 + 5], v[j * 8 + 6], v[j * 8 + 7]}; }
        } else { st_row32(xb + (size_t)row * D, F.lane, v); st_row32_fp8(ws + WS_XB8 + (size_t)row * D, F.lane, v); st_row32_i8(ws + WS_XQ8 + (size_t)row * D, (float*)(ws + WS_XSC) + row, F.lane, v); }
    }
    __syncthreads();
}

__device__ __forceinline__ void phase_attn_mfma(const Frame& F, int l) {
    unsigned char* ws = F.ws_();
    constexpr int KS = 136, VS = 144;
    LAS bf16_t* Ks = (LAS bf16_t*)F.lds; LAS bf16_t* Vs = Ks + 256 * KS;
    const bf16_t* q = (const bf16_t*)(ws + WS_Q); const bf16_t* km = (const bf16_t*)(ws + WS_KM) + (size_t)l * TM * W; const bf16_t* vm = (const bf16_t*)(ws + WS_VM) + (size_t)l * TM * W;
    unsigned char* o = ws + WS_O;
    const int nunit = (T / 128) * 4, upw = (nunit + F.nwg - 1) / F.nwg;
    const int lane = F.lane, g = lane >> 4, li = lane & 15;
    int loaded = -1;
    const int u_end = (F.wg + 1) * upw < nunit ? (F.wg + 1) * upw : nunit;
    for (int u = F.wg * upw; u < u_end; ++u) {
        const int bh = u >> 5, blk = u & 31, b = bh >> 2, hh = bh & 3;
        if (bh != loaded) {
            __syncthreads();
            const int m = F.tid >> 1, half = F.tid & 1;
            const bf16_t* kr = km + (size_t)(b * MEM + m) * W + hh * HD + half * 64; const bf16_t* vr = vm + (size_t)(b * MEM + m) * W + hh * HD + half * 64;
#pragma unroll
            for (int j = 0; j < 8; ++j) { *(LAS u32x4*)(Ks + m * KS + half * 64 + j * 8) = *(const u32x4*)(kr + j * 8); *(LAS u32x4*)(Vs + m * VS + half * 64 + j * 8) = *(const u32x4*)(vr + j * 8); }
            __syncthreads(); loaded = bh;
        }
        const int t0 = b * SEQ + blk * 128 + F.wave * 16;
        bf16x8 qf[4];
#pragma unroll
        for (int kk = 0; kk < 4; ++kk) qf[kk] = *(const bf16x8*)(q + (size_t)(t0 + li) * W + hh * HD + kk * 32 + g * 8);
        f32x4 sacc[16];
#pragma unroll
        for (int tt = 0; tt < 16; ++tt) { f32x4 acc = {0.f, 0.f, 0.f, 0.f};
#pragma unroll
            for (int kk = 0; kk < 4; ++kk) { const bf16x8 kf = *(const LAS bf16x8*)(Ks + (16 * tt + li) * KS + kk * 32 + g * 8); acc = __builtin_amdgcn_mfma_f32_16x16x32_bf16(kf, qf[kk], acc, 0, 0, 0); }
            sacc[tt] = acc; }
        float mx = -INFINITY;
#pragma unroll
        for (int tt = 0; tt < 16; ++tt) mx = fmaxf(mx, fmaxf(fmaxf(sacc[tt][0], sacc[tt][1]), fmaxf(sacc[tt][2], sacc[tt][3])));
        mx = fmaxf(mx, __shfl_xor(mx, 16)); mx = fmaxf(mx, __shfl_xor(mx, 32));
        const float c2 = 0.08838834764831845f * 1.4426950408889634f; float sum = 0.f;
#pragma unroll
        for (int tt = 0; tt < 16; ++tt)
#pragma unroll
            for (int r = 0; r < 4; ++r) { const float p = exp2f((sacc[tt][r] - mx) * c2); sacc[tt][r] = p; sum += p; }
        sum += __shfl_xor(sum, 16); sum += __shfl_xor(sum, 32);
        const float rs = 1.0f / sum;
        bf16x8 pk[8];
#pragma unroll
        for (int u8 = 0; u8 < 8; ++u8) pk[u8] = pack8(sacc[2 * u8], sacc[2 * u8 + 1]);
#pragma unroll
        for (int dvt = 0; dvt < 8; ++dvt) { f32x4 acc = {0.f, 0.f, 0.f, 0.f};
#pragma unroll
            for (int u8 = 0; u8 < 8; ++u8) { const s16x4 a0 = lds_tr(Vs + (32 * u8 + 4 * g + (li >> 2)) * VS + dvt * 16 + 4 * (li & 3)); const s16x4 a1 = lds_tr(Vs + (32 * u8 + 16 + 4 * g + (li >> 2)) * VS + dvt * 16 + 4 * (li & 3));
                acc = __builtin_amdgcn_mfma_f32_16x16x32_bf16(cat4(a0, a1), pk[u8], acc, 0, 0, 0); }
            { const f32x4 ov = acc * (rs * O8_SCALE); *(unsigned*)(o + (size_t)(t0 + li) * W + hh * HD + dvt * 16 + 4 * g) = pack_fp8x4(ov[0], ov[1], ov[2], ov[3]); } }
    }
    __syncthreads();
}

template <class Epi>
__device__ __forceinline__ void gemm_dense_mfma(const Frame& F, const bf16_t* A, const bf16_t* Bt, int M, int N, int K, const Epi& E) {
    DenseSched S; S.A = A; S.Bt = Bt; S.K = K; S.nM = M / 256; S.nN = N / 256; S.nwg = S.nM * S.nN; S.G = F.nwg; S.c = F.wg; S.i0 = 0; S.i1 = 1 << 30; S.pnoff = 0;
    gemm_phase_mfma(F, K, S, E);
}
constexpr int NPL = 14, NPHASE = 1 + DEPTH * NPL;
#ifndef NCONV
#define NCONV 40
#endif
#if MK_PER_PHASE
#define IN(k) (lo <= (k) && (k) < hi)
#define SEAM(k) do { if (IN((k) + 1)) { XcdBarrier b2_ = bar; asm volatile("" : "+s"(b2_.bar)); asm volatile("" : "+s"(b2_.x)); xcd_barrier(b2_); } } while (0)
#else
#define IN(k) true
#define SEAM(k) do { if ((k) + 1 < NPHASE) for (int rb_ = 0; rb_ < ((PROBE_DBL & 4096) ? 3 : 1); ++rb_) { XcdBarrier b2_ = bar; asm volatile("" : "+s"(b2_.bar)); asm volatile("" : "+s"(b2_.x)); xcd_barrier(b2_); } } while (0)
#endif
template <int l> __device__ __forceinline__ void run_layer(const Frame& F0, const XcdBarrier& bar, int lo, int hi) {
    const int pb = 1 + l * NPL;
    if (IN(pb + 0)) { const Frame F = fresh(F0); unsigned char* ws = F.ws_();
        EpiProj E{(bf16_t*)(ws + WS_PROJ), (bf16_t*)(ws + WS_GATES)};
        { DenseSched S; S.A = (const bf16_t*)(ws + WS_XQ8); S.Bt = (const bf16_t*)(ws + WS_WINQ + l * SZ_WINQ); S.K = D / 2; S.nM = T / 256; S.nN = NBR / 256; S.nwg = S.nM * S.nN; S.G = F.nwg; S.c = F.wg; S.i0 = 0; S.i1 = 1 << 30; S.pnoff = 0;
          const float wsc = __uint_as_float(((const unsigned*)(ws + WS_CTL))[CW_WABS + l * 32]) * (1.0f / 127.0f);
          gemm_phase_mfma<EpiProj, DenseSched, 2>(F, D, S, E, wsc, (const float*)(ws + WS_XSC)); }
        { const Frame F2 = fresh(F0); unsigned char* ws2 = F2.ws_(); EpiProj E2{(bf16_t*)(ws2 + WS_PROJ), (bf16_t*)(ws2 + WS_GATES)};
          DenseSched S; S.A = (const bf16_t*)(ws2 + WS_XB8); S.Bt = (const bf16_t*)(ws2 + WS_WIN8 + l * SZ_WIN8 + (size_t)NBR * D); S.K = D / 2; S.nM = T / 256; S.nN = (NPROJ - NBR) / 256; S.nwg = S.nM * S.nN; S.G = F2.nwg; S.c = F2.wg; S.i0 = 0; S.i1 = 1 << 30; S.pnoff = NBR / 256;
          gemm_phase_mfma<EpiProj, DenseSched, 1>(F2, D, S, E2, 1.0f / (X8_SCALE * W8_SCALE)); if (PROBE_DBL & 64) gemm_phase_mfma<EpiProj, DenseSched, 1>(F2, D, S, E2, 1.0f / (X8_SCALE * W8_SCALE)); }
        SEAM(pb + 0); }
    if (IN(pb + 1)) { const Frame F = fresh(F0); phase_mix1v2(F, l, (const bf16_t*)(F.ws_() + WS_XB)); if (PROBE_DBL & 8192) { const Frame G = fresh(F0); phase_mix1v2<false>(G, l, (const bf16_t*)(G.ws_() + WS_XB)); } SEAM(pb + 1); }
    if (IN(pb + 2)) { const Frame F = fresh(F0); phase_scan_mfma(F); if (PROBE_DBL & 2) { const Frame G = fresh(F0); phase_scan_mfma(G); } SEAM(pb + 2); }
    if (IN(pb + 3)) { const Frame F = fresh(F0); phase_chunk_mfma(F, l); if (PROBE_DBL & 4) { const Frame G = fresh(F0); phase_chunk_mfma(G, l); } SEAM(pb + 3); }
    if (IN(pb + 4)) { const Frame F = fresh(F0); unsigned char* ws = F.ws_();
        EpiBranch E{ws + WS_GATES, ws + WS_MRG};
        DenseSched S; S.A = (const bf16_t*)(ws + WS_BR); S.Bt = (const bf16_t*)(ws + WS_WB + l * SZ_DD); S.K = D / 2; S.nM = T / 256; S.nN = D / 256; S.nwg = S.nM * S.nN; S.G = F.nwg; S.c = F.wg; S.i0 = 0; S.i1 = 1 << 30; S.pnoff = 0;
        gemm_phase_mfma<EpiBranch, DenseSched, 1>(F, D, S, E, 1.0f / (X8_SCALE * W8_SCALE)); SEAM(pb + 4); }
    if (IN(pb + 5)) { const Frame F = fresh(F0); unsigned char* ws = F.ws_();
        EpiResid E{(const bf16_t*)(ws + WS_XB), (bf16_t*)(ws + WS_Y)};
        DenseSched S; S.A = (const bf16_t*)(ws + WS_MRG); S.Bt = (const bf16_t*)(ws + WS_WOUT + l * SZ_DD); S.K = D / 2; S.nM = T / 256; S.nN = D / 256; S.nwg = S.nM * S.nN; S.G = F.nwg; S.c = F.wg; S.i0 = 0; S.i1 = 1 << 30; S.pnoff = 0;
        gemm_phase_mfma<EpiResid, DenseSched, 1>(F, D, S, E, 1.0f / (X8_SCALE * W8_SCALE)); SEAM(pb + 5); }
    if (IN(pb + 6)) { const Frame F = fresh(F0); unsigned char* ws = F.ws_();
        phase_ln(F, (const bf16_t*)(ws + WS_Y), ((const float*)F.ka->in[IN_LNW]) + (size_t)l * 3 * D, ((const float*)F.ka->in[IN_LNB]) + (size_t)l * 3 * D, (bf16_t*)(ws + WS_XB), ws + WS_XB8); SEAM(pb + 6); }
    if (IN(pb + 7)) { const Frame F = fresh(F0);
        EpiQKV E{}; QkvSched S; S.ws = F.ws_(); S.l = l; S.G = F.nwg; S.c = F.wg; gemm_phase_mfma<EpiQKV, QkvSched, 1>(F, D, S, E, 1.0f / (X8_SCALE * W8_SCALE)); SEAM(pb + 7); }
    if (IN(pb + 8)) { const Frame F = fresh(F0); phase_attn_mfma(F, l); if (PROBE_DBL & 8) { const Frame G = fresh(F0); phase_attn_mfma(G, l); } SEAM(pb + 8); }
    if (IN(pb + 9)) { const Frame F = fresh(F0); unsigned char* ws = F.ws_();
        EpiResid E{(const bf16_t*)(ws + WS_XB), (bf16_t*)(ws + WS_Y)};
        DenseSched S; S.A = (const bf16_t*)(ws + WS_O); S.Bt = (const bf16_t*)(ws + WS_WO + l * SZ_WQ); S.K = W / 2; S.nM = T / 256; S.nN = D / 256; S.nwg = S.nM * S.nN; S.G = F.nwg; S.c = F.wg; S.i0 = 0; S.i1 = 1 << 30; S.pnoff = 0;
        gemm_phase_mfma<EpiResid, DenseSched, 1>(F, W, S, E, 1.0f / (O8_SCALE * W8_SCALE)); SEAM(pb + 9); }
    if (IN(pb + 10)) { const Frame F = fresh(F0); unsigned char* ws = F.ws_(); phase_ln_router(F, l, (const bf16_t*)(ws + WS_Y), (bf16_t*)(ws + WS_XB)); SEAM(pb + 10); }
    if (IN(pb + 11)) { const Frame F = fresh(F0); unsigned char* ws = F.ws_();
        LAS int* pst = (LAS int*)(F.lds + LDS_BYTES - 2048); build_pstart(F, l, pst);
        const int nrt = pst[NE + 1] >> 8; EpiSwiglu E{ws + WS_HB};
        MoeSched<4, true> S; S.ws = ws; S.pst = pst; S.l = l; S.G = F.nwg; S.c = F.wg; S.nunits = nrt * 4; gemm_phase_mfma<EpiSwiglu, MoeSched<4, true>, 1>(F, D, S, E, 1.0f / (X8_SCALE * W8_SCALE)); SEAM(pb + 11); }
    if (IN(pb + 12)) { const Frame F = fresh(F0); unsigned char* ws = F.ws_();
        LAS int* pst = (LAS int*)(F.lds + LDS_BYTES - 2048); build_pstart(F, l, pst);
        const int nrt = pst[NE + 1] >> 8; EpiDown E{ws + WS_YB};
        MoeSched<8, false> S; S.ws = ws; S.pst = pst; S.l = l; S.G = F.nwg; S.c = F.wg; S.nunits = nrt * 8; gemm_phase_mfma<EpiDown, MoeSched<8, false>, 1>(F, ED, S, E, Y8_SCALE / (H8_SCALE * W8_SCALE)); SEAM(pb + 12); }
    if (IN(pb + 13)) { const Frame F = fresh(F0); phase_combine_ln(F, l, (bf16_t*)(F.ws_() + WS_XB), l == DEPTH - 1 ? ((float*)F.ka->out) : (float*)nullptr); if ((PROBE_DBL & 16384) && l == DEPTH - 1) { const Frame G = fresh(F0); phase_combine_ln(G, l, (bf16_t*)(G.ws_() + WS_XB), ((float*)G.ka->out)); } SEAM(pb + 13); }
}

__global__ void __launch_bounds__(NTHR, 2) fwd(Args args_unused) {
    asm volatile("s_setreg_imm32_b32 hwreg(HW_REG_MODE, 23, 1), 1" ::: "memory");
    extern __shared__ __attribute__((aligned(16))) unsigned char lds_raw[];
    Frame F0; F0.lds = (LAS unsigned char*)lds_raw; F0.tid = threadIdx.x; F0.lane = F0.tid & 63; F0.wave = __builtin_amdgcn_readfirstlane(F0.tid >> 6); F0.wg = blockIdx.x; F0.nwg = gridDim.x;
    F0.ka = (KArgs)__builtin_amdgcn_kernarg_segment_ptr(); F0.wsg = F0.ka->ws;
    volatile LAS unsigned* xbw = (volatile LAS unsigned*)(F0.lds + LDS_BYTES - 16);
    if (F0.tid == 0) { xbw[0] = 0u; xbw[1] = 0u; }
    __syncthreads();
    XcdBarrier bar; bar.bar = (unsigned*)(F0.ws_() + WS_CTL); bar.x = 0; bar.st = xbw;
#if MK_PER_PHASE
    const int lo = F0.ka->ph_lo, hi = F0.ka->ph_hi;
    if (hi - lo > 1) bar = xcd_barrier_post((unsigned*)(F0.ws_() + WS_CTL), xbw);
#else
    const int lo = 0, hi = NPHASE;
    bar = xcd_barrier_post((unsigned*)(F0.ws_() + WS_CTL), xbw);
#endif
    if (IN(0)) { { const Frame F = fresh(F0); phase_wabs(F); } { XcdBarrier b2_ = bar; asm volatile("" : "+s"(b2_.bar)); asm volatile("" : "+s"(b2_.x)); xcd_barrier(b2_); }
        const Frame F = fresh(F0); phase_prologue(F); { const Frame G = fresh(F0); prologue_deferred(G, G.wg, G.nwg); } SEAM(0); }
    run_layer<0>(F0, bar, lo, hi);
    run_layer<1>(F0, bar, lo, hi);
#undef IN
#undef SEAM
}

extern "C" void kernel_launch(void* const* d_in, const int* in_sizes, int n_in, void* d_out, int out_size, void* d_ws, size_t ws_size, hipStream_t stream) {
    static int grid = 0;
    if (grid == 0) {
        if (n_in != 23 || ws_size < WS_END) { fprintf(stderr, "kernel_launch: unexpected inputs (n_in %d, ws %zu < %zu)\n", n_in, ws_size, (size_t)WS_END); grid = -1; return; }
        int dev = 0, cus = 0, per_cu = 0;
        if (hipGetDevice(&dev) != hipSuccess || hipDeviceGetAttribute(&cus, hipDeviceAttributeMultiprocessorCount, dev) != hipSuccess) { grid = -1; return; }
        if (hipFuncSetAttribute((const void*)fwd, hipFuncAttributeMaxDynamicSharedMemorySize, LDS_BYTES) != hipSuccess) { fprintf(stderr, "kernel_launch: hipFuncSetAttribute failed\n"); grid = -1; return; }
        if (hipOccupancyMaxActiveBlocksPerMultiprocessor(&per_cu, (const void*)fwd, NTHR, LDS_BYTES) != hipSuccess || per_cu < 1) { fprintf(stderr, "kernel_launch: occupancy query says %d\n", per_cu); }
        (void)hipGetLastError();
        grid = cus;
    }
    if (grid < 0) return;
    (void)hipMemsetAsync((char*)d_ws + WS_CTL, 0, CTL_BYTES, stream);
    Args a{};
    for (int i = 0; i < 23; ++i) a.in[i] = (const float*)d_in[i];
    a.out = (float*)d_out; a.ws = (unsigned char*)d_ws;
#if MK_PER_PHASE
    for (int p = 0; p < NPHASE; ++p) { a.ph_lo = p; a.ph_hi = p + 1; hipLaunchKernelGGL(fwd, dim3(grid), dim3(NTHR), LDS_BYTES, stream, a); }
#else
    a.ph_lo = 0; a.ph_hi = NPHASE;
    hipLaunchKernelGGL(fwd, dim3(grid), dim3(NTHR), LDS_BYTES, stream, a);
#endif
    const hipError_t le = hipPeekAtLastError();
    if (le != hipSuccess) fprintf(stderr, "kernel_launch: launch failed: %s\n", hipGetErrorName(le));
}
```
